# Optimizing an MI355X kernel written in HIP

```python
import math
import jax, jax.numpy as jnp
from jax import lax
import numpy as np

D_MODEL = 1024
BATCH = 4
SEQ = 8192
DEPTH = 2

N_HEADS = 16
HEAD_DIM = D_MODEL // N_HEADS
ROPE_THETA = 10000.0
N_MIXERS = 2
DN_ALPHA = (2 * DEPTH) ** 0.25
DN_BETA = (8 * DEPTH) ** -0.25
LN_EPS = 1e-5
NEG = -1e30
FORCE = 1e9

NSA_KV_GROUPS = 4
NSA_HPG = N_HEADS // NSA_KV_GROUPS
NSA_KV_DIM = NSA_KV_GROUPS * HEAD_DIM
NSA_CMP_LEN = 32
NSA_CMP_STRIDE = 16
NSA_CMP_HIDDEN = 256
NSA_SEL_BLOCK = 64
NSA_SEL_TOPN = 16
NSA_WINDOW = 512
NSA_QB = 64
NSA_IN_DIM = D_MODEL + 6 * NSA_KV_DIM + 3 * N_HEADS

MOBA_BLOCK = 256
MOBA_TOPK = 3
MOBA_QB = 16
MOBA_IN_DIM = 3 * D_MODEL

N_EXPERTS = 16
N_GROUPS = 4
EXPERTS_PER_GROUP = N_EXPERTS // N_GROUPS
TOP_K = 2
D_EXPERT = 512

N_NSA_LAYERS = (DEPTH + 1) // 2
N_MOBA_LAYERS = DEPTH // 2

kernel_name = 'nsa_moba_interleaved_grouped_moe_deepnorm'


def layer_norm(x, g, b):
    xf = x.astype(jnp.float32)
    mu = xf.mean(-1, keepdims=True)
    var = jnp.mean(jnp.square(xf - mu), -1, keepdims=True)
    return ((xf - mu) * lax.rsqrt(var + LN_EPS) * g.astype(jnp.float32) + b.astype(jnp.float32)).astype(x.dtype)


def rope_tables(pos):
    inv = 1.0 / (ROPE_THETA ** (jnp.arange(0, HEAD_DIM, 2, dtype=jnp.float32) / HEAD_DIM))
    ang = pos.astype(jnp.float32)[:, None] * inv[None, :]
    return jnp.cos(ang), jnp.sin(ang)


def apply_rope(x, cos, sin):
    x1, x2 = jnp.split(x.astype(jnp.float32), 2, axis=-1)
    return jnp.concatenate([x1 * cos - x2 * sin, x2 * cos + x1 * sin], axis=-1).astype(x.dtype)


def _split_heads(t, n):
    B, S, _ = t.shape
    return t.reshape(B, S, n, HEAD_DIM).transpose(0, 2, 1, 3)


def _merge_chunks(o):
    nc, B, H, qb, dh = o.shape
    return o.transpose(1, 0, 3, 2, 4).reshape(B, nc * qb, H * dh)


def nsa_mixer(h, w_in, w_out, cmp_k_w1, cmp_k_w2, cmp_v_w1, cmp_v_w2, cmp_k_pos, cmp_v_pos):
    B, S, _ = h.shape
    G, HPG, dh = NSA_KV_GROUPS, NSA_HPG, HEAD_DIM
    L, STR, SB, W, QB = NSA_CMP_LEN, NSA_CMP_STRIDE, NSA_SEL_BLOCK, NSA_WINDOW, NSA_QB
    n_cmp = (S - L) // STR + 1
    n_sel = S // SB
    top_n = min(NSA_SEL_TOPN, n_sel)
    scale = dh ** -0.5

    proj = h @ w_in
    splits = np.cumsum([D_MODEL] + [NSA_KV_DIM] * 6).tolist()
    q, kc_raw, vc_raw, ks, vs, kw, vw, gates = jnp.split(proj, splits, axis=-1)

    cos, sin = rope_tables(jnp.arange(S))
    q = apply_rope(_split_heads(q, N_HEADS), cos, sin).reshape(B, G, HPG, S, dh)
    ks = apply_rope(_split_heads(ks, G), cos, sin)
    kw = apply_rope(_split_heads(kw, G), cos, sin)
    vs = _split_heads(vs, G)
    vw = _split_heads(vw, G)

    win_idx = jnp.arange(n_cmp)[:, None] * STR + jnp.arange(L)[None, :]
    cmp_end = win_idx[:, -1]

    def compress(t, pos_emb, w1, w2):
        blocks = _split_heads(t, G)[:, :, win_idx] + pos_emb
        return jax.nn.gelu(blocks.reshape(B, G, n_cmp, L * dh) @ w1) @ w2

    ccos, csin = rope_tables(cmp_end)
    kc = apply_rope(compress(kc_raw, cmp_k_pos, cmp_k_w1, cmp_k_w2), ccos, csin)
    vc = compress(vc_raw, cmp_v_pos, cmp_v_w1, cmp_v_w2)

    ci = jnp.arange(n_cmp)[:, None]
    sj = jnp.arange(n_sel)[None, :]
    overlap = ((ci * STR < (sj + 1) * SB) & (ci * STR + L > sj * SB)).astype(jnp.float32)

    ks_blk = ks.reshape(B, G, n_sel, SB, dh)
    vs_blk = vs.reshape(B, G, n_sel, SB, dh)
    pad = ((0, 0), (0, 0), (W, 0), (0, 0))
    kw_pad = jnp.pad(kw, pad)
    vw_pad = jnp.pad(vw, pad)
    bi = jnp.arange(B)[:, None, None, None]
    gi = jnp.arange(G)[None, :, None, None]
    blk_ids = jnp.arange(n_sel)

    def chunk(c):
        s0 = c * QB
        tq = s0 + jnp.arange(QB)
        qc = lax.dynamic_slice_in_dim(q, s0, QB, axis=3)

        sc = jnp.einsum('bghqd,bgnd->bghqn', qc, kc, preferred_element_type=jnp.float32) * scale
        cmask = cmp_end[None, :] <= tq[:, None]
        pc = jax.nn.softmax(jnp.where(cmask, sc, NEG), axis=-1) * cmask
        o_cmp = jnp.einsum('bghqn,bgnd->bghqd', pc.astype(vc.dtype), vc)

        imp = jnp.einsum('bghqn,nj->bgqj', pc, overlap)
        jq = s0 // SB
        forced = (blk_ids == 0) | (blk_ids == jq) | (blk_ids == jq - 1)
        imp = jnp.where(blk_ids > jq, NEG, jnp.where(forced, FORCE, imp))
        _, sel = lax.top_k(imp, top_n)
        kg = ks_blk[bi, gi, sel].reshape(B, G, QB, top_n * SB, dh)
        vg = vs_blk[bi, gi, sel].reshape(B, G, QB, top_n * SB, dh)
        kpos = (sel[..., None] * SB + jnp.arange(SB)).reshape(B, G, QB, top_n * SB)
        smask = (kpos <= tq[None, None, :, None])[:, :, None]
        ss = jnp.einsum('bghqd,bgqkd->bghqk', qc, kg, preferred_element_type=jnp.float32) * scale
        ps = jax.nn.softmax(jnp.where(smask, ss, NEG), axis=-1)
        o_slc = jnp.einsum('bghqk,bgqkd->bghqd', ps.astype(vg.dtype), vg)

        kwc = lax.dynamic_slice_in_dim(kw_pad, s0, W + QB, axis=2)
        vwc = lax.dynamic_slice_in_dim(vw_pad, s0, W + QB, axis=2)
        wpos = s0 - W + jnp.arange(W + QB)
        wmask = (wpos[None, :] <= tq[:, None]) & (wpos[None, :] > tq[:, None] - W) & (wpos[None, :] >= 0)
        sw = jnp.einsum('bghqd,bgkd->bghqk', qc, kwc, preferred_element_type=jnp.float32) * scale
        pw = jax.nn.softmax(jnp.where(wmask, sw, NEG), axis=-1)
        o_win = jnp.einsum('bghqk,bgkd->bghqd', pw.astype(vwc.dtype), vwc)
        return o_cmp, o_slc, o_win

    o_cmp, o_slc, o_win = lax.map(chunk, jnp.arange(S // QB))

    def heads(o):
        return _merge_chunks(o.reshape(-1, B, N_HEADS, QB, dh)).reshape(B, S, N_HEADS, dh)

    g = jax.nn.sigmoid(gates).reshape(B, S, 3, N_HEADS, 1)
    o = g[:, :, 0] * heads(o_cmp) + g[:, :, 1] * heads(o_slc) + g[:, :, 2] * heads(o_win)
    return o.reshape(B, S, D_MODEL) @ w_out


def moba_mixer(h, w_in, w_out):
    B, S, _ = h.shape
    BLK, QB, dh, H = MOBA_BLOCK, MOBA_QB, HEAD_DIM, N_HEADS
    nb = -(-S // BLK)
    s_pad = nb * BLK
    top_k = min(MOBA_TOPK, nb)
    n_g = top_k * BLK
    scale = dh ** -0.5

    q, k, v = jnp.split(h @ w_in, 3, axis=-1)
    cos, sin = rope_tables(jnp.arange(S))
    q = apply_rope(_split_heads(q, H), cos, sin)
    k = apply_rope(_split_heads(k, H), cos, sin)
    v = _split_heads(v, H)
    padw = ((0, 0), (0, 0), (0, s_pad - S), (0, 0))
    k_blk = jnp.pad(k, padw).reshape(B, H, nb, BLK, dh)
    v_blk = jnp.pad(v, padw).reshape(B, H, nb, BLK, dh)
    k_mean = k_blk.astype(jnp.float32).mean(axis=3)
    bi = jnp.arange(B)[:, None, None, None]
    hi = jnp.arange(H)[None, :, None, None]
    blk_ids = jnp.arange(nb)

    def chunk(c):
        s0 = c * QB
        tq = s0 + jnp.arange(QB)
        cb = s0 // BLK
        qc = lax.dynamic_slice_in_dim(q, s0, QB, axis=2)
        gsc = jnp.einsum('bhqd,bhnd->bhqn', qc.astype(jnp.float32), k_mean)
        gsc = jnp.where(blk_ids < cb, gsc, NEG)
        _, sel = lax.top_k(gsc, top_k)
        valid = jnp.repeat(sel < cb, BLK, axis=-1)
        kg = k_blk[bi, hi, sel].reshape(B, H, QB, n_g, dh)
        vg = v_blk[bi, hi, sel].reshape(B, H, QB, n_g, dh)
        ko = k_blk[:, :, cb]
        vo = v_blk[:, :, cb]
        omask = (cb * BLK + jnp.arange(BLK))[None, :] <= tq[:, None]
        sg = jnp.einsum('bhqd,bhqkd->bhqk', qc, kg, preferred_element_type=jnp.float32) * scale
        so = jnp.einsum('bhqd,bhkd->bhqk', qc, ko, preferred_element_type=jnp.float32) * scale
        s = jnp.concatenate([jnp.where(valid, sg, NEG), jnp.where(omask, so, NEG)], axis=-1)
        p = jax.nn.softmax(s, axis=-1).astype(v.dtype)
        return (jnp.einsum('bhqk,bhqkd->bhqd', p[..., :n_g], vg)
                + jnp.einsum('bhqk,bhkd->bhqd', p[..., n_g:], vo))

    o = lax.map(chunk, jnp.arange(S // QB))
    return _merge_chunks(o) @ w_out


def grouped_moe(h, router_w, router_bias, w_gate, w_up, w_down):
    B, S, D = h.shape
    xt = h.reshape(B * S, D)
    scores = jax.nn.sigmoid((xt @ router_w).astype(jnp.float32))
    biased = scores + router_bias.astype(jnp.float32)
    grp = biased.reshape(-1, N_GROUPS, EXPERTS_PER_GROUP)
    grp_score = lax.top_k(grp, 2)[0].sum(-1)
    _, g_sel = lax.top_k(grp_score, 1)
    emask = jnp.repeat(jnp.arange(N_GROUPS)[None, :] == g_sel, EXPERTS_PER_GROUP, axis=-1)
    _, e_sel = lax.top_k(jnp.where(emask, biased, NEG), TOP_K)
    w_sel = jnp.take_along_axis(scores, e_sel, axis=-1)
    w_sel = w_sel / w_sel.sum(-1, keepdims=True)
    gate = jnp.einsum('tk,tke->te', w_sel, jax.nn.one_hot(e_sel, N_EXPERTS, dtype=jnp.float32)).astype(xt.dtype)
    out = jnp.zeros_like(xt)
    for e in range(N_EXPERTS):
        he = jax.nn.silu(xt @ w_gate[e]) * (xt @ w_up[e])
        out = out + (he @ w_down[e]) * gate[:, e:e + 1]
    return out.reshape(B, S, D)


def setup_inputs(seed: int = 0) -> dict:
    key = jax.random.key(seed)
    ks = jax.random.split(key, 18)
    f32 = jnp.float32
    nrm = lambda k, shape, s: jax.random.normal(k, shape, f32) * s
    beta = DN_BETA
    KV = NSA_KV_DIM
    nsa_col = np.concatenate([np.ones(D_MODEL), np.ones(KV), np.full(KV, beta), np.ones(KV),
                              np.full(KV, beta), np.ones(KV), np.full(KV, beta),
                              np.ones(3 * N_HEADS)]).astype(np.float32)
    moba_col = np.concatenate([np.ones(2 * D_MODEL), np.full(D_MODEL, beta)]).astype(np.float32)
    cmp_in = NSA_CMP_LEN * HEAD_DIM
    return {
        'x': jax.random.normal(ks[0], (BATCH, SEQ, D_MODEL), f32),
        'nsa_w_in': nrm(ks[1], (N_NSA_LAYERS, D_MODEL, NSA_IN_DIM), D_MODEL ** -0.5) * jnp.asarray(nsa_col),
        'nsa_w_out': nrm(ks[2], (N_NSA_LAYERS, D_MODEL, D_MODEL), D_MODEL ** -0.5 * beta),
        'nsa_cmp_k_w1': nrm(ks[3], (N_NSA_LAYERS, cmp_in, NSA_CMP_HIDDEN), cmp_in ** -0.5),
        'nsa_cmp_k_w2': nrm(ks[4], (N_NSA_LAYERS, NSA_CMP_HIDDEN, HEAD_DIM), NSA_CMP_HIDDEN ** -0.5),
        'nsa_cmp_v_w1': nrm(ks[5], (N_NSA_LAYERS, cmp_in, NSA_CMP_HIDDEN), cmp_in ** -0.5),
        'nsa_cmp_v_w2': nrm(ks[6], (N_NSA_LAYERS, NSA_CMP_HIDDEN, HEAD_DIM), NSA_CMP_HIDDEN ** -0.5 * beta),
        'nsa_cmp_k_pos': nrm(ks[7], (N_NSA_LAYERS, NSA_CMP_LEN, HEAD_DIM), 0.1),
        'nsa_cmp_v_pos': nrm(ks[8], (N_NSA_LAYERS, NSA_CMP_LEN, HEAD_DIM), 0.1),
        'moba_w_in': nrm(ks[9], (N_MOBA_LAYERS, D_MODEL, MOBA_IN_DIM), D_MODEL ** -0.5) * jnp.asarray(moba_col),
        'moba_w_out': nrm(ks[10], (N_MOBA_LAYERS, D_MODEL, D_MODEL), D_MODEL ** -0.5 * beta),
        'router_w': nrm(ks[11], (D_MODEL, N_EXPERTS), D_MODEL ** -0.5),
        'router_bias': nrm(ks[12], (N_EXPERTS,), 0.01),
        'moe_w_gate': nrm(ks[13], (DEPTH, N_EXPERTS, D_MODEL, D_EXPERT), D_MODEL ** -0.5),
        'moe_w_up': nrm(ks[14], (DEPTH, N_EXPERTS, D_MODEL, D_EXPERT), D_MODEL ** -0.5),
        'moe_w_down': nrm(ks[15], (DEPTH, N_EXPERTS, D_EXPERT, D_MODEL), D_EXPERT ** -0.5 * beta),
        'ln_g': 1.0 + nrm(ks[16], (DEPTH, 2, D_MODEL), 0.05),
        'ln_b': nrm(ks[17], (DEPTH, 2, D_MODEL), 0.05),
    }


def reference(x, nsa_w_in, nsa_w_out, nsa_cmp_k_w1, nsa_cmp_k_w2, nsa_cmp_v_w1, nsa_cmp_v_w2,
              nsa_cmp_k_pos, nsa_cmp_v_pos, moba_w_in, moba_w_out, router_w, router_bias,
              moe_w_gate, moe_w_up, moe_w_down, ln_g, ln_b):
    for layer in range(DEPTH):
        j = layer // N_MIXERS
        if layer % N_MIXERS == 0:
            mix = nsa_mixer(x, nsa_w_in[j], nsa_w_out[j], nsa_cmp_k_w1[j], nsa_cmp_k_w2[j],
                            nsa_cmp_v_w1[j], nsa_cmp_v_w2[j], nsa_cmp_k_pos[j], nsa_cmp_v_pos[j])
        else:
            mix = moba_mixer(x, moba_w_in[j], moba_w_out[j])
        x = layer_norm(DN_ALPHA * x + mix, ln_g[layer, 0], ln_b[layer, 0])
        ffn = grouped_moe(x, router_w, router_bias, moe_w_gate[layer], moe_w_up[layer], moe_w_down[layer])
        x = layer_norm(DN_ALPHA * x + ffn, ln_g[layer, 1], ln_b[layer, 1])
    return x
```

```cpp
#include <hip/hip_runtime.h>
#include <cstdio>
#include <cstdint>

#ifndef MK_SINGLE
#define MK_SINGLE 1
#endif

#define LAS __attribute__((address_space(3)))
typedef unsigned short bf16_t;
typedef short bf16x8 __attribute__((ext_vector_type(8)));
typedef float f32x4 __attribute__((ext_vector_type(4)));
typedef unsigned u32x4 __attribute__((ext_vector_type(4)));
typedef unsigned u32x2 __attribute__((ext_vector_type(2)));

constexpr int NB = 4, SEQ = 8192, NTOK = NB * SEQ, DM = 1024, NH = 16, DH = 64, NG = 4;
constexpr int NSA_IN = 2608, NSA_INP = 2816;
constexpr int NE = 16, DE = 512;
constexpr float DN_ALPHA = 1.4142135623730951f;
constexpr float LN_EPS = 1e-5f;
constexpr int NWAVES = 8, NTHREADS = 512;
constexpr float QSCALE = 0.125f * 1.4426950408889634f;
constexpr int LDS_BYTES = 163840;
constexpr int ROWCAP = 2 * NTOK + NE * 256;

constexpr size_t MiB = 1u << 20;
constexpr size_t WS_CTL = 0, CTL_BYTES = 1 * MiB;
constexpr size_t WS_ROPE = 1 * MiB;
constexpr size_t WS_BIAS1 = 3 * MiB;
constexpr size_t WS_KMEAN = 4 * MiB;
constexpr size_t WS_ROUTE = 5 * MiB;
constexpr size_t WS_ROWLIST = 6 * MiB;
constexpr size_t WS_SEL = 8 * MiB;
constexpr size_t WS_GATES = 10 * MiB;
constexpr size_t WS_H1K = 17 * MiB, WS_H1V = 21 * MiB;
constexpr size_t WS_KC = 25 * MiB, WS_VC = 26 * MiB;
constexpr size_t WS_WT_NSA_IN = 27 * MiB;
constexpr size_t WS_WT_NSA_OUT = 33 * MiB;
constexpr size_t WS_WT_C1K = 35 * MiB, WS_WT_C1V = 36 * MiB;
constexpr size_t WS_WT_MOBA_IN = 37 * MiB;
constexpr size_t WS_WT_MOBA_OUT = 43 * MiB;
constexpr size_t WS_WT_GU = 45 * MiB;
constexpr size_t WS_WT_DN = 77 * MiB;
constexpr size_t WS_XB = 93 * MiB;
constexpr size_t WS_ATTN = 161 * MiB;
constexpr size_t WS_Q = WS_ATTN;
constexpr size_t WS_KV0 = WS_ATTN + 64 * MiB;
constexpr size_t KVSEG = 16 * MiB;
constexpr size_t WS_K1 = WS_ATTN + 64 * MiB, WS_V1 = WS_ATTN + 128 * MiB;
constexpr size_t WS_X1B = WS_ATTN;
constexpr size_t WS_MIX = WS_ATTN + 64 * MiB;
constexpr size_t WS_Y2 = WS_ATTN;
constexpr size_t WS_HBUF = WS_XB;
constexpr size_t WS_XR = 353 * MiB;
constexpr size_t WS_END = 481 * MiB;
static_assert((size_t)ROWCAP * 512 * 2 <= 68 * MiB && (size_t)ROWCAP * 1024 * 2 <= 192 * MiB, "overlay sizes");

constexpr int CW_TMO = 0;
constexpr int CW_CNT0 = 1024, CW_CNT1 = 2048;
constexpr int CW_BAR = 8192;

__device__ __forceinline__ unsigned f2bf(float f) { unsigned u = __float_as_uint(f); return (u + 0x7fffu + ((u >> 16) & 1u)) >> 16; }
typedef float f32x2v __attribute__((ext_vector_type(2)));
typedef __bf16 bf16x2v __attribute__((ext_vector_type(2)));
__device__ __forceinline__ unsigned pk2(float lo, float hi) { const f32x2v v = {lo, hi}; const bf16x2v b = __builtin_convertvector(v, bf16x2v); return __builtin_bit_cast(unsigned, b); }
__device__ __forceinline__ float bflo(unsigned u) { return __uint_as_float(u << 16); }
__device__ __forceinline__ float bfhi(unsigned u) { return __uint_as_float(u & 0xffff0000u); }
__device__ __forceinline__ float bf2f(bf16_t b) { return __uint_as_float((unsigned)b << 16); }
__device__ __forceinline__ float wave_sum(float v) {
#pragma unroll
    for (int o = 1; o < 64; o <<= 1) v += __shfl_xor(v, o);
    return v;
}
__device__ __forceinline__ float wave_max(float v) {
#pragma unroll
    for (int o = 1; o < 64; o <<= 1) v = fmaxf(v, __shfl_xor(v, o));
    return v;
}
#define WAVE_LDS_SYNC() asm volatile("s_waitcnt lgkmcnt(0)" ::: "memory")
__device__ __forceinline__ float sigmoidf_(float x) { return 1.0f / (1.0f + __expf(-x)); }
__device__ __forceinline__ float gelu_tanh(float x) {
    const float u = 0.7978845608028654f * (x + 0.044715f * x * x * x);
    const float t = 1.0f - 2.0f / (__expf(2.0f * u) + 1.0f);
    return 0.5f * x * (1.0f + t);
}

#define XB_TMO      128
#define XB_XCNT(j)  (256  + 64 * (j))
#define XB_XSUB(j)  (1280 + 64 * (j))
#define XB_XGEN(j)  (2304 + 64 * (j))
#define XB_TOP      3328
#define XB_TOPGEN   3392
#define XCD_BAR_WORDS 3456
#define XB_SPIN_CAP (1u << 22)
__device__ __forceinline__ unsigned xb_ld(unsigned* p)              { return __hip_atomic_load(p, __ATOMIC_RELAXED, __HIP_MEMORY_SCOPE_AGENT); }
__device__ __forceinline__ unsigned xb_add(unsigned* p, unsigned v) { return __hip_atomic_fetch_add(p, v, __ATOMIC_RELAXED, __HIP_MEMORY_SCOPE_AGENT); }
__device__ __forceinline__ unsigned xb_xcc_id() { return (unsigned)__builtin_amdgcn_s_getreg((3 << 11) | 20) & 0xFu; }
#define XB_SPIN(cond, bar) do { unsigned _sp = 0; while (cond) { __builtin_amdgcn_s_sleep(1); \
    if ((++_sp & 255u) == 0u) { if (xb_ld(&(bar)[XB_TMO])) break; if (_sp > XB_SPIN_CAP) { atomicAdd(&(bar)[XB_TMO], 1u); break; } } } } while (0)
struct XcdBarrier { unsigned* bar; unsigned x; volatile LAS unsigned* st; };
__device__ __forceinline__ XcdBarrier xcd_barrier_post(unsigned* bar, volatile LAS unsigned* st) {
    XcdBarrier b; b.bar = bar; b.x = xb_xcc_id(); b.st = st;
    if (threadIdx.x == 0) (void)xb_add(&bar[XB_XCNT(b.x)], 1u);
    return b;
}
__device__ __forceinline__ void xcd_barrier_complete(unsigned* bar, unsigned x, unsigned& nloc, unsigned& nx) {
    const unsigned G = gridDim.x * gridDim.y * gridDim.z;
    unsigned sum, cnt, mine, sp = 0u;
    for (;;) {
        sum = 0u; cnt = 0u; mine = 0u;
#pragma unroll
        for (unsigned j = 0; j < 16; ++j) { const unsigned c = xb_ld(&bar[XB_XCNT(j)]); sum += c; cnt += (c > 0u) ? 1u : 0u; mine = (j == x) ? c : mine; }
        if (sum == G) break;
        __builtin_amdgcn_s_sleep(1);
        if ((++sp & 255u) == 0u) { if (xb_ld(&bar[XB_TMO])) break; if (sp > XB_SPIN_CAP) { atomicAdd(&bar[XB_TMO], 1u); break; } }
    }
    nloc = mine > 0u ? mine : 1u; nx = cnt > 0u ? cnt : 1u;
}
__device__ __forceinline__ void xcd_barrier(const XcdBarrier& b) {
    asm volatile("s_waitcnt vmcnt(0)" ::: "memory");
    __syncthreads();
    if (threadIdx.x == 0) {
        unsigned* bar = b.bar;
        __builtin_amdgcn_s_waitcnt(0);
        unsigned nloc = b.st[0], nx = b.st[1];
        if (nloc == 0u) { xcd_barrier_complete(bar, b.x, nloc, nx); b.st[0] = nloc; b.st[1] = nx; }
        const unsigned old = xb_add(&bar[XB_XSUB(b.x)], 1u);
        const unsigned gen = old / nloc;
        if (old + 1u == (gen + 1u) * nloc) {
            __builtin_amdgcn_fence(__ATOMIC_RELEASE, "agent");
            asm volatile("s_waitcnt vmcnt(0)" ::: "memory");
            const unsigned og = xb_add(&bar[XB_TOP], 1u);
            const unsigned tg = og / nx;
            if (og + 1u == (tg + 1u) * nx) xb_add(&bar[XB_TOPGEN], 1u);
            else XB_SPIN(xb_ld(&bar[XB_TOPGEN]) == tg, bar);
            __builtin_amdgcn_fence(__ATOMIC_ACQUIRE, "agent");
            xb_add(&bar[XB_XGEN(b.x)], 1u);
            asm volatile("s_waitcnt vmcnt(0)" ::: "memory");
        } else {
            XB_SPIN(xb_ld(&bar[XB_XGEN(b.x)]) == gen, bar);
            __builtin_amdgcn_fence(__ATOMIC_ACQUIRE, "agent");
            asm volatile("s_waitcnt vmcnt(0)" ::: "memory");
        }
    }
    __syncthreads();
}

struct Args { const float* in[18]; float* out; unsigned char* ws; int ph_lo, ph_hi; };
struct Ctx {
    const float* in[18]; float* out; unsigned char* ws; unsigned char* lds;
    int tid, lane, wave, bid, nb;
};
enum { I_X = 0, I_NSA_WIN, I_NSA_WOUT, I_CK_W1, I_CK_W2, I_CV_W1, I_CV_W2, I_CK_POS, I_CV_POS, I_MOBA_WIN, I_MOBA_WOUT, I_RW, I_RB, I_WG, I_WU, I_WD, I_LNG, I_LNB };

__device__ __forceinline__ int il64(int d) { return d < 32 ? 2 * d : 2 * (d - 32) + 1; }
__device__ __forceinline__ int rowmap(int kind, int n) {
    switch (kind) {
        case 1: { const bool r = (n < 1024) || (n >= 1536 && n < 1792) || (n >= 2048 && n < 2304); return r ? (n & ~63) + il64(n & 63) : n; }
        case 2: return n < 2048 ? (n & ~63) + il64(n & 63) : n;
        case 3: return 2 * n;
        case 4: return 2 * n + 1;
        default: return n;
    }
}
__device__ __forceinline__ void transpose_item(const float* W, int ldw, int ncols, bf16_t* WT, int K, int kb, int nbk, int kind, float* scr, int lane) {
    const int k0 = 64 * kb, n0 = 32 * nbk;
    const int cq = lane & 7, nn = n0 + 4 * cq;
#pragma unroll
    for (int i = 0; i < 8; ++i) { const int kk = 8 * i + (lane >> 3);
        *(f32x4*)(scr + kk * 36 + 4 * cq) = nn < ncols ? *(const f32x4*)(W + (size_t)(k0 + kk) * ldw + nn) : (f32x4){0.f, 0.f, 0.f, 0.f}; }
    WAVE_LDS_SYNC();
    const int c = lane & 7;
#pragma unroll
    for (int j = 0; j < 4; ++j) {
        const int n = (lane >> 3) + 8 * j; const float* s = scr + (8 * c) * 36 + n;
        u32x4 o; o.x = pk2(s[0 * 36], s[1 * 36]); o.y = pk2(s[2 * 36], s[3 * 36]); o.z = pk2(s[4 * 36], s[5 * 36]); o.w = pk2(s[6 * 36], s[7 * 36]);
        *(u32x4*)(WT + (size_t)rowmap(kind, n0 + n) * K + k0 + 8 * c) = o;
    }
    WAVE_LDS_SYNC();
}
constexpr int MOE_W_ITEMS = NE * 768;
__device__ __forceinline__ void moe_weight_item(const Ctx& C, int layer, int r, float* scr) {
    const int e = r / 768; int q = r % 768;
    bf16_t* gu = (bf16_t*)(C.ws + WS_WT_GU) + (size_t)e * 1024 * 1024;
    bf16_t* dn = (bf16_t*)(C.ws + WS_WT_DN) + (size_t)e * 1024 * 512;
    const size_t eo = (size_t)(layer * NE + e);
    if (q < 256) { transpose_item(C.in[I_WG] + eo * DM * DE, DE, DE, gu, DM, q / 16, q % 16, 3, scr, C.lane); return; } q -= 256;
    if (q < 256) { transpose_item(C.in[I_WU] + eo * DM * DE, DE, DE, gu, DM, q / 16, q % 16, 4, scr, C.lane); return; } q -= 256;
    transpose_item(C.in[I_WD] + eo * DE * DM, DM, DM, dn, DE, q / 32, q % 32, 0, scr, C.lane);
}

__device__ __forceinline__ void ph_prologue(const Ctx& C) {
    float* scr = (float*)(C.lds + C.wave * 9216);
    const int gw = C.bid * NWAVES + C.wave, NGW = C.nb * NWAVES;
    constexpr int I_A = 16 * 82, I_B = 16 * 32, I_C = 32 * 8, I_D = 16 * 96, I_E = 16 * 32;
    constexpr int NIT = I_A + I_B + 2 * I_C + I_D + I_E + MOE_W_ITEMS;
    for (int it = gw; it < NIT; it += NGW) {
        int r = it;
        if (r < I_A) { transpose_item(C.in[I_NSA_WIN], NSA_IN, NSA_IN, (bf16_t*)(C.ws + WS_WT_NSA_IN), DM, r / 82, r % 82, 1, scr, C.lane); continue; } r -= I_A;
        if (r < I_B) { transpose_item(C.in[I_NSA_WOUT], DM, DM, (bf16_t*)(C.ws + WS_WT_NSA_OUT), DM, r / 32, r % 32, 0, scr, C.lane); continue; } r -= I_B;
        if (r < I_C) { transpose_item(C.in[I_CK_W1], 256, 256, (bf16_t*)(C.ws + WS_WT_C1K), 2048, r / 8, r % 8, 0, scr, C.lane); continue; } r -= I_C;
        if (r < I_C) { transpose_item(C.in[I_CV_W1], 256, 256, (bf16_t*)(C.ws + WS_WT_C1V), 2048, r / 8, r % 8, 0, scr, C.lane); continue; } r -= I_C;
        if (r < I_D) { transpose_item(C.in[I_MOBA_WIN], 3072, 3072, (bf16_t*)(C.ws + WS_WT_MOBA_IN), DM, r / 96, r % 96, 2, scr, C.lane); continue; } r -= I_D;
        if (r < I_E) { transpose_item(C.in[I_MOBA_WOUT], DM, DM, (bf16_t*)(C.ws + WS_WT_MOBA_OUT), DM, r / 32, r % 32, 0, scr, C.lane); continue; } r -= I_E;
        moe_weight_item(C, 0, r, scr);
    }
    const int gt = C.bid * NTHREADS + C.tid, NGT = C.nb * NTHREADS;
    { u32x4* p = (u32x4*)((bf16_t*)(C.ws + WS_WT_NSA_IN) + (size_t)2624 * DM); const int n = (NSA_INP - 2624) * DM / 8;
      for (int i = gt; i < n; i += NGT) p[i] = (u32x4){0u, 0u, 0u, 0u}; }
    { const f32x4* x4 = (const f32x4*)C.in[I_X]; u32x4* o = (u32x4*)(C.ws + WS_XB); const int n = NTOK * DM / 8;
      for (int i = gt; i < n; i += NGT) { const f32x4 a = x4[2 * i], b = x4[2 * i + 1]; o[i] = (u32x4){pk2(a.x, a.y), pk2(a.z, a.w), pk2(b.x, b.y), pk2(b.z, b.w)}; } }
    { const float INV[32] = {1.000000000e+00f, 7.498942018e-01f, 5.623413324e-01f, 4.216965139e-01f, 3.162277639e-01f, 2.371373922e-01f, 1.778279394e-01f, 1.333521456e-01f,
                             1.000000015e-01f, 7.498941571e-02f, 5.623412877e-02f, 4.216964915e-02f, 3.162277862e-02f, 2.371373586e-02f, 1.778279431e-02f, 1.333521493e-02f,
                             9.999999776e-03f, 7.498942316e-03f, 5.623413250e-03f, 4.216964822e-03f, 3.162277862e-03f, 2.371373819e-03f, 1.778279431e-03f, 1.333521446e-03f,
                             1.000000047e-03f, 7.498941850e-04f, 5.623413017e-04f, 4.216965463e-04f, 3.162277862e-04f, 2.371373848e-04f, 1.778279402e-04f, 1.333521504e-04f};
      float2* tab = (float2*)(C.ws + WS_ROPE);
      for (int i = gt; i < SEQ * 32; i += NGT) {
          const int t = i >> 5, f = i & 31;
          float inv = INV[0];
#pragma unroll
          for (int q = 1; q < 32; ++q) inv = (f == q) ? INV[q] : inv;
          const float ang = (float)t * inv;
          const double a = (double)ang; const double k = __builtin_rint(a * 0.15915494309189535); const float rf = (float)(a - k * 6.283185307179586);
          tab[i] = make_float2(__cosf(rf), __sinf(rf));
      } }
    for (int o = gw; o < 512; o += NGW) {
        const int which = o >> 8, c = o & 255;
        const float* pos = C.in[which ? I_CV_POS : I_CK_POS]; const float* w1 = C.in[which ? I_CV_W1 : I_CK_W1];
        float s = 0.f;
        for (int k = C.lane; k < 2048; k += 64) s += pos[k] * w1[(size_t)k * 256 + c];
        s = wave_sum(s);
        if (C.lane == 0) ((float*)(C.ws + WS_BIAS1))[o] = s;
    }
}

__device__ __forceinline__ void mma_core(const bf16_t* a0, const bf16_t* a1, const bf16_t* b0, const bf16_t* b1, int K, f32x4 (&acc)[2][2]) {
#pragma unroll
    for (int i = 0; i < 2; ++i)
#pragma unroll
        for (int j = 0; j < 2; ++j) acc[i][j] = (f32x4){0.f, 0.f, 0.f, 0.f};
#pragma unroll 4
    for (int k = 0; k < K; k += 32) {
        const bf16x8 A0 = *(const bf16x8*)(a0 + k), A1 = *(const bf16x8*)(a1 + k), B0 = *(const bf16x8*)(b0 + k), B1 = *(const bf16x8*)(b1 + k);
        acc[0][0] = __builtin_amdgcn_mfma_f32_16x16x32_bf16(B0, A0, acc[0][0], 0, 0, 0);
        acc[0][1] = __builtin_amdgcn_mfma_f32_16x16x32_bf16(B1, A0, acc[0][1], 0, 0, 0);
        acc[1][0] = __builtin_amdgcn_mfma_f32_16x16x32_bf16(B0, A1, acc[1][0], 0, 0, 0);
        acc[1][1] = __builtin_amdgcn_mfma_f32_16x16x32_bf16(B1, A1, acc[1][1], 0, 0, 0);
    }
}
namespace g8 {
constexpr int BM = 256, BK = 64, HALF = 128, HTB = HALF * BK * 2, STAGE_BYTES = 8 * HTB, NXCD = 8, WGM = 8;
__device__ __forceinline__ int lds_byte(int r, int c) { const int st = (r >> 4) * 2 + (c >> 5), rr = r & 15, cc = c & 31, ob = rr * 64 + cc * 2; return st * 1024 + (ob ^ (((ob >> 9) & 1) << 5)); }
__device__ __forceinline__ void stage_rc(int b, int& R, int& C) { const int st = b / 1024, sb = b % 1024, swz = sb ^ (((sb >> 9) & 1) << 5); R = (st >> 1) * 16 + swz / 64; C = (st & 1) * 32 + (swz % 64) / 2; }
struct Unit { int pm, pn, bt, e; };
struct StaticOrder {
    int nM, nN, nwg, G, c;
    __device__ void init(int nM_, int nN_, int G_, int c_) { nM = nM_; nN = nN_; nwg = nM * nN; G = G_; c = c_; }
    __device__ bool next(int i, Unit& u) const {
        const long L = (long)i * G + c; if (L >= nwg) return false;
        int wgid = (int)L; { const int q = nwg / NXCD, r = nwg % NXCD, xcd = wgid % NXCD, off = wgid / NXCD; wgid = (xcd < r ? xcd * (q + 1) : r * (q + 1) + (xcd - r) * q) + off; }
        const int nig = WGM * nN, gid = wgid / nig, fm = gid * WGM, gsz = (nM - fm) < WGM ? (nM - fm) : WGM;
        u.pm = fm + ((wgid % nig) % gsz); u.pn = (wgid % nig) / gsz; u.bt = u.pn; u.e = 0; return true;
    }
};
struct GroupedOrder {
    StaticOrder so; const LAS int* sm;
    __device__ void init(const LAS int* sm_, int nN_, int G_, int c_) { sm = sm_; so.init(sm_[32] / BM, nN_, G_, c_); }
    __device__ bool next(int i, Unit& u) const {
        if (!so.next(i, u)) return false;
        const int rowt = u.pm * BM; int e = 0;
#pragma unroll
        for (int q = 1; q < NE; ++q) e = (rowt >= sm[16 + q]) ? q : e;
        u.e = e; u.bt = e * so.nN + u.pn; return true;
    }
};
struct GatherInfo { const int* rowlist; const LAS int* sm; };

__device__ __forceinline__ int perm32(int rho) { const int n = rho >> 4, i = rho & 15; return 8 * (i >> 2) + 4 * n + (i & 3); }
template <bool GATHER, class Epi, class Sched>
__device__ __forceinline__ void gemm8(LAS unsigned char* lds, const bf16_t* A, int lda, const bf16_t* Bt, int K, const Sched& S, const Epi& E, GatherInfo gi) {
    const int tid = threadIdx.x, wid = __builtin_amdgcn_readfirstlane(tid >> 6), lane = tid & 63, wr = wid >> 2, wc = wid & 3, fr = lane & 15, fq = lane >> 4;
    const int nt = K / BK;
    int Rr[2], Cc[2]; unsigned voffB[2]; unsigned vAc[2][2], vAn[2][2];
#pragma unroll
    for (int i = 0; i < 2; ++i) { stage_rc(tid * 16 + i * 8192, Rr[i], Cc[i]); voffB[i] = (unsigned)(((Rr[i] & ~31) + perm32(Rr[i] & 31)) * K + Cc[i]) * 2u;
#pragma unroll
        for (int h = 0; h < 2; ++h) { vAc[h][i] = (unsigned)((Rr[i] + HALF * h) * lda + Cc[i]) * 2u; vAn[h][i] = vAc[h][i]; } }
    const size_t kstep = (size_t)(BK * 2);
    const size_t hstepB = (size_t)HALF * K * 2, tstepB = 2 * hstepB, tstepA = (size_t)BM * lda * 2;
    const unsigned ldsw = (unsigned)wid * 1024u;
    const int aoff = lds_byte(wr * 64 + fr, fq * 8), boff = lds_byte(wc * 32 + fr, fq * 8);
#define G8_SA(b, h) (((b) * 2 + (h)) * HTB)
#define G8_SB(b, h) ((4 + (b) * 2 + (h)) * HTB)
#define G8_STAGEB(bufoff, gbase) do { _Pragma("unroll") for (int _i = 0; _i < 2; ++_i) \
        __builtin_amdgcn_global_load_lds((const unsigned*)((const char*)(gbase) + voffB[_i]), (LAS unsigned*)(lds + (bufoff) + ldsw + _i * 8192), 16, 0, 0); } while (0)
#define G8_STAGEA(bufoff, gbase, v0, v1) do { \
        __builtin_amdgcn_global_load_lds((const unsigned*)((const char*)(gbase) + (v0)), (LAS unsigned*)(lds + (bufoff) + ldsw), 16, 0, 0); \
        __builtin_amdgcn_global_load_lds((const unsigned*)((const char*)(gbase) + (v1)), (LAS unsigned*)(lds + (bufoff) + ldsw + 8192), 16, 0, 0); } while (0)
#define G8_LDA(dst, b, h) do { _Pragma("unroll") for (int m = 0; m < 4; ++m) _Pragma("unroll") for (int k = 0; k < 2; ++k) dst[m][k] = *(const LAS bf16x8*)(lds + G8_SA(b, h) + aoff + m * 2048 + k * 1024); } while (0)
#define G8_LDB(dst, b, h) do { _Pragma("unroll") for (int n = 0; n < 2; ++n) _Pragma("unroll") for (int k = 0; k < 2; ++k) dst[n][k] = *(const LAS bf16x8*)(lds + G8_SB(b, h) + boff + n * 2048 + k * 1024); } while (0)
#define G8_MMA(ai, bj, At, Bt_) do { __builtin_amdgcn_s_setprio(1); _Pragma("unroll") for (int m = 0; m < 4; ++m) _Pragma("unroll") for (int n = 0; n < 2; ++n) _Pragma("unroll") for (int k = 0; k < 2; ++k) \
        acc[ai][bj][m][n] = __builtin_amdgcn_mfma_f32_16x16x32_bf16(Bt_[n][k], At[m][k], acc[ai][bj][m][n], 0, 0, 0); __builtin_amdgcn_s_setprio(0); } while (0)
#define G8_WAIT_V(n) asm volatile("s_waitcnt vmcnt(" #n ")" ::: "memory")
#define G8_WAIT_L(n) asm volatile("s_waitcnt lgkmcnt(" #n ")" ::: "memory")
#define G8_BAR __builtin_amdgcn_s_barrier()
#define G8_SCHED __builtin_amdgcn_sched_barrier(0)
#define G8_GATHER(u, v) do { if (GATHER) { const int _eb = gi.sm[16 + (u).e], _ec = gi.sm[(u).e]; \
        _Pragma("unroll") for (int _h = 0; _h < 2; ++_h) _Pragma("unroll") for (int _i = 0; _i < 2; ++_i) { const int _s = (u).pm * BM + HALF * _h + Rr[_i] - _eb; \
            const int _t = gi.rowlist[(u).e * NTOK + (_s < _ec ? _s : 0)]; v[_h][_i] = (unsigned)(_t * K + Cc[_i]) * 2u; } } } while (0)
    Unit cur, nxt; int ui = 0;
    if (!S.next(0, cur)) return;
    f32x4 acc[2][2][4][2];
#pragma unroll
    for (int a = 0; a < 2; ++a)
#pragma unroll
        for (int b = 0; b < 2; ++b)
#pragma unroll
            for (int m = 0; m < 4; ++m)
#pragma unroll
                for (int n = 0; n < 2; ++n) acc[a][b][m][n] = (f32x4){0.f, 0.f, 0.f, 0.f};
    bf16x8 At[4][2], B0[2][2], B1[2][2];
    G8_GATHER(cur, vAc);
    const char* cA = GATHER ? (const char*)A : (const char*)A + (size_t)cur.pm * tstepA; const char* cB = (const char*)Bt + (size_t)cur.bt * tstepB;
    G8_STAGEB(G8_SB(0, 0), cB); G8_STAGEB(G8_SB(0, 1), cB + hstepB); G8_STAGEA(G8_SA(0, 0), cA, vAc[0][0], vAc[0][1]); G8_STAGEA(G8_SA(0, 1), cA, vAc[1][0], vAc[1][1]);
    if (wr == 1) G8_BAR;
    G8_WAIT_V(2); G8_BAR;
    G8_STAGEB(G8_SB(1, 0), cB + kstep); G8_STAGEA(G8_SA(1, 0), cA + kstep, vAc[0][0], vAc[0][1]); G8_STAGEB(G8_SB(1, 1), cB + hstepB + kstep);
    G8_WAIT_V(6); G8_BAR;
    for (;;) {
        const bool has_next = S.next(ui + 1, nxt);
        if (has_next) G8_GATHER(nxt, vAn);
        const char* nA = has_next ? (GATHER ? (const char*)A : (const char*)A + (size_t)nxt.pm * tstepA) : cA; const char* nB = has_next ? (const char*)Bt + (size_t)nxt.bt * tstepB : cB;
        for (int t = 0; t < nt; t += 2) {
            const bool last = (t == nt - 2);
            const char* a1 = cA + (size_t)(t + 1) * kstep;
            const char* a2 = last ? nA : cA + (size_t)(t + 2) * kstep; const char* b2 = last ? nB : cB + (size_t)(t + 2) * kstep;
            const char* a3 = a2 + kstep; const char* b3 = b2 + kstep;
            const bool usen = GATHER && last && has_next;
            const unsigned w00 = usen ? vAn[0][0] : vAc[0][0], w01 = usen ? vAn[0][1] : vAc[0][1], w10 = usen ? vAn[1][0] : vAc[1][0], w11 = usen ? vAn[1][1] : vAc[1][1];
            G8_LDB(B0, 0, 0); G8_LDB(B1, 0, 1); G8_SCHED; G8_LDA(At, 0, 0); G8_STAGEA(G8_SA(1, 1), a1, vAc[1][0], vAc[1][1]);
            G8_WAIT_V(8); G8_WAIT_L(0); G8_BAR; G8_MMA(0, 0, At, B0); G8_MMA(0, 1, At, B1); G8_BAR; G8_SCHED;
            G8_LDA(At, 0, 1); G8_STAGEB(G8_SB(0, 0), b2); G8_STAGEB(G8_SB(0, 1), b2 + hstepB); G8_STAGEA(G8_SA(0, 0), a2, w00, w01);
            G8_WAIT_V(8); G8_WAIT_L(0); G8_BAR; G8_MMA(1, 0, At, B0); G8_MMA(1, 1, At, B1); G8_BAR; G8_SCHED;
            G8_LDB(B0, 1, 0); G8_LDB(B1, 1, 1); G8_SCHED; G8_LDA(At, 1, 0); G8_STAGEA(G8_SA(0, 1), a2, w10, w11);
            G8_WAIT_V(8); G8_WAIT_L(0); G8_BAR; G8_MMA(0, 0, At, B0); G8_MMA(0, 1, At, B1); G8_BAR; G8_SCHED;
            G8_LDA(At, 1, 1); G8_STAGEB(G8_SB(1, 0), b3); G8_STAGEB(G8_SB(1, 1), b3 + hstepB); G8_STAGEA(G8_SA(1, 0), a3, w00, w01);
            G8_WAIT_V(8); G8_WAIT_L(0); G8_BAR; G8_MMA(1, 0, At, B0); G8_MMA(1, 1, At, B1); G8_BAR; G8_SCHED;
        }
        if (wr == 0) G8_BAR;
        E(acc, cur, wr, wc, fr, fq);
        if (!has_next) break;
#pragma unroll
        for (int a = 0; a < 2; ++a)
#pragma unroll
            for (int b = 0; b < 2; ++b)
#pragma unroll
                for (int m = 0; m < 4; ++m)
#pragma unroll
                    for (int n = 0; n < 2; ++n) acc[a][b][m][n] = (f32x4){0.f, 0.f, 0.f, 0.f};
        cur = nxt; cA = nA; cB = nB; ++ui;
#pragma unroll
        for (int h = 0; h < 2; ++h)
#pragma unroll
            for (int i = 0; i < 2; ++i) vAc[h][i] = vAn[h][i];
        if (wr == 1) G8_BAR;
    }
    G8_WAIT_V(0);
    G8_BAR;
#undef G8_SA
#undef G8_SB
#undef G8_STAGEA
#undef G8_STAGEB
#undef G8_LDA
#undef G8_LDB
#undef G8_MMA
#undef G8_WAIT_V
#undef G8_WAIT_L
#undef G8_BAR
#undef G8_SCHED
#undef G8_GATHER
}
template <class F> struct EpiEl {
    F f;
    __device__ __forceinline__ void operator()(const f32x4 (&acc)[2][2][4][2], const Unit& u, int wr, int wc, int fr, int fq) const {
#pragma unroll
        for (int ai = 0; ai < 2; ++ai)
#pragma unroll
            for (int m = 0; m < 4; ++m) { const int row = u.pm * BM + ai * HALF + wr * 64 + m * 16 + fr;
#pragma unroll
                for (int bj = 0; bj < 2; ++bj) f(row, u.pn * BM + bj * HALF + wc * 32 + 8 * fq, acc[ai][bj][m][0], acc[ai][bj][m][1]); }
    }
};
}

struct EpiNsaIn {
    bf16_t* Q; bf16_t* KV; float* gates; const float2* rope;
    __device__ __forceinline__ void operator()(int row, int c, f32x4 v) const {
        const int t = row & (SEQ - 1), b = row >> 13;
        if (c < 1024) {
            v = v * QSCALE;
            const int d = (c & 63) >> 1; const float2 c0 = rope[t * 32 + d], c1 = rope[t * 32 + d + 1];
            bf16_t* p = Q + (size_t)row * DM + (c & ~63);
            *(unsigned*)(p + d) = pk2(v[0] * c0.x - v[1] * c0.y, v[2] * c1.x - v[3] * c1.y);
            *(unsigned*)(p + d + 32) = pk2(v[1] * c0.x + v[0] * c0.y, v[3] * c1.x + v[2] * c1.y);
        } else if (c < 2560) {
            const int s = (c - 1024) >> 8, g = ((c - 1024) >> 6) & 3;
            bf16_t* p = KV + (size_t)s * (KVSEG / 2) + ((size_t)(b * NG + g) * SEQ + t) * DH;
            if (s == 2 || s == 4) {
                const int d = (c & 63) >> 1; const float2 c0 = rope[t * 32 + d], c1 = rope[t * 32 + d + 1];
                *(unsigned*)(p + d) = pk2(v[0] * c0.x - v[1] * c0.y, v[2] * c1.x - v[3] * c1.y);
                *(unsigned*)(p + d + 32) = pk2(v[1] * c0.x + v[0] * c0.y, v[3] * c1.x + v[2] * c1.y);
            } else {
                *(u32x2*)(p + (c & 63)) = (u32x2){pk2(v[0], v[1]), pk2(v[2], v[3])};
            }
        } else if (c < NSA_IN) {
            float* gp = gates + (size_t)row * 48 + (c - 2560);
            *(f32x4*)gp = (f32x4){sigmoidf_(v[0]), sigmoidf_(v[1]), sigmoidf_(v[2]), sigmoidf_(v[3])};
        }
    }
    __device__ __forceinline__ void operator()(int row, int c, f32x4 v, f32x4 w) const {
        const int t = row & (SEQ - 1), b = row >> 13;
        const int s = (c - 1024) >> 8;
        const bool isq = c < 1024, roped = isq || s == 2 || s == 4;
        if (roped) {
            if (isq) { v = v * QSCALE; w = w * QSCALE; }
            const int g = ((c - 1024) >> 6) & 3, d = (c & 63) >> 1;
            bf16_t* p = isq ? Q + (size_t)row * DM + (c & ~63) : KV + (size_t)s * (KVSEG / 2) + ((size_t)(b * NG + g) * SEQ + t) * DH;
            const f32x4 cs01 = *(const f32x4*)(rope + t * 32 + d), cs23 = *(const f32x4*)(rope + t * 32 + d + 2);
            *(u32x2*)(p + d) = (u32x2){pk2(v[0] * cs01[0] - v[1] * cs01[1], v[2] * cs01[2] - v[3] * cs01[3]), pk2(w[0] * cs23[0] - w[1] * cs23[1], w[2] * cs23[2] - w[3] * cs23[3])};
            *(u32x2*)(p + d + 32) = (u32x2){pk2(v[1] * cs01[0] + v[0] * cs01[1], v[3] * cs01[2] + v[2] * cs01[3]), pk2(w[1] * cs23[0] + w[0] * cs23[1], w[3] * cs23[2] + w[2] * cs23[3])};
        } else {
            const int g = ((c - 1024) >> 6) & 3;
            bf16_t* p = KV + (size_t)s * (KVSEG / 2) + ((size_t)(b * NG + g) * SEQ + t) * DH + (c & 63);
            *(u32x4*)p = (u32x4){pk2(v[0], v[1]), pk2(v[2], v[3]), pk2(w[0], w[1]), pk2(w[2], w[3])};
        }
    }
};
struct EpiMobaIn {
    bf16_t* Q; bf16_t* K; bf16_t* V; const float2* rope;
    __device__ __forceinline__ void operator()(int row, int c, f32x4 v) const {
        const int t = row & (SEQ - 1), b = row >> 13;
        if (c < 2048) {
            if (c < 1024) v = v * QSCALE;
            const int d = (c & 63) >> 1; const float2 c0 = rope[t * 32 + d], c1 = rope[t * 32 + d + 1];
            bf16_t* p = c < 1024 ? Q + (size_t)row * DM + (c & ~63) : K + ((size_t)(b * NH + ((c - 1024) >> 6)) * SEQ + t) * DH;
            *(unsigned*)(p + d) = pk2(v[0] * c0.x - v[1] * c0.y, v[2] * c1.x - v[3] * c1.y);
            *(unsigned*)(p + d + 32) = pk2(v[1] * c0.x + v[0] * c0.y, v[3] * c1.x + v[2] * c1.y);
        } else {
            bf16_t* p = V + ((size_t)(b * NH + ((c - 2048) >> 6)) * SEQ + t) * DH + (c & 63);
            *(u32x2*)p = (u32x2){pk2(v[0], v[1]), pk2(v[2], v[3])};
        }
    }
    __device__ __forceinline__ void operator()(int row, int c, f32x4 v, f32x4 w) const {
        const int t = row & (SEQ - 1), b = row >> 13;
        if (c < 2048) {
            if (c < 1024) { v = v * QSCALE; w = w * QSCALE; }
            const int d = (c & 63) >> 1;
            bf16_t* p = c < 1024 ? Q + (size_t)row * DM + (c & ~63) : K + ((size_t)(b * NH + ((c - 1024) >> 6)) * SEQ + t) * DH;
            const f32x4 cs01 = *(const f32x4*)(rope + t * 32 + d), cs23 = *(const f32x4*)(rope + t * 32 + d + 2);
            *(u32x2*)(p + d) = (u32x2){pk2(v[0] * cs01[0] - v[1] * cs01[1], v[2] * cs01[2] - v[3] * cs01[3]), pk2(w[0] * cs23[0] - w[1] * cs23[1], w[2] * cs23[2] - w[3] * cs23[3])};
            *(u32x2*)(p + d + 32) = (u32x2){pk2(v[1] * cs01[0] + v[0] * cs01[1], v[3] * cs01[2] + v[2] * cs01[3]), pk2(w[1] * cs23[0] + w[0] * cs23[1], w[3] * cs23[2] + w[2] * cs23[3])};
        } else {
            bf16_t* p = V + ((size_t)(b * NH + ((c - 2048) >> 6)) * SEQ + t) * DH + (c & 63);
            *(u32x4*)p = (u32x4){pk2(v[0], v[1]), pk2(v[2], v[3]), pk2(w[0], w[1]), pk2(w[2], w[3])};
        }
    }
};
struct EpiGelu {
    bf16_t* O; const float* bias;
    __device__ __forceinline__ void operator()(int row, int c, f32x4 v) const {
        const f32x4 bv = *(const f32x4*)(bias + c);
        *(u32x2*)(O + (size_t)row * 256 + c) = (u32x2){pk2(gelu_tanh(v[0] + bv[0]), gelu_tanh(v[1] + bv[1])), pk2(gelu_tanh(v[2] + bv[2]), gelu_tanh(v[3] + bv[3]))};
    }
    __device__ __forceinline__ void operator()(int row, int c, f32x4 v, f32x4 w) const {
        const f32x4 bv = *(const f32x4*)(bias + c), bw = *(const f32x4*)(bias + c + 4);
        *(u32x4*)(O + (size_t)row * 256 + c) = (u32x4){pk2(gelu_tanh(v[0] + bv[0]), gelu_tanh(v[1] + bv[1])), pk2(gelu_tanh(v[2] + bv[2]), gelu_tanh(v[3] + bv[3])),
                                                      pk2(gelu_tanh(w[0] + bw[0]), gelu_tanh(w[1] + bw[1])), pk2(gelu_tanh(w[2] + bw[2]), gelu_tanh(w[3] + bw[3]))};
    }
};
struct EpiSwiGLU {
    bf16_t* H;
    __device__ __forceinline__ void operator()(int row, int c, f32x4 v) const {
        const float h0 = v[0] * sigmoidf_(v[0]) * v[1], h1 = v[2] * sigmoidf_(v[2]) * v[3];
        *(unsigned*)(H + (size_t)row * DE + (c >> 1)) = pk2(h0, h1);
    }
    __device__ __forceinline__ void operator()(int row, int c, f32x4 v, f32x4 w) const {
        *(u32x2*)(H + (size_t)row * DE + (c >> 1)) = (u32x2){pk2(v[0] * sigmoidf_(v[0]) * v[1], v[2] * sigmoidf_(v[2]) * v[3]), pk2(w[0] * sigmoidf_(w[0]) * w[1], w[2] * sigmoidf_(w[2]) * w[3])};
    }
};
struct EpiBf16 {
    bf16_t* Y;
    __device__ __forceinline__ void operator()(int row, int c, f32x4 v) const { *(u32x2*)(Y + (size_t)row * DM + c) = (u32x2){pk2(v[0], v[1]), pk2(v[2], v[3])}; }
    __device__ __forceinline__ void operator()(int row, int c, f32x4 v, f32x4 w) const { *(u32x4*)(Y + (size_t)row * DM + c) = (u32x4){pk2(v[0], v[1]), pk2(v[2], v[3]), pk2(w[0], w[1]), pk2(w[2], w[3])}; }
};

struct ExpertMap { int cnt[NE]; int base[NE + 1]; };
__device__ __forceinline__ void load_expert_map(const Ctx& C, int cw, LAS int* sm  ) {
    if (C.tid == 0) {
        const unsigned* ctl = (const unsigned*)(C.ws + WS_CTL); int acc = 0;
        for (int e = 0; e < NE; ++e) { const int c = (int)__hip_atomic_load(ctl + cw + 64 * e, __ATOMIC_RELAXED, __HIP_MEMORY_SCOPE_AGENT); sm[e] = c; sm[16 + e] = acc; acc += (c + 255) & ~255; }
        sm[32] = acc;
    }
    __syncthreads();
}

__device__ __forceinline__ void ph_cmp2(const Ctx& C) {
    const int gt = C.bid * NTHREADS + C.tid, NGT = C.nb * NTHREADS;
    const float2* rope = (const float2*)(C.ws + WS_ROPE);
    for (int i = gt; i < 2 * 8192 * 32; i += NGT) {
        const int which = i >= 8192 * 32; const int j = i - which * 8192 * 32; const int r = j >> 5, d = j & 31, ci = r & 511;
        const bf16_t* h = (const bf16_t*)(C.ws + (which ? WS_H1V : WS_H1K)) + (size_t)r * 256;
        const float* w2 = C.in[which ? I_CV_W2 : I_CK_W2];
        float s0 = 0.f, s1 = 0.f;
        for (int k = 0; k < 256; ++k) { const float hv = bf2f(h[k]); s0 += hv * w2[k * 64 + d]; s1 += hv * w2[k * 64 + d + 32]; }
        bf16_t* o = (bf16_t*)(C.ws + (which ? WS_VC : WS_KC)) + (size_t)r * 64;
        if (ci == 511) { s0 = 0.f; s1 = 0.f; }
        else if (!which) { const float2 cs = rope[(16 * ci + 31) * 32 + d]; const float a = s0 * cs.x - s1 * cs.y, b2 = s1 * cs.x + s0 * cs.y; s0 = a; s1 = b2; }
        o[d] = (bf16_t)f2bf(s0); o[d + 32] = (bf16_t)f2bf(s1);
    }
}

__device__ __forceinline__ void load_qh(const bf16_t* qp, float (&qh)[64]) {
    const uint4* q4 = (const uint4*)qp;
#pragma unroll
    for (int c = 0; c < 8; ++c) { const uint4 w = q4[c]; qh[8 * c] = bflo(w.x); qh[8 * c + 1] = bfhi(w.x); qh[8 * c + 2] = bflo(w.y); qh[8 * c + 3] = bfhi(w.y);
        qh[8 * c + 4] = bflo(w.z); qh[8 * c + 5] = bfhi(w.z); qh[8 * c + 6] = bflo(w.w); qh[8 * c + 7] = bfhi(w.w); }
}
namespace fa {
constexpr int SLOT = 16384, NSLOT = 4;
constexpr float C2 = 0.125f * 1.4426950408889634f;
constexpr float NEGBIG = -1e30f;
typedef short v4i16 __attribute__((ext_vector_type(4)));
__device__ __forceinline__ void dma_block(LAS unsigned char* slot, const bf16_t* Kg, const bf16_t* Vg, int wave, int lane) {
    { const int key = 8 * wave + (lane >> 3), c = (lane & 7) ^ ((key >> 1) & 7);
      __builtin_amdgcn_global_load_lds((const unsigned*)(Kg + key * 64 + 8 * c), (LAS unsigned*)(slot + wave * 1024), 16, 0, 0); }
    { const int key = 16 * (wave & 3) + (lane >> 2), cp = lane & 3, d = (wave >> 2) * 32 + ((((cp >> 1) ^ ((key >> 2) & 1))) << 4) + ((cp & 1) << 3);
      __builtin_amdgcn_global_load_lds((const unsigned*)(Vg + key * 64 + d), (LAS unsigned*)(slot + 8192 + wave * 1024), 16, 0, 0); }
}
__device__ __forceinline__ unsigned cvt_pk_bf16(float lo, float hi) { const f32x2v v = {lo, hi}; const bf16x2v b = __builtin_convertvector(v, bf16x2v); return __builtin_bit_cast(unsigned, b); }
struct Task { bf16x8 q[2]; int kmin, kmax; float m, l, cinit; f32x4 O[4]; f32x4 L; unsigned fw0, fw1, fw2, fw3; int imptok; };
template <int FM> __device__ __forceinline__ bool row_flag(const Task& t, int jb) {
    if (FM == 0) return true;
    if (FM == 1) { const unsigned a0 = t.fw0, a1 = t.fw1, a2 = t.fw2, a3 = t.fw3; const unsigned lo = jb < 32 ? a0 : a1, hi = jb < 96 ? a2 : a3; const unsigned w = jb < 64 ? lo : hi; return ((w >> (jb & 31)) & 1u) != 0u; }
    return ((t.fw0 >> (jb >> 2)) & 1u) != 0u;
}
struct LaneC { int fq, koff0, koff1, voffA, voffB; };
__device__ __forceinline__ LaneC lane_consts(int lane) {
    const int i16 = lane & 15, fq = lane >> 4, kx = (i16 >> 1) & 7, q4 = i16 >> 2, p4 = lane & 3;
    LaneC lc; lc.fq = fq; lc.koff0 = i16 * 128 + ((fq ^ kx) << 4); lc.koff1 = i16 * 128 + (((4 + fq) ^ kx) << 4);
    lc.voffA = 8192 + (4 * fq + q4) * 64 + ((0 ^ (fq & 1)) << 5) + 8 * p4; lc.voffB = 8192 + (4 * fq + q4) * 64 + ((1 ^ (fq & 1)) << 5) + 8 * p4;
    return lc;
}
__device__ __forceinline__ float xrow16_max(float x) {
    auto s = __builtin_amdgcn_permlane16_swap(__float_as_uint(x), __float_as_uint(x), false, false);
    x = fmaxf(__uint_as_float(s[0]), __uint_as_float(s[1]));
    auto t = __builtin_amdgcn_permlane32_swap(__float_as_uint(x), __float_as_uint(x), false, false);
    return fmaxf(__uint_as_float(t[0]), __uint_as_float(t[1]));
}
__device__ __forceinline__ float xrow16_sum(float x) {
    auto s = __builtin_amdgcn_permlane16_swap(__float_as_uint(x), __float_as_uint(x), false, false);
    x = __uint_as_float(s[0]) + __uint_as_float(s[1]);
    auto t = __builtin_amdgcn_permlane32_swap(__float_as_uint(x), __float_as_uint(x), false, false);
    return __uint_as_float(t[0]) + __uint_as_float(t[1]);
}
__device__ __forceinline__ void t_mask(const Task& t, f32x4 (&s)[4], int kb, int fq) {
#pragma unroll
    for (int kt = 0; kt < 4; ++kt)
#pragma unroll
        for (int r = 0; r < 4; ++r) { const int key = kb + 16 * kt + 4 * fq + r; s[kt][r] = (key >= t.kmin && key <= t.kmax) ? s[kt][r] : NEGBIG; }
}
template <int MODE> __device__ __forceinline__ float t_stats(Task& t, f32x4 (&s)[4], bool rf) {
    float bm = fmaxf(fmaxf(fmaxf(s[0][0], s[0][1]), fmaxf(s[0][2], s[0][3])), fmaxf(fmaxf(s[1][0], s[1][1]), fmaxf(s[1][2], s[1][3])));
    bm = fmaxf(bm, fmaxf(fmaxf(fmaxf(s[2][0], s[2][1]), fmaxf(s[2][2], s[2][3])), fmaxf(fmaxf(s[3][0], s[3][1]), fmaxf(s[3][2], s[3][3]))));
    bm = xrow16_max(bm);
    if (!rf) bm = NEGBIG;
    const float mnew = fmaxf(t.m, bm);
    const float alpha = __builtin_amdgcn_exp2f(t.m - mnew);
    t.m = mnew;
    const float msub = (rf && mnew > -1e29f) ? mnew : __builtin_inff();
#pragma unroll
    for (int kt = 0; kt < 4; ++kt) s[kt] = s[kt] - msub;
    if (MODE == 1) t.l *= alpha;
    return alpha;
}
__device__ __forceinline__ void t_exp(f32x4 (&s)[4]) {
#pragma unroll
    for (int kt = 0; kt < 4; ++kt)
#pragma unroll
        for (int r = 0; r < 4; ++r) s[kt][r] = __builtin_amdgcn_exp2f(s[kt][r]);
}
__device__ __forceinline__ float quad_sum(float x) {
    x += __builtin_bit_cast(float, __builtin_amdgcn_mov_dpp(__builtin_bit_cast(int, x), 0xB1, 0xf, 0xf, true));
    x += __builtin_bit_cast(float, __builtin_amdgcn_mov_dpp(__builtin_bit_cast(int, x), 0x4E, 0xf, 0xf, true));
    return x;
}
__device__ __forceinline__ void t_imp(const Task& t, const f32x4 (&s)[4], int kb, int fq, LAS float* impbase) {
    float ga[4], gb[4];
#pragma unroll
    for (int kt = 0; kt < 4; ++kt) { ga[kt] = quad_sum((s[kt][0] + s[kt][1]) + (s[kt][2] + s[kt][3])); gb[kt] = quad_sum(s[kt][3]); }
    if ((t.imptok & 0x10000) == 0) return;
    LAS float* ip = impbase + (t.imptok & 0xffff) * 130 + (kb >> 2) + fq;
#pragma unroll
    for (int kt = 0; kt < 4; ++kt) { ip[4 * kt] = ga[kt]; ip[64 * 130 + 4 * kt] = gb[kt]; }
}
__device__ __forceinline__ bf16x8 t_pack(const f32x4 (&s)[4], int u) {
    u32x4 pw; pw.x = cvt_pk_bf16(s[2 * u][0], s[2 * u][1]); pw.y = cvt_pk_bf16(s[2 * u][2], s[2 * u][3]); pw.z = cvt_pk_bf16(s[2 * u + 1][0], s[2 * u + 1][1]); pw.w = cvt_pk_bf16(s[2 * u + 1][2], s[2 * u + 1][3]);
    return __builtin_bit_cast(bf16x8, pw);
}
template <int MODE, bool DA, bool DB>
__device__ __forceinline__ void do_blk(Task& a, Task& b, bool rfa, bool rfb, bool masked, LAS unsigned char* slot, int kb, LAS float* impbase, const LaneC& lc) {
    f32x4 sa[4], sb[4];
    const float xa = (MODE >= 2) ? (rfa ? a.cinit : -__builtin_inff()) : 0.f, xb = (MODE >= 2) ? (rfb ? b.cinit : -__builtin_inff()) : 0.f;
    const f32x4 ca = (f32x4){xa, xa, xa, xa}, cb = (f32x4){xb, xb, xb, xb};
#pragma unroll
    for (int kt = 0; kt < 4; ++kt) {
        const bf16x8 k0 = *(const LAS bf16x8*)(slot + lc.koff0 + kt * 2048), k1 = *(const LAS bf16x8*)(slot + lc.koff1 + kt * 2048);
        if (DA) { sa[kt] = __builtin_amdgcn_mfma_f32_16x16x32_bf16(k0, a.q[0], ca, 0, 0, 0); sa[kt] = __builtin_amdgcn_mfma_f32_16x16x32_bf16(k1, a.q[1], sa[kt], 0, 0, 0); }
        if (DB) { sb[kt] = __builtin_amdgcn_mfma_f32_16x16x32_bf16(k0, b.q[0], cb, 0, 0, 0); sb[kt] = __builtin_amdgcn_mfma_f32_16x16x32_bf16(k1, b.q[1], sb[kt], 0, 0, 0); }
    }
    if (masked) { if (DA) t_mask(a, sa, kb, lc.fq); if (DB) t_mask(b, sb, kb, lc.fq); }
    if (MODE < 2) {
        float ala = 1.0f, alb = 1.0f;
        if (DA) ala = t_stats<MODE>(a, sa, rfa);
        if (DB) alb = t_stats<MODE>(b, sb, rfb);
        if (MODE == 0) {
            if (__ballot((DA && ala != 1.0f) || (DB && alb != 1.0f)) != 0ull) {
#pragma unroll
                for (int dt = 0; dt < 4; ++dt) { if (DA) a.O[dt] = a.O[dt] * ala; if (DB) b.O[dt] = b.O[dt] * alb; }
                if (DA) a.L = a.L * ala; if (DB) b.L = b.L * alb;
            }
        }
    }
    if (DA) t_exp(sa);
    if (DB) t_exp(sb);
    if (MODE == 1) {
        if (DA) a.l += ((sa[0][0] + sa[0][1]) + (sa[0][2] + sa[0][3])) + ((sa[1][0] + sa[1][1]) + (sa[1][2] + sa[1][3])) + ((sa[2][0] + sa[2][1]) + (sa[2][2] + sa[2][3])) + ((sa[3][0] + sa[3][1]) + (sa[3][2] + sa[3][3]));
        if (DB) b.l += ((sb[0][0] + sb[0][1]) + (sb[0][2] + sb[0][3])) + ((sb[1][0] + sb[1][1]) + (sb[1][2] + sb[1][3])) + ((sb[2][0] + sb[2][1]) + (sb[2][2] + sb[2][3])) + ((sb[3][0] + sb[3][1]) + (sb[3][2] + sb[3][3]));
    }
    if (MODE == 2) { if (DA) t_imp(a, sa, kb, lc.fq, impbase); if (DB) t_imp(b, sb, kb, lc.fq, impbase); }
    if (MODE != 1) {
        const bf16x8 ones = (bf16x8){0x3F80, 0x3F80, 0x3F80, 0x3F80, 0x3F80, 0x3F80, 0x3F80, 0x3F80};
#pragma unroll
        for (int u = 0; u < 2; ++u) {
            bf16x8 pa, pb; if (DA) pa = t_pack(sa, u); if (DB) pb = t_pack(sb, u);
            if (MODE != 2) { if (DA) a.L = __builtin_amdgcn_mfma_f32_16x16x32_bf16(ones, pa, a.L, 0, 0, 0); if (DB) b.L = __builtin_amdgcn_mfma_f32_16x16x32_bf16(ones, pb, b.L, 0, 0, 0); }
#pragma unroll
            for (int dt = 0; dt < 4; ++dt) {
                const int vo = ((dt & 1) ? lc.voffB : lc.voffA) + (dt >> 1) * 4096 + u * 2048;
                const v4i16 a0 = __builtin_amdgcn_ds_read_tr16_b64_v4i16((LAS v4i16*)(slot + vo)), a1 = __builtin_amdgcn_ds_read_tr16_b64_v4i16((LAS v4i16*)(slot + vo + 1024));
                const bf16x8 vf = (bf16x8){a0[0], a0[1], a0[2], a0[3], a1[0], a1[1], a1[2], a1[3]};
                if (DA) a.O[dt] = __builtin_amdgcn_mfma_f32_16x16x32_bf16(vf, pa, a.O[dt], 0, 0, 0);
                if (DB) b.O[dt] = __builtin_amdgcn_mfma_f32_16x16x32_bf16(vf, pb, b.O[dt], 0, 0, 0);
            }
        }
    }
}
template <int MODE, int FM>
__device__ __forceinline__ void flash_loop(LAS unsigned char* ring, const bf16_t* Kg, const bf16_t* Vg, int nblk, Task& Ta, Task& Tb, LAS float* impbase, int wave, int lane) {
    const int i16 = lane & 15, fq = lane >> 4;
    const int kx = (i16 >> 1) & 7;
    const int q4 = i16 >> 2, p4 = lane & 3;
    LaneC lc; lc.fq = fq; lc.koff0 = i16 * 128 + ((fq ^ kx) << 4); lc.koff1 = i16 * 128 + (((4 + fq) ^ kx) << 4);
    lc.voffA = 8192 + (4 * fq + q4) * 64 + ((0 ^ (fq & 1)) << 5) + 8 * p4; lc.voffB = 8192 + (4 * fq + q4) * 64 + ((1 ^ (fq & 1)) << 5) + 8 * p4;
    const int amin = __builtin_amdgcn_readlane(Ta.kmin, 15), amax = __builtin_amdgcn_readlane(Ta.kmax, 0), bmin = __builtin_amdgcn_readlane(Tb.kmin, 15), bmax = __builtin_amdgcn_readlane(Tb.kmax, 0);
#pragma unroll
    for (int j = 0; j < NSLOT - 1; ++j) { const int jj = j < nblk ? j : nblk - 1; dma_block(ring + j * SLOT, Kg + (size_t)jj * 4096, Vg + (size_t)jj * 4096, wave, lane); }
    for (int jb = 0; jb < nblk; ++jb) {
        asm volatile("s_waitcnt vmcnt(4) lgkmcnt(0)\n\ts_barrier" ::: "memory");
        { const int jn = jb + 3 < nblk ? jb + 3 : nblk - 1; dma_block(ring + ((jb + 3) & 3) * SLOT, Kg + (size_t)jn * 4096, Vg + (size_t)jn * 4096, wave, lane); }
        LAS unsigned char* slot = ring + (jb & 3) * SLOT;
        const int kb = jb * 64;
        const bool rfa = row_flag<FM>(Ta, jb), rfb = row_flag<FM>(Tb, jb);
        const bool na = __ballot(rfa && Ta.kmax >= kb && Ta.kmin <= kb + 63) != 0ull, nb2 = __ballot(rfb && Tb.kmax >= kb && Tb.kmin <= kb + 63) != 0ull;
        const bool masked = !((!na || (kb >= amin && kb + 63 <= amax)) && (!nb2 || (kb >= bmin && kb + 63 <= bmax)));
        if (FM == 1) {
            if (na) do_blk<MODE, true, false>(Ta, Tb, rfa, rfb, masked, slot, kb, impbase, lc);
            if (nb2) do_blk<MODE, false, true>(Ta, Tb, rfa, rfb, masked, slot, kb, impbase, lc);
        } else {
            if (na || nb2) do_blk<MODE, true, true>(Ta, Tb, rfa, rfb, masked, slot, kb, impbase, lc);
        }
    }
    asm volatile("s_waitcnt vmcnt(0) lgkmcnt(0)\n\ts_barrier" ::: "memory");
}
template <int MODE, int FM>
__device__ __forceinline__ void flash_loop2(LAS unsigned char* ring, const bf16_t* Kg, const bf16_t* Vg, int nblk, Task& Ta, Task& Tb, LAS float* impbase, int wave, int lane) {
    const int i16 = lane & 15, fq = lane >> 4;
    const int kx = (i16 >> 1) & 7;
    const int q4 = i16 >> 2, p4 = lane & 3;
    LaneC lc; lc.fq = fq; lc.koff0 = i16 * 128 + ((fq ^ kx) << 4); lc.koff1 = i16 * 128 + (((4 + fq) ^ kx) << 4);
    lc.voffA = 8192 + (4 * fq + q4) * 64 + ((0 ^ (fq & 1)) << 5) + 8 * p4; lc.voffB = 8192 + (4 * fq + q4) * 64 + ((1 ^ (fq & 1)) << 5) + 8 * p4;
    const int amin = __builtin_amdgcn_readlane(Ta.kmin, 15), amax = __builtin_amdgcn_readlane(Ta.kmax, 0), bmin = __builtin_amdgcn_readlane(Tb.kmin, 15), bmax = __builtin_amdgcn_readlane(Tb.kmax, 0);
    const int nit = (nblk + 1) >> 1;
#pragma unroll
    for (int j = 0; j < 2; ++j) { const int jj = j < nblk ? j : nblk - 1; dma_block(ring + j * SLOT, Kg + (size_t)jj * 4096, Vg + (size_t)jj * 4096, wave, lane); }
    for (int i = 0; i < nit; ++i) {
        asm volatile("s_waitcnt vmcnt(0) lgkmcnt(0)\n\ts_barrier" ::: "memory");
#pragma unroll
        for (int j = 0; j < 2; ++j) { const int jn = 2 * i + 2 + j < nblk ? 2 * i + 2 + j : nblk - 1; dma_block(ring + ((2 * i + 2 + j) & 3) * SLOT, Kg + (size_t)jn * 4096, Vg + (size_t)jn * 4096, wave, lane); }
        if (FM == 1) {
#pragma unroll
        for (int k = 0; k < 2; ++k) {
            const int jb = 2 * i + k;
            if (jb < nblk) {
                LAS unsigned char* slot = ring + (jb & 3) * SLOT;
                const int kb = jb * 64;
                const bool rfa = row_flag<FM>(Ta, jb), rfb = row_flag<FM>(Tb, jb);
                const bool na = __ballot(rfa && Ta.kmax >= kb && Ta.kmin <= kb + 63) != 0ull, nb2 = __ballot(rfb && Tb.kmax >= kb && Tb.kmin <= kb + 63) != 0ull;
                const bool masked = !((!na || (kb >= amin && kb + 63 <= amax)) && (!nb2 || (kb >= bmin && kb + 63 <= bmax)));
                if (na) do_blk<MODE, true, false>(Ta, Tb, rfa, rfb, masked, slot, kb, impbase, lc);
                if (nb2) do_blk<MODE, false, true>(Ta, Tb, rfa, rfb, masked, slot, kb, impbase, lc);
            }
        }
        } else {
            const int j0 = 2 * i, j1 = 2 * i + 1;
            const bool ra0 = row_flag<FM>(Ta, j0), rb0 = row_flag<FM>(Tb, j0), ra1 = row_flag<FM>(Ta, j1), rb1 = row_flag<FM>(Tb, j1);
            if (__ballot(ra0 || rb0 || ra1 || rb1) != 0ull) {
                do_blk<MODE, true, true>(Ta, Tb, ra0, rb0, false, ring + (j0 & 3) * SLOT, j0 * 64, impbase, lc);
                do_blk<MODE, true, true>(Ta, Tb, ra1, rb1, false, ring + (j1 & 3) * SLOT, j1 * 64, impbase, lc);
            }
        }
    }
    asm volatile("s_waitcnt vmcnt(0) lgkmcnt(0)\n\ts_barrier" ::: "memory");
}
__device__ __forceinline__ void task_reset(Task& t) { t.m = NEGBIG; t.l = 0.f; t.cinit = 0.f; t.L = (f32x4){0.f, 0.f, 0.f, 0.f};
#pragma unroll
    for (int dt = 0; dt < 4; ++dt) t.O[dt] = (f32x4){0.f, 0.f, 0.f, 0.f}; }
__device__ __forceinline__ float task_rowsum(const Task& t) { return t.L[0]; }
__device__ __forceinline__ float task_rowsum_stats(const Task& t) { return xrow16_sum(t.l); }
constexpr float REF_DELTA = 32.f;
__device__ __forceinline__ void task_fix_ref(Task& t) {
    t.cinit = -(t.m + REF_DELTA);
    const float sc = __builtin_amdgcn_exp2f(-REF_DELTA);
    t.L = t.L * sc;
#pragma unroll
    for (int dt = 0; dt < 4; ++dt) t.O[dt] = t.O[dt] * sc;
}
}

struct NsaRow { int tokl, head, tt; size_t grow; u32x2 out[4]; };
__device__ __forceinline__ void nsa_row_init(NsaRow& r, fa::Task& t, const bf16_t* Q, int b, int g, int c, int R, int fq) {
    r.tokl = R >> 2; r.head = R & 3; r.tt = 64 * c + r.tokl; r.grow = (size_t)(b * SEQ + r.tt);
    const bf16_t* qp = Q + r.grow * DM + (g * 4 + r.head) * DH + 8 * fq;
    t.q[0] = *(const bf16x8*)qp; t.q[1] = *(const bf16x8*)(qp + 32);
    t.imptok = r.tokl | (r.head == 0 ? 0x10000 : 0); t.fw0 = 0u; t.fw1 = 0u; t.fw2 = 0u; t.fw3 = 0u;
#pragma unroll
    for (int dt = 0; dt < 4; ++dt) r.out[dt] = (u32x2){0u, 0u};
}
__device__ __forceinline__ void nsa_cmp_setup(const NsaRow& r, fa::Task& t) {
    const int nv = r.tt >= 31 ? (((r.tt - 31) >> 4) + 1 > 511 ? 511 : ((r.tt - 31) >> 4) + 1) : 0;
    t.kmin = 0; t.kmax = nv - 1; fa::task_reset(t);
}
__device__ __forceinline__ void nsa_accum(NsaRow& r, const fa::Task& t, float sc) {
#pragma unroll
    for (int dt = 0; dt < 4; ++dt) { const f32x4 o = t.O[dt] * sc; const u32x2 w = r.out[dt];
        r.out[dt] = (u32x2){pk2(bflo(w.x) + o[0], bfhi(w.x) + o[1]), pk2(bflo(w.y) + o[2], bfhi(w.y) + o[3])}; }
}
__device__ __forceinline__ void nsa_store(const NsaRow& r, bf16_t* AO, int g, int fq) {
    bf16_t* op = AO + r.grow * DM + (g * 4 + r.head) * DH + 4 * fq;
#pragma unroll
    for (int dt = 0; dt < 4; ++dt) *(u32x2*)(op + 16 * dt) = r.out[dt];
}
__device__ __forceinline__ void ph_nsa_fa(const Ctx& C) {
    LAS unsigned char* L = (LAS unsigned char*)C.lds;
    LAS unsigned char* ring = L;
    LAS float* imp = (LAS float*)(L + 65536);
    LAS unsigned* selm = (LAS unsigned*)(L + 135168);
    const bf16_t* Q = (const bf16_t*)(C.ws + WS_Q); const bf16_t* KC = (const bf16_t*)(C.ws + WS_KC); const bf16_t* VC = (const bf16_t*)(C.ws + WS_VC);
    const bf16_t* KS = (const bf16_t*)(C.ws + WS_KV0 + 2 * KVSEG); const bf16_t* VS = (const bf16_t*)(C.ws + WS_KV0 + 3 * KVSEG);
    const bf16_t* KW = (const bf16_t*)(C.ws + WS_KV0 + 4 * KVSEG); const bf16_t* VW = (const bf16_t*)(C.ws + WS_KV0 + 5 * KVSEG);
    const float* gates = (const float*)(C.ws + WS_GATES); bf16_t* AO = (bf16_t*)(C.ws + WS_XB);
    const int wave = C.wave;
    for (int u = C.bid; u < NB * NG * (SEQ / 64); u += C.nb) {
        int lane = C.lane; asm volatile("" : "+v"(lane));
        const int i16 = lane & 15, fq = lane >> 4;
        const int rnd = u / C.nb, idx = (u % C.nb) >> 4, bg = u & 15, b = bg >> 2, g = bg & 3;
        const int c = (C.nb == 256) ? 127 - 16 * rnd - ((rnd & 1) ? 15 - idx : idx) : 127 - (u >> 4);
        fa::Task T0, T1; NsaRow R0, R1;
        nsa_row_init(R0, T0, Q, b, g, c, 32 * wave + i16, fq);
        nsa_row_init(R1, T1, Q, b, g, c, 32 * wave + 16 + i16, fq);
        for (int i = C.tid; i < 2 * 64 * 130; i += NTHREADS) imp[i] = 0.f;
        if (C.tid < 256) selm[C.tid] = 0u;
        const int nvm = ((64 * c + 63 - 31) >> 4) + 1;
        const int nvmax = nvm > 511 ? 511 : nvm;
        const int nblkc = (nvmax + 63) >> 6;
        nsa_cmp_setup(R0, T0); nsa_cmp_setup(R1, T1);
        fa::flash_loop<1, 0>(ring, KC + (size_t)bg * 512 * DH, VC + (size_t)bg * 512 * DH, nblkc, T0, T1, imp, wave, lane);
        { const float l0 = fa::task_rowsum_stats(T0), l1 = fa::task_rowsum_stats(T1);
          T0.cinit = l0 > 0.f ? -T0.m - __builtin_amdgcn_logf(l0) : -__builtin_inff(); T1.cinit = l1 > 0.f ? -T1.m - __builtin_amdgcn_logf(l1) : -__builtin_inff(); }
        fa::flash_loop<2, 0>(ring, KC + (size_t)bg * 512 * DH, VC + (size_t)bg * 512 * DH, nblkc, T0, T1, imp, wave, lane);
        nsa_accum(R0, T0, gates[R0.grow * 48 + g * 4 + R0.head]);
        nsa_accum(R1, T1, gates[R1.grow * 48 + g * 4 + R1.head]);
        {
            const int jq = c, ncand = jq - 2 > 0 ? jq - 2 : 0, nforced = jq == 0 ? 1 : (jq == 1 ? 2 : 3), need = 16 - nforced;
#pragma unroll
            for (int g2 = 0; g2 < 2; ++g2) {
                const int tk = 8 * wave + 4 * g2 + (lane >> 4);
                unsigned key[8]; unsigned selb = 0u;
#pragma unroll
                for (int k = 0; k < 8; ++k) { const int j = i16 + 16 * k; const bool cand = j >= 1 && j <= jq - 2;
                    key[k] = cand ? ((__float_as_uint(imp[tk * 130 + j] + imp[64 * 130 + tk * 130 + j - 1]) & 0xFFFFFF80u) | (unsigned)(127 - j)) : 0u; }
                if (ncand <= need) {
#pragma unroll
                    for (int k = 0; k < 8; ++k) selb |= (key[k] != 0u) ? (1u << k) : 0u;
                } else {
                    for (int r = 0; r < need; ++r) {
                        unsigned m = max(max(max(key[0], key[1]), max(key[2], key[3])), max(max(key[4], key[5]), max(key[6], key[7])));
                        m = max(m, (unsigned)__builtin_amdgcn_mov_dpp((int)m, 0xB1, 0xf, 0xf, true));
                        m = max(m, (unsigned)__builtin_amdgcn_mov_dpp((int)m, 0x4E, 0xf, 0xf, true));
                        m = max(m, (unsigned)__builtin_amdgcn_mov_dpp((int)m, 0x141, 0xf, 0xf, true));
                        m = max(m, (unsigned)__builtin_amdgcn_mov_dpp((int)m, 0x140, 0xf, 0xf, true));
#pragma unroll
                        for (int k = 0; k < 8; ++k) { const bool hit = key[k] == m; selb |= hit ? (1u << k) : 0u; key[k] = hit ? 0u : key[k]; }
                    }
                }
#pragma unroll
                for (int k = 0; k < 8; ++k) { const int j = i16 + 16 * k; if (j == 0 || j == jq || j == jq - 1) selb |= 1u << k; }
#pragma unroll
                for (int w2 = 0; w2 < 4; ++w2) {
                    const unsigned bits = (((selb >> (2 * w2)) & 1u) << i16) | (((selb >> (2 * w2 + 1)) & 1u) << (16 + i16));
                    if (bits) __hip_atomic_fetch_or(selm + tk * 4 + w2, bits, __ATOMIC_RELAXED, __HIP_MEMORY_SCOPE_WORKGROUP);
                }
            }
        }
        asm volatile("s_waitcnt lgkmcnt(0)\n\ts_barrier" ::: "memory");
        {
            const int jlo = c - 8 > 0 ? c - 8 : 0;
            T0.kmin = R0.tt - 511 - 64 * jlo; T0.kmax = R0.tt - 64 * jlo; fa::task_reset(T0);
            T1.kmin = R1.tt - 511 - 64 * jlo; T1.kmax = R1.tt - 64 * jlo; fa::task_reset(T1);
            fa::flash_loop<0, 0>(ring, KW + ((size_t)bg * SEQ + 64 * jlo) * DH, VW + ((size_t)bg * SEQ + 64 * jlo) * DH, c - jlo + 1, T0, T1, imp, wave, lane);
            const float l0 = fa::task_rowsum(T0), l1 = fa::task_rowsum(T1);
            nsa_accum(R0, T0, (l0 > 0.f ? 1.0f / l0 : 0.f) * gates[R0.grow * 48 + 32 + g * 4 + R0.head]);
            nsa_accum(R1, T1, (l1 > 0.f ? 1.0f / l1 : 0.f) * gates[R1.grow * 48 + 32 + g * 4 + R1.head]);
        }
        {
            T0.fw0 = selm[R0.tokl * 4 + 0]; T0.fw1 = selm[R0.tokl * 4 + 1]; T0.fw2 = selm[R0.tokl * 4 + 2]; T0.fw3 = selm[R0.tokl * 4 + 3];
            T1.fw0 = selm[R1.tokl * 4 + 0]; T1.fw1 = selm[R1.tokl * 4 + 1]; T1.fw2 = selm[R1.tokl * 4 + 2]; T1.fw3 = selm[R1.tokl * 4 + 3];
            T0.kmin = 0; T0.kmax = R0.tokl; fa::task_reset(T0); T1.kmin = 0; T1.kmax = R1.tokl; fa::task_reset(T1);
            fa::flash_loop<0, 0>(ring, KS + ((size_t)bg * SEQ + 64 * c) * DH, VS + ((size_t)bg * SEQ + 64 * c) * DH, 1, T0, T1, imp, wave, lane);
            T0.kmax = R0.tt; T1.kmax = R1.tt; fa::task_fix_ref(T0); fa::task_fix_ref(T1);
            if (c > 0) fa::flash_loop2<3, 1>(ring, KS + (size_t)bg * SEQ * DH, VS + (size_t)bg * SEQ * DH, c, T0, T1, imp, wave, lane);
            const float l0 = fa::task_rowsum(T0), l1 = fa::task_rowsum(T1);
            nsa_accum(R0, T0, (l0 > 0.f ? 1.0f / l0 : 0.f) * gates[R0.grow * 48 + 16 + g * 4 + R0.head]);
            nsa_accum(R1, T1, (l1 > 0.f ? 1.0f / l1 : 0.f) * gates[R1.grow * 48 + 16 + g * 4 + R1.head]);
        }
        nsa_store(R0, AO, g, fq); nsa_store(R1, AO, g, fq);
    }
}

__device__ __forceinline__ void ph_moba_fa(const Ctx& C) {
    LAS unsigned char* L = (LAS unsigned char*)C.lds;
    LAS unsigned char* ring = L;
    LAS float* kms = (LAS float*)(L + 65536);
    LAS unsigned* rmask = (LAS unsigned*)(L + 65536 + 8192);
    const bf16_t* Q = (const bf16_t*)(C.ws + WS_Q); const bf16_t* K1 = (const bf16_t*)(C.ws + WS_K1); const bf16_t* V1 = (const bf16_t*)(C.ws + WS_V1);
    const float* KM = (const float*)(C.ws + WS_KMEAN); bf16_t* AO = (bf16_t*)(C.ws + WS_XB);
    const int wave = C.wave;
    for (int u = C.bid; u < NB * NH * 32; u += C.nb) {
        int lane = C.lane; asm volatile("" : "+v"(lane));
        const int i16 = lane & 15, fq = lane >> 4;
        const int rnd = u / C.nb, idx = (u % C.nb) >> 6, bh = u & 63, b = bh >> 4, h = bh & 15;
        const int cb = (C.nb == 256) ? 31 - 4 * rnd - ((rnd & 1) ? 3 - idx : idx) : 31 - (u >> 6);
        for (int i = C.tid; i < 32 * 64; i += NTHREADS) kms[i] = KM[(size_t)bh * 2048 + i];
        asm volatile("s_waitcnt vmcnt(0) lgkmcnt(0)\n\ts_barrier" ::: "memory");
        {
            const int row = C.tid >> 1, half = C.tid & 1;
            float qh[64]; load_qh(Q + (size_t)(b * SEQ + 256 * cb + row) * DM + h * DH, qh);
            float b0 = -3e38f, b1 = -3e38f, b2 = -3e38f; int j0 = 99, j1 = 99, j2 = 99;
            for (int n = half; n < cb; n += 2) {
                const LAS f32x4* km = (const LAS f32x4*)(kms + n * 64); float a = 0.f;
#pragma unroll
                for (int q = 0; q < 16; ++q) { const f32x4 w = km[q]; a += w[0] * qh[4 * q] + w[1] * qh[4 * q + 1] + w[2] * qh[4 * q + 2] + w[3] * qh[4 * q + 3]; }
                if (a > b0) { b2 = b1; j2 = j1; b1 = b0; j1 = j0; b0 = a; j0 = n; } else if (a > b1) { b2 = b1; j2 = j1; b1 = a; j1 = n; } else if (a > b2) { b2 = a; j2 = n; }
            }
            const float ov0 = __shfl_xor(b0, 1), ov1 = __shfl_xor(b1, 1), ov2 = __shfl_xor(b2, 1); const int oj0 = __shfl_xor(j0, 1), oj1 = __shfl_xor(j1, 1), oj2 = __shfl_xor(j2, 1);
#define MERGE3(a, n) do { if ((a) > b0 || ((a) == b0 && (n) < j0)) { b2 = b1; j2 = j1; b1 = b0; j1 = j0; b0 = (a); j0 = (n); } \
                else if ((a) > b1 || ((a) == b1 && (n) < j1)) { b2 = b1; j2 = j1; b1 = (a); j1 = (n); } \
                else if ((a) > b2 || ((a) == b2 && (n) < j2)) { b2 = (a); j2 = (n); } } while (0)
            MERGE3(ov0, oj0); MERGE3(ov1, oj1); MERGE3(ov2, oj2);
#undef MERGE3
            unsigned mk = 1u << cb;
            if (j0 < cb) mk |= 1u << j0; if (j1 < cb) mk |= 1u << j1; if (j2 < cb) mk |= 1u << j2;
            if (half == 0) rmask[row] = mk;
        }
        asm volatile("s_waitcnt lgkmcnt(0)\n\ts_barrier" ::: "memory");
        fa::Task T[2]; int tt[2];
#pragma unroll
        for (int ti = 0; ti < 2; ++ti) {
            const int R = 32 * wave + 16 * ti + i16; tt[ti] = 256 * cb + R; T[ti].fw0 = rmask[R]; T[ti].imptok = 0;
            const bf16_t* qp = Q + (size_t)(b * SEQ + tt[ti]) * DM + h * DH + 8 * fq;
            T[ti].q[0] = *(const bf16x8*)qp; T[ti].q[1] = *(const bf16x8*)(qp + 32);
            T[ti].kmin = 0; T[ti].kmax = tt[ti]; fa::task_reset(T[ti]);
        }
#pragma unroll
        for (int ti = 0; ti < 2; ++ti) { T[ti].kmax = tt[ti] - 256 * cb; }
        fa::flash_loop<0, 0>(ring, K1 + ((size_t)bh * SEQ + 256 * cb) * DH, V1 + ((size_t)bh * SEQ + 256 * cb) * DH, 4, T[0], T[1], kms, wave, lane);
#pragma unroll
        for (int ti = 0; ti < 2; ++ti) { T[ti].kmax = tt[ti]; fa::task_fix_ref(T[ti]); }
        if (cb > 0) fa::flash_loop2<3, 2>(ring, K1 + (size_t)bh * SEQ * DH, V1 + (size_t)bh * SEQ * DH, 4 * cb, T[0], T[1], kms, wave, lane);
#pragma unroll
        for (int ti = 0; ti < 2; ++ti) { const float l = fa::task_rowsum(T[ti]); const float sc_ = l > 0.f ? 1.0f / l : 0.f;
            bf16_t* op = AO + (size_t)(b * SEQ + tt[ti]) * DM + h * DH + 4 * fq;
#pragma unroll
            for (int dt = 0; dt < 4; ++dt) { const f32x4 o = T[ti].O[dt] * sc_; *(u32x2*)(op + 16 * dt) = (u32x2){pk2(o[0], o[1]), pk2(o[2], o[3])}; } }
    }
}

struct Route { int e0, s0, e1, s1; float w0, w1; int pad0, pad1; };
__device__ __forceinline__ void ph_ln_route(const Ctx& C, int layer) {
    const float* resid = layer ? (const float*)(C.ws + WS_XR) : C.in[I_X]; const bf16_t* MIX = (const bf16_t*)(C.ws + WS_MIX);
    float* XR = (float*)(C.ws + WS_XR); bf16_t* X1B = (bf16_t*)(C.ws + WS_X1B); Route* RT = (Route*)(C.ws + WS_ROUTE);
    int* rowlist = (int*)(C.ws + WS_ROWLIST); unsigned* cnt = (unsigned*)(C.ws + WS_CTL) + (layer ? CW_CNT1 : CW_CNT0);
    const float* lg = C.in[I_LNG] + (size_t)(layer * 2 + 0) * DM; const float* lb = C.in[I_LNB] + (size_t)(layer * 2 + 0) * DM;
    const float* rw = C.in[I_RW]; const float* rb = C.in[I_RB];
    LAS unsigned* lcnt = (LAS unsigned*)C.lds;
    LAS float* rec = (LAS float*)(C.lds + 256);
    LAS float* lsb = (LAS float*)(C.lds + 4096 + C.wave * 512);
    const int lane = C.lane;
    LAS unsigned char* rwl = (LAS unsigned char*)(C.lds + 8192);
    for (int gi = C.tid; gi < DM * NE / 4; gi += NTHREADS) { const int c = gi >> 2, e4 = gi & 3;
        *(LAS f32x4*)(rwl + (c >> 8) * 17408 + ((c & 255) >> 2) * 272 + (c & 3) * 64 + e4 * 16) = ((const f32x4*)rw)[gi]; }
    __syncthreads();
    for (int chunk = C.bid; chunk < NTOK / 128; chunk += C.nb) {
        if (C.tid < 16) lcnt[C.tid] = 0u;
        __syncthreads();
        for (int i2 = 0; i2 < 8; ++i2) {
            const int rl0 = C.wave * 16 + i2 * 2, row0 = chunk * 128 + rl0;
            f32x4 v[2][4]; float s[2], s2[2];
#pragma unroll
            for (int r = 0; r < 2; ++r) { const f32x4* xr = (const f32x4*)(resid + (size_t)(row0 + r) * DM) + lane; const u32x2* mr = (const u32x2*)(MIX + (size_t)(row0 + r) * DM) + lane; s[r] = 0.f;
#pragma unroll
                for (int j = 0; j < 4; ++j) { const u32x2 w = mr[64 * j]; v[r][j] = xr[64 * j] * DN_ALPHA + (f32x4){bflo(w.x), bfhi(w.x), bflo(w.y), bfhi(w.y)};
                    s[r] += (v[r][j][0] + v[r][j][1]) + (v[r][j][2] + v[r][j][3]); } }
#pragma unroll
            for (int o = 1; o < 64; o <<= 1) { s[0] += __shfl_xor(s[0], o); s[1] += __shfl_xor(s[1], o); }
#pragma unroll
            for (int r = 0; r < 2; ++r) { const float mean = s[r] * (1.f / DM); s2[r] = 0.f;
#pragma unroll
                for (int j = 0; j < 4; ++j) { v[r][j] = v[r][j] - mean; s2[r] += (v[r][j][0] * v[r][j][0] + v[r][j][1] * v[r][j][1]) + (v[r][j][2] * v[r][j][2] + v[r][j][3] * v[r][j][3]); } }
#pragma unroll
            for (int o = 1; o < 64; o <<= 1) { s2[0] += __shfl_xor(s2[0], o); s2[1] += __shfl_xor(s2[1], o); }
            const float rstd0 = 1.f / sqrtf(s2[0] * (1.f / DM) + LN_EPS), rstd1 = 1.f / sqrtf(s2[1] * (1.f / DM) + LN_EPS);
            float p[32];
#pragma unroll
            for (int q = 0; q < 32; ++q) p[q] = 0.f;
#pragma unroll
            for (int j = 0; j < 4; ++j) {
                const int c0 = 4 * lane + 256 * j;
                const f32x4 gg = *(const f32x4*)(lg + c0), bb = *(const f32x4*)(lb + c0);
#pragma unroll
                for (int r = 0; r < 2; ++r) {
                    v[r][j] = v[r][j] * (r ? rstd1 : rstd0) * gg + bb;
                    *((f32x4*)(XR + (size_t)(row0 + r) * DM) + lane + 64 * j) = v[r][j];
                    *(u32x2*)(X1B + (size_t)(row0 + r) * DM + c0) = (u32x2){pk2(v[r][j][0], v[r][j][1]), pk2(v[r][j][2], v[r][j][3])}; }
#pragma unroll
                for (int q = 0; q < 4; ++q) {
                    const LAS f32x4* wr = (const LAS f32x4*)(rwl + j * 17408 + lane * 272 + q * 64);
                    const f32x4 w0 = wr[0], w1 = wr[1], w2 = wr[2], w3 = wr[3];
#pragma unroll
                    for (int r = 0; r < 2; ++r) { const float x = v[r][j][q];
                        p[16 * r + 0] += x * w0[0]; p[16 * r + 1] += x * w0[1]; p[16 * r + 2] += x * w0[2]; p[16 * r + 3] += x * w0[3];
                        p[16 * r + 4] += x * w1[0]; p[16 * r + 5] += x * w1[1]; p[16 * r + 6] += x * w1[2]; p[16 * r + 7] += x * w1[3];
                        p[16 * r + 8] += x * w2[0]; p[16 * r + 9] += x * w2[1]; p[16 * r + 10] += x * w2[2]; p[16 * r + 11] += x * w2[3];
                        p[16 * r + 12] += x * w3[0]; p[16 * r + 13] += x * w3[1]; p[16 * r + 14] += x * w3[2]; p[16 * r + 15] += x * w3[3]; }
                    if (q == 3) asm volatile("" ::: "memory");
                }
            }
#define TRED(N, M) { const bool up = (lane & (M)) != 0; _Pragma("unroll") for (int q = 0; q < (N); ++q) { const float keep = up ? p[q + (N)] : p[q], send = up ? p[q] : p[q + (N)]; p[q] = keep + __shfl_xor(send, (M)); } }
            TRED(16, 32) TRED(8, 16) TRED(4, 8) TRED(2, 4) TRED(1, 2)
#undef TRED
            p[0] += __shfl_xor(p[0], 1);
            const float sc_own = 1.0f / (1.0f + expf(-p[0]));
            if ((lane & 1) == 0) { lsb[lane >> 1] = sc_own; lsb[32 + (lane >> 1)] = sc_own + rb[(lane >> 1) & 15]; }
            WAVE_LDS_SYNC();
            float sc[16], bi[16];
            { const LAS f32x4* a4 = (const LAS f32x4*)(lsb + ((lane >> 5) << 4)); const LAS f32x4* b4 = (const LAS f32x4*)(lsb + 32 + ((lane >> 5) << 4));
#pragma unroll
              for (int q = 0; q < 4; ++q) { const f32x4 x = a4[q], y = b4[q]; sc[4 * q] = x[0]; sc[4 * q + 1] = x[1]; sc[4 * q + 2] = x[2]; sc[4 * q + 3] = x[3]; bi[4 * q] = y[0]; bi[4 * q + 1] = y[1]; bi[4 * q + 2] = y[2]; bi[4 * q + 3] = y[3]; } }
            WAVE_LDS_SYNC();
            int gsel = 0; float gbest = -3e38f;
#pragma unroll
            for (int gq = 0; gq < 4; ++gq) {
                float m1 = -3e38f, m2 = -3e38f;
#pragma unroll
                for (int q = 0; q < 4; ++q) { const float x = bi[4 * gq + q]; if (x > m1) { m2 = m1; m1 = x; } else if (x > m2) m2 = x; }
                const float gs = m1 + m2; if (gs > gbest) { gbest = gs; gsel = gq; }
            }
            int e0 = 0, e1 = 0; float b0 = -3e38f, b1 = -3e38f, w0 = 0.f, w1 = 0.f;
#pragma unroll
            for (int e = 0; e < 16; ++e) {
                if ((e >> 2) == gsel) {
                    const float x = bi[e];
                    if (x > b0) { b1 = b0; e1 = e0; w1 = w0; b0 = x; e0 = e; w0 = sc[e]; }
                    else if (x > b1) { b1 = x; e1 = e; w1 = sc[e]; }
                }
            }
            if ((lane & 31) == 0) {
                const int rl = rl0 + (lane >> 5);
                const float ws_ = w0 + w1;
                const unsigned l0 = __hip_atomic_fetch_add(lcnt + e0, 1u, __ATOMIC_RELAXED, __HIP_MEMORY_SCOPE_WORKGROUP), l1 = __hip_atomic_fetch_add(lcnt + e1, 1u, __ATOMIC_RELAXED, __HIP_MEMORY_SCOPE_WORKGROUP);
                LAS float* r = rec + rl * 6; r[0] = __int_as_float(e0); r[1] = __int_as_float(e1); r[2] = __uint_as_float(l0); r[3] = __uint_as_float(l1); r[4] = w0 / ws_; r[5] = w1 / ws_;
            }
        }
        __syncthreads();
        if (C.tid < 16) lcnt[16 + C.tid] = atomicAdd(cnt + 64 * C.tid, lcnt[C.tid]);
        __syncthreads();
        if (C.tid < 128) {
            const LAS float* r = rec + C.tid * 6; const int row = chunk * 128 + C.tid;
            const int e0 = __float_as_int(r[0]), e1 = __float_as_int(r[1]);
            const int s0 = (int)(lcnt[16 + e0] + __float_as_uint(r[2])), s1 = (int)(lcnt[16 + e1] + __float_as_uint(r[3]));
            rowlist[e0 * NTOK + s0] = row; rowlist[e1 * NTOK + s1] = row;
            Route rr; rr.e0 = e0; rr.s0 = s0; rr.e1 = e1; rr.s1 = s1; rr.w0 = r[4]; rr.w1 = r[5]; rr.pad0 = 0; rr.pad1 = 0;
            RT[row] = rr;
        }
        __syncthreads();
    }
}
__device__ __forceinline__ void ph_combine(const Ctx& C, int layer, float* outp, LAS int* sm) {
    const float* XR = (const float*)(C.ws + WS_XR); const bf16_t* Y2 = (const bf16_t*)(C.ws + WS_Y2); const Route* RT = (const Route*)(C.ws + WS_ROUTE);
    bf16_t* XB = (bf16_t*)(C.ws + WS_XB);
    const float* lg = C.in[I_LNG] + (size_t)(layer * 2 + 1) * DM; const float* lb = C.in[I_LNB] + (size_t)(layer * 2 + 1) * DM;
    const int gw = C.bid * NWAVES + C.wave, NGW = C.nb * NWAVES, lane = C.lane;
    for (int row = gw; row < NTOK; row += NGW) {
        const Route r = RT[row];
        const bf16_t* y0 = Y2 + (size_t)(sm[16 + r.e0] + r.s0) * DM; const bf16_t* y1 = Y2 + (size_t)(sm[16 + r.e1] + r.s1) * DM;
        const f32x4* xr = (const f32x4*)(XR + (size_t)row * DM) + lane;
        f32x4 v[4]; float s = 0.f;
#pragma unroll
        for (int j = 0; j < 4; ++j) {
            const int c0 = 4 * lane + 256 * j;
            const u32x2 a = *(const u32x2*)(y0 + c0), b = *(const u32x2*)(y1 + c0);
            const f32x4 ya = (f32x4){bflo(a.x), bfhi(a.x), bflo(a.y), bfhi(a.y)}, yb = (f32x4){bflo(b.x), bfhi(b.x), bflo(b.y), bfhi(b.y)};
            v[j] = xr[64 * j] * DN_ALPHA + ya * r.w0 + yb * r.w1;
            s += (v[j][0] + v[j][1]) + (v[j][2] + v[j][3]);
        }
        const float mean = wave_sum(s) * (1.f / DM); float s2 = 0.f;
#pragma unroll
        for (int j = 0; j < 4; ++j) { v[j] = v[j] - mean; s2 += (v[j][0] * v[j][0] + v[j][1] * v[j][1]) + (v[j][2] * v[j][2] + v[j][3] * v[j][3]); }
        const float rstd = 1.f / sqrtf(wave_sum(s2) * (1.f / DM) + LN_EPS);
#pragma unroll
        for (int j = 0; j < 4; ++j) {
            const int c0 = 4 * lane + 256 * j;
            const f32x4 gg = *(const f32x4*)(lg + c0), bb = *(const f32x4*)(lb + c0);
            v[j] = v[j] * rstd * gg + bb;
            *(f32x4*)(outp + (size_t)row * DM + c0) = v[j];
            *(u32x2*)(XB + (size_t)row * DM + c0) = (u32x2){pk2(v[j][0], v[j][1]), pk2(v[j][2], v[j][3])};
        }
    }
}

__device__ __forceinline__ void ph_kmean(const Ctx& C) {
    const bf16_t* K1 = (const bf16_t*)(C.ws + WS_K1); float* KM = (float*)(C.ws + WS_KMEAN);
    const int gw = C.bid * NWAVES + C.wave, NGW = C.nb * NWAVES, lane = C.lane;
    for (int it = gw; it < NB * NH * 32; it += NGW) {
        const bf16_t* p = K1 + (size_t)it * 256 * DH + lane; float s = 0.f;
#pragma unroll 8
        for (int j = 0; j < 256; ++j) s += bf2f(p[j * DH]);
        KM[(size_t)it * DH + lane] = s * (1.0f / 256.0f);
    }
}
constexpr int NPHASE = 19;
__global__ void __launch_bounds__(NTHREADS, 2) fwd(Args args) {
    extern __shared__ __attribute__((aligned(16))) unsigned char lds[];
    Ctx C;
#pragma unroll
    for (int i = 0; i < 18; ++i) C.in[i] = args.in[i];
    C.out = args.out; C.ws = args.ws; C.lds = lds;
    C.tid = threadIdx.x; C.lane = C.tid & 63; C.wave = __builtin_amdgcn_readfirstlane(C.tid >> 6); C.bid = blockIdx.x; C.nb = gridDim.x;
    LAS unsigned* misc = (LAS unsigned*)(lds + LDS_BYTES - 512);
    LAS int* sm = (LAS int*)(misc + 16);
    if (C.tid < 4) misc[C.tid] = 0u;
    __syncthreads();
#if MK_SINGLE
    XcdBarrier bar = xcd_barrier_post((unsigned*)(C.ws + WS_CTL) + CW_BAR, (volatile LAS unsigned*)misc);
#define SEAM() xcd_barrier(bar)
#else
#define SEAM() do {} while (0)
#endif
    const int lo = args.ph_lo, hi = args.ph_hi;
#ifndef PH_MASK
#define PH_MASK 0xFFFFFFFFu
#endif
#define IN(k) (((PH_MASK >> (k)) & 1u) && lo <= (k) && (k) < hi)
#define BOTH(k) (IN(k) && IN((k) + 1))
    unsigned char* ws = C.ws;
    const float2* rope = (const float2*)(ws + WS_ROPE);
    LAS unsigned char* L = (LAS unsigned char*)lds;

    if (IN(0)) { ph_prologue(C); if (BOTH(0)) SEAM(); }
    if (IN(1)) {
        EpiNsaIn E{(bf16_t*)(ws + WS_Q), (bf16_t*)(ws + WS_KV0), (float*)(ws + WS_GATES), rope};
        g8::StaticOrder S; S.init(NTOK / 256, 2560 / 256, C.nb, C.bid);
        g8::gemm8<false>(L, (const bf16_t*)(ws + WS_XB), DM, (const bf16_t*)(ws + WS_WT_NSA_IN), DM, S, g8::EpiEl<EpiNsaIn>{E}, g8::GatherInfo{nullptr, sm});
        if (BOTH(1)) SEAM();
    }
    if (IN(2)) {
        EpiGelu EK{(bf16_t*)(ws + WS_H1K), (const float*)(ws + WS_BIAS1)}, EV{(bf16_t*)(ws + WS_H1V), (const float*)(ws + WS_BIAS1) + 256};
        g8::StaticOrder SK, SV; SK.init(32, 1, C.nb, C.bid); SV.init(32, 1, C.nb, (C.bid + C.nb / 2) % C.nb);
        g8::gemm8<false>(L, (const bf16_t*)(ws + WS_KV0), 1024, (const bf16_t*)(ws + WS_WT_C1K), 2048, SK, g8::EpiEl<EpiGelu>{EK}, g8::GatherInfo{nullptr, sm});
        g8::gemm8<false>(L, (const bf16_t*)(ws + WS_KV0 + KVSEG), 1024, (const bf16_t*)(ws + WS_WT_C1V), 2048, SV, g8::EpiEl<EpiGelu>{EV}, g8::GatherInfo{nullptr, sm});
        if (C.nb == 256 && !((C.bid < 32) || (C.bid >= 128 && C.bid < 160))) {
            EpiNsaIn E{(bf16_t*)(ws + WS_Q), (bf16_t*)(ws + WS_KV0), (float*)(ws + WS_GATES), rope};
            const int gidx = C.bid < 128 ? C.bid - 32 : C.bid - 64, fr = C.lane & 15, fq = C.lane >> 4;
            for (int tile = gidx * NWAVES + C.wave; tile < 2048; tile += 192 * NWAVES) {
                const int row0 = (tile >> 1) * 32, col0 = 2560 + (tile & 1) * 32;
                const bf16_t* a0 = (const bf16_t*)(ws + WS_XB) + (size_t)(row0 + fr) * DM + fq * 8; const bf16_t* a1 = a0 + (size_t)16 * DM;
                const bf16_t* b0 = (const bf16_t*)(ws + WS_WT_NSA_IN) + (size_t)(col0 + fr) * DM + fq * 8; const bf16_t* b1 = b0 + (size_t)16 * DM;
                f32x4 acc[2][2]; mma_core(a0, a1, b0, b1, DM, acc);
#pragma unroll
                for (int mi = 0; mi < 2; ++mi)
#pragma unroll
                    for (int ni = 0; ni < 2; ++ni) E(row0 + 16 * mi + fr, col0 + 16 * ni + 4 * fq, acc[mi][ni]);
            }
        } else if (C.nb != 256) {
            EpiNsaIn E{(bf16_t*)(ws + WS_Q), (bf16_t*)(ws + WS_KV0), (float*)(ws + WS_GATES), rope};
            const int fr = C.lane & 15, fq = C.lane >> 4;
            for (int tile = C.bid * NWAVES + C.wave; tile < 2048; tile += C.nb * NWAVES) {
                const int row0 = (tile >> 1) * 32, col0 = 2560 + (tile & 1) * 32;
                const bf16_t* a0 = (const bf16_t*)(ws + WS_XB) + (size_t)(row0 + fr) * DM + fq * 8; const bf16_t* a1 = a0 + (size_t)16 * DM;
                const bf16_t* b0 = (const bf16_t*)(ws + WS_WT_NSA_IN) + (size_t)(col0 + fr) * DM + fq * 8; const bf16_t* b1 = b0 + (size_t)16 * DM;
                f32x4 acc[2][2]; mma_core(a0, a1, b0, b1, DM, acc);
#pragma unroll
                for (int mi = 0; mi < 2; ++mi)
#pragma unroll
                    for (int ni = 0; ni < 2; ++ni) E(row0 + 16 * mi + fr, col0 + 16 * ni + 4 * fq, acc[mi][ni]);
            }
        }
        if (BOTH(2)) SEAM();
    }
    if (IN(3)) { ph_cmp2(C); if (BOTH(3)) SEAM(); }
    if (IN(4)) { ph_nsa_fa(C); if (BOTH(4)) SEAM(); }
    if (IN(6)) {
        EpiBf16 E{(bf16_t*)(ws + WS_MIX)};
        g8::StaticOrder S; S.init(NTOK / 256, DM / 256, C.nb, C.bid);
        g8::gemm8<false>(L, (const bf16_t*)(ws + WS_XB), DM, (const bf16_t*)(ws + WS_WT_NSA_OUT), DM, S, g8::EpiEl<EpiBf16>{E}, g8::GatherInfo{nullptr, sm});
        if (BOTH(6)) SEAM();
    }
    if (IN(7)) { ph_ln_route(C, 0); if (BOTH(7)) SEAM(); }
    if (IN(8)) {
        load_expert_map(C, CW_CNT0, sm);
        EpiSwiGLU E{(bf16_t*)(ws + WS_HBUF)};
        g8::GroupedOrder S; S.init(sm, 4, C.nb, C.bid);
        g8::gemm8<true>(L, (const bf16_t*)(ws + WS_X1B), DM, (const bf16_t*)(ws + WS_WT_GU), 1024, S, g8::EpiEl<EpiSwiGLU>{E}, g8::GatherInfo{(const int*)(ws + WS_ROWLIST), sm});
        if (BOTH(8)) SEAM();
    }
    if (IN(9)) {
        load_expert_map(C, CW_CNT0, sm);
        EpiBf16 E{(bf16_t*)(ws + WS_Y2)};
        g8::GroupedOrder S; S.init(sm, 4, C.nb, C.bid);
        g8::gemm8<false>(L, (const bf16_t*)(ws + WS_HBUF), DE, (const bf16_t*)(ws + WS_WT_DN), DE, S, g8::EpiEl<EpiBf16>{E}, g8::GatherInfo{nullptr, sm});
        if (BOTH(9)) SEAM();
    }
    if (IN(10)) {
        load_expert_map(C, CW_CNT0, sm);
        ph_combine(C, 0, (float*)(ws + WS_XR), sm);
        { float* scr = (float*)(C.lds + C.wave * 9216); const int gw = C.bid * NWAVES + C.wave, NGW = C.nb * NWAVES;
          for (int it = gw; it < MOE_W_ITEMS; it += NGW) moe_weight_item(C, 1, it, scr); }
        if (BOTH(10)) SEAM();
    }
    if (IN(11)) {
        EpiMobaIn E{(bf16_t*)(ws + WS_Q), (bf16_t*)(ws + WS_K1), (bf16_t*)(ws + WS_V1), rope};
        g8::StaticOrder S; S.init(NTOK / 256, 3072 / 256, C.nb, C.bid);
        g8::gemm8<false>(L, (const bf16_t*)(ws + WS_XB), DM, (const bf16_t*)(ws + WS_WT_MOBA_IN), DM, S, g8::EpiEl<EpiMobaIn>{E}, g8::GatherInfo{nullptr, sm});
        if (BOTH(11)) SEAM();
    }
    if (IN(12)) { ph_kmean(C); if (BOTH(12)) SEAM(); }
    if (IN(13)) { ph_moba_fa(C); if (BOTH(13)) SEAM(); }
    if (IN(14)) {
        EpiBf16 E{(bf16_t*)(ws + WS_MIX)};
        g8::StaticOrder S; S.init(NTOK / 256, DM / 256, C.nb, C.bid);
        g8::gemm8<false>(L, (const bf16_t*)(ws + WS_XB), DM, (const bf16_t*)(ws + WS_WT_MOBA_OUT), DM, S, g8::EpiEl<EpiBf16>{E}, g8::GatherInfo{nullptr, sm});
        if (BOTH(14)) SEAM();
    }
    if (IN(15)) { ph_ln_route(C, 1); if (BOTH(15)) SEAM(); }
    if (IN(16)) {
        load_expert_map(C, CW_CNT1, sm);
        EpiSwiGLU E{(bf16_t*)(ws + WS_HBUF)};
        g8::GroupedOrder S; S.init(sm, 4, C.nb, C.bid);
        g8::gemm8<true>(L, (const bf16_t*)(ws + WS_X1B), DM, (const bf16_t*)(ws + WS_WT_GU), 1024, S, g8::EpiEl<EpiSwiGLU>{E}, g8::GatherInfo{(const int*)(ws + WS_ROWLIST), sm});
        if (BOTH(16)) SEAM();
    }
    if (IN(17)) {
        load_expert_map(C, CW_CNT1, sm);
        EpiBf16 E{(bf16_t*)(ws + WS_Y2)};
        g8::GroupedOrder S; S.init(sm, 4, C.nb, C.bid);
        g8::gemm8<false>(L, (const bf16_t*)(ws + WS_HBUF), DE, (const bf16_t*)(ws + WS_WT_DN), DE, S, g8::EpiEl<EpiBf16>{E}, g8::GatherInfo{nullptr, sm});
        if (BOTH(17)) SEAM();
    }
    if (IN(18)) {
        load_expert_map(C, CW_CNT1, sm);
        ph_combine(C, 1, C.out, sm);
    }
#undef IN
#undef BOTH
}

extern "C" void kernel_launch(void* const* d_in, const int* in_sizes, int n_in, void* d_out, int out_size, void* d_ws, size_t ws_size, hipStream_t stream) {
    static int grid = 0;
    if (grid == 0) {
        if (n_in != 18 || in_sizes[0] != NTOK * DM || out_size != NTOK * DM || ws_size < WS_END) {
            fprintf(stderr, "kernel_launch: unexpected shapes (n_in %d, in0 %d, out %d, ws %zu; need ws >= %zu); nothing launched\n", n_in, n_in > 0 ? in_sizes[0] : -1, out_size, ws_size, (size_t)WS_END);
            grid = -1; return;
        }
        int dev = 0, cus = 0, per_cu = 0;
        if (hipGetDevice(&dev) != hipSuccess || hipDeviceGetAttribute(&cus, hipDeviceAttributeMultiprocessorCount, dev) != hipSuccess) { grid = -1; return; }
        if (hipFuncSetAttribute((const void*)fwd, hipFuncAttributeMaxDynamicSharedMemorySize, LDS_BYTES) != hipSuccess) { fprintf(stderr, "kernel_launch: hipFuncSetAttribute failed\n"); grid = -1; return; }
        if (hipOccupancyMaxActiveBlocksPerMultiprocessor(&per_cu, (const void*)fwd, NTHREADS, LDS_BYTES) != hipSuccess || per_cu < 1)
            fprintf(stderr, "kernel_launch: occupancy query reports %d blocks per CU\n", per_cu);
        (void)hipGetLastError();
        grid = cus;
    }
    if (grid < 0) return;
    if (hipMemsetAsync((char*)d_ws + WS_CTL, 0, CTL_BYTES, stream) != hipSuccess) { fprintf(stderr, "kernel_launch: memset failed\n"); return; }
    Args a{};
    for (int i = 0; i < 18; ++i) a.in[i] = (const float*)d_in[i];
    a.out = (float*)d_out; a.ws = (unsigned char*)d_ws;
#if defined(PROBE_PH)
    { const int lo3[3] = {0, PROBE_PH, PROBE_PH + 1}, hi3[3] = {PROBE_PH + 1, PROBE_PH + 1, NPHASE};
      for (int q = 0; q < 3; ++q) { if (lo3[q] >= hi3[q]) continue;
          if (q) (void)hipMemsetAsync((char*)d_ws + WS_CTL + CW_BAR * 4, 0, XCD_BAR_WORDS * 4, stream);
          a.ph_lo = lo3[q]; a.ph_hi = hi3[q]; hipLaunchKernelGGL(fwd, dim3(grid), dim3(NTHREADS), LDS_BYTES, stream, a); } }
#elif MK_SINGLE
    a.ph_lo = 0; a.ph_hi = NPHASE;
    hipLaunchKernelGGL(fwd, dim3(grid), dim3(NTHREADS), LDS_BYTES, stream, a);
#else
    for (int p = 0; p < NPHASE; ++p) { a.ph_lo = p; a.ph_hi = p + 1; hipLaunchKernelGGL(fwd, dim3(grid), dim3(NTHREADS), LDS_BYTES, stream, a); }
#endif
    const hipError_t le = hipPeekAtLastError();
    if (le != hipSuccess) fprintf(stderr, "kernel_launch: launch failed: %s\n", hipGetErrorName(le));
}
```

```cpp
#include <hip/hip_runtime.h>
#include <cstdio>
#include <cstdint>

#ifndef SEL_FUSED
#define SEL_FUSED 1
#endif
#ifndef MK_SINGLE
#define MK_SINGLE 1
#endif

#define LAS __attribute__((address_space(3)))
typedef unsigned short bf16_t;
typedef short bf16x8 __attribute__((ext_vector_type(8)));
typedef float f32x4 __attribute__((ext_vector_type(4)));
typedef unsigned u32x4 __attribute__((ext_vector_type(4)));
typedef unsigned u32x2 __attribute__((ext_vector_type(2)));

constexpr int NB = 4, SEQ = 8192, NTOK = NB * SEQ, DM = 1024, NH = 16, DH = 64, NG = 4;
constexpr int NSA_IN = 2608, NSA_INP = 2816;
constexpr int NE = 16, DE = 512;
constexpr float DN_ALPHA = 1.4142135623730951f;
constexpr float LN_EPS = 1e-5f;
constexpr int NWAVES = 8, NTHREADS = 512;
constexpr float QSCALE = 0.125f * 1.4426950408889634f;
constexpr int LDS_BYTES = 163840;
constexpr int ROWCAP = 2 * NTOK + NE * 256;

constexpr size_t MiB = 1u << 20;
constexpr size_t WS_CTL = 0, CTL_BYTES = 1 * MiB;
constexpr size_t WS_ROPE = 1 * MiB;
constexpr size_t WS_BIAS1 = 3 * MiB;
constexpr size_t WS_KMEAN = 4 * MiB;
constexpr size_t WS_ROUTE = 5 * MiB;
constexpr size_t WS_ROWLIST = 6 * MiB;
constexpr size_t WS_SEL = 8 * MiB;
constexpr size_t WS_GATES = 10 * MiB;
constexpr size_t WS_H1K = 17 * MiB, WS_H1V = 21 * MiB;
constexpr size_t WS_KC = 25 * MiB, WS_VC = 26 * MiB;
constexpr size_t WS_WT_NSA_IN = 27 * MiB;
constexpr size_t WS_WT_NSA_OUT = 33 * MiB;
constexpr size_t WS_WT_C1K = 35 * MiB, WS_WT_C1V = 36 * MiB;
constexpr size_t WS_WT_MOBA_IN = 37 * MiB;
constexpr size_t WS_WT_MOBA_OUT = 43 * MiB;
constexpr size_t WS_WT_GU = 45 * MiB;
constexpr size_t WS_WT_DN = 77 * MiB;
constexpr size_t WS_XB = 93 * MiB;
constexpr size_t WS_ATTN = 161 * MiB;
constexpr size_t WS_Q = WS_ATTN;
constexpr size_t WS_KV0 = WS_ATTN + 64 * MiB;
constexpr size_t KVSEG = 16 * MiB;
constexpr size_t WS_K1 = WS_ATTN + 64 * MiB, WS_V1 = WS_ATTN + 128 * MiB;
constexpr size_t WS_X1B = WS_ATTN;
constexpr size_t WS_MIX = WS_ATTN + 64 * MiB;
constexpr size_t WS_Y2 = WS_ATTN;
constexpr size_t WS_HBUF = WS_XB;
constexpr size_t WS_XR = 353 * MiB;
constexpr size_t WS_END = 481 * MiB;
static_assert((size_t)ROWCAP * 512 * 2 <= 68 * MiB && (size_t)ROWCAP * 1024 * 2 <= 192 * MiB, "overlay sizes");

constexpr int CW_TMO = 0;
constexpr int CW_CNT0 = 1024, CW_CNT1 = 2048;
constexpr int CW_BAR = 8192;

__device__ __forceinline__ unsigned f2bf(float f) { unsigned u = __float_as_uint(f); return (u + 0x7fffu + ((u >> 16) & 1u)) >> 16; }
typedef float f32x2v __attribute__((ext_vector_type(2)));
typedef __bf16 bf16x2v __attribute__((ext_vector_type(2)));
__device__ __forceinline__ unsigned pk2(float lo, float hi) { const f32x2v v = {lo, hi}; const bf16x2v b = __builtin_convertvector(v, bf16x2v); return __builtin_bit_cast(unsigned, b); }
__device__ __forceinline__ float bflo(unsigned u) { return __uint_as_float(u << 16); }
__device__ __forceinline__ float bfhi(unsigned u) { return __uint_as_float(u & 0xffff0000u); }
__device__ __forceinline__ float bf2f(bf16_t b) { return __uint_as_float((unsigned)b << 16); }
__device__ __forceinline__ float wave_sum(float v) {
#pragma unroll
    for (int o = 1; o < 64; o <<= 1) v += __shfl_xor(v, o);
    return v;
}
__device__ __forceinline__ float wave_max(float v) {
#pragma unroll
    for (int o = 1; o < 64; o <<= 1) v = fmaxf(v, __shfl_xor(v, o));
    return v;
}
#define WAVE_LDS_SYNC() asm volatile("s_waitcnt lgkmcnt(0)" ::: "memory")
__device__ __forceinline__ float sigmoidf_(float x) { return 1.0f / (1.0f + __expf(-x)); }
__device__ __forceinline__ float gelu_tanh(float x) {
    const float u = 0.7978845608028654f * (x + 0.044715f * x * x * x);
    const float t = 1.0f - 2.0f / (__expf(2.0f * u) + 1.0f);
    return 0.5f * x * (1.0f + t);
}

#define XB_TMO      128
#define XB_XCNT(j)  (256  + 64 * (j))
#define XB_XSUB(j)  (1280 + 64 * (j))
#define XB_XGEN(j)  (2304 + 64 * (j))
#define XB_TOP      3328
#define XB_TOPGEN   3392
#define XCD_BAR_WORDS 3456
#define XB_SPIN_CAP (1u << 22)
__device__ __forceinline__ unsigned xb_ld(unsigned* p)              { return __hip_atomic_load(p, __ATOMIC_RELAXED, __HIP_MEMORY_SCOPE_AGENT); }
__device__ __forceinline__ unsigned xb_add(unsigned* p, unsigned v) { return __hip_atomic_fetch_add(p, v, __ATOMIC_RELAXED, __HIP_MEMORY_SCOPE_AGENT); }
__device__ __forceinline__ unsigned xb_xcc_id() { return (unsigned)__builtin_amdgcn_s_getreg((3 << 11) | 20) & 0xFu; }
#define XB_SPIN(cond, bar) do { unsigned _sp = 0; while (cond) { __builtin_amdgcn_s_sleep(1); \
    if ((++_sp & 255u) == 0u) { if (xb_ld(&(bar)[XB_TMO])) break; if (_sp > XB_SPIN_CAP) { atomicAdd(&(bar)[XB_TMO], 1u); break; } } } } while (0)
struct XcdBarrier { unsigned* bar; unsigned x; volatile LAS unsigned* st; };
__device__ __forceinline__ XcdBarrier xcd_barrier_post(unsigned* bar, volatile LAS unsigned* st) {
    XcdBarrier b; b.bar = bar; b.x = xb_xcc_id(); b.st = st;
    if (threadIdx.x == 0) (void)xb_add(&bar[XB_XCNT(b.x)], 1u);
    return b;
}
__device__ __forceinline__ void xcd_barrier_complete(unsigned* bar, unsigned x, unsigned& nloc, unsigned& nx) {
    const unsigned G = gridDim.x * gridDim.y * gridDim.z;
    unsigned sum, cnt, mine, sp = 0u;
    for (;;) {
        sum = 0u; cnt = 0u; mine = 0u;
#pragma unroll
        for (unsigned j = 0; j < 16; ++j) { const unsigned c = xb_ld(&bar[XB_XCNT(j)]); sum += c; cnt += (c > 0u) ? 1u : 0u; mine = (j == x) ? c : mine; }
        if (sum == G) break;
        __builtin_amdgcn_s_sleep(1);
        if ((++sp & 255u) == 0u) { if (xb_ld(&bar[XB_TMO])) break; if (sp > XB_SPIN_CAP) { atomicAdd(&bar[XB_TMO], 1u); break; } }
    }
    nloc = mine > 0u ? mine : 1u; nx = cnt > 0u ? cnt : 1u;
}
__device__ __forceinline__ void xcd_barrier(const XcdBarrier& b) {
    asm volatile("s_waitcnt vmcnt(0)" ::: "memory");
    __syncthreads();
    if (threadIdx.x == 0) {
        unsigned* bar = b.bar;
        __builtin_amdgcn_s_waitcnt(0);
        unsigned nloc = b.st[0], nx = b.st[1];
        if (nloc == 0u) { xcd_barrier_complete(bar, b.x, nloc, nx); b.st[0] = nloc; b.st[1] = nx; }
        const unsigned old = xb_add(&bar[XB_XSUB(b.x)], 1u);
        const unsigned gen = old / nloc;
        if (old + 1u == (gen + 1u) * nloc) {
            __builtin_amdgcn_fence(__ATOMIC_RELEASE, "agent");
            asm volatile("s_waitcnt vmcnt(0)" ::: "memory");
            const unsigned og = xb_add(&bar[XB_TOP], 1u);
            const unsigned tg = og / nx;
            if (og + 1u == (tg + 1u) * nx) xb_add(&bar[XB_TOPGEN], 1u);
            else XB_SPIN(xb_ld(&bar[XB_TOPGEN]) == tg, bar);
            __builtin_amdgcn_fence(__ATOMIC_ACQUIRE, "agent");
            xb_add(&bar[XB_XGEN(b.x)], 1u);
            asm volatile("s_waitcnt vmcnt(0)" ::: "memory");
        } else {
            XB_SPIN(xb_ld(&bar[XB_XGEN(b.x)]) == gen, bar);
            __builtin_amdgcn_fence(__ATOMIC_ACQUIRE, "agent");
            asm volatile("s_waitcnt vmcnt(0)" ::: "memory");
        }
    }
    __syncthreads();
}

struct Args { const float* in[18]; float* out; unsigned char* ws; int ph_lo, ph_hi; };
struct Ctx {
    const float* in[18]; float* out; unsigned char* ws; unsigned char* lds;
    int tid, lane, wave, bid, nb;
};
enum { I_X = 0, I_NSA_WIN, I_NSA_WOUT, I_CK_W1, I_CK_W2, I_CV_W1, I_CV_W2, I_CK_POS, I_CV_POS, I_MOBA_WIN, I_MOBA_WOUT, I_RW, I_RB, I_WG, I_WU, I_WD, I_LNG, I_LNB };

__device__ __forceinline__ int il64(int d) { return d < 32 ? 2 * d : 2 * (d - 32) + 1; }
__device__ __forceinline__ int rowmap(int kind, int n) {
    switch (kind) {
        case 1: { const bool r = (n < 1024) || (n >= 1536 && n < 1792) || (n >= 2048 && n < 2304); return r ? (n & ~63) + il64(n & 63) : n; }
        case 2: return n < 2048 ? (n & ~63) + il64(n & 63) : n;
        case 3: return 2 * n;
        case 4: return 2 * n + 1;
        default: return n;
    }
}
__device__ __forceinline__ void transpose_item(const float* W, int ldw, int ncols, bf16_t* WT, int K, int kb, int nbk, int kind, float* scr, int lane) {
    const int k0 = 64 * kb, n0 = 32 * nbk;
    const int cq = lane & 7, nn = n0 + 4 * cq;
#pragma unroll
    for (int i = 0; i < 8; ++i) { const int kk = 8 * i + (lane >> 3);
        *(f32x4*)(scr + kk * 36 + 4 * cq) = nn < ncols ? *(const f32x4*)(W + (size_t)(k0 + kk) * ldw + nn) : (f32x4){0.f, 0.f, 0.f, 0.f}; }
    WAVE_LDS_SYNC();
    const int c = lane & 7;
#pragma unroll
    for (int j = 0; j < 4; ++j) {
        const int n = (lane >> 3) + 8 * j; const float* s = scr + (8 * c) * 36 + n;
        u32x4 o; o.x = pk2(s[0 * 36], s[1 * 36]); o.y = pk2(s[2 * 36], s[3 * 36]); o.z = pk2(s[4 * 36], s[5 * 36]); o.w = pk2(s[6 * 36], s[7 * 36]);
        *(u32x4*)(WT + (size_t)rowmap(kind, n0 + n) * K + k0 + 8 * c) = o;
    }
    WAVE_LDS_SYNC();
}
constexpr int MOE_W_ITEMS = NE * 768;
__device__ __forceinline__ void moe_weight_item(const Ctx& C, int layer, int r, float* scr) {
    const int e = r / 768; int q = r % 768;
    bf16_t* gu = (bf16_t*)(C.ws + WS_WT_GU) + (size_t)e * 1024 * 1024;
    bf16_t* dn = (bf16_t*)(C.ws + WS_WT_DN) + (size_t)e * 1024 * 512;
    const size_t eo = (size_t)(layer * NE + e);
    if (q < 256) { transpose_item(C.in[I_WG] + eo * DM * DE, DE, DE, gu, DM, q / 16, q % 16, 3, scr, C.lane); return; } q -= 256;
    if (q < 256) { transpose_item(C.in[I_WU] + eo * DM * DE, DE, DE, gu, DM, q / 16, q % 16, 4, scr, C.lane); return; } q -= 256;
    transpose_item(C.in[I_WD] + eo * DE * DM, DM, DM, dn, DE, q / 32, q % 32, 0, scr, C.lane);
}

__device__ __forceinline__ void ph_prologue(const Ctx& C) {
    float* scr = (float*)(C.lds + C.wave * 9216);
    const int gw = C.bid * NWAVES + C.wave, NGW = C.nb * NWAVES;
    constexpr int I_A = 16 * 82, I_B = 16 * 32, I_C = 32 * 8, I_D = 16 * 96, I_E = 16 * 32;
    constexpr int NIT = I_A + I_B + 2 * I_C + I_D + I_E + MOE_W_ITEMS;
    for (int it = gw; it < NIT; it += NGW) {
        int r = it;
        if (r < I_A) { transpose_item(C.in[I_NSA_WIN], NSA_IN, NSA_IN, (bf16_t*)(C.ws + WS_WT_NSA_IN), DM, r / 82, r % 82, 1, scr, C.lane); continue; } r -= I_A;
        if (r < I_B) { transpose_item(C.in[I_NSA_WOUT], DM, DM, (bf16_t*)(C.ws + WS_WT_NSA_OUT), DM, r / 32, r % 32, 0, scr, C.lane); continue; } r -= I_B;
        if (r < I_C) { transpose_item(C.in[I_CK_W1], 256, 256, (bf16_t*)(C.ws + WS_WT_C1K), 2048, r / 8, r % 8, 0, scr, C.lane); continue; } r -= I_C;
        if (r < I_C) { transpose_item(C.in[I_CV_W1], 256, 256, (bf16_t*)(C.ws + WS_WT_C1V), 2048, r / 8, r % 8, 0, scr, C.lane); continue; } r -= I_C;
        if (r < I_D) { transpose_item(C.in[I_MOBA_WIN], 3072, 3072, (bf16_t*)(C.ws + WS_WT_MOBA_IN), DM, r / 96, r % 96, 2, scr, C.lane); continue; } r -= I_D;
        if (r < I_E) { transpose_item(C.in[I_MOBA_WOUT], DM, DM, (bf16_t*)(C.ws + WS_WT_MOBA_OUT), DM, r / 32, r % 32, 0, scr, C.lane); continue; } r -= I_E;
        moe_weight_item(C, 0, r, scr);
    }
    const int gt = C.bid * NTHREADS + C.tid, NGT = C.nb * NTHREADS;
    { u32x4* p = (u32x4*)((bf16_t*)(C.ws + WS_WT_NSA_IN) + (size_t)2624 * DM); const int n = (NSA_INP - 2624) * DM / 8;
      for (int i = gt; i < n; i += NGT) p[i] = (u32x4){0u, 0u, 0u, 0u}; }
    { const f32x4* x4 = (const f32x4*)C.in[I_X]; u32x4* o = (u32x4*)(C.ws + WS_XB); const int n = NTOK * DM / 8;
      for (int i = gt; i < n; i += NGT) { const f32x4 a = x4[2 * i], b = x4[2 * i + 1]; o[i] = (u32x4){pk2(a.x, a.y), pk2(a.z, a.w), pk2(b.x, b.y), pk2(b.z, b.w)}; } }
    { const float INV[32] = {1.000000000e+00f, 7.498942018e-01f, 5.623413324e-01f, 4.216965139e-01f, 3.162277639e-01f, 2.371373922e-01f, 1.778279394e-01f, 1.333521456e-01f,
                             1.000000015e-01f, 7.498941571e-02f, 5.623412877e-02f, 4.216964915e-02f, 3.162277862e-02f, 2.371373586e-02f, 1.778279431e-02f, 1.333521493e-02f,
                             9.999999776e-03f, 7.498942316e-03f, 5.623413250e-03f, 4.216964822e-03f, 3.162277862e-03f, 2.371373819e-03f, 1.778279431e-03f, 1.333521446e-03f,
                             1.000000047e-03f, 7.498941850e-04f, 5.623413017e-04f, 4.216965463e-04f, 3.162277862e-04f, 2.371373848e-04f, 1.778279402e-04f, 1.333521504e-04f};
      float2* tab = (float2*)(C.ws + WS_ROPE);
      for (int i = gt; i < SEQ * 32; i += NGT) {
          const int t = i >> 5, f = i & 31;
          float inv = INV[0];
#pragma unroll
          for (int q = 1; q < 32; ++q) inv = (f == q) ? INV[q] : inv;
          const float ang = (float)t * inv;
          const double a = (double)ang; const double k = __builtin_rint(a * 0.15915494309189535); const float rf = (float)(a - k * 6.283185307179586);
          tab[i] = make_float2(__cosf(rf), __sinf(rf));
      } }
    for (int o = gw; o < 512; o += NGW) {
        const int which = o >> 8, c = o & 255;
        const float* pos = C.in[which ? I_CV_POS : I_CK_POS]; const float* w1 = C.in[which ? I_CV_W1 : I_CK_W1];
        float s = 0.f;
        for (int k = C.lane; k < 2048; k += 64) s += pos[k] * w1[(size_t)k * 256 + c];
        s = wave_sum(s);
        if (C.lane == 0) ((float*)(C.ws + WS_BIAS1))[o] = s;
    }
}

__device__ __forceinline__ void mma_core(const bf16_t* a0, const bf16_t* a1, const bf16_t* b0, const bf16_t* b1, int K, f32x4 (&acc)[2][2]) {
#pragma unroll
    for (int i = 0; i < 2; ++i)
#pragma unroll
        for (int j = 0; j < 2; ++j) acc[i][j] = (f32x4){0.f, 0.f, 0.f, 0.f};
#pragma unroll 4
    for (int k = 0; k < K; k += 32) {
        const bf16x8 A0 = *(const bf16x8*)(a0 + k), A1 = *(const bf16x8*)(a1 + k), B0 = *(const bf16x8*)(b0 + k), B1 = *(const bf16x8*)(b1 + k);
        acc[0][0] = __builtin_amdgcn_mfma_f32_16x16x32_bf16(B0, A0, acc[0][0], 0, 0, 0);
        acc[0][1] = __builtin_amdgcn_mfma_f32_16x16x32_bf16(B1, A0, acc[0][1], 0, 0, 0);
        acc[1][0] = __builtin_amdgcn_mfma_f32_16x16x32_bf16(B0, A1, acc[1][0], 0, 0, 0);
        acc[1][1] = __builtin_amdgcn_mfma_f32_16x16x32_bf16(B1, A1, acc[1][1], 0, 0, 0);
    }
}
namespace g8 {
constexpr int BM = 256, BK = 64, HALF = 128, HTB = HALF * BK * 2, STAGE_BYTES = 8 * HTB, NXCD = 8, WGM = 8;
__device__ __forceinline__ int lds_byte(int r, int c) { const int st = (r >> 4) * 2 + (c >> 5), rr = r & 15, cc = c & 31, ob = rr * 64 + cc * 2; return st * 1024 + (ob ^ (((ob >> 9) & 1) << 5)); }
__device__ __forceinline__ void stage_rc(int b, int& R, int& C) { const int st = b / 1024, sb = b % 1024, swz = sb ^ (((sb >> 9) & 1) << 5); R = (st >> 1) * 16 + swz / 64; C = (st & 1) * 32 + (swz % 64) / 2; }
struct Unit { int pm, pn, bt, e; };
struct StaticOrder {
    int nM, nN, nwg, G, c;
    __device__ void init(int nM_, int nN_, int G_, int c_) { nM = nM_; nN = nN_; nwg = nM * nN; G = G_; c = c_; }
    __device__ bool next(int i, Unit& u) const {
        const long L = (long)i * G + c; if (L >= nwg) return false;
        int wgid = (int)L; { const int q = nwg / NXCD, r = nwg % NXCD, xcd = wgid % NXCD, off = wgid / NXCD; wgid = (xcd < r ? xcd * (q + 1) : r * (q + 1) + (xcd - r) * q) + off; }
        const int nig = WGM * nN, gid = wgid / nig, fm = gid * WGM, gsz = (nM - fm) < WGM ? (nM - fm) : WGM;
        u.pm = fm + ((wgid % nig) % gsz); u.pn = (wgid % nig) / gsz; u.bt = u.pn; u.e = 0; return true;
    }
};
struct GroupedOrder {
    StaticOrder so; const LAS int* sm;
    __device__ void init(const LAS int* sm_, int nN_, int G_, int c_) { sm = sm_; so.init(sm_[32] / BM, nN_, G_, c_); }
    __device__ bool next(int i, Unit& u) const {
        if (!so.next(i, u)) return false;
        const int rowt = u.pm * BM; int e = 0;
#pragma unroll
        for (int q = 1; q < NE; ++q) e = (rowt >= sm[16 + q]) ? q : e;
        u.e = e; u.bt = e * so.nN + u.pn; return true;
    }
};
struct GatherInfo { const int* rowlist; const LAS int* sm; };

__device__ __forceinline__ int perm32(int rho) { const int n = rho >> 4, i = rho & 15; return 8 * (i >> 2) + 4 * n + (i & 3); }
template <bool GATHER, class Epi, class Sched>
__device__ __forceinline__ void gemm8(LAS unsigned char* lds, const bf16_t* A, int lda, const bf16_t* Bt, int K, const Sched& S, const Epi& E, GatherInfo gi) {
    const int tid = threadIdx.x, wid = __builtin_amdgcn_readfirstlane(tid >> 6), lane = tid & 63, wr = wid >> 2, wc = wid & 3, fr = lane & 15, fq = lane >> 4;
    const int nt = K / BK;
    int Rr[2], Cc[2]; unsigned voffB[2]; unsigned vAc[2][2], vAn[2][2];
#pragma unroll
    for (int i = 0; i < 2; ++i) { stage_rc(tid * 16 + i * 8192, Rr[i], Cc[i]); voffB[i] = (unsigned)(((Rr[i] & ~31) + perm32(Rr[i] & 31)) * K + Cc[i]) * 2u;
#pragma unroll
        for (int h = 0; h < 2; ++h) { vAc[h][i] = (unsigned)((Rr[i] + HALF * h) * lda + Cc[i]) * 2u; vAn[h][i] = vAc[h][i]; } }
    const size_t kstep = (size_t)(BK * 2);
    const size_t hstepB = (size_t)HALF * K * 2, tstepB = 2 * hstepB, tstepA = (size_t)BM * lda * 2;
    const unsigned ldsw = (unsigned)wid * 1024u;
    const int aoff = lds_byte(wr * 64 + fr, fq * 8), boff = lds_byte(wc * 32 + fr, fq * 8);
#define G8_SA(b, h) (((b) * 2 + (h)) * HTB)
#define G8_SB(b, h) ((4 + (b) * 2 + (h)) * HTB)
#define G8_STAGEB(bufoff, gbase) do { _Pragma("unroll") for (int _i = 0; _i < 2; ++_i) \
        __builtin_amdgcn_global_load_lds((const unsigned*)((const char*)(gbase) + voffB[_i]), (LAS unsigned*)(lds + (bufoff) + ldsw + _i * 8192), 16, 0, 0); } while (0)
#define G8_STAGEA(bufoff, gbase, v0, v1) do { \
        __builtin_amdgcn_global_load_lds((const unsigned*)((const char*)(gbase) + (v0)), (LAS unsigned*)(lds + (bufoff) + ldsw), 16, 0, 0); \
        __builtin_amdgcn_global_load_lds((const unsigned*)((const char*)(gbase) + (v1)), (LAS unsigned*)(lds + (bufoff) + ldsw + 8192), 16, 0, 0); } while (0)
#define G8_LDA(dst, b, h) do { _Pragma("unroll") for (int m = 0; m < 4; ++m) _Pragma("unroll") for (int k = 0; k < 2; ++k) dst[m][k] = *(const LAS bf16x8*)(lds + G8_SA(b, h) + aoff + m * 2048 + k * 1024); } while (0)
#define G8_LDB(dst, b, h) do { _Pragma("unroll") for (int n = 0; n < 2; ++n) _Pragma("unroll") for (int k = 0; k < 2; ++k) dst[n][k] = *(const LAS bf16x8*)(lds + G8_SB(b, h) + boff + n * 2048 + k * 1024); } while (0)
#define G8_MMA(ai, bj, At, Bt_) do { __builtin_amdgcn_s_setprio(1); _Pragma("unroll") for (int m = 0; m < 4; ++m) _Pragma("unroll") for (int n = 0; n < 2; ++n) _Pragma("unroll") for (int k = 0; k < 2; ++k) \
        acc[ai][bj][m][n] = __builtin_amdgcn_mfma_f32_16x16x32_bf16(Bt_[n][k], At[m][k], acc[ai][bj][m][n], 0, 0, 0); __builtin_amdgcn_s_setprio(0); } while (0)
#define G8_WAIT_V(n) asm volatile("s_waitcnt vmcnt(" #n ")" ::: "memory")
#define G8_WAIT_L(n) asm volatile("s_waitcnt lgkmcnt(" #n ")" ::: "memory")
#define G8_BAR __builtin_amdgcn_s_barrier()
#define G8_SCHED __builtin_amdgcn_sched_barrier(0)
#define G8_GATHER(u, v) do { if (GATHER) { const int _eb = gi.sm[16 + (u).e], _ec = gi.sm[(u).e]; \
        _Pragma("unroll") for (int _h = 0; _h < 2; ++_h) _Pragma("unroll") for (int _i = 0; _i < 2; ++_i) { const int _s = (u).pm * BM + HALF * _h + Rr[_i] - _eb; \
            const int _t = gi.rowlist[(u).e * NTOK + (_s < _ec ? _s : 0)]; v[_h][_i] = (unsigned)(_t * K + Cc[_i]) * 2u; } } } while (0)
    Unit cur, nxt; int ui = 0;
    if (!S.next(0, cur)) return;
    f32x4 acc[2][2][4][2];
#pragma unroll
    for (int a = 0; a < 2; ++a)
#pragma unroll
        for (int b = 0; b < 2; ++b)
#pragma unroll
            for (int m = 0; m < 4; ++m)
#pragma unroll
                for (int n = 0; n < 2; ++n) acc[a][b][m][n] = (f32x4){0.f, 0.f, 0.f, 0.f};
    bf16x8 At[4][2], B0[2][2], B1[2][2];
    G8_GATHER(cur, vAc);
    const char* cA = GATHER ? (const char*)A : (const char*)A + (size_t)cur.pm * tstepA; const char* cB = (const char*)Bt + (size_t)cur.bt * tstepB;
    G8_STAGEB(G8_SB(0, 0), cB); G8_STAGEB(G8_SB(0, 1), cB + hstepB); G8_STAGEA(G8_SA(0, 0), cA, vAc[0][0], vAc[0][1]); G8_STAGEA(G8_SA(0, 1), cA, vAc[1][0], vAc[1][1]);
    if (wr == 1) G8_BAR;
    G8_WAIT_V(2); G8_BAR;
    G8_STAGEB(G8_SB(1, 0), cB + kstep); G8_STAGEA(G8_SA(1, 0), cA + kstep, vAc[0][0], vAc[0][1]); G8_STAGEB(G8_SB(1, 1), cB + hstepB + kstep);
    G8_WAIT_V(6); G8_BAR;
    for (;;) {
        const bool has_next = S.next(ui + 1, nxt);
        if (has_next) G8_GATHER(nxt, vAn);
        const char* nA = has_next ? (GATHER ? (const char*)A : (const char*)A + (size_t)nxt.pm * tstepA) : cA; const char* nB = has_next ? (const char*)Bt + (size_t)nxt.bt * tstepB : cB;
        for (int t = 0; t < nt; t += 2) {
            const bool last = (t == nt - 2);
            const char* a1 = cA + (size_t)(t + 1) * kstep;
            const char* a2 = last ? nA : cA + (size_t)(t + 2) * kstep; const char* b2 = last ? nB : cB + (size_t)(t + 2) * kstep;
            const char* a3 = a2 + kstep; const char* b3 = b2 + kstep;
            const bool usen = GATHER && last && has_next;
            const unsigned w00 = usen ? vAn[0][0] : vAc[0][0], w01 = usen ? vAn[0][1] : vAc[0][1], w10 = usen ? vAn[1][0] : vAc[1][0], w11 = usen ? vAn[1][1] : vAc[1][1];
            G8_LDB(B0, 0, 0); G8_LDB(B1, 0, 1); G8_SCHED; G8_LDA(At, 0, 0); G8_STAGEA(G8_SA(1, 1), a1, vAc[1][0], vAc[1][1]);
            G8_WAIT_V(8); G8_WAIT_L(0); G8_BAR; G8_MMA(0, 0, At, B0); G8_MMA(0, 1, At, B1); G8_BAR; G8_SCHED;
            G8_LDA(At, 0, 1); G8_STAGEB(G8_SB(0, 0), b2); G8_STAGEB(G8_SB(0, 1), b2 + hstepB); G8_STAGEA(G8_SA(0, 0), a2, w00, w01);
            G8_WAIT_V(8); G8_WAIT_L(0); G8_BAR; G8_MMA(1, 0, At, B0); G8_MMA(1, 1, At, B1); G8_BAR; G8_SCHED;
            G8_LDB(B0, 1, 0); G8_LDB(B1, 1, 1); G8_SCHED; G8_LDA(At, 1, 0); G8_STAGEA(G8_SA(0, 1), a2, w10, w11);
            G8_WAIT_V(8); G8_WAIT_L(0); G8_BAR; G8_MMA(0, 0, At, B0); G8_MMA(0, 1, At, B1); G8_BAR; G8_SCHED;
            G8_LDA(At, 1, 1); G8_STAGEB(G8_SB(1, 0), b3); G8_STAGEB(G8_SB(1, 1), b3 + hstepB); G8_STAGEA(G8_SA(1, 0), a3, w00, w01);
            G8_WAIT_V(8); G8_WAIT_L(0); G8_BAR; G8_MMA(1, 0, At, B0); G8_MMA(1, 1, At, B1); G8_BAR; G8_SCHED;
        }
        if (wr == 0) G8_BAR;
        E(acc, cur, wr, wc, fr, fq);
        if (!has_next) break;
#pragma unroll
        for (int a = 0; a < 2; ++a)
#pragma unroll
            for (int b = 0; b < 2; ++b)
#pragma unroll
                for (int m = 0; m < 4; ++m)
#pragma unroll
                    for (int n = 0; n < 2; ++n) acc[a][b][m][n] = (f32x4){0.f, 0.f, 0.f, 0.f};
        cur = nxt; cA = nA; cB = nB; ++ui;
#pragma unroll
        for (int h = 0; h < 2; ++h)
#pragma unroll
            for (int i = 0; i < 2; ++i) vAc[h][i] = vAn[h][i];
        if (wr == 1) G8_BAR;
    }
    G8_WAIT_V(0);
    G8_BAR;
#undef G8_SA
#undef G8_SB
#undef G8_STAGEA
#undef G8_STAGEB
#undef G8_LDA
#undef G8_LDB
#undef G8_MMA
#undef G8_WAIT_V
#undef G8_WAIT_L
#undef G8_BAR
#undef G8_SCHED
#undef G8_GATHER
}
template <class F> struct EpiEl {
    F f;
    __device__ __forceinline__ void operator()(const f32x4 (&acc)[2][2][4][2], const Unit& u, int wr, int wc, int fr, int fq) const {
#pragma unroll
        for (int ai = 0; ai < 2; ++ai)
#pragma unroll
            for (int m = 0; m < 4; ++m) { const int row = u.pm * BM + ai * HALF + wr * 64 + m * 16 + fr;
#pragma unroll
                for (int bj = 0; bj < 2; ++bj) f(row, u.pn * BM + bj * HALF + wc * 32 + 8 * fq, acc[ai][bj][m][0], acc[ai][bj][m][1]); }
    }
};
}

struct EpiNsaIn {
    bf16_t* Q; bf16_t* KV; float* gates; const float2* rope;
    __device__ __forceinline__ void operator()(int row, int c, f32x4 v) const {
        const int t = row & (SEQ - 1), b = row >> 13;
        if (c < 1024) {
            v = v * QSCALE;
            const int d = (c & 63) >> 1; const float2 c0 = rope[t * 32 + d], c1 = rope[t * 32 + d + 1];
            bf16_t* p = Q + (size_t)row * DM + (c & ~63);
            *(unsigned*)(p + d) = pk2(v[0] * c0.x - v[1] * c0.y, v[2] * c1.x - v[3] * c1.y);
            *(unsigned*)(p + d + 32) = pk2(v[1] * c0.x + v[0] * c0.y, v[3] * c1.x + v[2] * c1.y);
        } else if (c < 2560) {
            const int s = (c - 1024) >> 8, g = ((c - 1024) >> 6) & 3;
            bf16_t* p = KV + (size_t)s * (KVSEG / 2) + ((size_t)(b * NG + g) * SEQ + t) * DH;
            if (s == 2 || s == 4) {
                const int d = (c & 63) >> 1; const float2 c0 = rope[t * 32 + d], c1 = rope[t * 32 + d + 1];
                *(unsigned*)(p + d) = pk2(v[0] * c0.x - v[1] * c0.y, v[2] * c1.x - v[3] * c1.y);
                *(unsigned*)(p + d + 32) = pk2(v[1] * c0.x + v[0] * c0.y, v[3] * c1.x + v[2] * c1.y);
            } else {
                *(u32x2*)(p + (c & 63)) = (u32x2){pk2(v[0], v[1]), pk2(v[2], v[3])};
            }
        } else if (c < NSA_IN) {
            float* gp = gates + (size_t)row * 48 + (c - 2560);
            *(f32x4*)gp = (f32x4){sigmoidf_(v[0]), sigmoidf_(v[1]), sigmoidf_(v[2]), sigmoidf_(v[3])};
        }
    }
    __device__ __forceinline__ void operator()(int row, int c, f32x4 v, f32x4 w) const {
        const int t = row & (SEQ - 1), b = row >> 13;
        const int s = (c - 1024) >> 8;
        const bool isq = c < 1024, roped = isq || s == 2 || s == 4;
        if (roped) {
            if (isq) { v = v * QSCALE; w = w * QSCALE; }
            const int g = ((c - 1024) >> 6) & 3, d = (c & 63) >> 1;
            bf16_t* p = isq ? Q + (size_t)row * DM + (c & ~63) : KV + (size_t)s * (KVSEG / 2) + ((size_t)(b * NG + g) * SEQ + t) * DH;
            const f32x4 cs01 = *(const f32x4*)(rope + t * 32 + d), cs23 = *(const f32x4*)(rope + t * 32 + d + 2);
            *(u32x2*)(p + d) = (u32x2){pk2(v[0] * cs01[0] - v[1] * cs01[1], v[2] * cs01[2] - v[3] * cs01[3]), pk2(w[0] * cs23[0] - w[1] * cs23[1], w[2] * cs23[2] - w[3] * cs23[3])};
            *(u32x2*)(p + d + 32) = (u32x2){pk2(v[1] * cs01[0] + v[0] * cs01[1], v[3] * cs01[2] + v[2] * cs01[3]), pk2(w[1] * cs23[0] + w[0] * cs23[1], w[3] * cs23[2] + w[2] * cs23[3])};
        } else {
            const int g = ((c - 1024) >> 6) & 3;
            bf16_t* p = KV + (size_t)s * (KVSEG / 2) + ((size_t)(b * NG + g) * SEQ + t) * DH + (c & 63);
            *(u32x4*)p = (u32x4){pk2(v[0], v[1]), pk2(v[2], v[3]), pk2(w[0], w[1]), pk2(w[2], w[3])};
        }
    }
};
struct EpiMobaIn {
    bf16_t* Q; bf16_t* K; bf16_t* V; const float2* rope;
    __device__ __forceinline__ void operator()(int row, int c, f32x4 v) const {
        const int t = row & (SEQ - 1), b = row >> 13;
        if (c < 2048) {
            if (c < 1024) v = v * QSCALE;
            const int d = (c & 63) >> 1; const float2 c0 = rope[t * 32 + d], c1 = rope[t * 32 + d + 1];
            bf16_t* p = c < 1024 ? Q + (size_t)row * DM + (c & ~63) : K + ((size_t)(b * NH + ((c - 1024) >> 6)) * SEQ + t) * DH;
            *(unsigned*)(p + d) = pk2(v[0] * c0.x - v[1] * c0.y, v[2] * c1.x - v[3] * c1.y);
            *(unsigned*)(p + d + 32) = pk2(v[1] * c0.x + v[0] * c0.y, v[3] * c1.x + v[2] * c1.y);
        } else {
            bf16_t* p = V + ((size_t)(b * NH + ((c - 2048) >> 6)) * SEQ + t) * DH + (c & 63);
            *(u32x2*)p = (u32x2){pk2(v[0], v[1]), pk2(v[2], v[3])};
        }
    }
    __device__ __forceinline__ void operator()(int row, int c, f32x4 v, f32x4 w) const {
        const int t = row & (SEQ - 1), b = row >> 13;
        if (c < 2048) {
            if (c < 1024) { v = v * QSCALE; w = w * QSCALE; }
            const int d = (c & 63) >> 1;
            bf16_t* p = c < 1024 ? Q + (size_t)row * DM + (c & ~63) : K + ((size_t)(b * NH + ((c - 1024) >> 6)) * SEQ + t) * DH;
            const f32x4 cs01 = *(const f32x4*)(rope + t * 32 + d), cs23 = *(const f32x4*)(rope + t * 32 + d + 2);
            *(u32x2*)(p + d) = (u32x2){pk2(v[0] * cs01[0] - v[1] * cs01[1], v[2] * cs01[2] - v[3] * cs01[3]), pk2(w[0] * cs23[0] - w[1] * cs23[1], w[2] * cs23[2] - w[3] * cs23[3])};
            *(u32x2*)(p + d + 32) = (u32x2){pk2(v[1] * cs01[0] + v[0] * cs01[1], v[3] * cs01[2] + v[2] * cs01[3]), pk2(w[1] * cs23[0] + w[0] * cs23[1], w[3] * cs23[2] + w[2] * cs23[3])};
        } else {
            bf16_t* p = V + ((size_t)(b * NH + ((c - 2048) >> 6)) * SEQ + t) * DH + (c & 63);
            *(u32x4*)p = (u32x4){pk2(v[0], v[1]), pk2(v[2], v[3]), pk2(w[0], w[1]), pk2(w[2], w[3])};
        }
    }
};
struct EpiGelu {
    bf16_t* O; const float* bias;
    __device__ __forceinline__ void operator()(int row, int c, f32x4 v) const {
        const f32x4 bv = *(const f32x4*)(bias + c);
        *(u32x2*)(O + (size_t)row * 256 + c) = (u32x2){pk2(gelu_tanh(v[0] + bv[0]), gelu_tanh(v[1] + bv[1])), pk2(gelu_tanh(v[2] + bv[2]), gelu_tanh(v[3] + bv[3]))};
    }
    __device__ __forceinline__ void operator()(int row, int c, f32x4 v, f32x4 w) const {
        const f32x4 bv = *(const f32x4*)(bias + c), bw = *(const f32x4*)(bias + c + 4);
        *(u32x4*)(O + (size_t)row * 256 + c) = (u32x4){pk2(gelu_tanh(v[0] + bv[0]), gelu_tanh(v[1] + bv[1])), pk2(gelu_tanh(v[2] + bv[2]), gelu_tanh(v[3] + bv[3])),
                                                      pk2(gelu_tanh(w[0] + bw[0]), gelu_tanh(w[1] + bw[1])), pk2(gelu_tanh(w[2] + bw[2]), gelu_tanh(w[3] + bw[3]))};
    }
};
struct EpiSwiGLU {
    bf16_t* H;
    __device__ __forceinline__ void operator()(int row, int c, f32x4 v) const {
        const float h0 = v[0] * sigmoidf_(v[0]) * v[1], h1 = v[2] * sigmoidf_(v[2]) * v[3];
        *(unsigned*)(H + (size_t)row * DE + (c >> 1)) = pk2(h0, h1);
    }
    __device__ __forceinline__ void operator()(int row, int c, f32x4 v, f32x4 w) const {
        *(u32x2*)(H + (size_t)row * DE + (c >> 1)) = (u32x2){pk2(v[0] * sigmoidf_(v[0]) * v[1], v[2] * sigmoidf_(v[2]) * v[3]), pk2(w[0] * sigmoidf_(w[0]) * w[1], w[2] * sigmoidf_(w[2]) * w[3])};
    }
};
struct EpiBf16 {
    bf16_t* Y;
    __device__ __forceinline__ void operator()(int row, int c, f32x4 v) const { *(u32x2*)(Y + (size_t)row * DM + c) = (u32x2){pk2(v[0], v[1]), pk2(v[2], v[3])}; }
    __device__ __forceinline__ void operator()(int row, int c, f32x4 v, f32x4 w) const { *(u32x4*)(Y + (size_t)row * DM + c) = (u32x4){pk2(v[0], v[1]), pk2(v[2], v[3]), pk2(w[0], w[1]), pk2(w[2], w[3])}; }
};

struct ExpertMap { int cnt[NE]; int base[NE + 1]; };
__device__ __forceinline__ void load_expert_map(const Ctx& C, int cw, LAS int* sm  ) {
    if (C.tid == 0) {
        const unsigned* ctl = (const unsigned*)(C.ws + WS_CTL); int acc = 0;
        for (int e = 0; e < NE; ++e) { const int c = (int)__hip_atomic_load(ctl + cw + 64 * e, __ATOMIC_RELAXED, __HIP_MEMORY_SCOPE_AGENT); sm[e] = c; sm[16 + e] = acc; acc += (c + 255) & ~255; }
        sm[32] = acc;
    }
    __syncthreads();
}

__device__ __forceinline__ void ph_cmp2(const Ctx& C) {
    const int gt = C.bid * NTHREADS + C.tid, NGT = C.nb * NTHREADS;
    const float2* rope = (const float2*)(C.ws + WS_ROPE);
    for (int i = gt; i < 2 * 8192 * 32; i += NGT) {
        const int which = i >= 8192 * 32; const int j = i - which * 8192 * 32; const int r = j >> 5, d = j & 31, ci = r & 511;
        const bf16_t* h = (const bf16_t*)(C.ws + (which ? WS_H1V : WS_H1K)) + (size_t)r * 256;
        const float* w2 = C.in[which ? I_CV_W2 : I_CK_W2];
        float s0 = 0.f, s1 = 0.f;
        for (int k = 0; k < 256; ++k) { const float hv = bf2f(h[k]); s0 += hv * w2[k * 64 + d]; s1 += hv * w2[k * 64 + d + 32]; }
        bf16_t* o = (bf16_t*)(C.ws + (which ? WS_VC : WS_KC)) + (size_t)r * 64;
        if (ci == 511) { s0 = 0.f; s1 = 0.f; }
        else if (!which) { const float2 cs = rope[(16 * ci + 31) * 32 + d]; const float a = s0 * cs.x - s1 * cs.y, b2 = s1 * cs.x + s0 * cs.y; s0 = a; s1 = b2; }
        o[d] = (bf16_t)f2bf(s0); o[d + 32] = (bf16_t)f2bf(s1);
    }
}

__device__ __forceinline__ void load_qh(const bf16_t* qp, float (&qh)[64]) {
    const uint4* q4 = (const uint4*)qp;
#pragma unroll
    for (int c = 0; c < 8; ++c) { const uint4 w = q4[c]; qh[8 * c] = bflo(w.x); qh[8 * c + 1] = bfhi(w.x); qh[8 * c + 2] = bflo(w.y); qh[8 * c + 3] = bfhi(w.y);
        qh[8 * c + 4] = bflo(w.z); qh[8 * c + 5] = bfhi(w.z); qh[8 * c + 6] = bflo(w.w); qh[8 * c + 7] = bfhi(w.w); }
}
namespace fa {
constexpr int SLOT = 16384, NSLOT = 4;
constexpr float C2 = 0.125f * 1.4426950408889634f;
constexpr float NEGBIG = -1e30f;
typedef short v4i16 __attribute__((ext_vector_type(4)));
__device__ __forceinline__ void dma_block(LAS unsigned char* slot, const bf16_t* Kg, const bf16_t* Vg, int wave, int lane) {
    { const int key = 8 * wave + (lane >> 3), c = (lane & 7) ^ ((key >> 1) & 7);
      __builtin_amdgcn_global_load_lds((const unsigned*)(Kg + key * 64 + 8 * c), (LAS unsigned*)(slot + wave * 1024), 16, 0, 0); }
    { const int key = 16 * (wave & 3) + (lane >> 2), cp = lane & 3, d = (wave >> 2) * 32 + ((((cp >> 1) ^ ((key >> 2) & 1))) << 4) + ((cp & 1) << 3);
      __builtin_amdgcn_global_load_lds((const unsigned*)(Vg + key * 64 + d), (LAS unsigned*)(slot + 8192 + wave * 1024), 16, 0, 0); }
}
__device__ __forceinline__ unsigned cvt_pk_bf16(float lo, float hi) { const f32x2v v = {lo, hi}; const bf16x2v b = __builtin_convertvector(v, bf16x2v); return __builtin_bit_cast(unsigned, b); }
struct Task { bf16x8 q[2]; int kmin, kmax; float m, l, cinit; f32x4 O[4]; f32x4 L; unsigned fw0; const LAS unsigned* fwp; int imptok; };
template <int FM> __device__ __forceinline__ bool row_flag(const Task& t, int jb) {
    if (FM == 0) return true;
    if (FM == 1) { const unsigned w = t.fwp[jb >> 5]; return ((w >> (jb & 31)) & 1u) != 0u; }
    return ((t.fw0 >> (jb >> 2)) & 1u) != 0u;
}
struct LaneC { int fq, koff0, koff1, voffA, voffB; };
__device__ __forceinline__ LaneC lane_consts(int lane) {
    const int i16 = lane & 15, fq = lane >> 4, kx = (i16 >> 1) & 7, q4 = i16 >> 2, p4 = lane & 3;
    LaneC lc; lc.fq = fq; lc.koff0 = i16 * 128 + ((fq ^ kx) << 4); lc.koff1 = i16 * 128 + (((4 + fq) ^ kx) << 4);
    lc.voffA = 8192 + (4 * fq + q4) * 64 + ((0 ^ (fq & 1)) << 5) + 8 * p4; lc.voffB = 8192 + (4 * fq + q4) * 64 + ((1 ^ (fq & 1)) << 5) + 8 * p4;
    return lc;
}
__device__ __forceinline__ float xrow16_max(float x) {
    auto s = __builtin_amdgcn_permlane16_swap(__float_as_uint(x), __float_as_uint(x), false, false);
    x = fmaxf(__uint_as_float(s[0]), __uint_as_float(s[1]));
    auto t = __builtin_amdgcn_permlane32_swap(__float_as_uint(x), __float_as_uint(x), false, false);
    return fmaxf(__uint_as_float(t[0]), __uint_as_float(t[1]));
}
__device__ __forceinline__ float xrow16_sum(float x) {
    auto s = __builtin_amdgcn_permlane16_swap(__float_as_uint(x), __float_as_uint(x), false, false);
    x = __uint_as_float(s[0]) + __uint_as_float(s[1]);
    auto t = __builtin_amdgcn_permlane32_swap(__float_as_uint(x), __float_as_uint(x), false, false);
    return __uint_as_float(t[0]) + __uint_as_float(t[1]);
}
__device__ __forceinline__ void t_mask(const Task& t, f32x4 (&s)[4], int kb, int fq) {
#pragma unroll
    for (int kt = 0; kt < 4; ++kt)
#pragma unroll
        for (int r = 0; r < 4; ++r) { const int key = kb + 16 * kt + 4 * fq + r; s[kt][r] = (key >= t.kmin && key <= t.kmax) ? s[kt][r] : NEGBIG; }
}
template <int MODE> __device__ __forceinline__ float t_stats(Task& t, f32x4 (&s)[4], bool rf) {
    float bm = fmaxf(fmaxf(fmaxf(s[0][0], s[0][1]), fmaxf(s[0][2], s[0][3])), fmaxf(fmaxf(s[1][0], s[1][1]), fmaxf(s[1][2], s[1][3])));
    bm = fmaxf(bm, fmaxf(fmaxf(fmaxf(s[2][0], s[2][1]), fmaxf(s[2][2], s[2][3])), fmaxf(fmaxf(s[3][0], s[3][1]), fmaxf(s[3][2], s[3][3]))));
    bm = xrow16_max(bm);
    if (!rf) bm = NEGBIG;
    const float mnew = fmaxf(t.m, bm);
    const float alpha = __builtin_amdgcn_exp2f(t.m - mnew);
    t.m = mnew;
    const float msub = (rf && mnew > -1e29f) ? mnew : __builtin_inff();
#pragma unroll
    for (int kt = 0; kt < 4; ++kt) s[kt] = s[kt] - msub;
    if (MODE == 1) t.l *= alpha;
    return alpha;
}
__device__ __forceinline__ void t_exp(f32x4 (&s)[4]) {
#pragma unroll
    for (int kt = 0; kt < 4; ++kt)
#pragma unroll
        for (int r = 0; r < 4; ++r) s[kt][r] = __builtin_amdgcn_exp2f(s[kt][r]);
}
__device__ __forceinline__ float quad_sum(float x) {
    x += __builtin_bit_cast(float, __builtin_amdgcn_mov_dpp(__builtin_bit_cast(int, x), 0xB1, 0xf, 0xf, true));
    x += __builtin_bit_cast(float, __builtin_amdgcn_mov_dpp(__builtin_bit_cast(int, x), 0x4E, 0xf, 0xf, true));
    return x;
}
__device__ __forceinline__ void t_imp(const Task& t, const f32x4 (&s)[4], int kb, int fq, LAS float* impbase) {
    float ga[4], gb[4];
#pragma unroll
    for (int kt = 0; kt < 4; ++kt) { ga[kt] = quad_sum((s[kt][0] + s[kt][1]) + (s[kt][2] + s[kt][3])); gb[kt] = quad_sum(s[kt][3]); }
    if ((t.imptok & 0x10000) == 0) return;
    LAS float* ip = impbase + (t.imptok & 0xffff) * 130 + (kb >> 2) + fq;
#pragma unroll
    for (int kt = 0; kt < 4; ++kt) { ip[4 * kt] = ga[kt]; ip[64 * 130 + 4 * kt] = gb[kt]; }
}
__device__ __forceinline__ bf16x8 t_pack(const f32x4 (&s)[4], int u) {
    u32x4 pw; pw.x = cvt_pk_bf16(s[2 * u][0], s[2 * u][1]); pw.y = cvt_pk_bf16(s[2 * u][2], s[2 * u][3]); pw.z = cvt_pk_bf16(s[2 * u + 1][0], s[2 * u + 1][1]); pw.w = cvt_pk_bf16(s[2 * u + 1][2], s[2 * u + 1][3]);
    return __builtin_bit_cast(bf16x8, pw);
}
template <int MODE, bool DA, bool DB>
__device__ __forceinline__ void do_blk(Task& a, Task& b, bool rfa, bool rfb, bool masked, LAS unsigned char* slot, int kb, LAS float* impbase, const LaneC& lc) {
    f32x4 sa[4], sb[4];
    const float xa = (MODE >= 2) ? (rfa ? a.cinit : -__builtin_inff()) : 0.f, xb = (MODE >= 2) ? (rfb ? b.cinit : -__builtin_inff()) : 0.f;
    const f32x4 ca = (f32x4){xa, xa, xa, xa}, cb = (f32x4){xb, xb, xb, xb};
#pragma unroll
    for (int kt = 0; kt < 4; ++kt) {
        const bf16x8 k0 = *(const LAS bf16x8*)(slot + lc.koff0 + kt * 2048), k1 = *(const LAS bf16x8*)(slot + lc.koff1 + kt * 2048);
        if (DA) { sa[kt] = __builtin_amdgcn_mfma_f32_16x16x32_bf16(k0, a.q[0], ca, 0, 0, 0); sa[kt] = __builtin_amdgcn_mfma_f32_16x16x32_bf16(k1, a.q[1], sa[kt], 0, 0, 0); }
        if (DB) { sb[kt] = __builtin_amdgcn_mfma_f32_16x16x32_bf16(k0, b.q[0], cb, 0, 0, 0); sb[kt] = __builtin_amdgcn_mfma_f32_16x16x32_bf16(k1, b.q[1], sb[kt], 0, 0, 0); }
    }
    if (masked) { if (DA) t_mask(a, sa, kb, lc.fq); if (DB) t_mask(b, sb, kb, lc.fq); }
    if (MODE < 2) {
        float ala = 1.0f, alb = 1.0f;
        if (DA) ala = t_stats<MODE>(a, sa, rfa);
        if (DB) alb = t_stats<MODE>(b, sb, rfb);
        if (MODE == 0) {
            if (__ballot((DA && ala != 1.0f) || (DB && alb != 1.0f)) != 0ull) {
#pragma unroll
                for (int dt = 0; dt < 4; ++dt) { if (DA) a.O[dt] = a.O[dt] * ala; if (DB) b.O[dt] = b.O[dt] * alb; }
                if (DA) a.L = a.L * ala; if (DB) b.L = b.L * alb;
            }
        }
    }
    if (DA) t_exp(sa);
    if (DB) t_exp(sb);
    if (MODE == 1) {
        if (DA) a.l += ((sa[0][0] + sa[0][1]) + (sa[0][2] + sa[0][3])) + ((sa[1][0] + sa[1][1]) + (sa[1][2] + sa[1][3])) + ((sa[2][0] + sa[2][1]) + (sa[2][2] + sa[2][3])) + ((sa[3][0] + sa[3][1]) + (sa[3][2] + sa[3][3]));
        if (DB) b.l += ((sb[0][0] + sb[0][1]) + (sb[0][2] + sb[0][3])) + ((sb[1][0] + sb[1][1]) + (sb[1][2] + sb[1][3])) + ((sb[2][0] + sb[2][1]) + (sb[2][2] + sb[2][3])) + ((sb[3][0] + sb[3][1]) + (sb[3][2] + sb[3][3]));
    }
    if (MODE == 2) { if (DA) t_imp(a, sa, kb, lc.fq, impbase); if (DB) t_imp(b, sb, kb, lc.fq, impbase); }
    if (MODE != 1) {
        const bf16x8 ones = (bf16x8){0x3F80, 0x3F80, 0x3F80, 0x3F80, 0x3F80, 0x3F80, 0x3F80, 0x3F80};
#pragma unroll
        for (int u = 0; u < 2; ++u) {
            bf16x8 pa, pb; if (DA) pa = t_pack(sa, u); if (DB) pb = t_pack(sb, u);
            if (MODE != 2) { if (DA) a.L = __builtin_amdgcn_mfma_f32_16x16x32_bf16(ones, pa, a.L, 0, 0, 0); if (DB) b.L = __builtin_amdgcn_mfma_f32_16x16x32_bf16(ones, pb, b.L, 0, 0, 0); }
#pragma unroll
            for (int dt = 0; dt < 4; ++dt) {
                const int vo = ((dt & 1) ? lc.voffB : lc.voffA) + (dt >> 1) * 4096 + u * 2048;
                const v4i16 a0 = __builtin_amdgcn_ds_read_tr16_b64_v4i16((LAS v4i16*)(slot + vo)), a1 = __builtin_amdgcn_ds_read_tr16_b64_v4i16((LAS v4i16*)(slot + vo + 1024));
                const bf16x8 vf = (bf16x8){a0[0], a0[1], a0[2], a0[3], a1[0], a1[1], a1[2], a1[3]};
                if (DA) a.O[dt] = __builtin_amdgcn_mfma_f32_16x16x32_bf16(vf, pa, a.O[dt], 0, 0, 0);
                if (DB) b.O[dt] = __builtin_amdgcn_mfma_f32_16x16x32_bf16(vf, pb, b.O[dt], 0, 0, 0);
            }
        }
    }
}
template <int MODE, int FM>
__device__ __forceinline__ void flash_loop(LAS unsigned char* ring, const bf16_t* Kg, const bf16_t* Vg, int nblk, Task& Ta, Task& Tb, LAS float* impbase, int wave, int lane) {
    const int i16 = lane & 15, fq = lane >> 4;
    const int kx = (i16 >> 1) & 7;
    const int q4 = i16 >> 2, p4 = lane & 3;
    LaneC lc; lc.fq = fq; lc.koff0 = i16 * 128 + ((fq ^ kx) << 4); lc.koff1 = i16 * 128 + (((4 + fq) ^ kx) << 4);
    lc.voffA = 8192 + (4 * fq + q4) * 64 + ((0 ^ (fq & 1)) << 5) + 8 * p4; lc.voffB = 8192 + (4 * fq + q4) * 64 + ((1 ^ (fq & 1)) << 5) + 8 * p4;
    const int amin = __builtin_amdgcn_readlane(Ta.kmin, 15), amax = __builtin_amdgcn_readlane(Ta.kmax, 0), bmin = __builtin_amdgcn_readlane(Tb.kmin, 15), bmax = __builtin_amdgcn_readlane(Tb.kmax, 0);
#pragma unroll
    for (int j = 0; j < NSLOT - 1; ++j) { const int jj = j < nblk ? j : nblk - 1; dma_block(ring + j * SLOT, Kg + (size_t)jj * 4096, Vg + (size_t)jj * 4096, wave, lane); }
    for (int jb = 0; jb < nblk; ++jb) {
        asm volatile("s_waitcnt vmcnt(4) lgkmcnt(0)\n\ts_barrier" ::: "memory");
        { const int jn = jb + 3 < nblk ? jb + 3 : nblk - 1; dma_block(ring + ((jb + 3) & 3) * SLOT, Kg + (size_t)jn * 4096, Vg + (size_t)jn * 4096, wave, lane); }
        LAS unsigned char* slot = ring + (jb & 3) * SLOT;
        const int kb = jb * 64;
        const bool rfa = row_flag<FM>(Ta, jb), rfb = row_flag<FM>(Tb, jb);
        const bool na = __ballot(rfa && Ta.kmax >= kb && Ta.kmin <= kb + 63) != 0ull, nb2 = __ballot(rfb && Tb.kmax >= kb && Tb.kmin <= kb + 63) != 0ull;
        const bool masked = !((!na || (kb >= amin && kb + 63 <= amax)) && (!nb2 || (kb >= bmin && kb + 63 <= bmax)));
        if (FM == 1) {
            if (na) do_blk<MODE, true, false>(Ta, Tb, rfa, rfb, masked, slot, kb, impbase, lc);
            if (nb2) do_blk<MODE, false, true>(Ta, Tb, rfa, rfb, masked, slot, kb, impbase, lc);
        } else {
            if (na || nb2) do_blk<MODE, true, true>(Ta, Tb, rfa, rfb, masked, slot, kb, impbase, lc);
        }
    }
    asm volatile("s_waitcnt vmcnt(0) lgkmcnt(0)\n\ts_barrier" ::: "memory");
}
template <int MODE, int FM>
__device__ __forceinline__ void flash_loop2(LAS unsigned char* ring, const bf16_t* Kg, const bf16_t* Vg, int nblk, Task& Ta, Task& Tb, LAS float* impbase, int wave, int lane) {
    const int i16 = lane & 15, fq = lane >> 4;
    const int kx = (i16 >> 1) & 7;
    const int q4 = i16 >> 2, p4 = lane & 3;
    LaneC lc; lc.fq = fq; lc.koff0 = i16 * 128 + ((fq ^ kx) << 4); lc.koff1 = i16 * 128 + (((4 + fq) ^ kx) << 4);
    lc.voffA = 8192 + (4 * fq + q4) * 64 + ((0 ^ (fq & 1)) << 5) + 8 * p4; lc.voffB = 8192 + (4 * fq + q4) * 64 + ((1 ^ (fq & 1)) << 5) + 8 * p4;
    const int amin = __builtin_amdgcn_readlane(Ta.kmin, 15), amax = __builtin_amdgcn_readlane(Ta.kmax, 0), bmin = __builtin_amdgcn_readlane(Tb.kmin, 15), bmax = __builtin_amdgcn_readlane(Tb.kmax, 0);
    const int nit = (nblk + 1) >> 1;
#pragma unroll
    for (int j = 0; j < 2; ++j) { const int jj = j < nblk ? j : nblk - 1; dma_block(ring + j * SLOT, Kg + (size_t)jj * 4096, Vg + (size_t)jj * 4096, wave, lane); }
    for (int i = 0; i < nit; ++i) {
        asm volatile("s_waitcnt vmcnt(0) lgkmcnt(0)\n\ts_barrier" ::: "memory");
#pragma unroll
        for (int j = 0; j < 2; ++j) { const int jn = 2 * i + 2 + j < nblk ? 2 * i + 2 + j : nblk - 1; dma_block(ring + ((2 * i + 2 + j) & 3) * SLOT, Kg + (size_t)jn * 4096, Vg + (size_t)jn * 4096, wave, lane); }
        if (FM == 1 && !SEL_FUSED) {
#pragma unroll
        for (int k = 0; k < 2; ++k) {
            const int jb = 2 * i + k;
            if (jb < nblk) {
                LAS unsigned char* slot = ring + (jb & 3) * SLOT;
                const int kb = jb * 64;
                const bool rfa = row_flag<FM>(Ta, jb), rfb = row_flag<FM>(Tb, jb);
                const bool na = __ballot(rfa && Ta.kmax >= kb && Ta.kmin <= kb + 63) != 0ull, nb2 = __ballot(rfb && Tb.kmax >= kb && Tb.kmin <= kb + 63) != 0ull;
                const bool masked = !((!na || (kb >= amin && kb + 63 <= amax)) && (!nb2 || (kb >= bmin && kb + 63 <= bmax)));
                if (na) do_blk<MODE, true, false>(Ta, Tb, rfa, rfb, masked, slot, kb, impbase, lc);
                if (nb2) do_blk<MODE, false, true>(Ta, Tb, rfa, rfb, masked, slot, kb, impbase, lc);
            }
        }
        } else {
            const int j0 = 2 * i, j1 = 2 * i + 1;
            const bool ra0 = row_flag<FM>(Ta, j0), rb0 = row_flag<FM>(Tb, j0), ra1 = j1 < nblk && row_flag<FM>(Ta, j1), rb1 = j1 < nblk && row_flag<FM>(Tb, j1);
            if (__ballot(ra0 || rb0 || ra1 || rb1) != 0ull) {
                const int k0 = j0 * 64, k1 = j1 * 64;
                const bool mk = (FM == 0) && !(k0 >= amin && k1 + 63 <= amax && k0 >= bmin && k1 + 63 <= bmax);
                if (!mk) {
                    do_blk<MODE, true, true>(Ta, Tb, ra0, rb0, false, ring + (j0 & 3) * SLOT, k0, impbase, lc);
                    if (FM != 2) __builtin_amdgcn_sched_barrier(0);
                    do_blk<MODE, true, true>(Ta, Tb, ra1, rb1, false, ring + (j1 & 3) * SLOT, k1, impbase, lc);
                } else {
                    do_blk<MODE, true, true>(Ta, Tb, ra0, rb0, true, ring + (j0 & 3) * SLOT, k0, impbase, lc);
                    __builtin_amdgcn_sched_barrier(0);
                    do_blk<MODE, true, true>(Ta, Tb, ra1, rb1, true, ring + (j1 & 3) * SLOT, k1, impbase, lc);
                }
            }
        }
    }
    asm volatile("s_waitcnt vmcnt(0) lgkmcnt(0)\n\ts_barrier" ::: "memory");
}
__device__ __forceinline__ void task_reset(Task& t) { t.m = NEGBIG; t.l = 0.f; t.cinit = 0.f; t.L = (f32x4){0.f, 0.f, 0.f, 0.f};
#pragma unroll
    for (int dt = 0; dt < 4; ++dt) t.O[dt] = (f32x4){0.f, 0.f, 0.f, 0.f}; }
__device__ __forceinline__ float task_rowsum(const Task& t) { return t.L[0]; }
__device__ __forceinline__ float task_rowsum_stats(const Task& t) { return xrow16_sum(t.l); }
constexpr float REF_DELTA = 32.f;
__device__ __forceinline__ void task_fix_ref(Task& t) {
    t.cinit = -(t.m + REF_DELTA);
    const float sc = __builtin_amdgcn_exp2f(-REF_DELTA);
    t.L = t.L * sc;
#pragma unroll
    for (int dt = 0; dt < 4; ++dt) t.O[dt] = t.O[dt] * sc;
}
}

struct NsaRow { int RI, c, b; u32x2 out[4];
    __device__ __forceinline__ int tokl() const { return RI >> 2; }
    __device__ __forceinline__ int head() const { return RI & 3; }
    __device__ __forceinline__ int tt() const { return 64 * c + (RI >> 2); }
    __device__ __forceinline__ size_t grow() const { return (size_t)(b * SEQ + 64 * c + (RI >> 2)); }
};
__device__ __forceinline__ void nsa_row_init(NsaRow& r, fa::Task& t, const bf16_t* Q, int b, int g, int c, int R, int fq) {
    r.RI = R; r.c = c; r.b = b;
    const bf16_t* qp = Q + r.grow() * DM + (g * 4 + r.head()) * DH + 8 * fq;
    t.q[0] = *(const bf16x8*)qp; t.q[1] = *(const bf16x8*)(qp + 32);
    t.imptok = r.tokl() | (r.head() == 0 ? 0x10000 : 0); t.fw0 = 0u; t.fwp = nullptr;
#pragma unroll
    for (int dt = 0; dt < 4; ++dt) r.out[dt] = (u32x2){0u, 0u};
}
__device__ __forceinline__ void nsa_cmp_setup(const NsaRow& r, fa::Task& t) {
    const int tt_ = r.tt(); const int nv = tt_ >= 31 ? (((tt_ - 31) >> 4) + 1 > 511 ? 511 : ((tt_ - 31) >> 4) + 1) : 0;
    t.kmin = 0; t.kmax = nv - 1; fa::task_reset(t);
}
__device__ __forceinline__ void nsa_accum(NsaRow& r, const fa::Task& t, float sc) {
#pragma unroll
    for (int dt = 0; dt < 4; ++dt) { const f32x4 o = t.O[dt] * sc; const u32x2 w = r.out[dt];
        r.out[dt] = (u32x2){pk2(bflo(w.x) + o[0], bfhi(w.x) + o[1]), pk2(bflo(w.y) + o[2], bfhi(w.y) + o[3])}; }
}
__device__ __forceinline__ void nsa_store(const NsaRow& r, bf16_t* AO, int g, int fq) {
    bf16_t* op = AO + r.grow() * DM + (g * 4 + r.head()) * DH + 4 * fq;
#pragma unroll
    for (int dt = 0; dt < 4; ++dt) *(u32x2*)(op + 16 * dt) = r.out[dt];
}
__device__ __forceinline__ void ph_nsa_fa(const Ctx& C) {
    LAS unsigned char* L = (LAS unsigned char*)C.lds;
    LAS unsigned char* ring = L;
    LAS float* imp = (LAS float*)(L + 65536);
    LAS unsigned* selm = (LAS unsigned*)(L + 135168);
    const bf16_t* Q = (const bf16_t*)(C.ws + WS_Q); const bf16_t* KC = (const bf16_t*)(C.ws + WS_KC); const bf16_t* VC = (const bf16_t*)(C.ws + WS_VC);
    const bf16_t* KS = (const bf16_t*)(C.ws + WS_KV0 + 2 * KVSEG); const bf16_t* VS = (const bf16_t*)(C.ws + WS_KV0 + 3 * KVSEG);
    const bf16_t* KW = (const bf16_t*)(C.ws + WS_KV0 + 4 * KVSEG); const bf16_t* VW = (const bf16_t*)(C.ws + WS_KV0 + 5 * KVSEG);
    const float* gates = (const float*)(C.ws + WS_GATES); bf16_t* AO = (bf16_t*)(C.ws + WS_XB);
    const int wave = C.wave;
    for (int u = C.bid; u < NB * NG * (SEQ / 64); u += C.nb) {
        int lane = C.lane; asm volatile("" : "+v"(lane));
        const int i16 = lane & 15, fq = lane >> 4;
        const int rnd = u / C.nb, idx = (u % C.nb) >> 4, bg = u & 15, b = bg >> 2, g = bg & 3;
        const int c = (C.nb == 256) ? 127 - 16 * rnd - ((rnd & 1) ? 15 - idx : idx) : 127 - (u >> 4);
        fa::Task T0, T1; NsaRow R0, R1;
        nsa_row_init(R0, T0, Q, b, g, c, 32 * wave + i16, fq);
        nsa_row_init(R1, T1, Q, b, g, c, 32 * wave + 16 + i16, fq);
        for (int i = C.tid; i < 2 * 64 * 130; i += NTHREADS) imp[i] = 0.f;
        if (C.tid < 256) selm[C.tid] = 0u;
        const int nvm = ((64 * c + 63 - 31) >> 4) + 1;
        const int nvmax = nvm > 511 ? 511 : nvm;
        const int nblkc = (nvmax + 63) >> 6;
        nsa_cmp_setup(R0, T0); nsa_cmp_setup(R1, T1);
        fa::flash_loop<1, 0>(ring, KC + (size_t)bg * 512 * DH, VC + (size_t)bg * 512 * DH, nblkc, T0, T1, imp, wave, lane);
        { const float l0 = fa::task_rowsum_stats(T0), l1 = fa::task_rowsum_stats(T1);
          T0.cinit = l0 > 0.f ? -T0.m - __builtin_amdgcn_logf(l0) : -__builtin_inff(); T1.cinit = l1 > 0.f ? -T1.m - __builtin_amdgcn_logf(l1) : -__builtin_inff(); }
        fa::flash_loop<2, 0>(ring, KC + (size_t)bg * 512 * DH, VC + (size_t)bg * 512 * DH, nblkc, T0, T1, imp, wave, lane);
        nsa_accum(R0, T0, gates[R0.grow() * 48 + g * 4 + R0.head()]);
        nsa_accum(R1, T1, gates[R1.grow() * 48 + g * 4 + R1.head()]);
        {
            const int jq = c, ncand = jq - 2 > 0 ? jq - 2 : 0, nforced = jq == 0 ? 1 : (jq == 1 ? 2 : 3), need = 16 - nforced;
#pragma unroll
            for (int g2 = 0; g2 < 2; ++g2) {
                const int tk = 8 * wave + 4 * g2 + (lane >> 4);
                unsigned key[8]; unsigned selb = 0u;
#pragma unroll
                for (int k = 0; k < 8; ++k) { const int j = i16 + 16 * k; const bool cand = j >= 1 && j <= jq - 2;
                    key[k] = cand ? ((__float_as_uint(imp[tk * 130 + j] + imp[64 * 130 + tk * 130 + j - 1]) & 0xFFFFFF80u) | (unsigned)(127 - j)) : 0u; }
                if (ncand <= need) {
#pragma unroll
                    for (int k = 0; k < 8; ++k) selb |= (key[k] != 0u) ? (1u << k) : 0u;
                } else {
                    for (int r = 0; r < need; ++r) {
                        unsigned m = max(max(max(key[0], key[1]), max(key[2], key[3])), max(max(key[4], key[5]), max(key[6], key[7])));
                        m = max(m, (unsigned)__builtin_amdgcn_mov_dpp((int)m, 0xB1, 0xf, 0xf, true));
                        m = max(m, (unsigned)__builtin_amdgcn_mov_dpp((int)m, 0x4E, 0xf, 0xf, true));
                        m = max(m, (unsigned)__builtin_amdgcn_mov_dpp((int)m, 0x141, 0xf, 0xf, true));
                        m = max(m, (unsigned)__builtin_amdgcn_mov_dpp((int)m, 0x140, 0xf, 0xf, true));
#pragma unroll
                        for (int k = 0; k < 8; ++k) { const bool hit = key[k] == m; selb |= hit ? (1u << k) : 0u; key[k] = hit ? 0u : key[k]; }
                    }
                }
#pragma unroll
                for (int k = 0; k < 8; ++k) { const int j = i16 + 16 * k; if (j == 0 || j == jq || j == jq - 1) selb |= 1u << k; }
#pragma unroll
                for (int w2 = 0; w2 < 4; ++w2) {
                    const unsigned bits = (((selb >> (2 * w2)) & 1u) << i16) | (((selb >> (2 * w2 + 1)) & 1u) << (16 + i16));
                    if (bits) __hip_atomic_fetch_or(selm + tk * 4 + w2, bits, __ATOMIC_RELAXED, __HIP_MEMORY_SCOPE_WORKGROUP);
                }
            }
        }
        asm volatile("s_waitcnt lgkmcnt(0)\n\ts_barrier" ::: "memory");
        {
            const int jlo = c - 8 > 0 ? c - 8 : 0;
            T0.kmin = 0; T0.kmax = R0.tokl(); fa::task_reset(T0); T1.kmin = 0; T1.kmax = R1.tokl(); fa::task_reset(T1);
            fa::flash_loop<0, 0>(ring, KW + ((size_t)bg * SEQ + 64 * c) * DH, VW + ((size_t)bg * SEQ + 64 * c) * DH, 1, T0, T1, imp, wave, lane);
            fa::task_fix_ref(T0); fa::task_fix_ref(T1);
            T0.kmin = R0.tt() - 511 - 64 * jlo; T0.kmax = R0.tt() - 64 * jlo; T1.kmin = R1.tt() - 511 - 64 * jlo; T1.kmax = R1.tt() - 64 * jlo;
            if (c > jlo) fa::flash_loop2<3, 0>(ring, KW + ((size_t)bg * SEQ + 64 * jlo) * DH, VW + ((size_t)bg * SEQ + 64 * jlo) * DH, c - jlo, T0, T1, imp, wave, lane);
            const float l0 = fa::task_rowsum(T0), l1 = fa::task_rowsum(T1);
            nsa_accum(R0, T0, (l0 > 0.f ? 1.0f / l0 : 0.f) * gates[R0.grow() * 48 + 32 + g * 4 + R0.head()]);
            nsa_accum(R1, T1, (l1 > 0.f ? 1.0f / l1 : 0.f) * gates[R1.grow() * 48 + 32 + g * 4 + R1.head()]);
        }
        {
            T0.fwp = selm + R0.tokl() * 4; T1.fwp = selm + R1.tokl() * 4;
            T0.kmin = 0; T0.kmax = R0.tokl(); fa::task_reset(T0); T1.kmin = 0; T1.kmax = R1.tokl(); fa::task_reset(T1);
            fa::flash_loop<0, 0>(ring, KS + ((size_t)bg * SEQ + 64 * c) * DH, VS + ((size_t)bg * SEQ + 64 * c) * DH, 1, T0, T1, imp, wave, lane);
            T0.kmax = R0.tt(); T1.kmax = R1.tt(); fa::task_fix_ref(T0); fa::task_fix_ref(T1);
            if (c > 0) fa::flash_loop2<3, 1>(ring, KS + (size_t)bg * SEQ * DH, VS + (size_t)bg * SEQ * DH, c, T0, T1, imp, wave, lane);
            const float l0 = fa::task_rowsum(T0), l1 = fa::task_rowsum(T1);
            nsa_accum(R0, T0, (l0 > 0.f ? 1.0f / l0 : 0.f) * gates[R0.grow() * 48 + 16 + g * 4 + R0.head()]);
            nsa_accum(R1, T1, (l1 > 0.f ? 1.0f / l1 : 0.f) * gates[R1.grow() * 48 + 16 + g * 4 + R1.head()]);
        }
        nsa_store(R0, AO, g, fq); nsa_store(R1, AO, g, fq);
    }
}

__device__ __forceinline__ void ph_moba_fa(const Ctx& C) {
    LAS unsigned char* L = (LAS unsigned char*)C.lds;
    LAS unsigned char* ring = L;
    LAS float* kms = (LAS float*)(L + 65536);
    LAS unsigned* rmask = (LAS unsigned*)(L + 65536 + 8192);
    const bf16_t* Q = (const bf16_t*)(C.ws + WS_Q); const bf16_t* K1 = (const bf16_t*)(C.ws + WS_K1); const bf16_t* V1 = (const bf16_t*)(C.ws + WS_V1);
    const float* KM = (const float*)(C.ws + WS_KMEAN); bf16_t* AO = (bf16_t*)(C.ws + WS_XB);
    const int wave = C.wave;
    for (int u = C.bid; u < NB * NH * 32; u += C.nb) {
        int lane = C.lane; asm volatile("" : "+v"(lane));
        const int i16 = lane & 15, fq = lane >> 4;
        const int rnd = u / C.nb, idx = (u % C.nb) >> 6, bh = u & 63, b = bh >> 4, h = bh & 15;
        const int cb = (C.nb == 256) ? 31 - 4 * rnd - ((rnd & 1) ? 3 - idx : idx) : 31 - (u >> 6);
        for (int i = C.tid; i < 32 * 64; i += NTHREADS) kms[i] = KM[(size_t)bh * 2048 + i];
        asm volatile("s_waitcnt vmcnt(0) lgkmcnt(0)\n\ts_barrier" ::: "memory");
        {
            const int row = C.tid >> 1, half = C.tid & 1;
            float qh[64]; load_qh(Q + (size_t)(b * SEQ + 256 * cb + row) * DM + h * DH, qh);
            float b0 = -3e38f, b1 = -3e38f, b2 = -3e38f; int j0 = 99, j1 = 99, j2 = 99;
            for (int n = half; n < cb; n += 2) {
                const LAS f32x4* km = (const LAS f32x4*)(kms + n * 64); float a = 0.f;
#pragma unroll
                for (int q = 0; q < 16; ++q) { const f32x4 w = km[q]; a += w[0] * qh[4 * q] + w[1] * qh[4 * q + 1] + w[2] * qh[4 * q + 2] + w[3] * qh[4 * q + 3]; }
                if (a > b0) { b2 = b1; j2 = j1; b1 = b0; j1 = j0; b0 = a; j0 = n; } else if (a > b1) { b2 = b1; j2 = j1; b1 = a; j1 = n; } else if (a > b2) { b2 = a; j2 = n; }
            }
            const float ov0 = __shfl_xor(b0, 1), ov1 = __shfl_xor(b1, 1), ov2 = __shfl_xor(b2, 1); const int oj0 = __shfl_xor(j0, 1), oj1 = __shfl_xor(j1, 1), oj2 = __shfl_xor(j2, 1);
#define MERGE3(a, n) do { if ((a) > b0 || ((a) == b0 && (n) < j0)) { b2 = b1; j2 = j1; b1 = b0; j1 = j0; b0 = (a); j0 = (n); } \
                else if ((a) > b1 || ((a) == b1 && (n) < j1)) { b2 = b1; j2 = j1; b1 = (a); j1 = (n); } \
                else if ((a) > b2 || ((a) == b2 && (n) < j2)) { b2 = (a); j2 = (n); } } while (0)
            MERGE3(ov0, oj0); MERGE3(ov1, oj1); MERGE3(ov2, oj2);
#undef MERGE3
            unsigned mk = 1u << cb;
            if (j0 < cb) mk |= 1u << j0; if (j1 < cb) mk |= 1u << j1; if (j2 < cb) mk |= 1u << j2;
            if (half == 0) rmask[row] = mk;
        }
        asm volatile("s_waitcnt lgkmcnt(0)\n\ts_barrier" ::: "memory");
        fa::Task T[2]; int tt[2];
#pragma unroll
        for (int ti = 0; ti < 2; ++ti) {
            const int R = 32 * wave + 16 * ti + i16; tt[ti] = 256 * cb + R; T[ti].fw0 = rmask[R]; T[ti].imptok = 0;
            const bf16_t* qp = Q + (size_t)(b * SEQ + tt[ti]) * DM + h * DH + 8 * fq;
            T[ti].q[0] = *(const bf16x8*)qp; T[ti].q[1] = *(const bf16x8*)(qp + 32);
            T[ti].kmin = 0; T[ti].kmax = tt[ti]; fa::task_reset(T[ti]);
        }
#pragma unroll
        for (int ti = 0; ti < 2; ++ti) { T[ti].kmax = tt[ti] - 256 * cb; }
        fa::flash_loop<0, 0>(ring, K1 + ((size_t)bh * SEQ + 256 * cb) * DH, V1 + ((size_t)bh * SEQ + 256 * cb) * DH, 4, T[0], T[1], kms, wave, lane);
#pragma unroll
        for (int ti = 0; ti < 2; ++ti) { T[ti].kmax = tt[ti]; fa::task_fix_ref(T[ti]); }
        if (cb > 0) fa::flash_loop2<3, 2>(ring, K1 + (size_t)bh * SEQ * DH, V1 + (size_t)bh * SEQ * DH, 4 * cb, T[0], T[1], kms, wave, lane);
#pragma unroll
        for (int ti = 0; ti < 2; ++ti) { const float l = fa::task_rowsum(T[ti]); const float sc_ = l > 0.f ? 1.0f / l : 0.f;
            bf16_t* op = AO + (size_t)(b * SEQ + tt[ti]) * DM + h * DH + 4 * fq;
#pragma unroll
            for (int dt = 0; dt < 4; ++dt) { const f32x4 o = T[ti].O[dt] * sc_; *(u32x2*)(op + 16 * dt) = (u32x2){pk2(o[0], o[1]), pk2(o[2], o[3])}; } }
    }
}

struct Route { int e0, s0, e1, s1; float w0, w1; int pad0, pad1; };
__device__ __forceinline__ void ph_ln_route(const Ctx& C, int layer) {
    const float* resid = layer ? (const float*)(C.ws + WS_XR) : C.in[I_X]; const bf16_t* MIX = (const bf16_t*)(C.ws + WS_MIX);
    float* XR = (float*)(C.ws + WS_XR); bf16_t* X1B = (bf16_t*)(C.ws + WS_X1B); Route* RT = (Route*)(C.ws + WS_ROUTE);
    int* rowlist = (int*)(C.ws + WS_ROWLIST); unsigned* cnt = (unsigned*)(C.ws + WS_CTL) + (layer ? CW_CNT1 : CW_CNT0);
    const float* lg = C.in[I_LNG] + (size_t)(layer * 2 + 0) * DM; const float* lb = C.in[I_LNB] + (size_t)(layer * 2 + 0) * DM;
    const float* rw = C.in[I_RW]; const float* rb = C.in[I_RB];
    LAS unsigned* lcnt = (LAS unsigned*)C.lds;
    LAS float* rec = (LAS float*)(C.lds + 256);
    LAS float* lsb = (LAS float*)(C.lds + 4096 + C.wave * 512);
    const int lane = C.lane;
    LAS unsigned char* rwl = (LAS unsigned char*)(C.lds + 8192);
    for (int gi = C.tid; gi < DM * NE / 4; gi += NTHREADS) { const int c = gi >> 2, e4 = gi & 3;
        *(LAS f32x4*)(rwl + (c >> 8) * 17408 + ((c & 255) >> 2) * 272 + (c & 3) * 64 + e4 * 16) = ((const f32x4*)rw)[gi]; }
    __syncthreads();
    for (int chunk = C.bid; chunk < NTOK / 128; chunk += C.nb) {
        if (C.tid < 16) lcnt[C.tid] = 0u;
        __syncthreads();
        for (int i2 = 0; i2 < 8; ++i2) {
            const int rl0 = C.wave * 16 + i2 * 2, row0 = chunk * 128 + rl0;
            f32x4 v[2][4]; float s[2], s2[2];
#pragma unroll
            for (int r = 0; r < 2; ++r) { const f32x4* xr = (const f32x4*)(resid + (size_t)(row0 + r) * DM) + lane; const u32x2* mr = (const u32x2*)(MIX + (size_t)(row0 + r) * DM) + lane; s[r] = 0.f;
#pragma unroll
                for (int j = 0; j < 4; ++j) { const u32x2 w = mr[64 * j]; v[r][j] = xr[64 * j] * DN_ALPHA + (f32x4){bflo(w.x), bfhi(w.x), bflo(w.y), bfhi(w.y)};
                    s[r] += (v[r][j][0] + v[r][j][1]) + (v[r][j][2] + v[r][j][3]); } }
#pragma unroll
            for (int o = 1; o < 64; o <<= 1) { s[0] += __shfl_xor(s[0], o); s[1] += __shfl_xor(s[1], o); }
#pragma unroll
            for (int r = 0; r < 2; ++r) { const float mean = s[r] * (1.f / DM); s2[r] = 0.f;
#pragma unroll
                for (int j = 0; j < 4; ++j) { v[r][j] = v[r][j] - mean; s2[r] += (v[r][j][0] * v[r][j][0] + v[r][j][1] * v[r][j][1]) + (v[r][j][2] * v[r][j][2] + v[r][j][3] * v[r][j][3]); } }
#pragma unroll
            for (int o = 1; o < 64; o <<= 1) { s2[0] += __shfl_xor(s2[0], o); s2[1] += __shfl_xor(s2[1], o); }
            const float rstd0 = 1.f / sqrtf(s2[0] * (1.f / DM) + LN_EPS), rstd1 = 1.f / sqrtf(s2[1] * (1.f / DM) + LN_EPS);
            float p[32];
#pragma unroll
            for (int q = 0; q < 32; ++q) p[q] = 0.f;
#pragma unroll
            for (int j = 0; j < 4; ++j) {
                const int c0 = 4 * lane + 256 * j;
                const f32x4 gg = *(const f32x4*)(lg + c0), bb = *(const f32x4*)(lb + c0);
#pragma unroll
                for (int r = 0; r < 2; ++r) {
                    v[r][j] = v[r][j] * (r ? rstd1 : rstd0) * gg + bb;
                    *((f32x4*)(XR + (size_t)(row0 + r) * DM) + lane + 64 * j) = v[r][j];
                    *(u32x2*)(X1B + (size_t)(row0 + r) * DM + c0) = (u32x2){pk2(v[r][j][0], v[r][j][1]), pk2(v[r][j][2], v[r][j][3])}; }
#pragma unroll
                for (int q = 0; q < 4; ++q) {
                    const LAS f32x4* wr = (const LAS f32x4*)(rwl + j * 17408 + lane * 272 + q * 64);
                    const f32x4 w0 = wr[0], w1 = wr[1], w2 = wr[2], w3 = wr[3];
#pragma unroll
                    for (int r = 0; r < 2; ++r) { const float x = v[r][j][q];
                        p[16 * r + 0] += x * w0[0]; p[16 * r + 1] += x * w0[1]; p[16 * r + 2] += x * w0[2]; p[16 * r + 3] += x * w0[3];
                        p[16 * r + 4] += x * w1[0]; p[16 * r + 5] += x * w1[1]; p[16 * r + 6] += x * w1[2]; p[16 * r + 7] += x * w1[3];
                        p[16 * r + 8] += x * w2[0]; p[16 * r + 9] += x * w2[1]; p[16 * r + 10] += x * w2[2]; p[16 * r + 11] += x * w2[3];
                        p[16 * r + 12] += x * w3[0]; p[16 * r + 13] += x * w3[1]; p[16 * r + 14] += x * w3[2]; p[16 * r + 15] += x * w3[3]; }
                    if (q == 3) asm volatile("" ::: "memory");
                }
            }
#define TRED(N, M) { const bool up = (lane & (M)) != 0; _Pragma("unroll") for (int q = 0; q < (N); ++q) { const float keep = up ? p[q + (N)] : p[q], send = up ? p[q] : p[q + (N)]; p[q] = keep + __shfl_xor(send, (M)); } }
            TRED(16, 32) TRED(8, 16) TRED(4, 8) TRED(2, 4) TRED(1, 2)
#undef TRED
            p[0] += __shfl_xor(p[0], 1);
            const float sc_own = 1.0f / (1.0f + expf(-p[0]));
            if ((lane & 1) == 0) { lsb[lane >> 1] = sc_own; lsb[32 + (lane >> 1)] = sc_own + rb[(lane >> 1) & 15]; }
            WAVE_LDS_SYNC();
            float sc[16], bi[16];
            { const LAS f32x4* a4 = (const LAS f32x4*)(lsb + ((lane >> 5) << 4)); const LAS f32x4* b4 = (const LAS f32x4*)(lsb + 32 + ((lane >> 5) << 4));
#pragma unroll
              for (int q = 0; q < 4; ++q) { const f32x4 x = a4[q], y = b4[q]; sc[4 * q] = x[0]; sc[4 * q + 1] = x[1]; sc[4 * q + 2] = x[2]; sc[4 * q + 3] = x[3]; bi[4 * q] = y[0]; bi[4 * q + 1] = y[1]; bi[4 * q + 2] = y[2]; bi[4 * q + 3] = y[3]; } }
            WAVE_LDS_SYNC();
            int gsel = 0; float gbest = -3e38f;
#pragma unroll
            for (int gq = 0; gq < 4; ++gq) {
                float m1 = -3e38f, m2 = -3e38f;
#pragma unroll
                for (int q = 0; q < 4; ++q) { const float x = bi[4 * gq + q]; if (x > m1) { m2 = m1; m1 = x; } else if (x > m2) m2 = x; }
                const float gs = m1 + m2; if (gs > gbest) { gbest = gs; gsel = gq; }
            }
            int e0 = 0, e1 = 0; float b0 = -3e38f, b1 = -3e38f, w0 = 0.f, w1 = 0.f;
#pragma unroll
            for (int e = 0; e < 16; ++e) {
                if ((e >> 2) == gsel) {
                    const float x = bi[e];
                    if (x > b0) { b1 = b0; e1 = e0; w1 = w0; b0 = x; e0 = e; w0 = sc[e]; }
                    else if (x > b1) { b1 = x; e1 = e; w1 = sc[e]; }
                }
            }
            if ((lane & 31) == 0) {
                const int rl = rl0 + (lane >> 5);
                const float ws_ = w0 + w1;
                const unsigned l0 = __hip_atomic_fetch_add(lcnt + e0, 1u, __ATOMIC_RELAXED, __HIP_MEMORY_SCOPE_WORKGROUP), l1 = __hip_atomic_fetch_add(lcnt + e1, 1u, __ATOMIC_RELAXED, __HIP_MEMORY_SCOPE_WORKGROUP);
                LAS float* r = rec + rl * 6; r[0] = __int_as_float(e0); r[1] = __int_as_float(e1); r[2] = __uint_as_float(l0); r[3] = __uint_as_float(l1); r[4] = w0 / ws_; r[5] = w1 / ws_;
            }
        }
        __syncthreads();
        if (C.tid < 16) lcnt[16 + C.tid] = atomicAdd(cnt + 64 * C.tid, lcnt[C.tid]);
        __syncthreads();
        if (C.tid < 128) {
            const LAS float* r = rec + C.tid * 6; const int row = chunk * 128 + C.tid;
            const int e0 = __float_as_int(r[0]), e1 = __float_as_int(r[1]);
            const int s0 = (int)(lcnt[16 + e0] + __float_as_uint(r[2])), s1 = (int)(lcnt[16 + e1] + __float_as_uint(r[3]));
            rowlist[e0 * NTOK + s0] = row; rowlist[e1 * NTOK + s1] = row;
            Route rr; rr.e0 = e0; rr.s0 = s0; rr.e1 = e1; rr.s1 = s1; rr.w0 = r[4]; rr.w1 = r[5]; rr.pad0 = 0; rr.pad1 = 0;
            RT[row] = rr;
        }
        __syncthreads();
    }
}
__device__ __forceinline__ void ph_combine(const Ctx& C, int layer, float* outp, LAS int* sm) {
    const float* XR = (const float*)(C.ws + WS_XR); const bf16_t* Y2 = (const bf16_t*)(C.ws + WS_Y2); const Route* RT = (const Route*)(C.ws + WS_ROUTE);
    bf16_t* XB = (bf16_t*)(C.ws + WS_XB);
    const float* lg = C.in[I_LNG] + (size_t)(layer * 2 + 1) * DM; const float* lb = C.in[I_LNB] + (size_t)(layer * 2 + 1) * DM;
    const int gw = C.bid * NWAVES + C.wave, NGW = C.nb * NWAVES, lane = C.lane;
    for (int row = gw; row < NTOK; row += NGW) {
        const Route r = RT[row];
        const bf16_t* y0 = Y2 + (size_t)(sm[16 + r.e0] + r.s0) * DM; const bf16_t* y1 = Y2 + (size_t)(sm[16 + r.e1] + r.s1) * DM;
        const f32x4* xr = (const f32x4*)(XR + (size_t)row * DM) + lane;
        f32x4 v[4]; float s = 0.f;
#pragma unroll
        for (int j = 0; j < 4; ++j) {
            const int c0 = 4 * lane + 256 * j;
            const u32x2 a = *(const u32x2*)(y0 + c0), b = *(const u32x2*)(y1 + c0);
            const f32x4 ya = (f32x4){bflo(a.x), bfhi(a.x), bflo(a.y), bfhi(a.y)}, yb = (f32x4){bflo(b.x), bfhi(b.x), bflo(b.y), bfhi(b.y)};
            v[j] = xr[64 * j] * DN_ALPHA + ya * r.w0 + yb * r.w1;
            s += (v[j][0] + v[j][1]) + (v[j][2] + v[j][3]);
        }
        const float mean = wave_sum(s) * (1.f / DM); float s2 = 0.f;
#pragma unroll
        for (int j = 0; j < 4; ++j) { v[j] = v[j] - mean; s2 += (v[j][0] * v[j][0] + v[j][1] * v[j][1]) + (v[j][2] * v[j][2] + v[j][3] * v[j][3]); }
        const float rstd = 1.f / sqrtf(wave_sum(s2) * (1.f / DM) + LN_EPS);
#pragma unroll
        for (int j = 0; j < 4; ++j) {
            const int c0 = 4 * lane + 256 * j;
            const f32x4 gg = *(const f32x4*)(lg + c0), bb = *(const f32x4*)(lb + c0);
            v[j] = v[j] * rstd * gg + bb;
            *(f32x4*)(outp + (size_t)row * DM + c0) = v[j];
            *(u32x2*)(XB + (size_t)row * DM + c0) = (u32x2){pk2(v[j][0], v[j][1]), pk2(v[j][2], v[j][3])};
        }
    }
}

__device__ __forceinline__ void ph_kmean(const Ctx& C) {
    const bf16_t* K1 = (const bf16_t*)(C.ws + WS_K1); float* KM = (float*)(C.ws + WS_KMEAN);
    const int gw = C.bid * NWAVES + C.wave, NGW = C.nb * NWAVES, lane = C.lane;
    for (int it = gw; it < NB * NH * 32; it += NGW) {
        const bf16_t* p = K1 + (size_t)it * 256 * DH + lane; float s = 0.f;
#pragma unroll 8
        for (int j = 0; j < 256; ++j) s += bf2f(p[j * DH]);
        KM[(size_t)it * DH + lane] = s * (1.0f / 256.0f);
    }
}
constexpr int NPHASE = 19;
__global__ void __launch_bounds__(NTHREADS, 2) fwd(Args args) {
    extern __shared__ __attribute__((aligned(16))) unsigned char lds[];
    Ctx C;
#pragma unroll
    for (int i = 0; i < 18; ++i) C.in[i] = args.in[i];
    C.out = args.out; C.ws = args.ws; C.lds = lds;
    C.tid = threadIdx.x; C.lane = C.tid & 63; C.wave = __builtin_amdgcn_readfirstlane(C.tid >> 6); C.bid = blockIdx.x; C.nb = gridDim.x;
    LAS unsigned* misc = (LAS unsigned*)(lds + LDS_BYTES - 512);
    LAS int* sm = (LAS int*)(misc + 16);
    if (C.tid < 4) misc[C.tid] = 0u;
    __syncthreads();
#if MK_SINGLE
    XcdBarrier bar = xcd_barrier_post((unsigned*)(C.ws + WS_CTL) + CW_BAR, (volatile LAS unsigned*)misc);
#define SEAM() xcd_barrier(bar)
#else
#define SEAM() do {} while (0)
#endif
    const int lo = args.ph_lo, hi = args.ph_hi;
#ifndef PH_MASK
#define PH_MASK 0xFFFFFFFFu
#endif
#define IN(k) (((PH_MASK >> (k)) & 1u) && lo <= (k) && (k) < hi)
#define BOTH(k) (IN(k) && IN((k) + 1))
    unsigned char* ws = C.ws;
    const float2* rope = (const float2*)(ws + WS_ROPE);
    LAS unsigned char* L = (LAS unsigned char*)lds;

    if (IN(0)) { ph_prologue(C); if (BOTH(0)) SEAM(); }
    if (IN(1)) {
        EpiNsaIn E{(bf16_t*)(ws + WS_Q), (bf16_t*)(ws + WS_KV0), (float*)(ws + WS_GATES), rope};
        g8::StaticOrder S; S.init(NTOK / 256, 2560 / 256, C.nb, C.bid);
        g8::gemm8<false>(L, (const bf16_t*)(ws + WS_XB), DM, (const bf16_t*)(ws + WS_WT_NSA_IN), DM, S, g8::EpiEl<EpiNsaIn>{E}, g8::GatherInfo{nullptr, sm});
        if (BOTH(1)) SEAM();
    }
    if (IN(2)) {
        EpiGelu EK{(bf16_t*)(ws + WS_H1K), (const float*)(ws + WS_BIAS1)}, EV{(bf16_t*)(ws + WS_H1V), (const float*)(ws + WS_BIAS1) + 256};
        g8::StaticOrder SK, SV; SK.init(32, 1, C.nb, C.bid); SV.init(32, 1, C.nb, (C.bid + C.nb / 2) % C.nb);
        g8::gemm8<false>(L, (const bf16_t*)(ws + WS_KV0), 1024, (const bf16_t*)(ws + WS_WT_C1K), 2048, SK, g8::EpiEl<EpiGelu>{EK}, g8::GatherInfo{nullptr, sm});
        g8::gemm8<false>(L, (const bf16_t*)(ws + WS_KV0 + KVSEG), 1024, (const bf16_t*)(ws + WS_WT_C1V), 2048, SV, g8::EpiEl<EpiGelu>{EV}, g8::GatherInfo{nullptr, sm});
        if (C.nb == 256 && !((C.bid < 32) || (C.bid >= 128 && C.bid < 160))) {
            EpiNsaIn E{(bf16_t*)(ws + WS_Q), (bf16_t*)(ws + WS_KV0), (float*)(ws + WS_GATES), rope};
            const int gidx = C.bid < 128 ? C.bid - 32 : C.bid - 64, fr = C.lane & 15, fq = C.lane >> 4;
            for (int tile = gidx * NWAVES + C.wave; tile < 2048; tile += 192 * NWAVES) {
                const int row0 = (tile >> 1) * 32, col0 = 2560 + (tile & 1) * 32;
                const bf16_t* a0 = (const bf16_t*)(ws + WS_XB) + (size_t)(row0 + fr) * DM + fq * 8; const bf16_t* a1 = a0 + (size_t)16 * DM;
                const bf16_t* b0 = (const bf16_t*)(ws + WS_WT_NSA_IN) + (size_t)(col0 + fr) * DM + fq * 8; const bf16_t* b1 = b0 + (size_t)16 * DM;
                f32x4 acc[2][2]; mma_core(a0, a1, b0, b1, DM, acc);
#pragma unroll
                for (int mi = 0; mi < 2; ++mi)
#pragma unroll
                    for (int ni = 0; ni < 2; ++ni) E(row0 + 16 * mi + fr, col0 + 16 * ni + 4 * fq, acc[mi][ni]);
            }
        } else if (C.nb != 256) {
            EpiNsaIn E{(bf16_t*)(ws + WS_Q), (bf16_t*)(ws + WS_KV0), (float*)(ws + WS_GATES), rope};
            const int fr = C.lane & 15, fq = C.lane >> 4;
            for (int tile = C.bid * NWAVES + C.wave; tile < 2048; tile += C.nb * NWAVES) {
                const int row0 = (tile >> 1) * 32, col0 = 2560 + (tile & 1) * 32;
                const bf16_t* a0 = (const bf16_t*)(ws + WS_XB) + (size_t)(row0 + fr) * DM + fq * 8; const bf16_t* a1 = a0 + (size_t)16 * DM;
                const bf16_t* b0 = (const bf16_t*)(ws + WS_WT_NSA_IN) + (size_t)(col0 + fr) * DM + fq * 8; const bf16_t* b1 = b0 + (size_t)16 * DM;
                f32x4 acc[2][2]; mma_core(a0, a1, b0, b1, DM, acc);
#pragma unroll
                for (int mi = 0; mi < 2; ++mi)
#pragma unroll
                    for (int ni = 0; ni < 2; ++ni) E(row0 + 16 * mi + fr, col0 + 16 * ni + 4 * fq, acc[mi][ni]);
            }
        }
        if (BOTH(2)) SEAM();
    }
    if (IN(3)) { ph_cmp2(C); if (BOTH(3)) SEAM(); }
    if (IN(4)) { ph_nsa_fa(C); if (BOTH(4)) SEAM(); }
    if (IN(6)) {
        EpiBf16 E{(bf16_t*)(ws + WS_MIX)};
        g8::StaticOrder S; S.init(NTOK / 256, DM / 256, C.nb, C.bid);
        g8::gemm8<false>(L, (const bf16_t*)(ws + WS_XB), DM, (const bf16_t*)(ws + WS_WT_NSA_OUT), DM, S, g8::EpiEl<EpiBf16>{E}, g8::GatherInfo{nullptr, sm});
        if (BOTH(6)) SEAM();
    }
    if (IN(7)) { ph_ln_route(C, 0); if (BOTH(7)) SEAM(); }
    if (IN(8)) {
        load_expert_map(C, CW_CNT0, sm);
        EpiSwiGLU E{(bf16_t*)(ws + WS_HBUF)};
        g8::GroupedOrder S; S.init(sm, 4, C.nb, C.bid);
        g8::gemm8<true>(L, (const bf16_t*)(ws + WS_X1B), DM, (const bf16_t*)(ws + WS_WT_GU), 1024, S, g8::EpiEl<EpiSwiGLU>{E}, g8::GatherInfo{(const int*)(ws + WS_ROWLIST), sm});
        if (BOTH(8)) SEAM();
    }
    if (IN(9)) {
        load_expert_map(C, CW_CNT0, sm);
        EpiBf16 E{(bf16_t*)(ws + WS_Y2)};
        g8::GroupedOrder S; S.init(sm, 4, C.nb, C.bid);
        g8::gemm8<false>(L, (const bf16_t*)(ws + WS_HBUF), DE, (const bf16_t*)(ws + WS_WT_DN), DE, S, g8::EpiEl<EpiBf16>{E}, g8::GatherInfo{nullptr, sm});
        if (BOTH(9)) SEAM();
    }
    if (IN(10)) {
        load_expert_map(C, CW_CNT0, sm);
        ph_combine(C, 0, (float*)(ws + WS_XR), sm);
        { float* scr = (float*)(C.lds + C.wave * 9216); const int gw = C.bid * NWAVES + C.wave, NGW = C.nb * NWAVES;
          for (int it = gw; it < MOE_W_ITEMS; it += NGW) moe_weight_item(C, 1, it, scr); }
        if (BOTH(10)) SEAM();
    }
    if (IN(11)) {
        EpiMobaIn E{(bf16_t*)(ws + WS_Q), (bf16_t*)(ws + WS_K1), (bf16_t*)(ws + WS_V1), rope};
        g8::StaticOrder S; S.init(NTOK / 256, 3072 / 256, C.nb, C.bid);
        g8::gemm8<false>(L, (const bf16_t*)(ws + WS_XB), DM, (const bf16_t*)(ws + WS_WT_MOBA_IN), DM, S, g8::EpiEl<EpiMobaIn>{E}, g8::GatherInfo{nullptr, sm});
        if (BOTH(11)) SEAM();
    }
    if (IN(12)) { ph_kmean(C); if (BOTH(12)) SEAM(); }
    if (IN(13)) { ph_moba_fa(C); if (BOTH(13)) SEAM(); }
    if (IN(14)) {
        EpiBf16 E{(bf16_t*)(ws + WS_MIX)};
        g8::StaticOrder S; S.init(NTOK / 256, DM / 256, C.nb, C.bid);
        g8::gemm8<false>(L, (const bf16_t*)(ws + WS_XB), DM, (const bf16_t*)(ws + WS_WT_MOBA_OUT), DM, S, g8::EpiEl<EpiBf16>{E}, g8::GatherInfo{nullptr, sm});
        if (BOTH(14)) SEAM();
    }
    if (IN(15)) { ph_ln_route(C, 1); if (BOTH(15)) SEAM(); }
    if (IN(16)) {
        load_expert_map(C, CW_CNT1, sm);
        EpiSwiGLU E{(bf16_t*)(ws + WS_HBUF)};
        g8::GroupedOrder S; S.init(sm, 4, C.nb, C.bid);
        g8::gemm8<true>(L, (const bf16_t*)(ws + WS_X1B), DM, (const bf16_t*)(ws + WS_WT_GU), 1024, S, g8::EpiEl<EpiSwiGLU>{E}, g8::GatherInfo{(const int*)(ws + WS_ROWLIST), sm});
        if (BOTH(16)) SEAM();
    }
    if (IN(17)) {
        load_expert_map(C, CW_CNT1, sm);
        EpiBf16 E{(bf16_t*)(ws + WS_Y2)};
        g8::GroupedOrder S; S.init(sm, 4, C.nb, C.bid);
        g8::gemm8<false>(L, (const bf16_t*)(ws + WS_HBUF), DE, (const bf16_t*)(ws + WS_WT_DN), DE, S, g8::EpiEl<EpiBf16>{E}, g8::GatherInfo{nullptr, sm});
        if (BOTH(17)) SEAM();
    }
    if (IN(18)) {
        load_expert_map(C, CW_CNT1, sm);
        ph_combine(C, 1, C.out, sm);
    }
#undef IN
#undef BOTH
}

extern "C" void kernel_launch(void* const* d_in, const int* in_sizes, int n_in, void* d_out, int out_size, void* d_ws, size_t ws_size, hipStream_t stream) {
    static int grid = 0;
    if (grid == 0) {
        if (n_in != 18 || in_sizes[0] != NTOK * DM || out_size != NTOK * DM || ws_size < WS_END) {
            fprintf(stderr, "kernel_launch: unexpected shapes (n_in %d, in0 %d, out %d, ws %zu; need ws >= %zu); nothing launched\n", n_in, n_in > 0 ? in_sizes[0] : -1, out_size, ws_size, (size_t)WS_END);
            grid = -1; return;
        }
        int dev = 0, cus = 0, per_cu = 0;
        if (hipGetDevice(&dev) != hipSuccess || hipDeviceGetAttribute(&cus, hipDeviceAttributeMultiprocessorCount, dev) != hipSuccess) { grid = -1; return; }
        if (hipFuncSetAttribute((const void*)fwd, hipFuncAttributeMaxDynamicSharedMemorySize, LDS_BYTES) != hipSuccess) { fprintf(stderr, "kernel_launch: hipFuncSetAttribute failed\n"); grid = -1; return; }
        if (hipOccupancyMaxActiveBlocksPerMultiprocessor(&per_cu, (const void*)fwd, NTHREADS, LDS_BYTES) != hipSuccess || per_cu < 1)
            fprintf(stderr, "kernel_launch: occupancy query reports %d blocks per CU\n", per_cu);
        (void)hipGetLastError();
        grid = cus;
    }
    if (grid < 0) return;
    if (hipMemsetAsync((char*)d_ws + WS_CTL, 0, CTL_BYTES, stream) != hipSuccess) { fprintf(stderr, "kernel_launch: memset failed\n"); return; }
    Args a{};
    for (int i = 0; i < 18; ++i) a.in[i] = (const float*)d_in[i];
    a.out = (float*)d_out; a.ws = (unsigned char*)d_ws;
#if defined(PROBE_PH)
    { const int lo3[3] = {0, PROBE_PH, PROBE_PH + 1}, hi3[3] = {PROBE_PH + 1, PROBE_PH + 1, NPHASE};
      for (int q = 0; q < 3; ++q) { if (lo3[q] >= hi3[q]) continue;
          if (q) (void)hipMemsetAsync((char*)d_ws + WS_CTL + CW_BAR * 4, 0, XCD_BAR_WORDS * 4, stream);
          a.ph_lo = lo3[q]; a.ph_hi = hi3[q]; hipLaunchKernelGGL(fwd, dim3(grid), dim3(NTHREADS), LDS_BYTES, stream, a); } }
#elif MK_SINGLE
    a.ph_lo = 0; a.ph_hi = NPHASE;
    hipLaunchKernelGGL(fwd, dim3(grid), dim3(NTHREADS), LDS_BYTES, stream, a);
#else
    for (int p = 0; p < NPHASE; ++p) { a.ph_lo = p; a.ph_hi = p + 1; hipLaunchKernelGGL(fwd, dim3(grid), dim3(NTHREADS), LDS_BYTES, stream, a); }
#endif
    const hipError_t le = hipPeekAtLastError();
    if (le != hipSuccess) fprintf(stderr, "kernel_launch: launch failed: %s\n", hipGetErrorName(le));
}
```

```cpp
#include <hip/hip_runtime.h>
#include <cstdio>
#include <cstdint>

#ifndef SEL_FUSED
#define SEL_FUSED 1
#endif
#ifndef MK_SINGLE
#define MK_SINGLE 1
#endif

#define LAS __attribute__((address_space(3)))
typedef unsigned short bf16_t;
typedef short bf16x8 __attribute__((ext_vector_type(8)));
typedef float f32x4 __attribute__((ext_vector_type(4)));
typedef unsigned u32x4 __attribute__((ext_vector_type(4)));
typedef unsigned u32x2 __attribute__((ext_vector_type(2)));

constexpr int NB = 4, SEQ = 8192, NTOK = NB * SEQ, DM = 1024, NH = 16, DH = 64, NG = 4;
constexpr int NSA_IN = 2608, NSA_INP = 2816;
constexpr int NE = 16, DE = 512;
constexpr float DN_ALPHA = 1.4142135623730951f;
constexpr float LN_EPS = 1e-5f;
constexpr int NWAVES = 8, NTHREADS = 512;
constexpr float QSCALE = 0.125f * 1.4426950408889634f;
constexpr int LDS_BYTES = 163840;
constexpr int ROWCAP = 2 * NTOK + NE * 256;

constexpr size_t MiB = 1u << 20;
constexpr size_t WS_CTL = 0, CTL_BYTES = 1 * MiB;
constexpr size_t WS_ROPE = 1 * MiB;
constexpr size_t WS_BIAS1 = 3 * MiB;
constexpr size_t WS_KMEAN = 4 * MiB;
constexpr size_t WS_ROUTE = 5 * MiB;
constexpr size_t WS_ROWLIST = 6 * MiB;
constexpr size_t WS_SEL = 8 * MiB;
constexpr size_t WS_GATES = 10 * MiB;
constexpr size_t WS_H1K = 17 * MiB, WS_H1V = 21 * MiB;
constexpr size_t WS_KC = 25 * MiB, WS_VC = 26 * MiB;
constexpr size_t WS_WT_NSA_IN = 27 * MiB;
constexpr size_t WS_WT_NSA_OUT = 33 * MiB;
constexpr size_t WS_WT_C1K = 35 * MiB, WS_WT_C1V = 36 * MiB;
constexpr size_t WS_WT_MOBA_IN = 37 * MiB;
constexpr size_t WS_WT_MOBA_OUT = 43 * MiB;
constexpr size_t WS_WT_GU = 45 * MiB;
constexpr size_t WS_WT_DN = 77 * MiB;
constexpr size_t WS_XB = 93 * MiB;
constexpr size_t WS_ATTN = 161 * MiB;
constexpr size_t WS_Q = WS_ATTN;
constexpr size_t WS_KV0 = WS_ATTN + 64 * MiB;
constexpr size_t KVSEG = 16 * MiB;
constexpr size_t WS_K1 = WS_ATTN + 64 * MiB, WS_V1 = WS_ATTN + 128 * MiB;
constexpr size_t WS_X1B = 353 * MiB;
constexpr size_t WS_X2B = 417 * MiB;
constexpr size_t WS_MIX = WS_ATTN + 64 * MiB;
constexpr size_t WS_Y2 = WS_ATTN;
constexpr size_t WS_HBUF = WS_XB;
constexpr size_t WS_XR = 353 * MiB;
constexpr size_t WS_END = 481 * MiB;
static_assert((size_t)ROWCAP * 512 * 2 <= 68 * MiB && (size_t)ROWCAP * 1024 * 2 <= 192 * MiB, "overlay sizes");

constexpr int CW_TMO = 0;
constexpr int CW_CNT0 = 1024, CW_CNT1 = 2048;
constexpr int CW_BAR = 8192;

__device__ __forceinline__ unsigned f2bf(float f) { unsigned u = __float_as_uint(f); return (u + 0x7fffu + ((u >> 16) & 1u)) >> 16; }
typedef float f32x2v __attribute__((ext_vector_type(2)));
typedef __bf16 bf16x2v __attribute__((ext_vector_type(2)));
__device__ __forceinline__ unsigned pk2(float lo, float hi) { const f32x2v v = {lo, hi}; const bf16x2v b = __builtin_convertvector(v, bf16x2v); return __builtin_bit_cast(unsigned, b); }
__device__ __forceinline__ float bflo(unsigned u) { return __uint_as_float(u << 16); }
__device__ __forceinline__ float bfhi(unsigned u) { return __uint_as_float(u & 0xffff0000u); }
__device__ __forceinline__ float bf2f(bf16_t b) { return __uint_as_float((unsigned)b << 16); }
__device__ __forceinline__ float wave_sum(float v) {
#pragma unroll
    for (int o = 1; o < 64; o <<= 1) v += __shfl_xor(v, o);
    return v;
}
__device__ __forceinline__ float wave_max(float v) {
#pragma unroll
    for (int o = 1; o < 64; o <<= 1) v = fmaxf(v, __shfl_xor(v, o));
    return v;
}
#define WAVE_LDS_SYNC() asm volatile("s_waitcnt lgkmcnt(0)" ::: "memory")
__device__ __forceinline__ float sigmoidf_(float x) { return 1.0f / (1.0f + __expf(-x)); }
__device__ __forceinline__ float gelu_tanh(float x) {
    const float u = 0.7978845608028654f * (x + 0.044715f * x * x * x);
    const float t = 1.0f - 2.0f / (__expf(2.0f * u) + 1.0f);
    return 0.5f * x * (1.0f + t);
}

#define XB_TMO      128
#define XB_XCNT(j)  (256  + 64 * (j))
#define XB_XSUB(j)  (1280 + 64 * (j))
#define XB_XGEN(j)  (2304 + 64 * (j))
#define XB_TOP      3328
#define XB_TOPGEN   3392
#define XCD_BAR_WORDS 3456
#define XB_SPIN_CAP (1u << 22)
__device__ __forceinline__ unsigned xb_ld(unsigned* p)              { return __hip_atomic_load(p, __ATOMIC_RELAXED, __HIP_MEMORY_SCOPE_AGENT); }
__device__ __forceinline__ unsigned xb_add(unsigned* p, unsigned v) { return __hip_atomic_fetch_add(p, v, __ATOMIC_RELAXED, __HIP_MEMORY_SCOPE_AGENT); }
__device__ __forceinline__ unsigned xb_xcc_id() { return (unsigned)__builtin_amdgcn_s_getreg((3 << 11) | 20) & 0xFu; }
#define XB_SPIN(cond, bar) do { unsigned _sp = 0; while (cond) { __builtin_amdgcn_s_sleep(1); \
    if ((++_sp & 255u) == 0u) { if (xb_ld(&(bar)[XB_TMO])) break; if (_sp > XB_SPIN_CAP) { atomicAdd(&(bar)[XB_TMO], 1u); break; } } } } while (0)
struct XcdBarrier { unsigned* bar; unsigned x; volatile LAS unsigned* st; };
__device__ __forceinline__ XcdBarrier xcd_barrier_post(unsigned* bar, volatile LAS unsigned* st) {
    XcdBarrier b; b.bar = bar; b.x = xb_xcc_id(); b.st = st;
    if (threadIdx.x == 0) (void)xb_add(&bar[XB_XCNT(b.x)], 1u);
    return b;
}
__device__ __forceinline__ void xcd_barrier_complete(unsigned* bar, unsigned x, unsigned& nloc, unsigned& nx) {
    const unsigned G = gridDim.x * gridDim.y * gridDim.z;
    unsigned sum, cnt, mine, sp = 0u;
    for (;;) {
        sum = 0u; cnt = 0u; mine = 0u;
#pragma unroll
        for (unsigned j = 0; j < 16; ++j) { const unsigned c = xb_ld(&bar[XB_XCNT(j)]); sum += c; cnt += (c > 0u) ? 1u : 0u; mine = (j == x) ? c : mine; }
        if (sum == G) break;
        __builtin_amdgcn_s_sleep(1);
        if ((++sp & 255u) == 0u) { if (xb_ld(&bar[XB_TMO])) break; if (sp > XB_SPIN_CAP) { atomicAdd(&bar[XB_TMO], 1u); break; } }
    }
    nloc = mine > 0u ? mine : 1u; nx = cnt > 0u ? cnt : 1u;
}
__device__ __forceinline__ void xcd_barrier(const XcdBarrier& b) {
    asm volatile("s_waitcnt vmcnt(0)" ::: "memory");
    __syncthreads();
    if (threadIdx.x == 0) {
        unsigned* bar = b.bar;
        __builtin_amdgcn_s_waitcnt(0);
        unsigned nloc = b.st[0], nx = b.st[1];
        if (nloc == 0u) { xcd_barrier_complete(bar, b.x, nloc, nx); b.st[0] = nloc; b.st[1] = nx; }
        const unsigned old = xb_add(&bar[XB_XSUB(b.x)], 1u);
        const unsigned gen = old / nloc;
        if (old + 1u == (gen + 1u) * nloc) {
            __builtin_amdgcn_fence(__ATOMIC_RELEASE, "agent");
            asm volatile("s_waitcnt vmcnt(0)" ::: "memory");
            const unsigned og = xb_add(&bar[XB_TOP], 1u);
            const unsigned tg = og / nx;
            if (og + 1u == (tg + 1u) * nx) xb_add(&bar[XB_TOPGEN], 1u);
            else XB_SPIN(xb_ld(&bar[XB_TOPGEN]) == tg, bar);
            __builtin_amdgcn_fence(__ATOMIC_ACQUIRE, "agent");
            xb_add(&bar[XB_XGEN(b.x)], 1u);
            asm volatile("s_waitcnt vmcnt(0)" ::: "memory");
        } else {
            XB_SPIN(xb_ld(&bar[XB_XGEN(b.x)]) == gen, bar);
            __builtin_amdgcn_fence(__ATOMIC_ACQUIRE, "agent");
            asm volatile("s_waitcnt vmcnt(0)" ::: "memory");
        }
    }
    __syncthreads();
}

struct Args { const float* in[18]; float* out; unsigned char* ws; int ph_lo, ph_hi; };
struct Ctx {
    const float* in[18]; float* out; unsigned char* ws; unsigned char* lds;
    int tid, lane, wave, bid, nb;
};
enum { I_X = 0, I_NSA_WIN, I_NSA_WOUT, I_CK_W1, I_CK_W2, I_CV_W1, I_CV_W2, I_CK_POS, I_CV_POS, I_MOBA_WIN, I_MOBA_WOUT, I_RW, I_RB, I_WG, I_WU, I_WD, I_LNG, I_LNB };

__device__ __forceinline__ int il64(int d) { return d < 32 ? 2 * d : 2 * (d - 32) + 1; }
__device__ __forceinline__ int rowmap(int kind, int n) {
    switch (kind) {
        case 1: { const bool r = (n < 1024) || (n >= 1536 && n < 1792) || (n >= 2048 && n < 2304); return r ? (n & ~63) + il64(n & 63) : n; }
        case 2: return n < 2048 ? (n & ~63) + il64(n & 63) : n;
        case 3: return 2 * n;
        case 4: return 2 * n + 1;
        default: return n;
    }
}
__device__ __forceinline__ void transpose_item(const float* W, int ldw, int ncols, bf16_t* WT, int K, int kb, int nbk, int kind, float* scr, int lane) {
    const int k0 = 64 * kb, n0 = 32 * nbk;
    const int cq = lane & 7, nn = n0 + 4 * cq;
#pragma unroll
    for (int i = 0; i < 8; ++i) { const int kk = 8 * i + (lane >> 3);
        *(f32x4*)(scr + kk * 36 + 4 * cq) = nn < ncols ? *(const f32x4*)(W + (size_t)(k0 + kk) * ldw + nn) : (f32x4){0.f, 0.f, 0.f, 0.f}; }
    WAVE_LDS_SYNC();
    const int c = lane & 7;
#pragma unroll
    for (int j = 0; j < 4; ++j) {
        const int n = (lane >> 3) + 8 * j; const float* s = scr + (8 * c) * 36 + n;
        u32x4 o; o.x = pk2(s[0 * 36], s[1 * 36]); o.y = pk2(s[2 * 36], s[3 * 36]); o.z = pk2(s[4 * 36], s[5 * 36]); o.w = pk2(s[6 * 36], s[7 * 36]);
        *(u32x4*)(WT + (size_t)rowmap(kind, n0 + n) * K + k0 + 8 * c) = o;
    }
    WAVE_LDS_SYNC();
}
constexpr int MOE_W_ITEMS = NE * 768;
__device__ __forceinline__ void moe_weight_item(const Ctx& C, int layer, int r, float* scr) {
    const int e = r / 768; int q = r % 768;
    bf16_t* gu = (bf16_t*)(C.ws + WS_WT_GU) + (size_t)e * 1024 * 1024;
    bf16_t* dn = (bf16_t*)(C.ws + WS_WT_DN) + (size_t)e * 1024 * 512;
    const size_t eo = (size_t)(layer * NE + e);
    if (q < 256) { transpose_item(C.in[I_WG] + eo * DM * DE, DE, DE, gu, DM, q / 16, q % 16, 3, scr, C.lane); return; } q -= 256;
    if (q < 256) { transpose_item(C.in[I_WU] + eo * DM * DE, DE, DE, gu, DM, q / 16, q % 16, 4, scr, C.lane); return; } q -= 256;
    transpose_item(C.in[I_WD] + eo * DE * DM, DM, DM, dn, DE, q / 32, q % 32, 0, scr, C.lane);
}

__device__ __forceinline__ void ph_prologue(const Ctx& C) {
    float* scr = (float*)(C.lds + C.wave * 9216);
    const int gw = C.bid * NWAVES + C.wave, NGW = C.nb * NWAVES;
    constexpr int I_A = 16 * 82, I_B = 16 * 32, I_C = 32 * 8, I_D = 16 * 96, I_E = 16 * 32;
    constexpr int NIT = I_A + I_B + 2 * I_C + I_D + I_E + MOE_W_ITEMS;
    for (int it = gw; it < NIT; it += NGW) {
        int r = it;
        if (r < I_A) { transpose_item(C.in[I_NSA_WIN], NSA_IN, NSA_IN, (bf16_t*)(C.ws + WS_WT_NSA_IN), DM, r / 82, r % 82, 1, scr, C.lane); continue; } r -= I_A;
        if (r < I_B) { transpose_item(C.in[I_NSA_WOUT], DM, DM, (bf16_t*)(C.ws + WS_WT_NSA_OUT), DM, r / 32, r % 32, 0, scr, C.lane); continue; } r -= I_B;
        if (r < I_C) { transpose_item(C.in[I_CK_W1], 256, 256, (bf16_t*)(C.ws + WS_WT_C1K), 2048, r / 8, r % 8, 0, scr, C.lane); continue; } r -= I_C;
        if (r < I_C) { transpose_item(C.in[I_CV_W1], 256, 256, (bf16_t*)(C.ws + WS_WT_C1V), 2048, r / 8, r % 8, 0, scr, C.lane); continue; } r -= I_C;
        if (r < I_D) { transpose_item(C.in[I_MOBA_WIN], 3072, 3072, (bf16_t*)(C.ws + WS_WT_MOBA_IN), DM, r / 96, r % 96, 2, scr, C.lane); continue; } r -= I_D;
        if (r < I_E) { transpose_item(C.in[I_MOBA_WOUT], DM, DM, (bf16_t*)(C.ws + WS_WT_MOBA_OUT), DM, r / 32, r % 32, 0, scr, C.lane); continue; } r -= I_E;
        moe_weight_item(C, 0, r, scr);
    }
    const int gt = C.bid * NTHREADS + C.tid, NGT = C.nb * NTHREADS;
    { u32x4* p = (u32x4*)((bf16_t*)(C.ws + WS_WT_NSA_IN) + (size_t)2624 * DM); const int n = (NSA_INP - 2624) * DM / 8;
      for (int i = gt; i < n; i += NGT) p[i] = (u32x4){0u, 0u, 0u, 0u}; }
    { const f32x4* x4 = (const f32x4*)C.in[I_X]; u32x4* o = (u32x4*)(C.ws + WS_XB); const int n = NTOK * DM / 8;
      for (int i = gt; i < n; i += NGT) { const f32x4 a = x4[2 * i], b = x4[2 * i + 1]; o[i] = (u32x4){pk2(a.x, a.y), pk2(a.z, a.w), pk2(b.x, b.y), pk2(b.z, b.w)}; } }
    { const float INV[32] = {1.000000000e+00f, 7.498942018e-01f, 5.623413324e-01f, 4.216965139e-01f, 3.162277639e-01f, 2.371373922e-01f, 1.778279394e-01f, 1.333521456e-01f,
                             1.000000015e-01f, 7.498941571e-02f, 5.623412877e-02f, 4.216964915e-02f, 3.162277862e-02f, 2.371373586e-02f, 1.778279431e-02f, 1.333521493e-02f,
                             9.999999776e-03f, 7.498942316e-03f, 5.623413250e-03f, 4.216964822e-03f, 3.162277862e-03f, 2.371373819e-03f, 1.778279431e-03f, 1.333521446e-03f,
                             1.000000047e-03f, 7.498941850e-04f, 5.623413017e-04f, 4.216965463e-04f, 3.162277862e-04f, 2.371373848e-04f, 1.778279402e-04f, 1.333521504e-04f};
      float2* tab = (float2*)(C.ws + WS_ROPE);
      for (int i = gt; i < SEQ * 32; i += NGT) {
          const int t = i >> 5, f = i & 31;
          float inv = INV[0];
#pragma unroll
          for (int q = 1; q < 32; ++q) inv = (f == q) ? INV[q] : inv;
          const float ang = (float)t * inv;
          const double a = (double)ang; const double k = __builtin_rint(a * 0.15915494309189535); const float rf = (float)(a - k * 6.283185307179586);
          tab[i] = make_float2(__cosf(rf), __sinf(rf));
      } }
    for (int o = gw; o < 512; o += NGW) {
        const int which = o >> 8, c = o & 255;
        const float* pos = C.in[which ? I_CV_POS : I_CK_POS]; const float* w1 = C.in[which ? I_CV_W1 : I_CK_W1];
        float s = 0.f;
        for (int k = C.lane; k < 2048; k += 64) s += pos[k] * w1[(size_t)k * 256 + c];
        s = wave_sum(s);
        if (C.lane == 0) ((float*)(C.ws + WS_BIAS1))[o] = s;
    }
}

__device__ __forceinline__ void mma_core(const bf16_t* a0, const bf16_t* a1, const bf16_t* b0, const bf16_t* b1, int K, f32x4 (&acc)[2][2]) {
#pragma unroll
    for (int i = 0; i < 2; ++i)
#pragma unroll
        for (int j = 0; j < 2; ++j) acc[i][j] = (f32x4){0.f, 0.f, 0.f, 0.f};
#pragma unroll 4
    for (int k = 0; k < K; k += 32) {
        const bf16x8 A0 = *(const bf16x8*)(a0 + k), A1 = *(const bf16x8*)(a1 + k), B0 = *(const bf16x8*)(b0 + k), B1 = *(const bf16x8*)(b1 + k);
        acc[0][0] = __builtin_amdgcn_mfma_f32_16x16x32_bf16(B0, A0, acc[0][0], 0, 0, 0);
        acc[0][1] = __builtin_amdgcn_mfma_f32_16x16x32_bf16(B1, A0, acc[0][1], 0, 0, 0);
        acc[1][0] = __builtin_amdgcn_mfma_f32_16x16x32_bf16(B0, A1, acc[1][0], 0, 0, 0);
        acc[1][1] = __builtin_amdgcn_mfma_f32_16x16x32_bf16(B1, A1, acc[1][1], 0, 0, 0);
    }
}
namespace g8 {
constexpr int BM = 256, BK = 64, HALF = 128, HTB = HALF * BK * 2, STAGE_BYTES = 8 * HTB, NXCD = 8, WGM = 8;
__device__ __forceinline__ int lds_byte(int r, int c) { const int st = (r >> 4) * 2 + (c >> 5), rr = r & 15, cc = c & 31, ob = rr * 64 + cc * 2; return st * 1024 + (ob ^ (((ob >> 9) & 1) << 5)); }
__device__ __forceinline__ void stage_rc(int b, int& R, int& C) { const int st = b / 1024, sb = b % 1024, swz = sb ^ (((sb >> 9) & 1) << 5); R = (st >> 1) * 16 + swz / 64; C = (st & 1) * 32 + (swz % 64) / 2; }
struct Unit { int pm, pn, bt, e; };
struct StaticOrder {
    int nM, nN, nwg, G, c;
    __device__ void init(int nM_, int nN_, int G_, int c_) { nM = nM_; nN = nN_; nwg = nM * nN; G = G_; c = c_; }
    __device__ bool next(int i, Unit& u) const {
        const long L = (long)i * G + c; if (L >= nwg) return false;
        int wgid = (int)L; { const int q = nwg / NXCD, r = nwg % NXCD, xcd = wgid % NXCD, off = wgid / NXCD; wgid = (xcd < r ? xcd * (q + 1) : r * (q + 1) + (xcd - r) * q) + off; }
        const int nig = WGM * nN, gid = wgid / nig, fm = gid * WGM, gsz = (nM - fm) < WGM ? (nM - fm) : WGM;
        u.pm = fm + ((wgid % nig) % gsz); u.pn = (wgid % nig) / gsz; u.bt = u.pn; u.e = 0; return true;
    }
};
struct GroupedOrder {
    StaticOrder so; const LAS int* sm;
    __device__ void init(const LAS int* sm_, int nN_, int G_, int c_) { sm = sm_; so.init(sm_[32] / BM, nN_, G_, c_); }
    __device__ bool next(int i, Unit& u) const {
        if (!so.next(i, u)) return false;
        const int rowt = u.pm * BM; int e = 0;
#pragma unroll
        for (int q = 1; q < NE; ++q) e = (rowt >= sm[16 + q]) ? q : e;
        u.e = e; u.bt = e * so.nN + u.pn; return true;
    }
};
struct GatherInfo { const int* rowlist; const LAS int* sm; };

__device__ __forceinline__ int perm32(int rho) { const int n = rho >> 4, i = rho & 15; return 8 * (i >> 2) + 4 * n + (i & 3); }
template <bool GATHER, class Epi, class Sched>
__device__ __forceinline__ void gemm8(LAS unsigned char* lds, const bf16_t* A, int lda, const bf16_t* Bt, int K, const Sched& S, const Epi& E, GatherInfo gi) {
    const int tid = threadIdx.x, wid = __builtin_amdgcn_readfirstlane(tid >> 6), lane = tid & 63, wr = wid >> 2, wc = wid & 3, fr = lane & 15, fq = lane >> 4;
    const int nt = K / BK;
    int Rr[2], Cc[2]; unsigned voffB[2]; unsigned vAc[2][2], vAn[2][2];
#pragma unroll
    for (int i = 0; i < 2; ++i) { stage_rc(tid * 16 + i * 8192, Rr[i], Cc[i]); voffB[i] = (unsigned)(((Rr[i] & ~31) + perm32(Rr[i] & 31)) * K + Cc[i]) * 2u;
#pragma unroll
        for (int h = 0; h < 2; ++h) { vAc[h][i] = (unsigned)((Rr[i] + HALF * h) * lda + Cc[i]) * 2u; vAn[h][i] = vAc[h][i]; } }
    const size_t kstep = (size_t)(BK * 2);
    const size_t hstepB = (size_t)HALF * K * 2, tstepB = 2 * hstepB, tstepA = (size_t)BM * lda * 2;
    const unsigned ldsw = (unsigned)wid * 1024u;
    const int aoff = lds_byte(wr * 64 + fr, fq * 8), boff = lds_byte(wc * 32 + fr, fq * 8);
#define G8_SA(b, h) (((b) * 2 + (h)) * HTB)
#define G8_SB(b, h) ((4 + (b) * 2 + (h)) * HTB)
#define G8_STAGEB(bufoff, gbase) do { _Pragma("unroll") for (int _i = 0; _i < 2; ++_i) \
        __builtin_amdgcn_global_load_lds((const unsigned*)((const char*)(gbase) + voffB[_i]), (LAS unsigned*)(lds + (bufoff) + ldsw + _i * 8192), 16, 0, 0); } while (0)
#define G8_STAGEA(bufoff, gbase, v0, v1) do { \
        __builtin_amdgcn_global_load_lds((const unsigned*)((const char*)(gbase) + (v0)), (LAS unsigned*)(lds + (bufoff) + ldsw), 16, 0, 0); \
        __builtin_amdgcn_global_load_lds((const unsigned*)((const char*)(gbase) + (v1)), (LAS unsigned*)(lds + (bufoff) + ldsw + 8192), 16, 0, 0); } while (0)
#define G8_LDA(dst, b, h) do { _Pragma("unroll") for (int m = 0; m < 4; ++m) _Pragma("unroll") for (int k = 0; k < 2; ++k) dst[m][k] = *(const LAS bf16x8*)(lds + G8_SA(b, h) + aoff + m * 2048 + k * 1024); } while (0)
#define G8_LDB(dst, b, h) do { _Pragma("unroll") for (int n = 0; n < 2; ++n) _Pragma("unroll") for (int k = 0; k < 2; ++k) dst[n][k] = *(const LAS bf16x8*)(lds + G8_SB(b, h) + boff + n * 2048 + k * 1024); } while (0)
#define G8_MMA(ai, bj, At, Bt_) do { __builtin_amdgcn_s_setprio(1); _Pragma("unroll") for (int m = 0; m < 4; ++m) _Pragma("unroll") for (int n = 0; n < 2; ++n) _Pragma("unroll") for (int k = 0; k < 2; ++k) \
        acc[ai][bj][m][n] = __builtin_amdgcn_mfma_f32_16x16x32_bf16(Bt_[n][k], At[m][k], acc[ai][bj][m][n], 0, 0, 0); __builtin_amdgcn_s_setprio(0); } while (0)
#define G8_WAIT_V(n) asm volatile("s_waitcnt vmcnt(" #n ")" ::: "memory")
#define G8_WAIT_L(n) asm volatile("s_waitcnt lgkmcnt(" #n ")" ::: "memory")
#define G8_BAR __builtin_amdgcn_s_barrier()
#define G8_SCHED __builtin_amdgcn_sched_barrier(0)
#define G8_GATHER(u, v) do { if (GATHER) { const int _eb = gi.sm[16 + (u).e], _ec = gi.sm[(u).e]; \
        _Pragma("unroll") for (int _h = 0; _h < 2; ++_h) _Pragma("unroll") for (int _i = 0; _i < 2; ++_i) { const int _s = (u).pm * BM + HALF * _h + Rr[_i] - _eb; \
            const int _t = gi.rowlist[(u).e * NTOK + (_s < _ec ? _s : 0)]; v[_h][_i] = (unsigned)(_t * K + Cc[_i]) * 2u; } } } while (0)
    Unit cur, nxt; int ui = 0;
    if (!S.next(0, cur)) return;
    f32x4 acc[2][2][4][2];
#pragma unroll
    for (int a = 0; a < 2; ++a)
#pragma unroll
        for (int b = 0; b < 2; ++b)
#pragma unroll
            for (int m = 0; m < 4; ++m)
#pragma unroll
                for (int n = 0; n < 2; ++n) acc[a][b][m][n] = (f32x4){0.f, 0.f, 0.f, 0.f};
    bf16x8 At[4][2], B0[2][2], B1[2][2];
    G8_GATHER(cur, vAc);
    const char* cA = GATHER ? (const char*)A : (const char*)A + (size_t)cur.pm * tstepA; const char* cB = (const char*)Bt + (size_t)cur.bt * tstepB;
    G8_STAGEB(G8_SB(0, 0), cB); G8_STAGEB(G8_SB(0, 1), cB + hstepB); G8_STAGEA(G8_SA(0, 0), cA, vAc[0][0], vAc[0][1]); G8_STAGEA(G8_SA(0, 1), cA, vAc[1][0], vAc[1][1]);
    if (wr == 1) G8_BAR;
    G8_WAIT_V(2); G8_BAR;
    G8_STAGEB(G8_SB(1, 0), cB + kstep); G8_STAGEA(G8_SA(1, 0), cA + kstep, vAc[0][0], vAc[0][1]); G8_STAGEB(G8_SB(1, 1), cB + hstepB + kstep);
    G8_WAIT_V(6); G8_BAR;
    for (;;) {
        const bool has_next = S.next(ui + 1, nxt);
        if (has_next) G8_GATHER(nxt, vAn);
        const char* nA = has_next ? (GATHER ? (const char*)A : (const char*)A + (size_t)nxt.pm * tstepA) : cA; const char* nB = has_next ? (const char*)Bt + (size_t)nxt.bt * tstepB : cB;
        for (int t = 0; t < nt; t += 2) {
            const bool last = (t == nt - 2);
            const char* a1 = cA + (size_t)(t + 1) * kstep;
            const char* a2 = last ? nA : cA + (size_t)(t + 2) * kstep; const char* b2 = last ? nB : cB + (size_t)(t + 2) * kstep;
            const char* a3 = a2 + kstep; const char* b3 = b2 + kstep;
            const bool usen = GATHER && last && has_next;
            const unsigned w00 = usen ? vAn[0][0] : vAc[0][0], w01 = usen ? vAn[0][1] : vAc[0][1], w10 = usen ? vAn[1][0] : vAc[1][0], w11 = usen ? vAn[1][1] : vAc[1][1];
            G8_LDB(B0, 0, 0); G8_LDB(B1, 0, 1); G8_SCHED; G8_LDA(At, 0, 0); G8_STAGEA(G8_SA(1, 1), a1, vAc[1][0], vAc[1][1]);
            G8_WAIT_V(8); G8_WAIT_L(0); G8_BAR; G8_MMA(0, 0, At, B0); G8_MMA(0, 1, At, B1); G8_BAR; G8_SCHED;
            G8_LDA(At, 0, 1); G8_STAGEB(G8_SB(0, 0), b2); G8_STAGEB(G8_SB(0, 1), b2 + hstepB); G8_STAGEA(G8_SA(0, 0), a2, w00, w01);
            G8_WAIT_V(8); G8_WAIT_L(0); G8_BAR; G8_MMA(1, 0, At, B0); G8_MMA(1, 1, At, B1); G8_BAR; G8_SCHED;
            G8_LDB(B0, 1, 0); G8_LDB(B1, 1, 1); G8_SCHED; G8_LDA(At, 1, 0); G8_STAGEA(G8_SA(0, 1), a2, w10, w11);
            G8_WAIT_V(8); G8_WAIT_L(0); G8_BAR; G8_MMA(0, 0, At, B0); G8_MMA(0, 1, At, B1); G8_BAR; G8_SCHED;
            G8_LDA(At, 1, 1); G8_STAGEB(G8_SB(1, 0), b3); G8_STAGEB(G8_SB(1, 1), b3 + hstepB); G8_STAGEA(G8_SA(1, 0), a3, w00, w01);
            G8_WAIT_V(8); G8_WAIT_L(0); G8_BAR; G8_MMA(1, 0, At, B0); G8_MMA(1, 1, At, B1); G8_BAR; G8_SCHED;
        }
        if (wr == 0) G8_BAR;
        E(acc, cur, wr, wc, fr, fq);
        if (!has_next) break;
#pragma unroll
        for (int a = 0; a < 2; ++a)
#pragma unroll
            for (int b = 0; b < 2; ++b)
#pragma unroll
                for (int m = 0; m < 4; ++m)
#pragma unroll
                    for (int n = 0; n < 2; ++n) acc[a][b][m][n] = (f32x4){0.f, 0.f, 0.f, 0.f};
        cur = nxt; cA = nA; cB = nB; ++ui;
#pragma unroll
        for (int h = 0; h < 2; ++h)
#pragma unroll
            for (int i = 0; i < 2; ++i) vAc[h][i] = vAn[h][i];
        if (wr == 1) G8_BAR;
    }
    G8_WAIT_V(0);
    G8_BAR;
#undef G8_SA
#undef G8_SB
#undef G8_STAGEA
#undef G8_STAGEB
#undef G8_LDA
#undef G8_LDB
#undef G8_MMA
#undef G8_WAIT_V
#undef G8_WAIT_L
#undef G8_BAR
#undef G8_SCHED
#undef G8_GATHER
}
template <class F> struct EpiEl {
    F f;
    __device__ __forceinline__ void operator()(const f32x4 (&acc)[2][2][4][2], const Unit& u, int wr, int wc, int fr, int fq) const {
#pragma unroll
        for (int ai = 0; ai < 2; ++ai)
#pragma unroll
            for (int m = 0; m < 4; ++m) { const int row = u.pm * BM + ai * HALF + wr * 64 + m * 16 + fr;
#pragma unroll
                for (int bj = 0; bj < 2; ++bj) f(row, u.pn * BM + bj * HALF + wc * 32 + 8 * fq, acc[ai][bj][m][0], acc[ai][bj][m][1]); }
    }
};
}

struct EpiNsaIn {
    bf16_t* Q; bf16_t* KV; float* gates; const float2* rope;
    __device__ __forceinline__ void operator()(int row, int c, f32x4 v) const {
        const int t = row & (SEQ - 1), b = row >> 13;
        if (c < 1024) {
            v = v * QSCALE;
            const int d = (c & 63) >> 1; const float2 c0 = rope[t * 32 + d], c1 = rope[t * 32 + d + 1];
            bf16_t* p = Q + (size_t)row * DM + (c & ~63);
            *(unsigned*)(p + d) = pk2(v[0] * c0.x - v[1] * c0.y, v[2] * c1.x - v[3] * c1.y);
            *(unsigned*)(p + d + 32) = pk2(v[1] * c0.x + v[0] * c0.y, v[3] * c1.x + v[2] * c1.y);
        } else if (c < 2560) {
            const int s = (c - 1024) >> 8, g = ((c - 1024) >> 6) & 3;
            bf16_t* p = KV + (size_t)s * (KVSEG / 2) + ((size_t)(b * NG + g) * SEQ + t) * DH;
            if (s == 2 || s == 4) {
                const int d = (c & 63) >> 1; const float2 c0 = rope[t * 32 + d], c1 = rope[t * 32 + d + 1];
                *(unsigned*)(p + d) = pk2(v[0] * c0.x - v[1] * c0.y, v[2] * c1.x - v[3] * c1.y);
                *(unsigned*)(p + d + 32) = pk2(v[1] * c0.x + v[0] * c0.y, v[3] * c1.x + v[2] * c1.y);
            } else {
                *(u32x2*)(p + (c & 63)) = (u32x2){pk2(v[0], v[1]), pk2(v[2], v[3])};
            }
        } else if (c < NSA_IN) {
            float* gp = gates + (size_t)row * 48 + (c - 2560);
            *(f32x4*)gp = (f32x4){sigmoidf_(v[0]), sigmoidf_(v[1]), sigmoidf_(v[2]), sigmoidf_(v[3])};
        }
    }
    __device__ __forceinline__ void operator()(int row, int c, f32x4 v, f32x4 w) const {
        const int t = row & (SEQ - 1), b = row >> 13;
        const int s = (c - 1024) >> 8;
        const bool isq = c < 1024, roped = isq || s == 2 || s == 4;
        if (roped) {
            if (isq) { v = v * QSCALE; w = w * QSCALE; }
            const int g = ((c - 1024) >> 6) & 3, d = (c & 63) >> 1;
            bf16_t* p = isq ? Q + (size_t)row * DM + (c & ~63) : KV + (size_t)s * (KVSEG / 2) + ((size_t)(b * NG + g) * SEQ + t) * DH;
            const f32x4 cs01 = *(const f32x4*)(rope + t * 32 + d), cs23 = *(const f32x4*)(rope + t * 32 + d + 2);
            *(u32x2*)(p + d) = (u32x2){pk2(v[0] * cs01[0] - v[1] * cs01[1], v[2] * cs01[2] - v[3] * cs01[3]), pk2(w[0] * cs23[0] - w[1] * cs23[1], w[2] * cs23[2] - w[3] * cs23[3])};
            *(u32x2*)(p + d + 32) = (u32x2){pk2(v[1] * cs01[0] + v[0] * cs01[1], v[3] * cs01[2] + v[2] * cs01[3]), pk2(w[1] * cs23[0] + w[0] * cs23[1], w[3] * cs23[2] + w[2] * cs23[3])};
        } else {
            const int g = ((c - 1024) >> 6) & 3;
            bf16_t* p = KV + (size_t)s * (KVSEG / 2) + ((size_t)(b * NG + g) * SEQ + t) * DH + (c & 63);
            *(u32x4*)p = (u32x4){pk2(v[0], v[1]), pk2(v[2], v[3]), pk2(w[0], w[1]), pk2(w[2], w[3])};
        }
    }
};
struct EpiMobaIn {
    bf16_t* Q; bf16_t* K; bf16_t* V; const float2* rope;
    __device__ __forceinline__ void operator()(int row, int c, f32x4 v) const {
        const int t = row & (SEQ - 1), b = row >> 13;
        if (c < 2048) {
            if (c < 1024) v = v * QSCALE;
            const int d = (c & 63) >> 1; const float2 c0 = rope[t * 32 + d], c1 = rope[t * 32 + d + 1];
            bf16_t* p = c < 1024 ? Q + (size_t)row * DM + (c & ~63) : K + ((size_t)(b * NH + ((c - 1024) >> 6)) * SEQ + t) * DH;
            *(unsigned*)(p + d) = pk2(v[0] * c0.x - v[1] * c0.y, v[2] * c1.x - v[3] * c1.y);
            *(unsigned*)(p + d + 32) = pk2(v[1] * c0.x + v[0] * c0.y, v[3] * c1.x + v[2] * c1.y);
        } else {
            bf16_t* p = V + ((size_t)(b * NH + ((c - 2048) >> 6)) * SEQ + t) * DH + (c & 63);
            *(u32x2*)p = (u32x2){pk2(v[0], v[1]), pk2(v[2], v[3])};
        }
    }
    __device__ __forceinline__ void operator()(int row, int c, f32x4 v, f32x4 w) const {
        const int t = row & (SEQ - 1), b = row >> 13;
        if (c < 2048) {
            if (c < 1024) { v = v * QSCALE; w = w * QSCALE; }
            const int d = (c & 63) >> 1;
            bf16_t* p = c < 1024 ? Q + (size_t)row * DM + (c & ~63) : K + ((size_t)(b * NH + ((c - 1024) >> 6)) * SEQ + t) * DH;
            const f32x4 cs01 = *(const f32x4*)(rope + t * 32 + d), cs23 = *(const f32x4*)(rope + t * 32 + d + 2);
            *(u32x2*)(p + d) = (u32x2){pk2(v[0] * cs01[0] - v[1] * cs01[1], v[2] * cs01[2] - v[3] * cs01[3]), pk2(w[0] * cs23[0] - w[1] * cs23[1], w[2] * cs23[2] - w[3] * cs23[3])};
            *(u32x2*)(p + d + 32) = (u32x2){pk2(v[1] * cs01[0] + v[0] * cs01[1], v[3] * cs01[2] + v[2] * cs01[3]), pk2(w[1] * cs23[0] + w[0] * cs23[1], w[3] * cs23[2] + w[2] * cs23[3])};
        } else {
            bf16_t* p = V + ((size_t)(b * NH + ((c - 2048) >> 6)) * SEQ + t) * DH + (c & 63);
            *(u32x4*)p = (u32x4){pk2(v[0], v[1]), pk2(v[2], v[3]), pk2(w[0], w[1]), pk2(w[2], w[3])};
        }
    }
};
struct EpiGelu {
    bf16_t* O; const float* bias;
    __device__ __forceinline__ void operator()(int row, int c, f32x4 v) const {
        const f32x4 bv = *(const f32x4*)(bias + c);
        *(u32x2*)(O + (size_t)row * 256 + c) = (u32x2){pk2(gelu_tanh(v[0] + bv[0]), gelu_tanh(v[1] + bv[1])), pk2(gelu_tanh(v[2] + bv[2]), gelu_tanh(v[3] + bv[3]))};
    }
    __device__ __forceinline__ void operator()(int row, int c, f32x4 v, f32x4 w) const {
        const f32x4 bv = *(const f32x4*)(bias + c), bw = *(const f32x4*)(bias + c + 4);
        *(u32x4*)(O + (size_t)row * 256 + c) = (u32x4){pk2(gelu_tanh(v[0] + bv[0]), gelu_tanh(v[1] + bv[1])), pk2(gelu_tanh(v[2] + bv[2]), gelu_tanh(v[3] + bv[3])),
                                                      pk2(gelu_tanh(w[0] + bw[0]), gelu_tanh(w[1] + bw[1])), pk2(gelu_tanh(w[2] + bw[2]), gelu_tanh(w[3] + bw[3]))};
    }
};
struct EpiSwiGLU {
    bf16_t* H;
    __device__ __forceinline__ void operator()(int row, int c, f32x4 v) const {
        const float h0 = v[0] * sigmoidf_(v[0]) * v[1], h1 = v[2] * sigmoidf_(v[2]) * v[3];
        *(unsigned*)(H + (size_t)row * DE + (c >> 1)) = pk2(h0, h1);
    }
    __device__ __forceinline__ void operator()(int row, int c, f32x4 v, f32x4 w) const {
        *(u32x2*)(H + (size_t)row * DE + (c >> 1)) = (u32x2){pk2(v[0] * sigmoidf_(v[0]) * v[1], v[2] * sigmoidf_(v[2]) * v[3]), pk2(w[0] * sigmoidf_(w[0]) * w[1], w[2] * sigmoidf_(w[2]) * w[3])};
    }
};
struct EpiBf16 {
    bf16_t* Y;
    __device__ __forceinline__ void operator()(int row, int c, f32x4 v) const { *(u32x2*)(Y + (size_t)row * DM + c) = (u32x2){pk2(v[0], v[1]), pk2(v[2], v[3])}; }
    __device__ __forceinline__ void operator()(int row, int c, f32x4 v, f32x4 w) const { *(u32x4*)(Y + (size_t)row * DM + c) = (u32x4){pk2(v[0], v[1]), pk2(v[2], v[3]), pk2(w[0], w[1]), pk2(w[2], w[3])}; }
};

struct ExpertMap { int cnt[NE]; int base[NE + 1]; };
__device__ __forceinline__ void load_expert_map(const Ctx& C, int cw, LAS int* sm  ) {
    if (C.tid == 0) {
        const unsigned* ctl = (const unsigned*)(C.ws + WS_CTL); int acc = 0;
        for (int e = 0; e < NE; ++e) { const int c = (int)__hip_atomic_load(ctl + cw + 64 * e, __ATOMIC_RELAXED, __HIP_MEMORY_SCOPE_AGENT); sm[e] = c; sm[16 + e] = acc; acc += (c + 255) & ~255; }
        sm[32] = acc;
    }
    __syncthreads();
}

__device__ __forceinline__ void ph_cmp2(const Ctx& C) {
    const int gt = C.bid * NTHREADS + C.tid, NGT = C.nb * NTHREADS;
    const float2* rope = (const float2*)(C.ws + WS_ROPE);
    for (int i = gt; i < 2 * 8192 * 32; i += NGT) {
        const int which = i >= 8192 * 32; const int j = i - which * 8192 * 32; const int r = j >> 5, d = j & 31, ci = r & 511;
        const bf16_t* h = (const bf16_t*)(C.ws + (which ? WS_H1V : WS_H1K)) + (size_t)r * 256;
        const float* w2 = C.in[which ? I_CV_W2 : I_CK_W2];
        float s0 = 0.f, s1 = 0.f;
        for (int k = 0; k < 256; ++k) { const float hv = bf2f(h[k]); s0 += hv * w2[k * 64 + d]; s1 += hv * w2[k * 64 + d + 32]; }
        bf16_t* o = (bf16_t*)(C.ws + (which ? WS_VC : WS_KC)) + (size_t)r * 64;
        if (ci == 511) { s0 = 0.f; s1 = 0.f; }
        else if (!which) { const float2 cs = rope[(16 * ci + 31) * 32 + d]; const float a = s0 * cs.x - s1 * cs.y, b2 = s1 * cs.x + s0 * cs.y; s0 = a; s1 = b2; }
        o[d] = (bf16_t)f2bf(s0); o[d + 32] = (bf16_t)f2bf(s1);
    }
}

__device__ __forceinline__ void load_qh(const bf16_t* qp, float (&qh)[64]) {
    const uint4* q4 = (const uint4*)qp;
#pragma unroll
    for (int c = 0; c < 8; ++c) { const uint4 w = q4[c]; qh[8 * c] = bflo(w.x); qh[8 * c + 1] = bfhi(w.x); qh[8 * c + 2] = bflo(w.y); qh[8 * c + 3] = bfhi(w.y);
        qh[8 * c + 4] = bflo(w.z); qh[8 * c + 5] = bfhi(w.z); qh[8 * c + 6] = bflo(w.w); qh[8 * c + 7] = bfhi(w.w); }
}
namespace fa {
constexpr int SLOT = 16384, NSLOT = 4;
constexpr float C2 = 0.125f * 1.4426950408889634f;
constexpr float NEGBIG = -1e30f;
typedef short v4i16 __attribute__((ext_vector_type(4)));
__device__ __forceinline__ void dma_block(LAS unsigned char* slot, const bf16_t* Kg, const bf16_t* Vg, int wave, int lane) {
    { const int key = 8 * wave + (lane >> 3), c = (lane & 7) ^ ((key >> 1) & 7);
      __builtin_amdgcn_global_load_lds((const unsigned*)(Kg + key * 64 + 8 * c), (LAS unsigned*)(slot + wave * 1024), 16, 0, 0); }
    { const int key = 16 * (wave & 3) + (lane >> 2), cp = lane & 3, d = (wave >> 2) * 32 + ((((cp >> 1) ^ ((key >> 2) & 1))) << 4) + ((cp & 1) << 3);
      __builtin_amdgcn_global_load_lds((const unsigned*)(Vg + key * 64 + d), (LAS unsigned*)(slot + 8192 + wave * 1024), 16, 0, 0); }
}
__device__ __forceinline__ unsigned cvt_pk_bf16(float lo, float hi) { const f32x2v v = {lo, hi}; const bf16x2v b = __builtin_convertvector(v, bf16x2v); return __builtin_bit_cast(unsigned, b); }
struct Task { bf16x8 q[2]; int kmin, kmax; float m, l, cinit; f32x4 O[4]; f32x4 L; unsigned fw0; const LAS unsigned* fwp; int imptok; };
template <int FM> __device__ __forceinline__ bool row_flag(const Task& t, int jb) {
    if (FM == 0) return true;
    if (FM == 1) { const unsigned w = t.fwp[jb >> 5]; return ((w >> (jb & 31)) & 1u) != 0u; }
    return ((t.fw0 >> (jb >> 2)) & 1u) != 0u;
}
struct LaneC { int fq, koff0, koff1, voffA, voffB; };
__device__ __forceinline__ LaneC lane_consts(int lane) {
    const int i16 = lane & 15, fq = lane >> 4, kx = (i16 >> 1) & 7, q4 = i16 >> 2, p4 = lane & 3;
    LaneC lc; lc.fq = fq; lc.koff0 = i16 * 128 + ((fq ^ kx) << 4); lc.koff1 = i16 * 128 + (((4 + fq) ^ kx) << 4);
    lc.voffA = 8192 + (4 * fq + q4) * 64 + ((0 ^ (fq & 1)) << 5) + 8 * p4; lc.voffB = 8192 + (4 * fq + q4) * 64 + ((1 ^ (fq & 1)) << 5) + 8 * p4;
    return lc;
}
__device__ __forceinline__ float xrow16_max(float x) {
    auto s = __builtin_amdgcn_permlane16_swap(__float_as_uint(x), __float_as_uint(x), false, false);
    x = fmaxf(__uint_as_float(s[0]), __uint_as_float(s[1]));
    auto t = __builtin_amdgcn_permlane32_swap(__float_as_uint(x), __float_as_uint(x), false, false);
    return fmaxf(__uint_as_float(t[0]), __uint_as_float(t[1]));
}
__device__ __forceinline__ float xrow16_sum(float x) {
    auto s = __builtin_amdgcn_permlane16_swap(__float_as_uint(x), __float_as_uint(x), false, false);
    x = __uint_as_float(s[0]) + __uint_as_float(s[1]);
    auto t = __builtin_amdgcn_permlane32_swap(__float_as_uint(x), __float_as_uint(x), false, false);
    return __uint_as_float(t[0]) + __uint_as_float(t[1]);
}
__device__ __forceinline__ void t_mask(const Task& t, f32x4 (&s)[4], int kb, int fq) {
#pragma unroll
    for (int kt = 0; kt < 4; ++kt)
#pragma unroll
        for (int r = 0; r < 4; ++r) { const int key = kb + 16 * kt + 4 * fq + r; s[kt][r] = (key >= t.kmin && key <= t.kmax) ? s[kt][r] : NEGBIG; }
}
template <int MODE> __device__ __forceinline__ float t_stats(Task& t, f32x4 (&s)[4], bool rf) {
    float bm = fmaxf(fmaxf(fmaxf(s[0][0], s[0][1]), fmaxf(s[0][2], s[0][3])), fmaxf(fmaxf(s[1][0], s[1][1]), fmaxf(s[1][2], s[1][3])));
    bm = fmaxf(bm, fmaxf(fmaxf(fmaxf(s[2][0], s[2][1]), fmaxf(s[2][2], s[2][3])), fmaxf(fmaxf(s[3][0], s[3][1]), fmaxf(s[3][2], s[3][3]))));
    bm = xrow16_max(bm);
    if (!rf) bm = NEGBIG;
    const float mnew = fmaxf(t.m, bm);
    const float alpha = __builtin_amdgcn_exp2f(t.m - mnew);
    t.m = mnew;
    const float msub = (rf && mnew > -1e29f) ? mnew : __builtin_inff();
#pragma unroll
    for (int kt = 0; kt < 4; ++kt) s[kt] = s[kt] - msub;
    if (MODE == 1) t.l *= alpha;
    return alpha;
}
__device__ __forceinline__ void t_exp(f32x4 (&s)[4]) {
#pragma unroll
    for (int kt = 0; kt < 4; ++kt)
#pragma unroll
        for (int r = 0; r < 4; ++r) s[kt][r] = __builtin_amdgcn_exp2f(s[kt][r]);
}
__device__ __forceinline__ float quad_sum(float x) {
    x += __builtin_bit_cast(float, __builtin_amdgcn_mov_dpp(__builtin_bit_cast(int, x), 0xB1, 0xf, 0xf, true));
    x += __builtin_bit_cast(float, __builtin_amdgcn_mov_dpp(__builtin_bit_cast(int, x), 0x4E, 0xf, 0xf, true));
    return x;
}
__device__ __forceinline__ void t_imp(const Task& t, const f32x4 (&s)[4], int kb, int fq, LAS float* impbase) {
    float ga[4], gb[4];
#pragma unroll
    for (int kt = 0; kt < 4; ++kt) { ga[kt] = quad_sum((s[kt][0] + s[kt][1]) + (s[kt][2] + s[kt][3])); gb[kt] = quad_sum(s[kt][3]); }
    if ((t.imptok & 0x10000) == 0) return;
    LAS float* ip = impbase + (t.imptok & 0xffff) * 130 + (kb >> 2) + fq;
#pragma unroll
    for (int kt = 0; kt < 4; ++kt) { ip[4 * kt] = ga[kt]; ip[64 * 130 + 4 * kt] = gb[kt]; }
}
__device__ __forceinline__ bf16x8 t_pack(const f32x4 (&s)[4], int u) {
    u32x4 pw; pw.x = cvt_pk_bf16(s[2 * u][0], s[2 * u][1]); pw.y = cvt_pk_bf16(s[2 * u][2], s[2 * u][3]); pw.z = cvt_pk_bf16(s[2 * u + 1][0], s[2 * u + 1][1]); pw.w = cvt_pk_bf16(s[2 * u + 1][2], s[2 * u + 1][3]);
    return __builtin_bit_cast(bf16x8, pw);
}
template <int MODE, bool DA, bool DB>
__device__ __forceinline__ void do_blk(Task& a, Task& b, bool rfa, bool rfb, bool masked, LAS unsigned char* slot, int kb, LAS float* impbase, const LaneC& lc) {
    f32x4 sa[4], sb[4];
    const float xa = (MODE >= 2) ? (rfa ? a.cinit : -__builtin_inff()) : 0.f, xb = (MODE >= 2) ? (rfb ? b.cinit : -__builtin_inff()) : 0.f;
    const f32x4 ca = (f32x4){xa, xa, xa, xa}, cb = (f32x4){xb, xb, xb, xb};
#pragma unroll
    for (int kt = 0; kt < 4; ++kt) {
        const bf16x8 k0 = *(const LAS bf16x8*)(slot + lc.koff0 + kt * 2048), k1 = *(const LAS bf16x8*)(slot + lc.koff1 + kt * 2048);
        if (DA) { sa[kt] = __builtin_amdgcn_mfma_f32_16x16x32_bf16(k0, a.q[0], ca, 0, 0, 0); sa[kt] = __builtin_amdgcn_mfma_f32_16x16x32_bf16(k1, a.q[1], sa[kt], 0, 0, 0); }
        if (DB) { sb[kt] = __builtin_amdgcn_mfma_f32_16x16x32_bf16(k0, b.q[0], cb, 0, 0, 0); sb[kt] = __builtin_amdgcn_mfma_f32_16x16x32_bf16(k1, b.q[1], sb[kt], 0, 0, 0); }
    }
    if (masked) { if (DA) t_mask(a, sa, kb, lc.fq); if (DB) t_mask(b, sb, kb, lc.fq); }
    if (MODE < 2) {
        float ala = 1.0f, alb = 1.0f;
        if (DA) ala = t_stats<MODE>(a, sa, rfa);
        if (DB) alb = t_stats<MODE>(b, sb, rfb);
        if (MODE == 0) {
            if (__ballot((DA && ala != 1.0f) || (DB && alb != 1.0f)) != 0ull) {
#pragma unroll
                for (int dt = 0; dt < 4; ++dt) { if (DA) a.O[dt] = a.O[dt] * ala; if (DB) b.O[dt] = b.O[dt] * alb; }
                if (DA) a.L = a.L * ala; if (DB) b.L = b.L * alb;
            }
        }
    }
    if (DA) t_exp(sa);
    if (DB) t_exp(sb);
    if (MODE == 1) {
        if (DA) a.l += ((sa[0][0] + sa[0][1]) + (sa[0][2] + sa[0][3])) + ((sa[1][0] + sa[1][1]) + (sa[1][2] + sa[1][3])) + ((sa[2][0] + sa[2][1]) + (sa[2][2] + sa[2][3])) + ((sa[3][0] + sa[3][1]) + (sa[3][2] + sa[3][3]));
        if (DB) b.l += ((sb[0][0] + sb[0][1]) + (sb[0][2] + sb[0][3])) + ((sb[1][0] + sb[1][1]) + (sb[1][2] + sb[1][3])) + ((sb[2][0] + sb[2][1]) + (sb[2][2] + sb[2][3])) + ((sb[3][0] + sb[3][1]) + (sb[3][2] + sb[3][3]));
    }
    if (MODE == 2) { if (DA) t_imp(a, sa, kb, lc.fq, impbase); if (DB) t_imp(b, sb, kb, lc.fq, impbase); }
    if (MODE != 1) {
        const bf16x8 ones = (bf16x8){0x3F80, 0x3F80, 0x3F80, 0x3F80, 0x3F80, 0x3F80, 0x3F80, 0x3F80};
#pragma unroll
        for (int u = 0; u < 2; ++u) {
            bf16x8 pa, pb; if (DA) pa = t_pack(sa, u); if (DB) pb = t_pack(sb, u);
            if (MODE != 2) { if (DA) a.L = __builtin_amdgcn_mfma_f32_16x16x32_bf16(ones, pa, a.L, 0, 0, 0); if (DB) b.L = __builtin_amdgcn_mfma_f32_16x16x32_bf16(ones, pb, b.L, 0, 0, 0); }
#pragma unroll
            for (int dt = 0; dt < 4; ++dt) {
                const int vo = ((dt & 1) ? lc.voffB : lc.voffA) + (dt >> 1) * 4096 + u * 2048;
                const v4i16 a0 = __builtin_amdgcn_ds_read_tr16_b64_v4i16((LAS v4i16*)(slot + vo)), a1 = __builtin_amdgcn_ds_read_tr16_b64_v4i16((LAS v4i16*)(slot + vo + 1024));
                const bf16x8 vf = (bf16x8){a0[0], a0[1], a0[2], a0[3], a1[0], a1[1], a1[2], a1[3]};
                if (DA) a.O[dt] = __builtin_amdgcn_mfma_f32_16x16x32_bf16(vf, pa, a.O[dt], 0, 0, 0);
                if (DB) b.O[dt] = __builtin_amdgcn_mfma_f32_16x16x32_bf16(vf, pb, b.O[dt], 0, 0, 0);
            }
        }
    }
}
template <int MODE, int FM>
__device__ __forceinline__ void flash_loop(LAS unsigned char* ring, const bf16_t* Kg, const bf16_t* Vg, int nblk, Task& Ta, Task& Tb, LAS float* impbase, int wave, int lane) {
    const int i16 = lane & 15, fq = lane >> 4;
    const int kx = (i16 >> 1) & 7;
    const int q4 = i16 >> 2, p4 = lane & 3;
    LaneC lc; lc.fq = fq; lc.koff0 = i16 * 128 + ((fq ^ kx) << 4); lc.koff1 = i16 * 128 + (((4 + fq) ^ kx) << 4);
    lc.voffA = 8192 + (4 * fq + q4) * 64 + ((0 ^ (fq & 1)) << 5) + 8 * p4; lc.voffB = 8192 + (4 * fq + q4) * 64 + ((1 ^ (fq & 1)) << 5) + 8 * p4;
    const int amin = __builtin_amdgcn_readlane(Ta.kmin, 15), amax = __builtin_amdgcn_readlane(Ta.kmax, 0), bmin = __builtin_amdgcn_readlane(Tb.kmin, 15), bmax = __builtin_amdgcn_readlane(Tb.kmax, 0);
#pragma unroll
    for (int j = 0; j < NSLOT - 1; ++j) { const int jj = j < nblk ? j : nblk - 1; dma_block(ring + j * SLOT, Kg + (size_t)jj * 4096, Vg + (size_t)jj * 4096, wave, lane); }
    for (int jb = 0; jb < nblk; ++jb) {
        asm volatile("s_waitcnt vmcnt(4) lgkmcnt(0)\n\ts_barrier" ::: "memory");
        { const int jn = jb + 3 < nblk ? jb + 3 : nblk - 1; dma_block(ring + ((jb + 3) & 3) * SLOT, Kg + (size_t)jn * 4096, Vg + (size_t)jn * 4096, wave, lane); }
        LAS unsigned char* slot = ring + (jb & 3) * SLOT;
        const int kb = jb * 64;
        const bool rfa = row_flag<FM>(Ta, jb), rfb = row_flag<FM>(Tb, jb);
        const bool na = __ballot(rfa && Ta.kmax >= kb && Ta.kmin <= kb + 63) != 0ull, nb2 = __ballot(rfb && Tb.kmax >= kb && Tb.kmin <= kb + 63) != 0ull;
        const bool masked = !((!na || (kb >= amin && kb + 63 <= amax)) && (!nb2 || (kb >= bmin && kb + 63 <= bmax)));
        if (FM == 1) {
            if (na) do_blk<MODE, true, false>(Ta, Tb, rfa, rfb, masked, slot, kb, impbase, lc);
            if (nb2) do_blk<MODE, false, true>(Ta, Tb, rfa, rfb, masked, slot, kb, impbase, lc);
        } else {
            if (na || nb2) do_blk<MODE, true, true>(Ta, Tb, rfa, rfb, masked, slot, kb, impbase, lc);
        }
    }
    asm volatile("s_waitcnt vmcnt(0) lgkmcnt(0)\n\ts_barrier" ::: "memory");
}
template <int MODE, int FM>
__device__ __forceinline__ void flash_loop2(LAS unsigned char* ring, const bf16_t* Kg, const bf16_t* Vg, int nblk, Task& Ta, Task& Tb, LAS float* impbase, int wave, int lane) {
    const int i16 = lane & 15, fq = lane >> 4;
    const int kx = (i16 >> 1) & 7;
    const int q4 = i16 >> 2, p4 = lane & 3;
    LaneC lc; lc.fq = fq; lc.koff0 = i16 * 128 + ((fq ^ kx) << 4); lc.koff1 = i16 * 128 + (((4 + fq) ^ kx) << 4);
    lc.voffA = 8192 + (4 * fq + q4) * 64 + ((0 ^ (fq & 1)) << 5) + 8 * p4; lc.voffB = 8192 + (4 * fq + q4) * 64 + ((1 ^ (fq & 1)) << 5) + 8 * p4;
    const int amin = __builtin_amdgcn_readlane(Ta.kmin, 15), amax = __builtin_amdgcn_readlane(Ta.kmax, 0), bmin = __builtin_amdgcn_readlane(Tb.kmin, 15), bmax = __builtin_amdgcn_readlane(Tb.kmax, 0);
    const int nit = (nblk + 1) >> 1;
#pragma unroll
    for (int j = 0; j < 2; ++j) { const int jj = j < nblk ? j : nblk - 1; dma_block(ring + j * SLOT, Kg + (size_t)jj * 4096, Vg + (size_t)jj * 4096, wave, lane); }
    for (int i = 0; i < nit; ++i) {
        asm volatile("s_waitcnt vmcnt(0) lgkmcnt(0)\n\ts_barrier" ::: "memory");
#pragma unroll
        for (int j = 0; j < 2; ++j) { const int jn = 2 * i + 2 + j < nblk ? 2 * i + 2 + j : nblk - 1; dma_block(ring + ((2 * i + 2 + j) & 3) * SLOT, Kg + (size_t)jn * 4096, Vg + (size_t)jn * 4096, wave, lane); }
        if (FM == 1 && !SEL_FUSED) {
#pragma unroll
        for (int k = 0; k < 2; ++k) {
            const int jb = 2 * i + k;
            if (jb < nblk) {
                LAS unsigned char* slot = ring + (jb & 3) * SLOT;
                const int kb = jb * 64;
                const bool rfa = row_flag<FM>(Ta, jb), rfb = row_flag<FM>(Tb, jb);
                const bool na = __ballot(rfa && Ta.kmax >= kb && Ta.kmin <= kb + 63) != 0ull, nb2 = __ballot(rfb && Tb.kmax >= kb && Tb.kmin <= kb + 63) != 0ull;
                const bool masked = !((!na || (kb >= amin && kb + 63 <= amax)) && (!nb2 || (kb >= bmin && kb + 63 <= bmax)));
                if (na) do_blk<MODE, true, false>(Ta, Tb, rfa, rfb, masked, slot, kb, impbase, lc);
                if (nb2) do_blk<MODE, false, true>(Ta, Tb, rfa, rfb, masked, slot, kb, impbase, lc);
            }
        }
        } else {
            const int j0 = 2 * i, j1 = 2 * i + 1;
            const bool ra0 = row_flag<FM>(Ta, j0), rb0 = row_flag<FM>(Tb, j0), ra1 = j1 < nblk && row_flag<FM>(Ta, j1), rb1 = j1 < nblk && row_flag<FM>(Tb, j1);
            if (__ballot(ra0 || rb0 || ra1 || rb1) != 0ull) {
                const int k0 = j0 * 64, k1 = j1 * 64;
                const bool mk = (FM == 0) && !(k0 >= amin && k1 + 63 <= amax && k0 >= bmin && k1 + 63 <= bmax);
                if (!mk) {
                    do_blk<MODE, true, true>(Ta, Tb, ra0, rb0, false, ring + (j0 & 3) * SLOT, k0, impbase, lc);
                    if (FM != 2) __builtin_amdgcn_sched_barrier(0);
                    do_blk<MODE, true, true>(Ta, Tb, ra1, rb1, false, ring + (j1 & 3) * SLOT, k1, impbase, lc);
                } else {
                    do_blk<MODE, true, true>(Ta, Tb, ra0, rb0, true, ring + (j0 & 3) * SLOT, k0, impbase, lc);
                    __builtin_amdgcn_sched_barrier(0);
                    do_blk<MODE, true, true>(Ta, Tb, ra1, rb1, true, ring + (j1 & 3) * SLOT, k1, impbase, lc);
                }
            }
        }
    }
    asm volatile("s_waitcnt vmcnt(0) lgkmcnt(0)\n\ts_barrier" ::: "memory");
}
__device__ __forceinline__ void task_reset(Task& t) { t.m = NEGBIG; t.l = 0.f; t.cinit = 0.f; t.L = (f32x4){0.f, 0.f, 0.f, 0.f};
#pragma unroll
    for (int dt = 0; dt < 4; ++dt) t.O[dt] = (f32x4){0.f, 0.f, 0.f, 0.f}; }
__device__ __forceinline__ float task_rowsum(const Task& t) { return t.L[0]; }
__device__ __forceinline__ float task_rowsum_stats(const Task& t) { return xrow16_sum(t.l); }
constexpr float REF_DELTA = 32.f;
__device__ __forceinline__ void task_fix_ref(Task& t) {
    t.cinit = -(t.m + REF_DELTA);
    const float sc = __builtin_amdgcn_exp2f(-REF_DELTA);
    t.L = t.L * sc;
#pragma unroll
    for (int dt = 0; dt < 4; ++dt) t.O[dt] = t.O[dt] * sc;
}
}

struct NsaRow { int RI, c, b; u32x2 out[4];
    __device__ __forceinline__ int tokl() const { return RI >> 2; }
    __device__ __forceinline__ int head() const { return RI & 3; }
    __device__ __forceinline__ int tt() const { return 64 * c + (RI >> 2); }
    __device__ __forceinline__ size_t grow() const { return (size_t)(b * SEQ + 64 * c + (RI >> 2)); }
};
__device__ __forceinline__ void nsa_row_init(NsaRow& r, fa::Task& t, const bf16_t* Q, int b, int g, int c, int R, int fq) {
    r.RI = R; r.c = c; r.b = b;
    const bf16_t* qp = Q + r.grow() * DM + (g * 4 + r.head()) * DH + 8 * fq;
    t.q[0] = *(const bf16x8*)qp; t.q[1] = *(const bf16x8*)(qp + 32);
    t.imptok = r.tokl() | (r.head() == 0 ? 0x10000 : 0); t.fw0 = 0u; t.fwp = nullptr;
#pragma unroll
    for (int dt = 0; dt < 4; ++dt) r.out[dt] = (u32x2){0u, 0u};
}
__device__ __forceinline__ void nsa_cmp_setup(const NsaRow& r, fa::Task& t) {
    const int tt_ = r.tt(); const int nv = tt_ >= 31 ? (((tt_ - 31) >> 4) + 1 > 511 ? 511 : ((tt_ - 31) >> 4) + 1) : 0;
    t.kmin = 0; t.kmax = nv - 1; fa::task_reset(t);
}
__device__ __forceinline__ void nsa_accum(NsaRow& r, const fa::Task& t, float sc) {
#pragma unroll
    for (int dt = 0; dt < 4; ++dt) { const f32x4 o = t.O[dt] * sc; const u32x2 w = r.out[dt];
        r.out[dt] = (u32x2){pk2(bflo(w.x) + o[0], bfhi(w.x) + o[1]), pk2(bflo(w.y) + o[2], bfhi(w.y) + o[3])}; }
}
__device__ __forceinline__ void nsa_store(const NsaRow& r, bf16_t* AO, int g, int fq) {
    bf16_t* op = AO + r.grow() * DM + (g * 4 + r.head()) * DH + 4 * fq;
#pragma unroll
    for (int dt = 0; dt < 4; ++dt) *(u32x2*)(op + 16 * dt) = r.out[dt];
}
__device__ __forceinline__ void ph_nsa_fa(const Ctx& C) {
    LAS unsigned char* L = (LAS unsigned char*)C.lds;
    LAS unsigned char* ring = L;
    LAS float* imp = (LAS float*)(L + 65536);
    LAS unsigned* selm = (LAS unsigned*)(L + 135168);
    const bf16_t* Q = (const bf16_t*)(C.ws + WS_Q); const bf16_t* KC = (const bf16_t*)(C.ws + WS_KC); const bf16_t* VC = (const bf16_t*)(C.ws + WS_VC);
    const bf16_t* KS = (const bf16_t*)(C.ws + WS_KV0 + 2 * KVSEG); const bf16_t* VS = (const bf16_t*)(C.ws + WS_KV0 + 3 * KVSEG);
    const bf16_t* KW = (const bf16_t*)(C.ws + WS_KV0 + 4 * KVSEG); const bf16_t* VW = (const bf16_t*)(C.ws + WS_KV0 + 5 * KVSEG);
    const float* gates = (const float*)(C.ws + WS_GATES); bf16_t* AO = (bf16_t*)(C.ws + WS_XB);
    const int wave = C.wave;
    for (int u = C.bid; u < NB * NG * (SEQ / 64); u += C.nb) {
        int lane = C.lane; asm volatile("" : "+v"(lane));
        const int i16 = lane & 15, fq = lane >> 4;
        const int rnd = u / C.nb, idx = (u % C.nb) >> 4, bg = u & 15, b = bg >> 2, g = bg & 3;
        const int c = (C.nb == 256) ? 127 - 16 * rnd - ((rnd & 1) ? 15 - idx : idx) : 127 - (u >> 4);
        fa::Task T0, T1; NsaRow R0, R1;
        nsa_row_init(R0, T0, Q, b, g, c, 32 * wave + i16, fq);
        nsa_row_init(R1, T1, Q, b, g, c, 32 * wave + 16 + i16, fq);
        for (int i = C.tid; i < 2 * 64 * 130; i += NTHREADS) imp[i] = 0.f;
        if (C.tid < 256) selm[C.tid] = 0u;
        const int nvm = ((64 * c + 63 - 31) >> 4) + 1;
        const int nvmax = nvm > 511 ? 511 : nvm;
        const int nblkc = (nvmax + 63) >> 6;
        nsa_cmp_setup(R0, T0); nsa_cmp_setup(R1, T1);
        fa::flash_loop<1, 0>(ring, KC + (size_t)bg * 512 * DH, VC + (size_t)bg * 512 * DH, nblkc, T0, T1, imp, wave, lane);
        { const float l0 = fa::task_rowsum_stats(T0), l1 = fa::task_rowsum_stats(T1);
          T0.cinit = l0 > 0.f ? -T0.m - __builtin_amdgcn_logf(l0) : -__builtin_inff(); T1.cinit = l1 > 0.f ? -T1.m - __builtin_amdgcn_logf(l1) : -__builtin_inff(); }
        fa::flash_loop<2, 0>(ring, KC + (size_t)bg * 512 * DH, VC + (size_t)bg * 512 * DH, nblkc, T0, T1, imp, wave, lane);
        nsa_accum(R0, T0, gates[R0.grow() * 48 + g * 4 + R0.head()]);
        nsa_accum(R1, T1, gates[R1.grow() * 48 + g * 4 + R1.head()]);
        {
            const int jq = c, ncand = jq - 2 > 0 ? jq - 2 : 0, nforced = jq == 0 ? 1 : (jq == 1 ? 2 : 3), need = 16 - nforced;
#pragma unroll
            for (int g2 = 0; g2 < 2; ++g2) {
                const int tk = 8 * wave + 4 * g2 + (lane >> 4);
                unsigned key[8]; unsigned selb = 0u;
#pragma unroll
                for (int k = 0; k < 8; ++k) { const int j = i16 + 16 * k; const bool cand = j >= 1 && j <= jq - 2;
                    key[k] = cand ? ((__float_as_uint(imp[tk * 130 + j] + imp[64 * 130 + tk * 130 + j - 1]) & 0xFFFFFF80u) | (unsigned)(127 - j)) : 0u; }
                if (ncand <= need) {
#pragma unroll
                    for (int k = 0; k < 8; ++k) selb |= (key[k] != 0u) ? (1u << k) : 0u;
                } else {
                    for (int r = 0; r < need; ++r) {
                        unsigned m = max(max(max(key[0], key[1]), max(key[2], key[3])), max(max(key[4], key[5]), max(key[6], key[7])));
                        m = max(m, (unsigned)__builtin_amdgcn_mov_dpp((int)m, 0xB1, 0xf, 0xf, true));
                        m = max(m, (unsigned)__builtin_amdgcn_mov_dpp((int)m, 0x4E, 0xf, 0xf, true));
                        m = max(m, (unsigned)__builtin_amdgcn_mov_dpp((int)m, 0x141, 0xf, 0xf, true));
                        m = max(m, (unsigned)__builtin_amdgcn_mov_dpp((int)m, 0x140, 0xf, 0xf, true));
#pragma unroll
                        for (int k = 0; k < 8; ++k) { const bool hit = key[k] == m; selb |= hit ? (1u << k) : 0u; key[k] = hit ? 0u : key[k]; }
                    }
                }
#pragma unroll
                for (int k = 0; k < 8; ++k) { const int j = i16 + 16 * k; if (j == 0 || j == jq || j == jq - 1) selb |= 1u << k; }
#pragma unroll
                for (int w2 = 0; w2 < 4; ++w2) {
                    const unsigned bits = (((selb >> (2 * w2)) & 1u) << i16) | (((selb >> (2 * w2 + 1)) & 1u) << (16 + i16));
                    if (bits) __hip_atomic_fetch_or(selm + tk * 4 + w2, bits, __ATOMIC_RELAXED, __HIP_MEMORY_SCOPE_WORKGROUP);
                }
            }
        }
        asm volatile("s_waitcnt lgkmcnt(0)\n\ts_barrier" ::: "memory");
        {
            const int jlo = c - 8 > 0 ? c - 8 : 0;
            T0.kmin = 0; T0.kmax = R0.tokl(); fa::task_reset(T0); T1.kmin = 0; T1.kmax = R1.tokl(); fa::task_reset(T1);
            fa::flash_loop<0, 0>(ring, KW + ((size_t)bg * SEQ + 64 * c) * DH, VW + ((size_t)bg * SEQ + 64 * c) * DH, 1, T0, T1, imp, wave, lane);
            fa::task_fix_ref(T0); fa::task_fix_ref(T1);
            T0.kmin = R0.tt() - 511 - 64 * jlo; T0.kmax = R0.tt() - 64 * jlo; T1.kmin = R1.tt() - 511 - 64 * jlo; T1.kmax = R1.tt() - 64 * jlo;
            if (c > jlo) fa::flash_loop2<3, 0>(ring, KW + ((size_t)bg * SEQ + 64 * jlo) * DH, VW + ((size_t)bg * SEQ + 64 * jlo) * DH, c - jlo, T0, T1, imp, wave, lane);
            const float l0 = fa::task_rowsum(T0), l1 = fa::task_rowsum(T1);
            nsa_accum(R0, T0, (l0 > 0.f ? 1.0f / l0 : 0.f) * gates[R0.grow() * 48 + 32 + g * 4 + R0.head()]);
            nsa_accum(R1, T1, (l1 > 0.f ? 1.0f / l1 : 0.f) * gates[R1.grow() * 48 + 32 + g * 4 + R1.head()]);
        }
        {
            T0.fwp = selm + R0.tokl() * 4; T1.fwp = selm + R1.tokl() * 4;
            T0.kmin = 0; T0.kmax = R0.tokl(); fa::task_reset(T0); T1.kmin = 0; T1.kmax = R1.tokl(); fa::task_reset(T1);
            fa::flash_loop<0, 0>(ring, KS + ((size_t)bg * SEQ + 64 * c) * DH, VS + ((size_t)bg * SEQ + 64 * c) * DH, 1, T0, T1, imp, wave, lane);
            T0.kmax = R0.tt(); T1.kmax = R1.tt(); fa::task_fix_ref(T0); fa::task_fix_ref(T1);
            if (c > 0) fa::flash_loop2<3, 1>(ring, KS + (size_t)bg * SEQ * DH, VS + (size_t)bg * SEQ * DH, c, T0, T1, imp, wave, lane);
            const float l0 = fa::task_rowsum(T0), l1 = fa::task_rowsum(T1);
            nsa_accum(R0, T0, (l0 > 0.f ? 1.0f / l0 : 0.f) * gates[R0.grow() * 48 + 16 + g * 4 + R0.head()]);
            nsa_accum(R1, T1, (l1 > 0.f ? 1.0f / l1 : 0.f) * gates[R1.grow() * 48 + 16 + g * 4 + R1.head()]);
        }
        nsa_store(R0, AO, g, fq); nsa_store(R1, AO, g, fq);
    }
}

__device__ __forceinline__ void ph_moba_fa(const Ctx& C) {
    LAS unsigned char* L = (LAS unsigned char*)C.lds;
    LAS unsigned char* ring = L;
    LAS float* kms = (LAS float*)(L + 65536);
    LAS unsigned* rmask = (LAS unsigned*)(L + 65536 + 8192);
    const bf16_t* Q = (const bf16_t*)(C.ws + WS_Q); const bf16_t* K1 = (const bf16_t*)(C.ws + WS_K1); const bf16_t* V1 = (const bf16_t*)(C.ws + WS_V1);
    const float* KM = (const float*)(C.ws + WS_KMEAN); bf16_t* AO = (bf16_t*)(C.ws + WS_XB);
    const int wave = C.wave;
    for (int u = C.bid; u < NB * NH * 32; u += C.nb) {
        int lane = C.lane; asm volatile("" : "+v"(lane));
        const int i16 = lane & 15, fq = lane >> 4;
        const int rnd = u / C.nb, idx = (u % C.nb) >> 6, bh = u & 63, b = bh >> 4, h = bh & 15;
        const int cb = (C.nb == 256) ? 31 - 4 * rnd - ((rnd & 1) ? 3 - idx : idx) : 31 - (u >> 6);
        for (int i = C.tid; i < 32 * 64; i += NTHREADS) kms[i] = KM[(size_t)bh * 2048 + i];
        asm volatile("s_waitcnt vmcnt(0) lgkmcnt(0)\n\ts_barrier" ::: "memory");
        {
            const int row = C.tid >> 1, half = C.tid & 1;
            float qh[64]; load_qh(Q + (size_t)(b * SEQ + 256 * cb + row) * DM + h * DH, qh);
            float b0 = -3e38f, b1 = -3e38f, b2 = -3e38f; int j0 = 99, j1 = 99, j2 = 99;
            for (int n = half; n < cb; n += 2) {
                const LAS f32x4* km = (const LAS f32x4*)(kms + n * 64); float a = 0.f;
#pragma unroll
                for (int q = 0; q < 16; ++q) { const f32x4 w = km[q]; a += w[0] * qh[4 * q] + w[1] * qh[4 * q + 1] + w[2] * qh[4 * q + 2] + w[3] * qh[4 * q + 3]; }
                if (a > b0) { b2 = b1; j2 = j1; b1 = b0; j1 = j0; b0 = a; j0 = n; } else if (a > b1) { b2 = b1; j2 = j1; b1 = a; j1 = n; } else if (a > b2) { b2 = a; j2 = n; }
            }
            const float ov0 = __shfl_xor(b0, 1), ov1 = __shfl_xor(b1, 1), ov2 = __shfl_xor(b2, 1); const int oj0 = __shfl_xor(j0, 1), oj1 = __shfl_xor(j1, 1), oj2 = __shfl_xor(j2, 1);
#define MERGE3(a, n) do { if ((a) > b0 || ((a) == b0 && (n) < j0)) { b2 = b1; j2 = j1; b1 = b0; j1 = j0; b0 = (a); j0 = (n); } \
                else if ((a) > b1 || ((a) == b1 && (n) < j1)) { b2 = b1; j2 = j1; b1 = (a); j1 = (n); } \
                else if ((a) > b2 || ((a) == b2 && (n) < j2)) { b2 = (a); j2 = (n); } } while (0)
            MERGE3(ov0, oj0); MERGE3(ov1, oj1); MERGE3(ov2, oj2);
#undef MERGE3
            unsigned mk = 1u << cb;
            if (j0 < cb) mk |= 1u << j0; if (j1 < cb) mk |= 1u << j1; if (j2 < cb) mk |= 1u << j2;
            if (half == 0) rmask[row] = mk;
        }
        asm volatile("s_waitcnt lgkmcnt(0)\n\ts_barrier" ::: "memory");
        fa::Task T[2]; int tt[2];
#pragma unroll
        for (int ti = 0; ti < 2; ++ti) {
            const int R = 32 * wave + 16 * ti + i16; tt[ti] = 256 * cb + R; T[ti].fw0 = rmask[R]; T[ti].imptok = 0;
            const bf16_t* qp = Q + (size_t)(b * SEQ + tt[ti]) * DM + h * DH + 8 * fq;
            T[ti].q[0] = *(const bf16x8*)qp; T[ti].q[1] = *(const bf16x8*)(qp + 32);
            T[ti].kmin = 0; T[ti].kmax = tt[ti]; fa::task_reset(T[ti]);
        }
#pragma unroll
        for (int ti = 0; ti < 2; ++ti) { T[ti].kmax = tt[ti] - 256 * cb; }
        fa::flash_loop<0, 0>(ring, K1 + ((size_t)bh * SEQ + 256 * cb) * DH, V1 + ((size_t)bh * SEQ + 256 * cb) * DH, 4, T[0], T[1], kms, wave, lane);
#pragma unroll
        for (int ti = 0; ti < 2; ++ti) { T[ti].kmax = tt[ti]; fa::task_fix_ref(T[ti]); }
        if (cb > 0) fa::flash_loop2<3, 2>(ring, K1 + (size_t)bh * SEQ * DH, V1 + (size_t)bh * SEQ * DH, 4 * cb, T[0], T[1], kms, wave, lane);
#pragma unroll
        for (int ti = 0; ti < 2; ++ti) { const float l = fa::task_rowsum(T[ti]); const float sc_ = l > 0.f ? 1.0f / l : 0.f;
            bf16_t* op = AO + (size_t)(b * SEQ + tt[ti]) * DM + h * DH + 4 * fq;
#pragma unroll
            for (int dt = 0; dt < 4; ++dt) { const f32x4 o = T[ti].O[dt] * sc_; *(u32x2*)(op + 16 * dt) = (u32x2){pk2(o[0], o[1]), pk2(o[2], o[3])}; } }
    }
}

struct Route { int e0, s0, e1, s1; float w0, w1; int pad0, pad1; };
__device__ __forceinline__ void ph_ln_route(const Ctx& C, int layer) {
    const float* resid = C.in[I_X]; const bf16_t* residb = (const bf16_t*)(C.ws + WS_X2B); const bf16_t* MIX = (const bf16_t*)(C.ws + WS_MIX);
    bf16_t* X1B = (bf16_t*)(C.ws + WS_X1B); Route* RT = (Route*)(C.ws + WS_ROUTE);
    int* rowlist = (int*)(C.ws + WS_ROWLIST); unsigned* cnt = (unsigned*)(C.ws + WS_CTL) + (layer ? CW_CNT1 : CW_CNT0);
    const float* lg = C.in[I_LNG] + (size_t)(layer * 2 + 0) * DM; const float* lb = C.in[I_LNB] + (size_t)(layer * 2 + 0) * DM;
    const float* rw = C.in[I_RW]; const float* rb = C.in[I_RB];
    LAS unsigned* lcnt = (LAS unsigned*)C.lds;
    LAS float* rec = (LAS float*)(C.lds + 256);
    LAS float* lsb = (LAS float*)(C.lds + 4096 + C.wave * 512);
    const int lane = C.lane;
    LAS unsigned char* rwl = (LAS unsigned char*)(C.lds + 8192);
    for (int gi = C.tid; gi < DM * NE / 4; gi += NTHREADS) { const int c = gi >> 2, e4 = gi & 3;
        *(LAS f32x4*)(rwl + (c >> 8) * 17408 + ((c & 255) >> 2) * 272 + (c & 3) * 64 + e4 * 16) = ((const f32x4*)rw)[gi]; }
    __syncthreads();
    for (int chunk = C.bid; chunk < NTOK / 128; chunk += C.nb) {
        if (C.tid < 16) lcnt[C.tid] = 0u;
        __syncthreads();
        for (int i2 = 0; i2 < 8; ++i2) {
            const int rl0 = C.wave * 16 + i2 * 2, row0 = chunk * 128 + rl0;
            f32x4 v[2][4]; float s[2], s2[2];
#pragma unroll
            for (int r = 0; r < 2; ++r) { const f32x4* xr = (const f32x4*)(resid + (size_t)(row0 + r) * DM) + lane; const u32x2* xb = (const u32x2*)(residb + (size_t)(row0 + r) * DM) + lane;
                const u32x2* mr = (const u32x2*)(MIX + (size_t)(row0 + r) * DM) + lane; s[r] = 0.f;
#pragma unroll
                for (int j = 0; j < 4; ++j) { const u32x2 w = mr[64 * j]; f32x4 xv;
                    if (layer) { const u32x2 q = xb[64 * j]; xv = (f32x4){bflo(q.x), bfhi(q.x), bflo(q.y), bfhi(q.y)}; } else xv = xr[64 * j];
                    v[r][j] = xv * DN_ALPHA + (f32x4){bflo(w.x), bfhi(w.x), bflo(w.y), bfhi(w.y)};
                    s[r] += (v[r][j][0] + v[r][j][1]) + (v[r][j][2] + v[r][j][3]); } }
#pragma unroll
            for (int o = 1; o < 64; o <<= 1) { s[0] += __shfl_xor(s[0], o); s[1] += __shfl_xor(s[1], o); }
#pragma unroll
            for (int r = 0; r < 2; ++r) { const float mean = s[r] * (1.f / DM); s2[r] = 0.f;
#pragma unroll
                for (int j = 0; j < 4; ++j) { v[r][j] = v[r][j] - mean; s2[r] += (v[r][j][0] * v[r][j][0] + v[r][j][1] * v[r][j][1]) + (v[r][j][2] * v[r][j][2] + v[r][j][3] * v[r][j][3]); } }
#pragma unroll
            for (int o = 1; o < 64; o <<= 1) { s2[0] += __shfl_xor(s2[0], o); s2[1] += __shfl_xor(s2[1], o); }
            const float rstd0 = 1.f / sqrtf(s2[0] * (1.f / DM) + LN_EPS), rstd1 = 1.f / sqrtf(s2[1] * (1.f / DM) + LN_EPS);
            float p[32];
#pragma unroll
            for (int q = 0; q < 32; ++q) p[q] = 0.f;
#pragma unroll
            for (int j = 0; j < 4; ++j) {
                const int c0 = 4 * lane + 256 * j;
                const f32x4 gg = *(const f32x4*)(lg + c0), bb = *(const f32x4*)(lb + c0);
#pragma unroll
                for (int r = 0; r < 2; ++r) {
                    v[r][j] = v[r][j] * (r ? rstd1 : rstd0) * gg + bb;
                    *(u32x2*)(X1B + (size_t)(row0 + r) * DM + c0) = (u32x2){pk2(v[r][j][0], v[r][j][1]), pk2(v[r][j][2], v[r][j][3])}; }
#pragma unroll
                for (int q = 0; q < 4; ++q) {
                    const LAS f32x4* wr = (const LAS f32x4*)(rwl + j * 17408 + lane * 272 + q * 64);
                    const f32x4 w0 = wr[0], w1 = wr[1], w2 = wr[2], w3 = wr[3];
#pragma unroll
                    for (int r = 0; r < 2; ++r) { const float x = v[r][j][q];
                        p[16 * r + 0] += x * w0[0]; p[16 * r + 1] += x * w0[1]; p[16 * r + 2] += x * w0[2]; p[16 * r + 3] += x * w0[3];
                        p[16 * r + 4] += x * w1[0]; p[16 * r + 5] += x * w1[1]; p[16 * r + 6] += x * w1[2]; p[16 * r + 7] += x * w1[3];
                        p[16 * r + 8] += x * w2[0]; p[16 * r + 9] += x * w2[1]; p[16 * r + 10] += x * w2[2]; p[16 * r + 11] += x * w2[3];
                        p[16 * r + 12] += x * w3[0]; p[16 * r + 13] += x * w3[1]; p[16 * r + 14] += x * w3[2]; p[16 * r + 15] += x * w3[3]; }
                    if (q == 3) asm volatile("" ::: "memory");
                }
            }
#define TRED(N, M) { const bool up = (lane & (M)) != 0; _Pragma("unroll") for (int q = 0; q < (N); ++q) { const float keep = up ? p[q + (N)] : p[q], send = up ? p[q] : p[q + (N)]; p[q] = keep + __shfl_xor(send, (M)); } }
            TRED(16, 32) TRED(8, 16) TRED(4, 8) TRED(2, 4) TRED(1, 2)
#undef TRED
            p[0] += __shfl_xor(p[0], 1);
            const float sc_own = 1.0f / (1.0f + expf(-p[0]));
            if ((lane & 1) == 0) { lsb[lane >> 1] = sc_own; lsb[32 + (lane >> 1)] = sc_own + rb[(lane >> 1) & 15]; }
            WAVE_LDS_SYNC();
            float sc[16], bi[16];
            { const LAS f32x4* a4 = (const LAS f32x4*)(lsb + ((lane >> 5) << 4)); const LAS f32x4* b4 = (const LAS f32x4*)(lsb + 32 + ((lane >> 5) << 4));
#pragma unroll
              for (int q = 0; q < 4; ++q) { const f32x4 x = a4[q], y = b4[q]; sc[4 * q] = x[0]; sc[4 * q + 1] = x[1]; sc[4 * q + 2] = x[2]; sc[4 * q + 3] = x[3]; bi[4 * q] = y[0]; bi[4 * q + 1] = y[1]; bi[4 * q + 2] = y[2]; bi[4 * q + 3] = y[3]; } }
            WAVE_LDS_SYNC();
            int gsel = 0; float gbest = -3e38f;
#pragma unroll
            for (int gq = 0; gq < 4; ++gq) {
                float m1 = -3e38f, m2 = -3e38f;
#pragma unroll
                for (int q = 0; q < 4; ++q) { const float x = bi[4 * gq + q]; if (x > m1) { m2 = m1; m1 = x; } else if (x > m2) m2 = x; }
                const float gs = m1 + m2; if (gs > gbest) { gbest = gs; gsel = gq; }
            }
            int e0 = 0, e1 = 0; float b0 = -3e38f, b1 = -3e38f, w0 = 0.f, w1 = 0.f;
#pragma unroll
            for (int e = 0; e < 16; ++e) {
                if ((e >> 2) == gsel) {
                    const float x = bi[e];
                    if (x > b0) { b1 = b0; e1 = e0; w1 = w0; b0 = x; e0 = e; w0 = sc[e]; }
                    else if (x > b1) { b1 = x; e1 = e; w1 = sc[e]; }
                }
            }
            if ((lane & 31) == 0) {
                const int rl = rl0 + (lane >> 5);
                const float ws_ = w0 + w1;
                const unsigned l0 = __hip_atomic_fetch_add(lcnt + e0, 1u, __ATOMIC_RELAXED, __HIP_MEMORY_SCOPE_WORKGROUP), l1 = __hip_atomic_fetch_add(lcnt + e1, 1u, __ATOMIC_RELAXED, __HIP_MEMORY_SCOPE_WORKGROUP);
                LAS float* r = rec + rl * 6; r[0] = __int_as_float(e0); r[1] = __int_as_float(e1); r[2] = __uint_as_float(l0); r[3] = __uint_as_float(l1); r[4] = w0 / ws_; r[5] = w1 / ws_;
            }
        }
        __syncthreads();
        if (C.tid < 16) lcnt[16 + C.tid] = atomicAdd(cnt + 64 * C.tid, lcnt[C.tid]);
        __syncthreads();
        if (C.tid < 128) {
            const LAS float* r = rec + C.tid * 6; const int row = chunk * 128 + C.tid;
            const int e0 = __float_as_int(r[0]), e1 = __float_as_int(r[1]);
            const int s0 = (int)(lcnt[16 + e0] + __float_as_uint(r[2])), s1 = (int)(lcnt[16 + e1] + __float_as_uint(r[3]));
            rowlist[e0 * NTOK + s0] = row; rowlist[e1 * NTOK + s1] = row;
            Route rr; rr.e0 = e0; rr.s0 = s0; rr.e1 = e1; rr.s1 = s1; rr.w0 = r[4]; rr.w1 = r[5]; rr.pad0 = 0; rr.pad1 = 0;
            RT[row] = rr;
        }
        __syncthreads();
    }
}
__device__ __forceinline__ void ph_combine(const Ctx& C, int layer, float* outp, LAS int* sm) {
    const bf16_t* X1B = (const bf16_t*)(C.ws + WS_X1B); const bf16_t* Y2 = (const bf16_t*)(C.ws + WS_Y2); const Route* RT = (const Route*)(C.ws + WS_ROUTE);
    bf16_t* XB = (bf16_t*)(C.ws + WS_XB); bf16_t* X2B = (bf16_t*)(C.ws + WS_X2B);
    const float* lg = C.in[I_LNG] + (size_t)(layer * 2 + 1) * DM; const float* lb = C.in[I_LNB] + (size_t)(layer * 2 + 1) * DM;
    const int gw = C.bid * NWAVES + C.wave, NGW = C.nb * NWAVES, lane = C.lane;
    for (int row = gw; row < NTOK; row += NGW) {
        const Route r = RT[row];
        const bf16_t* y0 = Y2 + (size_t)(sm[16 + r.e0] + r.s0) * DM; const bf16_t* y1 = Y2 + (size_t)(sm[16 + r.e1] + r.s1) * DM;
        const u32x2* xr = (const u32x2*)(X1B + (size_t)row * DM) + lane;
        f32x4 v[4]; float s = 0.f;
#pragma unroll
        for (int j = 0; j < 4; ++j) {
            const int c0 = 4 * lane + 256 * j;
            const u32x2 a = *(const u32x2*)(y0 + c0), b = *(const u32x2*)(y1 + c0), x = xr[64 * j];
            const f32x4 ya = (f32x4){bflo(a.x), bfhi(a.x), bflo(a.y), bfhi(a.y)}, yb = (f32x4){bflo(b.x), bfhi(b.x), bflo(b.y), bfhi(b.y)}, xv = (f32x4){bflo(x.x), bfhi(x.x), bflo(x.y), bfhi(x.y)};
            v[j] = xv * DN_ALPHA + ya * r.w0 + yb * r.w1;
            s += (v[j][0] + v[j][1]) + (v[j][2] + v[j][3]);
        }
        const float mean = wave_sum(s) * (1.f / DM); float s2 = 0.f;
#pragma unroll
        for (int j = 0; j < 4; ++j) { v[j] = v[j] - mean; s2 += (v[j][0] * v[j][0] + v[j][1] * v[j][1]) + (v[j][2] * v[j][2] + v[j][3] * v[j][3]); }
        const float rstd = 1.f / sqrtf(wave_sum(s2) * (1.f / DM) + LN_EPS);
#pragma unroll
        for (int j = 0; j < 4; ++j) {
            const int c0 = 4 * lane + 256 * j;
            const f32x4 gg = *(const f32x4*)(lg + c0), bb = *(const f32x4*)(lb + c0);
            v[j] = v[j] * rstd * gg + bb;
            if (layer) *(f32x4*)(outp + (size_t)row * DM + c0) = v[j];
            else { const u32x2 w = (u32x2){pk2(v[j][0], v[j][1]), pk2(v[j][2], v[j][3])}; *(u32x2*)(XB + (size_t)row * DM + c0) = w; *(u32x2*)(X2B + (size_t)row * DM + c0) = w; }
        }
    }
}

__device__ __forceinline__ void ph_kmean(const Ctx& C) {
    const bf16_t* K1 = (const bf16_t*)(C.ws + WS_K1); float* KM = (float*)(C.ws + WS_KMEAN);
    const int gw = C.bid * NWAVES + C.wave, NGW = C.nb * NWAVES, lane = C.lane;
    for (int it = gw; it < NB * NH * 32; it += NGW) {
        const bf16_t* p = K1 + (size_t)it * 256 * DH + lane; float s = 0.f;
#pragma unroll 8
        for (int j = 0; j < 256; ++j) s += bf2f(p[j * DH]);
        KM[(size_t)it * DH + lane] = s * (1.0f / 256.0f);
    }
}
constexpr int NPHASE = 19;
__global__ void __launch_bounds__(NTHREADS, 2) fwd(Args args) {
    extern __shared__ __attribute__((aligned(16))) unsigned char lds[];
    Ctx C;
#pragma unroll
    for (int i = 0; i < 18; ++i) C.in[i] = args.in[i];
    C.out = args.out; C.ws = args.ws; C.lds = lds;
    C.tid = threadIdx.x; C.lane = C.tid & 63; C.wave = __builtin_amdgcn_readfirstlane(C.tid >> 6); C.bid = blockIdx.x; C.nb = gridDim.x;
    LAS unsigned* misc = (LAS unsigned*)(lds + LDS_BYTES - 512);
    LAS int* sm = (LAS int*)(misc + 16);
    if (C.tid < 4) misc[C.tid] = 0u;
    __syncthreads();
#if MK_SINGLE
    XcdBarrier bar = xcd_barrier_post((unsigned*)(C.ws + WS_CTL) + CW_BAR, (volatile LAS unsigned*)misc);
#define SEAM() xcd_barrier(bar)
#else
#define SEAM() do {} while (0)
#endif
    const int lo = args.ph_lo, hi = args.ph_hi;
#ifndef PH_MASK
#define PH_MASK 0xFFFFFFFFu
#endif
#define IN(k) (((PH_MASK >> (k)) & 1u) && lo <= (k) && (k) < hi)
#define BOTH(k) (IN(k) && IN((k) + 1))
    unsigned char* ws = C.ws;
    const float2* rope = (const float2*)(ws + WS_ROPE);
    LAS unsigned char* L = (LAS unsigned char*)lds;

    if (IN(0)) { ph_prologue(C); if (BOTH(0)) SEAM(); }
    if (IN(1)) {
        EpiNsaIn E{(bf16_t*)(ws + WS_Q), (bf16_t*)(ws + WS_KV0), (float*)(ws + WS_GATES), rope};
        g8::StaticOrder S; S.init(NTOK / 256, 2560 / 256, C.nb, C.bid);
        g8::gemm8<false>(L, (const bf16_t*)(ws + WS_XB), DM, (const bf16_t*)(ws + WS_WT_NSA_IN), DM, S, g8::EpiEl<EpiNsaIn>{E}, g8::GatherInfo{nullptr, sm});
        if (BOTH(1)) SEAM();
    }
    if (IN(2)) {
        EpiGelu EK{(bf16_t*)(ws + WS_H1K), (const float*)(ws + WS_BIAS1)}, EV{(bf16_t*)(ws + WS_H1V), (const float*)(ws + WS_BIAS1) + 256};
        g8::StaticOrder SK, SV; SK.init(32, 1, C.nb, C.bid); SV.init(32, 1, C.nb, (C.bid + C.nb / 2) % C.nb);
        g8::gemm8<false>(L, (const bf16_t*)(ws + WS_KV0), 1024, (const bf16_t*)(ws + WS_WT_C1K), 2048, SK, g8::EpiEl<EpiGelu>{EK}, g8::GatherInfo{nullptr, sm});
        g8::gemm8<false>(L, (const bf16_t*)(ws + WS_KV0 + KVSEG), 1024, (const bf16_t*)(ws + WS_WT_C1V), 2048, SV, g8::EpiEl<EpiGelu>{EV}, g8::GatherInfo{nullptr, sm});
        if (C.nb == 256 && !((C.bid < 32) || (C.bid >= 128 && C.bid < 160))) {
            EpiNsaIn E{(bf16_t*)(ws + WS_Q), (bf16_t*)(ws + WS_KV0), (float*)(ws + WS_GATES), rope};
            const int gidx = C.bid < 128 ? C.bid - 32 : C.bid - 64, fr = C.lane & 15, fq = C.lane >> 4;
            for (int tile = gidx * NWAVES + C.wave; tile < 2048; tile += 192 * NWAVES) {
                const int row0 = (tile >> 1) * 32, col0 = 2560 + (tile & 1) * 32;
                const bf16_t* a0 = (const bf16_t*)(ws + WS_XB) + (size_t)(row0 + fr) * DM + fq * 8; const bf16_t* a1 = a0 + (size_t)16 * DM;
                const bf16_t* b0 = (const bf16_t*)(ws + WS_WT_NSA_IN) + (size_t)(col0 + fr) * DM + fq * 8; const bf16_t* b1 = b0 + (size_t)16 * DM;
                f32x4 acc[2][2]; mma_core(a0, a1, b0, b1, DM, acc);
#pragma unroll
                for (int mi = 0; mi < 2; ++mi)
#pragma unroll
                    for (int ni = 0; ni < 2; ++ni) E(row0 + 16 * mi + fr, col0 + 16 * ni + 4 * fq, acc[mi][ni]);
            }
        } else if (C.nb != 256) {
            EpiNsaIn E{(bf16_t*)(ws + WS_Q), (bf16_t*)(ws + WS_KV0), (float*)(ws + WS_GATES), rope};
            const int fr = C.lane & 15, fq = C.lane >> 4;
            for (int tile = C.bid * NWAVES + C.wave; tile < 2048; tile += C.nb * NWAVES) {
                const int row0 = (tile >> 1) * 32, col0 = 2560 + (tile & 1) * 32;
                const bf16_t* a0 = (const bf16_t*)(ws + WS_XB) + (size_t)(row0 + fr) * DM + fq * 8; const bf16_t* a1 = a0 + (size_t)16 * DM;
                const bf16_t* b0 = (const bf16_t*)(ws + WS_WT_NSA_IN) + (size_t)(col0 + fr) * DM + fq * 8; const bf16_t* b1 = b0 + (size_t)16 * DM;
                f32x4 acc[2][2]; mma_core(a0, a1, b0, b1, DM, acc);
#pragma unroll
                for (int mi = 0; mi < 2; ++mi)
#pragma unroll
                    for (int ni = 0; ni < 2; ++ni) E(row0 + 16 * mi + fr, col0 + 16 * ni + 4 * fq, acc[mi][ni]);
            }
        }
        if (BOTH(2)) SEAM();
    }
    if (IN(3)) { ph_cmp2(C); if (BOTH(3)) SEAM(); }
    if (IN(4)) { ph_nsa_fa(C); if (BOTH(4)) SEAM(); }
    if (IN(6)) {
        EpiBf16 E{(bf16_t*)(ws + WS_MIX)};
        g8::StaticOrder S; S.init(NTOK / 256, DM / 256, C.nb, C.bid);
        g8::gemm8<false>(L, (const bf16_t*)(ws + WS_XB), DM, (const bf16_t*)(ws + WS_WT_NSA_OUT), DM, S, g8::EpiEl<EpiBf16>{E}, g8::GatherInfo{nullptr, sm});
        if (BOTH(6)) SEAM();
    }
    if (IN(7)) { ph_ln_route(C, 0); if (BOTH(7)) SEAM(); }
    if (IN(8)) {
        load_expert_map(C, CW_CNT0, sm);
        EpiSwiGLU E{(bf16_t*)(ws + WS_HBUF)};
        g8::GroupedOrder S; S.init(sm, 4, C.nb, C.bid);
        g8::gemm8<true>(L, (const bf16_t*)(ws + WS_X1B), DM, (const bf16_t*)(ws + WS_WT_GU), 1024, S, g8::EpiEl<EpiSwiGLU>{E}, g8::GatherInfo{(const int*)(ws + WS_ROWLIST), sm});
        if (BOTH(8)) SEAM();
    }
    if (IN(9)) {
        load_expert_map(C, CW_CNT0, sm);
        EpiBf16 E{(bf16_t*)(ws + WS_Y2)};
        g8::GroupedOrder S; S.init(sm, 4, C.nb, C.bid);
        g8::gemm8<false>(L, (const bf16_t*)(ws + WS_HBUF), DE, (const bf16_t*)(ws + WS_WT_DN), DE, S, g8::EpiEl<EpiBf16>{E}, g8::GatherInfo{nullptr, sm});
        if (BOTH(9)) SEAM();
    }
    if (IN(10)) {
        load_expert_map(C, CW_CNT0, sm);
        ph_combine(C, 0, (float*)(ws + WS_XR), sm);
        { float* scr = (float*)(C.lds + C.wave * 9216); const int gw = C.bid * NWAVES + C.wave, NGW = C.nb * NWAVES;
          for (int it = gw; it < MOE_W_ITEMS; it += NGW) moe_weight_item(C, 1, it, scr); }
        if (BOTH(10)) SEAM();
    }
    if (IN(11)) {
        EpiMobaIn E{(bf16_t*)(ws + WS_Q), (bf16_t*)(ws + WS_K1), (bf16_t*)(ws + WS_V1), rope};
        g8::StaticOrder S; S.init(NTOK / 256, 3072 / 256, C.nb, C.bid);
        g8::gemm8<false>(L, (const bf16_t*)(ws + WS_XB), DM, (const bf16_t*)(ws + WS_WT_MOBA_IN), DM, S, g8::EpiEl<EpiMobaIn>{E}, g8::GatherInfo{nullptr, sm});
        if (BOTH(11)) SEAM();
    }
    if (IN(12)) { ph_kmean(C); if (BOTH(12)) SEAM(); }
    if (IN(13)) { ph_moba_fa(C); if (BOTH(13)) SEAM(); }
    if (IN(14)) {
        EpiBf16 E{(bf16_t*)(ws + WS_MIX)};
        g8::StaticOrder S; S.init(NTOK / 256, DM / 256, C.nb, C.bid);
        g8::gemm8<false>(L, (const bf16_t*)(ws + WS_XB), DM, (const bf16_t*)(ws + WS_WT_MOBA_OUT), DM, S, g8::EpiEl<EpiBf16>{E}, g8::GatherInfo{nullptr, sm});
        if (BOTH(14)) SEAM();
    }
    if (IN(15)) { ph_ln_route(C, 1); if (BOTH(15)) SEAM(); }
    if (IN(16)) {
        load_expert_map(C, CW_CNT1, sm);
        EpiSwiGLU E{(bf16_t*)(ws + WS_HBUF)};
        g8::GroupedOrder S; S.init(sm, 4, C.nb, C.bid);
        g8::gemm8<true>(L, (const bf16_t*)(ws + WS_X1B), DM, (const bf16_t*)(ws + WS_WT_GU), 1024, S, g8::EpiEl<EpiSwiGLU>{E}, g8::GatherInfo{(const int*)(ws + WS_ROWLIST), sm});
        if (BOTH(16)) SEAM();
    }
    if (IN(17)) {
        load_expert_map(C, CW_CNT1, sm);
        EpiBf16 E{(bf16_t*)(ws + WS_Y2)};
        g8::GroupedOrder S; S.init(sm, 4, C.nb, C.bid);
        g8::gemm8<false>(L, (const bf16_t*)(ws + WS_HBUF), DE, (const bf16_t*)(ws + WS_WT_DN), DE, S, g8::EpiEl<EpiBf16>{E}, g8::GatherInfo{nullptr, sm});
        if (BOTH(17)) SEAM();
    }
    if (IN(18)) {
        load_expert_map(C, CW_CNT1, sm);
        ph_combine(C, 1, C.out, sm);
    }
#undef IN
#undef BOTH
}

extern "C" void kernel_launch(void* const* d_in, const int* in_sizes, int n_in, void* d_out, int out_size, void* d_ws, size_t ws_size, hipStream_t stream) {
    static int grid = 0;
    if (grid == 0) {
        if (n_in != 18 || in_sizes[0] != NTOK * DM || out_size != NTOK * DM || ws_size < WS_END) {
            fprintf(stderr, "kernel_launch: unexpected shapes (n_in %d, in0 %d, out %d, ws %zu; need ws >= %zu); nothing launched\n", n_in, n_in > 0 ? in_sizes[0] : -1, out_size, ws_size, (size_t)WS_END);
            grid = -1; return;
        }
        int dev = 0, cus = 0, per_cu = 0;
        if (hipGetDevice(&dev) != hipSuccess || hipDeviceGetAttribute(&cus, hipDeviceAttributeMultiprocessorCount, dev) != hipSuccess) { grid = -1; return; }
        if (hipFuncSetAttribute((const void*)fwd, hipFuncAttributeMaxDynamicSharedMemorySize, LDS_BYTES) != hipSuccess) { fprintf(stderr, "kernel_launch: hipFuncSetAttribute failed\n"); grid = -1; return; }
        if (hipOccupancyMaxActiveBlocksPerMultiprocessor(&per_cu, (const void*)fwd, NTHREADS, LDS_BYTES) != hipSuccess || per_cu < 1)
            fprintf(stderr, "kernel_launch: occupancy query reports %d blocks per CU\n", per_cu);
        (void)hipGetLastError();
        grid = cus;
    }
    if (grid < 0) return;
    if (hipMemsetAsync((char*)d_ws + WS_CTL, 0, CTL_BYTES, stream) != hipSuccess) { fprintf(stderr, "kernel_launch: memset failed\n"); return; }
    Args a{};
    for (int i = 0; i < 18; ++i) a.in[i] = (const float*)d_in[i];
    a.out = (float*)d_out; a.ws = (unsigned char*)d_ws;
#if defined(PROBE_PH)
    { const int lo3[3] = {0, PROBE_PH, PROBE_PH + 1}, hi3[3] = {PROBE_PH + 1, PROBE_PH + 1, NPHASE};
      for (int q = 0; q < 3; ++q) { if (lo3[q] >= hi3[q]) continue;
          if (q) (void)hipMemsetAsync((char*)d_ws + WS_CTL + CW_BAR * 4, 0, XCD_BAR_WORDS * 4, stream);
          a.ph_lo = lo3[q]; a.ph_hi = hi3[q]; hipLaunchKernelGGL(fwd, dim3(grid), dim3(NTHREADS), LDS_BYTES, stream, a); } }
#elif MK_SINGLE
    a.ph_lo = 0; a.ph_hi = NPHASE;
    hipLaunchKernelGGL(fwd, dim3(grid), dim3(NTHREADS), LDS_BYTES, stream, a);
#else
    for (int p = 0; p < NPHASE; ++p) { a.ph_lo = p; a.ph_hi = p + 1; hipLaunchKernelGGL(fwd, dim3(grid), dim3(NTHREADS), LDS_BYTES, stream, a); }
#endif
    const hipError_t le = hipPeekAtLastError();
    if (le != hipSuccess) fprintf(stderr, "kernel_launch: launch failed: %s\n", hipGetErrorName(le));
}
```

```cpp
#include <hip/hip_runtime.h>
#include <cstdio>
#include <cstdint>

#ifndef SEL_FUSED
#define SEL_FUSED 1
#endif
#ifndef MK_SINGLE
#define MK_SINGLE 1
#endif

#define LAS __attribute__((address_space(3)))
typedef unsigned short bf16_t;
typedef short bf16x8 __attribute__((ext_vector_type(8)));
typedef float f32x4 __attribute__((ext_vector_type(4)));
typedef unsigned u32x4 __attribute__((ext_vector_type(4)));
typedef unsigned u32x2 __attribute__((ext_vector_type(2)));

constexpr int NB = 4, SEQ = 8192, NTOK = NB * SEQ, DM = 1024, NH = 16, DH = 64, NG = 4;
constexpr int NSA_IN = 2608, NSA_INP = 2816;
constexpr int NE = 16, DE = 512;
constexpr float DN_ALPHA = 1.4142135623730951f;
constexpr float LN_EPS = 1e-5f;
constexpr int NWAVES = 8, NTHREADS = 512;
constexpr float QSCALE = 0.125f * 1.4426950408889634f;
constexpr int LDS_BYTES = 163840;
constexpr int ROWCAP = 2 * NTOK + NE * 256;

constexpr size_t MiB = 1u << 20;
constexpr size_t WS_CTL = 0, CTL_BYTES = 1 * MiB;
constexpr size_t WS_ROPE = 1 * MiB;
constexpr size_t WS_BIAS1 = 3 * MiB;
constexpr size_t WS_KMEAN = 4 * MiB;
constexpr size_t WS_ROUTE = 5 * MiB;
constexpr size_t WS_ROWLIST = 6 * MiB;
constexpr size_t WS_SEL = 8 * MiB;
constexpr size_t WS_GATES = 10 * MiB;
constexpr size_t WS_H1K = 17 * MiB, WS_H1V = 21 * MiB;
constexpr size_t WS_KC = 25 * MiB, WS_VC = 26 * MiB;
constexpr size_t WS_WT_NSA_IN = 27 * MiB;
constexpr size_t WS_WT_NSA_OUT = 33 * MiB;
constexpr size_t WS_WT_C1K = 35 * MiB, WS_WT_C1V = 36 * MiB;
constexpr size_t WS_WT_MOBA_IN = 37 * MiB;
constexpr size_t WS_WT_MOBA_OUT = 43 * MiB;
constexpr size_t WS_WT_GU = 45 * MiB;
constexpr size_t WS_WT_DN = 77 * MiB;
constexpr size_t WS_XB = 93 * MiB;
constexpr size_t WS_ATTN = 161 * MiB;
constexpr size_t WS_Q = WS_ATTN;
constexpr size_t WS_KV0 = WS_ATTN + 64 * MiB;
constexpr size_t KVSEG = 16 * MiB;
constexpr size_t WS_K1 = WS_ATTN + 64 * MiB, WS_V1 = WS_ATTN + 128 * MiB;
constexpr size_t WS_X1B = 353 * MiB;
constexpr size_t WS_X2B = 417 * MiB;
constexpr size_t WS_MIX = WS_ATTN + 64 * MiB;
constexpr size_t WS_Y2 = WS_ATTN;
constexpr size_t WS_HBUF = WS_XB;
constexpr size_t WS_XR = 353 * MiB;
constexpr size_t WS_END = 481 * MiB;
static_assert((size_t)ROWCAP * 512 * 2 <= 68 * MiB && (size_t)ROWCAP * 1024 * 2 <= 192 * MiB, "overlay sizes");

constexpr int CW_TMO = 0;
constexpr int CW_CNT0 = 1024, CW_CNT1 = 2048;
constexpr int CW_BAR = 8192;

__device__ __forceinline__ unsigned f2bf(float f) { unsigned u = __float_as_uint(f); return (u + 0x7fffu + ((u >> 16) & 1u)) >> 16; }
typedef float f32x2v __attribute__((ext_vector_type(2)));
typedef __bf16 bf16x2v __attribute__((ext_vector_type(2)));
__device__ __forceinline__ unsigned pk2(float lo, float hi) { const f32x2v v = {lo, hi}; const bf16x2v b = __builtin_convertvector(v, bf16x2v); return __builtin_bit_cast(unsigned, b); }
__device__ __forceinline__ float bflo(unsigned u) { return __uint_as_float(u << 16); }
__device__ __forceinline__ float bfhi(unsigned u) { return __uint_as_float(u & 0xffff0000u); }
__device__ __forceinline__ float bf2f(bf16_t b) { return __uint_as_float((unsigned)b << 16); }
__device__ __forceinline__ float wave_sum(float v) {
#pragma unroll
    for (int o = 1; o < 64; o <<= 1) v += __shfl_xor(v, o);
    return v;
}
__device__ __forceinline__ float wave_max(float v) {
#pragma unroll
    for (int o = 1; o < 64; o <<= 1) v = fmaxf(v, __shfl_xor(v, o));
    return v;
}
#define WAVE_LDS_SYNC() asm volatile("s_waitcnt lgkmcnt(0)" ::: "memory")
__device__ __forceinline__ float sigmoidf_(float x) { return 1.0f / (1.0f + __expf(-x)); }
__device__ __forceinline__ float gelu_tanh(float x) {
    const float u = 0.7978845608028654f * (x + 0.044715f * x * x * x);
    const float t = 1.0f - 2.0f / (__expf(2.0f * u) + 1.0f);
    return 0.5f * x * (1.0f + t);
}

#define XB_TMO      128
#define XB_XCNT(j)  (256  + 64 * (j))
#define XB_XSUB(j)  (1280 + 64 * (j))
#define XB_XGEN(j)  (2304 + 64 * (j))
#define XB_TOP      3328
#define XB_TOPGEN   3392
#define XCD_BAR_WORDS 3456
#define XB_SPIN_CAP (1u << 22)
__device__ __forceinline__ unsigned xb_ld(unsigned* p)              { return __hip_atomic_load(p, __ATOMIC_RELAXED, __HIP_MEMORY_SCOPE_AGENT); }
__device__ __forceinline__ unsigned xb_add(unsigned* p, unsigned v) { return __hip_atomic_fetch_add(p, v, __ATOMIC_RELAXED, __HIP_MEMORY_SCOPE_AGENT); }
__device__ __forceinline__ unsigned xb_xcc_id() { return (unsigned)__builtin_amdgcn_s_getreg((3 << 11) | 20) & 0xFu; }
#define XB_SPIN(cond, bar) do { unsigned _sp = 0; while (cond) { __builtin_amdgcn_s_sleep(1); \
    if ((++_sp & 255u) == 0u) { if (xb_ld(&(bar)[XB_TMO])) break; if (_sp > XB_SPIN_CAP) { atomicAdd(&(bar)[XB_TMO], 1u); break; } } } } while (0)
struct XcdBarrier { unsigned* bar; unsigned x; volatile LAS unsigned* st; };
__device__ __forceinline__ XcdBarrier xcd_barrier_post(unsigned* bar, volatile LAS unsigned* st) {
    XcdBarrier b; b.bar = bar; b.x = xb_xcc_id(); b.st = st;
    if (threadIdx.x == 0) (void)xb_add(&bar[XB_XCNT(b.x)], 1u);
    return b;
}
__device__ __forceinline__ void xcd_barrier_complete(unsigned* bar, unsigned x, unsigned& nloc, unsigned& nx) {
    const unsigned G = gridDim.x * gridDim.y * gridDim.z;
    unsigned sum, cnt, mine, sp = 0u;
    for (;;) {
        sum = 0u; cnt = 0u; mine = 0u;
#pragma unroll
        for (unsigned j = 0; j < 16; ++j) { const unsigned c = xb_ld(&bar[XB_XCNT(j)]); sum += c; cnt += (c > 0u) ? 1u : 0u; mine = (j == x) ? c : mine; }
        if (sum == G) break;
        __builtin_amdgcn_s_sleep(1);
        if ((++sp & 255u) == 0u) { if (xb_ld(&bar[XB_TMO])) break; if (sp > XB_SPIN_CAP) { atomicAdd(&bar[XB_TMO], 1u); break; } }
    }
    nloc = mine > 0u ? mine : 1u; nx = cnt > 0u ? cnt : 1u;
}
__device__ __forceinline__ void xcd_barrier(const XcdBarrier& b) {
    asm volatile("s_waitcnt vmcnt(0)" ::: "memory");
    __syncthreads();
    if (threadIdx.x == 0) {
        unsigned* bar = b.bar;
        __builtin_amdgcn_s_waitcnt(0);
        unsigned nloc = b.st[0], nx = b.st[1];
        if (nloc == 0u) { xcd_barrier_complete(bar, b.x, nloc, nx); b.st[0] = nloc; b.st[1] = nx; }
        const unsigned old = xb_add(&bar[XB_XSUB(b.x)], 1u);
        const unsigned gen = old / nloc;
        if (old + 1u == (gen + 1u) * nloc) {
            __builtin_amdgcn_fence(__ATOMIC_RELEASE, "agent");
            asm volatile("s_waitcnt vmcnt(0)" ::: "memory");
            const unsigned og = xb_add(&bar[XB_TOP], 1u);
            const unsigned tg = og / nx;
            if (og + 1u == (tg + 1u) * nx) xb_add(&bar[XB_TOPGEN], 1u);
            else XB_SPIN(xb_ld(&bar[XB_TOPGEN]) == tg, bar);
            __builtin_amdgcn_fence(__ATOMIC_ACQUIRE, "agent");
            xb_add(&bar[XB_XGEN(b.x)], 1u);
            asm volatile("s_waitcnt vmcnt(0)" ::: "memory");
        } else {
            XB_SPIN(xb_ld(&bar[XB_XGEN(b.x)]) == gen, bar);
            __builtin_amdgcn_fence(__ATOMIC_ACQUIRE, "agent");
            asm volatile("s_waitcnt vmcnt(0)" ::: "memory");
        }
    }
    __syncthreads();
}

struct Args { const float* in[18]; float* out; unsigned char* ws; int ph_lo, ph_hi; };
struct Ctx {
    const float* in[18]; float* out; unsigned char* ws; unsigned char* lds;
    int tid, lane, wave, bid, nb;
};
enum { I_X = 0, I_NSA_WIN, I_NSA_WOUT, I_CK_W1, I_CK_W2, I_CV_W1, I_CV_W2, I_CK_POS, I_CV_POS, I_MOBA_WIN, I_MOBA_WOUT, I_RW, I_RB, I_WG, I_WU, I_WD, I_LNG, I_LNB };

__device__ __forceinline__ int il64(int d) { return d < 32 ? 2 * d : 2 * (d - 32) + 1; }
__device__ __forceinline__ int rowmap(int kind, int n) {
    switch (kind) {
        case 1: { const bool r = (n < 1024) || (n >= 1536 && n < 1792) || (n >= 2048 && n < 2304); return r ? (n & ~63) + il64(n & 63) : n; }
        case 2: return n < 2048 ? (n & ~63) + il64(n & 63) : n;
        case 3: return 2 * n;
        case 4: return 2 * n + 1;
        default: return n;
    }
}
__device__ __forceinline__ void transpose_item(const float* W, int ldw, int ncols, bf16_t* WT, int K, int kb, int nbk, int kind, float* scr, int lane) {
    const int k0 = 64 * kb, n0 = 32 * nbk;
    const int cq = lane & 7, nn = n0 + 4 * cq;
#pragma unroll
    for (int i = 0; i < 8; ++i) { const int kk = 8 * i + (lane >> 3);
        *(f32x4*)(scr + kk * 36 + 4 * cq) = nn < ncols ? *(const f32x4*)(W + (size_t)(k0 + kk) * ldw + nn) : (f32x4){0.f, 0.f, 0.f, 0.f}; }
    WAVE_LDS_SYNC();
    const int c = lane & 7;
#pragma unroll
    for (int j = 0; j < 4; ++j) {
        const int n = (lane >> 3) + 8 * j; const float* s = scr + (8 * c) * 36 + n;
        u32x4 o; o.x = pk2(s[0 * 36], s[1 * 36]); o.y = pk2(s[2 * 36], s[3 * 36]); o.z = pk2(s[4 * 36], s[5 * 36]); o.w = pk2(s[6 * 36], s[7 * 36]);
        *(u32x4*)(WT + (size_t)rowmap(kind, n0 + n) * K + k0 + 8 * c) = o;
    }
    WAVE_LDS_SYNC();
}
constexpr int MOE_W_ITEMS = NE * 768;
__device__ __forceinline__ void moe_weight_item(const Ctx& C, int layer, int r, float* scr) {
    const int e = r / 768; int q = r % 768;
    bf16_t* gu = (bf16_t*)(C.ws + WS_WT_GU) + (size_t)e * 1024 * 1024;
    bf16_t* dn = (bf16_t*)(C.ws + WS_WT_DN) + (size_t)e * 1024 * 512;
    const size_t eo = (size_t)(layer * NE + e);
    if (q < 256) { transpose_item(C.in[I_WG] + eo * DM * DE, DE, DE, gu, DM, q / 16, q % 16, 3, scr, C.lane); return; } q -= 256;
    if (q < 256) { transpose_item(C.in[I_WU] + eo * DM * DE, DE, DE, gu, DM, q / 16, q % 16, 4, scr, C.lane); return; } q -= 256;
    transpose_item(C.in[I_WD] + eo * DE * DM, DM, DM, dn, DE, q / 32, q % 32, 0, scr, C.lane);
}

__device__ __forceinline__ void ph_prologue(const Ctx& C) {
    float* scr = (float*)(C.lds + C.wave * 9216);
    const int gw = C.bid * NWAVES + C.wave, NGW = C.nb * NWAVES;
    constexpr int I_A = 16 * 82, I_B = 16 * 32, I_C = 32 * 8, I_D = 16 * 96, I_E = 16 * 32;
    constexpr int NIT = I_A + I_B + 2 * I_C + I_D + I_E + MOE_W_ITEMS;
    for (int it = gw; it < NIT; it += NGW) {
        int r = it;
        if (r < I_A) { transpose_item(C.in[I_NSA_WIN], NSA_IN, NSA_IN, (bf16_t*)(C.ws + WS_WT_NSA_IN), DM, r / 82, r % 82, 1, scr, C.lane); continue; } r -= I_A;
        if (r < I_B) { transpose_item(C.in[I_NSA_WOUT], DM, DM, (bf16_t*)(C.ws + WS_WT_NSA_OUT), DM, r / 32, r % 32, 0, scr, C.lane); continue; } r -= I_B;
        if (r < I_C) { transpose_item(C.in[I_CK_W1], 256, 256, (bf16_t*)(C.ws + WS_WT_C1K), 2048, r / 8, r % 8, 0, scr, C.lane); continue; } r -= I_C;
        if (r < I_C) { transpose_item(C.in[I_CV_W1], 256, 256, (bf16_t*)(C.ws + WS_WT_C1V), 2048, r / 8, r % 8, 0, scr, C.lane); continue; } r -= I_C;
        if (r < I_D) { transpose_item(C.in[I_MOBA_WIN], 3072, 3072, (bf16_t*)(C.ws + WS_WT_MOBA_IN), DM, r / 96, r % 96, 2, scr, C.lane); continue; } r -= I_D;
        if (r < I_E) { transpose_item(C.in[I_MOBA_WOUT], DM, DM, (bf16_t*)(C.ws + WS_WT_MOBA_OUT), DM, r / 32, r % 32, 0, scr, C.lane); continue; } r -= I_E;
        moe_weight_item(C, 0, r, scr);
    }
    const int gt = C.bid * NTHREADS + C.tid, NGT = C.nb * NTHREADS;
    { u32x4* p = (u32x4*)((bf16_t*)(C.ws + WS_WT_NSA_IN) + (size_t)2624 * DM); const int n = (NSA_INP - 2624) * DM / 8;
      for (int i = gt; i < n; i += NGT) p[i] = (u32x4){0u, 0u, 0u, 0u}; }
    { const f32x4* x4 = (const f32x4*)C.in[I_X]; u32x4* o = (u32x4*)(C.ws + WS_XB); const int n = NTOK * DM / 8;
      for (int i = gt; i < n; i += NGT) { const f32x4 a = x4[2 * i], b = x4[2 * i + 1]; o[i] = (u32x4){pk2(a.x, a.y), pk2(a.z, a.w), pk2(b.x, b.y), pk2(b.z, b.w)}; } }
    { const float INV[32] = {1.000000000e+00f, 7.498942018e-01f, 5.623413324e-01f, 4.216965139e-01f, 3.162277639e-01f, 2.371373922e-01f, 1.778279394e-01f, 1.333521456e-01f,
                             1.000000015e-01f, 7.498941571e-02f, 5.623412877e-02f, 4.216964915e-02f, 3.162277862e-02f, 2.371373586e-02f, 1.778279431e-02f, 1.333521493e-02f,
                             9.999999776e-03f, 7.498942316e-03f, 5.623413250e-03f, 4.216964822e-03f, 3.162277862e-03f, 2.371373819e-03f, 1.778279431e-03f, 1.333521446e-03f,
                             1.000000047e-03f, 7.498941850e-04f, 5.623413017e-04f, 4.216965463e-04f, 3.162277862e-04f, 2.371373848e-04f, 1.778279402e-04f, 1.333521504e-04f};
      float2* tab = (float2*)(C.ws + WS_ROPE);
      for (int i = gt; i < SEQ * 32; i += NGT) {
          const int t = i >> 5, f = i & 31;
          float inv = INV[0];
#pragma unroll
          for (int q = 1; q < 32; ++q) inv = (f == q) ? INV[q] : inv;
          const float ang = (float)t * inv;
          const double a = (double)ang; const double k = __builtin_rint(a * 0.15915494309189535); const float rf = (float)(a - k * 6.283185307179586);
          tab[i] = make_float2(__cosf(rf), __sinf(rf));
      } }
    for (int o = gw; o < 512; o += NGW) {
        const int which = o >> 8, c = o & 255;
        const float* pos = C.in[which ? I_CV_POS : I_CK_POS]; const float* w1 = C.in[which ? I_CV_W1 : I_CK_W1];
        float s = 0.f;
        for (int k = C.lane; k < 2048; k += 64) s += pos[k] * w1[(size_t)k * 256 + c];
        s = wave_sum(s);
        if (C.lane == 0) ((float*)(C.ws + WS_BIAS1))[o] = s;
    }
}

__device__ __forceinline__ void mma_core(const bf16_t* a0, const bf16_t* a1, const bf16_t* b0, const bf16_t* b1, int K, f32x4 (&acc)[2][2]) {
#pragma unroll
    for (int i = 0; i < 2; ++i)
#pragma unroll
        for (int j = 0; j < 2; ++j) acc[i][j] = (f32x4){0.f, 0.f, 0.f, 0.f};
#pragma unroll 4
    for (int k = 0; k < K; k += 32) {
        const bf16x8 A0 = *(const bf16x8*)(a0 + k), A1 = *(const bf16x8*)(a1 + k), B0 = *(const bf16x8*)(b0 + k), B1 = *(const bf16x8*)(b1 + k);
        acc[0][0] = __builtin_amdgcn_mfma_f32_16x16x32_bf16(B0, A0, acc[0][0], 0, 0, 0);
        acc[0][1] = __builtin_amdgcn_mfma_f32_16x16x32_bf16(B1, A0, acc[0][1], 0, 0, 0);
        acc[1][0] = __builtin_amdgcn_mfma_f32_16x16x32_bf16(B0, A1, acc[1][0], 0, 0, 0);
        acc[1][1] = __builtin_amdgcn_mfma_f32_16x16x32_bf16(B1, A1, acc[1][1], 0, 0, 0);
    }
}
namespace g8 {
constexpr int BM = 256, BK = 64, HALF = 128, HTB = HALF * BK * 2, STAGE_BYTES = 8 * HTB, NXCD = 8, WGM = 8;
__device__ __forceinline__ int lds_byte(int r, int c) { const int st = (r >> 4) * 2 + (c >> 5), rr = r & 15, cc = c & 31, ob = rr * 64 + cc * 2; return st * 1024 + (ob ^ (((ob >> 9) & 1) << 5)); }
__device__ __forceinline__ void stage_rc(int b, int& R, int& C) { const int st = b / 1024, sb = b % 1024, swz = sb ^ (((sb >> 9) & 1) << 5); R = (st >> 1) * 16 + swz / 64; C = (st & 1) * 32 + (swz % 64) / 2; }
struct Unit { int pm, pn, bt, e; };
struct StaticOrder {
    int nM, nN, nwg, G, c;
    __device__ void init(int nM_, int nN_, int G_, int c_) { nM = nM_; nN = nN_; nwg = nM * nN; G = G_; c = c_; }
    __device__ bool next(int i, Unit& u) const {
        const long L = (long)i * G + c; if (L >= nwg) return false;
        int wgid = (int)L; { const int q = nwg / NXCD, r = nwg % NXCD, xcd = wgid % NXCD, off = wgid / NXCD; wgid = (xcd < r ? xcd * (q + 1) : r * (q + 1) + (xcd - r) * q) + off; }
        const int nig = WGM * nN, gid = wgid / nig, fm = gid * WGM, gsz = (nM - fm) < WGM ? (nM - fm) : WGM;
        u.pm = fm + ((wgid % nig) % gsz); u.pn = (wgid % nig) / gsz; u.bt = u.pn; u.e = 0; return true;
    }
};
struct GroupedOrder {
    StaticOrder so; const LAS int* sm;
    __device__ void init(const LAS int* sm_, int nN_, int G_, int c_) { sm = sm_; so.init(sm_[32] / BM, nN_, G_, c_); }
    __device__ bool next(int i, Unit& u) const {
        if (!so.next(i, u)) return false;
        const int rowt = u.pm * BM; int e = 0;
#pragma unroll
        for (int q = 1; q < NE; ++q) e = (rowt >= sm[16 + q]) ? q : e;
        u.e = e; u.bt = e * so.nN + u.pn; return true;
    }
};
struct GatherInfo { const int* rowlist; const LAS int* sm; };

__device__ __forceinline__ int perm32(int rho) { const int n = rho >> 4, i = rho & 15; return 8 * (i >> 2) + 4 * n + (i & 3); }
template <bool GATHER, class Epi, class Sched>
__device__ __forceinline__ void gemm8(LAS unsigned char* lds, const bf16_t* A, int lda, const bf16_t* Bt, int K, const Sched& S, const Epi& E, GatherInfo gi) {
    const int tid = threadIdx.x, wid = __builtin_amdgcn_readfirstlane(tid >> 6), lane = tid & 63, wr = wid >> 2, wc = wid & 3, fr = lane & 15, fq = lane >> 4;
    const int nt = K / BK;
    int Rr[2], Cc[2]; unsigned voffB[2]; unsigned vAc[2][2], vAn[2][2];
#pragma unroll
    for (int i = 0; i < 2; ++i) { stage_rc(tid * 16 + i * 8192, Rr[i], Cc[i]); voffB[i] = (unsigned)(((Rr[i] & ~31) + perm32(Rr[i] & 31)) * K + Cc[i]) * 2u;
#pragma unroll
        for (int h = 0; h < 2; ++h) { vAc[h][i] = (unsigned)((Rr[i] + HALF * h) * lda + Cc[i]) * 2u; vAn[h][i] = vAc[h][i]; } }
    const size_t kstep = (size_t)(BK * 2);
    const size_t hstepB = (size_t)HALF * K * 2, tstepB = 2 * hstepB, tstepA = (size_t)BM * lda * 2;
    const unsigned ldsw = (unsigned)wid * 1024u;
    const int aoff = lds_byte(wr * 64 + fr, fq * 8), boff = lds_byte(wc * 32 + fr, fq * 8);
#define G8_SA(b, h) (((b) * 2 + (h)) * HTB)
#define G8_SB(b, h) ((4 + (b) * 2 + (h)) * HTB)
#define G8_STAGEB(bufoff, gbase) do { _Pragma("unroll") for (int _i = 0; _i < 2; ++_i) \
        __builtin_amdgcn_global_load_lds((const unsigned*)((const char*)(gbase) + voffB[_i]), (LAS unsigned*)(lds + (bufoff) + ldsw + _i * 8192), 16, 0, 0); } while (0)
#define G8_STAGEA(bufoff, gbase, v0, v1) do { \
        __builtin_amdgcn_global_load_lds((const unsigned*)((const char*)(gbase) + (v0)), (LAS unsigned*)(lds + (bufoff) + ldsw), 16, 0, 0); \
        __builtin_amdgcn_global_load_lds((const unsigned*)((const char*)(gbase) + (v1)), (LAS unsigned*)(lds + (bufoff) + ldsw + 8192), 16, 0, 0); } while (0)
#define G8_LDA(dst, b, h) do { _Pragma("unroll") for (int m = 0; m < 4; ++m) _Pragma("unroll") for (int k = 0; k < 2; ++k) dst[m][k] = *(const LAS bf16x8*)(lds + G8_SA(b, h) + aoff + m * 2048 + k * 1024); } while (0)
#define G8_LDB(dst, b, h) do { _Pragma("unroll") for (int n = 0; n < 2; ++n) _Pragma("unroll") for (int k = 0; k < 2; ++k) dst[n][k] = *(const LAS bf16x8*)(lds + G8_SB(b, h) + boff + n * 2048 + k * 1024); } while (0)
#define G8_MMA(ai, bj, At, Bt_) do { __builtin_amdgcn_s_setprio(1); _Pragma("unroll") for (int m = 0; m < 4; ++m) _Pragma("unroll") for (int n = 0; n < 2; ++n) _Pragma("unroll") for (int k = 0; k < 2; ++k) \
        acc[ai][bj][m][n] = __builtin_amdgcn_mfma_f32_16x16x32_bf16(Bt_[n][k], At[m][k], acc[ai][bj][m][n], 0, 0, 0); __builtin_amdgcn_s_setprio(0); } while (0)
#define G8_WAIT_V(n) asm volatile("s_waitcnt vmcnt(" #n ")" ::: "memory")
#define G8_WAIT_L(n) asm volatile("s_waitcnt lgkmcnt(" #n ")" ::: "memory")
#define G8_BAR __builtin_amdgcn_s_barrier()
#define G8_SCHED __builtin_amdgcn_sched_barrier(0)
#define G8_GATHER(u, v) do { if (GATHER) { const int _eb = gi.sm[16 + (u).e], _ec = gi.sm[(u).e]; \
        _Pragma("unroll") for (int _h = 0; _h < 2; ++_h) _Pragma("unroll") for (int _i = 0; _i < 2; ++_i) { const int _s = (u).pm * BM + HALF * _h + Rr[_i] - _eb; \
            const int _t = gi.rowlist[(u).e * NTOK + (_s < _ec ? _s : 0)]; v[_h][_i] = (unsigned)(_t * K + Cc[_i]) * 2u; } } } while (0)
    Unit cur, nxt; int ui = 0;
    if (!S.next(0, cur)) return;
    f32x4 acc[2][2][4][2];
#pragma unroll
    for (int a = 0; a < 2; ++a)
#pragma unroll
        for (int b = 0; b < 2; ++b)
#pragma unroll
            for (int m = 0; m < 4; ++m)
#pragma unroll
                for (int n = 0; n < 2; ++n) acc[a][b][m][n] = (f32x4){0.f, 0.f, 0.f, 0.f};
    bf16x8 At[4][2], B0[2][2], B1[2][2];
    G8_GATHER(cur, vAc);
    const char* cA = GATHER ? (const char*)A : (const char*)A + (size_t)cur.pm * tstepA; const char* cB = (const char*)Bt + (size_t)cur.bt * tstepB;
    G8_STAGEB(G8_SB(0, 0), cB); G8_STAGEB(G8_SB(0, 1), cB + hstepB); G8_STAGEA(G8_SA(0, 0), cA, vAc[0][0], vAc[0][1]); G8_STAGEA(G8_SA(0, 1), cA, vAc[1][0], vAc[1][1]);
    if (wr == 1) G8_BAR;
    G8_WAIT_V(2); G8_BAR;
    G8_STAGEB(G8_SB(1, 0), cB + kstep); G8_STAGEA(G8_SA(1, 0), cA + kstep, vAc[0][0], vAc[0][1]); G8_STAGEB(G8_SB(1, 1), cB + hstepB + kstep);
    G8_WAIT_V(6); G8_BAR;
    for (;;) {
        const bool has_next = S.next(ui + 1, nxt);
        if (has_next) G8_GATHER(nxt, vAn);
        const char* nA = has_next ? (GATHER ? (const char*)A : (const char*)A + (size_t)nxt.pm * tstepA) : cA; const char* nB = has_next ? (const char*)Bt + (size_t)nxt.bt * tstepB : cB;
        for (int t = 0; t < nt; t += 2) {
            const bool last = (t == nt - 2);
            const char* a1 = cA + (size_t)(t + 1) * kstep;
            const char* a2 = last ? nA : cA + (size_t)(t + 2) * kstep; const char* b2 = last ? nB : cB + (size_t)(t + 2) * kstep;
            const char* a3 = a2 + kstep; const char* b3 = b2 + kstep;
            const bool usen = GATHER && last && has_next;
            const unsigned w00 = usen ? vAn[0][0] : vAc[0][0], w01 = usen ? vAn[0][1] : vAc[0][1], w10 = usen ? vAn[1][0] : vAc[1][0], w11 = usen ? vAn[1][1] : vAc[1][1];
            G8_LDB(B0, 0, 0); G8_LDB(B1, 0, 1); G8_SCHED; G8_LDA(At, 0, 0); G8_STAGEA(G8_SA(1, 1), a1, vAc[1][0], vAc[1][1]);
            G8_WAIT_V(8); G8_WAIT_L(0); G8_BAR; G8_MMA(0, 0, At, B0); G8_MMA(0, 1, At, B1); G8_BAR; G8_SCHED;
            G8_LDA(At, 0, 1); G8_STAGEB(G8_SB(0, 0), b2); G8_STAGEB(G8_SB(0, 1), b2 + hstepB); G8_STAGEA(G8_SA(0, 0), a2, w00, w01);
            G8_WAIT_V(8); G8_WAIT_L(0); G8_BAR; G8_MMA(1, 0, At, B0); G8_MMA(1, 1, At, B1); G8_BAR; G8_SCHED;
            G8_LDB(B0, 1, 0); G8_LDB(B1, 1, 1); G8_SCHED; G8_LDA(At, 1, 0); G8_STAGEA(G8_SA(0, 1), a2, w10, w11);
            G8_WAIT_V(8); G8_WAIT_L(0); G8_BAR; G8_MMA(0, 0, At, B0); G8_MMA(0, 1, At, B1); G8_BAR; G8_SCHED;
            G8_LDA(At, 1, 1); G8_STAGEB(G8_SB(1, 0), b3); G8_STAGEB(G8_SB(1, 1), b3 + hstepB); G8_STAGEA(G8_SA(1, 0), a3, w00, w01);
            G8_WAIT_V(8); G8_WAIT_L(0); G8_BAR; G8_MMA(1, 0, At, B0); G8_MMA(1, 1, At, B1); G8_BAR; G8_SCHED;
        }
        if (wr == 0) G8_BAR;
        E(acc, cur, wr, wc, fr, fq);
        if (!has_next) break;
#pragma unroll
        for (int a = 0; a < 2; ++a)
#pragma unroll
            for (int b = 0; b < 2; ++b)
#pragma unroll
                for (int m = 0; m < 4; ++m)
#pragma unroll
                    for (int n = 0; n < 2; ++n) acc[a][b][m][n] = (f32x4){0.f, 0.f, 0.f, 0.f};
        cur = nxt; cA = nA; cB = nB; ++ui;
#pragma unroll
        for (int h = 0; h < 2; ++h)
#pragma unroll
            for (int i = 0; i < 2; ++i) vAc[h][i] = vAn[h][i];
        if (wr == 1) G8_BAR;
    }
    G8_WAIT_V(0);
    G8_BAR;
#undef G8_SA
#undef G8_SB
#undef G8_STAGEA
#undef G8_STAGEB
#undef G8_LDA
#undef G8_LDB
#undef G8_MMA
#undef G8_WAIT_V
#undef G8_WAIT_L
#undef G8_BAR
#undef G8_SCHED
#undef G8_GATHER
}
template <class F> struct EpiEl {
    F f;
    __device__ __forceinline__ void operator()(const f32x4 (&acc)[2][2][4][2], const Unit& u, int wr, int wc, int fr, int fq) const {
#pragma unroll
        for (int ai = 0; ai < 2; ++ai)
#pragma unroll
            for (int m = 0; m < 4; ++m) { const int row = u.pm * BM + ai * HALF + wr * 64 + m * 16 + fr;
#pragma unroll
                for (int bj = 0; bj < 2; ++bj) f(row, u.pn * BM + bj * HALF + wc * 32 + 8 * fq, acc[ai][bj][m][0], acc[ai][bj][m][1]); }
    }
};
}

struct EpiNsaIn {
    bf16_t* Q; bf16_t* KV; float* gates; const float2* rope;
    __device__ __forceinline__ void operator()(int row, int c, f32x4 v) const {
        const int t = row & (SEQ - 1), b = row >> 13;
        if (c < 1024) {
            v = v * QSCALE;
            const int d = (c & 63) >> 1; const float2 c0 = rope[t * 32 + d], c1 = rope[t * 32 + d + 1];
            bf16_t* p = Q + (size_t)row * DM + (c & ~63);
            *(unsigned*)(p + d) = pk2(v[0] * c0.x - v[1] * c0.y, v[2] * c1.x - v[3] * c1.y);
            *(unsigned*)(p + d + 32) = pk2(v[1] * c0.x + v[0] * c0.y, v[3] * c1.x + v[2] * c1.y);
        } else if (c < 2560) {
            const int s = (c - 1024) >> 8, g = ((c - 1024) >> 6) & 3;
            bf16_t* p = KV + (size_t)s * (KVSEG / 2) + ((size_t)(b * NG + g) * SEQ + t) * DH;
            if (s == 2 || s == 4) {
                const int d = (c & 63) >> 1; const float2 c0 = rope[t * 32 + d], c1 = rope[t * 32 + d + 1];
                *(unsigned*)(p + d) = pk2(v[0] * c0.x - v[1] * c0.y, v[2] * c1.x - v[3] * c1.y);
                *(unsigned*)(p + d + 32) = pk2(v[1] * c0.x + v[0] * c0.y, v[3] * c1.x + v[2] * c1.y);
            } else {
                *(u32x2*)(p + (c & 63)) = (u32x2){pk2(v[0], v[1]), pk2(v[2], v[3])};
            }
        } else if (c < NSA_IN) {
            float* gp = gates + (size_t)row * 48 + (c - 2560);
            *(f32x4*)gp = (f32x4){sigmoidf_(v[0]), sigmoidf_(v[1]), sigmoidf_(v[2]), sigmoidf_(v[3])};
        }
    }
    __device__ __forceinline__ void operator()(int row, int c, f32x4 v, f32x4 w) const {
        const int t = row & (SEQ - 1), b = row >> 13;
        const int s = (c - 1024) >> 8;
        const bool isq = c < 1024, roped = isq || s == 2 || s == 4;
        if (roped) {
            if (isq) { v = v * QSCALE; w = w * QSCALE; }
            const int g = ((c - 1024) >> 6) & 3, d = (c & 63) >> 1;
            bf16_t* p = isq ? Q + (size_t)row * DM + (c & ~63) : KV + (size_t)s * (KVSEG / 2) + ((size_t)(b * NG + g) * SEQ + t) * DH;
            const f32x4 cs01 = *(const f32x4*)(rope + t * 32 + d), cs23 = *(const f32x4*)(rope + t * 32 + d + 2);
            *(u32x2*)(p + d) = (u32x2){pk2(v[0] * cs01[0] - v[1] * cs01[1], v[2] * cs01[2] - v[3] * cs01[3]), pk2(w[0] * cs23[0] - w[1] * cs23[1], w[2] * cs23[2] - w[3] * cs23[3])};
            *(u32x2*)(p + d + 32) = (u32x2){pk2(v[1] * cs01[0] + v[0] * cs01[1], v[3] * cs01[2] + v[2] * cs01[3]), pk2(w[1] * cs23[0] + w[0] * cs23[1], w[3] * cs23[2] + w[2] * cs23[3])};
        } else {
            const int g = ((c - 1024) >> 6) & 3;
            bf16_t* p = KV + (size_t)s * (KVSEG / 2) + ((size_t)(b * NG + g) * SEQ + t) * DH + (c & 63);
            *(u32x4*)p = (u32x4){pk2(v[0], v[1]), pk2(v[2], v[3]), pk2(w[0], w[1]), pk2(w[2], w[3])};
        }
    }
};
struct EpiMobaIn {
    bf16_t* Q; bf16_t* K; bf16_t* V; const float2* rope;
    __device__ __forceinline__ void operator()(int row, int c, f32x4 v) const {
        const int t = row & (SEQ - 1), b = row >> 13;
        if (c < 2048) {
            if (c < 1024) v = v * QSCALE;
            const int d = (c & 63) >> 1; const float2 c0 = rope[t * 32 + d], c1 = rope[t * 32 + d + 1];
            bf16_t* p = c < 1024 ? Q + (size_t)row * DM + (c & ~63) : K + ((size_t)(b * NH + ((c - 1024) >> 6)) * SEQ + t) * DH;
            *(unsigned*)(p + d) = pk2(v[0] * c0.x - v[1] * c0.y, v[2] * c1.x - v[3] * c1.y);
            *(unsigned*)(p + d + 32) = pk2(v[1] * c0.x + v[0] * c0.y, v[3] * c1.x + v[2] * c1.y);
        } else {
            bf16_t* p = V + ((size_t)(b * NH + ((c - 2048) >> 6)) * SEQ + t) * DH + (c & 63);
            *(u32x2*)p = (u32x2){pk2(v[0], v[1]), pk2(v[2], v[3])};
        }
    }
    __device__ __forceinline__ void operator()(int row, int c, f32x4 v, f32x4 w) const {
        const int t = row & (SEQ - 1), b = row >> 13;
        if (c < 2048) {
            if (c < 1024) { v = v * QSCALE; w = w * QSCALE; }
            const int d = (c & 63) >> 1;
            bf16_t* p = c < 1024 ? Q + (size_t)row * DM + (c & ~63) : K + ((size_t)(b * NH + ((c - 1024) >> 6)) * SEQ + t) * DH;
            const f32x4 cs01 = *(const f32x4*)(rope + t * 32 + d), cs23 = *(const f32x4*)(rope + t * 32 + d + 2);
            *(u32x2*)(p + d) = (u32x2){pk2(v[0] * cs01[0] - v[1] * cs01[1], v[2] * cs01[2] - v[3] * cs01[3]), pk2(w[0] * cs23[0] - w[1] * cs23[1], w[2] * cs23[2] - w[3] * cs23[3])};
            *(u32x2*)(p + d + 32) = (u32x2){pk2(v[1] * cs01[0] + v[0] * cs01[1], v[3] * cs01[2] + v[2] * cs01[3]), pk2(w[1] * cs23[0] + w[0] * cs23[1], w[3] * cs23[2] + w[2] * cs23[3])};
        } else {
            bf16_t* p = V + ((size_t)(b * NH + ((c - 2048) >> 6)) * SEQ + t) * DH + (c & 63);
            *(u32x4*)p = (u32x4){pk2(v[0], v[1]), pk2(v[2], v[3]), pk2(w[0], w[1]), pk2(w[2], w[3])};
        }
    }
};
struct EpiGelu {
    bf16_t* O; const float* bias;
    __device__ __forceinline__ void operator()(int row, int c, f32x4 v) const {
        const f32x4 bv = *(const f32x4*)(bias + c);
        *(u32x2*)(O + (size_t)row * 256 + c) = (u32x2){pk2(gelu_tanh(v[0] + bv[0]), gelu_tanh(v[1] + bv[1])), pk2(gelu_tanh(v[2] + bv[2]), gelu_tanh(v[3] + bv[3]))};
    }
    __device__ __forceinline__ void operator()(int row, int c, f32x4 v, f32x4 w) const {
        const f32x4 bv = *(const f32x4*)(bias + c), bw = *(const f32x4*)(bias + c + 4);
        *(u32x4*)(O + (size_t)row * 256 + c) = (u32x4){pk2(gelu_tanh(v[0] + bv[0]), gelu_tanh(v[1] + bv[1])), pk2(gelu_tanh(v[2] + bv[2]), gelu_tanh(v[3] + bv[3])),
                                                      pk2(gelu_tanh(w[0] + bw[0]), gelu_tanh(w[1] + bw[1])), pk2(gelu_tanh(w[2] + bw[2]), gelu_tanh(w[3] + bw[3]))};
    }
};
struct EpiSwiGLU {
    bf16_t* H;
    __device__ __forceinline__ void operator()(int row, int c, f32x4 v) const {
        const float h0 = v[0] * sigmoidf_(v[0]) * v[1], h1 = v[2] * sigmoidf_(v[2]) * v[3];
        *(unsigned*)(H + (size_t)row * DE + (c >> 1)) = pk2(h0, h1);
    }
    __device__ __forceinline__ void operator()(int row, int c, f32x4 v, f32x4 w) const {
        *(u32x2*)(H + (size_t)row * DE + (c >> 1)) = (u32x2){pk2(v[0] * sigmoidf_(v[0]) * v[1], v[2] * sigmoidf_(v[2]) * v[3]), pk2(w[0] * sigmoidf_(w[0]) * w[1], w[2] * sigmoidf_(w[2]) * w[3])};
    }
};
struct EpiBf16 {
    bf16_t* Y;
    __device__ __forceinline__ void operator()(int row, int c, f32x4 v) const { *(u32x2*)(Y + (size_t)row * DM + c) = (u32x2){pk2(v[0], v[1]), pk2(v[2], v[3])}; }
    __device__ __forceinline__ void operator()(int row, int c, f32x4 v, f32x4 w) const { *(u32x4*)(Y + (size_t)row * DM + c) = (u32x4){pk2(v[0], v[1]), pk2(v[2], v[3]), pk2(w[0], w[1]), pk2(w[2], w[3])}; }
};

struct ExpertMap { int cnt[NE]; int base[NE + 1]; };
__device__ __forceinline__ void load_expert_map(const Ctx& C, int cw, LAS int* sm  ) {
    if (C.tid == 0) {
        const unsigned* ctl = (const unsigned*)(C.ws + WS_CTL); int acc = 0;
        for (int e = 0; e < NE; ++e) { const int c = (int)__hip_atomic_load(ctl + cw + 64 * e, __ATOMIC_RELAXED, __HIP_MEMORY_SCOPE_AGENT); sm[e] = c; sm[16 + e] = acc; acc += (c + 255) & ~255; }
        sm[32] = acc;
    }
    __syncthreads();
}

__device__ __forceinline__ void ph_cmp2(const Ctx& C) {
    const int gt = C.bid * NTHREADS + C.tid, NGT = C.nb * NTHREADS;
    const float2* rope = (const float2*)(C.ws + WS_ROPE);
    for (int i = gt; i < 2 * 8192 * 32; i += NGT) {
        const int which = i >= 8192 * 32; const int j = i - which * 8192 * 32; const int r = j >> 5, d = j & 31, ci = r & 511;
        const bf16_t* h = (const bf16_t*)(C.ws + (which ? WS_H1V : WS_H1K)) + (size_t)r * 256;
        const float* w2 = C.in[which ? I_CV_W2 : I_CK_W2];
        float s0 = 0.f, s1 = 0.f;
        for (int k = 0; k < 256; ++k) { const float hv = bf2f(h[k]); s0 += hv * w2[k * 64 + d]; s1 += hv * w2[k * 64 + d + 32]; }
        bf16_t* o = (bf16_t*)(C.ws + (which ? WS_VC : WS_KC)) + (size_t)r * 64;
        if (ci == 511) { s0 = 0.f; s1 = 0.f; }
        else if (!which) { const float2 cs = rope[(16 * ci + 31) * 32 + d]; const float a = s0 * cs.x - s1 * cs.y, b2 = s1 * cs.x + s0 * cs.y; s0 = a; s1 = b2; }
        o[d] = (bf16_t)f2bf(s0); o[d + 32] = (bf16_t)f2bf(s1);
    }
}

__device__ __forceinline__ void load_qh(const bf16_t* qp, float (&qh)[64]) {
    const uint4* q4 = (const uint4*)qp;
#pragma unroll
    for (int c = 0; c < 8; ++c) { const uint4 w = q4[c]; qh[8 * c] = bflo(w.x); qh[8 * c + 1] = bfhi(w.x); qh[8 * c + 2] = bflo(w.y); qh[8 * c + 3] = bfhi(w.y);
        qh[8 * c + 4] = bflo(w.z); qh[8 * c + 5] = bfhi(w.z); qh[8 * c + 6] = bflo(w.w); qh[8 * c + 7] = bfhi(w.w); }
}
namespace fa {
constexpr int SLOT = 16384, NSLOT = 4;
constexpr float C2 = 0.125f * 1.4426950408889634f;
constexpr float NEGBIG = -1e30f;
typedef short v4i16 __attribute__((ext_vector_type(4)));
__device__ __forceinline__ void dma_block(LAS unsigned char* slot, const bf16_t* Kg, const bf16_t* Vg, int wave, int lane) {
    { const int key = 8 * wave + (lane >> 3), c = (lane & 7) ^ ((key >> 1) & 7);
      __builtin_amdgcn_global_load_lds((const unsigned*)(Kg + key * 64 + 8 * c), (LAS unsigned*)(slot + wave * 1024), 16, 0, 0); }
    { const int key = 16 * (wave & 3) + (lane >> 2), cp = lane & 3, d = (wave >> 2) * 32 + ((((cp >> 1) ^ ((key >> 2) & 1))) << 4) + ((cp & 1) << 3);
      __builtin_amdgcn_global_load_lds((const unsigned*)(Vg + key * 64 + d), (LAS unsigned*)(slot + 8192 + wave * 1024), 16, 0, 0); }
}
__device__ __forceinline__ unsigned cvt_pk_bf16(float lo, float hi) { const f32x2v v = {lo, hi}; const bf16x2v b = __builtin_convertvector(v, bf16x2v); return __builtin_bit_cast(unsigned, b); }
struct Task { bf16x8 q[2]; int kmin, kmax; float m, l, cinit; f32x4 O[4]; f32x4 L; unsigned fw0; const LAS unsigned* fwp; int imptok; };
template <int FM> __device__ __forceinline__ bool row_flag(const Task& t, int jb) {
    if (FM == 0) return true;
    if (FM == 1) { const unsigned w = t.fwp[jb >> 5]; return ((w >> (jb & 31)) & 1u) != 0u; }
    return ((t.fw0 >> (jb >> 2)) & 1u) != 0u;
}
struct LaneC { int fq, koff0, koff1, voffA, voffB; };
__device__ __forceinline__ LaneC lane_consts(int lane) {
    const int i16 = lane & 15, fq = lane >> 4, kx = (i16 >> 1) & 7, q4 = i16 >> 2, p4 = lane & 3;
    LaneC lc; lc.fq = fq; lc.koff0 = i16 * 128 + ((fq ^ kx) << 4); lc.koff1 = i16 * 128 + (((4 + fq) ^ kx) << 4);
    lc.voffA = 8192 + (4 * fq + q4) * 64 + ((0 ^ (fq & 1)) << 5) + 8 * p4; lc.voffB = 8192 + (4 * fq + q4) * 64 + ((1 ^ (fq & 1)) << 5) + 8 * p4;
    return lc;
}
__device__ __forceinline__ float xrow16_max(float x) {
    auto s = __builtin_amdgcn_permlane16_swap(__float_as_uint(x), __float_as_uint(x), false, false);
    x = fmaxf(__uint_as_float(s[0]), __uint_as_float(s[1]));
    auto t = __builtin_amdgcn_permlane32_swap(__float_as_uint(x), __float_as_uint(x), false, false);
    return fmaxf(__uint_as_float(t[0]), __uint_as_float(t[1]));
}
__device__ __forceinline__ float xrow16_sum(float x) {
    auto s = __builtin_amdgcn_permlane16_swap(__float_as_uint(x), __float_as_uint(x), false, false);
    x = __uint_as_float(s[0]) + __uint_as_float(s[1]);
    auto t = __builtin_amdgcn_permlane32_swap(__float_as_uint(x), __float_as_uint(x), false, false);
    return __uint_as_float(t[0]) + __uint_as_float(t[1]);
}
__device__ __forceinline__ void t_mask(const Task& t, f32x4 (&s)[4], int kb, int fq) {
#pragma unroll
    for (int kt = 0; kt < 4; ++kt)
#pragma unroll
        for (int r = 0; r < 4; ++r) { const int key = kb + 16 * kt + 4 * fq + r; s[kt][r] = (key >= t.kmin && key <= t.kmax) ? s[kt][r] : NEGBIG; }
}
template <int MODE> __device__ __forceinline__ float t_stats(Task& t, f32x4 (&s)[4], bool rf) {
    float bm = fmaxf(fmaxf(fmaxf(s[0][0], s[0][1]), fmaxf(s[0][2], s[0][3])), fmaxf(fmaxf(s[1][0], s[1][1]), fmaxf(s[1][2], s[1][3])));
    bm = fmaxf(bm, fmaxf(fmaxf(fmaxf(s[2][0], s[2][1]), fmaxf(s[2][2], s[2][3])), fmaxf(fmaxf(s[3][0], s[3][1]), fmaxf(s[3][2], s[3][3]))));
    bm = xrow16_max(bm);
    if (!rf) bm = NEGBIG;
    const float mnew = fmaxf(t.m, bm);
    const float alpha = __builtin_amdgcn_exp2f(t.m - mnew);
    t.m = mnew;
    const float msub = (rf && mnew > -1e29f) ? mnew : __builtin_inff();
#pragma unroll
    for (int kt = 0; kt < 4; ++kt) s[kt] = s[kt] - msub;
    if (MODE == 1) t.l *= alpha;
    return alpha;
}
__device__ __forceinline__ void t_exp(f32x4 (&s)[4]) {
#pragma unroll
    for (int kt = 0; kt < 4; ++kt)
#pragma unroll
        for (int r = 0; r < 4; ++r) s[kt][r] = __builtin_amdgcn_exp2f(s[kt][r]);
}
__device__ __forceinline__ float quad_sum(float x) {
    x += __builtin_bit_cast(float, __builtin_amdgcn_mov_dpp(__builtin_bit_cast(int, x), 0xB1, 0xf, 0xf, true));
    x += __builtin_bit_cast(float, __builtin_amdgcn_mov_dpp(__builtin_bit_cast(int, x), 0x4E, 0xf, 0xf, true));
    return x;
}
__device__ __forceinline__ void t_imp(const Task& t, const f32x4 (&s)[4], int kb, int fq, LAS float* impbase) {
    float ga[4], gb[4];
#pragma unroll
    for (int kt = 0; kt < 4; ++kt) { ga[kt] = quad_sum((s[kt][0] + s[kt][1]) + (s[kt][2] + s[kt][3])); gb[kt] = quad_sum(s[kt][3]); }
    if ((t.imptok & 0x10000) == 0) return;
    LAS float* ip = impbase + (t.imptok & 0xffff) * 130 + (kb >> 2) + fq;
#pragma unroll
    for (int kt = 0; kt < 4; ++kt) { ip[4 * kt] = ga[kt]; ip[64 * 130 + 4 * kt] = gb[kt]; }
}
__device__ __forceinline__ bf16x8 t_pack(const f32x4 (&s)[4], int u) {
    u32x4 pw; pw.x = cvt_pk_bf16(s[2 * u][0], s[2 * u][1]); pw.y = cvt_pk_bf16(s[2 * u][2], s[2 * u][3]); pw.z = cvt_pk_bf16(s[2 * u + 1][0], s[2 * u + 1][1]); pw.w = cvt_pk_bf16(s[2 * u + 1][2], s[2 * u + 1][3]);
    return __builtin_bit_cast(bf16x8, pw);
}
template <int MODE, bool DA, bool DB>
__device__ __forceinline__ void do_blk(Task& a, Task& b, bool rfa, bool rfb, bool masked, LAS unsigned char* slot, int kb, LAS float* impbase, const LaneC& lc) {
    f32x4 sa[4], sb[4];
    const float xa = (MODE >= 2) ? (rfa ? a.cinit : -__builtin_inff()) : 0.f, xb = (MODE >= 2) ? (rfb ? b.cinit : -__builtin_inff()) : 0.f;
    const f32x4 ca = (f32x4){xa, xa, xa, xa}, cb = (f32x4){xb, xb, xb, xb};
#pragma unroll
    for (int kt = 0; kt < 4; ++kt) {
        const bf16x8 k0 = *(const LAS bf16x8*)(slot + lc.koff0 + kt * 2048), k1 = *(const LAS bf16x8*)(slot + lc.koff1 + kt * 2048);
        if (DA) { sa[kt] = __builtin_amdgcn_mfma_f32_16x16x32_bf16(k0, a.q[0], ca, 0, 0, 0); sa[kt] = __builtin_amdgcn_mfma_f32_16x16x32_bf16(k1, a.q[1], sa[kt], 0, 0, 0); }
        if (DB) { sb[kt] = __builtin_amdgcn_mfma_f32_16x16x32_bf16(k0, b.q[0], cb, 0, 0, 0); sb[kt] = __builtin_amdgcn_mfma_f32_16x16x32_bf16(k1, b.q[1], sb[kt], 0, 0, 0); }
    }
    if (masked) { if (DA) t_mask(a, sa, kb, lc.fq); if (DB) t_mask(b, sb, kb, lc.fq); }
    if (MODE < 2) {
        float ala = 1.0f, alb = 1.0f;
        if (DA) ala = t_stats<MODE>(a, sa, rfa);
        if (DB) alb = t_stats<MODE>(b, sb, rfb);
        if (MODE == 0) {
            if (__ballot((DA && ala != 1.0f) || (DB && alb != 1.0f)) != 0ull) {
#pragma unroll
                for (int dt = 0; dt < 4; ++dt) { if (DA) a.O[dt] = a.O[dt] * ala; if (DB) b.O[dt] = b.O[dt] * alb; }
                if (DA) a.L = a.L * ala; if (DB) b.L = b.L * alb;
            }
        }
    }
    if (DA) t_exp(sa);
    if (DB) t_exp(sb);
    if (MODE == 1) {
        if (DA) a.l += ((sa[0][0] + sa[0][1]) + (sa[0][2] + sa[0][3])) + ((sa[1][0] + sa[1][1]) + (sa[1][2] + sa[1][3])) + ((sa[2][0] + sa[2][1]) + (sa[2][2] + sa[2][3])) + ((sa[3][0] + sa[3][1]) + (sa[3][2] + sa[3][3]));
        if (DB) b.l += ((sb[0][0] + sb[0][1]) + (sb[0][2] + sb[0][3])) + ((sb[1][0] + sb[1][1]) + (sb[1][2] + sb[1][3])) + ((sb[2][0] + sb[2][1]) + (sb[2][2] + sb[2][3])) + ((sb[3][0] + sb[3][1]) + (sb[3][2] + sb[3][3]));
    }
    if (MODE == 2) { if (DA) t_imp(a, sa, kb, lc.fq, impbase); if (DB) t_imp(b, sb, kb, lc.fq, impbase); }
    if (MODE != 1) {
        const bf16x8 ones = (bf16x8){0x3F80, 0x3F80, 0x3F80, 0x3F80, 0x3F80, 0x3F80, 0x3F80, 0x3F80};
#pragma unroll
        for (int u = 0; u < 2; ++u) {
            bf16x8 pa, pb; if (DA) pa = t_pack(sa, u); if (DB) pb = t_pack(sb, u);
            if (MODE != 2) { if (DA) a.L = __builtin_amdgcn_mfma_f32_16x16x32_bf16(ones, pa, a.L, 0, 0, 0); if (DB) b.L = __builtin_amdgcn_mfma_f32_16x16x32_bf16(ones, pb, b.L, 0, 0, 0); }
#pragma unroll
            for (int dt = 0; dt < 4; ++dt) {
                const int vo = ((dt & 1) ? lc.voffB : lc.voffA) + (dt >> 1) * 4096 + u * 2048;
                const v4i16 a0 = __builtin_amdgcn_ds_read_tr16_b64_v4i16((LAS v4i16*)(slot + vo)), a1 = __builtin_amdgcn_ds_read_tr16_b64_v4i16((LAS v4i16*)(slot + vo + 1024));
                const bf16x8 vf = (bf16x8){a0[0], a0[1], a0[2], a0[3], a1[0], a1[1], a1[2], a1[3]};
                if (DA) a.O[dt] = __builtin_amdgcn_mfma_f32_16x16x32_bf16(vf, pa, a.O[dt], 0, 0, 0);
                if (DB) b.O[dt] = __builtin_amdgcn_mfma_f32_16x16x32_bf16(vf, pb, b.O[dt], 0, 0, 0);
            }
        }
    }
}
template <int MODE, int FM>
__device__ __forceinline__ void flash_loop(LAS unsigned char* ring, const bf16_t* Kg, const bf16_t* Vg, int nblk, Task& Ta, Task& Tb, LAS float* impbase, int wave, int lane) {
    const int i16 = lane & 15, fq = lane >> 4;
    const int kx = (i16 >> 1) & 7;
    const int q4 = i16 >> 2, p4 = lane & 3;
    LaneC lc; lc.fq = fq; lc.koff0 = i16 * 128 + ((fq ^ kx) << 4); lc.koff1 = i16 * 128 + (((4 + fq) ^ kx) << 4);
    lc.voffA = 8192 + (4 * fq + q4) * 64 + ((0 ^ (fq & 1)) << 5) + 8 * p4; lc.voffB = 8192 + (4 * fq + q4) * 64 + ((1 ^ (fq & 1)) << 5) + 8 * p4;
    const int amin = __builtin_amdgcn_readlane(Ta.kmin, 15), amax = __builtin_amdgcn_readlane(Ta.kmax, 0), bmin = __builtin_amdgcn_readlane(Tb.kmin, 15), bmax = __builtin_amdgcn_readlane(Tb.kmax, 0);
#pragma unroll
    for (int j = 0; j < NSLOT - 1; ++j) { const int jj = j < nblk ? j : nblk - 1; dma_block(ring + j * SLOT, Kg + (size_t)jj * 4096, Vg + (size_t)jj * 4096, wave, lane); }
    for (int jb = 0; jb < nblk; ++jb) {
        asm volatile("s_waitcnt vmcnt(4) lgkmcnt(0)\n\ts_barrier" ::: "memory");
        { const int jn = jb + 3 < nblk ? jb + 3 : nblk - 1; dma_block(ring + ((jb + 3) & 3) * SLOT, Kg + (size_t)jn * 4096, Vg + (size_t)jn * 4096, wave, lane); }
        LAS unsigned char* slot = ring + (jb & 3) * SLOT;
        const int kb = jb * 64;
        const bool rfa = row_flag<FM>(Ta, jb), rfb = row_flag<FM>(Tb, jb);
        const bool na = __ballot(rfa && Ta.kmax >= kb && Ta.kmin <= kb + 63) != 0ull, nb2 = __ballot(rfb && Tb.kmax >= kb && Tb.kmin <= kb + 63) != 0ull;
        const bool masked = !((!na || (kb >= amin && kb + 63 <= amax)) && (!nb2 || (kb >= bmin && kb + 63 <= bmax)));
        if (FM == 1) {
            if (na) do_blk<MODE, true, false>(Ta, Tb, rfa, rfb, masked, slot, kb, impbase, lc);
            if (nb2) do_blk<MODE, false, true>(Ta, Tb, rfa, rfb, masked, slot, kb, impbase, lc);
        } else {
            if (na || nb2) do_blk<MODE, true, true>(Ta, Tb, rfa, rfb, masked, slot, kb, impbase, lc);
        }
    }
    asm volatile("s_waitcnt vmcnt(0) lgkmcnt(0)\n\ts_barrier" ::: "memory");
}
template <int MODE, int FM>
__device__ __forceinline__ void flash_loop2(LAS unsigned char* ring, const bf16_t* Kg, const bf16_t* Vg, int nblk, Task& Ta, Task& Tb, LAS float* impbase, int wave, int lane) {
    const int i16 = lane & 15, fq = lane >> 4;
    const int kx = (i16 >> 1) & 7;
    const int q4 = i16 >> 2, p4 = lane & 3;
    LaneC lc; lc.fq = fq; lc.koff0 = i16 * 128 + ((fq ^ kx) << 4); lc.koff1 = i16 * 128 + (((4 + fq) ^ kx) << 4);
    lc.voffA = 8192 + (4 * fq + q4) * 64 + ((0 ^ (fq & 1)) << 5) + 8 * p4; lc.voffB = 8192 + (4 * fq + q4) * 64 + ((1 ^ (fq & 1)) << 5) + 8 * p4;
    const int amin = __builtin_amdgcn_readlane(Ta.kmin, 15), amax = __builtin_amdgcn_readlane(Ta.kmax, 0), bmin = __builtin_amdgcn_readlane(Tb.kmin, 15), bmax = __builtin_amdgcn_readlane(Tb.kmax, 0);
    const int nit = (nblk + 1) >> 1;
#pragma unroll
    for (int j = 0; j < 2; ++j) { const int jj = j < nblk ? j : nblk - 1; dma_block(ring + j * SLOT, Kg + (size_t)jj * 4096, Vg + (size_t)jj * 4096, wave, lane); }
    for (int i = 0; i < nit; ++i) {
        asm volatile("s_waitcnt vmcnt(0) lgkmcnt(0)\n\ts_barrier" ::: "memory");
#pragma unroll
        for (int j = 0; j < 2; ++j) { const int jn = 2 * i + 2 + j < nblk ? 2 * i + 2 + j : nblk - 1; dma_block(ring + ((2 * i + 2 + j) & 3) * SLOT, Kg + (size_t)jn * 4096, Vg + (size_t)jn * 4096, wave, lane); }
        if (FM == 1 && !SEL_FUSED) {
#pragma unroll
        for (int k = 0; k < 2; ++k) {
            const int jb = 2 * i + k;
            if (jb < nblk) {
                LAS unsigned char* slot = ring + (jb & 3) * SLOT;
                const int kb = jb * 64;
                const bool rfa = row_flag<FM>(Ta, jb), rfb = row_flag<FM>(Tb, jb);
                const bool na = __ballot(rfa && Ta.kmax >= kb && Ta.kmin <= kb + 63) != 0ull, nb2 = __ballot(rfb && Tb.kmax >= kb && Tb.kmin <= kb + 63) != 0ull;
                const bool masked = !((!na || (kb >= amin && kb + 63 <= amax)) && (!nb2 || (kb >= bmin && kb + 63 <= bmax)));
                if (na) do_blk<MODE, true, false>(Ta, Tb, rfa, rfb, masked, slot, kb, impbase, lc);
                if (nb2) do_blk<MODE, false, true>(Ta, Tb, rfa, rfb, masked, slot, kb, impbase, lc);
            }
        }
        } else {
            const int j0 = 2 * i, j1 = 2 * i + 1;
            const bool ra0 = row_flag<FM>(Ta, j0), rb0 = row_flag<FM>(Tb, j0), ra1 = j1 < nblk && row_flag<FM>(Ta, j1), rb1 = j1 < nblk && row_flag<FM>(Tb, j1);
            if (__ballot(ra0 || rb0 || ra1 || rb1) != 0ull) {
                const int k0 = j0 * 64, k1 = j1 * 64;
                const bool mk = (FM == 0) && !(k0 >= amin && k1 + 63 <= amax && k0 >= bmin && k1 + 63 <= bmax);
                if (!mk) {
                    do_blk<MODE, true, true>(Ta, Tb, ra0, rb0, false, ring + (j0 & 3) * SLOT, k0, impbase, lc);
                    if (FM != 2) __builtin_amdgcn_sched_barrier(0);
                    do_blk<MODE, true, true>(Ta, Tb, ra1, rb1, false, ring + (j1 & 3) * SLOT, k1, impbase, lc);
                } else {
                    do_blk<MODE, true, true>(Ta, Tb, ra0, rb0, true, ring + (j0 & 3) * SLOT, k0, impbase, lc);
                    __builtin_amdgcn_sched_barrier(0);
                    do_blk<MODE, true, true>(Ta, Tb, ra1, rb1, true, ring + (j1 & 3) * SLOT, k1, impbase, lc);
                }
            }
        }
    }
    asm volatile("s_waitcnt vmcnt(0) lgkmcnt(0)\n\ts_barrier" ::: "memory");
}
__device__ __forceinline__ void task_reset(Task& t) { t.m = NEGBIG; t.l = 0.f; t.cinit = 0.f; t.L = (f32x4){0.f, 0.f, 0.f, 0.f};
#pragma unroll
    for (int dt = 0; dt < 4; ++dt) t.O[dt] = (f32x4){0.f, 0.f, 0.f, 0.f}; }
__device__ __forceinline__ float task_rowsum(const Task& t) { return t.L[0]; }
__device__ __forceinline__ float task_rowsum_stats(const Task& t) { return xrow16_sum(t.l); }
constexpr float REF_DELTA = 32.f;
__device__ __forceinline__ void task_fix_ref(Task& t) {
    t.cinit = -(t.m + REF_DELTA);
    const float sc = __builtin_amdgcn_exp2f(-REF_DELTA);
    t.L = t.L * sc;
#pragma unroll
    for (int dt = 0; dt < 4; ++dt) t.O[dt] = t.O[dt] * sc;
}
}

struct NsaRow { int RI, c, b; u32x2 out[4];
    __device__ __forceinline__ int tokl() const { return RI >> 2; }
    __device__ __forceinline__ int head() const { return RI & 3; }
    __device__ __forceinline__ int tt() const { return 64 * c + (RI >> 2); }
    __device__ __forceinline__ size_t grow() const { return (size_t)(b * SEQ + 64 * c + (RI >> 2)); }
};
__device__ __forceinline__ void nsa_row_init(NsaRow& r, fa::Task& t, const bf16_t* Q, int b, int g, int c, int R, int fq) {
    r.RI = R; r.c = c; r.b = b;
    const bf16_t* qp = Q + r.grow() * DM + (g * 4 + r.head()) * DH + 8 * fq;
    t.q[0] = *(const bf16x8*)qp; t.q[1] = *(const bf16x8*)(qp + 32);
    t.imptok = r.tokl() | (r.head() == 0 ? 0x10000 : 0); t.fw0 = 0u; t.fwp = nullptr;
#pragma unroll
    for (int dt = 0; dt < 4; ++dt) r.out[dt] = (u32x2){0u, 0u};
}
__device__ __forceinline__ void nsa_cmp_setup(const NsaRow& r, fa::Task& t) {
    const int tt_ = r.tt(); const int nv = tt_ >= 31 ? (((tt_ - 31) >> 4) + 1 > 511 ? 511 : ((tt_ - 31) >> 4) + 1) : 0;
    t.kmin = 0; t.kmax = nv - 1; fa::task_reset(t);
}
__device__ __forceinline__ void nsa_accum(NsaRow& r, const fa::Task& t, float sc) {
#pragma unroll
    for (int dt = 0; dt < 4; ++dt) { const f32x4 o = t.O[dt] * sc; const u32x2 w = r.out[dt];
        r.out[dt] = (u32x2){pk2(bflo(w.x) + o[0], bfhi(w.x) + o[1]), pk2(bflo(w.y) + o[2], bfhi(w.y) + o[3])}; }
}
__device__ __forceinline__ void nsa_store(const NsaRow& r, bf16_t* AO, int g, int fq) {
    bf16_t* op = AO + r.grow() * DM + (g * 4 + r.head()) * DH + 4 * fq;
#pragma unroll
    for (int dt = 0; dt < 4; ++dt) *(u32x2*)(op + 16 * dt) = r.out[dt];
}
__device__ __forceinline__ void ph_nsa_fa(const Ctx& C) {
    LAS unsigned char* L = (LAS unsigned char*)C.lds;
    LAS unsigned char* ring = L;
    LAS float* imp = (LAS float*)(L + 65536);
    LAS unsigned* selm = (LAS unsigned*)(L + 135168);
    const bf16_t* Q = (const bf16_t*)(C.ws + WS_Q); const bf16_t* KC = (const bf16_t*)(C.ws + WS_KC); const bf16_t* VC = (const bf16_t*)(C.ws + WS_VC);
    const bf16_t* KS = (const bf16_t*)(C.ws + WS_KV0 + 2 * KVSEG); const bf16_t* VS = (const bf16_t*)(C.ws + WS_KV0 + 3 * KVSEG);
    const bf16_t* KW = (const bf16_t*)(C.ws + WS_KV0 + 4 * KVSEG); const bf16_t* VW = (const bf16_t*)(C.ws + WS_KV0 + 5 * KVSEG);
    const float* gates = (const float*)(C.ws + WS_GATES); bf16_t* AO = (bf16_t*)(C.ws + WS_XB);
    const int wave = C.wave;
    for (int u = C.bid; u < NB * NG * (SEQ / 64); u += C.nb) {
        int lane = C.lane; asm volatile("" : "+v"(lane));
        const int i16 = lane & 15, fq = lane >> 4;
        const int rnd = u / C.nb, idx = (u % C.nb) >> 4, bg = u & 15, b = bg >> 2, g = bg & 3;
        const int c = (C.nb == 256) ? 127 - 16 * rnd - ((rnd & 1) ? 15 - idx : idx) : 127 - (u >> 4);
        fa::Task T0, T1; NsaRow R0, R1;
        nsa_row_init(R0, T0, Q, b, g, c, 32 * wave + i16, fq);
        nsa_row_init(R1, T1, Q, b, g, c, 32 * wave + 16 + i16, fq);
        for (int i = C.tid; i < 2 * 64 * 130; i += NTHREADS) imp[i] = 0.f;
        if (C.tid < 256) selm[C.tid] = 0u;
        const int nvm = ((64 * c + 63 - 31) >> 4) + 1;
        const int nvmax = nvm > 511 ? 511 : nvm;
        const int nblkc = (nvmax + 63) >> 6;
        nsa_cmp_setup(R0, T0); nsa_cmp_setup(R1, T1);
        fa::flash_loop<1, 0>(ring, KC + (size_t)bg * 512 * DH, VC + (size_t)bg * 512 * DH, nblkc, T0, T1, imp, wave, lane);
        { const float l0 = fa::task_rowsum_stats(T0), l1 = fa::task_rowsum_stats(T1);
          T0.cinit = l0 > 0.f ? -T0.m - __builtin_amdgcn_logf(l0) : -__builtin_inff(); T1.cinit = l1 > 0.f ? -T1.m - __builtin_amdgcn_logf(l1) : -__builtin_inff(); }
        fa::flash_loop<2, 0>(ring, KC + (size_t)bg * 512 * DH, VC + (size_t)bg * 512 * DH, nblkc, T0, T1, imp, wave, lane);
        nsa_accum(R0, T0, gates[R0.grow() * 48 + g * 4 + R0.head()]);
        nsa_accum(R1, T1, gates[R1.grow() * 48 + g * 4 + R1.head()]);
        {
            const int jq = c, ncand = jq - 2 > 0 ? jq - 2 : 0, nforced = jq == 0 ? 1 : (jq == 1 ? 2 : 3), need = 16 - nforced;
#pragma unroll
            for (int g2 = 0; g2 < 2; ++g2) {
                const int tk = 8 * wave + 4 * g2 + (lane >> 4);
                unsigned key[8]; unsigned selb = 0u;
#pragma unroll
                for (int k = 0; k < 8; ++k) { const int j = i16 + 16 * k; const bool cand = j >= 1 && j <= jq - 2;
                    key[k] = cand ? ((__float_as_uint(imp[tk * 130 + j] + imp[64 * 130 + tk * 130 + j - 1]) & 0xFFFFFF80u) | (unsigned)(127 - j)) : 0u; }
                if (ncand <= need) {
#pragma unroll
                    for (int k = 0; k < 8; ++k) selb |= (key[k] != 0u) ? (1u << k) : 0u;
                } else {
                    for (int r = 0; r < need; ++r) {
                        unsigned m = max(max(max(key[0], key[1]), max(key[2], key[3])), max(max(key[4], key[5]), max(key[6], key[7])));
                        m = max(m, (unsigned)__builtin_amdgcn_mov_dpp((int)m, 0xB1, 0xf, 0xf, true));
                        m = max(m, (unsigned)__builtin_amdgcn_mov_dpp((int)m, 0x4E, 0xf, 0xf, true));
                        m = max(m, (unsigned)__builtin_amdgcn_mov_dpp((int)m, 0x141, 0xf, 0xf, true));
                        m = max(m, (unsigned)__builtin_amdgcn_mov_dpp((int)m, 0x140, 0xf, 0xf, true));
#pragma unroll
                        for (int k = 0; k < 8; ++k) { const bool hit = key[k] == m; selb |= hit ? (1u << k) : 0u; key[k] = hit ? 0u : key[k]; }
                    }
                }
#pragma unroll
                for (int k = 0; k < 8; ++k) { const int j = i16 + 16 * k; if (j == 0 || j == jq || j == jq - 1) selb |= 1u << k; }
#pragma unroll
                for (int w2 = 0; w2 < 4; ++w2) {
                    const unsigned bits = (((selb >> (2 * w2)) & 1u) << i16) | (((selb >> (2 * w2 + 1)) & 1u) << (16 + i16));
                    if (bits) __hip_atomic_fetch_or(selm + tk * 4 + w2, bits, __ATOMIC_RELAXED, __HIP_MEMORY_SCOPE_WORKGROUP);
                }
            }
        }
        asm volatile("s_waitcnt lgkmcnt(0)\n\ts_barrier" ::: "memory");
        {
            const int jlo = c - 8 > 0 ? c - 8 : 0;
            T0.kmin = 0; T0.kmax = R0.tokl(); fa::task_reset(T0); T1.kmin = 0; T1.kmax = R1.tokl(); fa::task_reset(T1);
            fa::flash_loop<0, 0>(ring, KW + ((size_t)bg * SEQ + 64 * c) * DH, VW + ((size_t)bg * SEQ + 64 * c) * DH, 1, T0, T1, imp, wave, lane);
            fa::task_fix_ref(T0); fa::task_fix_ref(T1);
            T0.kmin = R0.tt() - 511 - 64 * jlo; T0.kmax = R0.tt() - 64 * jlo; T1.kmin = R1.tt() - 511 - 64 * jlo; T1.kmax = R1.tt() - 64 * jlo;
            if (c > jlo) fa::flash_loop2<3, 0>(ring, KW + ((size_t)bg * SEQ + 64 * jlo) * DH, VW + ((size_t)bg * SEQ + 64 * jlo) * DH, c - jlo, T0, T1, imp, wave, lane);
            const float l0 = fa::task_rowsum(T0), l1 = fa::task_rowsum(T1);
            nsa_accum(R0, T0, (l0 > 0.f ? 1.0f / l0 : 0.f) * gates[R0.grow() * 48 + 32 + g * 4 + R0.head()]);
            nsa_accum(R1, T1, (l1 > 0.f ? 1.0f / l1 : 0.f) * gates[R1.grow() * 48 + 32 + g * 4 + R1.head()]);
        }
        {
            T0.fwp = selm + R0.tokl() * 4; T1.fwp = selm + R1.tokl() * 4;
            T0.kmin = 0; T0.kmax = R0.tokl(); fa::task_reset(T0); T1.kmin = 0; T1.kmax = R1.tokl(); fa::task_reset(T1);
            fa::flash_loop<0, 0>(ring, KS + ((size_t)bg * SEQ + 64 * c) * DH, VS + ((size_t)bg * SEQ + 64 * c) * DH, 1, T0, T1, imp, wave, lane);
            T0.kmax = R0.tt(); T1.kmax = R1.tt(); fa::task_fix_ref(T0); fa::task_fix_ref(T1);
            if (c > 0) fa::flash_loop2<3, 1>(ring, KS + (size_t)bg * SEQ * DH, VS + (size_t)bg * SEQ * DH, c, T0, T1, imp, wave, lane);
            const float l0 = fa::task_rowsum(T0), l1 = fa::task_rowsum(T1);
            nsa_accum(R0, T0, (l0 > 0.f ? 1.0f / l0 : 0.f) * gates[R0.grow() * 48 + 16 + g * 4 + R0.head()]);
            nsa_accum(R1, T1, (l1 > 0.f ? 1.0f / l1 : 0.f) * gates[R1.grow() * 48 + 16 + g * 4 + R1.head()]);
        }
        nsa_store(R0, AO, g, fq); nsa_store(R1, AO, g, fq);
    }
}

__device__ __forceinline__ void ph_moba_fa(const Ctx& C) {
    LAS unsigned char* L = (LAS unsigned char*)C.lds;
    LAS unsigned char* ring = L;
    LAS unsigned char* kmt = L + 65536;
    LAS float* kms = (LAS float*)(L + 65536);
    const bf16_t* Q = (const bf16_t*)(C.ws + WS_Q); const bf16_t* K1 = (const bf16_t*)(C.ws + WS_K1); const bf16_t* V1 = (const bf16_t*)(C.ws + WS_V1);
    const float* KM = (const float*)(C.ws + WS_KMEAN); bf16_t* AO = (bf16_t*)(C.ws + WS_XB);
    const int wave = C.wave;
    for (int u = C.bid; u < NB * NH * 32; u += C.nb) {
        int lane = C.lane; asm volatile("" : "+v"(lane));
        const int i16 = lane & 15, fq = lane >> 4;
        const int rnd = u / C.nb, idx = (u % C.nb) >> 6, bh = u & 63, b = bh >> 4, h = bh & 15;
        const int cb = (C.nb == 256) ? 31 - 4 * rnd - ((rnd & 1) ? 3 - idx : idx) : 31 - (u >> 6);
        if (C.tid < 256) {
            const int n = C.tid >> 3, c8 = C.tid & 7;
            const f32x4 a = *(const f32x4*)(KM + (size_t)bh * 2048 + n * 64 + 8 * c8), b2 = *(const f32x4*)(KM + (size_t)bh * 2048 + n * 64 + 8 * c8 + 4);
            u32x4 hi, lo;
            hi.x = pk2(a[0], a[1]); hi.y = pk2(a[2], a[3]); hi.z = pk2(b2[0], b2[1]); hi.w = pk2(b2[2], b2[3]);
            lo.x = pk2(a[0] - bflo(hi.x), a[1] - bfhi(hi.x)); lo.y = pk2(a[2] - bflo(hi.y), a[3] - bfhi(hi.y)); lo.z = pk2(b2[0] - bflo(hi.z), b2[1] - bfhi(hi.z)); lo.w = pk2(b2[2] - bflo(hi.w), b2[3] - bfhi(hi.w));
            const int off = n * 128 + ((c8 ^ ((n >> 1) & 7)) << 4);
            *(LAS u32x4*)(kmt + off) = hi; *(LAS u32x4*)(kmt + 4096 + off) = lo;
        }
        asm volatile("s_waitcnt vmcnt(0) lgkmcnt(0)\n\ts_barrier" ::: "memory");
        fa::Task T[2]; int tt[2];
#pragma unroll
        for (int ti = 0; ti < 2; ++ti) {
            const int R = 32 * wave + 16 * ti + i16; tt[ti] = 256 * cb + R; T[ti].imptok = 0;
            const bf16_t* qp = Q + (size_t)(b * SEQ + tt[ti]) * DM + h * DH + 8 * fq;
            T[ti].q[0] = *(const bf16x8*)qp; T[ti].q[1] = *(const bf16x8*)(qp + 32);
            T[ti].kmin = 0; T[ti].kmax = tt[ti]; fa::task_reset(T[ti]);
            const int kx = (i16 >> 1) & 7, ko0 = i16 * 128 + ((fq ^ kx) << 4), ko1 = i16 * 128 + (((4 + fq) ^ kx) << 4);
            float bv0 = -3e38f, bv1 = -3e38f, bv2 = -3e38f; int j0 = 99, j1 = 99, j2 = 99;
#define INS3(a, n) do { if ((a) > bv0 || ((a) == bv0 && (n) < j0)) { bv2 = bv1; j2 = j1; bv1 = bv0; j1 = j0; bv0 = (a); j0 = (n); } \
                else if ((a) > bv1 || ((a) == bv1 && (n) < j1)) { bv2 = bv1; j2 = j1; bv1 = (a); j1 = (n); } \
                else if ((a) > bv2 || ((a) == bv2 && (n) < j2)) { bv2 = (a); j2 = (n); } } while (0)
#pragma unroll
            for (int kt2 = 0; kt2 < 2; ++kt2) {
                const bf16x8 h0 = *(const LAS bf16x8*)(kmt + ko0 + kt2 * 2048), h1 = *(const LAS bf16x8*)(kmt + ko1 + kt2 * 2048);
                const bf16x8 l0 = *(const LAS bf16x8*)(kmt + 4096 + ko0 + kt2 * 2048), l1 = *(const LAS bf16x8*)(kmt + 4096 + ko1 + kt2 * 2048);
                f32x4 g = __builtin_amdgcn_mfma_f32_16x16x32_bf16(l0, T[ti].q[0], (f32x4){0.f, 0.f, 0.f, 0.f}, 0, 0, 0);
                g = __builtin_amdgcn_mfma_f32_16x16x32_bf16(l1, T[ti].q[1], g, 0, 0, 0);
                g = __builtin_amdgcn_mfma_f32_16x16x32_bf16(h0, T[ti].q[0], g, 0, 0, 0);
                g = __builtin_amdgcn_mfma_f32_16x16x32_bf16(h1, T[ti].q[1], g, 0, 0, 0);
#pragma unroll
                for (int r = 0; r < 4; ++r) { const int n = 16 * kt2 + 4 * fq + r; const float a = n < cb ? g[r] : -3e38f; INS3(a, n); }
            }
#pragma unroll
            for (int o = 16; o <= 32; o <<= 1) {
                const float ov0 = __shfl_xor(bv0, o), ov1 = __shfl_xor(bv1, o), ov2 = __shfl_xor(bv2, o); const int oj0 = __shfl_xor(j0, o), oj1 = __shfl_xor(j1, o), oj2 = __shfl_xor(j2, o);
                INS3(ov0, oj0); INS3(ov1, oj1); INS3(ov2, oj2);
            }
#undef INS3
            unsigned mk = 1u << cb;
            if (j0 < cb && bv0 > -1e38f) mk |= 1u << j0; if (j1 < cb && bv1 > -1e38f) mk |= 1u << j1; if (j2 < cb && bv2 > -1e38f) mk |= 1u << j2;
            T[ti].fw0 = mk;
        }
#pragma unroll
        for (int ti = 0; ti < 2; ++ti) { T[ti].kmax = tt[ti] - 256 * cb; }
        fa::flash_loop<0, 0>(ring, K1 + ((size_t)bh * SEQ + 256 * cb) * DH, V1 + ((size_t)bh * SEQ + 256 * cb) * DH, 4, T[0], T[1], kms, wave, lane);
#pragma unroll
        for (int ti = 0; ti < 2; ++ti) { T[ti].kmax = tt[ti]; fa::task_fix_ref(T[ti]); }
        if (cb > 0) fa::flash_loop2<3, 2>(ring, K1 + (size_t)bh * SEQ * DH, V1 + (size_t)bh * SEQ * DH, 4 * cb, T[0], T[1], kms, wave, lane);
#pragma unroll
        for (int ti = 0; ti < 2; ++ti) { const float l = fa::task_rowsum(T[ti]); const float sc_ = l > 0.f ? 1.0f / l : 0.f;
            bf16_t* op = AO + (size_t)(b * SEQ + tt[ti]) * DM + h * DH + 4 * fq;
#pragma unroll
            for (int dt = 0; dt < 4; ++dt) { const f32x4 o = T[ti].O[dt] * sc_; *(u32x2*)(op + 16 * dt) = (u32x2){pk2(o[0], o[1]), pk2(o[2], o[3])}; } }
    }
}

struct Route { int e0, s0, e1, s1; float w0, w1; int pad0, pad1; };
__device__ __forceinline__ void ph_ln_route(const Ctx& C, int layer) {
    const float* resid = C.in[I_X]; const bf16_t* residb = (const bf16_t*)(C.ws + WS_X2B); const bf16_t* MIX = (const bf16_t*)(C.ws + WS_MIX);
    bf16_t* X1B = (bf16_t*)(C.ws + WS_X1B); Route* RT = (Route*)(C.ws + WS_ROUTE);
    int* rowlist = (int*)(C.ws + WS_ROWLIST); unsigned* cnt = (unsigned*)(C.ws + WS_CTL) + (layer ? CW_CNT1 : CW_CNT0);
    const float* lg = C.in[I_LNG] + (size_t)(layer * 2 + 0) * DM; const float* lb = C.in[I_LNB] + (size_t)(layer * 2 + 0) * DM;
    const float* rw = C.in[I_RW]; const float* rb = C.in[I_RB];
    LAS unsigned* lcnt = (LAS unsigned*)C.lds;
    LAS float* rec = (LAS float*)(C.lds + 256);
    LAS float* lsb = (LAS float*)(C.lds + 4096 + C.wave * 512);
    const int lane = C.lane;
    LAS unsigned char* rwl = (LAS unsigned char*)(C.lds + 8192);
    for (int gi = C.tid; gi < DM * NE / 4; gi += NTHREADS) { const int c = gi >> 2, e4 = gi & 3;
        *(LAS f32x4*)(rwl + (c >> 8) * 17408 + ((c & 255) >> 2) * 272 + (c & 3) * 64 + e4 * 16) = ((const f32x4*)rw)[gi]; }
    __syncthreads();
    for (int chunk = C.bid; chunk < NTOK / 128; chunk += C.nb) {
        if (C.tid < 16) lcnt[C.tid] = 0u;
        __syncthreads();
        for (int i2 = 0; i2 < 8; ++i2) {
            const int rl0 = C.wave * 16 + i2 * 2, row0 = chunk * 128 + rl0;
            f32x4 v[2][4]; float s[2], s2[2];
#pragma unroll
            for (int r = 0; r < 2; ++r) { const f32x4* xr = (const f32x4*)(resid + (size_t)(row0 + r) * DM) + lane; const u32x2* xb = (const u32x2*)(residb + (size_t)(row0 + r) * DM) + lane;
                const u32x2* mr = (const u32x2*)(MIX + (size_t)(row0 + r) * DM) + lane; s[r] = 0.f;
#pragma unroll
                for (int j = 0; j < 4; ++j) { const u32x2 w = mr[64 * j]; f32x4 xv;
                    if (layer) { const u32x2 q = xb[64 * j]; xv = (f32x4){bflo(q.x), bfhi(q.x), bflo(q.y), bfhi(q.y)}; } else xv = xr[64 * j];
                    v[r][j] = xv * DN_ALPHA + (f32x4){bflo(w.x), bfhi(w.x), bflo(w.y), bfhi(w.y)};
                    s[r] += (v[r][j][0] + v[r][j][1]) + (v[r][j][2] + v[r][j][3]); } }
#pragma unroll
            for (int o = 1; o < 64; o <<= 1) { s[0] += __shfl_xor(s[0], o); s[1] += __shfl_xor(s[1], o); }
#pragma unroll
            for (int r = 0; r < 2; ++r) { const float mean = s[r] * (1.f / DM); s2[r] = 0.f;
#pragma unroll
                for (int j = 0; j < 4; ++j) { v[r][j] = v[r][j] - mean; s2[r] += (v[r][j][0] * v[r][j][0] + v[r][j][1] * v[r][j][1]) + (v[r][j][2] * v[r][j][2] + v[r][j][3] * v[r][j][3]); } }
#pragma unroll
            for (int o = 1; o < 64; o <<= 1) { s2[0] += __shfl_xor(s2[0], o); s2[1] += __shfl_xor(s2[1], o); }
            const float rstd0 = 1.f / sqrtf(s2[0] * (1.f / DM) + LN_EPS), rstd1 = 1.f / sqrtf(s2[1] * (1.f / DM) + LN_EPS);
            float p[32];
#pragma unroll
            for (int q = 0; q < 32; ++q) p[q] = 0.f;
#pragma unroll
            for (int j = 0; j < 4; ++j) {
                const int c0 = 4 * lane + 256 * j;
                const f32x4 gg = *(const f32x4*)(lg + c0), bb = *(const f32x4*)(lb + c0);
#pragma unroll
                for (int r = 0; r < 2; ++r) {
                    v[r][j] = v[r][j] * (r ? rstd1 : rstd0) * gg + bb;
                    *(u32x2*)(X1B + (size_t)(row0 + r) * DM + c0) = (u32x2){pk2(v[r][j][0], v[r][j][1]), pk2(v[r][j][2], v[r][j][3])}; }
#pragma unroll
                for (int q = 0; q < 4; ++q) {
                    const LAS f32x4* wr = (const LAS f32x4*)(rwl + j * 17408 + lane * 272 + q * 64);
                    const f32x4 w0 = wr[0], w1 = wr[1], w2 = wr[2], w3 = wr[3];
#pragma unroll
                    for (int r = 0; r < 2; ++r) { const float x = v[r][j][q];
                        p[16 * r + 0] += x * w0[0]; p[16 * r + 1] += x * w0[1]; p[16 * r + 2] += x * w0[2]; p[16 * r + 3] += x * w0[3];
                        p[16 * r + 4] += x * w1[0]; p[16 * r + 5] += x * w1[1]; p[16 * r + 6] += x * w1[2]; p[16 * r + 7] += x * w1[3];
                        p[16 * r + 8] += x * w2[0]; p[16 * r + 9] += x * w2[1]; p[16 * r + 10] += x * w2[2]; p[16 * r + 11] += x * w2[3];
                        p[16 * r + 12] += x * w3[0]; p[16 * r + 13] += x * w3[1]; p[16 * r + 14] += x * w3[2]; p[16 * r + 15] += x * w3[3]; }
                    if (q == 3) asm volatile("" ::: "memory");
                }
            }
#define TRED(N, M) { const bool up = (lane & (M)) != 0; _Pragma("unroll") for (int q = 0; q < (N); ++q) { const float keep = up ? p[q + (N)] : p[q], send = up ? p[q] : p[q + (N)]; p[q] = keep + __shfl_xor(send, (M)); } }
            TRED(16, 32) TRED(8, 16) TRED(4, 8) TRED(2, 4) TRED(1, 2)
#undef TRED
            p[0] += __shfl_xor(p[0], 1);
            const float sc_own = 1.0f / (1.0f + expf(-p[0]));
            if ((lane & 1) == 0) { lsb[lane >> 1] = sc_own; lsb[32 + (lane >> 1)] = sc_own + rb[(lane >> 1) & 15]; }
            WAVE_LDS_SYNC();
            float sc[16], bi[16];
            { const LAS f32x4* a4 = (const LAS f32x4*)(lsb + ((lane >> 5) << 4)); const LAS f32x4* b4 = (const LAS f32x4*)(lsb + 32 + ((lane >> 5) << 4));
#pragma unroll
              for (int q = 0; q < 4; ++q) { const f32x4 x = a4[q], y = b4[q]; sc[4 * q] = x[0]; sc[4 * q + 1] = x[1]; sc[4 * q + 2] = x[2]; sc[4 * q + 3] = x[3]; bi[4 * q] = y[0]; bi[4 * q + 1] = y[1]; bi[4 * q + 2] = y[2]; bi[4 * q + 3] = y[3]; } }
            WAVE_LDS_SYNC();
            int gsel = 0; float gbest = -3e38f;
#pragma unroll
            for (int gq = 0; gq < 4; ++gq) {
                float m1 = -3e38f, m2 = -3e38f;
#pragma unroll
                for (int q = 0; q < 4; ++q) { const float x = bi[4 * gq + q]; if (x > m1) { m2 = m1; m1 = x; } else if (x > m2) m2 = x; }
                const float gs = m1 + m2; if (gs > gbest) { gbest = gs; gsel = gq; }
            }
            int e0 = 0, e1 = 0; float b0 = -3e38f, b1 = -3e38f, w0 = 0.f, w1 = 0.f;
#pragma unroll
            for (int e = 0; e < 16; ++e) {
                if ((e >> 2) == gsel) {
                    const float x = bi[e];
                    if (x > b0) { b1 = b0; e1 = e0; w1 = w0; b0 = x; e0 = e; w0 = sc[e]; }
                    else if (x > b1) { b1 = x; e1 = e; w1 = sc[e]; }
                }
            }
            if ((lane & 31) == 0) {
                const int rl = rl0 + (lane >> 5);
                const float ws_ = w0 + w1;
                const unsigned l0 = __hip_atomic_fetch_add(lcnt + e0, 1u, __ATOMIC_RELAXED, __HIP_MEMORY_SCOPE_WORKGROUP), l1 = __hip_atomic_fetch_add(lcnt + e1, 1u, __ATOMIC_RELAXED, __HIP_MEMORY_SCOPE_WORKGROUP);
                LAS float* r = rec + rl * 6; r[0] = __int_as_float(e0); r[1] = __int_as_float(e1); r[2] = __uint_as_float(l0); r[3] = __uint_as_float(l1); r[4] = w0 / ws_; r[5] = w1 / ws_;
            }
        }
        __syncthreads();
        if (C.tid < 16) lcnt[16 + C.tid] = atomicAdd(cnt + 64 * C.tid, lcnt[C.tid]);
        __syncthreads();
        if (C.tid < 128) {
            const LAS float* r = rec + C.tid * 6; const int row = chunk * 128 + C.tid;
            const int e0 = __float_as_int(r[0]), e1 = __float_as_int(r[1]);
            const int s0 = (int)(lcnt[16 + e0] + __float_as_uint(r[2])), s1 = (int)(lcnt[16 + e1] + __float_as_uint(r[3]));
            rowlist[e0 * NTOK + s0] = row; rowlist[e1 * NTOK + s1] = row;
            Route rr; rr.e0 = e0; rr.s0 = s0; rr.e1 = e1; rr.s1 = s1; rr.w0 = r[4]; rr.w1 = r[5]; rr.pad0 = 0; rr.pad1 = 0;
            RT[row] = rr;
        }
        __syncthreads();
    }
}
__device__ __forceinline__ void ph_combine(const Ctx& C, int layer, float* outp, LAS int* sm) {
    const bf16_t* X1B = (const bf16_t*)(C.ws + WS_X1B); const bf16_t* Y2 = (const bf16_t*)(C.ws + WS_Y2); const Route* RT = (const Route*)(C.ws + WS_ROUTE);
    bf16_t* XB = (bf16_t*)(C.ws + WS_XB); bf16_t* X2B = (bf16_t*)(C.ws + WS_X2B);
    const float* lg = C.in[I_LNG] + (size_t)(layer * 2 + 1) * DM; const float* lb = C.in[I_LNB] + (size_t)(layer * 2 + 1) * DM;
    const int gw = C.bid * NWAVES + C.wave, NGW = C.nb * NWAVES, lane = C.lane;
    for (int row = gw; row < NTOK; row += NGW) {
        const Route r = RT[row];
        const bf16_t* y0 = Y2 + (size_t)(sm[16 + r.e0] + r.s0) * DM; const bf16_t* y1 = Y2 + (size_t)(sm[16 + r.e1] + r.s1) * DM;
        const u32x2* xr = (const u32x2*)(X1B + (size_t)row * DM) + lane;
        f32x4 v[4]; float s = 0.f;
#pragma unroll
        for (int j = 0; j < 4; ++j) {
            const int c0 = 4 * lane + 256 * j;
            const u32x2 a = *(const u32x2*)(y0 + c0), b = *(const u32x2*)(y1 + c0), x = xr[64 * j];
            const f32x4 ya = (f32x4){bflo(a.x), bfhi(a.x), bflo(a.y), bfhi(a.y)}, yb = (f32x4){bflo(b.x), bfhi(b.x), bflo(b.y), bfhi(b.y)}, xv = (f32x4){bflo(x.x), bfhi(x.x), bflo(x.y), bfhi(x.y)};
            v[j] = xv * DN_ALPHA + ya * r.w0 + yb * r.w1;
            s += (v[j][0] + v[j][1]) + (v[j][2] + v[j][3]);
        }
        const float mean = wave_sum(s) * (1.f / DM); float s2 = 0.f;
#pragma unroll
        for (int j = 0; j < 4; ++j) { v[j] = v[j] - mean; s2 += (v[j][0] * v[j][0] + v[j][1] * v[j][1]) + (v[j][2] * v[j][2] + v[j][3] * v[j][3]); }
        const float rstd = 1.f / sqrtf(wave_sum(s2) * (1.f / DM) + LN_EPS);
#pragma unroll
        for (int j = 0; j < 4; ++j) {
            const int c0 = 4 * lane + 256 * j;
            const f32x4 gg = *(const f32x4*)(lg + c0), bb = *(const f32x4*)(lb + c0);
            v[j] = v[j] * rstd * gg + bb;
            if (layer) *(f32x4*)(outp + (size_t)row * DM + c0) = v[j];
            else { const u32x2 w = (u32x2){pk2(v[j][0], v[j][1]), pk2(v[j][2], v[j][3])}; *(u32x2*)(XB + (size_t)row * DM + c0) = w; *(u32x2*)(X2B + (size_t)row * DM + c0) = w; }
        }
    }
}

__device__ __forceinline__ void ph_kmean(const Ctx& C) {
    const bf16_t* K1 = (const bf16_t*)(C.ws + WS_K1); float* KM = (float*)(C.ws + WS_KMEAN);
    const int gw = C.bid * NWAVES + C.wave, NGW = C.nb * NWAVES, lane = C.lane;
    for (int it = gw; it < NB * NH * 32; it += NGW) {
        const bf16_t* p = K1 + (size_t)it * 256 * DH + lane; float s = 0.f;
#pragma unroll 8
        for (int j = 0; j < 256; ++j) s += bf2f(p[j * DH]);
        KM[(size_t)it * DH + lane] = s * (1.0f / 256.0f);
    }
}
constexpr int NPHASE = 19;
__global__ void __launch_bounds__(NTHREADS, 2) fwd(Args args) {
    extern __shared__ __attribute__((aligned(16))) unsigned char lds[];
    Ctx C;
#pragma unroll
    for (int i = 0; i < 18; ++i) C.in[i] = args.in[i];
    C.out = args.out; C.ws = args.ws; C.lds = lds;
    C.tid = threadIdx.x; C.lane = C.tid & 63; C.wave = __builtin_amdgcn_readfirstlane(C.tid >> 6); C.bid = blockIdx.x; C.nb = gridDim.x;
    LAS unsigned* misc = (LAS unsigned*)(lds + LDS_BYTES - 512);
    LAS int* sm = (LAS int*)(misc + 16);
    if (C.tid < 4) misc[C.tid] = 0u;
    __syncthreads();
#if MK_SINGLE
    XcdBarrier bar = xcd_barrier_post((unsigned*)(C.ws + WS_CTL) + CW_BAR, (volatile LAS unsigned*)misc);
#define SEAM() xcd_barrier(bar)
#else
#define SEAM() do {} while (0)
#endif
    const int lo = args.ph_lo, hi = args.ph_hi;
#ifndef PH_MASK
#define PH_MASK 0xFFFFFFFFu
#endif
#define IN(k) (((PH_MASK >> (k)) & 1u) && lo <= (k) && (k) < hi)
#define BOTH(k) (IN(k) && IN((k) + 1))
    unsigned char* ws = C.ws;
    const float2* rope = (const float2*)(ws + WS_ROPE);
    LAS unsigned char* L = (LAS unsigned char*)lds;

    if (IN(0)) { ph_prologue(C); if (BOTH(0)) SEAM(); }
    if (IN(1)) {
        EpiNsaIn E{(bf16_t*)(ws + WS_Q), (bf16_t*)(ws + WS_KV0), (float*)(ws + WS_GATES), rope};
        g8::StaticOrder S; S.init(NTOK / 256, 2560 / 256, C.nb, C.bid);
        g8::gemm8<false>(L, (const bf16_t*)(ws + WS_XB), DM, (const bf16_t*)(ws + WS_WT_NSA_IN), DM, S, g8::EpiEl<EpiNsaIn>{E}, g8::GatherInfo{nullptr, sm});
        if (BOTH(1)) SEAM();
    }
    if (IN(2)) {
        EpiGelu EK{(bf16_t*)(ws + WS_H1K), (const float*)(ws + WS_BIAS1)}, EV{(bf16_t*)(ws + WS_H1V), (const float*)(ws + WS_BIAS1) + 256};
        g8::StaticOrder SK, SV; SK.init(32, 1, C.nb, C.bid); SV.init(32, 1, C.nb, (C.bid + C.nb / 2) % C.nb);
        g8::gemm8<false>(L, (const bf16_t*)(ws + WS_KV0), 1024, (const bf16_t*)(ws + WS_WT_C1K), 2048, SK, g8::EpiEl<EpiGelu>{EK}, g8::GatherInfo{nullptr, sm});
        g8::gemm8<false>(L, (const bf16_t*)(ws + WS_KV0 + KVSEG), 1024, (const bf16_t*)(ws + WS_WT_C1V), 2048, SV, g8::EpiEl<EpiGelu>{EV}, g8::GatherInfo{nullptr, sm});
        if (C.nb == 256 && !((C.bid < 32) || (C.bid >= 128 && C.bid < 160))) {
            EpiNsaIn E{(bf16_t*)(ws + WS_Q), (bf16_t*)(ws + WS_KV0), (float*)(ws + WS_GATES), rope};
            const int gidx = C.bid < 128 ? C.bid - 32 : C.bid - 64, fr = C.lane & 15, fq = C.lane >> 4;
            for (int tile = gidx * NWAVES + C.wave; tile < 2048; tile += 192 * NWAVES) {
                const int row0 = (tile >> 1) * 32, col0 = 2560 + (tile & 1) * 32;
                const bf16_t* a0 = (const bf16_t*)(ws + WS_XB) + (size_t)(row0 + fr) * DM + fq * 8; const bf16_t* a1 = a0 + (size_t)16 * DM;
                const bf16_t* b0 = (const bf16_t*)(ws + WS_WT_NSA_IN) + (size_t)(col0 + fr) * DM + fq * 8; const bf16_t* b1 = b0 + (size_t)16 * DM;
                f32x4 acc[2][2]; mma_core(a0, a1, b0, b1, DM, acc);
#pragma unroll
                for (int mi = 0; mi < 2; ++mi)
#pragma unroll
                    for (int ni = 0; ni < 2; ++ni) E(row0 + 16 * mi + fr, col0 + 16 * ni + 4 * fq, acc[mi][ni]);
            }
        } else if (C.nb != 256) {
            EpiNsaIn E{(bf16_t*)(ws + WS_Q), (bf16_t*)(ws + WS_KV0), (float*)(ws + WS_GATES), rope};
            const int fr = C.lane & 15, fq = C.lane >> 4;
            for (int tile = C.bid * NWAVES + C.wave; tile < 2048; tile += C.nb * NWAVES) {
                const int row0 = (tile >> 1) * 32, col0 = 2560 + (tile & 1) * 32;
                const bf16_t* a0 = (const bf16_t*)(ws + WS_XB) + (size_t)(row0 + fr) * DM + fq * 8; const bf16_t* a1 = a0 + (size_t)16 * DM;
                const bf16_t* b0 = (const bf16_t*)(ws + WS_WT_NSA_IN) + (size_t)(col0 + fr) * DM + fq * 8; const bf16_t* b1 = b0 + (size_t)16 * DM;
                f32x4 acc[2][2]; mma_core(a0, a1, b0, b1, DM, acc);
#pragma unroll
                for (int mi = 0; mi < 2; ++mi)
#pragma unroll
                    for (int ni = 0; ni < 2; ++ni) E(row0 + 16 * mi + fr, col0 + 16 * ni + 4 * fq, acc[mi][ni]);
            }
        }
        if (BOTH(2)) SEAM();
    }
    if (IN(3)) { ph_cmp2(C); if (BOTH(3)) SEAM(); }
    if (IN(4)) { ph_nsa_fa(C); if (BOTH(4)) SEAM(); }
    if (IN(6)) {
        EpiBf16 E{(bf16_t*)(ws + WS_MIX)};
        g8::StaticOrder S; S.init(NTOK / 256, DM / 256, C.nb, C.bid);
        g8::gemm8<false>(L, (const bf16_t*)(ws + WS_XB), DM, (const bf16_t*)(ws + WS_WT_NSA_OUT), DM, S, g8::EpiEl<EpiBf16>{E}, g8::GatherInfo{nullptr, sm});
        if (BOTH(6)) SEAM();
    }
    if (IN(7)) { ph_ln_route(C, 0); if (BOTH(7)) SEAM(); }
    if (IN(8)) {
        load_expert_map(C, CW_CNT0, sm);
        EpiSwiGLU E{(bf16_t*)(ws + WS_HBUF)};
        g8::GroupedOrder S; S.init(sm, 4, C.nb, C.bid);
        g8::gemm8<true>(L, (const bf16_t*)(ws + WS_X1B), DM, (const bf16_t*)(ws + WS_WT_GU), 1024, S, g8::EpiEl<EpiSwiGLU>{E}, g8::GatherInfo{(const int*)(ws + WS_ROWLIST), sm});
        if (BOTH(8)) SEAM();
    }
    if (IN(9)) {
        load_expert_map(C, CW_CNT0, sm);
        EpiBf16 E{(bf16_t*)(ws + WS_Y2)};
        g8::GroupedOrder S; S.init(sm, 4, C.nb, C.bid);
        g8::gemm8<false>(L, (const bf16_t*)(ws + WS_HBUF), DE, (const bf16_t*)(ws + WS_WT_DN), DE, S, g8::EpiEl<EpiBf16>{E}, g8::GatherInfo{nullptr, sm});
        if (BOTH(9)) SEAM();
    }
    if (IN(10)) {
        load_expert_map(C, CW_CNT0, sm);
        ph_combine(C, 0, (float*)(ws + WS_XR), sm);
        { float* scr = (float*)(C.lds + C.wave * 9216); const int gw = C.bid * NWAVES + C.wave, NGW = C.nb * NWAVES;
          for (int it = gw; it < MOE_W_ITEMS; it += NGW) moe_weight_item(C, 1, it, scr); }
        if (BOTH(10)) SEAM();
    }
    if (IN(11)) {
        EpiMobaIn E{(bf16_t*)(ws + WS_Q), (bf16_t*)(ws + WS_K1), (bf16_t*)(ws + WS_V1), rope};
        g8::StaticOrder S; S.init(NTOK / 256, 3072 / 256, C.nb, C.bid);
        g8::gemm8<false>(L, (const bf16_t*)(ws + WS_XB), DM, (const bf16_t*)(ws + WS_WT_MOBA_IN), DM, S, g8::EpiEl<EpiMobaIn>{E}, g8::GatherInfo{nullptr, sm});
        if (BOTH(11)) SEAM();
    }
    if (IN(12)) { ph_kmean(C); if (BOTH(12)) SEAM(); }
    if (IN(13)) { ph_moba_fa(C); if (BOTH(13)) SEAM(); }
    if (IN(14)) {
        EpiBf16 E{(bf16_t*)(ws + WS_MIX)};
        g8::StaticOrder S; S.init(NTOK / 256, DM / 256, C.nb, C.bid);
        g8::gemm8<false>(L, (const bf16_t*)(ws + WS_XB), DM, (const bf16_t*)(ws + WS_WT_MOBA_OUT), DM, S, g8::EpiEl<EpiBf16>{E}, g8::GatherInfo{nullptr, sm});
        if (BOTH(14)) SEAM();
    }
    if (IN(15)) { ph_ln_route(C, 1); if (BOTH(15)) SEAM(); }
    if (IN(16)) {
        load_expert_map(C, CW_CNT1, sm);
        EpiSwiGLU E{(bf16_t*)(ws + WS_HBUF)};
        g8::GroupedOrder S; S.init(sm, 4, C.nb, C.bid);
        g8::gemm8<true>(L, (const bf16_t*)(ws + WS_X1B), DM, (const bf16_t*)(ws + WS_WT_GU), 1024, S, g8::EpiEl<EpiSwiGLU>{E}, g8::GatherInfo{(const int*)(ws + WS_ROWLIST), sm});
        if (BOTH(16)) SEAM();
    }
    if (IN(17)) {
        load_expert_map(C, CW_CNT1, sm);
        EpiBf16 E{(bf16_t*)(ws + WS_Y2)};
        g8::GroupedOrder S; S.init(sm, 4, C.nb, C.bid);
        g8::gemm8<false>(L, (const bf16_t*)(ws + WS_HBUF), DE, (const bf16_t*)(ws + WS_WT_DN), DE, S, g8::EpiEl<EpiBf16>{E}, g8::GatherInfo{nullptr, sm});
        if (BOTH(17)) SEAM();
    }
    if (IN(18)) {
        load_expert_map(C, CW_CNT1, sm);
        ph_combine(C, 1, C.out, sm);
    }
#undef IN
#undef BOTH
}

extern "C" void kernel_launch(void* const* d_in, const int* in_sizes, int n_in, void* d_out, int out_size, void* d_ws, size_t ws_size, hipStream_t stream) {
    static int grid = 0;
    if (grid == 0) {
        if (n_in != 18 || in_sizes[0] != NTOK * DM || out_size != NTOK * DM || ws_size < WS_END) {
            fprintf(stderr, "kernel_launch: unexpected shapes (n_in %d, in0 %d, out %d, ws %zu; need ws >= %zu); nothing launched\n", n_in, n_in > 0 ? in_sizes[0] : -1, out_size, ws_size, (size_t)WS_END);
            grid = -1; return;
        }
        int dev = 0, cus = 0, per_cu = 0;
        if (hipGetDevice(&dev) != hipSuccess || hipDeviceGetAttribute(&cus, hipDeviceAttributeMultiprocessorCount, dev) != hipSuccess) { grid = -1; return; }
        if (hipFuncSetAttribute((const void*)fwd, hipFuncAttributeMaxDynamicSharedMemorySize, LDS_BYTES) != hipSuccess) { fprintf(stderr, "kernel_launch: hipFuncSetAttribute failed\n"); grid = -1; return; }
        if (hipOccupancyMaxActiveBlocksPerMultiprocessor(&per_cu, (const void*)fwd, NTHREADS, LDS_BYTES) != hipSuccess || per_cu < 1)
            fprintf(stderr, "kernel_launch: occupancy query reports %d blocks per CU\n", per_cu);
        (void)hipGetLastError();
        grid = cus;
    }
    if (grid < 0) return;
    if (hipMemsetAsync((char*)d_ws + WS_CTL, 0, CTL_BYTES, stream) != hipSuccess) { fprintf(stderr, "kernel_launch: memset failed\n"); return; }
    Args a{};
    for (int i = 0; i < 18; ++i) a.in[i] = (const float*)d_in[i];
    a.out = (float*)d_out; a.ws = (unsigned char*)d_ws;
#if defined(PROBE_PH)
    { const int lo3[3] = {0, PROBE_PH, PROBE_PH + 1}, hi3[3] = {PROBE_PH + 1, PROBE_PH + 1, NPHASE};
      for (int q = 0; q < 3; ++q) { if (lo3[q] >= hi3[q]) continue;
          if (q) (void)hipMemsetAsync((char*)d_ws + WS_CTL + CW_BAR * 4, 0, XCD_BAR_WORDS * 4, stream);
          a.ph_lo = lo3[q]; a.ph_hi = hi3[q]; hipLaunchKernelGGL(fwd, dim3(grid), dim3(NTHREADS), LDS_BYTES, stream, a); } }
#elif MK_SINGLE
    a.ph_lo = 0; a.ph_hi = NPHASE;
    hipLaunchKernelGGL(fwd, dim3(grid), dim3(NTHREADS), LDS_BYTES, stream, a);
#else
    for (int p = 0; p < NPHASE; ++p) { a.ph_lo = p; a.ph_hi = p + 1; hipLaunchKernelGGL(fwd, dim3(grid), dim3(NTHREADS), LDS_BYTES, stream, a); }
#endif
    const hipError_t le = hipPeekAtLastError();
    if (le != hipSuccess) fprintf(stderr, "kernel_launch: launch failed: %s\n", hipGetErrorName(le));
}
```

```cpp
#include <hip/hip_runtime.h>
#include <cstdio>
#include <cstdint>

#ifndef SEL_FUSED
#define SEL_FUSED 1
#endif
#ifndef MK_SINGLE
#define MK_SINGLE 1
#endif

#define LAS __attribute__((address_space(3)))
typedef unsigned short bf16_t;
typedef short bf16x8 __attribute__((ext_vector_type(8)));
typedef float f32x4 __attribute__((ext_vector_type(4)));
typedef unsigned u32x4 __attribute__((ext_vector_type(4)));
typedef unsigned u32x2 __attribute__((ext_vector_type(2)));

constexpr int NB = 4, SEQ = 8192, NTOK = NB * SEQ, DM = 1024, NH = 16, DH = 64, NG = 4;
constexpr int NSA_IN = 2608, NSA_INP = 2816;
constexpr int NE = 16, DE = 512;
constexpr float DN_ALPHA = 1.4142135623730951f;
constexpr float LN_EPS = 1e-5f;
constexpr int NWAVES = 8, NTHREADS = 512;
constexpr float QSCALE = 0.125f * 1.4426950408889634f;
constexpr int LDS_BYTES = 163840;
constexpr int ROWCAP = 2 * NTOK + NE * 256;

constexpr size_t MiB = 1u << 20;
constexpr size_t WS_CTL = 0, CTL_BYTES = 1 * MiB;
constexpr size_t WS_ROPE = 1 * MiB;
constexpr size_t WS_BIAS1 = 3 * MiB;
constexpr size_t WS_KMEAN = 4 * MiB;
constexpr size_t WS_ROUTE = 5 * MiB;
constexpr size_t WS_ROWLIST = 6 * MiB;
constexpr size_t WS_SEL = 8 * MiB;
constexpr size_t WS_GATES = 10 * MiB;
constexpr size_t WS_H1K = 17 * MiB, WS_H1V = 21 * MiB;
constexpr size_t WS_KC = 25 * MiB, WS_VC = 26 * MiB;
constexpr size_t WS_WT_NSA_IN = 27 * MiB;
constexpr size_t WS_WT_NSA_OUT = 33 * MiB;
constexpr size_t WS_WT_C1K = 35 * MiB, WS_WT_C1V = 36 * MiB;
constexpr size_t WS_WT_MOBA_IN = 37 * MiB;
constexpr size_t WS_WT_MOBA_OUT = 43 * MiB;
constexpr size_t WS_WT_GU = 45 * MiB;
constexpr size_t WS_WT_DN = 77 * MiB;
constexpr size_t WS_XB = 93 * MiB;
constexpr size_t WS_ATTN = 161 * MiB;
constexpr size_t WS_Q = WS_ATTN;
constexpr size_t WS_KV0 = WS_ATTN + 64 * MiB;
constexpr size_t KVSEG = 16 * MiB;
constexpr size_t WS_K1 = WS_ATTN + 64 * MiB, WS_V1 = WS_ATTN + 128 * MiB;
constexpr size_t WS_X1B = 353 * MiB;
constexpr size_t WS_X2B = 417 * MiB;
constexpr size_t WS_MIX = WS_ATTN + 64 * MiB;
constexpr size_t WS_Y2 = WS_ATTN;
constexpr size_t WS_HBUF = WS_XB;
constexpr size_t WS_XR = 353 * MiB;
constexpr size_t WS_END = 481 * MiB;
static_assert((size_t)ROWCAP * 512 * 2 <= 68 * MiB && (size_t)ROWCAP * 1024 * 2 <= 192 * MiB, "overlay sizes");

constexpr int CW_TMO = 0;
constexpr int CW_CNT0 = 1024, CW_CNT1 = 2048;
constexpr int CW_BAR = 8192;

__device__ __forceinline__ unsigned f2bf(float f) { unsigned u = __float_as_uint(f); return (u + 0x7fffu + ((u >> 16) & 1u)) >> 16; }
typedef float f32x2v __attribute__((ext_vector_type(2)));
typedef __bf16 bf16x2v __attribute__((ext_vector_type(2)));
__device__ __forceinline__ unsigned pk2(float lo, float hi) { const f32x2v v = {lo, hi}; const bf16x2v b = __builtin_convertvector(v, bf16x2v); return __builtin_bit_cast(unsigned, b); }
__device__ __forceinline__ float bflo(unsigned u) { return __uint_as_float(u << 16); }
__device__ __forceinline__ float bfhi(unsigned u) { return __uint_as_float(u & 0xffff0000u); }
__device__ __forceinline__ float bf2f(bf16_t b) { return __uint_as_float((unsigned)b << 16); }
__device__ __forceinline__ float wave_sum(float v) {
#pragma unroll
    for (int o = 1; o < 64; o <<= 1) v += __shfl_xor(v, o);
    return v;
}
__device__ __forceinline__ float wave_max(float v) {
#pragma unroll
    for (int o = 1; o < 64; o <<= 1) v = fmaxf(v, __shfl_xor(v, o));
    return v;
}
#define WAVE_LDS_SYNC() asm volatile("s_waitcnt lgkmcnt(0)" ::: "memory")
__device__ __forceinline__ float sigmoidf_(float x) { return 1.0f / (1.0f + __expf(-x)); }
__device__ __forceinline__ float gelu_tanh(float x) {
    const float u = 0.7978845608028654f * (x + 0.044715f * x * x * x);
    const float t = 1.0f - 2.0f / (__expf(2.0f * u) + 1.0f);
    return 0.5f * x * (1.0f + t);
}

#define XB_TMO      128
#define XB_XCNT(j)  (256  + 64 * (j))
#define XB_XSUB(j)  (1280 + 64 * (j))
#define XB_XGEN(j)  (2304 + 64 * (j))
#define XB_TOP      3328
#define XB_TOPGEN   3392
#define XCD_BAR_WORDS 3456
#define XB_SPIN_CAP (1u << 22)
__device__ __forceinline__ unsigned xb_ld(unsigned* p)              { return __hip_atomic_load(p, __ATOMIC_RELAXED, __HIP_MEMORY_SCOPE_AGENT); }
__device__ __forceinline__ unsigned xb_add(unsigned* p, unsigned v) { return __hip_atomic_fetch_add(p, v, __ATOMIC_RELAXED, __HIP_MEMORY_SCOPE_AGENT); }
__device__ __forceinline__ unsigned xb_xcc_id() { return (unsigned)__builtin_amdgcn_s_getreg((3 << 11) | 20) & 0xFu; }
#define XB_SPIN(cond, bar) do { unsigned _sp = 0; while (cond) { __builtin_amdgcn_s_sleep(1); \
    if ((++_sp & 255u) == 0u) { if (xb_ld(&(bar)[XB_TMO])) break; if (_sp > XB_SPIN_CAP) { atomicAdd(&(bar)[XB_TMO], 1u); break; } } } } while (0)
struct XcdBarrier { unsigned* bar; unsigned x; volatile LAS unsigned* st; };
__device__ __forceinline__ XcdBarrier xcd_barrier_post(unsigned* bar, volatile LAS unsigned* st) {
    XcdBarrier b; b.bar = bar; b.x = xb_xcc_id(); b.st = st;
    if (threadIdx.x == 0) (void)xb_add(&bar[XB_XCNT(b.x)], 1u);
    return b;
}
__device__ __forceinline__ void xcd_barrier_complete(unsigned* bar, unsigned x, unsigned& nloc, unsigned& nx) {
    const unsigned G = gridDim.x * gridDim.y * gridDim.z;
    unsigned sum, cnt, mine, sp = 0u;
    for (;;) {
        sum = 0u; cnt = 0u; mine = 0u;
#pragma unroll
        for (unsigned j = 0; j < 16; ++j) { const unsigned c = xb_ld(&bar[XB_XCNT(j)]); sum += c; cnt += (c > 0u) ? 1u : 0u; mine = (j == x) ? c : mine; }
        if (sum == G) break;
        __builtin_amdgcn_s_sleep(1);
        if ((++sp & 255u) == 0u) { if (xb_ld(&bar[XB_TMO])) break; if (sp > XB_SPIN_CAP) { atomicAdd(&bar[XB_TMO], 1u); break; } }
    }
    nloc = mine > 0u ? mine : 1u; nx = cnt > 0u ? cnt : 1u;
}
__device__ __forceinline__ void xcd_barrier(const XcdBarrier& b) {
    asm volatile("s_waitcnt vmcnt(0)" ::: "memory");
    __syncthreads();
    if (threadIdx.x == 0) {
        unsigned* bar = b.bar;
        __builtin_amdgcn_s_waitcnt(0);
        unsigned nloc = b.st[0], nx = b.st[1];
        if (nloc == 0u) { xcd_barrier_complete(bar, b.x, nloc, nx); b.st[0] = nloc; b.st[1] = nx; }
        const unsigned old = xb_add(&bar[XB_XSUB(b.x)], 1u);
        const unsigned gen = old / nloc;
        if (old + 1u == (gen + 1u) * nloc) {
            __builtin_amdgcn_fence(__ATOMIC_RELEASE, "agent");
            asm volatile("s_waitcnt vmcnt(0)" ::: "memory");
            const unsigned og = xb_add(&bar[XB_TOP], 1u);
            const unsigned tg = og / nx;
            if (og + 1u == (tg + 1u) * nx) xb_add(&bar[XB_TOPGEN], 1u);
            else XB_SPIN(xb_ld(&bar[XB_TOPGEN]) == tg, bar);
            __builtin_amdgcn_fence(__ATOMIC_ACQUIRE, "agent");
            xb_add(&bar[XB_XGEN(b.x)], 1u);
            asm volatile("s_waitcnt vmcnt(0)" ::: "memory");
        } else {
            XB_SPIN(xb_ld(&bar[XB_XGEN(b.x)]) == gen, bar);
            __builtin_amdgcn_fence(__ATOMIC_ACQUIRE, "agent");
            asm volatile("s_waitcnt vmcnt(0)" ::: "memory");
        }
    }
    __syncthreads();
}

struct Args { const float* in[18]; float* out; unsigned char* ws; int ph_lo, ph_hi; };
struct Ctx {
    const float* in[18]; float* out; unsigned char* ws; unsigned char* lds;
    int tid, lane, wave, bid, nb;
};
enum { I_X = 0, I_NSA_WIN, I_NSA_WOUT, I_CK_W1, I_CK_W2, I_CV_W1, I_CV_W2, I_CK_POS, I_CV_POS, I_MOBA_WIN, I_MOBA_WOUT, I_RW, I_RB, I_WG, I_WU, I_WD, I_LNG, I_LNB };

__device__ __forceinline__ int il64(int d) { return d < 32 ? 2 * d : 2 * (d - 32) + 1; }
__device__ __forceinline__ int rowmap(int kind, int n) {
    switch (kind) {
        case 1: { const bool r = (n < 1024) || (n >= 1536 && n < 1792) || (n >= 2048 && n < 2304); return r ? (n & ~63) + il64(n & 63) : n; }
        case 2: return n < 2048 ? (n & ~63) + il64(n & 63) : n;
        case 3: return 2 * n;
        case 4: return 2 * n + 1;
        default: return n;
    }
}
__device__ __forceinline__ void transpose_item(const float* W, int ldw, int ncols, bf16_t* WT, int K, int kb, int nbk, int kind, float* scr, int lane) {
    const int k0 = 64 * kb, n0 = 32 * nbk;
    const int cq = lane & 7, nn = n0 + 4 * cq;
#pragma unroll
    for (int i = 0; i < 8; ++i) { const int kk = 8 * i + (lane >> 3);
        *(f32x4*)(scr + kk * 36 + 4 * cq) = nn < ncols ? *(const f32x4*)(W + (size_t)(k0 + kk) * ldw + nn) : (f32x4){0.f, 0.f, 0.f, 0.f}; }
    WAVE_LDS_SYNC();
    const int c = lane & 7;
#pragma unroll
    for (int j = 0; j < 4; ++j) {
        const int n = (lane >> 3) + 8 * j; const float* s = scr + (8 * c) * 36 + n;
        u32x4 o; o.x = pk2(s[0 * 36], s[1 * 36]); o.y = pk2(s[2 * 36], s[3 * 36]); o.z = pk2(s[4 * 36], s[5 * 36]); o.w = pk2(s[6 * 36], s[7 * 36]);
        *(u32x4*)(WT + (size_t)rowmap(kind, n0 + n) * K + k0 + 8 * c) = o;
    }
    WAVE_LDS_SYNC();
}
constexpr int MOE_W_ITEMS = NE * 768;
__device__ __forceinline__ void moe_weight_item(const Ctx& C, int layer, int r, float* scr) {
    const int e = r / 768; int q = r % 768;
    bf16_t* gu = (bf16_t*)(C.ws + WS_WT_GU) + (size_t)e * 1024 * 1024;
    bf16_t* dn = (bf16_t*)(C.ws + WS_WT_DN) + (size_t)e * 1024 * 512;
    const size_t eo = (size_t)(layer * NE + e);
    if (q < 256) { transpose_item(C.in[I_WG] + eo * DM * DE, DE, DE, gu, DM, q / 16, q % 16, 3, scr, C.lane); return; } q -= 256;
    if (q < 256) { transpose_item(C.in[I_WU] + eo * DM * DE, DE, DE, gu, DM, q / 16, q % 16, 4, scr, C.lane); return; } q -= 256;
    transpose_item(C.in[I_WD] + eo * DE * DM, DM, DM, dn, DE, q / 32, q % 32, 0, scr, C.lane);
}

__device__ __forceinline__ void ph_prologue(const Ctx& C) {
    float* scr = (float*)(C.lds + C.wave * 9216);
    const int gw = C.bid * NWAVES + C.wave, NGW = C.nb * NWAVES;
    constexpr int I_A = 16 * 82, I_B = 16 * 32, I_C = 32 * 8, I_D = 16 * 96, I_E = 16 * 32;
    constexpr int NIT = I_A + I_B + 2 * I_C + I_D + I_E + MOE_W_ITEMS;
    for (int it = gw; it < NIT; it += NGW) {
        int r = it;
        if (r < I_A) { transpose_item(C.in[I_NSA_WIN], NSA_IN, NSA_IN, (bf16_t*)(C.ws + WS_WT_NSA_IN), DM, r / 82, r % 82, 1, scr, C.lane); continue; } r -= I_A;
        if (r < I_B) { transpose_item(C.in[I_NSA_WOUT], DM, DM, (bf16_t*)(C.ws + WS_WT_NSA_OUT), DM, r / 32, r % 32, 0, scr, C.lane); continue; } r -= I_B;
        if (r < I_C) { transpose_item(C.in[I_CK_W1], 256, 256, (bf16_t*)(C.ws + WS_WT_C1K), 2048, r / 8, r % 8, 0, scr, C.lane); continue; } r -= I_C;
        if (r < I_C) { transpose_item(C.in[I_CV_W1], 256, 256, (bf16_t*)(C.ws + WS_WT_C1V), 2048, r / 8, r % 8, 0, scr, C.lane); continue; } r -= I_C;
        if (r < I_D) { transpose_item(C.in[I_MOBA_WIN], 3072, 3072, (bf16_t*)(C.ws + WS_WT_MOBA_IN), DM, r / 96, r % 96, 2, scr, C.lane); continue; } r -= I_D;
        if (r < I_E) { transpose_item(C.in[I_MOBA_WOUT], DM, DM, (bf16_t*)(C.ws + WS_WT_MOBA_OUT), DM, r / 32, r % 32, 0, scr, C.lane); continue; } r -= I_E;
        moe_weight_item(C, 0, r, scr);
    }
    const int gt = C.bid * NTHREADS + C.tid, NGT = C.nb * NTHREADS;
    { u32x4* p = (u32x4*)((bf16_t*)(C.ws + WS_WT_NSA_IN) + (size_t)2624 * DM); const int n = (NSA_INP - 2624) * DM / 8;
      for (int i = gt; i < n; i += NGT) p[i] = (u32x4){0u, 0u, 0u, 0u}; }
    { const f32x4* x4 = (const f32x4*)C.in[I_X]; u32x4* o = (u32x4*)(C.ws + WS_XB); const int n = NTOK * DM / 8;
      for (int i = gt; i < n; i += NGT) { const f32x4 a = x4[2 * i], b = x4[2 * i + 1]; o[i] = (u32x4){pk2(a.x, a.y), pk2(a.z, a.w), pk2(b.x, b.y), pk2(b.z, b.w)}; } }
    { const float INV[32] = {1.000000000e+00f, 7.498942018e-01f, 5.623413324e-01f, 4.216965139e-01f, 3.162277639e-01f, 2.371373922e-01f, 1.778279394e-01f, 1.333521456e-01f,
                             1.000000015e-01f, 7.498941571e-02f, 5.623412877e-02f, 4.216964915e-02f, 3.162277862e-02f, 2.371373586e-02f, 1.778279431e-02f, 1.333521493e-02f,
                             9.999999776e-03f, 7.498942316e-03f, 5.623413250e-03f, 4.216964822e-03f, 3.162277862e-03f, 2.371373819e-03f, 1.778279431e-03f, 1.333521446e-03f,
                             1.000000047e-03f, 7.498941850e-04f, 5.623413017e-04f, 4.216965463e-04f, 3.162277862e-04f, 2.371373848e-04f, 1.778279402e-04f, 1.333521504e-04f};
      float2* tab = (float2*)(C.ws + WS_ROPE);
      for (int i = gt; i < SEQ * 32; i += NGT) {
          const int t = i >> 5, f = i & 31;
          float inv = INV[0];
#pragma unroll
          for (int q = 1; q < 32; ++q) inv = (f == q) ? INV[q] : inv;
          const float ang = (float)t * inv;
          const double a = (double)ang; const double k = __builtin_rint(a * 0.15915494309189535); const float rf = (float)(a - k * 6.283185307179586);
          tab[i] = make_float2(__cosf(rf), __sinf(rf));
      } }
    for (int o = gw; o < 512; o += NGW) {
        const int which = o >> 8, c = o & 255;
        const float* pos = C.in[which ? I_CV_POS : I_CK_POS]; const float* w1 = C.in[which ? I_CV_W1 : I_CK_W1];
        float s = 0.f;
        for (int k = C.lane; k < 2048; k += 64) s += pos[k] * w1[(size_t)k * 256 + c];
        s = wave_sum(s);
        if (C.lane == 0) ((float*)(C.ws + WS_BIAS1))[o] = s;
    }
}

__device__ __forceinline__ void mma_core(const bf16_t* a0, const bf16_t* a1, const bf16_t* b0, const bf16_t* b1, int K, f32x4 (&acc)[2][2]) {
#pragma unroll
    for (int i = 0; i < 2; ++i)
#pragma unroll
        for (int j = 0; j < 2; ++j) acc[i][j] = (f32x4){0.f, 0.f, 0.f, 0.f};
#pragma unroll 4
    for (int k = 0; k < K; k += 32) {
        const bf16x8 A0 = *(const bf16x8*)(a0 + k), A1 = *(const bf16x8*)(a1 + k), B0 = *(const bf16x8*)(b0 + k), B1 = *(const bf16x8*)(b1 + k);
        acc[0][0] = __builtin_amdgcn_mfma_f32_16x16x32_bf16(B0, A0, acc[0][0], 0, 0, 0);
        acc[0][1] = __builtin_amdgcn_mfma_f32_16x16x32_bf16(B1, A0, acc[0][1], 0, 0, 0);
        acc[1][0] = __builtin_amdgcn_mfma_f32_16x16x32_bf16(B0, A1, acc[1][0], 0, 0, 0);
        acc[1][1] = __builtin_amdgcn_mfma_f32_16x16x32_bf16(B1, A1, acc[1][1], 0, 0, 0);
    }
}
namespace g8 {
constexpr int BM = 256, BK = 64, HALF = 128, HTB = HALF * BK * 2, STAGE_BYTES = 8 * HTB, NXCD = 8, WGM = 8;
__device__ __forceinline__ int lds_byte(int r, int c) { const int st = (r >> 4) * 2 + (c >> 5), rr = r & 15, cc = c & 31, ob = rr * 64 + cc * 2; return st * 1024 + (ob ^ (((ob >> 9) & 1) << 5)); }
__device__ __forceinline__ void stage_rc(int b, int& R, int& C) { const int st = b / 1024, sb = b % 1024, swz = sb ^ (((sb >> 9) & 1) << 5); R = (st >> 1) * 16 + swz / 64; C = (st & 1) * 32 + (swz % 64) / 2; }
struct Unit { int pm, pn, bt, e; };
struct StaticOrder {
    int nM, nN, nwg, G, c;
    __device__ void init(int nM_, int nN_, int G_, int c_) { nM = nM_; nN = nN_; nwg = nM * nN; G = G_; c = c_; }
    __device__ bool next(int i, Unit& u) const {
        const long L = (long)i * G + c; if (L >= nwg) return false;
        int wgid = (int)L; { const int q = nwg / NXCD, r = nwg % NXCD, xcd = wgid % NXCD, off = wgid / NXCD; wgid = (xcd < r ? xcd * (q + 1) : r * (q + 1) + (xcd - r) * q) + off; }
        const int nig = WGM * nN, gid = wgid / nig, fm = gid * WGM, gsz = (nM - fm) < WGM ? (nM - fm) : WGM;
        u.pm = fm + ((wgid % nig) % gsz); u.pn = (wgid % nig) / gsz; u.bt = u.pn; u.e = 0; return true;
    }
};
struct GroupedOrder {
    StaticOrder so; const LAS int* sm;
    __device__ void init(const LAS int* sm_, int nN_, int G_, int c_) { sm = sm_; so.init(sm_[32] / BM, nN_, G_, c_); }
    __device__ bool next(int i, Unit& u) const {
        if (!so.next(i, u)) return false;
        const int rowt = u.pm * BM; int e = 0;
#pragma unroll
        for (int q = 1; q < NE; ++q) e = (rowt >= sm[16 + q]) ? q : e;
        u.e = e; u.bt = e * so.nN + u.pn; return true;
    }
};
struct GatherInfo { const int* rowlist; const LAS int* sm; };

__device__ __forceinline__ int perm32(int rho) { const int n = rho >> 4, i = rho & 15; return 8 * (i >> 2) + 4 * n + (i & 3); }
template <bool GATHER, class Epi, class Sched>
__device__ __forceinline__ void gemm8(LAS unsigned char* lds, const bf16_t* A, int lda, const bf16_t* Bt, int K, const Sched& S, const Epi& E, GatherInfo gi) {
    const int tid = threadIdx.x, wid = __builtin_amdgcn_readfirstlane(tid >> 6), lane = tid & 63, wr = wid >> 2, wc = wid & 3, fr = lane & 15, fq = lane >> 4;
    const int nt = K / BK;
    int Rr[2], Cc[2]; unsigned voffB[2]; unsigned vAc[2][2], vAn[2][2];
#pragma unroll
    for (int i = 0; i < 2; ++i) { stage_rc(tid * 16 + i * 8192, Rr[i], Cc[i]); voffB[i] = (unsigned)(((Rr[i] & ~31) + perm32(Rr[i] & 31)) * K + Cc[i]) * 2u;
#pragma unroll
        for (int h = 0; h < 2; ++h) { vAc[h][i] = (unsigned)((Rr[i] + HALF * h) * lda + Cc[i]) * 2u; vAn[h][i] = vAc[h][i]; } }
    const size_t kstep = (size_t)(BK * 2);
    const size_t hstepB = (size_t)HALF * K * 2, tstepB = 2 * hstepB, tstepA = (size_t)BM * lda * 2;
    const unsigned ldsw = (unsigned)wid * 1024u;
    const int aoff = lds_byte(wr * 64 + fr, fq * 8), boff = lds_byte(wc * 32 + fr, fq * 8);
#define G8_SA(b, h) (((b) * 2 + (h)) * HTB)
#define G8_SB(b, h) ((4 + (b) * 2 + (h)) * HTB)
#define G8_STAGEB(bufoff, gbase) do { _Pragma("unroll") for (int _i = 0; _i < 2; ++_i) \
        __builtin_amdgcn_global_load_lds((const unsigned*)((const char*)(gbase) + voffB[_i]), (LAS unsigned*)(lds + (bufoff) + ldsw + _i * 8192), 16, 0, 0); } while (0)
#define G8_STAGEA(bufoff, gbase, v0, v1) do { \
        __builtin_amdgcn_global_load_lds((const unsigned*)((const char*)(gbase) + (v0)), (LAS unsigned*)(lds + (bufoff) + ldsw), 16, 0, 0); \
        __builtin_amdgcn_global_load_lds((const unsigned*)((const char*)(gbase) + (v1)), (LAS unsigned*)(lds + (bufoff) + ldsw + 8192), 16, 0, 0); } while (0)
#define G8_LDA(dst, b, h) do { _Pragma("unroll") for (int m = 0; m < 4; ++m) _Pragma("unroll") for (int k = 0; k < 2; ++k) dst[m][k] = *(const LAS bf16x8*)(lds + G8_SA(b, h) + aoff + m * 2048 + k * 1024); } while (0)
#define G8_LDB(dst, b, h) do { _Pragma("unroll") for (int n = 0; n < 2; ++n) _Pragma("unroll") for (int k = 0; k < 2; ++k) dst[n][k] = *(const LAS bf16x8*)(lds + G8_SB(b, h) + boff + n * 2048 + k * 1024); } while (0)
#define G8_MMA(ai, bj, At, Bt_) do { __builtin_amdgcn_s_setprio(1); _Pragma("unroll") for (int m = 0; m < 4; ++m) _Pragma("unroll") for (int n = 0; n < 2; ++n) _Pragma("unroll") for (int k = 0; k < 2; ++k) \
        acc[ai][bj][m][n] = __builtin_amdgcn_mfma_f32_16x16x32_bf16(Bt_[n][k], At[m][k], acc[ai][bj][m][n], 0, 0, 0); __builtin_amdgcn_s_setprio(0); } while (0)
#define G8_WAIT_V(n) asm volatile("s_waitcnt vmcnt(" #n ")" ::: "memory")
#define G8_WAIT_L(n) asm volatile("s_waitcnt lgkmcnt(" #n ")" ::: "memory")
#define G8_BAR __builtin_amdgcn_s_barrier()
#define G8_SCHED __builtin_amdgcn_sched_barrier(0)
#define G8_GATHER(u, v) do { if (GATHER) { const int _eb = gi.sm[16 + (u).e], _ec = gi.sm[(u).e]; \
        _Pragma("unroll") for (int _h = 0; _h < 2; ++_h) _Pragma("unroll") for (int _i = 0; _i < 2; ++_i) { const int _s = (u).pm * BM + HALF * _h + Rr[_i] - _eb; \
            const int _t = gi.rowlist[(u).e * NTOK + (_s < _ec ? _s : 0)]; v[_h][_i] = (unsigned)(_t * K + Cc[_i]) * 2u; } } } while (0)
    Unit cur, nxt; int ui = 0;
    if (!S.next(0, cur)) return;
    f32x4 acc[2][2][4][2];
#pragma unroll
    for (int a = 0; a < 2; ++a)
#pragma unroll
        for (int b = 0; b < 2; ++b)
#pragma unroll
            for (int m = 0; m < 4; ++m)
#pragma unroll
                for (int n = 0; n < 2; ++n) acc[a][b][m][n] = (f32x4){0.f, 0.f, 0.f, 0.f};
    bf16x8 At[4][2], B0[2][2], B1[2][2];
    G8_GATHER(cur, vAc);
    const char* cA = GATHER ? (const char*)A : (const char*)A + (size_t)cur.pm * tstepA; const char* cB = (const char*)Bt + (size_t)cur.bt * tstepB;
    G8_STAGEB(G8_SB(0, 0), cB); G8_STAGEB(G8_SB(0, 1), cB + hstepB); G8_STAGEA(G8_SA(0, 0), cA, vAc[0][0], vAc[0][1]); G8_STAGEA(G8_SA(0, 1), cA, vAc[1][0], vAc[1][1]);
    if (wr == 1) G8_BAR;
    G8_WAIT_V(2); G8_BAR;
    G8_STAGEB(G8_SB(1, 0), cB + kstep); G8_STAGEA(G8_SA(1, 0), cA + kstep, vAc[0][0], vAc[0][1]); G8_STAGEB(G8_SB(1, 1), cB + hstepB + kstep);
    G8_WAIT_V(6); G8_BAR;
    for (;;) {
        const bool has_next = S.next(ui + 1, nxt);
        if (has_next) G8_GATHER(nxt, vAn);
        const char* nA = has_next ? (GATHER ? (const char*)A : (const char*)A + (size_t)nxt.pm * tstepA) : cA; const char* nB = has_next ? (const char*)Bt + (size_t)nxt.bt * tstepB : cB;
        for (int t = 0; t < nt; t += 2) {
            const bool last = (t == nt - 2);
            const char* a1 = cA + (size_t)(t + 1) * kstep;
            const char* a2 = last ? nA : cA + (size_t)(t + 2) * kstep; const char* b2 = last ? nB : cB + (size_t)(t + 2) * kstep;
            const char* a3 = a2 + kstep; const char* b3 = b2 + kstep;
            const bool usen = GATHER && last && has_next;
            const unsigned w00 = usen ? vAn[0][0] : vAc[0][0], w01 = usen ? vAn[0][1] : vAc[0][1], w10 = usen ? vAn[1][0] : vAc[1][0], w11 = usen ? vAn[1][1] : vAc[1][1];
            G8_LDB(B0, 0, 0); G8_LDB(B1, 0, 1); G8_SCHED; G8_LDA(At, 0, 0); G8_STAGEA(G8_SA(1, 1), a1, vAc[1][0], vAc[1][1]);
            G8_WAIT_V(8); G8_WAIT_L(0); G8_BAR; G8_MMA(0, 0, At, B0); G8_MMA(0, 1, At, B1); G8_BAR; G8_SCHED;
            G8_LDA(At, 0, 1); G8_STAGEB(G8_SB(0, 0), b2); G8_STAGEB(G8_SB(0, 1), b2 + hstepB); G8_STAGEA(G8_SA(0, 0), a2, w00, w01);
            G8_WAIT_V(8); G8_WAIT_L(0); G8_BAR; G8_MMA(1, 0, At, B0); G8_MMA(1, 1, At, B1); G8_BAR; G8_SCHED;
            G8_LDB(B0, 1, 0); G8_LDB(B1, 1, 1); G8_SCHED; G8_LDA(At, 1, 0); G8_STAGEA(G8_SA(0, 1), a2, w10, w11);
            G8_WAIT_V(8); G8_WAIT_L(0); G8_BAR; G8_MMA(0, 0, At, B0); G8_MMA(0, 1, At, B1); G8_BAR; G8_SCHED;
            G8_LDA(At, 1, 1); G8_STAGEB(G8_SB(1, 0), b3); G8_STAGEB(G8_SB(1, 1), b3 + hstepB); G8_STAGEA(G8_SA(1, 0), a3, w00, w01);
            G8_WAIT_V(8); G8_WAIT_L(0); G8_BAR; G8_MMA(1, 0, At, B0); G8_MMA(1, 1, At, B1); G8_BAR; G8_SCHED;
        }
        if (wr == 0) G8_BAR;
        E(acc, cur, wr, wc, fr, fq);
        if (!has_next) break;
#pragma unroll
        for (int a = 0; a < 2; ++a)
#pragma unroll
            for (int b = 0; b < 2; ++b)
#pragma unroll
                for (int m = 0; m < 4; ++m)
#pragma unroll
                    for (int n = 0; n < 2; ++n) acc[a][b][m][n] = (f32x4){0.f, 0.f, 0.f, 0.f};
        cur = nxt; cA = nA; cB = nB; ++ui;
#pragma unroll
        for (int h = 0; h < 2; ++h)
#pragma unroll
            for (int i = 0; i < 2; ++i) vAc[h][i] = vAn[h][i];
        if (wr == 1) G8_BAR;
    }
    G8_WAIT_V(0);
    G8_BAR;
#undef G8_SA
#undef G8_SB
#undef G8_STAGEA
#undef G8_STAGEB
#undef G8_LDA
#undef G8_LDB
#undef G8_MMA
#undef G8_WAIT_V
#undef G8_WAIT_L
#undef G8_BAR
#undef G8_SCHED
#undef G8_GATHER
}
template <class F> struct EpiEl {
    F f;
    __device__ __forceinline__ void operator()(const f32x4 (&acc)[2][2][4][2], const Unit& u, int wr, int wc, int fr, int fq) const {
#pragma unroll
        for (int ai = 0; ai < 2; ++ai)
#pragma unroll
            for (int m = 0; m < 4; ++m) { const int row = u.pm * BM + ai * HALF + wr * 64 + m * 16 + fr;
#pragma unroll
                for (int bj = 0; bj < 2; ++bj) f(row, u.pn * BM + bj * HALF + wc * 32 + 8 * fq, acc[ai][bj][m][0], acc[ai][bj][m][1]); }
    }
};
}

struct EpiNsaIn {
    bf16_t* Q; bf16_t* KV; float* gates; const float2* rope;
    __device__ __forceinline__ void operator()(int row, int c, f32x4 v) const {
        const int t = row & (SEQ - 1), b = row >> 13;
        if (c < 1024) {
            v = v * QSCALE;
            const int d = (c & 63) >> 1; const float2 c0 = rope[t * 32 + d], c1 = rope[t * 32 + d + 1];
            bf16_t* p = Q + (size_t)row * DM + (c & ~63);
            *(unsigned*)(p + d) = pk2(v[0] * c0.x - v[1] * c0.y, v[2] * c1.x - v[3] * c1.y);
            *(unsigned*)(p + d + 32) = pk2(v[1] * c0.x + v[0] * c0.y, v[3] * c1.x + v[2] * c1.y);
        } else if (c < 2560) {
            const int s = (c - 1024) >> 8, g = ((c - 1024) >> 6) & 3;
            bf16_t* p = KV + (size_t)s * (KVSEG / 2) + ((size_t)(b * NG + g) * SEQ + t) * DH;
            if (s == 2 || s == 4) {
                const int d = (c & 63) >> 1; const float2 c0 = rope[t * 32 + d], c1 = rope[t * 32 + d + 1];
                *(unsigned*)(p + d) = pk2(v[0] * c0.x - v[1] * c0.y, v[2] * c1.x - v[3] * c1.y);
                *(unsigned*)(p + d + 32) = pk2(v[1] * c0.x + v[0] * c0.y, v[3] * c1.x + v[2] * c1.y);
            } else {
                *(u32x2*)(p + (c & 63)) = (u32x2){pk2(v[0], v[1]), pk2(v[2], v[3])};
            }
        } else if (c < NSA_IN) {
            float* gp = gates + (size_t)row * 48 + (c - 2560);
            *(f32x4*)gp = (f32x4){sigmoidf_(v[0]), sigmoidf_(v[1]), sigmoidf_(v[2]), sigmoidf_(v[3])};
        }
    }
    __device__ __forceinline__ void operator()(int row, int c, f32x4 v, f32x4 w) const {
        const int t = row & (SEQ - 1), b = row >> 13;
        const int s = (c - 1024) >> 8;
        const bool isq = c < 1024, roped = isq || s == 2 || s == 4;
        if (roped) {
            if (isq) { v = v * QSCALE; w = w * QSCALE; }
            const int g = ((c - 1024) >> 6) & 3, d = (c & 63) >> 1;
            bf16_t* p = isq ? Q + (size_t)row * DM + (c & ~63) : KV + (size_t)s * (KVSEG / 2) + ((size_t)(b * NG + g) * SEQ + t) * DH;
            const f32x4 cs01 = *(const f32x4*)(rope + t * 32 + d), cs23 = *(const f32x4*)(rope + t * 32 + d + 2);
            *(u32x2*)(p + d) = (u32x2){pk2(v[0] * cs01[0] - v[1] * cs01[1], v[2] * cs01[2] - v[3] * cs01[3]), pk2(w[0] * cs23[0] - w[1] * cs23[1], w[2] * cs23[2] - w[3] * cs23[3])};
            *(u32x2*)(p + d + 32) = (u32x2){pk2(v[1] * cs01[0] + v[0] * cs01[1], v[3] * cs01[2] + v[2] * cs01[3]), pk2(w[1] * cs23[0] + w[0] * cs23[1], w[3] * cs23[2] + w[2] * cs23[3])};
        } else {
            const int g = ((c - 1024) >> 6) & 3;
            bf16_t* p = KV + (size_t)s * (KVSEG / 2) + ((size_t)(b * NG + g) * SEQ + t) * DH + (c & 63);
            *(u32x4*)p = (u32x4){pk2(v[0], v[1]), pk2(v[2], v[3]), pk2(w[0], w[1]), pk2(w[2], w[3])};
        }
    }
};
struct EpiMobaIn {
    bf16_t* Q; bf16_t* K; bf16_t* V; const float2* rope;
    __device__ __forceinline__ void operator()(int row, int c, f32x4 v) const {
        const int t = row & (SEQ - 1), b = row >> 13;
        if (c < 2048) {
            if (c < 1024) v = v * QSCALE;
            const int d = (c & 63) >> 1; const float2 c0 = rope[t * 32 + d], c1 = rope[t * 32 + d + 1];
            bf16_t* p = c < 1024 ? Q + (size_t)row * DM + (c & ~63) : K + ((size_t)(b * NH + ((c - 1024) >> 6)) * SEQ + t) * DH;
            *(unsigned*)(p + d) = pk2(v[0] * c0.x - v[1] * c0.y, v[2] * c1.x - v[3] * c1.y);
            *(unsigned*)(p + d + 32) = pk2(v[1] * c0.x + v[0] * c0.y, v[3] * c1.x + v[2] * c1.y);
        } else {
            bf16_t* p = V + ((size_t)(b * NH + ((c - 2048) >> 6)) * SEQ + t) * DH + (c & 63);
            *(u32x2*)p = (u32x2){pk2(v[0], v[1]), pk2(v[2], v[3])};
        }
    }
    __device__ __forceinline__ void operator()(int row, int c, f32x4 v, f32x4 w) const {
        const int t = row & (SEQ - 1), b = row >> 13;
        if (c < 2048) {
            if (c < 1024) { v = v * QSCALE; w = w * QSCALE; }
            const int d = (c & 63) >> 1;
            bf16_t* p = c < 1024 ? Q + (size_t)row * DM + (c & ~63) : K + ((size_t)(b * NH + ((c - 1024) >> 6)) * SEQ + t) * DH;
            const f32x4 cs01 = *(const f32x4*)(rope + t * 32 + d), cs23 = *(const f32x4*)(rope + t * 32 + d + 2);
            *(u32x2*)(p + d) = (u32x2){pk2(v[0] * cs01[0] - v[1] * cs01[1], v[2] * cs01[2] - v[3] * cs01[3]), pk2(w[0] * cs23[0] - w[1] * cs23[1], w[2] * cs23[2] - w[3] * cs23[3])};
            *(u32x2*)(p + d + 32) = (u32x2){pk2(v[1] * cs01[0] + v[0] * cs01[1], v[3] * cs01[2] + v[2] * cs01[3]), pk2(w[1] * cs23[0] + w[0] * cs23[1], w[3] * cs23[2] + w[2] * cs23[3])};
        } else {
            bf16_t* p = V + ((size_t)(b * NH + ((c - 2048) >> 6)) * SEQ + t) * DH + (c & 63);
            *(u32x4*)p = (u32x4){pk2(v[0], v[1]), pk2(v[2], v[3]), pk2(w[0], w[1]), pk2(w[2], w[3])};
        }
    }
};
struct EpiGelu {
    bf16_t* O; const float* bias;
    __device__ __forceinline__ void operator()(int row, int c, f32x4 v) const {
        const f32x4 bv = *(const f32x4*)(bias + c);
        *(u32x2*)(O + (size_t)row * 256 + c) = (u32x2){pk2(gelu_tanh(v[0] + bv[0]), gelu_tanh(v[1] + bv[1])), pk2(gelu_tanh(v[2] + bv[2]), gelu_tanh(v[3] + bv[3]))};
    }
    __device__ __forceinline__ void operator()(int row, int c, f32x4 v, f32x4 w) const {
        const f32x4 bv = *(const f32x4*)(bias + c), bw = *(const f32x4*)(bias + c + 4);
        *(u32x4*)(O + (size_t)row * 256 + c) = (u32x4){pk2(gelu_tanh(v[0] + bv[0]), gelu_tanh(v[1] + bv[1])), pk2(gelu_tanh(v[2] + bv[2]), gelu_tanh(v[3] + bv[3])),
                                                      pk2(gelu_tanh(w[0] + bw[0]), gelu_tanh(w[1] + bw[1])), pk2(gelu_tanh(w[2] + bw[2]), gelu_tanh(w[3] + bw[3]))};
    }
};
struct EpiSwiGLU {
    bf16_t* H;
    __device__ __forceinline__ void operator()(int row, int c, f32x4 v) const {
        const float h0 = v[0] * sigmoidf_(v[0]) * v[1], h1 = v[2] * sigmoidf_(v[2]) * v[3];
        *(unsigned*)(H + (size_t)row * DE + (c >> 1)) = pk2(h0, h1);
    }
    __device__ __forceinline__ void operator()(int row, int c, f32x4 v, f32x4 w) const {
        *(u32x2*)(H + (size_t)row * DE + (c >> 1)) = (u32x2){pk2(v[0] * sigmoidf_(v[0]) * v[1], v[2] * sigmoidf_(v[2]) * v[3]), pk2(w[0] * sigmoidf_(w[0]) * w[1], w[2] * sigmoidf_(w[2]) * w[3])};
    }
};
struct EpiBf16 {
    bf16_t* Y;
    __device__ __forceinline__ void operator()(int row, int c, f32x4 v) const { *(u32x2*)(Y + (size_t)row * DM + c) = (u32x2){pk2(v[0], v[1]), pk2(v[2], v[3])}; }
    __device__ __forceinline__ void operator()(int row, int c, f32x4 v, f32x4 w) const { *(u32x4*)(Y + (size_t)row * DM + c) = (u32x4){pk2(v[0], v[1]), pk2(v[2], v[3]), pk2(w[0], w[1]), pk2(w[2], w[3])}; }
};

struct ExpertMap { int cnt[NE]; int base[NE + 1]; };
__device__ __forceinline__ void load_expert_map(const Ctx& C, int cw, LAS int* sm  ) {
    if (C.tid == 0) {
        const unsigned* ctl = (const unsigned*)(C.ws + WS_CTL); int acc = 0;
        for (int e = 0; e < NE; ++e) { const int c = (int)__hip_atomic_load(ctl + cw + 64 * e, __ATOMIC_RELAXED, __HIP_MEMORY_SCOPE_AGENT); sm[e] = c; sm[16 + e] = acc; acc += (c + 255) & ~255; }
        sm[32] = acc;
    }
    __syncthreads();
}

__device__ __forceinline__ void ph_cmp2(const Ctx& C) {
    const int gt = C.bid * NTHREADS + C.tid, NGT = C.nb * NTHREADS;
    const float2* rope = (const float2*)(C.ws + WS_ROPE);
    for (int i = gt; i < 2 * 8192 * 32; i += NGT) {
        const int which = i >= 8192 * 32; const int j = i - which * 8192 * 32; const int r = j >> 5, d = j & 31, ci = r & 511;
        const bf16_t* h = (const bf16_t*)(C.ws + (which ? WS_H1V : WS_H1K)) + (size_t)r * 256;
        const float* w2 = C.in[which ? I_CV_W2 : I_CK_W2];
        float s0 = 0.f, s1 = 0.f;
        for (int k = 0; k < 256; ++k) { const float hv = bf2f(h[k]); s0 += hv * w2[k * 64 + d]; s1 += hv * w2[k * 64 + d + 32]; }
        bf16_t* o = (bf16_t*)(C.ws + (which ? WS_VC : WS_KC)) + (size_t)r * 64;
        if (ci == 511) { s0 = 0.f; s1 = 0.f; }
        else if (!which) { const float2 cs = rope[(16 * ci + 31) * 32 + d]; const float a = s0 * cs.x - s1 * cs.y, b2 = s1 * cs.x + s0 * cs.y; s0 = a; s1 = b2; }
        o[d] = (bf16_t)f2bf(s0); o[d + 32] = (bf16_t)f2bf(s1);
    }
}

__device__ __forceinline__ void load_qh(const bf16_t* qp, float (&qh)[64]) {
    const uint4* q4 = (const uint4*)qp;
#pragma unroll
    for (int c = 0; c < 8; ++c) { const uint4 w = q4[c]; qh[8 * c] = bflo(w.x); qh[8 * c + 1] = bfhi(w.x); qh[8 * c + 2] = bflo(w.y); qh[8 * c + 3] = bfhi(w.y);
        qh[8 * c + 4] = bflo(w.z); qh[8 * c + 5] = bfhi(w.z); qh[8 * c + 6] = bflo(w.w); qh[8 * c + 7] = bfhi(w.w); }
}
namespace fa {
constexpr int SLOT = 16384, NSLOT = 4;
constexpr float C2 = 0.125f * 1.4426950408889634f;
constexpr float NEGBIG = -1e30f;
typedef short v4i16 __attribute__((ext_vector_type(4)));
__device__ __forceinline__ void dma_block(LAS unsigned char* slot, const bf16_t* Kg, const bf16_t* Vg, int wave, int lane) {
    { const int key = 8 * wave + (lane >> 3), c = (lane & 7) ^ ((key >> 1) & 7);
      __builtin_amdgcn_global_load_lds((const unsigned*)(Kg + key * 64 + 8 * c), (LAS unsigned*)(slot + wave * 1024), 16, 0, 0); }
    { const int key = 16 * (wave & 3) + (lane >> 2), cp = lane & 3, d = (wave >> 2) * 32 + ((((cp >> 1) ^ ((key >> 2) & 1))) << 4) + ((cp & 1) << 3);
      __builtin_amdgcn_global_load_lds((const unsigned*)(Vg + key * 64 + d), (LAS unsigned*)(slot + 8192 + wave * 1024), 16, 0, 0); }
}
__device__ __forceinline__ unsigned cvt_pk_bf16(float lo, float hi) { const f32x2v v = {lo, hi}; const bf16x2v b = __builtin_convertvector(v, bf16x2v); return __builtin_bit_cast(unsigned, b); }
struct Task { bf16x8 q[2]; int kmin, kmax; float m, l, cinit; f32x4 O[4]; f32x4 L; unsigned fw0; const LAS unsigned* fwp; int imptok; };
template <int FM> __device__ __forceinline__ bool row_flag(const Task& t, int jb) {
    if (FM == 0) return true;
    if (FM == 1) { const unsigned w = t.fwp[jb >> 5]; return ((w >> (jb & 31)) & 1u) != 0u; }
    return ((t.fw0 >> (jb >> 2)) & 1u) != 0u;
}
struct LaneC { int fq, koff0, koff1, voffA, voffB; };
__device__ __forceinline__ LaneC lane_consts(int lane) {
    const int i16 = lane & 15, fq = lane >> 4, kx = (i16 >> 1) & 7, q4 = i16 >> 2, p4 = lane & 3;
    LaneC lc; lc.fq = fq; lc.koff0 = i16 * 128 + ((fq ^ kx) << 4); lc.koff1 = i16 * 128 + (((4 + fq) ^ kx) << 4);
    lc.voffA = 8192 + (4 * fq + q4) * 64 + ((0 ^ (fq & 1)) << 5) + 8 * p4; lc.voffB = 8192 + (4 * fq + q4) * 64 + ((1 ^ (fq & 1)) << 5) + 8 * p4;
    return lc;
}
__device__ __forceinline__ float xrow16_max(float x) {
    auto s = __builtin_amdgcn_permlane16_swap(__float_as_uint(x), __float_as_uint(x), false, false);
    x = fmaxf(__uint_as_float(s[0]), __uint_as_float(s[1]));
    auto t = __builtin_amdgcn_permlane32_swap(__float_as_uint(x), __float_as_uint(x), false, false);
    return fmaxf(__uint_as_float(t[0]), __uint_as_float(t[1]));
}
__device__ __forceinline__ float xrow16_sum(float x) {
    auto s = __builtin_amdgcn_permlane16_swap(__float_as_uint(x), __float_as_uint(x), false, false);
    x = __uint_as_float(s[0]) + __uint_as_float(s[1]);
    auto t = __builtin_amdgcn_permlane32_swap(__float_as_uint(x), __float_as_uint(x), false, false);
    return __uint_as_float(t[0]) + __uint_as_float(t[1]);
}
__device__ __forceinline__ void t_mask(const Task& t, f32x4 (&s)[4], int kb, int fq) {
#pragma unroll
    for (int kt = 0; kt < 4; ++kt)
#pragma unroll
        for (int r = 0; r < 4; ++r) { const int key = kb + 16 * kt + 4 * fq + r; s[kt][r] = (key >= t.kmin && key <= t.kmax) ? s[kt][r] : NEGBIG; }
}
template <int MODE> __device__ __forceinline__ float t_stats(Task& t, f32x4 (&s)[4], bool rf) {
    float bm = fmaxf(fmaxf(fmaxf(s[0][0], s[0][1]), fmaxf(s[0][2], s[0][3])), fmaxf(fmaxf(s[1][0], s[1][1]), fmaxf(s[1][2], s[1][3])));
    bm = fmaxf(bm, fmaxf(fmaxf(fmaxf(s[2][0], s[2][1]), fmaxf(s[2][2], s[2][3])), fmaxf(fmaxf(s[3][0], s[3][1]), fmaxf(s[3][2], s[3][3]))));
    bm = xrow16_max(bm);
    if (!rf) bm = NEGBIG;
    const float mnew = fmaxf(t.m, bm);
    const float alpha = __builtin_amdgcn_exp2f(t.m - mnew);
    t.m = mnew;
    const float msub = (rf && mnew > -1e29f) ? mnew : __builtin_inff();
#pragma unroll
    for (int kt = 0; kt < 4; ++kt) s[kt] = s[kt] - msub;
    if (MODE == 1) t.l *= alpha;
    return alpha;
}
__device__ __forceinline__ void t_exp(f32x4 (&s)[4]) {
#pragma unroll
    for (int kt = 0; kt < 4; ++kt)
#pragma unroll
        for (int r = 0; r < 4; ++r) s[kt][r] = __builtin_amdgcn_exp2f(s[kt][r]);
}
__device__ __forceinline__ float quad_sum(float x) {
    x += __builtin_bit_cast(float, __builtin_amdgcn_mov_dpp(__builtin_bit_cast(int, x), 0xB1, 0xf, 0xf, true));
    x += __builtin_bit_cast(float, __builtin_amdgcn_mov_dpp(__builtin_bit_cast(int, x), 0x4E, 0xf, 0xf, true));
    return x;
}
__device__ __forceinline__ void t_imp(const Task& t, const f32x4 (&s)[4], int kb, int fq, LAS float* impbase) {
    float ga[4], gb[4];
#pragma unroll
    for (int kt = 0; kt < 4; ++kt) { ga[kt] = quad_sum((s[kt][0] + s[kt][1]) + (s[kt][2] + s[kt][3])); gb[kt] = quad_sum(s[kt][3]); }
    if ((t.imptok & 0x10000) == 0) return;
    LAS float* ip = impbase + (t.imptok & 0xffff) * 130 + (kb >> 2) + fq;
#pragma unroll
    for (int kt = 0; kt < 4; ++kt) { ip[4 * kt] = ga[kt]; ip[64 * 130 + 4 * kt] = gb[kt]; }
}
__device__ __forceinline__ bf16x8 t_pack(const f32x4 (&s)[4], int u) {
    u32x4 pw; pw.x = cvt_pk_bf16(s[2 * u][0], s[2 * u][1]); pw.y = cvt_pk_bf16(s[2 * u][2], s[2 * u][3]); pw.z = cvt_pk_bf16(s[2 * u + 1][0], s[2 * u + 1][1]); pw.w = cvt_pk_bf16(s[2 * u + 1][2], s[2 * u + 1][3]);
    return __builtin_bit_cast(bf16x8, pw);
}
template <int MODE, bool DA, bool DB>
__device__ __forceinline__ void do_blk(Task& a, Task& b, bool rfa, bool rfb, bool masked, LAS unsigned char* slot, int kb, LAS float* impbase, const LaneC& lc) {
    f32x4 sa[4], sb[4];
    const float xa = (MODE >= 2) ? (rfa ? a.cinit : -__builtin_inff()) : 0.f, xb = (MODE >= 2) ? (rfb ? b.cinit : -__builtin_inff()) : 0.f;
    const f32x4 ca = (f32x4){xa, xa, xa, xa}, cb = (f32x4){xb, xb, xb, xb};
#pragma unroll
    for (int kt = 0; kt < 4; ++kt) {
        const bf16x8 k0 = *(const LAS bf16x8*)(slot + lc.koff0 + kt * 2048), k1 = *(const LAS bf16x8*)(slot + lc.koff1 + kt * 2048);
        if (DA) { sa[kt] = __builtin_amdgcn_mfma_f32_16x16x32_bf16(k0, a.q[0], ca, 0, 0, 0); sa[kt] = __builtin_amdgcn_mfma_f32_16x16x32_bf16(k1, a.q[1], sa[kt], 0, 0, 0); }
        if (DB) { sb[kt] = __builtin_amdgcn_mfma_f32_16x16x32_bf16(k0, b.q[0], cb, 0, 0, 0); sb[kt] = __builtin_amdgcn_mfma_f32_16x16x32_bf16(k1, b.q[1], sb[kt], 0, 0, 0); }
    }
    if (masked) { if (DA) t_mask(a, sa, kb, lc.fq); if (DB) t_mask(b, sb, kb, lc.fq); }
    if (MODE < 2) {
        float ala = 1.0f, alb = 1.0f;
        if (DA) ala = t_stats<MODE>(a, sa, rfa);
        if (DB) alb = t_stats<MODE>(b, sb, rfb);
        if (MODE == 0) {
            if (__ballot((DA && ala != 1.0f) || (DB && alb != 1.0f)) != 0ull) {
#pragma unroll
                for (int dt = 0; dt < 4; ++dt) { if (DA) a.O[dt] = a.O[dt] * ala; if (DB) b.O[dt] = b.O[dt] * alb; }
                if (DA) a.L = a.L * ala; if (DB) b.L = b.L * alb;
            }
        }
    }
    if (DA) t_exp(sa);
    if (DB) t_exp(sb);
    if (MODE == 1) {
        if (DA) a.l += ((sa[0][0] + sa[0][1]) + (sa[0][2] + sa[0][3])) + ((sa[1][0] + sa[1][1]) + (sa[1][2] + sa[1][3])) + ((sa[2][0] + sa[2][1]) + (sa[2][2] + sa[2][3])) + ((sa[3][0] + sa[3][1]) + (sa[3][2] + sa[3][3]));
        if (DB) b.l += ((sb[0][0] + sb[0][1]) + (sb[0][2] + sb[0][3])) + ((sb[1][0] + sb[1][1]) + (sb[1][2] + sb[1][3])) + ((sb[2][0] + sb[2][1]) + (sb[2][2] + sb[2][3])) + ((sb[3][0] + sb[3][1]) + (sb[3][2] + sb[3][3]));
    }
    if (MODE == 2) { if (DA) t_imp(a, sa, kb, lc.fq, impbase); if (DB) t_imp(b, sb, kb, lc.fq, impbase); }
    if (MODE != 1) {
        const bf16x8 ones = (bf16x8){0x3F80, 0x3F80, 0x3F80, 0x3F80, 0x3F80, 0x3F80, 0x3F80, 0x3F80};
#pragma unroll
        for (int u = 0; u < 2; ++u) {
            bf16x8 pa, pb; if (DA) pa = t_pack(sa, u); if (DB) pb = t_pack(sb, u);
            if (MODE != 2) { if (DA) a.L = __builtin_amdgcn_mfma_f32_16x16x32_bf16(ones, pa, a.L, 0, 0, 0); if (DB) b.L = __builtin_amdgcn_mfma_f32_16x16x32_bf16(ones, pb, b.L, 0, 0, 0); }
#pragma unroll
            for (int dt = 0; dt < 4; ++dt) {
                const int vo = ((dt & 1) ? lc.voffB : lc.voffA) + (dt >> 1) * 4096 + u * 2048;
                const v4i16 a0 = __builtin_amdgcn_ds_read_tr16_b64_v4i16((LAS v4i16*)(slot + vo)), a1 = __builtin_amdgcn_ds_read_tr16_b64_v4i16((LAS v4i16*)(slot + vo + 1024));
                const bf16x8 vf = (bf16x8){a0[0], a0[1], a0[2], a0[3], a1[0], a1[1], a1[2], a1[3]};
                if (DA) a.O[dt] = __builtin_amdgcn_mfma_f32_16x16x32_bf16(vf, pa, a.O[dt], 0, 0, 0);
                if (DB) b.O[dt] = __builtin_amdgcn_mfma_f32_16x16x32_bf16(vf, pb, b.O[dt], 0, 0, 0);
            }
        }
    }
}
template <int MODE, int FM>
__device__ __forceinline__ void flash_loop(LAS unsigned char* ring, const bf16_t* Kg, const bf16_t* Vg, int nblk, Task& Ta, Task& Tb, LAS float* impbase, int wave, int lane) {
    const int i16 = lane & 15, fq = lane >> 4;
    const int kx = (i16 >> 1) & 7;
    const int q4 = i16 >> 2, p4 = lane & 3;
    LaneC lc; lc.fq = fq; lc.koff0 = i16 * 128 + ((fq ^ kx) << 4); lc.koff1 = i16 * 128 + (((4 + fq) ^ kx) << 4);
    lc.voffA = 8192 + (4 * fq + q4) * 64 + ((0 ^ (fq & 1)) << 5) + 8 * p4; lc.voffB = 8192 + (4 * fq + q4) * 64 + ((1 ^ (fq & 1)) << 5) + 8 * p4;
    const int amin = __builtin_amdgcn_readlane(Ta.kmin, 15), amax = __builtin_amdgcn_readlane(Ta.kmax, 0), bmin = __builtin_amdgcn_readlane(Tb.kmin, 15), bmax = __builtin_amdgcn_readlane(Tb.kmax, 0);
#pragma unroll
    for (int j = 0; j < NSLOT - 1; ++j) { const int jj = j < nblk ? j : nblk - 1; dma_block(ring + j * SLOT, Kg + (size_t)jj * 4096, Vg + (size_t)jj * 4096, wave, lane); }
    for (int jb = 0; jb < nblk; ++jb) {
        asm volatile("s_waitcnt vmcnt(4) lgkmcnt(0)\n\ts_barrier" ::: "memory");
        { const int jn = jb + 3 < nblk ? jb + 3 : nblk - 1; dma_block(ring + ((jb + 3) & 3) * SLOT, Kg + (size_t)jn * 4096, Vg + (size_t)jn * 4096, wave, lane); }
        LAS unsigned char* slot = ring + (jb & 3) * SLOT;
        const int kb = jb * 64;
        const bool rfa = row_flag<FM>(Ta, jb), rfb = row_flag<FM>(Tb, jb);
        const bool na = __ballot(rfa && Ta.kmax >= kb && Ta.kmin <= kb + 63) != 0ull, nb2 = __ballot(rfb && Tb.kmax >= kb && Tb.kmin <= kb + 63) != 0ull;
        const bool masked = !((!na || (kb >= amin && kb + 63 <= amax)) && (!nb2 || (kb >= bmin && kb + 63 <= bmax)));
        if (FM == 1) {
            if (na) do_blk<MODE, true, false>(Ta, Tb, rfa, rfb, masked, slot, kb, impbase, lc);
            if (nb2) do_blk<MODE, false, true>(Ta, Tb, rfa, rfb, masked, slot, kb, impbase, lc);
        } else {
            if (na || nb2) do_blk<MODE, true, true>(Ta, Tb, rfa, rfb, masked, slot, kb, impbase, lc);
        }
    }
    asm volatile("s_waitcnt vmcnt(0) lgkmcnt(0)\n\ts_barrier" ::: "memory");
}
template <int MODE, int FM>
__device__ __forceinline__ void flash_loop2(LAS unsigned char* ring, const bf16_t* Kg, const bf16_t* Vg, int nblk, Task& Ta, Task& Tb, LAS float* impbase, int wave, int lane) {
    const int i16 = lane & 15, fq = lane >> 4;
    const int kx = (i16 >> 1) & 7;
    const int q4 = i16 >> 2, p4 = lane & 3;
    LaneC lc; lc.fq = fq; lc.koff0 = i16 * 128 + ((fq ^ kx) << 4); lc.koff1 = i16 * 128 + (((4 + fq) ^ kx) << 4);
    lc.voffA = 8192 + (4 * fq + q4) * 64 + ((0 ^ (fq & 1)) << 5) + 8 * p4; lc.voffB = 8192 + (4 * fq + q4) * 64 + ((1 ^ (fq & 1)) << 5) + 8 * p4;
    const int amin = __builtin_amdgcn_readlane(Ta.kmin, 15), amax = __builtin_amdgcn_readlane(Ta.kmax, 0), bmin = __builtin_amdgcn_readlane(Tb.kmin, 15), bmax = __builtin_amdgcn_readlane(Tb.kmax, 0);
    const int nit = (nblk + 1) >> 1;
#pragma unroll
    for (int j = 0; j < 2; ++j) { const int jj = j < nblk ? j : nblk - 1; dma_block(ring + j * SLOT, Kg + (size_t)jj * 4096, Vg + (size_t)jj * 4096, wave, lane); }
    for (int i = 0; i < nit; ++i) {
        asm volatile("s_waitcnt vmcnt(0) lgkmcnt(0)\n\ts_barrier" ::: "memory");
#pragma unroll
        for (int j = 0; j < 2; ++j) { const int jn = 2 * i + 2 + j < nblk ? 2 * i + 2 + j : nblk - 1; dma_block(ring + ((2 * i + 2 + j) & 3) * SLOT, Kg + (size_t)jn * 4096, Vg + (size_t)jn * 4096, wave, lane); }
        if (FM == 1 && !SEL_FUSED) {
#pragma unroll
        for (int k = 0; k < 2; ++k) {
            const int jb = 2 * i + k;
            if (jb < nblk) {
                LAS unsigned char* slot = ring + (jb & 3) * SLOT;
                const int kb = jb * 64;
                const bool rfa = row_flag<FM>(Ta, jb), rfb = row_flag<FM>(Tb, jb);
                const bool na = __ballot(rfa && Ta.kmax >= kb && Ta.kmin <= kb + 63) != 0ull, nb2 = __ballot(rfb && Tb.kmax >= kb && Tb.kmin <= kb + 63) != 0ull;
                const bool masked = !((!na || (kb >= amin && kb + 63 <= amax)) && (!nb2 || (kb >= bmin && kb + 63 <= bmax)));
                if (na) do_blk<MODE, true, false>(Ta, Tb, rfa, rfb, masked, slot, kb, impbase, lc);
                if (nb2) do_blk<MODE, false, true>(Ta, Tb, rfa, rfb, masked, slot, kb, impbase, lc);
            }
        }
        } else {
            const int j0 = 2 * i, j1 = 2 * i + 1;
            const bool ra0 = row_flag<FM>(Ta, j0), rb0 = row_flag<FM>(Tb, j0), ra1 = j1 < nblk && row_flag<FM>(Ta, j1), rb1 = j1 < nblk && row_flag<FM>(Tb, j1);
            if (__ballot(ra0 || rb0 || ra1 || rb1) != 0ull) {
                const int k0 = j0 * 64, k1 = j1 * 64;
                const bool mk = (FM == 0) && !(k0 >= amin && k1 + 63 <= amax && k0 >= bmin && k1 + 63 <= bmax);
                if (!mk) {
                    do_blk<MODE, true, true>(Ta, Tb, ra0, rb0, false, ring + (j0 & 3) * SLOT, k0, impbase, lc);
                    if (FM == 0) __builtin_amdgcn_sched_barrier(0);
                    do_blk<MODE, true, true>(Ta, Tb, ra1, rb1, false, ring + (j1 & 3) * SLOT, k1, impbase, lc);
                } else {
                    do_blk<MODE, true, true>(Ta, Tb, ra0, rb0, true, ring + (j0 & 3) * SLOT, k0, impbase, lc);
                    __builtin_amdgcn_sched_barrier(0);
                    do_blk<MODE, true, true>(Ta, Tb, ra1, rb1, true, ring + (j1 & 3) * SLOT, k1, impbase, lc);
                }
            }
        }
    }
    asm volatile("s_waitcnt vmcnt(0) lgkmcnt(0)\n\ts_barrier" ::: "memory");
}
__device__ __forceinline__ void task_reset(Task& t) { t.m = NEGBIG; t.l = 0.f; t.cinit = 0.f; t.L = (f32x4){0.f, 0.f, 0.f, 0.f};
#pragma unroll
    for (int dt = 0; dt < 4; ++dt) t.O[dt] = (f32x4){0.f, 0.f, 0.f, 0.f}; }
__device__ __forceinline__ float task_rowsum(const Task& t) { return t.L[0]; }
__device__ __forceinline__ float task_rowsum_stats(const Task& t) { return xrow16_sum(t.l); }
constexpr float REF_DELTA = 32.f;
__device__ __forceinline__ void task_fix_ref(Task& t) {
    t.cinit = -(t.m + REF_DELTA);
    const float sc = __builtin_amdgcn_exp2f(-REF_DELTA);
    t.L = t.L * sc;
#pragma unroll
    for (int dt = 0; dt < 4; ++dt) t.O[dt] = t.O[dt] * sc;
}
}

struct NsaRow { int RI, c, b; u32x2 out[4];
    __device__ __forceinline__ int tokl() const { return RI >> 2; }
    __device__ __forceinline__ int head() const { return RI & 3; }
    __device__ __forceinline__ int tt() const { return 64 * c + (RI >> 2); }
    __device__ __forceinline__ size_t grow() const { return (size_t)(b * SEQ + 64 * c + (RI >> 2)); }
};
__device__ __forceinline__ void nsa_row_init(NsaRow& r, fa::Task& t, const bf16_t* Q, int b, int g, int c, int R, int fq) {
    r.RI = R; r.c = c; r.b = b;
    const bf16_t* qp = Q + r.grow() * DM + (g * 4 + r.head()) * DH + 8 * fq;
    t.q[0] = *(const bf16x8*)qp; t.q[1] = *(const bf16x8*)(qp + 32);
    t.imptok = r.tokl() | (r.head() == 0 ? 0x10000 : 0); t.fw0 = 0u; t.fwp = nullptr;
#pragma unroll
    for (int dt = 0; dt < 4; ++dt) r.out[dt] = (u32x2){0u, 0u};
}
__device__ __forceinline__ void nsa_cmp_setup(const NsaRow& r, fa::Task& t) {
    const int tt_ = r.tt(); const int nv = tt_ >= 31 ? (((tt_ - 31) >> 4) + 1 > 511 ? 511 : ((tt_ - 31) >> 4) + 1) : 0;
    t.kmin = 0; t.kmax = nv - 1; fa::task_reset(t);
}
__device__ __forceinline__ void nsa_accum(NsaRow& r, const fa::Task& t, float sc) {
#pragma unroll
    for (int dt = 0; dt < 4; ++dt) { const f32x4 o = t.O[dt] * sc; const u32x2 w = r.out[dt];
        r.out[dt] = (u32x2){pk2(bflo(w.x) + o[0], bfhi(w.x) + o[1]), pk2(bflo(w.y) + o[2], bfhi(w.y) + o[3])}; }
}
__device__ __forceinline__ void nsa_store(const NsaRow& r, bf16_t* AO, int g, int fq) {
    bf16_t* op = AO + r.grow() * DM + (g * 4 + r.head()) * DH + 4 * fq;
#pragma unroll
    for (int dt = 0; dt < 4; ++dt) *(u32x2*)(op + 16 * dt) = r.out[dt];
}
__device__ __forceinline__ void ph_nsa_fa(const Ctx& C) {
    LAS unsigned char* L = (LAS unsigned char*)C.lds;
    LAS unsigned char* ring = L;
    LAS float* imp = (LAS float*)(L + 65536);
    LAS unsigned* selm = (LAS unsigned*)(L + 135168);
    const bf16_t* Q = (const bf16_t*)(C.ws + WS_Q); const bf16_t* KC = (const bf16_t*)(C.ws + WS_KC); const bf16_t* VC = (const bf16_t*)(C.ws + WS_VC);
    const bf16_t* KS = (const bf16_t*)(C.ws + WS_KV0 + 2 * KVSEG); const bf16_t* VS = (const bf16_t*)(C.ws + WS_KV0 + 3 * KVSEG);
    const bf16_t* KW = (const bf16_t*)(C.ws + WS_KV0 + 4 * KVSEG); const bf16_t* VW = (const bf16_t*)(C.ws + WS_KV0 + 5 * KVSEG);
    const float* gates = (const float*)(C.ws + WS_GATES); bf16_t* AO = (bf16_t*)(C.ws + WS_XB);
    const int wave = C.wave;
    for (int u = C.bid; u < NB * NG * (SEQ / 64); u += C.nb) {
        int lane = C.lane; asm volatile("" : "+v"(lane));
        const int i16 = lane & 15, fq = lane >> 4;
        const int rnd = u / C.nb, idx = (u % C.nb) >> 4, bg = u & 15, b = bg >> 2, g = bg & 3;
        const int c = (C.nb == 256) ? 127 - 16 * rnd - ((rnd & 1) ? 15 - idx : idx) : 127 - (u >> 4);
        fa::Task T0, T1; NsaRow R0, R1;
        nsa_row_init(R0, T0, Q, b, g, c, 32 * wave + i16, fq);
        nsa_row_init(R1, T1, Q, b, g, c, 32 * wave + 16 + i16, fq);
        for (int i = C.tid; i < 2 * 64 * 130; i += NTHREADS) imp[i] = 0.f;
        if (C.tid < 256) selm[C.tid] = 0u;
        const int nvm = ((64 * c + 63 - 31) >> 4) + 1;
        const int nvmax = nvm > 511 ? 511 : nvm;
        const int nblkc = (nvmax + 63) >> 6;
        nsa_cmp_setup(R0, T0); nsa_cmp_setup(R1, T1);
        fa::flash_loop<1, 0>(ring, KC + (size_t)bg * 512 * DH, VC + (size_t)bg * 512 * DH, nblkc, T0, T1, imp, wave, lane);
        { const float l0 = fa::task_rowsum_stats(T0), l1 = fa::task_rowsum_stats(T1);
          T0.cinit = l0 > 0.f ? -T0.m - __builtin_amdgcn_logf(l0) : -__builtin_inff(); T1.cinit = l1 > 0.f ? -T1.m - __builtin_amdgcn_logf(l1) : -__builtin_inff(); }
        fa::flash_loop<2, 0>(ring, KC + (size_t)bg * 512 * DH, VC + (size_t)bg * 512 * DH, nblkc, T0, T1, imp, wave, lane);
        nsa_accum(R0, T0, gates[R0.grow() * 48 + g * 4 + R0.head()]);
        nsa_accum(R1, T1, gates[R1.grow() * 48 + g * 4 + R1.head()]);
        {
            const int jq = c, ncand = jq - 2 > 0 ? jq - 2 : 0, nforced = jq == 0 ? 1 : (jq == 1 ? 2 : 3), need = 16 - nforced;
#pragma unroll
            for (int g2 = 0; g2 < 2; ++g2) {
                const int tk = 8 * wave + 4 * g2 + (lane >> 4);
                unsigned key[8]; unsigned selb = 0u;
#pragma unroll
                for (int k = 0; k < 8; ++k) { const int j = i16 + 16 * k; const bool cand = j >= 1 && j <= jq - 2;
                    key[k] = cand ? ((__float_as_uint(imp[tk * 130 + j] + imp[64 * 130 + tk * 130 + j - 1]) & 0xFFFFFF80u) | (unsigned)(127 - j)) : 0u; }
                if (ncand <= need) {
#pragma unroll
                    for (int k = 0; k < 8; ++k) selb |= (key[k] != 0u) ? (1u << k) : 0u;
                } else {
                    for (int r = 0; r < need; ++r) {
                        unsigned m = max(max(max(key[0], key[1]), max(key[2], key[3])), max(max(key[4], key[5]), max(key[6], key[7])));
                        m = max(m, (unsigned)__builtin_amdgcn_mov_dpp((int)m, 0xB1, 0xf, 0xf, true));
                        m = max(m, (unsigned)__builtin_amdgcn_mov_dpp((int)m, 0x4E, 0xf, 0xf, true));
                        m = max(m, (unsigned)__builtin_amdgcn_mov_dpp((int)m, 0x141, 0xf, 0xf, true));
                        m = max(m, (unsigned)__builtin_amdgcn_mov_dpp((int)m, 0x140, 0xf, 0xf, true));
#pragma unroll
                        for (int k = 0; k < 8; ++k) { const bool hit = key[k] == m; selb |= hit ? (1u << k) : 0u; key[k] = hit ? 0u : key[k]; }
                    }
                }
#pragma unroll
                for (int k = 0; k < 8; ++k) { const int j = i16 + 16 * k; if (j == 0 || j == jq || j == jq - 1) selb |= 1u << k; }
#pragma unroll
                for (int w2 = 0; w2 < 4; ++w2) {
                    const unsigned bits = (((selb >> (2 * w2)) & 1u) << i16) | (((selb >> (2 * w2 + 1)) & 1u) << (16 + i16));
                    if (bits) __hip_atomic_fetch_or(selm + tk * 4 + w2, bits, __ATOMIC_RELAXED, __HIP_MEMORY_SCOPE_WORKGROUP);
                }
            }
        }
        asm volatile("s_waitcnt lgkmcnt(0)\n\ts_barrier" ::: "memory");
        {
            const int jlo = c - 8 > 0 ? c - 8 : 0;
            T0.kmin = 0; T0.kmax = R0.tokl(); fa::task_reset(T0); T1.kmin = 0; T1.kmax = R1.tokl(); fa::task_reset(T1);
            fa::flash_loop<0, 0>(ring, KW + ((size_t)bg * SEQ + 64 * c) * DH, VW + ((size_t)bg * SEQ + 64 * c) * DH, 1, T0, T1, imp, wave, lane);
            fa::task_fix_ref(T0); fa::task_fix_ref(T1);
            T0.kmin = R0.tt() - 511 - 64 * jlo; T0.kmax = R0.tt() - 64 * jlo; T1.kmin = R1.tt() - 511 - 64 * jlo; T1.kmax = R1.tt() - 64 * jlo;
            if (c > jlo) fa::flash_loop2<3, 0>(ring, KW + ((size_t)bg * SEQ + 64 * jlo) * DH, VW + ((size_t)bg * SEQ + 64 * jlo) * DH, c - jlo, T0, T1, imp, wave, lane);
            const float l0 = fa::task_rowsum(T0), l1 = fa::task_rowsum(T1);
            nsa_accum(R0, T0, (l0 > 0.f ? 1.0f / l0 : 0.f) * gates[R0.grow() * 48 + 32 + g * 4 + R0.head()]);
            nsa_accum(R1, T1, (l1 > 0.f ? 1.0f / l1 : 0.f) * gates[R1.grow() * 48 + 32 + g * 4 + R1.head()]);
        }
        {
            T0.fwp = selm + R0.tokl() * 4; T1.fwp = selm + R1.tokl() * 4;
            T0.kmin = 0; T0.kmax = R0.tokl(); fa::task_reset(T0); T1.kmin = 0; T1.kmax = R1.tokl(); fa::task_reset(T1);
            fa::flash_loop<0, 0>(ring, KS + ((size_t)bg * SEQ + 64 * c) * DH, VS + ((size_t)bg * SEQ + 64 * c) * DH, 1, T0, T1, imp, wave, lane);
            T0.kmax = R0.tt(); T1.kmax = R1.tt(); fa::task_fix_ref(T0); fa::task_fix_ref(T1);
            if (c > 0) fa::flash_loop2<3, 1>(ring, KS + (size_t)bg * SEQ * DH, VS + (size_t)bg * SEQ * DH, c, T0, T1, imp, wave, lane);
            const float l0 = fa::task_rowsum(T0), l1 = fa::task_rowsum(T1);
            nsa_accum(R0, T0, (l0 > 0.f ? 1.0f / l0 : 0.f) * gates[R0.grow() * 48 + 16 + g * 4 + R0.head()]);
            nsa_accum(R1, T1, (l1 > 0.f ? 1.0f / l1 : 0.f) * gates[R1.grow() * 48 + 16 + g * 4 + R1.head()]);
        }
        nsa_store(R0, AO, g, fq); nsa_store(R1, AO, g, fq);
    }
}

__device__ __forceinline__ void ph_moba_fa(const Ctx& C) {
    LAS unsigned char* L = (LAS unsigned char*)C.lds;
    LAS unsigned char* ring = L;
    LAS unsigned char* kmt = L + 65536;
    LAS float* kms = (LAS float*)(L + 65536);
    const bf16_t* Q = (const bf16_t*)(C.ws + WS_Q); const bf16_t* K1 = (const bf16_t*)(C.ws + WS_K1); const bf16_t* V1 = (const bf16_t*)(C.ws + WS_V1);
    const float* KM = (const float*)(C.ws + WS_KMEAN); bf16_t* AO = (bf16_t*)(C.ws + WS_XB);
    const int wave = C.wave;
    for (int u = C.bid; u < NB * NH * 32; u += C.nb) {
        int lane = C.lane; asm volatile("" : "+v"(lane));
        const int i16 = lane & 15, fq = lane >> 4;
        const int rnd = u / C.nb, idx = (u % C.nb) >> 6, bh = u & 63, b = bh >> 4, h = bh & 15;
        const int cb = (C.nb == 256) ? 31 - 4 * rnd - ((rnd & 1) ? 3 - idx : idx) : 31 - (u >> 6);
        if (C.tid < 256) {
            const int n = C.tid >> 3, c8 = C.tid & 7;
            const f32x4 a = *(const f32x4*)(KM + (size_t)bh * 2048 + n * 64 + 8 * c8), b2 = *(const f32x4*)(KM + (size_t)bh * 2048 + n * 64 + 8 * c8 + 4);
            u32x4 hi, lo;
            hi.x = pk2(a[0], a[1]); hi.y = pk2(a[2], a[3]); hi.z = pk2(b2[0], b2[1]); hi.w = pk2(b2[2], b2[3]);
            lo.x = pk2(a[0] - bflo(hi.x), a[1] - bfhi(hi.x)); lo.y = pk2(a[2] - bflo(hi.y), a[3] - bfhi(hi.y)); lo.z = pk2(b2[0] - bflo(hi.z), b2[1] - bfhi(hi.z)); lo.w = pk2(b2[2] - bflo(hi.w), b2[3] - bfhi(hi.w));
            const int off = n * 128 + ((c8 ^ ((n >> 1) & 7)) << 4);
            *(LAS u32x4*)(kmt + off) = hi; *(LAS u32x4*)(kmt + 4096 + off) = lo;
        }
        asm volatile("s_waitcnt vmcnt(0) lgkmcnt(0)\n\ts_barrier" ::: "memory");
        fa::Task T[2]; int tt[2];
#pragma unroll
        for (int ti = 0; ti < 2; ++ti) {
            const int R = 32 * wave + 16 * ti + i16; tt[ti] = 256 * cb + R; T[ti].imptok = 0;
            const bf16_t* qp = Q + (size_t)(b * SEQ + tt[ti]) * DM + h * DH + 8 * fq;
            T[ti].q[0] = *(const bf16x8*)qp; T[ti].q[1] = *(const bf16x8*)(qp + 32);
            T[ti].kmin = 0; T[ti].kmax = tt[ti]; fa::task_reset(T[ti]);
            const int kx = (i16 >> 1) & 7, ko0 = i16 * 128 + ((fq ^ kx) << 4), ko1 = i16 * 128 + (((4 + fq) ^ kx) << 4);
            float bv0 = -3e38f, bv1 = -3e38f, bv2 = -3e38f; int j0 = 99, j1 = 99, j2 = 99;
#define INS3(a, n) do { if ((a) > bv0 || ((a) == bv0 && (n) < j0)) { bv2 = bv1; j2 = j1; bv1 = bv0; j1 = j0; bv0 = (a); j0 = (n); } \
                else if ((a) > bv1 || ((a) == bv1 && (n) < j1)) { bv2 = bv1; j2 = j1; bv1 = (a); j1 = (n); } \
                else if ((a) > bv2 || ((a) == bv2 && (n) < j2)) { bv2 = (a); j2 = (n); } } while (0)
#pragma unroll
            for (int kt2 = 0; kt2 < 2; ++kt2) {
                const bf16x8 h0 = *(const LAS bf16x8*)(kmt + ko0 + kt2 * 2048), h1 = *(const LAS bf16x8*)(kmt + ko1 + kt2 * 2048);
                const bf16x8 l0 = *(const LAS bf16x8*)(kmt + 4096 + ko0 + kt2 * 2048), l1 = *(const LAS bf16x8*)(kmt + 4096 + ko1 + kt2 * 2048);
                f32x4 g = __builtin_amdgcn_mfma_f32_16x16x32_bf16(l0, T[ti].q[0], (f32x4){0.f, 0.f, 0.f, 0.f}, 0, 0, 0);
                g = __builtin_amdgcn_mfma_f32_16x16x32_bf16(l1, T[ti].q[1], g, 0, 0, 0);
                g = __builtin_amdgcn_mfma_f32_16x16x32_bf16(h0, T[ti].q[0], g, 0, 0, 0);
                g = __builtin_amdgcn_mfma_f32_16x16x32_bf16(h1, T[ti].q[1], g, 0, 0, 0);
#pragma unroll
                for (int r = 0; r < 4; ++r) { const int n = 16 * kt2 + 4 * fq + r; const float a = n < cb ? g[r] : -3e38f; INS3(a, n); }
            }
#pragma unroll
            for (int o = 16; o <= 32; o <<= 1) {
                const float ov0 = __shfl_xor(bv0, o), ov1 = __shfl_xor(bv1, o), ov2 = __shfl_xor(bv2, o); const int oj0 = __shfl_xor(j0, o), oj1 = __shfl_xor(j1, o), oj2 = __shfl_xor(j2, o);
                INS3(ov0, oj0); INS3(ov1, oj1); INS3(ov2, oj2);
            }
#undef INS3
            unsigned mk = 1u << cb;
            if (j0 < cb && bv0 > -1e38f) mk |= 1u << j0; if (j1 < cb && bv1 > -1e38f) mk |= 1u << j1; if (j2 < cb && bv2 > -1e38f) mk |= 1u << j2;
            T[ti].fw0 = mk;
        }
#pragma unroll
        for (int ti = 0; ti < 2; ++ti) { T[ti].kmax = tt[ti] - 256 * cb; }
        fa::flash_loop<0, 0>(ring, K1 + ((size_t)bh * SEQ + 256 * cb) * DH, V1 + ((size_t)bh * SEQ + 256 * cb) * DH, 4, T[0], T[1], kms, wave, lane);
#pragma unroll
        for (int ti = 0; ti < 2; ++ti) { T[ti].kmax = tt[ti]; fa::task_fix_ref(T[ti]); }
        if (cb > 0) fa::flash_loop2<3, 2>(ring, K1 + (size_t)bh * SEQ * DH, V1 + (size_t)bh * SEQ * DH, 4 * cb, T[0], T[1], kms, wave, lane);
#pragma unroll
        for (int ti = 0; ti < 2; ++ti) { const float l = fa::task_rowsum(T[ti]); const float sc_ = l > 0.f ? 1.0f / l : 0.f;
            bf16_t* op = AO + (size_t)(b * SEQ + tt[ti]) * DM + h * DH + 4 * fq;
#pragma unroll
            for (int dt = 0; dt < 4; ++dt) { const f32x4 o = T[ti].O[dt] * sc_; *(u32x2*)(op + 16 * dt) = (u32x2){pk2(o[0], o[1]), pk2(o[2], o[3])}; } }
    }
}

struct Route { int e0, s0, e1, s1; float w0, w1; int pad0, pad1; };
__device__ __forceinline__ void ph_ln_route(const Ctx& C, int layer) {
    const float* resid = C.in[I_X]; const bf16_t* residb = (const bf16_t*)(C.ws + WS_X2B); const bf16_t* MIX = (const bf16_t*)(C.ws + WS_MIX);
    bf16_t* X1B = (bf16_t*)(C.ws + WS_X1B); Route* RT = (Route*)(C.ws + WS_ROUTE);
    int* rowlist = (int*)(C.ws + WS_ROWLIST); unsigned* cnt = (unsigned*)(C.ws + WS_CTL) + (layer ? CW_CNT1 : CW_CNT0);
    const float* lg = C.in[I_LNG] + (size_t)(layer * 2 + 0) * DM; const float* lb = C.in[I_LNB] + (size_t)(layer * 2 + 0) * DM;
    const float* rw = C.in[I_RW]; const float* rb = C.in[I_RB];
    LAS unsigned* lcnt = (LAS unsigned*)C.lds;
    LAS float* rec = (LAS float*)(C.lds + 256);
    LAS float* lsb = (LAS float*)(C.lds + 4096 + C.wave * 512);
    const int lane = C.lane;
    LAS unsigned char* rwl = (LAS unsigned char*)(C.lds + 8192);
    for (int gi = C.tid; gi < DM * NE / 4; gi += NTHREADS) { const int c = gi >> 2, e4 = gi & 3;
        *(LAS f32x4*)(rwl + (c >> 8) * 17408 + ((c & 255) >> 2) * 272 + (c & 3) * 64 + e4 * 16) = ((const f32x4*)rw)[gi]; }
    __syncthreads();
    for (int chunk = C.bid; chunk < NTOK / 128; chunk += C.nb) {
        if (C.tid < 16) lcnt[C.tid] = 0u;
        __syncthreads();
        for (int i2 = 0; i2 < 8; ++i2) {
            const int rl0 = C.wave * 16 + i2 * 2, row0 = chunk * 128 + rl0;
            f32x4 v[2][4]; float s[2], s2[2];
#pragma unroll
            for (int r = 0; r < 2; ++r) { const f32x4* xr = (const f32x4*)(resid + (size_t)(row0 + r) * DM) + lane; const u32x2* xb = (const u32x2*)(residb + (size_t)(row0 + r) * DM) + lane;
                const u32x2* mr = (const u32x2*)(MIX + (size_t)(row0 + r) * DM) + lane; s[r] = 0.f;
#pragma unroll
                for (int j = 0; j < 4; ++j) { const u32x2 w = mr[64 * j]; f32x4 xv;
                    if (layer) { const u32x2 q = xb[64 * j]; xv = (f32x4){bflo(q.x), bfhi(q.x), bflo(q.y), bfhi(q.y)}; } else xv = xr[64 * j];
                    v[r][j] = xv * DN_ALPHA + (f32x4){bflo(w.x), bfhi(w.x), bflo(w.y), bfhi(w.y)};
                    s[r] += (v[r][j][0] + v[r][j][1]) + (v[r][j][2] + v[r][j][3]); } }
#pragma unroll
            for (int o = 1; o < 64; o <<= 1) { s[0] += __shfl_xor(s[0], o); s[1] += __shfl_xor(s[1], o); }
#pragma unroll
            for (int r = 0; r < 2; ++r) { const float mean = s[r] * (1.f / DM); s2[r] = 0.f;
#pragma unroll
                for (int j = 0; j < 4; ++j) { v[r][j] = v[r][j] - mean; s2[r] += (v[r][j][0] * v[r][j][0] + v[r][j][1] * v[r][j][1]) + (v[r][j][2] * v[r][j][2] + v[r][j][3] * v[r][j][3]); } }
#pragma unroll
            for (int o = 1; o < 64; o <<= 1) { s2[0] += __shfl_xor(s2[0], o); s2[1] += __shfl_xor(s2[1], o); }
            const float rstd0 = 1.f / sqrtf(s2[0] * (1.f / DM) + LN_EPS), rstd1 = 1.f / sqrtf(s2[1] * (1.f / DM) + LN_EPS);
            float p[32];
#pragma unroll
            for (int q = 0; q < 32; ++q) p[q] = 0.f;
#pragma unroll
            for (int j = 0; j < 4; ++j) {
                const int c0 = 4 * lane + 256 * j;
                const f32x4 gg = *(const f32x4*)(lg + c0), bb = *(const f32x4*)(lb + c0);
#pragma unroll
                for (int r = 0; r < 2; ++r) {
                    v[r][j] = v[r][j] * (r ? rstd1 : rstd0) * gg + bb;
                    *(u32x2*)(X1B + (size_t)(row0 + r) * DM + c0) = (u32x2){pk2(v[r][j][0], v[r][j][1]), pk2(v[r][j][2], v[r][j][3])}; }
#pragma unroll
                for (int q = 0; q < 4; ++q) {
                    const LAS f32x4* wr = (const LAS f32x4*)(rwl + j * 17408 + lane * 272 + q * 64);
                    const f32x4 w0 = wr[0], w1 = wr[1], w2 = wr[2], w3 = wr[3];
#pragma unroll
                    for (int r = 0; r < 2; ++r) { const float x = v[r][j][q];
                        p[16 * r + 0] += x * w0[0]; p[16 * r + 1] += x * w0[1]; p[16 * r + 2] += x * w0[2]; p[16 * r + 3] += x * w0[3];
                        p[16 * r + 4] += x * w1[0]; p[16 * r + 5] += x * w1[1]; p[16 * r + 6] += x * w1[2]; p[16 * r + 7] += x * w1[3];
                        p[16 * r + 8] += x * w2[0]; p[16 * r + 9] += x * w2[1]; p[16 * r + 10] += x * w2[2]; p[16 * r + 11] += x * w2[3];
                        p[16 * r + 12] += x * w3[0]; p[16 * r + 13] += x * w3[1]; p[16 * r + 14] += x * w3[2]; p[16 * r + 15] += x * w3[3]; }
                    if (q == 3) asm volatile("" ::: "memory");
                }
            }
#define TRED(N, M) { const bool up = (lane & (M)) != 0; _Pragma("unroll") for (int q = 0; q < (N); ++q) { const float keep = up ? p[q + (N)] : p[q], send = up ? p[q] : p[q + (N)]; p[q] = keep + __shfl_xor(send, (M)); } }
            TRED(16, 32) TRED(8, 16) TRED(4, 8) TRED(2, 4) TRED(1, 2)
#undef TRED
            p[0] += __shfl_xor(p[0], 1);
            const float sc_own = 1.0f / (1.0f + expf(-p[0]));
            if ((lane & 1) == 0) { lsb[lane >> 1] = sc_own; lsb[32 + (lane >> 1)] = sc_own + rb[(lane >> 1) & 15]; }
            WAVE_LDS_SYNC();
            float sc[16], bi[16];
            { const LAS f32x4* a4 = (const LAS f32x4*)(lsb + ((lane >> 5) << 4)); const LAS f32x4* b4 = (const LAS f32x4*)(lsb + 32 + ((lane >> 5) << 4));
#pragma unroll
              for (int q = 0; q < 4; ++q) { const f32x4 x = a4[q], y = b4[q]; sc[4 * q] = x[0]; sc[4 * q + 1] = x[1]; sc[4 * q + 2] = x[2]; sc[4 * q + 3] = x[3]; bi[4 * q] = y[0]; bi[4 * q + 1] = y[1]; bi[4 * q + 2] = y[2]; bi[4 * q + 3] = y[3]; } }
            WAVE_LDS_SYNC();
            int gsel = 0; float gbest = -3e38f;
#pragma unroll
            for (int gq = 0; gq < 4; ++gq) {
                float m1 = -3e38f, m2 = -3e38f;
#pragma unroll
                for (int q = 0; q < 4; ++q) { const float x = bi[4 * gq + q]; if (x > m1) { m2 = m1; m1 = x; } else if (x > m2) m2 = x; }
                const float gs = m1 + m2; if (gs > gbest) { gbest = gs; gsel = gq; }
            }
            int e0 = 0, e1 = 0; float b0 = -3e38f, b1 = -3e38f, w0 = 0.f, w1 = 0.f;
#pragma unroll
            for (int e = 0; e < 16; ++e) {
                if ((e >> 2) == gsel) {
                    const float x = bi[e];
                    if (x > b0) { b1 = b0; e1 = e0; w1 = w0; b0 = x; e0 = e; w0 = sc[e]; }
                    else if (x > b1) { b1 = x; e1 = e; w1 = sc[e]; }
                }
            }
            if ((lane & 31) == 0) {
                const int rl = rl0 + (lane >> 5);
                const float ws_ = w0 + w1;
                const unsigned l0 = __hip_atomic_fetch_add(lcnt + e0, 1u, __ATOMIC_RELAXED, __HIP_MEMORY_SCOPE_WORKGROUP), l1 = __hip_atomic_fetch_add(lcnt + e1, 1u, __ATOMIC_RELAXED, __HIP_MEMORY_SCOPE_WORKGROUP);
                LAS float* r = rec + rl * 6; r[0] = __int_as_float(e0); r[1] = __int_as_float(e1); r[2] = __uint_as_float(l0); r[3] = __uint_as_float(l1); r[4] = w0 / ws_; r[5] = w1 / ws_;
            }
        }
        __syncthreads();
        if (C.tid < 16) lcnt[16 + C.tid] = atomicAdd(cnt + 64 * C.tid, lcnt[C.tid]);
        __syncthreads();
        if (C.tid < 128) {
            const LAS float* r = rec + C.tid * 6; const int row = chunk * 128 + C.tid;
            const int e0 = __float_as_int(r[0]), e1 = __float_as_int(r[1]);
            const int s0 = (int)(lcnt[16 + e0] + __float_as_uint(r[2])), s1 = (int)(lcnt[16 + e1] + __float_as_uint(r[3]));
            rowlist[e0 * NTOK + s0] = row; rowlist[e1 * NTOK + s1] = row;
            Route rr; rr.e0 = e0; rr.s0 = s0; rr.e1 = e1; rr.s1 = s1; rr.w0 = r[4]; rr.w1 = r[5]; rr.pad0 = 0; rr.pad1 = 0;
            RT[row] = rr;
        }
        __syncthreads();
    }
}
__device__ __forceinline__ void ph_combine(const Ctx& C, int layer, float* outp, LAS int* sm) {
    const bf16_t* X1B = (const bf16_t*)(C.ws + WS_X1B); const bf16_t* Y2 = (const bf16_t*)(C.ws + WS_Y2); const Route* RT = (const Route*)(C.ws + WS_ROUTE);
    bf16_t* XB = (bf16_t*)(C.ws + WS_XB); bf16_t* X2B = (bf16_t*)(C.ws + WS_X2B);
    const float* lg = C.in[I_LNG] + (size_t)(layer * 2 + 1) * DM; const float* lb = C.in[I_LNB] + (size_t)(layer * 2 + 1) * DM;
    const int gw = C.bid * NWAVES + C.wave, NGW = C.nb * NWAVES, lane = C.lane;
    for (int row = gw; row < NTOK; row += NGW) {
        const Route r = RT[row];
        const bf16_t* y0 = Y2 + (size_t)(sm[16 + r.e0] + r.s0) * DM; const bf16_t* y1 = Y2 + (size_t)(sm[16 + r.e1] + r.s1) * DM;
        const u32x2* xr = (const u32x2*)(X1B + (size_t)row * DM) + lane;
        f32x4 v[4]; float s = 0.f;
#pragma unroll
        for (int j = 0; j < 4; ++j) {
            const int c0 = 4 * lane + 256 * j;
            const u32x2 a = *(const u32x2*)(y0 + c0), b = *(const u32x2*)(y1 + c0), x = xr[64 * j];
            const f32x4 ya = (f32x4){bflo(a.x), bfhi(a.x), bflo(a.y), bfhi(a.y)}, yb = (f32x4){bflo(b.x), bfhi(b.x), bflo(b.y), bfhi(b.y)}, xv = (f32x4){bflo(x.x), bfhi(x.x), bflo(x.y), bfhi(x.y)};
            v[j] = xv * DN_ALPHA + ya * r.w0 + yb * r.w1;
            s += (v[j][0] + v[j][1]) + (v[j][2] + v[j][3]);
        }
        const float mean = wave_sum(s) * (1.f / DM); float s2 = 0.f;
#pragma unroll
        for (int j = 0; j < 4; ++j) { v[j] = v[j] - mean; s2 += (v[j][0] * v[j][0] + v[j][1] * v[j][1]) + (v[j][2] * v[j][2] + v[j][3] * v[j][3]); }
        const float rstd = 1.f / sqrtf(wave_sum(s2) * (1.f / DM) + LN_EPS);
#pragma unroll
        for (int j = 0; j < 4; ++j) {
            const int c0 = 4 * lane + 256 * j;
            const f32x4 gg = *(const f32x4*)(lg + c0), bb = *(const f32x4*)(lb + c0);
            v[j] = v[j] * rstd * gg + bb;
            if (layer) *(f32x4*)(outp + (size_t)row * DM + c0) = v[j];
            else { const u32x2 w = (u32x2){pk2(v[j][0], v[j][1]), pk2(v[j][2], v[j][3])}; *(u32x2*)(XB + (size_t)row * DM + c0) = w; *(u32x2*)(X2B + (size_t)row * DM + c0) = w; }
        }
    }
}

__device__ __forceinline__ void ph_kmean(const Ctx& C) {
    const bf16_t* K1 = (const bf16_t*)(C.ws + WS_K1); float* KM = (float*)(C.ws + WS_KMEAN);
    const int gw = C.bid * NWAVES + C.wave, NGW = C.nb * NWAVES, lane = C.lane;
    for (int it = gw; it < NB * NH * 32; it += NGW) {
        const bf16_t* p = K1 + (size_t)it * 256 * DH + lane; float s = 0.f;
#pragma unroll 8
        for (int j = 0; j < 256; ++j) s += bf2f(p[j * DH]);
        KM[(size_t)it * DH + lane] = s * (1.0f / 256.0f);
    }
}
constexpr int NPHASE = 19;
__global__ void __launch_bounds__(NTHREADS, 2) fwd(Args args) {
    extern __shared__ __attribute__((aligned(16))) unsigned char lds[];
    Ctx C;
#pragma unroll
    for (int i = 0; i < 18; ++i) C.in[i] = args.in[i];
    C.out = args.out; C.ws = args.ws; C.lds = lds;
    C.tid = threadIdx.x; C.lane = C.tid & 63; C.wave = __builtin_amdgcn_readfirstlane(C.tid >> 6); C.bid = blockIdx.x; C.nb = gridDim.x;
    LAS unsigned* misc = (LAS unsigned*)(lds + LDS_BYTES - 512);
    LAS int* sm = (LAS int*)(misc + 16);
    if (C.tid < 4) misc[C.tid] = 0u;
    __syncthreads();
#if MK_SINGLE
    XcdBarrier bar = xcd_barrier_post((unsigned*)(C.ws + WS_CTL) + CW_BAR, (volatile LAS unsigned*)misc);
#define SEAM() xcd_barrier(bar)
#else
#define SEAM() do {} while (0)
#endif
    const int lo = args.ph_lo, hi = args.ph_hi;
#ifndef PH_MASK
#define PH_MASK 0xFFFFFFFFu
#endif
#define IN(k) (((PH_MASK >> (k)) & 1u) && lo <= (k) && (k) < hi)
#define BOTH(k) (IN(k) && IN((k) + 1))
    unsigned char* ws = C.ws;
    const float2* rope = (const float2*)(ws + WS_ROPE);
    LAS unsigned char* L = (LAS unsigned char*)lds;

    if (IN(0)) { ph_prologue(C); if (BOTH(0)) SEAM(); }
    if (IN(1)) {
        EpiNsaIn E{(bf16_t*)(ws + WS_Q), (bf16_t*)(ws + WS_KV0), (float*)(ws + WS_GATES), rope};
        g8::StaticOrder S; S.init(NTOK / 256, 2560 / 256, C.nb, C.bid);
        g8::gemm8<false>(L, (const bf16_t*)(ws + WS_XB), DM, (const bf16_t*)(ws + WS_WT_NSA_IN), DM, S, g8::EpiEl<EpiNsaIn>{E}, g8::GatherInfo{nullptr, sm});
        if (BOTH(1)) SEAM();
    }
    if (IN(2)) {
        EpiGelu EK{(bf16_t*)(ws + WS_H1K), (const float*)(ws + WS_BIAS1)}, EV{(bf16_t*)(ws + WS_H1V), (const float*)(ws + WS_BIAS1) + 256};
        g8::StaticOrder SK, SV; SK.init(32, 1, C.nb, C.bid); SV.init(32, 1, C.nb, (C.bid + C.nb / 2) % C.nb);
        g8::gemm8<false>(L, (const bf16_t*)(ws + WS_KV0), 1024, (const bf16_t*)(ws + WS_WT_C1K), 2048, SK, g8::EpiEl<EpiGelu>{EK}, g8::GatherInfo{nullptr, sm});
        g8::gemm8<false>(L, (const bf16_t*)(ws + WS_KV0 + KVSEG), 1024, (const bf16_t*)(ws + WS_WT_C1V), 2048, SV, g8::EpiEl<EpiGelu>{EV}, g8::GatherInfo{nullptr, sm});
        if (C.nb == 256 && !((C.bid < 32) || (C.bid >= 128 && C.bid < 160))) {
            EpiNsaIn E{(bf16_t*)(ws + WS_Q), (bf16_t*)(ws + WS_KV0), (float*)(ws + WS_GATES), rope};
            const int gidx = C.bid < 128 ? C.bid - 32 : C.bid - 64, fr = C.lane & 15, fq = C.lane >> 4;
            for (int tile = gidx * NWAVES + C.wave; tile < 2048; tile += 192 * NWAVES) {
                const int row0 = (tile >> 1) * 32, col0 = 2560 + (tile & 1) * 32;
                const bf16_t* a0 = (const bf16_t*)(ws + WS_XB) + (size_t)(row0 + fr) * DM + fq * 8; const bf16_t* a1 = a0 + (size_t)16 * DM;
                const bf16_t* b0 = (const bf16_t*)(ws + WS_WT_NSA_IN) + (size_t)(col0 + fr) * DM + fq * 8; const bf16_t* b1 = b0 + (size_t)16 * DM;
                f32x4 acc[2][2]; mma_core(a0, a1, b0, b1, DM, acc);
#pragma unroll
                for (int mi = 0; mi < 2; ++mi)
#pragma unroll
                    for (int ni = 0; ni < 2; ++ni) E(row0 + 16 * mi + fr, col0 + 16 * ni + 4 * fq, acc[mi][ni]);
            }
        } else if (C.nb != 256) {
            EpiNsaIn E{(bf16_t*)(ws + WS_Q), (bf16_t*)(ws + WS_KV0), (float*)(ws + WS_GATES), rope};
            const int fr = C.lane & 15, fq = C.lane >> 4;
            for (int tile = C.bid * NWAVES + C.wave; tile < 2048; tile += C.nb * NWAVES) {
                const int row0 = (tile >> 1) * 32, col0 = 2560 + (tile & 1) * 32;
                const bf16_t* a0 = (const bf16_t*)(ws + WS_XB) + (size_t)(row0 + fr) * DM + fq * 8; const bf16_t* a1 = a0 + (size_t)16 * DM;
                const bf16_t* b0 = (const bf16_t*)(ws + WS_WT_NSA_IN) + (size_t)(col0 + fr) * DM + fq * 8; const bf16_t* b1 = b0 + (size_t)16 * DM;
                f32x4 acc[2][2]; mma_core(a0, a1, b0, b1, DM, acc);
#pragma unroll
                for (int mi = 0; mi < 2; ++mi)
#pragma unroll
                    for (int ni = 0; ni < 2; ++ni) E(row0 + 16 * mi + fr, col0 + 16 * ni + 4 * fq, acc[mi][ni]);
            }
        }
        if (BOTH(2)) SEAM();
    }
    if (IN(3)) { ph_cmp2(C); if (BOTH(3)) SEAM(); }
    if (IN(4)) { ph_nsa_fa(C); if (BOTH(4)) SEAM(); }
    if (IN(6)) {
        EpiBf16 E{(bf16_t*)(ws + WS_MIX)};
        g8::StaticOrder S; S.init(NTOK / 256, DM / 256, C.nb, C.bid);
        g8::gemm8<false>(L, (const bf16_t*)(ws + WS_XB), DM, (const bf16_t*)(ws + WS_WT_NSA_OUT), DM, S, g8::EpiEl<EpiBf16>{E}, g8::GatherInfo{nullptr, sm});
        if (BOTH(6)) SEAM();
    }
    if (IN(7)) { ph_ln_route(C, 0); if (BOTH(7)) SEAM(); }
    if (IN(8)) {
        load_expert_map(C, CW_CNT0, sm);
        EpiSwiGLU E{(bf16_t*)(ws + WS_HBUF)};
        g8::GroupedOrder S; S.init(sm, 4, C.nb, C.bid);
        g8::gemm8<true>(L, (const bf16_t*)(ws + WS_X1B), DM, (const bf16_t*)(ws + WS_WT_GU), 1024, S, g8::EpiEl<EpiSwiGLU>{E}, g8::GatherInfo{(const int*)(ws + WS_ROWLIST), sm});
        if (BOTH(8)) SEAM();
    }
    if (IN(9)) {
        load_expert_map(C, CW_CNT0, sm);
        EpiBf16 E{(bf16_t*)(ws + WS_Y2)};
        g8::GroupedOrder S; S.init(sm, 4, C.nb, C.bid);
        g8::gemm8<false>(L, (const bf16_t*)(ws + WS_HBUF), DE, (const bf16_t*)(ws + WS_WT_DN), DE, S, g8::EpiEl<EpiBf16>{E}, g8::GatherInfo{nullptr, sm});
        if (BOTH(9)) SEAM();
    }
    if (IN(10)) {
        load_expert_map(C, CW_CNT0, sm);
        ph_combine(C, 0, (float*)(ws + WS_XR), sm);
        { float* scr = (float*)(C.lds + C.wave * 9216); const int gw = C.bid * NWAVES + C.wave, NGW = C.nb * NWAVES;
          for (int it = gw; it < MOE_W_ITEMS; it += NGW) moe_weight_item(C, 1, it, scr); }
        if (BOTH(10)) SEAM();
    }
    if (IN(11)) {
        EpiMobaIn E{(bf16_t*)(ws + WS_Q), (bf16_t*)(ws + WS_K1), (bf16_t*)(ws + WS_V1), rope};
        g8::StaticOrder S; S.init(NTOK / 256, 3072 / 256, C.nb, C.bid);
        g8::gemm8<false>(L, (const bf16_t*)(ws + WS_XB), DM, (const bf16_t*)(ws + WS_WT_MOBA_IN), DM, S, g8::EpiEl<EpiMobaIn>{E}, g8::GatherInfo{nullptr, sm});
        if (BOTH(11)) SEAM();
    }
    if (IN(12)) { ph_kmean(C); if (BOTH(12)) SEAM(); }
    if (IN(13)) { ph_moba_fa(C); if (BOTH(13)) SEAM(); }
    if (IN(14)) {
        EpiBf16 E{(bf16_t*)(ws + WS_MIX)};
        g8::StaticOrder S; S.init(NTOK / 256, DM / 256, C.nb, C.bid);
        g8::gemm8<false>(L, (const bf16_t*)(ws + WS_XB), DM, (const bf16_t*)(ws + WS_WT_MOBA_OUT), DM, S, g8::EpiEl<EpiBf16>{E}, g8::GatherInfo{nullptr, sm});
        if (BOTH(14)) SEAM();
    }
    if (IN(15)) { ph_ln_route(C, 1); if (BOTH(15)) SEAM(); }
    if (IN(16)) {
        load_expert_map(C, CW_CNT1, sm);
        EpiSwiGLU E{(bf16_t*)(ws + WS_HBUF)};
        g8::GroupedOrder S; S.init(sm, 4, C.nb, C.bid);
        g8::gemm8<true>(L, (const bf16_t*)(ws + WS_X1B), DM, (const bf16_t*)(ws + WS_WT_GU), 1024, S, g8::EpiEl<EpiSwiGLU>{E}, g8::GatherInfo{(const int*)(ws + WS_ROWLIST), sm});
        if (BOTH(16)) SEAM();
    }
    if (IN(17)) {
        load_expert_map(C, CW_CNT1, sm);
        EpiBf16 E{(bf16_t*)(ws + WS_Y2)};
        g8::GroupedOrder S; S.init(sm, 4, C.nb, C.bid);
        g8::gemm8<false>(L, (const bf16_t*)(ws + WS_HBUF), DE, (const bf16_t*)(ws + WS_WT_DN), DE, S, g8::EpiEl<EpiBf16>{E}, g8::GatherInfo{nullptr, sm});
        if (BOTH(17)) SEAM();
    }
    if (IN(18)) {
        load_expert_map(C, CW_CNT1, sm);
        ph_combine(C, 1, C.out, sm);
    }
#undef IN
#undef BOTH
}

extern "C" void kernel_launch(void* const* d_in, const int* in_sizes, int n_in, void* d_out, int out_size, void* d_ws, size_t ws_size, hipStream_t stream) {
    static int grid = 0;
    if (grid == 0) {
        if (n_in != 18 || in_sizes[0] != NTOK * DM || out_size != NTOK * DM || ws_size < WS_END) {
            fprintf(stderr, "kernel_launch: unexpected shapes (n_in %d, in0 %d, out %d, ws %zu; need ws >= %zu); nothing launched\n", n_in, n_in > 0 ? in_sizes[0] : -1, out_size, ws_size, (size_t)WS_END);
            grid = -1; return;
        }
        int dev = 0, cus = 0, per_cu = 0;
        if (hipGetDevice(&dev) != hipSuccess || hipDeviceGetAttribute(&cus, hipDeviceAttributeMultiprocessorCount, dev) != hipSuccess) { grid = -1; return; }
        if (hipFuncSetAttribute((const void*)fwd, hipFuncAttributeMaxDynamicSharedMemorySize, LDS_BYTES) != hipSuccess) { fprintf(stderr, "kernel_launch: hipFuncSetAttribute failed\n"); grid = -1; return; }
        if (hipOccupancyMaxActiveBlocksPerMultiprocessor(&per_cu, (const void*)fwd, NTHREADS, LDS_BYTES) != hipSuccess || per_cu < 1)
            fprintf(stderr, "kernel_launch: occupancy query reports %d blocks per CU\n", per_cu);
        (void)hipGetLastError();
        grid = cus;
    }
    if (grid < 0) return;
    if (hipMemsetAsync((char*)d_ws + WS_CTL, 0, CTL_BYTES, stream) != hipSuccess) { fprintf(stderr, "kernel_launch: memset failed\n"); return; }
    Args a{};
    for (int i = 0; i < 18; ++i) a.in[i] = (const float*)d_in[i];
    a.out = (float*)d_out; a.ws = (unsigned char*)d_ws;
#if defined(PROBE_PH)
    { const int lo3[3] = {0, PROBE_PH, PROBE_PH + 1}, hi3[3] = {PROBE_PH + 1, PROBE_PH + 1, NPHASE};
      for (int q = 0; q < 3; ++q) { if (lo3[q] >= hi3[q]) continue;
          if (q) (void)hipMemsetAsync((char*)d_ws + WS_CTL + CW_BAR * 4, 0, XCD_BAR_WORDS * 4, stream);
          a.ph_lo = lo3[q]; a.ph_hi = hi3[q]; hipLaunchKernelGGL(fwd, dim3(grid), dim3(NTHREADS), LDS_BYTES, stream, a); } }
#elif MK_SINGLE
    a.ph_lo = 0; a.ph_hi = NPHASE;
    hipLaunchKernelGGL(fwd, dim3(grid), dim3(NTHREADS), LDS_BYTES, stream, a);
#else
    for (int p = 0; p < NPHASE; ++p) { a.ph_lo = p; a.ph_hi = p + 1; hipLaunchKernelGGL(fwd, dim3(grid), dim3(NTHREADS), LDS_BYTES, stream, a); }
#endif
    const hipError_t le = hipPeekAtLastError();
    if (le != hipSuccess) fprintf(stderr, "kernel_launch: launch failed: %s\n", hipGetErrorName(le));
}
```

```cpp
#include <hip/hip_runtime.h>
#include <cstdio>
#include <cstdint>

#ifndef SEL_FUSED
#define SEL_FUSED 1
#endif
#ifndef MK_SINGLE
#define MK_SINGLE 1
#endif

#define LAS __attribute__((address_space(3)))
typedef unsigned short bf16_t;
typedef short bf16x8 __attribute__((ext_vector_type(8)));
typedef float f32x4 __attribute__((ext_vector_type(4)));
typedef unsigned u32x4 __attribute__((ext_vector_type(4)));
typedef unsigned u32x2 __attribute__((ext_vector_type(2)));

constexpr int NB = 4, SEQ = 8192, NTOK = NB * SEQ, DM = 1024, NH = 16, DH = 64, NG = 4;
constexpr int NSA_IN = 2608, NSA_INP = 2816;
constexpr int NE = 16, DE = 512;
constexpr float DN_ALPHA = 1.4142135623730951f;
constexpr float LN_EPS = 1e-5f;
constexpr int NWAVES = 8, NTHREADS = 512;
constexpr float QSCALE = 0.125f * 1.4426950408889634f;
constexpr int LDS_BYTES = 163840;
constexpr int ROWCAP = 2 * NTOK + NE * 256;

constexpr size_t MiB = 1u << 20;
constexpr size_t WS_CTL = 0, CTL_BYTES = 1 * MiB;
constexpr size_t WS_ROPE = 1 * MiB;
constexpr size_t WS_BIAS1 = 3 * MiB;
constexpr size_t WS_W2T = 3 * MiB + 4096;
constexpr size_t WS_KMEAN = 4 * MiB;
constexpr size_t WS_ROUTE = 5 * MiB;
constexpr size_t WS_ROWLIST = 6 * MiB;
constexpr size_t WS_SEL = 8 * MiB;
constexpr size_t WS_GATES = 10 * MiB;
constexpr size_t WS_KC = 25 * MiB, WS_VC = 26 * MiB;
constexpr size_t WS_WT_NSA_IN = 27 * MiB;
constexpr size_t WS_WT_NSA_OUT = 33 * MiB;
constexpr size_t WS_WT_C1K = 35 * MiB, WS_WT_C1V = 36 * MiB;
constexpr size_t WS_WT_MOBA_IN = 37 * MiB;
constexpr size_t WS_WT_MOBA_OUT = 43 * MiB;
constexpr size_t WS_WT_GU = 45 * MiB;
constexpr size_t WS_WT_DN = 77 * MiB;
constexpr size_t WS_XB = 93 * MiB;
constexpr size_t WS_ATTN = 161 * MiB;
constexpr size_t WS_Q = WS_ATTN;
constexpr size_t WS_KV0 = WS_ATTN + 64 * MiB;
constexpr size_t KVSEG = 16 * MiB;
constexpr size_t WS_K1 = WS_ATTN + 64 * MiB, WS_V1 = WS_ATTN + 128 * MiB;
constexpr size_t WS_X1B = 353 * MiB;
constexpr size_t WS_X2B = 417 * MiB;
constexpr size_t WS_MIX = WS_ATTN + 64 * MiB;
constexpr size_t WS_Y2 = WS_ATTN;
constexpr size_t WS_HBUF = WS_XB;
constexpr size_t WS_XR = 353 * MiB;
constexpr size_t WS_END = 481 * MiB;
static_assert((size_t)ROWCAP * 512 * 2 <= 68 * MiB && (size_t)ROWCAP * 1024 * 2 <= 192 * MiB, "overlay sizes");

constexpr int CW_TMO = 0;
constexpr int CW_CNT0 = 1024, CW_CNT1 = 2048;
constexpr int CW_BAR = 8192;

__device__ __forceinline__ unsigned f2bf(float f) { unsigned u = __float_as_uint(f); return (u + 0x7fffu + ((u >> 16) & 1u)) >> 16; }
typedef float f32x2v __attribute__((ext_vector_type(2)));
typedef __bf16 bf16x2v __attribute__((ext_vector_type(2)));
__device__ __forceinline__ unsigned pk2(float lo, float hi) { const f32x2v v = {lo, hi}; const bf16x2v b = __builtin_convertvector(v, bf16x2v); return __builtin_bit_cast(unsigned, b); }
__device__ __forceinline__ float bflo(unsigned u) { return __uint_as_float(u << 16); }
__device__ __forceinline__ float bfhi(unsigned u) { return __uint_as_float(u & 0xffff0000u); }
__device__ __forceinline__ float bf2f(bf16_t b) { return __uint_as_float((unsigned)b << 16); }
__device__ __forceinline__ float wave_sum(float v) {
#pragma unroll
    for (int o = 1; o < 64; o <<= 1) v += __shfl_xor(v, o);
    return v;
}
__device__ __forceinline__ float wave_max(float v) {
#pragma unroll
    for (int o = 1; o < 64; o <<= 1) v = fmaxf(v, __shfl_xor(v, o));
    return v;
}
#define WAVE_LDS_SYNC() asm volatile("s_waitcnt lgkmcnt(0)" ::: "memory")
__device__ __forceinline__ float sigmoidf_(float x) { return 1.0f / (1.0f + __expf(-x)); }
__device__ __forceinline__ float gelu_tanh(float x) {
    const float u = 0.7978845608028654f * (x + 0.044715f * x * x * x);
    const float t = 1.0f - 2.0f / (__expf(2.0f * u) + 1.0f);
    return 0.5f * x * (1.0f + t);
}

#define XB_TMO      128
#define XB_XCNT(j)  (256  + 64 * (j))
#define XB_XSUB(j)  (1280 + 64 * (j))
#define XB_XGEN(j)  (2304 + 64 * (j))
#define XB_TOP      3328
#define XB_TOPGEN   3392
#define XCD_BAR_WORDS 3456
#define XB_SPIN_CAP (1u << 22)
__device__ __forceinline__ unsigned xb_ld(unsigned* p)              { return __hip_atomic_load(p, __ATOMIC_RELAXED, __HIP_MEMORY_SCOPE_AGENT); }
__device__ __forceinline__ unsigned xb_add(unsigned* p, unsigned v) { return __hip_atomic_fetch_add(p, v, __ATOMIC_RELAXED, __HIP_MEMORY_SCOPE_AGENT); }
__device__ __forceinline__ unsigned xb_xcc_id() { return (unsigned)__builtin_amdgcn_s_getreg((3 << 11) | 20) & 0xFu; }
#define XB_SPIN(cond, bar) do { unsigned _sp = 0; while (cond) { __builtin_amdgcn_s_sleep(1); \
    if ((++_sp & 255u) == 0u) { if (xb_ld(&(bar)[XB_TMO])) break; if (_sp > XB_SPIN_CAP) { atomicAdd(&(bar)[XB_TMO], 1u); break; } } } } while (0)
struct XcdBarrier { unsigned* bar; unsigned x; volatile LAS unsigned* st; };
__device__ __forceinline__ XcdBarrier xcd_barrier_post(unsigned* bar, volatile LAS unsigned* st) {
    XcdBarrier b; b.bar = bar; b.x = xb_xcc_id(); b.st = st;
    if (threadIdx.x == 0) (void)xb_add(&bar[XB_XCNT(b.x)], 1u);
    return b;
}
__device__ __forceinline__ void xcd_barrier_complete(unsigned* bar, unsigned x, unsigned& nloc, unsigned& nx) {
    const unsigned G = gridDim.x * gridDim.y * gridDim.z;
    unsigned sum, cnt, mine, sp = 0u;
    for (;;) {
        sum = 0u; cnt = 0u; mine = 0u;
#pragma unroll
        for (unsigned j = 0; j < 16; ++j) { const unsigned c = xb_ld(&bar[XB_XCNT(j)]); sum += c; cnt += (c > 0u) ? 1u : 0u; mine = (j == x) ? c : mine; }
        if (sum == G) break;
        __builtin_amdgcn_s_sleep(1);
        if ((++sp & 255u) == 0u) { if (xb_ld(&bar[XB_TMO])) break; if (sp > XB_SPIN_CAP) { atomicAdd(&bar[XB_TMO], 1u); break; } }
    }
    nloc = mine > 0u ? mine : 1u; nx = cnt > 0u ? cnt : 1u;
}
__device__ __forceinline__ void xcd_barrier(const XcdBarrier& b) {
    asm volatile("s_waitcnt vmcnt(0)" ::: "memory");
    __syncthreads();
    if (threadIdx.x == 0) {
        unsigned* bar = b.bar;
        __builtin_amdgcn_s_waitcnt(0);
        unsigned nloc = b.st[0], nx = b.st[1];
        if (nloc == 0u) { xcd_barrier_complete(bar, b.x, nloc, nx); b.st[0] = nloc; b.st[1] = nx; }
        const unsigned old = xb_add(&bar[XB_XSUB(b.x)], 1u);
        const unsigned gen = old / nloc;
        if (old + 1u == (gen + 1u) * nloc) {
            __builtin_amdgcn_fence(__ATOMIC_RELEASE, "agent");
            asm volatile("s_waitcnt vmcnt(0)" ::: "memory");
            const unsigned og = xb_add(&bar[XB_TOP], 1u);
            const unsigned tg = og / nx;
            if (og + 1u == (tg + 1u) * nx) xb_add(&bar[XB_TOPGEN], 1u);
            else XB_SPIN(xb_ld(&bar[XB_TOPGEN]) == tg, bar);
            __builtin_amdgcn_fence(__ATOMIC_ACQUIRE, "agent");
            xb_add(&bar[XB_XGEN(b.x)], 1u);
            asm volatile("s_waitcnt vmcnt(0)" ::: "memory");
        } else {
            XB_SPIN(xb_ld(&bar[XB_XGEN(b.x)]) == gen, bar);
            __builtin_amdgcn_fence(__ATOMIC_ACQUIRE, "agent");
            asm volatile("s_waitcnt vmcnt(0)" ::: "memory");
        }
    }
    __syncthreads();
}

struct Args { const float* in[18]; float* out; unsigned char* ws; int ph_lo, ph_hi; };
struct Ctx {
    const float* in[18]; float* out; unsigned char* ws; unsigned char* lds;
    int tid, lane, wave, bid, nb;
};
enum { I_X = 0, I_NSA_WIN, I_NSA_WOUT, I_CK_W1, I_CK_W2, I_CV_W1, I_CV_W2, I_CK_POS, I_CV_POS, I_MOBA_WIN, I_MOBA_WOUT, I_RW, I_RB, I_WG, I_WU, I_WD, I_LNG, I_LNB };

__device__ __forceinline__ int il64(int d) { return d < 32 ? 2 * d : 2 * (d - 32) + 1; }
__device__ __forceinline__ int rowmap(int kind, int n) {
    switch (kind) {
        case 1: { const bool r = (n < 1024) || (n >= 1536 && n < 1792) || (n >= 2048 && n < 2304); return r ? (n & ~63) + il64(n & 63) : n; }
        case 2: return n < 2048 ? (n & ~63) + il64(n & 63) : n;
        case 3: return 2 * n;
        case 4: return 2 * n + 1;
        default: return n;
    }
}
__device__ __forceinline__ void transpose_item(const float* W, int ldw, int ncols, bf16_t* WT, int K, int kb, int nbk, int kind, float* scr, int lane) {
    const int k0 = 64 * kb, n0 = 32 * nbk;
    const int cq = lane & 7, nn = n0 + 4 * cq;
#pragma unroll
    for (int i = 0; i < 8; ++i) { const int kk = 8 * i + (lane >> 3);
        *(f32x4*)(scr + kk * 36 + 4 * cq) = nn < ncols ? *(const f32x4*)(W + (size_t)(k0 + kk) * ldw + nn) : (f32x4){0.f, 0.f, 0.f, 0.f}; }
    WAVE_LDS_SYNC();
    const int c = lane & 7;
#pragma unroll
    for (int j = 0; j < 4; ++j) {
        const int n = (lane >> 3) + 8 * j; const float* s = scr + (8 * c) * 36 + n;
        u32x4 o; o.x = pk2(s[0 * 36], s[1 * 36]); o.y = pk2(s[2 * 36], s[3 * 36]); o.z = pk2(s[4 * 36], s[5 * 36]); o.w = pk2(s[6 * 36], s[7 * 36]);
        *(u32x4*)(WT + (size_t)rowmap(kind, n0 + n) * K + k0 + 8 * c) = o;
    }
    WAVE_LDS_SYNC();
}
constexpr int MOE_W_ITEMS = NE * 768;
__device__ __forceinline__ void moe_weight_item(const Ctx& C, int layer, int r, float* scr) {
    const int e = r / 768; int q = r % 768;
    bf16_t* gu = (bf16_t*)(C.ws + WS_WT_GU) + (size_t)e * 1024 * 1024;
    bf16_t* dn = (bf16_t*)(C.ws + WS_WT_DN) + (size_t)e * 1024 * 512;
    const size_t eo = (size_t)(layer * NE + e);
    if (q < 256) { transpose_item(C.in[I_WG] + eo * DM * DE, DE, DE, gu, DM, q / 16, q % 16, 3, scr, C.lane); return; } q -= 256;
    if (q < 256) { transpose_item(C.in[I_WU] + eo * DM * DE, DE, DE, gu, DM, q / 16, q % 16, 4, scr, C.lane); return; } q -= 256;
    transpose_item(C.in[I_WD] + eo * DE * DM, DM, DM, dn, DE, q / 32, q % 32, 0, scr, C.lane);
}

__device__ __forceinline__ void ph_prologue(const Ctx& C) {
    float* scr = (float*)(C.lds + C.wave * 9216);
    const int gw = C.bid * NWAVES + C.wave, NGW = C.nb * NWAVES;
    constexpr int I_A = 16 * 82, I_B = 16 * 32, I_C = 32 * 8, I_D = 16 * 96, I_E = 16 * 32;
    constexpr int NIT = I_A + I_B + 2 * I_C + I_D + I_E + MOE_W_ITEMS;
    for (int it = gw; it < NIT; it += NGW) {
        int r = it;
        if (r < I_A) { transpose_item(C.in[I_NSA_WIN], NSA_IN, NSA_IN, (bf16_t*)(C.ws + WS_WT_NSA_IN), DM, r / 82, r % 82, 1, scr, C.lane); continue; } r -= I_A;
        if (r < I_B) { transpose_item(C.in[I_NSA_WOUT], DM, DM, (bf16_t*)(C.ws + WS_WT_NSA_OUT), DM, r / 32, r % 32, 0, scr, C.lane); continue; } r -= I_B;
        if (r < I_C) { transpose_item(C.in[I_CK_W1], 256, 256, (bf16_t*)(C.ws + WS_WT_C1K), 2048, r / 8, r % 8, 0, scr, C.lane); continue; } r -= I_C;
        if (r < I_C) { transpose_item(C.in[I_CV_W1], 256, 256, (bf16_t*)(C.ws + WS_WT_C1V), 2048, r / 8, r % 8, 0, scr, C.lane); continue; } r -= I_C;
        if (r < I_D) { transpose_item(C.in[I_MOBA_WIN], 3072, 3072, (bf16_t*)(C.ws + WS_WT_MOBA_IN), DM, r / 96, r % 96, 2, scr, C.lane); continue; } r -= I_D;
        if (r < I_E) { transpose_item(C.in[I_MOBA_WOUT], DM, DM, (bf16_t*)(C.ws + WS_WT_MOBA_OUT), DM, r / 32, r % 32, 0, scr, C.lane); continue; } r -= I_E;
        moe_weight_item(C, 0, r, scr);
    }
    const int gt = C.bid * NTHREADS + C.tid, NGT = C.nb * NTHREADS;
    { u32x4* p = (u32x4*)((bf16_t*)(C.ws + WS_WT_NSA_IN) + (size_t)2624 * DM); const int n = (NSA_INP - 2624) * DM / 8;
      for (int i = gt; i < n; i += NGT) p[i] = (u32x4){0u, 0u, 0u, 0u}; }
    { const f32x4* x4 = (const f32x4*)C.in[I_X]; u32x4* o = (u32x4*)(C.ws + WS_XB); const int n = NTOK * DM / 8;
      for (int i = gt; i < n; i += NGT) { const f32x4 a = x4[2 * i], b = x4[2 * i + 1]; o[i] = (u32x4){pk2(a.x, a.y), pk2(a.z, a.w), pk2(b.x, b.y), pk2(b.z, b.w)}; } }
    { const float INV[32] = {1.000000000e+00f, 7.498942018e-01f, 5.623413324e-01f, 4.216965139e-01f, 3.162277639e-01f, 2.371373922e-01f, 1.778279394e-01f, 1.333521456e-01f,
                             1.000000015e-01f, 7.498941571e-02f, 5.623412877e-02f, 4.216964915e-02f, 3.162277862e-02f, 2.371373586e-02f, 1.778279431e-02f, 1.333521493e-02f,
                             9.999999776e-03f, 7.498942316e-03f, 5.623413250e-03f, 4.216964822e-03f, 3.162277862e-03f, 2.371373819e-03f, 1.778279431e-03f, 1.333521446e-03f,
                             1.000000047e-03f, 7.498941850e-04f, 5.623413017e-04f, 4.216965463e-04f, 3.162277862e-04f, 2.371373848e-04f, 1.778279402e-04f, 1.333521504e-04f};
      float2* tab = (float2*)(C.ws + WS_ROPE);
      for (int i = gt; i < SEQ * 32; i += NGT) {
          const int t = i >> 5, f = i & 31;
          float inv = INV[0];
#pragma unroll
          for (int q = 1; q < 32; ++q) inv = (f == q) ? INV[q] : inv;
          const float ang = (float)t * inv;
          const double a = (double)ang; const double k = __builtin_rint(a * 0.15915494309189535); const float rf = (float)(a - k * 6.283185307179586);
          tab[i] = make_float2(__cosf(rf), __sinf(rf));
      } }
    for (int i = gt; i < 2 * 64 * 256; i += NGT) { const int which = i >> 14, d = (i >> 8) & 63, c = i & 255;
        ((bf16_t*)(C.ws + WS_W2T))[i] = (bf16_t)f2bf(C.in[which ? I_CV_W2 : I_CK_W2][c * 64 + d]); }
    for (int o = gw; o < 512; o += NGW) {
        const int which = o >> 8, c = o & 255;
        const float* pos = C.in[which ? I_CV_POS : I_CK_POS]; const float* w1 = C.in[which ? I_CV_W1 : I_CK_W1];
        float s = 0.f;
        for (int k = C.lane; k < 2048; k += 64) s += pos[k] * w1[(size_t)k * 256 + c];
        s = wave_sum(s);
        if (C.lane == 0) ((float*)(C.ws + WS_BIAS1))[o] = s;
    }
}

__device__ __forceinline__ void mma_core(const bf16_t* a0, const bf16_t* a1, const bf16_t* b0, const bf16_t* b1, int K, f32x4 (&acc)[2][2]) {
#pragma unroll
    for (int i = 0; i < 2; ++i)
#pragma unroll
        for (int j = 0; j < 2; ++j) acc[i][j] = (f32x4){0.f, 0.f, 0.f, 0.f};
#pragma unroll 4
    for (int k = 0; k < K; k += 32) {
        const bf16x8 A0 = *(const bf16x8*)(a0 + k), A1 = *(const bf16x8*)(a1 + k), B0 = *(const bf16x8*)(b0 + k), B1 = *(const bf16x8*)(b1 + k);
        acc[0][0] = __builtin_amdgcn_mfma_f32_16x16x32_bf16(B0, A0, acc[0][0], 0, 0, 0);
        acc[0][1] = __builtin_amdgcn_mfma_f32_16x16x32_bf16(B1, A0, acc[0][1], 0, 0, 0);
        acc[1][0] = __builtin_amdgcn_mfma_f32_16x16x32_bf16(B0, A1, acc[1][0], 0, 0, 0);
        acc[1][1] = __builtin_amdgcn_mfma_f32_16x16x32_bf16(B1, A1, acc[1][1], 0, 0, 0);
    }
}
namespace g8 {
constexpr int BM = 256, BK = 64, HALF = 128, HTB = HALF * BK * 2, STAGE_BYTES = 8 * HTB, NXCD = 8, WGM = 8;
__device__ __forceinline__ int lds_byte(int r, int c) { const int st = (r >> 4) * 2 + (c >> 5), rr = r & 15, cc = c & 31, ob = rr * 64 + cc * 2; return st * 1024 + (ob ^ (((ob >> 9) & 1) << 5)); }
__device__ __forceinline__ void stage_rc(int b, int& R, int& C) { const int st = b / 1024, sb = b % 1024, swz = sb ^ (((sb >> 9) & 1) << 5); R = (st >> 1) * 16 + swz / 64; C = (st & 1) * 32 + (swz % 64) / 2; }
struct Unit { int pm, pn, bt, e; };
struct StaticOrder {
    int nM, nN, nwg, G, c;
    __device__ void init(int nM_, int nN_, int G_, int c_) { nM = nM_; nN = nN_; nwg = nM * nN; G = G_; c = c_; }
    __device__ bool next(int i, Unit& u) const {
        const long L = (long)i * G + c; if (L >= nwg) return false;
        int wgid = (int)L; { const int q = nwg / NXCD, r = nwg % NXCD, xcd = wgid % NXCD, off = wgid / NXCD; wgid = (xcd < r ? xcd * (q + 1) : r * (q + 1) + (xcd - r) * q) + off; }
        const int nig = WGM * nN, gid = wgid / nig, fm = gid * WGM, gsz = (nM - fm) < WGM ? (nM - fm) : WGM;
        u.pm = fm + ((wgid % nig) % gsz); u.pn = (wgid % nig) / gsz; u.bt = u.pn; u.e = 0; return true;
    }
};
struct GroupedOrder {
    StaticOrder so; const LAS int* sm;
    __device__ void init(const LAS int* sm_, int nN_, int G_, int c_) { sm = sm_; so.init(sm_[32] / BM, nN_, G_, c_); }
    __device__ bool next(int i, Unit& u) const {
        if (!so.next(i, u)) return false;
        const int rowt = u.pm * BM; int e = 0;
#pragma unroll
        for (int q = 1; q < NE; ++q) e = (rowt >= sm[16 + q]) ? q : e;
        u.e = e; u.bt = e * so.nN + u.pn; return true;
    }
};
struct GatherInfo { const int* rowlist; const LAS int* sm; };

__device__ __forceinline__ int perm32(int rho) { const int n = rho >> 4, i = rho & 15; return 8 * (i >> 2) + 4 * n + (i & 3); }
template <bool GATHER, class Epi, class Sched>
__device__ __forceinline__ void gemm8(LAS unsigned char* lds, const bf16_t* A, int lda, const bf16_t* Bt, int K, const Sched& S, const Epi& E, GatherInfo gi) {
    const int tid = threadIdx.x, wid = __builtin_amdgcn_readfirstlane(tid >> 6), lane = tid & 63, wr = wid >> 2, wc = wid & 3, fr = lane & 15, fq = lane >> 4;
    const int nt = K / BK;
    int Rr[2], Cc[2]; unsigned voffB[2]; unsigned vAc[2][2], vAn[2][2];
#pragma unroll
    for (int i = 0; i < 2; ++i) { stage_rc(tid * 16 + i * 8192, Rr[i], Cc[i]); voffB[i] = (unsigned)(((Rr[i] & ~31) + perm32(Rr[i] & 31)) * K + Cc[i]) * 2u;
#pragma unroll
        for (int h = 0; h < 2; ++h) { vAc[h][i] = (unsigned)((Rr[i] + HALF * h) * lda + Cc[i]) * 2u; vAn[h][i] = vAc[h][i]; } }
    const size_t kstep = (size_t)(BK * 2);
    const size_t hstepB = (size_t)HALF * K * 2, tstepB = 2 * hstepB, tstepA = (size_t)BM * lda * 2;
    const unsigned ldsw = (unsigned)wid * 1024u;
    const int aoff = lds_byte(wr * 64 + fr, fq * 8), boff = lds_byte(wc * 32 + fr, fq * 8);
#define G8_SA(b, h) (((b) * 2 + (h)) * HTB)
#define G8_SB(b, h) ((4 + (b) * 2 + (h)) * HTB)
#define G8_STAGEB(bufoff, gbase) do { _Pragma("unroll") for (int _i = 0; _i < 2; ++_i) \
        __builtin_amdgcn_global_load_lds((const unsigned*)((const char*)(gbase) + voffB[_i]), (LAS unsigned*)(lds + (bufoff) + ldsw + _i * 8192), 16, 0, 0); } while (0)
#define G8_STAGEA(bufoff, gbase, v0, v1) do { \
        __builtin_amdgcn_global_load_lds((const unsigned*)((const char*)(gbase) + (v0)), (LAS unsigned*)(lds + (bufoff) + ldsw), 16, 0, 0); \
        __builtin_amdgcn_global_load_lds((const unsigned*)((const char*)(gbase) + (v1)), (LAS unsigned*)(lds + (bufoff) + ldsw + 8192), 16, 0, 0); } while (0)
#define G8_LDA(dst, b, h) do { _Pragma("unroll") for (int m = 0; m < 4; ++m) _Pragma("unroll") for (int k = 0; k < 2; ++k) dst[m][k] = *(const LAS bf16x8*)(lds + G8_SA(b, h) + aoff + m * 2048 + k * 1024); } while (0)
#define G8_LDB(dst, b, h) do { _Pragma("unroll") for (int n = 0; n < 2; ++n) _Pragma("unroll") for (int k = 0; k < 2; ++k) dst[n][k] = *(const LAS bf16x8*)(lds + G8_SB(b, h) + boff + n * 2048 + k * 1024); } while (0)
#define G8_MMA(ai, bj, At, Bt_) do { __builtin_amdgcn_s_setprio(1); _Pragma("unroll") for (int m = 0; m < 4; ++m) _Pragma("unroll") for (int n = 0; n < 2; ++n) _Pragma("unroll") for (int k = 0; k < 2; ++k) \
        acc[ai][bj][m][n] = __builtin_amdgcn_mfma_f32_16x16x32_bf16(Bt_[n][k], At[m][k], acc[ai][bj][m][n], 0, 0, 0); __builtin_amdgcn_s_setprio(0); } while (0)
#define G8_WAIT_V(n) asm volatile("s_waitcnt vmcnt(" #n ")" ::: "memory")
#define G8_WAIT_L(n) asm volatile("s_waitcnt lgkmcnt(" #n ")" ::: "memory")
#define G8_BAR __builtin_amdgcn_s_barrier()
#define G8_SCHED __builtin_amdgcn_sched_barrier(0)
#define G8_GATHER(u, v) do { if (GATHER) { const int _eb = gi.sm[16 + (u).e], _ec = gi.sm[(u).e]; \
        _Pragma("unroll") for (int _h = 0; _h < 2; ++_h) _Pragma("unroll") for (int _i = 0; _i < 2; ++_i) { const int _s = (u).pm * BM + HALF * _h + Rr[_i] - _eb; \
            const int _t = gi.rowlist[(u).e * NTOK + (_s < _ec ? _s : 0)]; v[_h][_i] = (unsigned)(_t * K + Cc[_i]) * 2u; } } } while (0)
    Unit cur, nxt; int ui = 0;
    if (!S.next(0, cur)) return;
    f32x4 acc[2][2][4][2];
#pragma unroll
    for (int a = 0; a < 2; ++a)
#pragma unroll
        for (int b = 0; b < 2; ++b)
#pragma unroll
            for (int m = 0; m < 4; ++m)
#pragma unroll
                for (int n = 0; n < 2; ++n) acc[a][b][m][n] = (f32x4){0.f, 0.f, 0.f, 0.f};
    bf16x8 At[4][2], B0[2][2], B1[2][2];
    G8_GATHER(cur, vAc);
    const char* cA = GATHER ? (const char*)A : (const char*)A + (size_t)cur.pm * tstepA; const char* cB = (const char*)Bt + (size_t)cur.bt * tstepB;
    G8_STAGEB(G8_SB(0, 0), cB); G8_STAGEB(G8_SB(0, 1), cB + hstepB); G8_STAGEA(G8_SA(0, 0), cA, vAc[0][0], vAc[0][1]); G8_STAGEA(G8_SA(0, 1), cA, vAc[1][0], vAc[1][1]);
    if (wr == 1) G8_BAR;
    G8_WAIT_V(2); G8_BAR;
    G8_STAGEB(G8_SB(1, 0), cB + kstep); G8_STAGEA(G8_SA(1, 0), cA + kstep, vAc[0][0], vAc[0][1]); G8_STAGEB(G8_SB(1, 1), cB + hstepB + kstep);
    G8_WAIT_V(6); G8_BAR;
    for (;;) {
        const bool has_next = S.next(ui + 1, nxt);
        if (has_next) G8_GATHER(nxt, vAn);
        const char* nA = has_next ? (GATHER ? (const char*)A : (const char*)A + (size_t)nxt.pm * tstepA) : cA; const char* nB = has_next ? (const char*)Bt + (size_t)nxt.bt * tstepB : cB;
        for (int t = 0; t < nt; t += 2) {
            const bool last = (t == nt - 2);
            const char* a1 = cA + (size_t)(t + 1) * kstep;
            const char* a2 = last ? nA : cA + (size_t)(t + 2) * kstep; const char* b2 = last ? nB : cB + (size_t)(t + 2) * kstep;
            const char* a3 = a2 + kstep; const char* b3 = b2 + kstep;
            const bool usen = GATHER && last && has_next;
            const unsigned w00 = usen ? vAn[0][0] : vAc[0][0], w01 = usen ? vAn[0][1] : vAc[0][1], w10 = usen ? vAn[1][0] : vAc[1][0], w11 = usen ? vAn[1][1] : vAc[1][1];
            G8_LDB(B0, 0, 0); G8_LDB(B1, 0, 1); G8_SCHED; G8_LDA(At, 0, 0); G8_STAGEA(G8_SA(1, 1), a1, vAc[1][0], vAc[1][1]);
            G8_WAIT_V(8); G8_WAIT_L(0); G8_BAR; G8_MMA(0, 0, At, B0); G8_MMA(0, 1, At, B1); G8_BAR; G8_SCHED;
            G8_LDA(At, 0, 1); G8_STAGEB(G8_SB(0, 0), b2); G8_STAGEB(G8_SB(0, 1), b2 + hstepB); G8_STAGEA(G8_SA(0, 0), a2, w00, w01);
            G8_WAIT_V(8); G8_WAIT_L(0); G8_BAR; G8_MMA(1, 0, At, B0); G8_MMA(1, 1, At, B1); G8_BAR; G8_SCHED;
            G8_LDB(B0, 1, 0); G8_LDB(B1, 1, 1); G8_SCHED; G8_LDA(At, 1, 0); G8_STAGEA(G8_SA(0, 1), a2, w10, w11);
            G8_WAIT_V(8); G8_WAIT_L(0); G8_BAR; G8_MMA(0, 0, At, B0); G8_MMA(0, 1, At, B1); G8_BAR; G8_SCHED;
            G8_LDA(At, 1, 1); G8_STAGEB(G8_SB(1, 0), b3); G8_STAGEB(G8_SB(1, 1), b3 + hstepB); G8_STAGEA(G8_SA(1, 0), a3, w00, w01);
            G8_WAIT_V(8); G8_WAIT_L(0); G8_BAR; G8_MMA(1, 0, At, B0); G8_MMA(1, 1, At, B1); G8_BAR; G8_SCHED;
        }
        if (wr == 0) G8_BAR;
        E(acc, cur, wr, wc, fr, fq);
        if (!has_next) break;
#pragma unroll
        for (int a = 0; a < 2; ++a)
#pragma unroll
            for (int b = 0; b < 2; ++b)
#pragma unroll
                for (int m = 0; m < 4; ++m)
#pragma unroll
                    for (int n = 0; n < 2; ++n) acc[a][b][m][n] = (f32x4){0.f, 0.f, 0.f, 0.f};
        cur = nxt; cA = nA; cB = nB; ++ui;
#pragma unroll
        for (int h = 0; h < 2; ++h)
#pragma unroll
            for (int i = 0; i < 2; ++i) vAc[h][i] = vAn[h][i];
        if (wr == 1) G8_BAR;
    }
    G8_WAIT_V(0);
    G8_BAR;
    if constexpr (Epi::AFTER) E.after(acc, cur, lds, wr, wc, fr, fq, wid, lane);
#undef G8_SA
#undef G8_SB
#undef G8_STAGEA
#undef G8_STAGEB
#undef G8_LDA
#undef G8_LDB
#undef G8_MMA
#undef G8_WAIT_V
#undef G8_WAIT_L
#undef G8_BAR
#undef G8_SCHED
#undef G8_GATHER
}
template <class F> struct EpiEl {
    static constexpr bool AFTER = false;
    F f;
    __device__ __forceinline__ void operator()(const f32x4 (&acc)[2][2][4][2], const Unit& u, int wr, int wc, int fr, int fq) const {
#pragma unroll
        for (int ai = 0; ai < 2; ++ai)
#pragma unroll
            for (int m = 0; m < 4; ++m) { const int row = u.pm * BM + ai * HALF + wr * 64 + m * 16 + fr;
#pragma unroll
                for (int bj = 0; bj < 2; ++bj) f(row, u.pn * BM + bj * HALF + wc * 32 + 8 * fq, acc[ai][bj][m][0], acc[ai][bj][m][1]); }
    }
};
}

struct EpiNsaIn {
    bf16_t* Q; bf16_t* KV; float* gates; const float2* rope;
    __device__ __forceinline__ void operator()(int row, int c, f32x4 v) const {
        const int t = row & (SEQ - 1), b = row >> 13;
        if (c < 1024) {
            v = v * QSCALE;
            const int d = (c & 63) >> 1; const float2 c0 = rope[t * 32 + d], c1 = rope[t * 32 + d + 1];
            bf16_t* p = Q + (size_t)row * DM + (c & ~63);
            *(unsigned*)(p + d) = pk2(v[0] * c0.x - v[1] * c0.y, v[2] * c1.x - v[3] * c1.y);
            *(unsigned*)(p + d + 32) = pk2(v[1] * c0.x + v[0] * c0.y, v[3] * c1.x + v[2] * c1.y);
        } else if (c < 2560) {
            const int s = (c - 1024) >> 8, g = ((c - 1024) >> 6) & 3;
            bf16_t* p = KV + (size_t)s * (KVSEG / 2) + ((size_t)(b * NG + g) * SEQ + t) * DH;
            if (s == 2 || s == 4) {
                const int d = (c & 63) >> 1; const float2 c0 = rope[t * 32 + d], c1 = rope[t * 32 + d + 1];
                *(unsigned*)(p + d) = pk2(v[0] * c0.x - v[1] * c0.y, v[2] * c1.x - v[3] * c1.y);
                *(unsigned*)(p + d + 32) = pk2(v[1] * c0.x + v[0] * c0.y, v[3] * c1.x + v[2] * c1.y);
            } else {
                *(u32x2*)(p + (c & 63)) = (u32x2){pk2(v[0], v[1]), pk2(v[2], v[3])};
            }
        } else if (c < NSA_IN) {
            float* gp = gates + (size_t)row * 48 + (c - 2560);
            *(f32x4*)gp = (f32x4){sigmoidf_(v[0]), sigmoidf_(v[1]), sigmoidf_(v[2]), sigmoidf_(v[3])};
        }
    }
    __device__ __forceinline__ void operator()(int row, int c, f32x4 v, f32x4 w) const {
        const int t = row & (SEQ - 1), b = row >> 13;
        const int s = (c - 1024) >> 8;
        const bool isq = c < 1024, roped = isq || s == 2 || s == 4;
        if (roped) {
            if (isq) { v = v * QSCALE; w = w * QSCALE; }
            const int g = ((c - 1024) >> 6) & 3, d = (c & 63) >> 1;
            bf16_t* p = isq ? Q + (size_t)row * DM + (c & ~63) : KV + (size_t)s * (KVSEG / 2) + ((size_t)(b * NG + g) * SEQ + t) * DH;
            const f32x4 cs01 = *(const f32x4*)(rope + t * 32 + d), cs23 = *(const f32x4*)(rope + t * 32 + d + 2);
            *(u32x2*)(p + d) = (u32x2){pk2(v[0] * cs01[0] - v[1] * cs01[1], v[2] * cs01[2] - v[3] * cs01[3]), pk2(w[0] * cs23[0] - w[1] * cs23[1], w[2] * cs23[2] - w[3] * cs23[3])};
            *(u32x2*)(p + d + 32) = (u32x2){pk2(v[1] * cs01[0] + v[0] * cs01[1], v[3] * cs01[2] + v[2] * cs01[3]), pk2(w[1] * cs23[0] + w[0] * cs23[1], w[3] * cs23[2] + w[2] * cs23[3])};
        } else {
            const int g = ((c - 1024) >> 6) & 3;
            bf16_t* p = KV + (size_t)s * (KVSEG / 2) + ((size_t)(b * NG + g) * SEQ + t) * DH + (c & 63);
            *(u32x4*)p = (u32x4){pk2(v[0], v[1]), pk2(v[2], v[3]), pk2(w[0], w[1]), pk2(w[2], w[3])};
        }
    }
};
struct EpiMobaIn {
    bf16_t* Q; bf16_t* K; bf16_t* V; const float2* rope;
    __device__ __forceinline__ void operator()(int row, int c, f32x4 v) const {
        const int t = row & (SEQ - 1), b = row >> 13;
        if (c < 2048) {
            if (c < 1024) v = v * QSCALE;
            const int d = (c & 63) >> 1; const float2 c0 = rope[t * 32 + d], c1 = rope[t * 32 + d + 1];
            bf16_t* p = c < 1024 ? Q + (size_t)row * DM + (c & ~63) : K + ((size_t)(b * NH + ((c - 1024) >> 6)) * SEQ + t) * DH;
            *(unsigned*)(p + d) = pk2(v[0] * c0.x - v[1] * c0.y, v[2] * c1.x - v[3] * c1.y);
            *(unsigned*)(p + d + 32) = pk2(v[1] * c0.x + v[0] * c0.y, v[3] * c1.x + v[2] * c1.y);
        } else {
            bf16_t* p = V + ((size_t)(b * NH + ((c - 2048) >> 6)) * SEQ + t) * DH + (c & 63);
            *(u32x2*)p = (u32x2){pk2(v[0], v[1]), pk2(v[2], v[3])};
        }
    }
    __device__ __forceinline__ void operator()(int row, int c, f32x4 v, f32x4 w) const {
        const int t = row & (SEQ - 1), b = row >> 13;
        if (c < 2048) {
            if (c < 1024) { v = v * QSCALE; w = w * QSCALE; }
            const int d = (c & 63) >> 1;
            bf16_t* p = c < 1024 ? Q + (size_t)row * DM + (c & ~63) : K + ((size_t)(b * NH + ((c - 1024) >> 6)) * SEQ + t) * DH;
            const f32x4 cs01 = *(const f32x4*)(rope + t * 32 + d), cs23 = *(const f32x4*)(rope + t * 32 + d + 2);
            *(u32x2*)(p + d) = (u32x2){pk2(v[0] * cs01[0] - v[1] * cs01[1], v[2] * cs01[2] - v[3] * cs01[3]), pk2(w[0] * cs23[0] - w[1] * cs23[1], w[2] * cs23[2] - w[3] * cs23[3])};
            *(u32x2*)(p + d + 32) = (u32x2){pk2(v[1] * cs01[0] + v[0] * cs01[1], v[3] * cs01[2] + v[2] * cs01[3]), pk2(w[1] * cs23[0] + w[0] * cs23[1], w[3] * cs23[2] + w[2] * cs23[3])};
        } else {
            bf16_t* p = V + ((size_t)(b * NH + ((c - 2048) >> 6)) * SEQ + t) * DH + (c & 63);
            *(u32x4*)p = (u32x4){pk2(v[0], v[1]), pk2(v[2], v[3]), pk2(w[0], w[1]), pk2(w[2], w[3])};
        }
    }
};
struct EpiCmp {
    static constexpr bool AFTER = true;
    const float* bias; const bf16_t* W2T; const float2* rope; bf16_t* OUT;
    __device__ __forceinline__ void operator()(const f32x4 (&)[2][2][4][2], const g8::Unit&, int, int, int, int) const {}
    __device__ __forceinline__ void after(const f32x4 (&acc)[2][2][4][2], const g8::Unit& u, LAS unsigned char* lds, int wr, int wc, int fr, int fq, int wid, int lane) const {
#pragma unroll
        for (int bj = 0; bj < 2; ++bj) {
            const int c0 = bj * 128 + wc * 32 + 8 * fq;
            const f32x4 bv = *(const f32x4*)(bias + c0), bw = *(const f32x4*)(bias + c0 + 4);
#pragma unroll
            for (int ai = 0; ai < 2; ++ai)
#pragma unroll
                for (int m = 0; m < 4; ++m) { const int row = ai * 128 + wr * 64 + m * 16 + fr; const f32x4 v = acc[ai][bj][m][0] + bv, w = acc[ai][bj][m][1] + bw;
                    *(LAS u32x4*)(lds + row * 528 + c0 * 2) = (u32x4){pk2(gelu_tanh(v[0]), gelu_tanh(v[1])), pk2(gelu_tanh(v[2]), gelu_tanh(v[3])), pk2(gelu_tanh(w[0]), gelu_tanh(w[1])), pk2(gelu_tanh(w[2]), gelu_tanh(w[3]))}; }
        }
        asm volatile("s_waitcnt lgkmcnt(0)\n\ts_barrier" ::: "memory");
        f32x4 o[2][4];
#pragma unroll
        for (int rt = 0; rt < 2; ++rt)
#pragma unroll
            for (int dt = 0; dt < 4; ++dt) o[rt][dt] = (f32x4){0.f, 0.f, 0.f, 0.f};
#pragma unroll
        for (int s8 = 0; s8 < 8; ++s8) {
            bf16x8 hb[2], wa[4];
#pragma unroll
            for (int rt = 0; rt < 2; ++rt) hb[rt] = *(const LAS bf16x8*)(lds + (32 * wid + 16 * rt + fr) * 528 + (32 * s8 + 8 * fq) * 2);
#pragma unroll
            for (int dt = 0; dt < 4; ++dt) wa[dt] = *(const bf16x8*)(W2T + (16 * dt + fr) * 256 + 32 * s8 + 8 * fq);
#pragma unroll
            for (int rt = 0; rt < 2; ++rt)
#pragma unroll
                for (int dt = 0; dt < 4; ++dt) o[rt][dt] = __builtin_amdgcn_mfma_f32_16x16x32_bf16(wa[dt], hb[rt], o[rt][dt], 0, 0, 0);
        }
#pragma unroll
        for (int rt = 0; rt < 2; ++rt) {
            const int rg = u.pm * 256 + 32 * wid + 16 * rt + fr, ci = rg & 511;
            if (rope) {
#pragma unroll
                for (int dt = 0; dt < 2; ++dt) {
                    const f32x4 cs01 = *(const f32x4*)(rope + (16 * ci + 31) * 32 + 16 * dt + 4 * fq), cs23 = *(const f32x4*)(rope + (16 * ci + 31) * 32 + 16 * dt + 4 * fq + 2);
                    const f32x4 lo = o[rt][dt], hi = o[rt][dt + 2];
                    o[rt][dt] = (f32x4){lo[0] * cs01[0] - hi[0] * cs01[1], lo[1] * cs01[2] - hi[1] * cs01[3], lo[2] * cs23[0] - hi[2] * cs23[1], lo[3] * cs23[2] - hi[3] * cs23[3]};
                    o[rt][dt + 2] = (f32x4){hi[0] * cs01[0] + lo[0] * cs01[1], hi[1] * cs01[2] + lo[1] * cs01[3], hi[2] * cs23[0] + lo[2] * cs23[1], hi[3] * cs23[2] + lo[3] * cs23[3]};
                }
            }
            const float z = ci == 511 ? 0.f : 1.f;
#pragma unroll
            for (int dt = 0; dt < 4; ++dt) { const f32x4 x = o[rt][dt] * z; *(u32x2*)(OUT + (size_t)rg * 64 + 16 * dt + 4 * fq) = (u32x2){pk2(x[0], x[1]), pk2(x[2], x[3])}; }
        }
    }
};
struct EpiSwiGLU {
    bf16_t* H;
    __device__ __forceinline__ void operator()(int row, int c, f32x4 v) const {
        const float h0 = v[0] * sigmoidf_(v[0]) * v[1], h1 = v[2] * sigmoidf_(v[2]) * v[3];
        *(unsigned*)(H + (size_t)row * DE + (c >> 1)) = pk2(h0, h1);
    }
    __device__ __forceinline__ void operator()(int row, int c, f32x4 v, f32x4 w) const {
        *(u32x2*)(H + (size_t)row * DE + (c >> 1)) = (u32x2){pk2(v[0] * sigmoidf_(v[0]) * v[1], v[2] * sigmoidf_(v[2]) * v[3]), pk2(w[0] * sigmoidf_(w[0]) * w[1], w[2] * sigmoidf_(w[2]) * w[3])};
    }
};
struct EpiBf16 {
    bf16_t* Y;
    __device__ __forceinline__ void operator()(int row, int c, f32x4 v) const { *(u32x2*)(Y + (size_t)row * DM + c) = (u32x2){pk2(v[0], v[1]), pk2(v[2], v[3])}; }
    __device__ __forceinline__ void operator()(int row, int c, f32x4 v, f32x4 w) const { *(u32x4*)(Y + (size_t)row * DM + c) = (u32x4){pk2(v[0], v[1]), pk2(v[2], v[3]), pk2(w[0], w[1]), pk2(w[2], w[3])}; }
};

struct ExpertMap { int cnt[NE]; int base[NE + 1]; };
__device__ __forceinline__ void load_expert_map(const Ctx& C, int cw, LAS int* sm  ) {
    if (C.tid == 0) {
        const unsigned* ctl = (const unsigned*)(C.ws + WS_CTL); int acc = 0;
        for (int e = 0; e < NE; ++e) { const int c = (int)__hip_atomic_load(ctl + cw + 64 * e, __ATOMIC_RELAXED, __HIP_MEMORY_SCOPE_AGENT); sm[e] = c; sm[16 + e] = acc; acc += (c + 255) & ~255; }
        sm[32] = acc;
    }
    __syncthreads();
}

__device__ __forceinline__ void load_qh(const bf16_t* qp, float (&qh)[64]) {
    const uint4* q4 = (const uint4*)qp;
#pragma unroll
    for (int c = 0; c < 8; ++c) { const uint4 w = q4[c]; qh[8 * c] = bflo(w.x); qh[8 * c + 1] = bfhi(w.x); qh[8 * c + 2] = bflo(w.y); qh[8 * c + 3] = bfhi(w.y);
        qh[8 * c + 4] = bflo(w.z); qh[8 * c + 5] = bfhi(w.z); qh[8 * c + 6] = bflo(w.w); qh[8 * c + 7] = bfhi(w.w); }
}
namespace fa {
constexpr int SLOT = 16384, NSLOT = 4;
constexpr float C2 = 0.125f * 1.4426950408889634f;
constexpr float NEGBIG = -1e30f;
typedef short v4i16 __attribute__((ext_vector_type(4)));
__device__ __forceinline__ void dma_block(LAS unsigned char* slot, const bf16_t* Kg, const bf16_t* Vg, int wave, int lane) {
    { const int key = 8 * wave + (lane >> 3), c = (lane & 7) ^ ((key >> 1) & 7);
      __builtin_amdgcn_global_load_lds((const unsigned*)(Kg + key * 64 + 8 * c), (LAS unsigned*)(slot + wave * 1024), 16, 0, 0); }
    { const int key = 16 * (wave & 3) + (lane >> 2), cp = lane & 3, d = (wave >> 2) * 32 + ((((cp >> 1) ^ ((key >> 2) & 1))) << 4) + ((cp & 1) << 3);
      __builtin_amdgcn_global_load_lds((const unsigned*)(Vg + key * 64 + d), (LAS unsigned*)(slot + 8192 + wave * 1024), 16, 0, 0); }
}
__device__ __forceinline__ unsigned cvt_pk_bf16(float lo, float hi) { const f32x2v v = {lo, hi}; const bf16x2v b = __builtin_convertvector(v, bf16x2v); return __builtin_bit_cast(unsigned, b); }
struct Task { bf16x8 q[2]; int kmin, kmax; float m, l, cinit; f32x4 O[4]; f32x4 L; unsigned fw0; const LAS unsigned* fwp; int imptok; };
template <int FM> __device__ __forceinline__ bool row_flag(const Task& t, int jb) {
    if (FM == 0) return true;
    if (FM == 1) { const unsigned w = t.fwp[jb >> 5]; return ((w >> (jb & 31)) & 1u) != 0u; }
    return ((t.fw0 >> (jb >> 2)) & 1u) != 0u;
}
struct LaneC { int fq, koff0, koff1, voffA, voffB; };
__device__ __forceinline__ LaneC lane_consts(int lane) {
    const int i16 = lane & 15, fq = lane >> 4, kx = (i16 >> 1) & 7, q4 = i16 >> 2, p4 = lane & 3;
    LaneC lc; lc.fq = fq; lc.koff0 = i16 * 128 + ((fq ^ kx) << 4); lc.koff1 = i16 * 128 + (((4 + fq) ^ kx) << 4);
    lc.voffA = 8192 + (4 * fq + q4) * 64 + ((0 ^ (fq & 1)) << 5) + 8 * p4; lc.voffB = 8192 + (4 * fq + q4) * 64 + ((1 ^ (fq & 1)) << 5) + 8 * p4;
    return lc;
}
__device__ __forceinline__ float xrow16_max(float x) {
    auto s = __builtin_amdgcn_permlane16_swap(__float_as_uint(x), __float_as_uint(x), false, false);
    x = fmaxf(__uint_as_float(s[0]), __uint_as_float(s[1]));
    auto t = __builtin_amdgcn_permlane32_swap(__float_as_uint(x), __float_as_uint(x), false, false);
    return fmaxf(__uint_as_float(t[0]), __uint_as_float(t[1]));
}
__device__ __forceinline__ float xrow16_sum(float x) {
    auto s = __builtin_amdgcn_permlane16_swap(__float_as_uint(x), __float_as_uint(x), false, false);
    x = __uint_as_float(s[0]) + __uint_as_float(s[1]);
    auto t = __builtin_amdgcn_permlane32_swap(__float_as_uint(x), __float_as_uint(x), false, false);
    return __uint_as_float(t[0]) + __uint_as_float(t[1]);
}
__device__ __forceinline__ void t_mask(const Task& t, f32x4 (&s)[4], int kb, int fq) {
#pragma unroll
    for (int kt = 0; kt < 4; ++kt)
#pragma unroll
        for (int r = 0; r < 4; ++r) { const int key = kb + 16 * kt + 4 * fq + r; s[kt][r] = (key >= t.kmin && key <= t.kmax) ? s[kt][r] : NEGBIG; }
}
template <int MODE> __device__ __forceinline__ float t_stats(Task& t, f32x4 (&s)[4], bool rf) {
    float bm = fmaxf(fmaxf(fmaxf(s[0][0], s[0][1]), fmaxf(s[0][2], s[0][3])), fmaxf(fmaxf(s[1][0], s[1][1]), fmaxf(s[1][2], s[1][3])));
    bm = fmaxf(bm, fmaxf(fmaxf(fmaxf(s[2][0], s[2][1]), fmaxf(s[2][2], s[2][3])), fmaxf(fmaxf(s[3][0], s[3][1]), fmaxf(s[3][2], s[3][3]))));
    bm = xrow16_max(bm);
    if (!rf) bm = NEGBIG;
    const float mnew = fmaxf(t.m, bm);
    const float alpha = __builtin_amdgcn_exp2f(t.m - mnew);
    t.m = mnew;
    const float msub = (rf && mnew > -1e29f) ? mnew : __builtin_inff();
#pragma unroll
    for (int kt = 0; kt < 4; ++kt) s[kt] = s[kt] - msub;
    if (MODE == 1) t.l *= alpha;
    return alpha;
}
__device__ __forceinline__ void t_exp(f32x4 (&s)[4]) {
#pragma unroll
    for (int kt = 0; kt < 4; ++kt)
#pragma unroll
        for (int r = 0; r < 4; ++r) s[kt][r] = __builtin_amdgcn_exp2f(s[kt][r]);
}
__device__ __forceinline__ float quad_sum(float x) {
    x += __builtin_bit_cast(float, __builtin_amdgcn_mov_dpp(__builtin_bit_cast(int, x), 0xB1, 0xf, 0xf, true));
    x += __builtin_bit_cast(float, __builtin_amdgcn_mov_dpp(__builtin_bit_cast(int, x), 0x4E, 0xf, 0xf, true));
    return x;
}
__device__ __forceinline__ void t_imp(const Task& t, const f32x4 (&s)[4], int kb, int fq, LAS float* impbase) {
    float ga[4], gb[4];
#pragma unroll
    for (int kt = 0; kt < 4; ++kt) { ga[kt] = quad_sum((s[kt][0] + s[kt][1]) + (s[kt][2] + s[kt][3])); gb[kt] = quad_sum(s[kt][3]); }
    if ((t.imptok & 0x10000) == 0) return;
    LAS float* ip = impbase + (t.imptok & 0xffff) * 130 + (kb >> 2) + fq;
#pragma unroll
    for (int kt = 0; kt < 4; ++kt) { ip[4 * kt] = ga[kt]; ip[64 * 130 + 4 * kt] = gb[kt]; }
}
__device__ __forceinline__ bf16x8 t_pack(const f32x4 (&s)[4], int u) {
    u32x4 pw; pw.x = cvt_pk_bf16(s[2 * u][0], s[2 * u][1]); pw.y = cvt_pk_bf16(s[2 * u][2], s[2 * u][3]); pw.z = cvt_pk_bf16(s[2 * u + 1][0], s[2 * u + 1][1]); pw.w = cvt_pk_bf16(s[2 * u + 1][2], s[2 * u + 1][3]);
    return __builtin_bit_cast(bf16x8, pw);
}
template <int MODE, bool DA, bool DB>
__device__ __forceinline__ void do_blk(Task& a, Task& b, bool rfa, bool rfb, bool masked, LAS unsigned char* slot, int kb, LAS float* impbase, const LaneC& lc) {
    f32x4 sa[4], sb[4];
    const float xa = (MODE >= 2) ? (rfa ? a.cinit : -__builtin_inff()) : 0.f, xb = (MODE >= 2) ? (rfb ? b.cinit : -__builtin_inff()) : 0.f;
    const f32x4 ca = (f32x4){xa, xa, xa, xa}, cb = (f32x4){xb, xb, xb, xb};
#pragma unroll
    for (int kt = 0; kt < 4; ++kt) {
        const bf16x8 k0 = *(const LAS bf16x8*)(slot + lc.koff0 + kt * 2048), k1 = *(const LAS bf16x8*)(slot + lc.koff1 + kt * 2048);
        if (DA) { sa[kt] = __builtin_amdgcn_mfma_f32_16x16x32_bf16(k0, a.q[0], ca, 0, 0, 0); sa[kt] = __builtin_amdgcn_mfma_f32_16x16x32_bf16(k1, a.q[1], sa[kt], 0, 0, 0); }
        if (DB) { sb[kt] = __builtin_amdgcn_mfma_f32_16x16x32_bf16(k0, b.q[0], cb, 0, 0, 0); sb[kt] = __builtin_amdgcn_mfma_f32_16x16x32_bf16(k1, b.q[1], sb[kt], 0, 0, 0); }
    }
    if (masked) { if (DA) t_mask(a, sa, kb, lc.fq); if (DB) t_mask(b, sb, kb, lc.fq); }
    if (MODE < 2) {
        float ala = 1.0f, alb = 1.0f;
        if (DA) ala = t_stats<MODE>(a, sa, rfa);
        if (DB) alb = t_stats<MODE>(b, sb, rfb);
        if (MODE == 0) {
            if (__ballot((DA && ala != 1.0f) || (DB && alb != 1.0f)) != 0ull) {
#pragma unroll
                for (int dt = 0; dt < 4; ++dt) { if (DA) a.O[dt] = a.O[dt] * ala; if (DB) b.O[dt] = b.O[dt] * alb; }
                if (DA) a.L = a.L * ala; if (DB) b.L = b.L * alb;
            }
        }
    }
    if (DA) t_exp(sa);
    if (DB) t_exp(sb);
    if (MODE == 1) {
        if (DA) a.l += ((sa[0][0] + sa[0][1]) + (sa[0][2] + sa[0][3])) + ((sa[1][0] + sa[1][1]) + (sa[1][2] + sa[1][3])) + ((sa[2][0] + sa[2][1]) + (sa[2][2] + sa[2][3])) + ((sa[3][0] + sa[3][1]) + (sa[3][2] + sa[3][3]));
        if (DB) b.l += ((sb[0][0] + sb[0][1]) + (sb[0][2] + sb[0][3])) + ((sb[1][0] + sb[1][1]) + (sb[1][2] + sb[1][3])) + ((sb[2][0] + sb[2][1]) + (sb[2][2] + sb[2][3])) + ((sb[3][0] + sb[3][1]) + (sb[3][2] + sb[3][3]));
    }
    if (MODE == 2) { if (DA) t_imp(a, sa, kb, lc.fq, impbase); if (DB) t_imp(b, sb, kb, lc.fq, impbase); }
    if (MODE != 1) {
        const bf16x8 ones = (bf16x8){0x3F80, 0x3F80, 0x3F80, 0x3F80, 0x3F80, 0x3F80, 0x3F80, 0x3F80};
#pragma unroll
        for (int u = 0; u < 2; ++u) {
            bf16x8 pa, pb; if (DA) pa = t_pack(sa, u); if (DB) pb = t_pack(sb, u);
            if (MODE != 2) { if (DA) a.L = __builtin_amdgcn_mfma_f32_16x16x32_bf16(ones, pa, a.L, 0, 0, 0); if (DB) b.L = __builtin_amdgcn_mfma_f32_16x16x32_bf16(ones, pb, b.L, 0, 0, 0); }
#pragma unroll
            for (int dt = 0; dt < 4; ++dt) {
                const int vo = ((dt & 1) ? lc.voffB : lc.voffA) + (dt >> 1) * 4096 + u * 2048;
                const v4i16 a0 = __builtin_amdgcn_ds_read_tr16_b64_v4i16((LAS v4i16*)(slot + vo)), a1 = __builtin_amdgcn_ds_read_tr16_b64_v4i16((LAS v4i16*)(slot + vo + 1024));
                const bf16x8 vf = (bf16x8){a0[0], a0[1], a0[2], a0[3], a1[0], a1[1], a1[2], a1[3]};
                if (DA) a.O[dt] = __builtin_amdgcn_mfma_f32_16x16x32_bf16(vf, pa, a.O[dt], 0, 0, 0);
                if (DB) b.O[dt] = __builtin_amdgcn_mfma_f32_16x16x32_bf16(vf, pb, b.O[dt], 0, 0, 0);
            }
        }
    }
}
template <int MODE, int FM>
__device__ __forceinline__ void flash_loop(LAS unsigned char* ring, const bf16_t* Kg, const bf16_t* Vg, int nblk, Task& Ta, Task& Tb, LAS float* impbase, int wave, int lane) {
    const int i16 = lane & 15, fq = lane >> 4;
    const int kx = (i16 >> 1) & 7;
    const int q4 = i16 >> 2, p4 = lane & 3;
    LaneC lc; lc.fq = fq; lc.koff0 = i16 * 128 + ((fq ^ kx) << 4); lc.koff1 = i16 * 128 + (((4 + fq) ^ kx) << 4);
    lc.voffA = 8192 + (4 * fq + q4) * 64 + ((0 ^ (fq & 1)) << 5) + 8 * p4; lc.voffB = 8192 + (4 * fq + q4) * 64 + ((1 ^ (fq & 1)) << 5) + 8 * p4;
    const int amin = __builtin_amdgcn_readlane(Ta.kmin, 15), amax = __builtin_amdgcn_readlane(Ta.kmax, 0), bmin = __builtin_amdgcn_readlane(Tb.kmin, 15), bmax = __builtin_amdgcn_readlane(Tb.kmax, 0);
#pragma unroll
    for (int j = 0; j < NSLOT - 1; ++j) { const int jj = j < nblk ? j : nblk - 1; dma_block(ring + j * SLOT, Kg + (size_t)jj * 4096, Vg + (size_t)jj * 4096, wave, lane); }
    for (int jb = 0; jb < nblk; ++jb) {
        asm volatile("s_waitcnt vmcnt(4) lgkmcnt(0)\n\ts_barrier" ::: "memory");
        { const int jn = jb + 3 < nblk ? jb + 3 : nblk - 1; dma_block(ring + ((jb + 3) & 3) * SLOT, Kg + (size_t)jn * 4096, Vg + (size_t)jn * 4096, wave, lane); }
        LAS unsigned char* slot = ring + (jb & 3) * SLOT;
        const int kb = jb * 64;
        const bool rfa = row_flag<FM>(Ta, jb), rfb = row_flag<FM>(Tb, jb);
        const bool na = __ballot(rfa && Ta.kmax >= kb && Ta.kmin <= kb + 63) != 0ull, nb2 = __ballot(rfb && Tb.kmax >= kb && Tb.kmin <= kb + 63) != 0ull;
        const bool masked = !((!na || (kb >= amin && kb + 63 <= amax)) && (!nb2 || (kb >= bmin && kb + 63 <= bmax)));
        if (FM == 1) {
            if (na) do_blk<MODE, true, false>(Ta, Tb, rfa, rfb, masked, slot, kb, impbase, lc);
            if (nb2) do_blk<MODE, false, true>(Ta, Tb, rfa, rfb, masked, slot, kb, impbase, lc);
        } else {
            if (na || nb2) do_blk<MODE, true, true>(Ta, Tb, rfa, rfb, masked, slot, kb, impbase, lc);
        }
    }
    asm volatile("s_waitcnt vmcnt(0) lgkmcnt(0)\n\ts_barrier" ::: "memory");
}
template <int MODE, int FM>
__device__ __forceinline__ void flash_loop2(LAS unsigned char* ring, const bf16_t* Kg, const bf16_t* Vg, int nblk, Task& Ta, Task& Tb, LAS float* impbase, int wave, int lane) {
    const int i16 = lane & 15, fq = lane >> 4;
    const int kx = (i16 >> 1) & 7;
    const int q4 = i16 >> 2, p4 = lane & 3;
    LaneC lc; lc.fq = fq; lc.koff0 = i16 * 128 + ((fq ^ kx) << 4); lc.koff1 = i16 * 128 + (((4 + fq) ^ kx) << 4);
    lc.voffA = 8192 + (4 * fq + q4) * 64 + ((0 ^ (fq & 1)) << 5) + 8 * p4; lc.voffB = 8192 + (4 * fq + q4) * 64 + ((1 ^ (fq & 1)) << 5) + 8 * p4;
    const int amin = __builtin_amdgcn_readlane(Ta.kmin, 15), amax = __builtin_amdgcn_readlane(Ta.kmax, 0), bmin = __builtin_amdgcn_readlane(Tb.kmin, 15), bmax = __builtin_amdgcn_readlane(Tb.kmax, 0);
    const int nit = (nblk + 1) >> 1;
#pragma unroll
    for (int j = 0; j < 2; ++j) { const int jj = j < nblk ? j : nblk - 1; dma_block(ring + j * SLOT, Kg + (size_t)jj * 4096, Vg + (size_t)jj * 4096, wave, lane); }
    for (int i = 0; i < nit; ++i) {
        asm volatile("s_waitcnt vmcnt(0) lgkmcnt(0)\n\ts_barrier" ::: "memory");
#pragma unroll
        for (int j = 0; j < 2; ++j) { const int jn = 2 * i + 2 + j < nblk ? 2 * i + 2 + j : nblk - 1; dma_block(ring + ((2 * i + 2 + j) & 3) * SLOT, Kg + (size_t)jn * 4096, Vg + (size_t)jn * 4096, wave, lane); }
        if (FM == 1 && !SEL_FUSED) {
#pragma unroll
        for (int k = 0; k < 2; ++k) {
            const int jb = 2 * i + k;
            if (jb < nblk) {
                LAS unsigned char* slot = ring + (jb & 3) * SLOT;
                const int kb = jb * 64;
                const bool rfa = row_flag<FM>(Ta, jb), rfb = row_flag<FM>(Tb, jb);
                const bool na = __ballot(rfa && Ta.kmax >= kb && Ta.kmin <= kb + 63) != 0ull, nb2 = __ballot(rfb && Tb.kmax >= kb && Tb.kmin <= kb + 63) != 0ull;
                const bool masked = !((!na || (kb >= amin && kb + 63 <= amax)) && (!nb2 || (kb >= bmin && kb + 63 <= bmax)));
                if (na) do_blk<MODE, true, false>(Ta, Tb, rfa, rfb, masked, slot, kb, impbase, lc);
                if (nb2) do_blk<MODE, false, true>(Ta, Tb, rfa, rfb, masked, slot, kb, impbase, lc);
            }
        }
        } else {
            const int j0 = 2 * i, j1 = 2 * i + 1;
            const bool ra0 = row_flag<FM>(Ta, j0), rb0 = row_flag<FM>(Tb, j0), ra1 = j1 < nblk && row_flag<FM>(Ta, j1), rb1 = j1 < nblk && row_flag<FM>(Tb, j1);
            if (__ballot(ra0 || rb0 || ra1 || rb1) != 0ull) {
                const int k0 = j0 * 64, k1 = j1 * 64;
                const bool mk = (FM == 0) && !(k0 >= amin && k1 + 63 <= amax && k0 >= bmin && k1 + 63 <= bmax);
                if (!mk) {
                    do_blk<MODE, true, true>(Ta, Tb, ra0, rb0, false, ring + (j0 & 3) * SLOT, k0, impbase, lc);
                    if (FM == 0) __builtin_amdgcn_sched_barrier(0);
                    do_blk<MODE, true, true>(Ta, Tb, ra1, rb1, false, ring + (j1 & 3) * SLOT, k1, impbase, lc);
                } else {
                    do_blk<MODE, true, true>(Ta, Tb, ra0, rb0, true, ring + (j0 & 3) * SLOT, k0, impbase, lc);
                    __builtin_amdgcn_sched_barrier(0);
                    do_blk<MODE, true, true>(Ta, Tb, ra1, rb1, true, ring + (j1 & 3) * SLOT, k1, impbase, lc);
                }
            }
        }
    }
    asm volatile("s_waitcnt vmcnt(0) lgkmcnt(0)\n\ts_barrier" ::: "memory");
}
__device__ __forceinline__ void task_reset(Task& t) { t.m = NEGBIG; t.l = 0.f; t.cinit = 0.f; t.L = (f32x4){0.f, 0.f, 0.f, 0.f};
#pragma unroll
    for (int dt = 0; dt < 4; ++dt) t.O[dt] = (f32x4){0.f, 0.f, 0.f, 0.f}; }
__device__ __forceinline__ float task_rowsum(const Task& t) { return t.L[0]; }
__device__ __forceinline__ float task_rowsum_stats(const Task& t) { return xrow16_sum(t.l); }
constexpr float REF_DELTA = 32.f;
__device__ __forceinline__ void task_fix_ref(Task& t) {
    t.cinit = -(t.m + REF_DELTA);
    const float sc = __builtin_amdgcn_exp2f(-REF_DELTA);
    t.L = t.L * sc;
#pragma unroll
    for (int dt = 0; dt < 4; ++dt) t.O[dt] = t.O[dt] * sc;
}
}

struct NsaRow { int RI, c, b; u32x2 out[4];
    __device__ __forceinline__ int tokl() const { return RI >> 2; }
    __device__ __forceinline__ int head() const { return RI & 3; }
    __device__ __forceinline__ int tt() const { return 64 * c + (RI >> 2); }
    __device__ __forceinline__ size_t grow() const { return (size_t)(b * SEQ + 64 * c + (RI >> 2)); }
};
__device__ __forceinline__ void nsa_row_init(NsaRow& r, fa::Task& t, const bf16_t* Q, int b, int g, int c, int R, int fq) {
    r.RI = R; r.c = c; r.b = b;
    const bf16_t* qp = Q + r.grow() * DM + (g * 4 + r.head()) * DH + 8 * fq;
    t.q[0] = *(const bf16x8*)qp; t.q[1] = *(const bf16x8*)(qp + 32);
    t.imptok = r.tokl() | (r.head() == 0 ? 0x10000 : 0); t.fw0 = 0u; t.fwp = nullptr;
#pragma unroll
    for (int dt = 0; dt < 4; ++dt) r.out[dt] = (u32x2){0u, 0u};
}
__device__ __forceinline__ void nsa_cmp_setup(const NsaRow& r, fa::Task& t) {
    const int tt_ = r.tt(); const int nv = tt_ >= 31 ? (((tt_ - 31) >> 4) + 1 > 511 ? 511 : ((tt_ - 31) >> 4) + 1) : 0;
    t.kmin = 0; t.kmax = nv - 1; fa::task_reset(t);
}
__device__ __forceinline__ void nsa_accum(NsaRow& r, const fa::Task& t, float sc) {
#pragma unroll
    for (int dt = 0; dt < 4; ++dt) { const f32x4 o = t.O[dt] * sc; const u32x2 w = r.out[dt];
        r.out[dt] = (u32x2){pk2(bflo(w.x) + o[0], bfhi(w.x) + o[1]), pk2(bflo(w.y) + o[2], bfhi(w.y) + o[3])}; }
}
__device__ __forceinline__ void nsa_store(const NsaRow& r, bf16_t* AO, int g, int fq) {
    bf16_t* op = AO + r.grow() * DM + (g * 4 + r.head()) * DH + 4 * fq;
#pragma unroll
    for (int dt = 0; dt < 4; ++dt) *(u32x2*)(op + 16 * dt) = r.out[dt];
}
__device__ __forceinline__ void ph_nsa_fa(const Ctx& C) {
    LAS unsigned char* L = (LAS unsigned char*)C.lds;
    LAS unsigned char* ring = L;
    LAS float* imp = (LAS float*)(L + 65536);
    LAS unsigned* selm = (LAS unsigned*)(L + 135168);
    const bf16_t* Q = (const bf16_t*)(C.ws + WS_Q); const bf16_t* KC = (const bf16_t*)(C.ws + WS_KC); const bf16_t* VC = (const bf16_t*)(C.ws + WS_VC);
    const bf16_t* KS = (const bf16_t*)(C.ws + WS_KV0 + 2 * KVSEG); const bf16_t* VS = (const bf16_t*)(C.ws + WS_KV0 + 3 * KVSEG);
    const bf16_t* KW = (const bf16_t*)(C.ws + WS_KV0 + 4 * KVSEG); const bf16_t* VW = (const bf16_t*)(C.ws + WS_KV0 + 5 * KVSEG);
    const float* gates = (const float*)(C.ws + WS_GATES); bf16_t* AO = (bf16_t*)(C.ws + WS_XB);
    const int wave = C.wave;
    for (int u = C.bid; u < NB * NG * (SEQ / 64); u += C.nb) {
        int lane = C.lane; asm volatile("" : "+v"(lane));
        const int i16 = lane & 15, fq = lane >> 4;
        const int rnd = u / C.nb, idx = (u % C.nb) >> 4, bg = u & 15, b = bg >> 2, g = bg & 3;
        const int c = (C.nb == 256) ? 127 - 16 * rnd - ((rnd & 1) ? 15 - idx : idx) : 127 - (u >> 4);
        fa::Task T0, T1; NsaRow R0, R1;
        nsa_row_init(R0, T0, Q, b, g, c, 32 * wave + i16, fq);
        nsa_row_init(R1, T1, Q, b, g, c, 32 * wave + 16 + i16, fq);
        for (int i = C.tid; i < 2 * 64 * 130; i += NTHREADS) imp[i] = 0.f;
        if (C.tid < 256) selm[C.tid] = 0u;
        const int nvm = ((64 * c + 63 - 31) >> 4) + 1;
        const int nvmax = nvm > 511 ? 511 : nvm;
        const int nblkc = (nvmax + 63) >> 6;
        nsa_cmp_setup(R0, T0); nsa_cmp_setup(R1, T1);
        fa::flash_loop<1, 0>(ring, KC + (size_t)bg * 512 * DH, VC + (size_t)bg * 512 * DH, nblkc, T0, T1, imp, wave, lane);
        { const float l0 = fa::task_rowsum_stats(T0), l1 = fa::task_rowsum_stats(T1);
          T0.cinit = l0 > 0.f ? -T0.m - __builtin_amdgcn_logf(l0) : -__builtin_inff(); T1.cinit = l1 > 0.f ? -T1.m - __builtin_amdgcn_logf(l1) : -__builtin_inff(); }
        fa::flash_loop<2, 0>(ring, KC + (size_t)bg * 512 * DH, VC + (size_t)bg * 512 * DH, nblkc, T0, T1, imp, wave, lane);
        nsa_accum(R0, T0, gates[R0.grow() * 48 + g * 4 + R0.head()]);
        nsa_accum(R1, T1, gates[R1.grow() * 48 + g * 4 + R1.head()]);
        {
            const int jq = c, ncand = jq - 2 > 0 ? jq - 2 : 0, nforced = jq == 0 ? 1 : (jq == 1 ? 2 : 3), need = 16 - nforced;
#pragma unroll
            for (int g2 = 0; g2 < 2; ++g2) {
                const int tk = 8 * wave + 4 * g2 + (lane >> 4);
                unsigned key[8]; unsigned selb = 0u;
#pragma unroll
                for (int k = 0; k < 8; ++k) { const int j = i16 + 16 * k; const bool cand = j >= 1 && j <= jq - 2;
                    key[k] = cand ? ((__float_as_uint(imp[tk * 130 + j] + imp[64 * 130 + tk * 130 + j - 1]) & 0xFFFFFF80u) | (unsigned)(127 - j)) : 0u; }
                if (ncand <= need) {
#pragma unroll
                    for (int k = 0; k < 8; ++k) selb |= (key[k] != 0u) ? (1u << k) : 0u;
                } else {
                    for (int r = 0; r < need; ++r) {
                        unsigned m = max(max(max(key[0], key[1]), max(key[2], key[3])), max(max(key[4], key[5]), max(key[6], key[7])));
                        m = max(m, (unsigned)__builtin_amdgcn_mov_dpp((int)m, 0xB1, 0xf, 0xf, true));
                        m = max(m, (unsigned)__builtin_amdgcn_mov_dpp((int)m, 0x4E, 0xf, 0xf, true));
                        m = max(m, (unsigned)__builtin_amdgcn_mov_dpp((int)m, 0x141, 0xf, 0xf, true));
                        m = max(m, (unsigned)__builtin_amdgcn_mov_dpp((int)m, 0x140, 0xf, 0xf, true));
#pragma unroll
                        for (int k = 0; k < 8; ++k) { const bool hit = key[k] == m; selb |= hit ? (1u << k) : 0u; key[k] = hit ? 0u : key[k]; }
                    }
                }
#pragma unroll
                for (int k = 0; k < 8; ++k) { const int j = i16 + 16 * k; if (j == 0 || j == jq || j == jq - 1) selb |= 1u << k; }
#pragma unroll
                for (int w2 = 0; w2 < 4; ++w2) {
                    const unsigned bits = (((selb >> (2 * w2)) & 1u) << i16) | (((selb >> (2 * w2 + 1)) & 1u) << (16 + i16));
                    if (bits) __hip_atomic_fetch_or(selm + tk * 4 + w2, bits, __ATOMIC_RELAXED, __HIP_MEMORY_SCOPE_WORKGROUP);
                }
            }
        }
        asm volatile("s_waitcnt lgkmcnt(0)\n\ts_barrier" ::: "memory");
        {
            const int jlo = c - 8 > 0 ? c - 8 : 0;
            T0.kmin = 0; T0.kmax = R0.tokl(); fa::task_reset(T0); T1.kmin = 0; T1.kmax = R1.tokl(); fa::task_reset(T1);
            fa::flash_loop<0, 0>(ring, KW + ((size_t)bg * SEQ + 64 * c) * DH, VW + ((size_t)bg * SEQ + 64 * c) * DH, 1, T0, T1, imp, wave, lane);
            fa::task_fix_ref(T0); fa::task_fix_ref(T1);
            T0.kmin = R0.tt() - 511 - 64 * jlo; T0.kmax = R0.tt() - 64 * jlo; T1.kmin = R1.tt() - 511 - 64 * jlo; T1.kmax = R1.tt() - 64 * jlo;
            if (c > jlo) fa::flash_loop2<3, 0>(ring, KW + ((size_t)bg * SEQ + 64 * jlo) * DH, VW + ((size_t)bg * SEQ + 64 * jlo) * DH, c - jlo, T0, T1, imp, wave, lane);
            const float l0 = fa::task_rowsum(T0), l1 = fa::task_rowsum(T1);
            nsa_accum(R0, T0, (l0 > 0.f ? 1.0f / l0 : 0.f) * gates[R0.grow() * 48 + 32 + g * 4 + R0.head()]);
            nsa_accum(R1, T1, (l1 > 0.f ? 1.0f / l1 : 0.f) * gates[R1.grow() * 48 + 32 + g * 4 + R1.head()]);
        }
        {
            T0.fwp = selm + R0.tokl() * 4; T1.fwp = selm + R1.tokl() * 4;
            T0.kmin = 0; T0.kmax = R0.tokl(); fa::task_reset(T0); T1.kmin = 0; T1.kmax = R1.tokl(); fa::task_reset(T1);
            fa::flash_loop<0, 0>(ring, KS + ((size_t)bg * SEQ + 64 * c) * DH, VS + ((size_t)bg * SEQ + 64 * c) * DH, 1, T0, T1, imp, wave, lane);
            T0.kmax = R0.tt(); T1.kmax = R1.tt(); fa::task_fix_ref(T0); fa::task_fix_ref(T1);
            if (c > 0) fa::flash_loop2<3, 1>(ring, KS + (size_t)bg * SEQ * DH, VS + (size_t)bg * SEQ * DH, c, T0, T1, imp, wave, lane);
            const float l0 = fa::task_rowsum(T0), l1 = fa::task_rowsum(T1);
            nsa_accum(R0, T0, (l0 > 0.f ? 1.0f / l0 : 0.f) * gates[R0.grow() * 48 + 16 + g * 4 + R0.head()]);
            nsa_accum(R1, T1, (l1 > 0.f ? 1.0f / l1 : 0.f) * gates[R1.grow() * 48 + 16 + g * 4 + R1.head()]);
        }
        nsa_store(R0, AO, g, fq); nsa_store(R1, AO, g, fq);
    }
}

__device__ __forceinline__ void ph_moba_fa(const Ctx& C) {
    LAS unsigned char* L = (LAS unsigned char*)C.lds;
    LAS unsigned char* ring = L;
    LAS unsigned char* kmt = L + 65536;
    LAS float* kms = (LAS float*)(L + 65536);
    const bf16_t* Q = (const bf16_t*)(C.ws + WS_Q); const bf16_t* K1 = (const bf16_t*)(C.ws + WS_K1); const bf16_t* V1 = (const bf16_t*)(C.ws + WS_V1);
    const float* KM = (const float*)(C.ws + WS_KMEAN); bf16_t* AO = (bf16_t*)(C.ws + WS_XB);
    const int wave = C.wave;
    for (int u = C.bid; u < NB * NH * 32; u += C.nb) {
        int lane = C.lane; asm volatile("" : "+v"(lane));
        const int i16 = lane & 15, fq = lane >> 4;
        const int rnd = u / C.nb, idx = (u % C.nb) >> 6, bh = u & 63, b = bh >> 4, h = bh & 15;
        const int cb = (C.nb == 256) ? 31 - 4 * rnd - ((rnd & 1) ? 3 - idx : idx) : 31 - (u >> 6);
        if (C.tid < 256) {
            const int n = C.tid >> 3, c8 = C.tid & 7;
            const f32x4 a = *(const f32x4*)(KM + (size_t)bh * 2048 + n * 64 + 8 * c8), b2 = *(const f32x4*)(KM + (size_t)bh * 2048 + n * 64 + 8 * c8 + 4);
            u32x4 hi, lo;
            hi.x = pk2(a[0], a[1]); hi.y = pk2(a[2], a[3]); hi.z = pk2(b2[0], b2[1]); hi.w = pk2(b2[2], b2[3]);
            lo.x = pk2(a[0] - bflo(hi.x), a[1] - bfhi(hi.x)); lo.y = pk2(a[2] - bflo(hi.y), a[3] - bfhi(hi.y)); lo.z = pk2(b2[0] - bflo(hi.z), b2[1] - bfhi(hi.z)); lo.w = pk2(b2[2] - bflo(hi.w), b2[3] - bfhi(hi.w));
            const int off = n * 128 + ((c8 ^ ((n >> 1) & 7)) << 4);
            *(LAS u32x4*)(kmt + off) = hi; *(LAS u32x4*)(kmt + 4096 + off) = lo;
        }
        asm volatile("s_waitcnt vmcnt(0) lgkmcnt(0)\n\ts_barrier" ::: "memory");
        fa::Task T[2]; int tt[2];
#pragma unroll
        for (int ti = 0; ti < 2; ++ti) {
            const int R = 32 * wave + 16 * ti + i16; tt[ti] = 256 * cb + R; T[ti].imptok = 0;
            const bf16_t* qp = Q + (size_t)(b * SEQ + tt[ti]) * DM + h * DH + 8 * fq;
            T[ti].q[0] = *(const bf16x8*)qp; T[ti].q[1] = *(const bf16x8*)(qp + 32);
            T[ti].kmin = 0; T[ti].kmax = tt[ti]; fa::task_reset(T[ti]);
            const int kx = (i16 >> 1) & 7, ko0 = i16 * 128 + ((fq ^ kx) << 4), ko1 = i16 * 128 + (((4 + fq) ^ kx) << 4);
            float bv0 = -3e38f, bv1 = -3e38f, bv2 = -3e38f; int j0 = 99, j1 = 99, j2 = 99;
#define INS3(a, n) do { if ((a) > bv0 || ((a) == bv0 && (n) < j0)) { bv2 = bv1; j2 = j1; bv1 = bv0; j1 = j0; bv0 = (a); j0 = (n); } \
                else if ((a) > bv1 || ((a) == bv1 && (n) < j1)) { bv2 = bv1; j2 = j1; bv1 = (a); j1 = (n); } \
                else if ((a) > bv2 || ((a) == bv2 && (n) < j2)) { bv2 = (a); j2 = (n); } } while (0)
#pragma unroll
            for (int kt2 = 0; kt2 < 2; ++kt2) {
                const bf16x8 h0 = *(const LAS bf16x8*)(kmt + ko0 + kt2 * 2048), h1 = *(const LAS bf16x8*)(kmt + ko1 + kt2 * 2048);
                const bf16x8 l0 = *(const LAS bf16x8*)(kmt + 4096 + ko0 + kt2 * 2048), l1 = *(const LAS bf16x8*)(kmt + 4096 + ko1 + kt2 * 2048);
                f32x4 g = __builtin_amdgcn_mfma_f32_16x16x32_bf16(l0, T[ti].q[0], (f32x4){0.f, 0.f, 0.f, 0.f}, 0, 0, 0);
                g = __builtin_amdgcn_mfma_f32_16x16x32_bf16(l1, T[ti].q[1], g, 0, 0, 0);
                g = __builtin_amdgcn_mfma_f32_16x16x32_bf16(h0, T[ti].q[0], g, 0, 0, 0);
                g = __builtin_amdgcn_mfma_f32_16x16x32_bf16(h1, T[ti].q[1], g, 0, 0, 0);
#pragma unroll
                for (int r = 0; r < 4; ++r) { const int n = 16 * kt2 + 4 * fq + r; const float a = n < cb ? g[r] : -3e38f; INS3(a, n); }
            }
#pragma unroll
            for (int o = 16; o <= 32; o <<= 1) {
                const float ov0 = __shfl_xor(bv0, o), ov1 = __shfl_xor(bv1, o), ov2 = __shfl_xor(bv2, o); const int oj0 = __shfl_xor(j0, o), oj1 = __shfl_xor(j1, o), oj2 = __shfl_xor(j2, o);
                INS3(ov0, oj0); INS3(ov1, oj1); INS3(ov2, oj2);
            }
#undef INS3
            unsigned mk = 1u << cb;
            if (j0 < cb && bv0 > -1e38f) mk |= 1u << j0; if (j1 < cb && bv1 > -1e38f) mk |= 1u << j1; if (j2 < cb && bv2 > -1e38f) mk |= 1u << j2;
            T[ti].fw0 = mk;
        }
#pragma unroll
        for (int ti = 0; ti < 2; ++ti) { T[ti].kmax = tt[ti] - 256 * cb; }
        fa::flash_loop<0, 0>(ring, K1 + ((size_t)bh * SEQ + 256 * cb) * DH, V1 + ((size_t)bh * SEQ + 256 * cb) * DH, 4, T[0], T[1], kms, wave, lane);
#pragma unroll
        for (int ti = 0; ti < 2; ++ti) { T[ti].kmax = tt[ti]; fa::task_fix_ref(T[ti]); }
        if (cb > 0) fa::flash_loop2<3, 2>(ring, K1 + (size_t)bh * SEQ * DH, V1 + (size_t)bh * SEQ * DH, 4 * cb, T[0], T[1], kms, wave, lane);
#pragma unroll
        for (int ti = 0; ti < 2; ++ti) { const float l = fa::task_rowsum(T[ti]); const float sc_ = l > 0.f ? 1.0f / l : 0.f;
            bf16_t* op = AO + (size_t)(b * SEQ + tt[ti]) * DM + h * DH + 4 * fq;
#pragma unroll
            for (int dt = 0; dt < 4; ++dt) { const f32x4 o = T[ti].O[dt] * sc_; *(u32x2*)(op + 16 * dt) = (u32x2){pk2(o[0], o[1]), pk2(o[2], o[3])}; } }
    }
}

struct Route { int e0, s0, e1, s1; float w0, w1; int pad0, pad1; };
__device__ __forceinline__ void ph_ln_route(const Ctx& C, int layer) {
    const float* resid = C.in[I_X]; const bf16_t* residb = (const bf16_t*)(C.ws + WS_X2B); const bf16_t* MIX = (const bf16_t*)(C.ws + WS_MIX);
    bf16_t* X1B = (bf16_t*)(C.ws + WS_X1B); Route* RT = (Route*)(C.ws + WS_ROUTE);
    int* rowlist = (int*)(C.ws + WS_ROWLIST); unsigned* cnt = (unsigned*)(C.ws + WS_CTL) + (layer ? CW_CNT1 : CW_CNT0);
    const float* lg = C.in[I_LNG] + (size_t)(layer * 2 + 0) * DM; const float* lb = C.in[I_LNB] + (size_t)(layer * 2 + 0) * DM;
    const float* rw = C.in[I_RW]; const float* rb = C.in[I_RB];
    LAS unsigned* lcnt = (LAS unsigned*)C.lds;
    LAS float* rec = (LAS float*)(C.lds + 256);
    LAS float* lsb = (LAS float*)(C.lds + 4096 + C.wave * 512);
    const int lane = C.lane;
    LAS unsigned char* rwl = (LAS unsigned char*)(C.lds + 8192);
    for (int gi = C.tid; gi < DM * NE / 4; gi += NTHREADS) { const int c = gi >> 2, e4 = gi & 3;
        *(LAS f32x4*)(rwl + (c >> 8) * 17408 + ((c & 255) >> 2) * 272 + (c & 3) * 64 + e4 * 16) = ((const f32x4*)rw)[gi]; }
    __syncthreads();
    for (int chunk = C.bid; chunk < NTOK / 128; chunk += C.nb) {
        if (C.tid < 16) lcnt[C.tid] = 0u;
        __syncthreads();
        for (int i2 = 0; i2 < 8; ++i2) {
            const int rl0 = C.wave * 16 + i2 * 2, row0 = chunk * 128 + rl0;
            f32x4 v[2][4]; float s[2], s2[2];
#pragma unroll
            for (int r = 0; r < 2; ++r) { const f32x4* xr = (const f32x4*)(resid + (size_t)(row0 + r) * DM) + lane; const u32x2* xb = (const u32x2*)(residb + (size_t)(row0 + r) * DM) + lane;
                const u32x2* mr = (const u32x2*)(MIX + (size_t)(row0 + r) * DM) + lane; s[r] = 0.f;
#pragma unroll
                for (int j = 0; j < 4; ++j) { const u32x2 w = mr[64 * j]; f32x4 xv;
                    if (layer) { const u32x2 q = xb[64 * j]; xv = (f32x4){bflo(q.x), bfhi(q.x), bflo(q.y), bfhi(q.y)}; } else xv = xr[64 * j];
                    v[r][j] = xv * DN_ALPHA + (f32x4){bflo(w.x), bfhi(w.x), bflo(w.y), bfhi(w.y)};
                    s[r] += (v[r][j][0] + v[r][j][1]) + (v[r][j][2] + v[r][j][3]); } }
#pragma unroll
            for (int o = 1; o < 64; o <<= 1) { s[0] += __shfl_xor(s[0], o); s[1] += __shfl_xor(s[1], o); }
#pragma unroll
            for (int r = 0; r < 2; ++r) { const float mean = s[r] * (1.f / DM); s2[r] = 0.f;
#pragma unroll
                for (int j = 0; j < 4; ++j) { v[r][j] = v[r][j] - mean; s2[r] += (v[r][j][0] * v[r][j][0] + v[r][j][1] * v[r][j][1]) + (v[r][j][2] * v[r][j][2] + v[r][j][3] * v[r][j][3]); } }
#pragma unroll
            for (int o = 1; o < 64; o <<= 1) { s2[0] += __shfl_xor(s2[0], o); s2[1] += __shfl_xor(s2[1], o); }
            const float rstd0 = 1.f / sqrtf(s2[0] * (1.f / DM) + LN_EPS), rstd1 = 1.f / sqrtf(s2[1] * (1.f / DM) + LN_EPS);
            float p[32];
#pragma unroll
            for (int q = 0; q < 32; ++q) p[q] = 0.f;
#pragma unroll
            for (int j = 0; j < 4; ++j) {
                const int c0 = 4 * lane + 256 * j;
                const f32x4 gg = *(const f32x4*)(lg + c0), bb = *(const f32x4*)(lb + c0);
#pragma unroll
                for (int r = 0; r < 2; ++r) {
                    v[r][j] = v[r][j] * (r ? rstd1 : rstd0) * gg + bb;
                    *(u32x2*)(X1B + (size_t)(row0 + r) * DM + c0) = (u32x2){pk2(v[r][j][0], v[r][j][1]), pk2(v[r][j][2], v[r][j][3])}; }
#pragma unroll
                for (int q = 0; q < 4; ++q) {
                    const LAS f32x4* wr = (const LAS f32x4*)(rwl + j * 17408 + lane * 272 + q * 64);
                    const f32x4 w0 = wr[0], w1 = wr[1], w2 = wr[2], w3 = wr[3];
#pragma unroll
                    for (int r = 0; r < 2; ++r) { const float x = v[r][j][q];
                        p[16 * r + 0] += x * w0[0]; p[16 * r + 1] += x * w0[1]; p[16 * r + 2] += x * w0[2]; p[16 * r + 3] += x * w0[3];
                        p[16 * r + 4] += x * w1[0]; p[16 * r + 5] += x * w1[1]; p[16 * r + 6] += x * w1[2]; p[16 * r + 7] += x * w1[3];
                        p[16 * r + 8] += x * w2[0]; p[16 * r + 9] += x * w2[1]; p[16 * r + 10] += x * w2[2]; p[16 * r + 11] += x * w2[3];
                        p[16 * r + 12] += x * w3[0]; p[16 * r + 13] += x * w3[1]; p[16 * r + 14] += x * w3[2]; p[16 * r + 15] += x * w3[3]; }
                    if (q == 3) asm volatile("" ::: "memory");
                }
            }
#define TRED(N, M) { const bool up = (lane & (M)) != 0; _Pragma("unroll") for (int q = 0; q < (N); ++q) { const float keep = up ? p[q + (N)] : p[q], send = up ? p[q] : p[q + (N)]; p[q] = keep + __shfl_xor(send, (M)); } }
            TRED(16, 32) TRED(8, 16) TRED(4, 8) TRED(2, 4) TRED(1, 2)
#undef TRED
            p[0] += __shfl_xor(p[0], 1);
            const float sc_own = 1.0f / (1.0f + expf(-p[0]));
            if ((lane & 1) == 0) { lsb[lane >> 1] = sc_own; lsb[32 + (lane >> 1)] = sc_own + rb[(lane >> 1) & 15]; }
            WAVE_LDS_SYNC();
            float sc[16], bi[16];
            { const LAS f32x4* a4 = (const LAS f32x4*)(lsb + ((lane >> 5) << 4)); const LAS f32x4* b4 = (const LAS f32x4*)(lsb + 32 + ((lane >> 5) << 4));
#pragma unroll
              for (int q = 0; q < 4; ++q) { const f32x4 x = a4[q], y = b4[q]; sc[4 * q] = x[0]; sc[4 * q + 1] = x[1]; sc[4 * q + 2] = x[2]; sc[4 * q + 3] = x[3]; bi[4 * q] = y[0]; bi[4 * q + 1] = y[1]; bi[4 * q + 2] = y[2]; bi[4 * q + 3] = y[3]; } }
            WAVE_LDS_SYNC();
            int gsel = 0; float gbest = -3e38f;
#pragma unroll
            for (int gq = 0; gq < 4; ++gq) {
                float m1 = -3e38f, m2 = -3e38f;
#pragma unroll
                for (int q = 0; q < 4; ++q) { const float x = bi[4 * gq + q]; if (x > m1) { m2 = m1; m1 = x; } else if (x > m2) m2 = x; }
                const float gs = m1 + m2; if (gs > gbest) { gbest = gs; gsel = gq; }
            }
            int e0 = 0, e1 = 0; float b0 = -3e38f, b1 = -3e38f, w0 = 0.f, w1 = 0.f;
#pragma unroll
            for (int e = 0; e < 16; ++e) {
                if ((e >> 2) == gsel) {
                    const float x = bi[e];
                    if (x > b0) { b1 = b0; e1 = e0; w1 = w0; b0 = x; e0 = e; w0 = sc[e]; }
                    else if (x > b1) { b1 = x; e1 = e; w1 = sc[e]; }
                }
            }
            if ((lane & 31) == 0) {
                const int rl = rl0 + (lane >> 5);
                const float ws_ = w0 + w1;
                const unsigned l0 = __hip_atomic_fetch_add(lcnt + e0, 1u, __ATOMIC_RELAXED, __HIP_MEMORY_SCOPE_WORKGROUP), l1 = __hip_atomic_fetch_add(lcnt + e1, 1u, __ATOMIC_RELAXED, __HIP_MEMORY_SCOPE_WORKGROUP);
                LAS float* r = rec + rl * 6; r[0] = __int_as_float(e0); r[1] = __int_as_float(e1); r[2] = __uint_as_float(l0); r[3] = __uint_as_float(l1); r[4] = w0 / ws_; r[5] = w1 / ws_;
            }
        }
        __syncthreads();
        if (C.tid < 16) lcnt[16 + C.tid] = atomicAdd(cnt + 64 * C.tid, lcnt[C.tid]);
        __syncthreads();
        if (C.tid < 128) {
            const LAS float* r = rec + C.tid * 6; const int row = chunk * 128 + C.tid;
            const int e0 = __float_as_int(r[0]), e1 = __float_as_int(r[1]);
            const int s0 = (int)(lcnt[16 + e0] + __float_as_uint(r[2])), s1 = (int)(lcnt[16 + e1] + __float_as_uint(r[3]));
            rowlist[e0 * NTOK + s0] = row; rowlist[e1 * NTOK + s1] = row;
            Route rr; rr.e0 = e0; rr.s0 = s0; rr.e1 = e1; rr.s1 = s1; rr.w0 = r[4]; rr.w1 = r[5]; rr.pad0 = 0; rr.pad1 = 0;
            RT[row] = rr;
        }
        __syncthreads();
    }
}
__device__ __forceinline__ void ph_combine(const Ctx& C, int layer, float* outp, LAS int* sm) {
    const bf16_t* X1B = (const bf16_t*)(C.ws + WS_X1B); const bf16_t* Y2 = (const bf16_t*)(C.ws + WS_Y2); const Route* RT = (const Route*)(C.ws + WS_ROUTE);
    bf16_t* XB = (bf16_t*)(C.ws + WS_XB); bf16_t* X2B = (bf16_t*)(C.ws + WS_X2B);
    const float* lg = C.in[I_LNG] + (size_t)(layer * 2 + 1) * DM; const float* lb = C.in[I_LNB] + (size_t)(layer * 2 + 1) * DM;
    const int gw = C.bid * NWAVES + C.wave, NGW = C.nb * NWAVES, lane = C.lane;
    for (int row = gw; row < NTOK; row += NGW) {
        const Route r = RT[row];
        const bf16_t* y0 = Y2 + (size_t)(sm[16 + r.e0] + r.s0) * DM; const bf16_t* y1 = Y2 + (size_t)(sm[16 + r.e1] + r.s1) * DM;
        const u32x2* xr = (const u32x2*)(X1B + (size_t)row * DM) + lane;
        f32x4 v[4]; float s = 0.f;
#pragma unroll
        for (int j = 0; j < 4; ++j) {
            const int c0 = 4 * lane + 256 * j;
            const u32x2 a = *(const u32x2*)(y0 + c0), b = *(const u32x2*)(y1 + c0), x = xr[64 * j];
            const f32x4 ya = (f32x4){bflo(a.x), bfhi(a.x), bflo(a.y), bfhi(a.y)}, yb = (f32x4){bflo(b.x), bfhi(b.x), bflo(b.y), bfhi(b.y)}, xv = (f32x4){bflo(x.x), bfhi(x.x), bflo(x.y), bfhi(x.y)};
            v[j] = xv * DN_ALPHA + ya * r.w0 + yb * r.w1;
            s += (v[j][0] + v[j][1]) + (v[j][2] + v[j][3]);
        }
        const float mean = wave_sum(s) * (1.f / DM); float s2 = 0.f;
#pragma unroll
        for (int j = 0; j < 4; ++j) { v[j] = v[j] - mean; s2 += (v[j][0] * v[j][0] + v[j][1] * v[j][1]) + (v[j][2] * v[j][2] + v[j][3] * v[j][3]); }
        const float rstd = 1.f / sqrtf(wave_sum(s2) * (1.f / DM) + LN_EPS);
#pragma unroll
        for (int j = 0; j < 4; ++j) {
            const int c0 = 4 * lane + 256 * j;
            const f32x4 gg = *(const f32x4*)(lg + c0), bb = *(const f32x4*)(lb + c0);
            v[j] = v[j] * rstd * gg + bb;
            if (layer) *(f32x4*)(outp + (size_t)row * DM + c0) = v[j];
            else { const u32x2 w = (u32x2){pk2(v[j][0], v[j][1]), pk2(v[j][2], v[j][3])}; *(u32x2*)(XB + (size_t)row * DM + c0) = w; *(u32x2*)(X2B + (size_t)row * DM + c0) = w; }
        }
    }
}

__device__ __forceinline__ void ph_kmean(const Ctx& C) {
    const bf16_t* K1 = (const bf16_t*)(C.ws + WS_K1); float* KM = (float*)(C.ws + WS_KMEAN);
    const int gw = C.bid * NWAVES + C.wave, NGW = C.nb * NWAVES, lane = C.lane;
    for (int it = gw; it < NB * NH * 32; it += NGW) {
        const bf16_t* p = K1 + (size_t)it * 256 * DH + lane; float s = 0.f;
#pragma unroll 8
        for (int j = 0; j < 256; ++j) s += bf2f(p[j * DH]);
        KM[(size_t)it * DH + lane] = s * (1.0f / 256.0f);
    }
}
constexpr int NPHASE = 19;
__global__ void __launch_bounds__(NTHREADS, 2) fwd(Args args) {
    extern __shared__ __attribute__((aligned(16))) unsigned char lds[];
    Ctx C;
#pragma unroll
    for (int i = 0; i < 18; ++i) C.in[i] = args.in[i];
    C.out = args.out; C.ws = args.ws; C.lds = lds;
    C.tid = threadIdx.x; C.lane = C.tid & 63; C.wave = __builtin_amdgcn_readfirstlane(C.tid >> 6); C.bid = blockIdx.x; C.nb = gridDim.x;
    LAS unsigned* misc = (LAS unsigned*)(lds + LDS_BYTES - 512);
    LAS int* sm = (LAS int*)(misc + 16);
    if (C.tid < 4) misc[C.tid] = 0u;
    __syncthreads();
#if MK_SINGLE
    XcdBarrier bar = xcd_barrier_post((unsigned*)(C.ws + WS_CTL) + CW_BAR, (volatile LAS unsigned*)misc);
#define SEAM() xcd_barrier(bar)
#else
#define SEAM() do {} while (0)
#endif
    const int lo = args.ph_lo, hi = args.ph_hi;
#ifndef PH_MASK
#define PH_MASK 0xFFFFFFFFu
#endif
#define IN(k) (((PH_MASK >> (k)) & 1u) && lo <= (k) && (k) < hi)
#define BOTH(k) (IN(k) && IN((k) + 1))
    unsigned char* ws = C.ws;
    const float2* rope = (const float2*)(ws + WS_ROPE);
    LAS unsigned char* L = (LAS unsigned char*)lds;

    if (IN(0)) { ph_prologue(C); if (BOTH(0)) SEAM(); }
    if (IN(1)) {
        EpiNsaIn E{(bf16_t*)(ws + WS_Q), (bf16_t*)(ws + WS_KV0), (float*)(ws + WS_GATES), rope};
        g8::StaticOrder S; S.init(NTOK / 256, 2560 / 256, C.nb, C.bid);
        g8::gemm8<false>(L, (const bf16_t*)(ws + WS_XB), DM, (const bf16_t*)(ws + WS_WT_NSA_IN), DM, S, g8::EpiEl<EpiNsaIn>{E}, g8::GatherInfo{nullptr, sm});
        if (BOTH(1)) SEAM();
    }
    if (IN(2)) {
        EpiCmp EK{(const float*)(ws + WS_BIAS1), (const bf16_t*)(ws + WS_W2T), rope, (bf16_t*)(ws + WS_KC)}, EV{(const float*)(ws + WS_BIAS1) + 256, (const bf16_t*)(ws + WS_W2T) + 64 * 256, nullptr, (bf16_t*)(ws + WS_VC)};
        g8::StaticOrder SK, SV; SK.init(32, 1, C.nb, C.bid); SV.init(32, 1, C.nb, (C.bid + C.nb / 2) % C.nb);
        g8::gemm8<false>(L, (const bf16_t*)(ws + WS_KV0), 1024, (const bf16_t*)(ws + WS_WT_C1K), 2048, SK, EK, g8::GatherInfo{nullptr, sm});
        g8::gemm8<false>(L, (const bf16_t*)(ws + WS_KV0 + KVSEG), 1024, (const bf16_t*)(ws + WS_WT_C1V), 2048, SV, EV, g8::GatherInfo{nullptr, sm});
        if (C.nb == 256 && !((C.bid < 32) || (C.bid >= 128 && C.bid < 160))) {
            EpiNsaIn E{(bf16_t*)(ws + WS_Q), (bf16_t*)(ws + WS_KV0), (float*)(ws + WS_GATES), rope};
            const int gidx = C.bid < 128 ? C.bid - 32 : C.bid - 64, fr = C.lane & 15, fq = C.lane >> 4;
            for (int tile = gidx * NWAVES + C.wave; tile < 2048; tile += 192 * NWAVES) {
                const int row0 = (tile >> 1) * 32, col0 = 2560 + (tile & 1) * 32;
                const bf16_t* a0 = (const bf16_t*)(ws + WS_XB) + (size_t)(row0 + fr) * DM + fq * 8; const bf16_t* a1 = a0 + (size_t)16 * DM;
                const bf16_t* b0 = (const bf16_t*)(ws + WS_WT_NSA_IN) + (size_t)(col0 + fr) * DM + fq * 8; const bf16_t* b1 = b0 + (size_t)16 * DM;
                f32x4 acc[2][2]; mma_core(a0, a1, b0, b1, DM, acc);
#pragma unroll
                for (int mi = 0; mi < 2; ++mi)
#pragma unroll
                    for (int ni = 0; ni < 2; ++ni) E(row0 + 16 * mi + fr, col0 + 16 * ni + 4 * fq, acc[mi][ni]);
            }
        } else if (C.nb != 256) {
            EpiNsaIn E{(bf16_t*)(ws + WS_Q), (bf16_t*)(ws + WS_KV0), (float*)(ws + WS_GATES), rope};
            const int fr = C.lane & 15, fq = C.lane >> 4;
            for (int tile = C.bid * NWAVES + C.wave; tile < 2048; tile += C.nb * NWAVES) {
                const int row0 = (tile >> 1) * 32, col0 = 2560 + (tile & 1) * 32;
                const bf16_t* a0 = (const bf16_t*)(ws + WS_XB) + (size_t)(row0 + fr) * DM + fq * 8; const bf16_t* a1 = a0 + (size_t)16 * DM;
                const bf16_t* b0 = (const bf16_t*)(ws + WS_WT_NSA_IN) + (size_t)(col0 + fr) * DM + fq * 8; const bf16_t* b1 = b0 + (size_t)16 * DM;
                f32x4 acc[2][2]; mma_core(a0, a1, b0, b1, DM, acc);
#pragma unroll
                for (int mi = 0; mi < 2; ++mi)
#pragma unroll
                    for (int ni = 0; ni < 2; ++ni) E(row0 + 16 * mi + fr, col0 + 16 * ni + 4 * fq, acc[mi][ni]);
            }
        }
        if (BOTH(2)) SEAM();
    }
    if (IN(4)) { ph_nsa_fa(C); if (BOTH(4)) SEAM(); }
    if (IN(6)) {
        EpiBf16 E{(bf16_t*)(ws + WS_MIX)};
        g8::StaticOrder S; S.init(NTOK / 256, DM / 256, C.nb, C.bid);
        g8::gemm8<false>(L, (const bf16_t*)(ws + WS_XB), DM, (const bf16_t*)(ws + WS_WT_NSA_OUT), DM, S, g8::EpiEl<EpiBf16>{E}, g8::GatherInfo{nullptr, sm});
        if (BOTH(6)) SEAM();
    }
    if (IN(7)) { ph_ln_route(C, 0); if (BOTH(7)) SEAM(); }
    if (IN(8)) {
        load_expert_map(C, CW_CNT0, sm);
        EpiSwiGLU E{(bf16_t*)(ws + WS_HBUF)};
        g8::GroupedOrder S; S.init(sm, 4, C.nb, C.bid);
        g8::gemm8<true>(L, (const bf16_t*)(ws + WS_X1B), DM, (const bf16_t*)(ws + WS_WT_GU), 1024, S, g8::EpiEl<EpiSwiGLU>{E}, g8::GatherInfo{(const int*)(ws + WS_ROWLIST), sm});
        if (BOTH(8)) SEAM();
    }
    if (IN(9)) {
        load_expert_map(C, CW_CNT0, sm);
        EpiBf16 E{(bf16_t*)(ws + WS_Y2)};
        g8::GroupedOrder S; S.init(sm, 4, C.nb, C.bid);
        g8::gemm8<false>(L, (const bf16_t*)(ws + WS_HBUF), DE, (const bf16_t*)(ws + WS_WT_DN), DE, S, g8::EpiEl<EpiBf16>{E}, g8::GatherInfo{nullptr, sm});
        if (BOTH(9)) SEAM();
    }
    if (IN(10)) {
        load_expert_map(C, CW_CNT0, sm);
        ph_combine(C, 0, (float*)(ws + WS_XR), sm);
        { float* scr = (float*)(C.lds + C.wave * 9216); const int gw = C.bid * NWAVES + C.wave, NGW = C.nb * NWAVES;
          for (int it = gw; it < MOE_W_ITEMS; it += NGW) moe_weight_item(C, 1, it, scr); }
        if (BOTH(10)) SEAM();
    }
    if (IN(11)) {
        EpiMobaIn E{(bf16_t*)(ws + WS_Q), (bf16_t*)(ws + WS_K1), (bf16_t*)(ws + WS_V1), rope};
        g8::StaticOrder S; S.init(NTOK / 256, 3072 / 256, C.nb, C.bid);
        g8::gemm8<false>(L, (const bf16_t*)(ws + WS_XB), DM, (const bf16_t*)(ws + WS_WT_MOBA_IN), DM, S, g8::EpiEl<EpiMobaIn>{E}, g8::GatherInfo{nullptr, sm});
        if (BOTH(11)) SEAM();
    }
    if (IN(12)) { ph_kmean(C); if (BOTH(12)) SEAM(); }
    if (IN(13)) { ph_moba_fa(C); if (BOTH(13)) SEAM(); }
    if (IN(14)) {
        EpiBf16 E{(bf16_t*)(ws + WS_MIX)};
        g8::StaticOrder S; S.init(NTOK / 256, DM / 256, C.nb, C.bid);
        g8::gemm8<false>(L, (const bf16_t*)(ws + WS_XB), DM, (const bf16_t*)(ws + WS_WT_MOBA_OUT), DM, S, g8::EpiEl<EpiBf16>{E}, g8::GatherInfo{nullptr, sm});
        if (BOTH(14)) SEAM();
    }
    if (IN(15)) { ph_ln_route(C, 1); if (BOTH(15)) SEAM(); }
    if (IN(16)) {
        load_expert_map(C, CW_CNT1, sm);
        EpiSwiGLU E{(bf16_t*)(ws + WS_HBUF)};
        g8::GroupedOrder S; S.init(sm, 4, C.nb, C.bid);
        g8::gemm8<true>(L, (const bf16_t*)(ws + WS_X1B), DM, (const bf16_t*)(ws + WS_WT_GU), 1024, S, g8::EpiEl<EpiSwiGLU>{E}, g8::GatherInfo{(const int*)(ws + WS_ROWLIST), sm});
        if (BOTH(16)) SEAM();
    }
    if (IN(17)) {
        load_expert_map(C, CW_CNT1, sm);
        EpiBf16 E{(bf16_t*)(ws + WS_Y2)};
        g8::GroupedOrder S; S.init(sm, 4, C.nb, C.bid);
        g8::gemm8<false>(L, (const bf16_t*)(ws + WS_HBUF), DE, (const bf16_t*)(ws + WS_WT_DN), DE, S, g8::EpiEl<EpiBf16>{E}, g8::GatherInfo{nullptr, sm});
        if (BOTH(17)) SEAM();
    }
    if (IN(18)) {
        load_expert_map(C, CW_CNT1, sm);
        ph_combine(C, 1, C.out, sm);
    }
#undef IN
#undef BOTH
}

extern "C" void kernel_launch(void* const* d_in, const int* in_sizes, int n_in, void* d_out, int out_size, void* d_ws, size_t ws_size, hipStream_t stream) {
    static int grid = 0;
    if (grid == 0) {
        if (n_in != 18 || in_sizes[0] != NTOK * DM || out_size != NTOK * DM || ws_size < WS_END) {
            fprintf(stderr, "kernel_launch: unexpected shapes (n_in %d, in0 %d, out %d, ws %zu; need ws >= %zu); nothing launched\n", n_in, n_in > 0 ? in_sizes[0] : -1, out_size, ws_size, (size_t)WS_END);
            grid = -1; return;
        }
        int dev = 0, cus = 0, per_cu = 0;
        if (hipGetDevice(&dev) != hipSuccess || hipDeviceGetAttribute(&cus, hipDeviceAttributeMultiprocessorCount, dev) != hipSuccess) { grid = -1; return; }
        if (hipFuncSetAttribute((const void*)fwd, hipFuncAttributeMaxDynamicSharedMemorySize, LDS_BYTES) != hipSuccess) { fprintf(stderr, "kernel_launch: hipFuncSetAttribute failed\n"); grid = -1; return; }
        if (hipOccupancyMaxActiveBlocksPerMultiprocessor(&per_cu, (const void*)fwd, NTHREADS, LDS_BYTES) != hipSuccess || per_cu < 1)
            fprintf(stderr, "kernel_launch: occupancy query reports %d blocks per CU\n", per_cu);
        (void)hipGetLastError();
        grid = cus;
        if (grid != 256) { fprintf(stderr, "kernel_launch: built for a 256-CU device (got %d CUs); nothing launched\n", cus); grid = -1; return; }
    }
    if (grid < 0) return;
    if (hipMemsetAsync((char*)d_ws + WS_CTL, 0, CTL_BYTES, stream) != hipSuccess) { fprintf(stderr, "kernel_launch: memset failed\n"); return; }
    Args a{};
    for (int i = 0; i < 18; ++i) a.in[i] = (const float*)d_in[i];
    a.out = (float*)d_out; a.ws = (unsigned char*)d_ws;
#if defined(PROBE_PH)
    { const int lo3[3] = {0, PROBE_PH, PROBE_PH + 1}, hi3[3] = {PROBE_PH + 1, PROBE_PH + 1, NPHASE};
      for (int q = 0; q < 3; ++q) { if (lo3[q] >= hi3[q]) continue;
          if (q) (void)hipMemsetAsync((char*)d_ws + WS_CTL + CW_BAR * 4, 0, XCD_BAR_WORDS * 4, stream);
          a.ph_lo = lo3[q]; a.ph_hi = hi3[q]; hipLaunchKernelGGL(fwd, dim3(grid), dim3(NTHREADS), LDS_BYTES, stream, a); } }
#elif MK_SINGLE
    a.ph_lo = 0; a.ph_hi = NPHASE;
    hipLaunchKernelGGL(fwd, dim3(grid), dim3(NTHREADS), LDS_BYTES, stream, a);
#else
    for (int p = 0; p < NPHASE; ++p) { a.ph_lo = p; a.ph_hi = p + 1; hipLaunchKernelGGL(fwd, dim3(grid), dim3(NTHREADS), LDS_BYTES, stream, a); }
#endif
    const hipError_t le = hipPeekAtLastError();
    if (le != hipSuccess) fprintf(stderr, "kernel_launch: launch failed: %s\n", hipGetErrorName(le));
}
```

```cpp
#include <hip/hip_runtime.h>
#include <cstdio>
#include <cstdint>

#ifndef SEL_FUSED
#define SEL_FUSED 1
#endif
#ifndef MK_SINGLE
#define MK_SINGLE 1
#endif

#define LAS __attribute__((address_space(3)))
typedef unsigned short bf16_t;
typedef short bf16x8 __attribute__((ext_vector_type(8)));
typedef float f32x4 __attribute__((ext_vector_type(4)));
typedef unsigned u32x4 __attribute__((ext_vector_type(4)));
typedef unsigned u32x2 __attribute__((ext_vector_type(2)));

constexpr int NB = 4, SEQ = 8192, NTOK = NB * SEQ, DM = 1024, NH = 16, DH = 64, NG = 4;
constexpr int NSA_IN = 2608, NSA_INP = 2816;
constexpr int NE = 16, DE = 512;
constexpr float DN_ALPHA = 1.4142135623730951f;
constexpr float LN_EPS = 1e-5f;
constexpr int NWAVES = 8, NTHREADS = 512;
constexpr float QSCALE = 0.125f * 1.4426950408889634f;
constexpr int LDS_BYTES = 163840;
constexpr int ROWCAP = 2 * NTOK + NE * 256;

constexpr size_t MiB = 1u << 20;
constexpr size_t WS_CTL = 0, CTL_BYTES = 1 * MiB;
constexpr size_t WS_ROPE = 1 * MiB;
constexpr size_t WS_BIAS1 = 3 * MiB;
constexpr size_t WS_W2T = 3 * MiB + 4096;
constexpr size_t WS_KMEAN = 4 * MiB;
constexpr size_t WS_ROUTE = 5 * MiB;
constexpr size_t WS_ROWLIST = 6 * MiB;
constexpr size_t WS_SEL = 8 * MiB;
constexpr size_t WS_GATES = 10 * MiB;
constexpr size_t WS_KC = 25 * MiB, WS_VC = 26 * MiB;
constexpr size_t WS_WT_NSA_IN = 27 * MiB;
constexpr size_t WS_WT_NSA_OUT = 33 * MiB;
constexpr size_t WS_WT_C1K = 35 * MiB, WS_WT_C1V = 36 * MiB;
constexpr size_t WS_WT_MOBA_IN = 37 * MiB;
constexpr size_t WS_WT_MOBA_OUT = 43 * MiB;
constexpr size_t WS_WT_GU = 45 * MiB;
constexpr size_t WS_WT_DN = 77 * MiB;
constexpr size_t WS_XB = 93 * MiB;
constexpr size_t WS_ATTN = 161 * MiB;
constexpr size_t WS_Q = WS_ATTN;
constexpr size_t WS_KV0 = WS_ATTN + 64 * MiB;
constexpr size_t KVSEG = 16 * MiB;
constexpr size_t WS_K1 = WS_ATTN + 64 * MiB, WS_V1 = WS_ATTN + 128 * MiB;
constexpr size_t WS_X1B = 353 * MiB;
constexpr size_t WS_MIX = WS_ATTN + 64 * MiB;
constexpr size_t WS_Y2 = WS_ATTN;
constexpr size_t WS_HBUF = WS_XB;
constexpr size_t WS_XR = 353 * MiB;
constexpr size_t WS_END = 481 * MiB;
static_assert((size_t)ROWCAP * 512 * 2 <= 68 * MiB && (size_t)ROWCAP * 1024 * 2 <= 192 * MiB, "overlay sizes");

constexpr int CW_TMO = 0;
constexpr int CW_CNT0 = 1024, CW_CNT1 = 2048;
constexpr int CW_BAR = 8192;

__device__ __forceinline__ unsigned f2bf(float f) { unsigned u = __float_as_uint(f); return (u + 0x7fffu + ((u >> 16) & 1u)) >> 16; }
typedef float f32x2v __attribute__((ext_vector_type(2)));
typedef __bf16 bf16x2v __attribute__((ext_vector_type(2)));
__device__ __forceinline__ unsigned pk2(float lo, float hi) { const f32x2v v = {lo, hi}; const bf16x2v b = __builtin_convertvector(v, bf16x2v); return __builtin_bit_cast(unsigned, b); }
__device__ __forceinline__ float bflo(unsigned u) { return __uint_as_float(u << 16); }
__device__ __forceinline__ float bfhi(unsigned u) { return __uint_as_float(u & 0xffff0000u); }
__device__ __forceinline__ float bf2f(bf16_t b) { return __uint_as_float((unsigned)b << 16); }
__device__ __forceinline__ float wave_sum(float v) {
#pragma unroll
    for (int o = 1; o < 64; o <<= 1) v += __shfl_xor(v, o);
    return v;
}
__device__ __forceinline__ float wave_max(float v) {
#pragma unroll
    for (int o = 1; o < 64; o <<= 1) v = fmaxf(v, __shfl_xor(v, o));
    return v;
}
#define WAVE_LDS_SYNC() asm volatile("s_waitcnt lgkmcnt(0)" ::: "memory")
__device__ __forceinline__ float sigmoidf_(float x) { return 1.0f / (1.0f + __expf(-x)); }
__device__ __forceinline__ float gelu_tanh(float x) {
    const float u = 0.7978845608028654f * (x + 0.044715f * x * x * x);
    const float t = 1.0f - 2.0f / (__expf(2.0f * u) + 1.0f);
    return 0.5f * x * (1.0f + t);
}

#define XB_TMO      128
#define XB_XCNT(j)  (256  + 64 * (j))
#define XB_XSUB(j)  (1280 + 64 * (j))
#define XB_XGEN(j)  (2304 + 64 * (j))
#define XB_TOP      3328
#define XB_TOPGEN   3392
#define XCD_BAR_WORDS 3456
#define XB_SPIN_CAP (1u << 22)
__device__ __forceinline__ unsigned xb_ld(unsigned* p)              { return __hip_atomic_load(p, __ATOMIC_RELAXED, __HIP_MEMORY_SCOPE_AGENT); }
__device__ __forceinline__ unsigned xb_add(unsigned* p, unsigned v) { return __hip_atomic_fetch_add(p, v, __ATOMIC_RELAXED, __HIP_MEMORY_SCOPE_AGENT); }
__device__ __forceinline__ unsigned xb_xcc_id() { return (unsigned)__builtin_amdgcn_s_getreg((3 << 11) | 20) & 0xFu; }
#define XB_SPIN(cond, bar) do { unsigned _sp = 0; while (cond) { __builtin_amdgcn_s_sleep(1); \
    if ((++_sp & 255u) == 0u) { if (xb_ld(&(bar)[XB_TMO])) break; if (_sp > XB_SPIN_CAP) { atomicAdd(&(bar)[XB_TMO], 1u); break; } } } } while (0)
struct XcdBarrier { unsigned* bar; unsigned x; volatile LAS unsigned* st; };
__device__ __forceinline__ XcdBarrier xcd_barrier_post(unsigned* bar, volatile LAS unsigned* st) {
    XcdBarrier b; b.bar = bar; b.x = xb_xcc_id(); b.st = st;
    if (threadIdx.x == 0) (void)xb_add(&bar[XB_XCNT(b.x)], 1u);
    return b;
}
__device__ __forceinline__ void xcd_barrier_complete(unsigned* bar, unsigned x, unsigned& nloc, unsigned& nx) {
    const unsigned G = gridDim.x * gridDim.y * gridDim.z;
    unsigned sum, cnt, mine, sp = 0u;
    for (;;) {
        sum = 0u; cnt = 0u; mine = 0u;
#pragma unroll
        for (unsigned j = 0; j < 16; ++j) { const unsigned c = xb_ld(&bar[XB_XCNT(j)]); sum += c; cnt += (c > 0u) ? 1u : 0u; mine = (j == x) ? c : mine; }
        if (sum == G) break;
        __builtin_amdgcn_s_sleep(1);
        if ((++sp & 255u) == 0u) { if (xb_ld(&bar[XB_TMO])) break; if (sp > XB_SPIN_CAP) { atomicAdd(&bar[XB_TMO], 1u); break; } }
    }
    nloc = mine > 0u ? mine : 1u; nx = cnt > 0u ? cnt : 1u;
}
__device__ __forceinline__ void xcd_barrier(const XcdBarrier& b) {
    asm volatile("s_waitcnt vmcnt(0)" ::: "memory");
    __syncthreads();
    if (threadIdx.x == 0) {
        unsigned* bar = b.bar;
        __builtin_amdgcn_s_waitcnt(0);
        unsigned nloc = b.st[0], nx = b.st[1];
        if (nloc == 0u) { xcd_barrier_complete(bar, b.x, nloc, nx); b.st[0] = nloc; b.st[1] = nx; }
        const unsigned old = xb_add(&bar[XB_XSUB(b.x)], 1u);
        const unsigned gen = old / nloc;
        if (old + 1u == (gen + 1u) * nloc) {
            __builtin_amdgcn_fence(__ATOMIC_RELEASE, "agent");
            asm volatile("s_waitcnt vmcnt(0)" ::: "memory");
            const unsigned og = xb_add(&bar[XB_TOP], 1u);
            const unsigned tg = og / nx;
            if (og + 1u == (tg + 1u) * nx) xb_add(&bar[XB_TOPGEN], 1u);
            else XB_SPIN(xb_ld(&bar[XB_TOPGEN]) == tg, bar);
            __builtin_amdgcn_fence(__ATOMIC_ACQUIRE, "agent");
            xb_add(&bar[XB_XGEN(b.x)], 1u);
            asm volatile("s_waitcnt vmcnt(0)" ::: "memory");
        } else {
            XB_SPIN(xb_ld(&bar[XB_XGEN(b.x)]) == gen, bar);
            __builtin_amdgcn_fence(__ATOMIC_ACQUIRE, "agent");
            asm volatile("s_waitcnt vmcnt(0)" ::: "memory");
        }
    }
    __syncthreads();
}

struct Args { const float* in[18]; float* out; unsigned char* ws; int ph_lo, ph_hi; };
struct Ctx {
    const float* in[18]; float* out; unsigned char* ws; unsigned char* lds;
    int tid, lane, wave, bid, nb;
};
enum { I_X = 0, I_NSA_WIN, I_NSA_WOUT, I_CK_W1, I_CK_W2, I_CV_W1, I_CV_W2, I_CK_POS, I_CV_POS, I_MOBA_WIN, I_MOBA_WOUT, I_RW, I_RB, I_WG, I_WU, I_WD, I_LNG, I_LNB };

__device__ __forceinline__ int il64(int d) { return d < 32 ? 2 * d : 2 * (d - 32) + 1; }
__device__ __forceinline__ int rowmap(int kind, int n) {
    switch (kind) {
        case 1: { const bool r = (n < 1024) || (n >= 1536 && n < 1792) || (n >= 2048 && n < 2304); return r ? (n & ~63) + il64(n & 63) : n; }
        case 2: return n < 2048 ? (n & ~63) + il64(n & 63) : n;
        case 3: return 2 * n;
        case 4: return 2 * n + 1;
        default: return n;
    }
}
__device__ __forceinline__ void transpose_item(const float* W, int ldw, int ncols, bf16_t* WT, int K, int kb, int nbk, int kind, float* scr, int lane) {
    const int k0 = 64 * kb, n0 = 32 * nbk;
    const int cq = lane & 7, nn = n0 + 4 * cq;
#pragma unroll
    for (int i = 0; i < 8; ++i) { const int kk = 8 * i + (lane >> 3);
        *(f32x4*)(scr + kk * 36 + 4 * cq) = nn < ncols ? *(const f32x4*)(W + (size_t)(k0 + kk) * ldw + nn) : (f32x4){0.f, 0.f, 0.f, 0.f}; }
    WAVE_LDS_SYNC();
    const int c = lane & 7;
#pragma unroll
    for (int j = 0; j < 4; ++j) {
        const int n = (lane >> 3) + 8 * j; const float* s = scr + (8 * c) * 36 + n;
        u32x4 o; o.x = pk2(s[0 * 36], s[1 * 36]); o.y = pk2(s[2 * 36], s[3 * 36]); o.z = pk2(s[4 * 36], s[5 * 36]); o.w = pk2(s[6 * 36], s[7 * 36]);
        *(u32x4*)(WT + (size_t)rowmap(kind, n0 + n) * K + k0 + 8 * c) = o;
    }
    WAVE_LDS_SYNC();
}
constexpr int MOE_W_ITEMS = NE * 768;
__device__ __forceinline__ void moe_weight_item(const Ctx& C, int layer, int r, float* scr) {
    const int e = r / 768; int q = r % 768;
    bf16_t* gu = (bf16_t*)(C.ws + WS_WT_GU) + (size_t)e * 1024 * 1024;
    bf16_t* dn = (bf16_t*)(C.ws + WS_WT_DN) + (size_t)e * 1024 * 512;
    const size_t eo = (size_t)(layer * NE + e);
    if (q < 256) { transpose_item(C.in[I_WG] + eo * DM * DE, DE, DE, gu, DM, q / 16, q % 16, 3, scr, C.lane); return; } q -= 256;
    if (q < 256) { transpose_item(C.in[I_WU] + eo * DM * DE, DE, DE, gu, DM, q / 16, q % 16, 4, scr, C.lane); return; } q -= 256;
    transpose_item(C.in[I_WD] + eo * DE * DM, DM, DM, dn, DE, q / 32, q % 32, 0, scr, C.lane);
}

__device__ __forceinline__ void ph_prologue(const Ctx& C) {
    float* scr = (float*)(C.lds + C.wave * 9216);
    const int gw = C.bid * NWAVES + C.wave, NGW = C.nb * NWAVES;
    constexpr int I_A = 16 * 82, I_B = 16 * 32, I_C = 32 * 8, I_D = 16 * 96, I_E = 16 * 32;
    constexpr int NIT = I_A + I_B + 2 * I_C + I_D + I_E + MOE_W_ITEMS;
    for (int it = gw; it < NIT; it += NGW) {
        int r = it;
        if (r < I_A) { transpose_item(C.in[I_NSA_WIN], NSA_IN, NSA_IN, (bf16_t*)(C.ws + WS_WT_NSA_IN), DM, r / 82, r % 82, 1, scr, C.lane); continue; } r -= I_A;
        if (r < I_B) { transpose_item(C.in[I_NSA_WOUT], DM, DM, (bf16_t*)(C.ws + WS_WT_NSA_OUT), DM, r / 32, r % 32, 0, scr, C.lane); continue; } r -= I_B;
        if (r < I_C) { transpose_item(C.in[I_CK_W1], 256, 256, (bf16_t*)(C.ws + WS_WT_C1K), 2048, r / 8, r % 8, 0, scr, C.lane); continue; } r -= I_C;
        if (r < I_C) { transpose_item(C.in[I_CV_W1], 256, 256, (bf16_t*)(C.ws + WS_WT_C1V), 2048, r / 8, r % 8, 0, scr, C.lane); continue; } r -= I_C;
        if (r < I_D) { transpose_item(C.in[I_MOBA_WIN], 3072, 3072, (bf16_t*)(C.ws + WS_WT_MOBA_IN), DM, r / 96, r % 96, 2, scr, C.lane); continue; } r -= I_D;
        if (r < I_E) { transpose_item(C.in[I_MOBA_WOUT], DM, DM, (bf16_t*)(C.ws + WS_WT_MOBA_OUT), DM, r / 32, r % 32, 0, scr, C.lane); continue; } r -= I_E;
        moe_weight_item(C, 0, r, scr);
    }
    const int gt = C.bid * NTHREADS + C.tid, NGT = C.nb * NTHREADS;
    { u32x4* p = (u32x4*)((bf16_t*)(C.ws + WS_WT_NSA_IN) + (size_t)2624 * DM); const int n = (NSA_INP - 2624) * DM / 8;
      for (int i = gt; i < n; i += NGT) p[i] = (u32x4){0u, 0u, 0u, 0u}; }
    { const f32x4* x4 = (const f32x4*)C.in[I_X]; u32x4* o = (u32x4*)(C.ws + WS_XB); const int n = NTOK * DM / 8;
      for (int i = gt; i < n; i += NGT) { const f32x4 a = x4[2 * i], b = x4[2 * i + 1]; o[i] = (u32x4){pk2(a.x, a.y), pk2(a.z, a.w), pk2(b.x, b.y), pk2(b.z, b.w)}; } }
    { const float INV[32] = {1.000000000e+00f, 7.498942018e-01f, 5.623413324e-01f, 4.216965139e-01f, 3.162277639e-01f, 2.371373922e-01f, 1.778279394e-01f, 1.333521456e-01f,
                             1.000000015e-01f, 7.498941571e-02f, 5.623412877e-02f, 4.216964915e-02f, 3.162277862e-02f, 2.371373586e-02f, 1.778279431e-02f, 1.333521493e-02f,
                             9.999999776e-03f, 7.498942316e-03f, 5.623413250e-03f, 4.216964822e-03f, 3.162277862e-03f, 2.371373819e-03f, 1.778279431e-03f, 1.333521446e-03f,
                             1.000000047e-03f, 7.498941850e-04f, 5.623413017e-04f, 4.216965463e-04f, 3.162277862e-04f, 2.371373848e-04f, 1.778279402e-04f, 1.333521504e-04f};
      float2* tab = (float2*)(C.ws + WS_ROPE);
      for (int i = gt; i < SEQ * 32; i += NGT) {
          const int t = i >> 5, f = i & 31;
          float inv = INV[0];
#pragma unroll
          for (int q = 1; q < 32; ++q) inv = (f == q) ? INV[q] : inv;
          const float ang = (float)t * inv;
          const double a = (double)ang; const double k = __builtin_rint(a * 0.15915494309189535); const float rf = (float)(a - k * 6.283185307179586);
          tab[i] = make_float2(__cosf(rf), __sinf(rf));
      } }
    for (int i = gt; i < 2 * 64 * 256; i += NGT) { const int which = i >> 14, d = (i >> 8) & 63, c = i & 255;
        ((bf16_t*)(C.ws + WS_W2T))[i] = (bf16_t)f2bf(C.in[which ? I_CV_W2 : I_CK_W2][c * 64 + d]); }
    for (int o = gw; o < 512; o += NGW) {
        const int which = o >> 8, c = o & 255;
        const float* pos = C.in[which ? I_CV_POS : I_CK_POS]; const float* w1 = C.in[which ? I_CV_W1 : I_CK_W1];
        float s = 0.f;
        for (int k = C.lane; k < 2048; k += 64) s += pos[k] * w1[(size_t)k * 256 + c];
        s = wave_sum(s);
        if (C.lane == 0) ((float*)(C.ws + WS_BIAS1))[o] = s;
    }
}

__device__ __forceinline__ void mma_core(const bf16_t* a0, const bf16_t* a1, const bf16_t* b0, const bf16_t* b1, int K, f32x4 (&acc)[2][2]) {
#pragma unroll
    for (int i = 0; i < 2; ++i)
#pragma unroll
        for (int j = 0; j < 2; ++j) acc[i][j] = (f32x4){0.f, 0.f, 0.f, 0.f};
#pragma unroll 4
    for (int k = 0; k < K; k += 32) {
        const bf16x8 A0 = *(const bf16x8*)(a0 + k), A1 = *(const bf16x8*)(a1 + k), B0 = *(const bf16x8*)(b0 + k), B1 = *(const bf16x8*)(b1 + k);
        acc[0][0] = __builtin_amdgcn_mfma_f32_16x16x32_bf16(B0, A0, acc[0][0], 0, 0, 0);
        acc[0][1] = __builtin_amdgcn_mfma_f32_16x16x32_bf16(B1, A0, acc[0][1], 0, 0, 0);
        acc[1][0] = __builtin_amdgcn_mfma_f32_16x16x32_bf16(B0, A1, acc[1][0], 0, 0, 0);
        acc[1][1] = __builtin_amdgcn_mfma_f32_16x16x32_bf16(B1, A1, acc[1][1], 0, 0, 0);
    }
}
namespace g8 {
constexpr int BM = 256, BK = 64, HALF = 128, HTB = HALF * BK * 2, STAGE_BYTES = 8 * HTB, NXCD = 8, WGM = 8;
__device__ __forceinline__ int lds_byte(int r, int c) { const int st = (r >> 4) * 2 + (c >> 5), rr = r & 15, cc = c & 31, ob = rr * 64 + cc * 2; return st * 1024 + (ob ^ (((ob >> 9) & 1) << 5)); }
__device__ __forceinline__ void stage_rc(int b, int& R, int& C) { const int st = b / 1024, sb = b % 1024, swz = sb ^ (((sb >> 9) & 1) << 5); R = (st >> 1) * 16 + swz / 64; C = (st & 1) * 32 + (swz % 64) / 2; }
struct Unit { int pm, pn, bt, e; };
struct StaticOrder {
    int nM, nN, nwg, G, c;
    __device__ void init(int nM_, int nN_, int G_, int c_) { nM = nM_; nN = nN_; nwg = nM * nN; G = G_; c = c_; }
    __device__ bool next(int i, Unit& u) const {
        const long L = (long)i * G + c; if (L >= nwg) return false;
        int wgid = (int)L; { const int q = nwg / NXCD, r = nwg % NXCD, xcd = wgid % NXCD, off = wgid / NXCD; wgid = (xcd < r ? xcd * (q + 1) : r * (q + 1) + (xcd - r) * q) + off; }
        const int nig = WGM * nN, gid = wgid / nig, fm = gid * WGM, gsz = (nM - fm) < WGM ? (nM - fm) : WGM;
        u.pm = fm + ((wgid % nig) % gsz); u.pn = (wgid % nig) / gsz; u.bt = u.pn; u.e = 0; return true;
    }
};
struct GroupedOrder {
    StaticOrder so; const LAS int* sm;
    __device__ void init(const LAS int* sm_, int nN_, int G_, int c_) { sm = sm_; so.init(sm_[32] / BM, nN_, G_, c_); }
    __device__ bool next(int i, Unit& u) const {
        if (!so.next(i, u)) return false;
        const int rowt = u.pm * BM; int e = 0;
#pragma unroll
        for (int q = 1; q < NE; ++q) e = (rowt >= sm[16 + q]) ? q : e;
        u.e = e; u.bt = e * so.nN + u.pn; return true;
    }
};
struct GatherInfo { const int* rowlist; const LAS int* sm; };

__device__ __forceinline__ int perm32(int rho) { const int n = rho >> 4, i = rho & 15; return 8 * (i >> 2) + 4 * n + (i & 3); }
template <bool GATHER, class Epi, class Sched>
__device__ __forceinline__ void gemm8(LAS unsigned char* lds, const bf16_t* A, int lda, const bf16_t* Bt, int K, const Sched& S, const Epi& E, GatherInfo gi) {
    const int tid = threadIdx.x, wid = __builtin_amdgcn_readfirstlane(tid >> 6), lane = tid & 63, wr = wid >> 2, wc = wid & 3, fr = lane & 15, fq = lane >> 4;
    const int nt = K / BK;
    int Rr[2], Cc[2]; unsigned voffB[2]; unsigned vAc[2][2], vAn[2][2];
#pragma unroll
    for (int i = 0; i < 2; ++i) { stage_rc(tid * 16 + i * 8192, Rr[i], Cc[i]); voffB[i] = (unsigned)(((Rr[i] & ~31) + perm32(Rr[i] & 31)) * K + Cc[i]) * 2u;
#pragma unroll
        for (int h = 0; h < 2; ++h) { vAc[h][i] = (unsigned)((Rr[i] + HALF * h) * lda + Cc[i]) * 2u; vAn[h][i] = vAc[h][i]; } }
    const size_t kstep = (size_t)(BK * 2);
    const size_t hstepB = (size_t)HALF * K * 2, tstepB = 2 * hstepB, tstepA = (size_t)BM * lda * 2;
    const unsigned ldsw = (unsigned)wid * 1024u;
    const int aoff = lds_byte(wr * 64 + fr, fq * 8), boff = lds_byte(wc * 32 + fr, fq * 8);
#define G8_SA(b, h) (((b) * 2 + (h)) * HTB)
#define G8_SB(b, h) ((4 + (b) * 2 + (h)) * HTB)
#define G8_STAGEB(bufoff, gbase) do { _Pragma("unroll") for (int _i = 0; _i < 2; ++_i) \
        __builtin_amdgcn_global_load_lds((const unsigned*)((const char*)(gbase) + voffB[_i]), (LAS unsigned*)(lds + (bufoff) + ldsw + _i * 8192), 16, 0, 0); } while (0)
#define G8_STAGEA(bufoff, gbase, v0, v1) do { \
        __builtin_amdgcn_global_load_lds((const unsigned*)((const char*)(gbase) + (v0)), (LAS unsigned*)(lds + (bufoff) + ldsw), 16, 0, 0); \
        __builtin_amdgcn_global_load_lds((const unsigned*)((const char*)(gbase) + (v1)), (LAS unsigned*)(lds + (bufoff) + ldsw + 8192), 16, 0, 0); } while (0)
#define G8_LDA(dst, b, h) do { _Pragma("unroll") for (int m = 0; m < 4; ++m) _Pragma("unroll") for (int k = 0; k < 2; ++k) dst[m][k] = *(const LAS bf16x8*)(lds + G8_SA(b, h) + aoff + m * 2048 + k * 1024); } while (0)
#define G8_LDB(dst, b, h) do { _Pragma("unroll") for (int n = 0; n < 2; ++n) _Pragma("unroll") for (int k = 0; k < 2; ++k) dst[n][k] = *(const LAS bf16x8*)(lds + G8_SB(b, h) + boff + n * 2048 + k * 1024); } while (0)
#define G8_MMA(ai, bj, At, Bt_) do { __builtin_amdgcn_s_setprio(1); _Pragma("unroll") for (int m = 0; m < 4; ++m) _Pragma("unroll") for (int n = 0; n < 2; ++n) _Pragma("unroll") for (int k = 0; k < 2; ++k) \
        acc[ai][bj][m][n] = __builtin_amdgcn_mfma_f32_16x16x32_bf16(Bt_[n][k], At[m][k], acc[ai][bj][m][n], 0, 0, 0); __builtin_amdgcn_s_setprio(0); } while (0)
#define G8_WAIT_V(n) asm volatile("s_waitcnt vmcnt(" #n ")" ::: "memory")
#define G8_WAIT_L(n) asm volatile("s_waitcnt lgkmcnt(" #n ")" ::: "memory")
#define G8_BAR __builtin_amdgcn_s_barrier()
#define G8_SCHED __builtin_amdgcn_sched_barrier(0)
#define G8_GATHER(u, v) do { if (GATHER) { const int _eb = gi.sm[16 + (u).e], _ec = gi.sm[(u).e]; \
        _Pragma("unroll") for (int _h = 0; _h < 2; ++_h) _Pragma("unroll") for (int _i = 0; _i < 2; ++_i) { const int _s = (u).pm * BM + HALF * _h + Rr[_i] - _eb; \
            const int _t = gi.rowlist[(u).e * NTOK + (_s < _ec ? _s : 0)]; v[_h][_i] = (unsigned)(_t * K + Cc[_i]) * 2u; } } } while (0)
    Unit cur, nxt; int ui = 0;
    if (!S.next(0, cur)) return;
    f32x4 acc[2][2][4][2];
#pragma unroll
    for (int a = 0; a < 2; ++a)
#pragma unroll
        for (int b = 0; b < 2; ++b)
#pragma unroll
            for (int m = 0; m < 4; ++m)
#pragma unroll
                for (int n = 0; n < 2; ++n) acc[a][b][m][n] = (f32x4){0.f, 0.f, 0.f, 0.f};
    bf16x8 At[4][2], B0[2][2], B1[2][2];
    G8_GATHER(cur, vAc);
    const char* cA = GATHER ? (const char*)A : (const char*)A + (size_t)cur.pm * tstepA; const char* cB = (const char*)Bt + (size_t)cur.bt * tstepB;
    G8_STAGEB(G8_SB(0, 0), cB); G8_STAGEB(G8_SB(0, 1), cB + hstepB); G8_STAGEA(G8_SA(0, 0), cA, vAc[0][0], vAc[0][1]); G8_STAGEA(G8_SA(0, 1), cA, vAc[1][0], vAc[1][1]);
    if (wr == 1) G8_BAR;
    G8_WAIT_V(2); G8_BAR;
    G8_STAGEB(G8_SB(1, 0), cB + kstep); G8_STAGEA(G8_SA(1, 0), cA + kstep, vAc[0][0], vAc[0][1]); G8_STAGEB(G8_SB(1, 1), cB + hstepB + kstep);
    G8_WAIT_V(6); G8_BAR;
    for (;;) {
        const bool has_next = S.next(ui + 1, nxt);
        if (has_next) G8_GATHER(nxt, vAn);
        const char* nA = has_next ? (GATHER ? (const char*)A : (const char*)A + (size_t)nxt.pm * tstepA) : cA; const char* nB = has_next ? (const char*)Bt + (size_t)nxt.bt * tstepB : cB;
        for (int t = 0; t < nt; t += 2) {
            const bool last = (t == nt - 2);
            const char* a1 = cA + (size_t)(t + 1) * kstep;
            const char* a2 = last ? nA : cA + (size_t)(t + 2) * kstep; const char* b2 = last ? nB : cB + (size_t)(t + 2) * kstep;
            const char* a3 = a2 + kstep; const char* b3 = b2 + kstep;
            const bool usen = GATHER && last && has_next;
            const unsigned w00 = usen ? vAn[0][0] : vAc[0][0], w01 = usen ? vAn[0][1] : vAc[0][1], w10 = usen ? vAn[1][0] : vAc[1][0], w11 = usen ? vAn[1][1] : vAc[1][1];
            G8_LDB(B0, 0, 0); G8_LDB(B1, 0, 1); G8_SCHED; G8_LDA(At, 0, 0); G8_STAGEA(G8_SA(1, 1), a1, vAc[1][0], vAc[1][1]);
            G8_WAIT_V(8); G8_WAIT_L(0); G8_BAR; G8_MMA(0, 0, At, B0); G8_MMA(0, 1, At, B1); G8_BAR; G8_SCHED;
            G8_LDA(At, 0, 1); G8_STAGEB(G8_SB(0, 0), b2); G8_STAGEB(G8_SB(0, 1), b2 + hstepB); G8_STAGEA(G8_SA(0, 0), a2, w00, w01);
            G8_WAIT_V(8); G8_WAIT_L(0); G8_BAR; G8_MMA(1, 0, At, B0); G8_MMA(1, 1, At, B1); G8_BAR; G8_SCHED;
            G8_LDB(B0, 1, 0); G8_LDB(B1, 1, 1); G8_SCHED; G8_LDA(At, 1, 0); G8_STAGEA(G8_SA(0, 1), a2, w10, w11);
            G8_WAIT_V(8); G8_WAIT_L(0); G8_BAR; G8_MMA(0, 0, At, B0); G8_MMA(0, 1, At, B1); G8_BAR; G8_SCHED;
            G8_LDA(At, 1, 1); G8_STAGEB(G8_SB(1, 0), b3); G8_STAGEB(G8_SB(1, 1), b3 + hstepB); G8_STAGEA(G8_SA(1, 0), a3, w00, w01);
            G8_WAIT_V(8); G8_WAIT_L(0); G8_BAR; G8_MMA(1, 0, At, B0); G8_MMA(1, 1, At, B1); G8_BAR; G8_SCHED;
        }
        if (wr == 0) G8_BAR;
        E(acc, cur, wr, wc, fr, fq);
        if (!has_next) break;
#pragma unroll
        for (int a = 0; a < 2; ++a)
#pragma unroll
            for (int b = 0; b < 2; ++b)
#pragma unroll
                for (int m = 0; m < 4; ++m)
#pragma unroll
                    for (int n = 0; n < 2; ++n) acc[a][b][m][n] = (f32x4){0.f, 0.f, 0.f, 0.f};
        cur = nxt; cA = nA; cB = nB; ++ui;
#pragma unroll
        for (int h = 0; h < 2; ++h)
#pragma unroll
            for (int i = 0; i < 2; ++i) vAc[h][i] = vAn[h][i];
        if (wr == 1) G8_BAR;
    }
    G8_WAIT_V(0);
    G8_BAR;
    if constexpr (Epi::AFTER) E.after(acc, cur, lds, wr, wc, fr, fq, wid, lane);
#undef G8_SA
#undef G8_SB
#undef G8_STAGEA
#undef G8_STAGEB
#undef G8_LDA
#undef G8_LDB
#undef G8_MMA
#undef G8_WAIT_V
#undef G8_WAIT_L
#undef G8_BAR
#undef G8_SCHED
#undef G8_GATHER
}
template <class F> struct EpiEl {
    static constexpr bool AFTER = false;
    F f;
    __device__ __forceinline__ void operator()(const f32x4 (&acc)[2][2][4][2], const Unit& u, int wr, int wc, int fr, int fq) const {
#pragma unroll
        for (int ai = 0; ai < 2; ++ai)
#pragma unroll
            for (int m = 0; m < 4; ++m) { const int row = u.pm * BM + ai * HALF + wr * 64 + m * 16 + fr;
#pragma unroll
                for (int bj = 0; bj < 2; ++bj) f(row, u.pn * BM + bj * HALF + wc * 32 + 8 * fq, acc[ai][bj][m][0], acc[ai][bj][m][1]); }
    }
};
}

struct EpiNsaIn {
    bf16_t* Q; bf16_t* KV; float* gates; const float2* rope;
    __device__ __forceinline__ void operator()(int row, int c, f32x4 v) const {
        const int t = row & (SEQ - 1), b = row >> 13;
        if (c < 1024) {
            v = v * QSCALE;
            const int d = (c & 63) >> 1; const float2 c0 = rope[t * 32 + d], c1 = rope[t * 32 + d + 1];
            bf16_t* p = Q + (size_t)row * DM + (c & ~63);
            *(unsigned*)(p + d) = pk2(v[0] * c0.x - v[1] * c0.y, v[2] * c1.x - v[3] * c1.y);
            *(unsigned*)(p + d + 32) = pk2(v[1] * c0.x + v[0] * c0.y, v[3] * c1.x + v[2] * c1.y);
        } else if (c < 2560) {
            const int s = (c - 1024) >> 8, g = ((c - 1024) >> 6) & 3;
            bf16_t* p = KV + (size_t)s * (KVSEG / 2) + ((size_t)(b * NG + g) * SEQ + t) * DH;
            if (s == 2 || s == 4) {
                const int d = (c & 63) >> 1; const float2 c0 = rope[t * 32 + d], c1 = rope[t * 32 + d + 1];
                *(unsigned*)(p + d) = pk2(v[0] * c0.x - v[1] * c0.y, v[2] * c1.x - v[3] * c1.y);
                *(unsigned*)(p + d + 32) = pk2(v[1] * c0.x + v[0] * c0.y, v[3] * c1.x + v[2] * c1.y);
            } else {
                *(u32x2*)(p + (c & 63)) = (u32x2){pk2(v[0], v[1]), pk2(v[2], v[3])};
            }
        } else if (c < NSA_IN) {
            float* gp = gates + (size_t)row * 48 + (c - 2560);
            *(f32x4*)gp = (f32x4){sigmoidf_(v[0]), sigmoidf_(v[1]), sigmoidf_(v[2]), sigmoidf_(v[3])};
        }
    }
    __device__ __forceinline__ void operator()(int row, int c, f32x4 v, f32x4 w) const {
        const int t = row & (SEQ - 1), b = row >> 13;
        const int s = (c - 1024) >> 8;
        const bool isq = c < 1024, roped = isq || s == 2 || s == 4;
        if (roped) {
            if (isq) { v = v * QSCALE; w = w * QSCALE; }
            const int g = ((c - 1024) >> 6) & 3, d = (c & 63) >> 1;
            bf16_t* p = isq ? Q + (size_t)row * DM + (c & ~63) : KV + (size_t)s * (KVSEG / 2) + ((size_t)(b * NG + g) * SEQ + t) * DH;
            const f32x4 cs01 = *(const f32x4*)(rope + t * 32 + d), cs23 = *(const f32x4*)(rope + t * 32 + d + 2);
            *(u32x2*)(p + d) = (u32x2){pk2(v[0] * cs01[0] - v[1] * cs01[1], v[2] * cs01[2] - v[3] * cs01[3]), pk2(w[0] * cs23[0] - w[1] * cs23[1], w[2] * cs23[2] - w[3] * cs23[3])};
            *(u32x2*)(p + d + 32) = (u32x2){pk2(v[1] * cs01[0] + v[0] * cs01[1], v[3] * cs01[2] + v[2] * cs01[3]), pk2(w[1] * cs23[0] + w[0] * cs23[1], w[3] * cs23[2] + w[2] * cs23[3])};
        } else {
            const int g = ((c - 1024) >> 6) & 3;
            bf16_t* p = KV + (size_t)s * (KVSEG / 2) + ((size_t)(b * NG + g) * SEQ + t) * DH + (c & 63);
            *(u32x4*)p = (u32x4){pk2(v[0], v[1]), pk2(v[2], v[3]), pk2(w[0], w[1]), pk2(w[2], w[3])};
        }
    }
};
struct EpiMobaIn {
    bf16_t* Q; bf16_t* K; bf16_t* V; const float2* rope;
    __device__ __forceinline__ void operator()(int row, int c, f32x4 v) const {
        const int t = row & (SEQ - 1), b = row >> 13;
        if (c < 2048) {
            if (c < 1024) v = v * QSCALE;
            const int d = (c & 63) >> 1; const float2 c0 = rope[t * 32 + d], c1 = rope[t * 32 + d + 1];
            bf16_t* p = c < 1024 ? Q + (size_t)row * DM + (c & ~63) : K + ((size_t)(b * NH + ((c - 1024) >> 6)) * SEQ + t) * DH;
            *(unsigned*)(p + d) = pk2(v[0] * c0.x - v[1] * c0.y, v[2] * c1.x - v[3] * c1.y);
            *(unsigned*)(p + d + 32) = pk2(v[1] * c0.x + v[0] * c0.y, v[3] * c1.x + v[2] * c1.y);
        } else {
            bf16_t* p = V + ((size_t)(b * NH + ((c - 2048) >> 6)) * SEQ + t) * DH + (c & 63);
            *(u32x2*)p = (u32x2){pk2(v[0], v[1]), pk2(v[2], v[3])};
        }
    }
    __device__ __forceinline__ void operator()(int row, int c, f32x4 v, f32x4 w) const {
        const int t = row & (SEQ - 1), b = row >> 13;
        if (c < 2048) {
            if (c < 1024) { v = v * QSCALE; w = w * QSCALE; }
            const int d = (c & 63) >> 1;
            bf16_t* p = c < 1024 ? Q + (size_t)row * DM + (c & ~63) : K + ((size_t)(b * NH + ((c - 1024) >> 6)) * SEQ + t) * DH;
            const f32x4 cs01 = *(const f32x4*)(rope + t * 32 + d), cs23 = *(const f32x4*)(rope + t * 32 + d + 2);
            *(u32x2*)(p + d) = (u32x2){pk2(v[0] * cs01[0] - v[1] * cs01[1], v[2] * cs01[2] - v[3] * cs01[3]), pk2(w[0] * cs23[0] - w[1] * cs23[1], w[2] * cs23[2] - w[3] * cs23[3])};
            *(u32x2*)(p + d + 32) = (u32x2){pk2(v[1] * cs01[0] + v[0] * cs01[1], v[3] * cs01[2] + v[2] * cs01[3]), pk2(w[1] * cs23[0] + w[0] * cs23[1], w[3] * cs23[2] + w[2] * cs23[3])};
        } else {
            bf16_t* p = V + ((size_t)(b * NH + ((c - 2048) >> 6)) * SEQ + t) * DH + (c & 63);
            *(u32x4*)p = (u32x4){pk2(v[0], v[1]), pk2(v[2], v[3]), pk2(w[0], w[1]), pk2(w[2], w[3])};
        }
    }
};
struct EpiCmp {
    static constexpr bool AFTER = true;
    const float* bias; const bf16_t* W2T; const float2* rope; bf16_t* OUT;
    __device__ __forceinline__ void operator()(const f32x4 (&)[2][2][4][2], const g8::Unit&, int, int, int, int) const {}
    __device__ __forceinline__ void after(const f32x4 (&acc)[2][2][4][2], const g8::Unit& u, LAS unsigned char* lds, int wr, int wc, int fr, int fq, int wid, int lane) const {
#pragma unroll
        for (int bj = 0; bj < 2; ++bj) {
            const int c0 = bj * 128 + wc * 32 + 8 * fq;
            const f32x4 bv = *(const f32x4*)(bias + c0), bw = *(const f32x4*)(bias + c0 + 4);
#pragma unroll
            for (int ai = 0; ai < 2; ++ai)
#pragma unroll
                for (int m = 0; m < 4; ++m) { const int row = ai * 128 + wr * 64 + m * 16 + fr; const f32x4 v = acc[ai][bj][m][0] + bv, w = acc[ai][bj][m][1] + bw;
                    *(LAS u32x4*)(lds + row * 528 + c0 * 2) = (u32x4){pk2(gelu_tanh(v[0]), gelu_tanh(v[1])), pk2(gelu_tanh(v[2]), gelu_tanh(v[3])), pk2(gelu_tanh(w[0]), gelu_tanh(w[1])), pk2(gelu_tanh(w[2]), gelu_tanh(w[3]))}; }
        }
        asm volatile("s_waitcnt lgkmcnt(0)\n\ts_barrier" ::: "memory");
        f32x4 o[2][4];
#pragma unroll
        for (int rt = 0; rt < 2; ++rt)
#pragma unroll
            for (int dt = 0; dt < 4; ++dt) o[rt][dt] = (f32x4){0.f, 0.f, 0.f, 0.f};
#pragma unroll
        for (int s8 = 0; s8 < 8; ++s8) {
            bf16x8 hb[2], wa[4];
#pragma unroll
            for (int rt = 0; rt < 2; ++rt) hb[rt] = *(const LAS bf16x8*)(lds + (32 * wid + 16 * rt + fr) * 528 + (32 * s8 + 8 * fq) * 2);
#pragma unroll
            for (int dt = 0; dt < 4; ++dt) wa[dt] = *(const bf16x8*)(W2T + (16 * dt + fr) * 256 + 32 * s8 + 8 * fq);
#pragma unroll
            for (int rt = 0; rt < 2; ++rt)
#pragma unroll
                for (int dt = 0; dt < 4; ++dt) o[rt][dt] = __builtin_amdgcn_mfma_f32_16x16x32_bf16(wa[dt], hb[rt], o[rt][dt], 0, 0, 0);
        }
#pragma unroll
        for (int rt = 0; rt < 2; ++rt) {
            const int rg = u.pm * 256 + 32 * wid + 16 * rt + fr, ci = rg & 511;
            if (rope) {
#pragma unroll
                for (int dt = 0; dt < 2; ++dt) {
                    const f32x4 cs01 = *(const f32x4*)(rope + (16 * ci + 31) * 32 + 16 * dt + 4 * fq), cs23 = *(const f32x4*)(rope + (16 * ci + 31) * 32 + 16 * dt + 4 * fq + 2);
                    const f32x4 lo = o[rt][dt], hi = o[rt][dt + 2];
                    o[rt][dt] = (f32x4){lo[0] * cs01[0] - hi[0] * cs01[1], lo[1] * cs01[2] - hi[1] * cs01[3], lo[2] * cs23[0] - hi[2] * cs23[1], lo[3] * cs23[2] - hi[3] * cs23[3]};
                    o[rt][dt + 2] = (f32x4){hi[0] * cs01[0] + lo[0] * cs01[1], hi[1] * cs01[2] + lo[1] * cs01[3], hi[2] * cs23[0] + lo[2] * cs23[1], hi[3] * cs23[2] + lo[3] * cs23[3]};
                }
            }
            const float z = ci == 511 ? 0.f : 1.f;
#pragma unroll
            for (int dt = 0; dt < 4; ++dt) { const f32x4 x = o[rt][dt] * z; *(u32x2*)(OUT + (size_t)rg * 64 + 16 * dt + 4 * fq) = (u32x2){pk2(x[0], x[1]), pk2(x[2], x[3])}; }
        }
    }
};
struct EpiSwiGLU {
    bf16_t* H;
    __device__ __forceinline__ void operator()(int row, int c, f32x4 v) const {
        const float h0 = v[0] * sigmoidf_(v[0]) * v[1], h1 = v[2] * sigmoidf_(v[2]) * v[3];
        *(unsigned*)(H + (size_t)row * DE + (c >> 1)) = pk2(h0, h1);
    }
    __device__ __forceinline__ void operator()(int row, int c, f32x4 v, f32x4 w) const {
        *(u32x2*)(H + (size_t)row * DE + (c >> 1)) = (u32x2){pk2(v[0] * sigmoidf_(v[0]) * v[1], v[2] * sigmoidf_(v[2]) * v[3]), pk2(w[0] * sigmoidf_(w[0]) * w[1], w[2] * sigmoidf_(w[2]) * w[3])};
    }
};
struct EpiBf16 {
    bf16_t* Y;
    __device__ __forceinline__ void operator()(int row, int c, f32x4 v) const { *(u32x2*)(Y + (size_t)row * DM + c) = (u32x2){pk2(v[0], v[1]), pk2(v[2], v[3])}; }
    __device__ __forceinline__ void operator()(int row, int c, f32x4 v, f32x4 w) const { *(u32x4*)(Y + (size_t)row * DM + c) = (u32x4){pk2(v[0], v[1]), pk2(v[2], v[3]), pk2(w[0], w[1]), pk2(w[2], w[3])}; }
};

struct ExpertMap { int cnt[NE]; int base[NE + 1]; };
__device__ __forceinline__ void load_expert_map(const Ctx& C, int cw, LAS int* sm  ) {
    if (C.tid == 0) {
        const unsigned* ctl = (const unsigned*)(C.ws + WS_CTL); int acc = 0;
        for (int e = 0; e < NE; ++e) { const int c = (int)__hip_atomic_load(ctl + cw + 64 * e, __ATOMIC_RELAXED, __HIP_MEMORY_SCOPE_AGENT); sm[e] = c; sm[16 + e] = acc; acc += (c + 255) & ~255; }
        sm[32] = acc;
    }
    __syncthreads();
}

__device__ __forceinline__ void load_qh(const bf16_t* qp, float (&qh)[64]) {
    const uint4* q4 = (const uint4*)qp;
#pragma unroll
    for (int c = 0; c < 8; ++c) { const uint4 w = q4[c]; qh[8 * c] = bflo(w.x); qh[8 * c + 1] = bfhi(w.x); qh[8 * c + 2] = bflo(w.y); qh[8 * c + 3] = bfhi(w.y);
        qh[8 * c + 4] = bflo(w.z); qh[8 * c + 5] = bfhi(w.z); qh[8 * c + 6] = bflo(w.w); qh[8 * c + 7] = bfhi(w.w); }
}
namespace fa {
constexpr int SLOT = 16384, NSLOT = 4;
constexpr float C2 = 0.125f * 1.4426950408889634f;
constexpr float NEGBIG = -1e30f;
typedef short v4i16 __attribute__((ext_vector_type(4)));
__device__ __forceinline__ void dma_block(LAS unsigned char* slot, const bf16_t* Kg, const bf16_t* Vg, int wave, int lane) {
    { const int key = 8 * wave + (lane >> 3), c = (lane & 7) ^ ((key >> 1) & 7);
      __builtin_amdgcn_global_load_lds((const unsigned*)(Kg + key * 64 + 8 * c), (LAS unsigned*)(slot + wave * 1024), 16, 0, 0); }
    { const int key = 16 * (wave & 3) + (lane >> 2), cp = lane & 3, d = (wave >> 2) * 32 + ((((cp >> 1) ^ ((key >> 2) & 1))) << 4) + ((cp & 1) << 3);
      __builtin_amdgcn_global_load_lds((const unsigned*)(Vg + key * 64 + d), (LAS unsigned*)(slot + 8192 + wave * 1024), 16, 0, 0); }
}
__device__ __forceinline__ unsigned cvt_pk_bf16(float lo, float hi) { const f32x2v v = {lo, hi}; const bf16x2v b = __builtin_convertvector(v, bf16x2v); return __builtin_bit_cast(unsigned, b); }
struct Task { bf16x8 q[2]; int kmin, kmax; float m, l, cinit; f32x4 O[4]; f32x4 L; unsigned fw0; const LAS unsigned* fwp; int imptok; };
template <int FM> __device__ __forceinline__ bool row_flag(const Task& t, int jb) {
    if (FM == 0) return true;
    if (FM == 1) { const unsigned w = t.fwp[jb >> 5]; return ((w >> (jb & 31)) & 1u) != 0u; }
    return ((t.fw0 >> (jb >> 2)) & 1u) != 0u;
}
struct LaneC { int fq, koff0, koff1, voffA, voffB; };
__device__ __forceinline__ LaneC lane_consts(int lane) {
    const int i16 = lane & 15, fq = lane >> 4, kx = (i16 >> 1) & 7, q4 = i16 >> 2, p4 = lane & 3;
    LaneC lc; lc.fq = fq; lc.koff0 = i16 * 128 + ((fq ^ kx) << 4); lc.koff1 = i16 * 128 + (((4 + fq) ^ kx) << 4);
    lc.voffA = 8192 + (4 * fq + q4) * 64 + ((0 ^ (fq & 1)) << 5) + 8 * p4; lc.voffB = 8192 + (4 * fq + q4) * 64 + ((1 ^ (fq & 1)) << 5) + 8 * p4;
    return lc;
}
__device__ __forceinline__ float xrow16_max(float x) {
    auto s = __builtin_amdgcn_permlane16_swap(__float_as_uint(x), __float_as_uint(x), false, false);
    x = fmaxf(__uint_as_float(s[0]), __uint_as_float(s[1]));
    auto t = __builtin_amdgcn_permlane32_swap(__float_as_uint(x), __float_as_uint(x), false, false);
    return fmaxf(__uint_as_float(t[0]), __uint_as_float(t[1]));
}
__device__ __forceinline__ float xrow16_sum(float x) {
    auto s = __builtin_amdgcn_permlane16_swap(__float_as_uint(x), __float_as_uint(x), false, false);
    x = __uint_as_float(s[0]) + __uint_as_float(s[1]);
    auto t = __builtin_amdgcn_permlane32_swap(__float_as_uint(x), __float_as_uint(x), false, false);
    return __uint_as_float(t[0]) + __uint_as_float(t[1]);
}
__device__ __forceinline__ void t_mask(const Task& t, f32x4 (&s)[4], int kb, int fq) {
#pragma unroll
    for (int kt = 0; kt < 4; ++kt)
#pragma unroll
        for (int r = 0; r < 4; ++r) { const int key = kb + 16 * kt + 4 * fq + r; s[kt][r] = (key >= t.kmin && key <= t.kmax) ? s[kt][r] : NEGBIG; }
}
template <int MODE> __device__ __forceinline__ float t_stats(Task& t, f32x4 (&s)[4], bool rf) {
    float bm = fmaxf(fmaxf(fmaxf(s[0][0], s[0][1]), fmaxf(s[0][2], s[0][3])), fmaxf(fmaxf(s[1][0], s[1][1]), fmaxf(s[1][2], s[1][3])));
    bm = fmaxf(bm, fmaxf(fmaxf(fmaxf(s[2][0], s[2][1]), fmaxf(s[2][2], s[2][3])), fmaxf(fmaxf(s[3][0], s[3][1]), fmaxf(s[3][2], s[3][3]))));
    bm = xrow16_max(bm);
    if (!rf) bm = NEGBIG;
    const float mnew = fmaxf(t.m, bm);
    const float alpha = __builtin_amdgcn_exp2f(t.m - mnew);
    t.m = mnew;
    const float msub = (rf && mnew > -1e29f) ? mnew : __builtin_inff();
#pragma unroll
    for (int kt = 0; kt < 4; ++kt) s[kt] = s[kt] - msub;
    if (MODE == 1) t.l *= alpha;
    return alpha;
}
__device__ __forceinline__ void t_exp(f32x4 (&s)[4]) {
#pragma unroll
    for (int kt = 0; kt < 4; ++kt)
#pragma unroll
        for (int r = 0; r < 4; ++r) s[kt][r] = __builtin_amdgcn_exp2f(s[kt][r]);
}
__device__ __forceinline__ float quad_sum(float x) {
    x += __builtin_bit_cast(float, __builtin_amdgcn_mov_dpp(__builtin_bit_cast(int, x), 0xB1, 0xf, 0xf, true));
    x += __builtin_bit_cast(float, __builtin_amdgcn_mov_dpp(__builtin_bit_cast(int, x), 0x4E, 0xf, 0xf, true));
    return x;
}
__device__ __forceinline__ void t_imp(const Task& t, const f32x4 (&s)[4], int kb, int fq, LAS float* impbase) {
    float ga[4], gb[4];
#pragma unroll
    for (int kt = 0; kt < 4; ++kt) { ga[kt] = quad_sum((s[kt][0] + s[kt][1]) + (s[kt][2] + s[kt][3])); gb[kt] = quad_sum(s[kt][3]); }
    if ((t.imptok & 0x10000) == 0) return;
    LAS float* ip = impbase + (t.imptok & 0xffff) * 130 + (kb >> 2) + fq;
#pragma unroll
    for (int kt = 0; kt < 4; ++kt) { ip[4 * kt] = ga[kt]; ip[64 * 130 + 4 * kt] = gb[kt]; }
}
__device__ __forceinline__ bf16x8 t_pack(const f32x4 (&s)[4], int u) {
    u32x4 pw; pw.x = cvt_pk_bf16(s[2 * u][0], s[2 * u][1]); pw.y = cvt_pk_bf16(s[2 * u][2], s[2 * u][3]); pw.z = cvt_pk_bf16(s[2 * u + 1][0], s[2 * u + 1][1]); pw.w = cvt_pk_bf16(s[2 * u + 1][2], s[2 * u + 1][3]);
    return __builtin_bit_cast(bf16x8, pw);
}
template <int MODE, bool DA, bool DB>
__device__ __forceinline__ void do_blk(Task& a, Task& b, bool rfa, bool rfb, bool masked, LAS unsigned char* slot, int kb, LAS float* impbase, const LaneC& lc) {
    f32x4 sa[4], sb[4];
    const float xa = (MODE >= 2) ? (rfa ? a.cinit : -__builtin_inff()) : 0.f, xb = (MODE >= 2) ? (rfb ? b.cinit : -__builtin_inff()) : 0.f;
    const f32x4 ca = (f32x4){xa, xa, xa, xa}, cb = (f32x4){xb, xb, xb, xb};
#pragma unroll
    for (int kt = 0; kt < 4; ++kt) {
        const bf16x8 k0 = *(const LAS bf16x8*)(slot + lc.koff0 + kt * 2048), k1 = *(const LAS bf16x8*)(slot + lc.koff1 + kt * 2048);
        if (DA) { sa[kt] = __builtin_amdgcn_mfma_f32_16x16x32_bf16(k0, a.q[0], ca, 0, 0, 0); sa[kt] = __builtin_amdgcn_mfma_f32_16x16x32_bf16(k1, a.q[1], sa[kt], 0, 0, 0); }
        if (DB) { sb[kt] = __builtin_amdgcn_mfma_f32_16x16x32_bf16(k0, b.q[0], cb, 0, 0, 0); sb[kt] = __builtin_amdgcn_mfma_f32_16x16x32_bf16(k1, b.q[1], sb[kt], 0, 0, 0); }
    }
    if (masked) { if (DA) t_mask(a, sa, kb, lc.fq); if (DB) t_mask(b, sb, kb, lc.fq); }
    if (MODE < 2) {
        float ala = 1.0f, alb = 1.0f;
        if (DA) ala = t_stats<MODE>(a, sa, rfa);
        if (DB) alb = t_stats<MODE>(b, sb, rfb);
        if (MODE == 0) {
            if (__ballot((DA && ala != 1.0f) || (DB && alb != 1.0f)) != 0ull) {
#pragma unroll
                for (int dt = 0; dt < 4; ++dt) { if (DA) a.O[dt] = a.O[dt] * ala; if (DB) b.O[dt] = b.O[dt] * alb; }
                if (DA) a.L = a.L * ala; if (DB) b.L = b.L * alb;
            }
        }
    }
    if (DA) t_exp(sa);
    if (DB) t_exp(sb);
    if (MODE == 1) {
        if (DA) a.l += ((sa[0][0] + sa[0][1]) + (sa[0][2] + sa[0][3])) + ((sa[1][0] + sa[1][1]) + (sa[1][2] + sa[1][3])) + ((sa[2][0] + sa[2][1]) + (sa[2][2] + sa[2][3])) + ((sa[3][0] + sa[3][1]) + (sa[3][2] + sa[3][3]));
        if (DB) b.l += ((sb[0][0] + sb[0][1]) + (sb[0][2] + sb[0][3])) + ((sb[1][0] + sb[1][1]) + (sb[1][2] + sb[1][3])) + ((sb[2][0] + sb[2][1]) + (sb[2][2] + sb[2][3])) + ((sb[3][0] + sb[3][1]) + (sb[3][2] + sb[3][3]));
    }
    if (MODE == 2) { if (DA) t_imp(a, sa, kb, lc.fq, impbase); if (DB) t_imp(b, sb, kb, lc.fq, impbase); }
    if (MODE != 1) {
        const bf16x8 ones = (bf16x8){0x3F80, 0x3F80, 0x3F80, 0x3F80, 0x3F80, 0x3F80, 0x3F80, 0x3F80};
#pragma unroll
        for (int u = 0; u < 2; ++u) {
            bf16x8 pa, pb; if (DA) pa = t_pack(sa, u); if (DB) pb = t_pack(sb, u);
            if (MODE != 2) { if (DA) a.L = __builtin_amdgcn_mfma_f32_16x16x32_bf16(ones, pa, a.L, 0, 0, 0); if (DB) b.L = __builtin_amdgcn_mfma_f32_16x16x32_bf16(ones, pb, b.L, 0, 0, 0); }
#pragma unroll
            for (int dt = 0; dt < 4; ++dt) {
                const int vo = ((dt & 1) ? lc.voffB : lc.voffA) + (dt >> 1) * 4096 + u * 2048;
                const v4i16 a0 = __builtin_amdgcn_ds_read_tr16_b64_v4i16((LAS v4i16*)(slot + vo)), a1 = __builtin_amdgcn_ds_read_tr16_b64_v4i16((LAS v4i16*)(slot + vo + 1024));
                const bf16x8 vf = (bf16x8){a0[0], a0[1], a0[2], a0[3], a1[0], a1[1], a1[2], a1[3]};
                if (DA) a.O[dt] = __builtin_amdgcn_mfma_f32_16x16x32_bf16(vf, pa, a.O[dt], 0, 0, 0);
                if (DB) b.O[dt] = __builtin_amdgcn_mfma_f32_16x16x32_bf16(vf, pb, b.O[dt], 0, 0, 0);
            }
        }
    }
}
template <int MODE, int FM>
__device__ __forceinline__ void flash_loop(LAS unsigned char* ring, const bf16_t* Kg, const bf16_t* Vg, int nblk, Task& Ta, Task& Tb, LAS float* impbase, int wave, int lane) {
    const int i16 = lane & 15, fq = lane >> 4;
    const int kx = (i16 >> 1) & 7;
    const int q4 = i16 >> 2, p4 = lane & 3;
    LaneC lc; lc.fq = fq; lc.koff0 = i16 * 128 + ((fq ^ kx) << 4); lc.koff1 = i16 * 128 + (((4 + fq) ^ kx) << 4);
    lc.voffA = 8192 + (4 * fq + q4) * 64 + ((0 ^ (fq & 1)) << 5) + 8 * p4; lc.voffB = 8192 + (4 * fq + q4) * 64 + ((1 ^ (fq & 1)) << 5) + 8 * p4;
    const int amin = __builtin_amdgcn_readlane(Ta.kmin, 15), amax = __builtin_amdgcn_readlane(Ta.kmax, 0), bmin = __builtin_amdgcn_readlane(Tb.kmin, 15), bmax = __builtin_amdgcn_readlane(Tb.kmax, 0);
#pragma unroll
    for (int j = 0; j < NSLOT - 1; ++j) { const int jj = j < nblk ? j : nblk - 1; dma_block(ring + j * SLOT, Kg + (size_t)jj * 4096, Vg + (size_t)jj * 4096, wave, lane); }
    for (int jb = 0; jb < nblk; ++jb) {
        asm volatile("s_waitcnt vmcnt(4) lgkmcnt(0)\n\ts_barrier" ::: "memory");
        { const int jn = jb + 3 < nblk ? jb + 3 : nblk - 1; dma_block(ring + ((jb + 3) & 3) * SLOT, Kg + (size_t)jn * 4096, Vg + (size_t)jn * 4096, wave, lane); }
        LAS unsigned char* slot = ring + (jb & 3) * SLOT;
        const int kb = jb * 64;
        const bool rfa = row_flag<FM>(Ta, jb), rfb = row_flag<FM>(Tb, jb);
        const bool na = __ballot(rfa && Ta.kmax >= kb && Ta.kmin <= kb + 63) != 0ull, nb2 = __ballot(rfb && Tb.kmax >= kb && Tb.kmin <= kb + 63) != 0ull;
        const bool masked = !((!na || (kb >= amin && kb + 63 <= amax)) && (!nb2 || (kb >= bmin && kb + 63 <= bmax)));
        if (FM == 1) {
            if (na) do_blk<MODE, true, false>(Ta, Tb, rfa, rfb, masked, slot, kb, impbase, lc);
            if (nb2) do_blk<MODE, false, true>(Ta, Tb, rfa, rfb, masked, slot, kb, impbase, lc);
        } else {
            if (na || nb2) do_blk<MODE, true, true>(Ta, Tb, rfa, rfb, masked, slot, kb, impbase, lc);
        }
    }
    asm volatile("s_waitcnt vmcnt(0) lgkmcnt(0)\n\ts_barrier" ::: "memory");
}
template <int MODE, int FM>
__device__ __forceinline__ void flash_loop2(LAS unsigned char* ring, const bf16_t* Kg, const bf16_t* Vg, int nblk, Task& Ta, Task& Tb, LAS float* impbase, int wave, int lane) {
    const int i16 = lane & 15, fq = lane >> 4;
    const int kx = (i16 >> 1) & 7;
    const int q4 = i16 >> 2, p4 = lane & 3;
    LaneC lc; lc.fq = fq; lc.koff0 = i16 * 128 + ((fq ^ kx) << 4); lc.koff1 = i16 * 128 + (((4 + fq) ^ kx) << 4);
    lc.voffA = 8192 + (4 * fq + q4) * 64 + ((0 ^ (fq & 1)) << 5) + 8 * p4; lc.voffB = 8192 + (4 * fq + q4) * 64 + ((1 ^ (fq & 1)) << 5) + 8 * p4;
    const int amin = __builtin_amdgcn_readlane(Ta.kmin, 15), amax = __builtin_amdgcn_readlane(Ta.kmax, 0), bmin = __builtin_amdgcn_readlane(Tb.kmin, 15), bmax = __builtin_amdgcn_readlane(Tb.kmax, 0);
    const int nit = (nblk + 1) >> 1;
#pragma unroll
    for (int j = 0; j < 2; ++j) { const int jj = j < nblk ? j : nblk - 1; dma_block(ring + j * SLOT, Kg + (size_t)jj * 4096, Vg + (size_t)jj * 4096, wave, lane); }
    for (int i = 0; i < nit; ++i) {
        asm volatile("s_waitcnt vmcnt(0) lgkmcnt(0)\n\ts_barrier" ::: "memory");
#pragma unroll
        for (int j = 0; j < 2; ++j) { const int jn = 2 * i + 2 + j < nblk ? 2 * i + 2 + j : nblk - 1; dma_block(ring + ((2 * i + 2 + j) & 3) * SLOT, Kg + (size_t)jn * 4096, Vg + (size_t)jn * 4096, wave, lane); }
        if (FM == 1 && !SEL_FUSED) {
#pragma unroll
        for (int k = 0; k < 2; ++k) {
            const int jb = 2 * i + k;
            if (jb < nblk) {
                LAS unsigned char* slot = ring + (jb & 3) * SLOT;
                const int kb = jb * 64;
                const bool rfa = row_flag<FM>(Ta, jb), rfb = row_flag<FM>(Tb, jb);
                const bool na = __ballot(rfa && Ta.kmax >= kb && Ta.kmin <= kb + 63) != 0ull, nb2 = __ballot(rfb && Tb.kmax >= kb && Tb.kmin <= kb + 63) != 0ull;
                const bool masked = !((!na || (kb >= amin && kb + 63 <= amax)) && (!nb2 || (kb >= bmin && kb + 63 <= bmax)));
                if (na) do_blk<MODE, true, false>(Ta, Tb, rfa, rfb, masked, slot, kb, impbase, lc);
                if (nb2) do_blk<MODE, false, true>(Ta, Tb, rfa, rfb, masked, slot, kb, impbase, lc);
            }
        }
        } else {
            const int j0 = 2 * i, j1 = 2 * i + 1;
            const bool ra0 = row_flag<FM>(Ta, j0), rb0 = row_flag<FM>(Tb, j0), ra1 = j1 < nblk && row_flag<FM>(Ta, j1), rb1 = j1 < nblk && row_flag<FM>(Tb, j1);
            if (__ballot(ra0 || rb0 || ra1 || rb1) != 0ull) {
                const int k0 = j0 * 64, k1 = j1 * 64;
                const bool mk = (FM == 0) && !(k0 >= amin && k1 + 63 <= amax && k0 >= bmin && k1 + 63 <= bmax);
                if (!mk) {
                    do_blk<MODE, true, true>(Ta, Tb, ra0, rb0, false, ring + (j0 & 3) * SLOT, k0, impbase, lc);
                    if (FM == 0) __builtin_amdgcn_sched_barrier(0);
                    do_blk<MODE, true, true>(Ta, Tb, ra1, rb1, false, ring + (j1 & 3) * SLOT, k1, impbase, lc);
                } else {
                    do_blk<MODE, true, true>(Ta, Tb, ra0, rb0, true, ring + (j0 & 3) * SLOT, k0, impbase, lc);
                    __builtin_amdgcn_sched_barrier(0);
                    do_blk<MODE, true, true>(Ta, Tb, ra1, rb1, true, ring + (j1 & 3) * SLOT, k1, impbase, lc);
                }
            }
        }
    }
    asm volatile("s_waitcnt vmcnt(0) lgkmcnt(0)\n\ts_barrier" ::: "memory");
}
__device__ __forceinline__ void task_reset(Task& t) { t.m = NEGBIG; t.l = 0.f; t.cinit = 0.f; t.L = (f32x4){0.f, 0.f, 0.f, 0.f};
#pragma unroll
    for (int dt = 0; dt < 4; ++dt) t.O[dt] = (f32x4){0.f, 0.f, 0.f, 0.f}; }
__device__ __forceinline__ float task_rowsum(const Task& t) { return t.L[0]; }
__device__ __forceinline__ float task_rowsum_stats(const Task& t) { return xrow16_sum(t.l); }
constexpr float REF_DELTA = 32.f;
__device__ __forceinline__ void task_fix_ref(Task& t) {
    t.cinit = -(t.m + REF_DELTA);
    const float sc = __builtin_amdgcn_exp2f(-REF_DELTA);
    t.L = t.L * sc;
#pragma unroll
    for (int dt = 0; dt < 4; ++dt) t.O[dt] = t.O[dt] * sc;
}
}

struct NsaRow { int RI, c, b; u32x2 out[4];
    __device__ __forceinline__ int tokl() const { return RI >> 2; }
    __device__ __forceinline__ int head() const { return RI & 3; }
    __device__ __forceinline__ int tt() const { return 64 * c + (RI >> 2); }
    __device__ __forceinline__ size_t grow() const { return (size_t)(b * SEQ + 64 * c + (RI >> 2)); }
};
__device__ __forceinline__ void nsa_row_init(NsaRow& r, fa::Task& t, const bf16_t* Q, int b, int g, int c, int R, int fq) {
    r.RI = R; r.c = c; r.b = b;
    const bf16_t* qp = Q + r.grow() * DM + (g * 4 + r.head()) * DH + 8 * fq;
    t.q[0] = *(const bf16x8*)qp; t.q[1] = *(const bf16x8*)(qp + 32);
    t.imptok = r.tokl() | (r.head() == 0 ? 0x10000 : 0); t.fw0 = 0u; t.fwp = nullptr;
#pragma unroll
    for (int dt = 0; dt < 4; ++dt) r.out[dt] = (u32x2){0u, 0u};
}
__device__ __forceinline__ void nsa_cmp_setup(const NsaRow& r, fa::Task& t) {
    const int tt_ = r.tt(); const int nv = tt_ >= 31 ? (((tt_ - 31) >> 4) + 1 > 511 ? 511 : ((tt_ - 31) >> 4) + 1) : 0;
    t.kmin = 0; t.kmax = nv - 1; fa::task_reset(t);
}
__device__ __forceinline__ void nsa_accum(NsaRow& r, const fa::Task& t, float sc) {
#pragma unroll
    for (int dt = 0; dt < 4; ++dt) { const f32x4 o = t.O[dt] * sc; const u32x2 w = r.out[dt];
        r.out[dt] = (u32x2){pk2(bflo(w.x) + o[0], bfhi(w.x) + o[1]), pk2(bflo(w.y) + o[2], bfhi(w.y) + o[3])}; }
}
__device__ __forceinline__ void nsa_store(const NsaRow& r, bf16_t* AO, int g, int fq) {
    bf16_t* op = AO + r.grow() * DM + (g * 4 + r.head()) * DH + 4 * fq;
#pragma unroll
    for (int dt = 0; dt < 4; ++dt) *(u32x2*)(op + 16 * dt) = r.out[dt];
}
__device__ __forceinline__ void ph_nsa_fa(const Ctx& C) {
    LAS unsigned char* L = (LAS unsigned char*)C.lds;
    LAS unsigned char* ring = L;
    LAS float* imp = (LAS float*)(L + 65536);
    LAS unsigned* selm = (LAS unsigned*)(L + 135168);
    const bf16_t* Q = (const bf16_t*)(C.ws + WS_Q); const bf16_t* KC = (const bf16_t*)(C.ws + WS_KC); const bf16_t* VC = (const bf16_t*)(C.ws + WS_VC);
    const bf16_t* KS = (const bf16_t*)(C.ws + WS_KV0 + 2 * KVSEG); const bf16_t* VS = (const bf16_t*)(C.ws + WS_KV0 + 3 * KVSEG);
    const bf16_t* KW = (const bf16_t*)(C.ws + WS_KV0 + 4 * KVSEG); const bf16_t* VW = (const bf16_t*)(C.ws + WS_KV0 + 5 * KVSEG);
    const float* gates = (const float*)(C.ws + WS_GATES); bf16_t* AO = (bf16_t*)(C.ws + WS_Q);
    const int wave = C.wave;
    for (int u = C.bid; u < NB * NG * (SEQ / 64); u += C.nb) {
        int lane = C.lane; asm volatile("" : "+v"(lane));
        const int i16 = lane & 15, fq = lane >> 4;
        const int rnd = u / C.nb, idx = (u % C.nb) >> 4, bg = u & 15, b = bg >> 2, g = bg & 3;
        const int c = (C.nb == 256) ? 127 - 16 * rnd - ((rnd & 1) ? 15 - idx : idx) : 127 - (u >> 4);
        fa::Task T0, T1; NsaRow R0, R1;
        nsa_row_init(R0, T0, Q, b, g, c, 32 * wave + i16, fq);
        nsa_row_init(R1, T1, Q, b, g, c, 32 * wave + 16 + i16, fq);
        for (int i = C.tid; i < 2 * 64 * 130; i += NTHREADS) imp[i] = 0.f;
        if (C.tid < 256) selm[C.tid] = 0u;
        const int nvm = ((64 * c + 63 - 31) >> 4) + 1;
        const int nvmax = nvm > 511 ? 511 : nvm;
        const int nblkc = (nvmax + 63) >> 6;
        nsa_cmp_setup(R0, T0); nsa_cmp_setup(R1, T1);
        fa::flash_loop<1, 0>(ring, KC + (size_t)bg * 512 * DH, VC + (size_t)bg * 512 * DH, nblkc, T0, T1, imp, wave, lane);
        { const float l0 = fa::task_rowsum_stats(T0), l1 = fa::task_rowsum_stats(T1);
          T0.cinit = l0 > 0.f ? -T0.m - __builtin_amdgcn_logf(l0) : -__builtin_inff(); T1.cinit = l1 > 0.f ? -T1.m - __builtin_amdgcn_logf(l1) : -__builtin_inff(); }
        fa::flash_loop<2, 0>(ring, KC + (size_t)bg * 512 * DH, VC + (size_t)bg * 512 * DH, nblkc, T0, T1, imp, wave, lane);
        nsa_accum(R0, T0, gates[R0.grow() * 48 + g * 4 + R0.head()]);
        nsa_accum(R1, T1, gates[R1.grow() * 48 + g * 4 + R1.head()]);
        {
            const int jq = c, ncand = jq - 2 > 0 ? jq - 2 : 0, nforced = jq == 0 ? 1 : (jq == 1 ? 2 : 3), need = 16 - nforced;
#pragma unroll
            for (int g2 = 0; g2 < 2; ++g2) {
                const int tk = 8 * wave + 4 * g2 + (lane >> 4);
                unsigned key[8]; unsigned selb = 0u;
#pragma unroll
                for (int k = 0; k < 8; ++k) { const int j = i16 + 16 * k; const bool cand = j >= 1 && j <= jq - 2;
                    key[k] = cand ? ((__float_as_uint(imp[tk * 130 + j] + imp[64 * 130 + tk * 130 + j - 1]) & 0xFFFFFF80u) | (unsigned)(127 - j)) : 0u; }
                if (ncand <= need) {
#pragma unroll
                    for (int k = 0; k < 8; ++k) selb |= (key[k] != 0u) ? (1u << k) : 0u;
                } else {
                    for (int r = 0; r < need; ++r) {
                        unsigned m = max(max(max(key[0], key[1]), max(key[2], key[3])), max(max(key[4], key[5]), max(key[6], key[7])));
                        m = max(m, (unsigned)__builtin_amdgcn_mov_dpp((int)m, 0xB1, 0xf, 0xf, true));
                        m = max(m, (unsigned)__builtin_amdgcn_mov_dpp((int)m, 0x4E, 0xf, 0xf, true));
                        m = max(m, (unsigned)__builtin_amdgcn_mov_dpp((int)m, 0x141, 0xf, 0xf, true));
                        m = max(m, (unsigned)__builtin_amdgcn_mov_dpp((int)m, 0x140, 0xf, 0xf, true));
#pragma unroll
                        for (int k = 0; k < 8; ++k) { const bool hit = key[k] == m; selb |= hit ? (1u << k) : 0u; key[k] = hit ? 0u : key[k]; }
                    }
                }
#pragma unroll
                for (int k = 0; k < 8; ++k) { const int j = i16 + 16 * k; if (j == 0 || j == jq || j == jq - 1) selb |= 1u << k; }
#pragma unroll
                for (int w2 = 0; w2 < 4; ++w2) {
                    const unsigned bits = (((selb >> (2 * w2)) & 1u) << i16) | (((selb >> (2 * w2 + 1)) & 1u) << (16 + i16));
                    if (bits) __hip_atomic_fetch_or(selm + tk * 4 + w2, bits, __ATOMIC_RELAXED, __HIP_MEMORY_SCOPE_WORKGROUP);
                }
            }
        }
        asm volatile("s_waitcnt lgkmcnt(0)\n\ts_barrier" ::: "memory");
        {
            const int jlo = c - 8 > 0 ? c - 8 : 0;
            T0.kmin = 0; T0.kmax = R0.tokl(); fa::task_reset(T0); T1.kmin = 0; T1.kmax = R1.tokl(); fa::task_reset(T1);
            fa::flash_loop<0, 0>(ring, KW + ((size_t)bg * SEQ + 64 * c) * DH, VW + ((size_t)bg * SEQ + 64 * c) * DH, 1, T0, T1, imp, wave, lane);
            fa::task_fix_ref(T0); fa::task_fix_ref(T1);
            T0.kmin = R0.tt() - 511 - 64 * jlo; T0.kmax = R0.tt() - 64 * jlo; T1.kmin = R1.tt() - 511 - 64 * jlo; T1.kmax = R1.tt() - 64 * jlo;
            if (c > jlo) fa::flash_loop2<3, 0>(ring, KW + ((size_t)bg * SEQ + 64 * jlo) * DH, VW + ((size_t)bg * SEQ + 64 * jlo) * DH, c - jlo, T0, T1, imp, wave, lane);
            const float l0 = fa::task_rowsum(T0), l1 = fa::task_rowsum(T1);
            nsa_accum(R0, T0, (l0 > 0.f ? 1.0f / l0 : 0.f) * gates[R0.grow() * 48 + 32 + g * 4 + R0.head()]);
            nsa_accum(R1, T1, (l1 > 0.f ? 1.0f / l1 : 0.f) * gates[R1.grow() * 48 + 32 + g * 4 + R1.head()]);
        }
        {
            T0.fwp = selm + R0.tokl() * 4; T1.fwp = selm + R1.tokl() * 4;
            T0.kmin = 0; T0.kmax = R0.tokl(); fa::task_reset(T0); T1.kmin = 0; T1.kmax = R1.tokl(); fa::task_reset(T1);
            fa::flash_loop<0, 0>(ring, KS + ((size_t)bg * SEQ + 64 * c) * DH, VS + ((size_t)bg * SEQ + 64 * c) * DH, 1, T0, T1, imp, wave, lane);
            T0.kmax = R0.tt(); T1.kmax = R1.tt(); fa::task_fix_ref(T0); fa::task_fix_ref(T1);
            if (c > 0) fa::flash_loop2<3, 1>(ring, KS + (size_t)bg * SEQ * DH, VS + (size_t)bg * SEQ * DH, c, T0, T1, imp, wave, lane);
            const float l0 = fa::task_rowsum(T0), l1 = fa::task_rowsum(T1);
            nsa_accum(R0, T0, (l0 > 0.f ? 1.0f / l0 : 0.f) * gates[R0.grow() * 48 + 16 + g * 4 + R0.head()]);
            nsa_accum(R1, T1, (l1 > 0.f ? 1.0f / l1 : 0.f) * gates[R1.grow() * 48 + 16 + g * 4 + R1.head()]);
        }
        nsa_store(R0, AO, g, fq); nsa_store(R1, AO, g, fq);
    }
}

__device__ __forceinline__ void ph_moba_fa(const Ctx& C) {
    LAS unsigned char* L = (LAS unsigned char*)C.lds;
    LAS unsigned char* ring = L;
    LAS unsigned char* kmt = L + 65536;
    LAS float* kms = (LAS float*)(L + 65536);
    const bf16_t* Q = (const bf16_t*)(C.ws + WS_Q); const bf16_t* K1 = (const bf16_t*)(C.ws + WS_K1); const bf16_t* V1 = (const bf16_t*)(C.ws + WS_V1);
    const float* KM = (const float*)(C.ws + WS_KMEAN); bf16_t* AO = (bf16_t*)(C.ws + WS_Q);
    const int wave = C.wave;
    for (int u = C.bid; u < NB * NH * 32; u += C.nb) {
        int lane = C.lane; asm volatile("" : "+v"(lane));
        const int i16 = lane & 15, fq = lane >> 4;
        const int rnd = u / C.nb, idx = (u % C.nb) >> 6, bh = u & 63, b = bh >> 4, h = bh & 15;
        const int cb = (C.nb == 256) ? 31 - 4 * rnd - ((rnd & 1) ? 3 - idx : idx) : 31 - (u >> 6);
        if (C.tid < 256) {
            const int n = C.tid >> 3, c8 = C.tid & 7;
            const f32x4 a = *(const f32x4*)(KM + (size_t)bh * 2048 + n * 64 + 8 * c8), b2 = *(const f32x4*)(KM + (size_t)bh * 2048 + n * 64 + 8 * c8 + 4);
            u32x4 hi, lo;
            hi.x = pk2(a[0], a[1]); hi.y = pk2(a[2], a[3]); hi.z = pk2(b2[0], b2[1]); hi.w = pk2(b2[2], b2[3]);
            lo.x = pk2(a[0] - bflo(hi.x), a[1] - bfhi(hi.x)); lo.y = pk2(a[2] - bflo(hi.y), a[3] - bfhi(hi.y)); lo.z = pk2(b2[0] - bflo(hi.z), b2[1] - bfhi(hi.z)); lo.w = pk2(b2[2] - bflo(hi.w), b2[3] - bfhi(hi.w));
            const int off = n * 128 + ((c8 ^ ((n >> 1) & 7)) << 4);
            *(LAS u32x4*)(kmt + off) = hi; *(LAS u32x4*)(kmt + 4096 + off) = lo;
        }
        asm volatile("s_waitcnt vmcnt(0) lgkmcnt(0)\n\ts_barrier" ::: "memory");
        fa::Task T[2]; int tt[2];
#pragma unroll
        for (int ti = 0; ti < 2; ++ti) {
            const int R = 32 * wave + 16 * ti + i16; tt[ti] = 256 * cb + R; T[ti].imptok = 0;
            const bf16_t* qp = Q + (size_t)(b * SEQ + tt[ti]) * DM + h * DH + 8 * fq;
            T[ti].q[0] = *(const bf16x8*)qp; T[ti].q[1] = *(const bf16x8*)(qp + 32);
            T[ti].kmin = 0; T[ti].kmax = tt[ti]; fa::task_reset(T[ti]);
            const int kx = (i16 >> 1) & 7, ko0 = i16 * 128 + ((fq ^ kx) << 4), ko1 = i16 * 128 + (((4 + fq) ^ kx) << 4);
            float bv0 = -3e38f, bv1 = -3e38f, bv2 = -3e38f; int j0 = 99, j1 = 99, j2 = 99;
#define INS3(a, n) do { if ((a) > bv0 || ((a) == bv0 && (n) < j0)) { bv2 = bv1; j2 = j1; bv1 = bv0; j1 = j0; bv0 = (a); j0 = (n); } \
                else if ((a) > bv1 || ((a) == bv1 && (n) < j1)) { bv2 = bv1; j2 = j1; bv1 = (a); j1 = (n); } \
                else if ((a) > bv2 || ((a) == bv2 && (n) < j2)) { bv2 = (a); j2 = (n); } } while (0)
#pragma unroll
            for (int kt2 = 0; kt2 < 2; ++kt2) {
                const bf16x8 h0 = *(const LAS bf16x8*)(kmt + ko0 + kt2 * 2048), h1 = *(const LAS bf16x8*)(kmt + ko1 + kt2 * 2048);
                const bf16x8 l0 = *(const LAS bf16x8*)(kmt + 4096 + ko0 + kt2 * 2048), l1 = *(const LAS bf16x8*)(kmt + 4096 + ko1 + kt2 * 2048);
                f32x4 g = __builtin_amdgcn_mfma_f32_16x16x32_bf16(l0, T[ti].q[0], (f32x4){0.f, 0.f, 0.f, 0.f}, 0, 0, 0);
                g = __builtin_amdgcn_mfma_f32_16x16x32_bf16(l1, T[ti].q[1], g, 0, 0, 0);
                g = __builtin_amdgcn_mfma_f32_16x16x32_bf16(h0, T[ti].q[0], g, 0, 0, 0);
                g = __builtin_amdgcn_mfma_f32_16x16x32_bf16(h1, T[ti].q[1], g, 0, 0, 0);
#pragma unroll
                for (int r = 0; r < 4; ++r) { const int n = 16 * kt2 + 4 * fq + r; const float a = n < cb ? g[r] : -3e38f; INS3(a, n); }
            }
#pragma unroll
            for (int o = 16; o <= 32; o <<= 1) {
                const float ov0 = __shfl_xor(bv0, o), ov1 = __shfl_xor(bv1, o), ov2 = __shfl_xor(bv2, o); const int oj0 = __shfl_xor(j0, o), oj1 = __shfl_xor(j1, o), oj2 = __shfl_xor(j2, o);
                INS3(ov0, oj0); INS3(ov1, oj1); INS3(ov2, oj2);
            }
#undef INS3
            unsigned mk = 1u << cb;
            if (j0 < cb && bv0 > -1e38f) mk |= 1u << j0; if (j1 < cb && bv1 > -1e38f) mk |= 1u << j1; if (j2 < cb && bv2 > -1e38f) mk |= 1u << j2;
            T[ti].fw0 = mk;
        }
#pragma unroll
        for (int ti = 0; ti < 2; ++ti) { T[ti].kmax = tt[ti] - 256 * cb; }
        fa::flash_loop<0, 0>(ring, K1 + ((size_t)bh * SEQ + 256 * cb) * DH, V1 + ((size_t)bh * SEQ + 256 * cb) * DH, 4, T[0], T[1], kms, wave, lane);
#pragma unroll
        for (int ti = 0; ti < 2; ++ti) { T[ti].kmax = tt[ti]; fa::task_fix_ref(T[ti]); }
        if (cb > 0) fa::flash_loop2<3, 2>(ring, K1 + (size_t)bh * SEQ * DH, V1 + (size_t)bh * SEQ * DH, 4 * cb, T[0], T[1], kms, wave, lane);
#pragma unroll
        for (int ti = 0; ti < 2; ++ti) { const float l = fa::task_rowsum(T[ti]); const float sc_ = l > 0.f ? 1.0f / l : 0.f;
            bf16_t* op = AO + (size_t)(b * SEQ + tt[ti]) * DM + h * DH + 4 * fq;
#pragma unroll
            for (int dt = 0; dt < 4; ++dt) { const f32x4 o = T[ti].O[dt] * sc_; *(u32x2*)(op + 16 * dt) = (u32x2){pk2(o[0], o[1]), pk2(o[2], o[3])}; } }
    }
}

struct Route { int e0, s0, e1, s1; float w0, w1; int pad0, pad1; };
__device__ __forceinline__ void ph_ln_route(const Ctx& C, int layer) {
    const float* resid = C.in[I_X]; const bf16_t* residb = (const bf16_t*)(C.ws + WS_XB)  ; const bf16_t* MIX = (const bf16_t*)(C.ws + WS_MIX);
    bf16_t* X1B = (bf16_t*)(C.ws + WS_X1B); Route* RT = (Route*)(C.ws + WS_ROUTE);
    int* rowlist = (int*)(C.ws + WS_ROWLIST); unsigned* cnt = (unsigned*)(C.ws + WS_CTL) + (layer ? CW_CNT1 : CW_CNT0);
    const float* lg = C.in[I_LNG] + (size_t)(layer * 2 + 0) * DM; const float* lb = C.in[I_LNB] + (size_t)(layer * 2 + 0) * DM;
    const float* rw = C.in[I_RW]; const float* rb = C.in[I_RB];
    LAS unsigned* lcnt = (LAS unsigned*)C.lds;
    LAS float* rec = (LAS float*)(C.lds + 256);
    LAS float* lsb = (LAS float*)(C.lds + 4096 + C.wave * 512);
    const int lane = C.lane;
    LAS unsigned char* rwl = (LAS unsigned char*)(C.lds + 8192);
    for (int gi = C.tid; gi < DM * NE / 4; gi += NTHREADS) { const int c = gi >> 2, e4 = gi & 3;
        *(LAS f32x4*)(rwl + (c >> 8) * 17408 + ((c & 255) >> 2) * 272 + (c & 3) * 64 + e4 * 16) = ((const f32x4*)rw)[gi]; }
    __syncthreads();
    for (int chunk = C.bid; chunk < NTOK / 128; chunk += C.nb) {
        if (C.tid < 16) lcnt[C.tid] = 0u;
        __syncthreads();
        for (int i2 = 0; i2 < 8; ++i2) {
            const int rl0 = C.wave * 16 + i2 * 2, row0 = chunk * 128 + rl0;
            f32x4 v[2][4]; float s[2], s2[2];
#pragma unroll
            for (int r = 0; r < 2; ++r) { const f32x4* xr = (const f32x4*)(resid + (size_t)(row0 + r) * DM) + lane; const u32x2* xb = (const u32x2*)(residb + (size_t)(row0 + r) * DM) + lane;
                const u32x2* mr = (const u32x2*)(MIX + (size_t)(row0 + r) * DM) + lane; s[r] = 0.f;
#pragma unroll
                for (int j = 0; j < 4; ++j) { const u32x2 w = mr[64 * j]; f32x4 xv;
                    if (layer) { const u32x2 q = xb[64 * j]; xv = (f32x4){bflo(q.x), bfhi(q.x), bflo(q.y), bfhi(q.y)}; } else xv = xr[64 * j];
                    v[r][j] = xv * DN_ALPHA + (f32x4){bflo(w.x), bfhi(w.x), bflo(w.y), bfhi(w.y)};
                    s[r] += (v[r][j][0] + v[r][j][1]) + (v[r][j][2] + v[r][j][3]); } }
#pragma unroll
            for (int o = 1; o < 64; o <<= 1) { s[0] += __shfl_xor(s[0], o); s[1] += __shfl_xor(s[1], o); }
#pragma unroll
            for (int r = 0; r < 2; ++r) { const float mean = s[r] * (1.f / DM); s2[r] = 0.f;
#pragma unroll
                for (int j = 0; j < 4; ++j) { v[r][j] = v[r][j] - mean; s2[r] += (v[r][j][0] * v[r][j][0] + v[r][j][1] * v[r][j][1]) + (v[r][j][2] * v[r][j][2] + v[r][j][3] * v[r][j][3]); } }
#pragma unroll
            for (int o = 1; o < 64; o <<= 1) { s2[0] += __shfl_xor(s2[0], o); s2[1] += __shfl_xor(s2[1], o); }
            const float rstd0 = 1.f / sqrtf(s2[0] * (1.f / DM) + LN_EPS), rstd1 = 1.f / sqrtf(s2[1] * (1.f / DM) + LN_EPS);
            float p[32];
#pragma unroll
            for (int q = 0; q < 32; ++q) p[q] = 0.f;
#pragma unroll
            for (int j = 0; j < 4; ++j) {
                const int c0 = 4 * lane + 256 * j;
                const f32x4 gg = *(const f32x4*)(lg + c0), bb = *(const f32x4*)(lb + c0);
#pragma unroll
                for (int r = 0; r < 2; ++r) {
                    v[r][j] = v[r][j] * (r ? rstd1 : rstd0) * gg + bb;
                    *(u32x2*)(X1B + (size_t)(row0 + r) * DM + c0) = (u32x2){pk2(v[r][j][0], v[r][j][1]), pk2(v[r][j][2], v[r][j][3])}; }
#pragma unroll
                for (int q = 0; q < 4; ++q) {
                    const LAS f32x4* wr = (const LAS f32x4*)(rwl + j * 17408 + lane * 272 + q * 64);
                    const f32x4 w0 = wr[0], w1 = wr[1], w2 = wr[2], w3 = wr[3];
#pragma unroll
                    for (int r = 0; r < 2; ++r) { const float x = v[r][j][q];
                        p[16 * r + 0] += x * w0[0]; p[16 * r + 1] += x * w0[1]; p[16 * r + 2] += x * w0[2]; p[16 * r + 3] += x * w0[3];
                        p[16 * r + 4] += x * w1[0]; p[16 * r + 5] += x * w1[1]; p[16 * r + 6] += x * w1[2]; p[16 * r + 7] += x * w1[3];
                        p[16 * r + 8] += x * w2[0]; p[16 * r + 9] += x * w2[1]; p[16 * r + 10] += x * w2[2]; p[16 * r + 11] += x * w2[3];
                        p[16 * r + 12] += x * w3[0]; p[16 * r + 13] += x * w3[1]; p[16 * r + 14] += x * w3[2]; p[16 * r + 15] += x * w3[3]; }
                    if (q == 3) asm volatile("" ::: "memory");
                }
            }
#define TRED(N, M) { const bool up = (lane & (M)) != 0; _Pragma("unroll") for (int q = 0; q < (N); ++q) { const float keep = up ? p[q + (N)] : p[q], send = up ? p[q] : p[q + (N)]; p[q] = keep + __shfl_xor(send, (M)); } }
            TRED(16, 32) TRED(8, 16) TRED(4, 8) TRED(2, 4) TRED(1, 2)
#undef TRED
            p[0] += __shfl_xor(p[0], 1);
            const float sc_own = 1.0f / (1.0f + expf(-p[0]));
            if ((lane & 1) == 0) { lsb[lane >> 1] = sc_own; lsb[32 + (lane >> 1)] = sc_own + rb[(lane >> 1) & 15]; }
            WAVE_LDS_SYNC();
            float sc[16], bi[16];
            { const LAS f32x4* a4 = (const LAS f32x4*)(lsb + ((lane >> 5) << 4)); const LAS f32x4* b4 = (const LAS f32x4*)(lsb + 32 + ((lane >> 5) << 4));
#pragma unroll
              for (int q = 0; q < 4; ++q) { const f32x4 x = a4[q], y = b4[q]; sc[4 * q] = x[0]; sc[4 * q + 1] = x[1]; sc[4 * q + 2] = x[2]; sc[4 * q + 3] = x[3]; bi[4 * q] = y[0]; bi[4 * q + 1] = y[1]; bi[4 * q + 2] = y[2]; bi[4 * q + 3] = y[3]; } }
            WAVE_LDS_SYNC();
            int gsel = 0; float gbest = -3e38f;
#pragma unroll
            for (int gq = 0; gq < 4; ++gq) {
                float m1 = -3e38f, m2 = -3e38f;
#pragma unroll
                for (int q = 0; q < 4; ++q) { const float x = bi[4 * gq + q]; if (x > m1) { m2 = m1; m1 = x; } else if (x > m2) m2 = x; }
                const float gs = m1 + m2; if (gs > gbest) { gbest = gs; gsel = gq; }
            }
            int e0 = 0, e1 = 0; float b0 = -3e38f, b1 = -3e38f, w0 = 0.f, w1 = 0.f;
#pragma unroll
            for (int e = 0; e < 16; ++e) {
                if ((e >> 2) == gsel) {
                    const float x = bi[e];
                    if (x > b0) { b1 = b0; e1 = e0; w1 = w0; b0 = x; e0 = e; w0 = sc[e]; }
                    else if (x > b1) { b1 = x; e1 = e; w1 = sc[e]; }
                }
            }
            if ((lane & 31) == 0) {
                const int rl = rl0 + (lane >> 5);
                const float ws_ = w0 + w1;
                const unsigned l0 = __hip_atomic_fetch_add(lcnt + e0, 1u, __ATOMIC_RELAXED, __HIP_MEMORY_SCOPE_WORKGROUP), l1 = __hip_atomic_fetch_add(lcnt + e1, 1u, __ATOMIC_RELAXED, __HIP_MEMORY_SCOPE_WORKGROUP);
                LAS float* r = rec + rl * 6; r[0] = __int_as_float(e0); r[1] = __int_as_float(e1); r[2] = __uint_as_float(l0); r[3] = __uint_as_float(l1); r[4] = w0 / ws_; r[5] = w1 / ws_;
            }
        }
        __syncthreads();
        if (C.tid < 16) lcnt[16 + C.tid] = atomicAdd(cnt + 64 * C.tid, lcnt[C.tid]);
        __syncthreads();
        if (C.tid < 128) {
            const LAS float* r = rec + C.tid * 6; const int row = chunk * 128 + C.tid;
            const int e0 = __float_as_int(r[0]), e1 = __float_as_int(r[1]);
            const int s0 = (int)(lcnt[16 + e0] + __float_as_uint(r[2])), s1 = (int)(lcnt[16 + e1] + __float_as_uint(r[3]));
            rowlist[e0 * NTOK + s0] = row; rowlist[e1 * NTOK + s1] = row;
            Route rr; rr.e0 = e0; rr.s0 = s0; rr.e1 = e1; rr.s1 = s1; rr.w0 = r[4]; rr.w1 = r[5]; rr.pad0 = 0; rr.pad1 = 0;
            RT[row] = rr;
        }
        __syncthreads();
    }
}
__device__ __forceinline__ void ph_combine(const Ctx& C, int layer, float* outp, LAS int* sm) {
    const bf16_t* X1B = (const bf16_t*)(C.ws + WS_X1B); const bf16_t* Y2 = (const bf16_t*)(C.ws + WS_Y2); const Route* RT = (const Route*)(C.ws + WS_ROUTE);
    bf16_t* XB = (bf16_t*)(C.ws + WS_XB);
    const float* lg = C.in[I_LNG] + (size_t)(layer * 2 + 1) * DM; const float* lb = C.in[I_LNB] + (size_t)(layer * 2 + 1) * DM;
    const int gw = C.bid * NWAVES + C.wave, NGW = C.nb * NWAVES, lane = C.lane;
    for (int row = gw; row < NTOK; row += NGW) {
        const Route r = RT[row];
        const bf16_t* y0 = Y2 + (size_t)(sm[16 + r.e0] + r.s0) * DM; const bf16_t* y1 = Y2 + (size_t)(sm[16 + r.e1] + r.s1) * DM;
        const u32x2* xr = (const u32x2*)(X1B + (size_t)row * DM) + lane;
        f32x4 v[4]; float s = 0.f;
#pragma unroll
        for (int j = 0; j < 4; ++j) {
            const int c0 = 4 * lane + 256 * j;
            const u32x2 a = *(const u32x2*)(y0 + c0), b = *(const u32x2*)(y1 + c0), x = xr[64 * j];
            const f32x4 ya = (f32x4){bflo(a.x), bfhi(a.x), bflo(a.y), bfhi(a.y)}, yb = (f32x4){bflo(b.x), bfhi(b.x), bflo(b.y), bfhi(b.y)}, xv = (f32x4){bflo(x.x), bfhi(x.x), bflo(x.y), bfhi(x.y)};
            v[j] = xv * DN_ALPHA + ya * r.w0 + yb * r.w1;
            s += (v[j][0] + v[j][1]) + (v[j][2] + v[j][3]);
        }
        const float mean = wave_sum(s) * (1.f / DM); float s2 = 0.f;
#pragma unroll
        for (int j = 0; j < 4; ++j) { v[j] = v[j] - mean; s2 += (v[j][0] * v[j][0] + v[j][1] * v[j][1]) + (v[j][2] * v[j][2] + v[j][3] * v[j][3]); }
        const float rstd = 1.f / sqrtf(wave_sum(s2) * (1.f / DM) + LN_EPS);
#pragma unroll
        for (int j = 0; j < 4; ++j) {
            const int c0 = 4 * lane + 256 * j;
            const f32x4 gg = *(const f32x4*)(lg + c0), bb = *(const f32x4*)(lb + c0);
            v[j] = v[j] * rstd * gg + bb;
            if (layer) *(f32x4*)(outp + (size_t)row * DM + c0) = v[j];
            else *(u32x2*)(XB + (size_t)row * DM + c0) = (u32x2){pk2(v[j][0], v[j][1]), pk2(v[j][2], v[j][3])};
        }
    }
}

__device__ __forceinline__ void ph_kmean(const Ctx& C) {
    const bf16_t* K1 = (const bf16_t*)(C.ws + WS_K1); float* KM = (float*)(C.ws + WS_KMEAN);
    const int gw = C.bid * NWAVES + C.wave, NGW = C.nb * NWAVES, lane = C.lane;
    for (int it = gw; it < NB * NH * 32; it += NGW) {
        const bf16_t* p = K1 + (size_t)it * 256 * DH + lane; float s = 0.f;
#pragma unroll 8
        for (int j = 0; j < 256; ++j) s += bf2f(p[j * DH]);
        KM[(size_t)it * DH + lane] = s * (1.0f / 256.0f);
    }
}
constexpr int NPHASE = 19;
__global__ void __launch_bounds__(NTHREADS, 2) fwd(Args args) {
    extern __shared__ __attribute__((aligned(16))) unsigned char lds[];
    Ctx C;
#pragma unroll
    for (int i = 0; i < 18; ++i) C.in[i] = args.in[i];
    C.out = args.out; C.ws = args.ws; C.lds = lds;
    C.tid = threadIdx.x; C.lane = C.tid & 63; C.wave = __builtin_amdgcn_readfirstlane(C.tid >> 6); C.bid = blockIdx.x; C.nb = gridDim.x;
    LAS unsigned* misc = (LAS unsigned*)(lds + LDS_BYTES - 512);
    LAS int* sm = (LAS int*)(misc + 16);
    if (C.tid < 4) misc[C.tid] = 0u;
    __syncthreads();
#if MK_SINGLE
    XcdBarrier bar = xcd_barrier_post((unsigned*)(C.ws + WS_CTL) + CW_BAR, (volatile LAS unsigned*)misc);
#define SEAM() xcd_barrier(bar)
#else
#define SEAM() do {} while (0)
#endif
    const int lo = args.ph_lo, hi = args.ph_hi;
#ifndef PH_MASK
#define PH_MASK 0xFFFFFFFFu
#endif
#define IN(k) (((PH_MASK >> (k)) & 1u) && lo <= (k) && (k) < hi)
#define BOTH(k) (IN(k) && IN((k) + 1))
    unsigned char* ws = C.ws;
    const float2* rope = (const float2*)(ws + WS_ROPE);
    LAS unsigned char* L = (LAS unsigned char*)lds;

    if (IN(0)) { ph_prologue(C); if (BOTH(0)) SEAM(); }
    if (IN(1)) {
        EpiNsaIn E{(bf16_t*)(ws + WS_Q), (bf16_t*)(ws + WS_KV0), (float*)(ws + WS_GATES), rope};
        g8::StaticOrder S; S.init(NTOK / 256, 2560 / 256, C.nb, C.bid);
        g8::gemm8<false>(L, (const bf16_t*)(ws + WS_XB), DM, (const bf16_t*)(ws + WS_WT_NSA_IN), DM, S, g8::EpiEl<EpiNsaIn>{E}, g8::GatherInfo{nullptr, sm});
        if (BOTH(1)) SEAM();
    }
    if (IN(2)) {
        EpiCmp EK{(const float*)(ws + WS_BIAS1), (const bf16_t*)(ws + WS_W2T), rope, (bf16_t*)(ws + WS_KC)}, EV{(const float*)(ws + WS_BIAS1) + 256, (const bf16_t*)(ws + WS_W2T) + 64 * 256, nullptr, (bf16_t*)(ws + WS_VC)};
        g8::StaticOrder SK, SV; SK.init(32, 1, C.nb, C.bid); SV.init(32, 1, C.nb, (C.bid + C.nb / 2) % C.nb);
        g8::gemm8<false>(L, (const bf16_t*)(ws + WS_KV0), 1024, (const bf16_t*)(ws + WS_WT_C1K), 2048, SK, EK, g8::GatherInfo{nullptr, sm});
        g8::gemm8<false>(L, (const bf16_t*)(ws + WS_KV0 + KVSEG), 1024, (const bf16_t*)(ws + WS_WT_C1V), 2048, SV, EV, g8::GatherInfo{nullptr, sm});
        if (C.nb == 256 && !((C.bid < 32) || (C.bid >= 128 && C.bid < 160))) {
            EpiNsaIn E{(bf16_t*)(ws + WS_Q), (bf16_t*)(ws + WS_KV0), (float*)(ws + WS_GATES), rope};
            const int gidx = C.bid < 128 ? C.bid - 32 : C.bid - 64, fr = C.lane & 15, fq = C.lane >> 4;
            for (int tile = gidx * NWAVES + C.wave; tile < 2048; tile += 192 * NWAVES) {
                const int row0 = (tile >> 1) * 32, col0 = 2560 + (tile & 1) * 32;
                const bf16_t* a0 = (const bf16_t*)(ws + WS_XB) + (size_t)(row0 + fr) * DM + fq * 8; const bf16_t* a1 = a0 + (size_t)16 * DM;
                const bf16_t* b0 = (const bf16_t*)(ws + WS_WT_NSA_IN) + (size_t)(col0 + fr) * DM + fq * 8; const bf16_t* b1 = b0 + (size_t)16 * DM;
                f32x4 acc[2][2]; mma_core(a0, a1, b0, b1, DM, acc);
#pragma unroll
                for (int mi = 0; mi < 2; ++mi)
#pragma unroll
                    for (int ni = 0; ni < 2; ++ni) E(row0 + 16 * mi + fr, col0 + 16 * ni + 4 * fq, acc[mi][ni]);
            }
        } else if (C.nb != 256) {
            EpiNsaIn E{(bf16_t*)(ws + WS_Q), (bf16_t*)(ws + WS_KV0), (float*)(ws + WS_GATES), rope};
            const int fr = C.lane & 15, fq = C.lane >> 4;
            for (int tile = C.bid * NWAVES + C.wave; tile < 2048; tile += C.nb * NWAVES) {
                const int row0 = (tile >> 1) * 32, col0 = 2560 + (tile & 1) * 32;
                const bf16_t* a0 = (const bf16_t*)(ws + WS_XB) + (size_t)(row0 + fr) * DM + fq * 8; const bf16_t* a1 = a0 + (size_t)16 * DM;
                const bf16_t* b0 = (const bf16_t*)(ws + WS_WT_NSA_IN) + (size_t)(col0 + fr) * DM + fq * 8; const bf16_t* b1 = b0 + (size_t)16 * DM;
                f32x4 acc[2][2]; mma_core(a0, a1, b0, b1, DM, acc);
#pragma unroll
                for (int mi = 0; mi < 2; ++mi)
#pragma unroll
                    for (int ni = 0; ni < 2; ++ni) E(row0 + 16 * mi + fr, col0 + 16 * ni + 4 * fq, acc[mi][ni]);
            }
        }
        if (BOTH(2)) SEAM();
    }
    if (IN(4)) { ph_nsa_fa(C); if (BOTH(4)) SEAM(); }
    if (IN(6)) {
        EpiBf16 E{(bf16_t*)(ws + WS_MIX)};
        g8::StaticOrder S; S.init(NTOK / 256, DM / 256, C.nb, C.bid);
        g8::gemm8<false>(L, (const bf16_t*)(ws + WS_Q), DM, (const bf16_t*)(ws + WS_WT_NSA_OUT), DM, S, g8::EpiEl<EpiBf16>{E}, g8::GatherInfo{nullptr, sm});
        if (BOTH(6)) SEAM();
    }
    if (IN(7)) { ph_ln_route(C, 0); if (BOTH(7)) SEAM(); }
    if (IN(8)) {
        load_expert_map(C, CW_CNT0, sm);
        EpiSwiGLU E{(bf16_t*)(ws + WS_HBUF)};
        g8::GroupedOrder S; S.init(sm, 4, C.nb, C.bid);
        g8::gemm8<true>(L, (const bf16_t*)(ws + WS_X1B), DM, (const bf16_t*)(ws + WS_WT_GU), 1024, S, g8::EpiEl<EpiSwiGLU>{E}, g8::GatherInfo{(const int*)(ws + WS_ROWLIST), sm});
        if (BOTH(8)) SEAM();
    }
    if (IN(9)) {
        load_expert_map(C, CW_CNT0, sm);
        EpiBf16 E{(bf16_t*)(ws + WS_Y2)};
        g8::GroupedOrder S; S.init(sm, 4, C.nb, C.bid);
        g8::gemm8<false>(L, (const bf16_t*)(ws + WS_HBUF), DE, (const bf16_t*)(ws + WS_WT_DN), DE, S, g8::EpiEl<EpiBf16>{E}, g8::GatherInfo{nullptr, sm});
        if (BOTH(9)) SEAM();
    }
    if (IN(10)) {
        load_expert_map(C, CW_CNT0, sm);
        ph_combine(C, 0, (float*)(ws + WS_XR), sm);
        { float* scr = (float*)(C.lds + C.wave * 9216); const int gw = C.bid * NWAVES + C.wave, NGW = C.nb * NWAVES;
          for (int it = gw; it < MOE_W_ITEMS; it += NGW) moe_weight_item(C, 1, it, scr); }
        if (BOTH(10)) SEAM();
    }
    if (IN(11)) {
        EpiMobaIn E{(bf16_t*)(ws + WS_Q), (bf16_t*)(ws + WS_K1), (bf16_t*)(ws + WS_V1), rope};
        g8::StaticOrder S; S.init(NTOK / 256, 3072 / 256, C.nb, C.bid);
        g8::gemm8<false>(L, (const bf16_t*)(ws + WS_XB), DM, (const bf16_t*)(ws + WS_WT_MOBA_IN), DM, S, g8::EpiEl<EpiMobaIn>{E}, g8::GatherInfo{nullptr, sm});
        if (BOTH(11)) SEAM();
    }
    if (IN(12)) { ph_kmean(C); if (BOTH(12)) SEAM(); }
    if (IN(13)) { ph_moba_fa(C); if (BOTH(13)) SEAM(); }
    if (IN(14)) {
        EpiBf16 E{(bf16_t*)(ws + WS_MIX)};
        g8::StaticOrder S; S.init(NTOK / 256, DM / 256, C.nb, C.bid);
        g8::gemm8<false>(L, (const bf16_t*)(ws + WS_Q), DM, (const bf16_t*)(ws + WS_WT_MOBA_OUT), DM, S, g8::EpiEl<EpiBf16>{E}, g8::GatherInfo{nullptr, sm});
        if (BOTH(14)) SEAM();
    }
    if (IN(15)) { ph_ln_route(C, 1); if (BOTH(15)) SEAM(); }
    if (IN(16)) {
        load_expert_map(C, CW_CNT1, sm);
        EpiSwiGLU E{(bf16_t*)(ws + WS_HBUF)};
        g8::GroupedOrder S; S.init(sm, 4, C.nb, C.bid);
        g8::gemm8<true>(L, (const bf16_t*)(ws + WS_X1B), DM, (const bf16_t*)(ws + WS_WT_GU), 1024, S, g8::EpiEl<EpiSwiGLU>{E}, g8::GatherInfo{(const int*)(ws + WS_ROWLIST), sm});
        if (BOTH(16)) SEAM();
    }
    if (IN(17)) {
        load_expert_map(C, CW_CNT1, sm);
        EpiBf16 E{(bf16_t*)(ws + WS_Y2)};
        g8::GroupedOrder S; S.init(sm, 4, C.nb, C.bid);
        g8::gemm8<false>(L, (const bf16_t*)(ws + WS_HBUF), DE, (const bf16_t*)(ws + WS_WT_DN), DE, S, g8::EpiEl<EpiBf16>{E}, g8::GatherInfo{nullptr, sm});
        if (BOTH(17)) SEAM();
    }
    if (IN(18)) {
        load_expert_map(C, CW_CNT1, sm);
        ph_combine(C, 1, C.out, sm);
    }
#undef IN
#undef BOTH
}

extern "C" void kernel_launch(void* const* d_in, const int* in_sizes, int n_in, void* d_out, int out_size, void* d_ws, size_t ws_size, hipStream_t stream) {
    static int grid = 0;
    if (grid == 0) {
        if (n_in != 18 || in_sizes[0] != NTOK * DM || out_size != NTOK * DM || ws_size < WS_END) {
            fprintf(stderr, "kernel_launch: unexpected shapes (n_in %d, in0 %d, out %d, ws %zu; need ws >= %zu); nothing launched\n", n_in, n_in > 0 ? in_sizes[0] : -1, out_size, ws_size, (size_t)WS_END);
            grid = -1; return;
        }
        int dev = 0, cus = 0, per_cu = 0;
        if (hipGetDevice(&dev) != hipSuccess || hipDeviceGetAttribute(&cus, hipDeviceAttributeMultiprocessorCount, dev) != hipSuccess) { grid = -1; return; }
        if (hipFuncSetAttribute((const void*)fwd, hipFuncAttributeMaxDynamicSharedMemorySize, LDS_BYTES) != hipSuccess) { fprintf(stderr, "kernel_launch: hipFuncSetAttribute failed\n"); grid = -1; return; }
        if (hipOccupancyMaxActiveBlocksPerMultiprocessor(&per_cu, (const void*)fwd, NTHREADS, LDS_BYTES) != hipSuccess || per_cu < 1)
            fprintf(stderr, "kernel_launch: occupancy query reports %d blocks per CU\n", per_cu);
        (void)hipGetLastError();
        grid = cus;
        if (grid != 256) { fprintf(stderr, "kernel_launch: built for a 256-CU device (got %d CUs); nothing launched\n", cus); grid = -1; return; }
    }
    if (grid < 0) return;
    if (hipMemsetAsync((char*)d_ws + WS_CTL, 0, CTL_BYTES, stream) != hipSuccess) { fprintf(stderr, "kernel_launch: memset failed\n"); return; }
    Args a{};
    for (int i = 0; i < 18; ++i) a.in[i] = (const float*)d_in[i];
    a.out = (float*)d_out; a.ws = (unsigned char*)d_ws;
#if defined(PROBE_PH)
    { const int lo3[3] = {0, PROBE_PH, PROBE_PH + 1}, hi3[3] = {PROBE_PH + 1, PROBE_PH + 1, NPHASE};
      for (int q = 0; q < 3; ++q) { if (lo3[q] >= hi3[q]) continue;
          if (q) (void)hipMemsetAsync((char*)d_ws + WS_CTL + CW_BAR * 4, 0, XCD_BAR_WORDS * 4, stream);
          a.ph_lo = lo3[q]; a.ph_hi = hi3[q]; hipLaunchKernelGGL(fwd, dim3(grid), dim3(NTHREADS), LDS_BYTES, stream, a); } }
#elif MK_SINGLE
    a.ph_lo = 0; a.ph_hi = NPHASE;
    hipLaunchKernelGGL(fwd, dim3(grid), dim3(NTHREADS), LDS_BYTES, stream, a);
#else
    for (int p = 0; p < NPHASE; ++p) { a.ph_lo = p; a.ph_hi = p + 1; hipLaunchKernelGGL(fwd, dim3(grid), dim3(NTHREADS), LDS_BYTES, stream, a); }
#endif
    const hipError_t le = hipPeekAtLastError();
    if (le != hipSuccess) fprintf(stderr, "kernel_launch: launch failed: %s\n", hipGetErrorName(le));
}
```

```cpp
#include <hip/hip_runtime.h>
#include <cstdio>
#include <cstdint>

#ifndef SEL_FUSED
#define SEL_FUSED 1
#endif
#ifndef MK_SINGLE
#define MK_SINGLE 1
#endif

#define LAS __attribute__((address_space(3)))
typedef unsigned short bf16_t;
typedef short bf16x8 __attribute__((ext_vector_type(8)));
typedef float f32x4 __attribute__((ext_vector_type(4)));
typedef unsigned u32x4 __attribute__((ext_vector_type(4)));
typedef unsigned u32x2 __attribute__((ext_vector_type(2)));

constexpr int NB = 4, SEQ = 8192, NTOK = NB * SEQ, DM = 1024, NH = 16, DH = 64, NG = 4;
constexpr int NSA_IN = 2608, NSA_INP = 2816;
constexpr int NE = 16, DE = 512;
constexpr float DN_ALPHA = 1.4142135623730951f;
constexpr float LN_EPS = 1e-5f;
constexpr int NWAVES = 8, NTHREADS = 512;
constexpr float QSCALE = 0.125f * 1.4426950408889634f;
constexpr int LDS_BYTES = 163840;
constexpr int ROWCAP = 2 * NTOK + NE * 256;

constexpr size_t MiB = 1u << 20;
constexpr size_t WS_CTL = 0, CTL_BYTES = 1 * MiB;
constexpr size_t WS_ROPE = 1 * MiB;
constexpr size_t WS_BIAS1 = 3 * MiB;
constexpr size_t WS_W2T = 3 * MiB + 4096;
constexpr size_t WS_KMEAN = 4 * MiB;
constexpr size_t WS_ROUTE = 5 * MiB;
constexpr size_t WS_ROWLIST = 6 * MiB;
constexpr size_t WS_SEL = 8 * MiB;
constexpr size_t WS_GATES = 10 * MiB;
constexpr size_t WS_KC = 25 * MiB, WS_VC = 26 * MiB;
constexpr size_t WS_WT_NSA_IN = 27 * MiB;
constexpr size_t WS_WT_NSA_OUT = 33 * MiB;
constexpr size_t WS_WT_C1K = 35 * MiB, WS_WT_C1V = 36 * MiB;
constexpr size_t WS_WT_MOBA_IN = 37 * MiB;
constexpr size_t WS_WT_MOBA_OUT = 43 * MiB;
constexpr size_t WS_WT_GU = 45 * MiB;
constexpr size_t WS_WT_DN = 77 * MiB;
constexpr size_t WS_XB = 93 * MiB;
constexpr size_t WS_ATTN = 161 * MiB;
constexpr size_t WS_Q = WS_ATTN;
constexpr size_t WS_KV0 = WS_ATTN + 64 * MiB;
constexpr size_t KVSEG = 16 * MiB;
constexpr size_t WS_K1 = WS_ATTN + 64 * MiB, WS_V1 = WS_ATTN + 128 * MiB;
constexpr size_t WS_X1B = 353 * MiB;
constexpr size_t WS_MIX = WS_ATTN + 64 * MiB;
constexpr size_t WS_Y2 = WS_ATTN;
constexpr size_t WS_HBUF = WS_XB;
constexpr size_t WS_XR = 353 * MiB;
constexpr size_t WS_END = 481 * MiB;
static_assert((size_t)ROWCAP * 512 * 2 <= 68 * MiB && (size_t)ROWCAP * 1024 * 2 <= 192 * MiB, "overlay sizes");

constexpr int CW_TMO = 0;
constexpr int CW_CNT0 = 1024, CW_CNT1 = 2048;
constexpr int CW_BAR = 8192;

__device__ __forceinline__ unsigned f2bf(float f) { unsigned u = __float_as_uint(f); return (u + 0x7fffu + ((u >> 16) & 1u)) >> 16; }
typedef float f32x2v __attribute__((ext_vector_type(2)));
typedef __bf16 bf16x2v __attribute__((ext_vector_type(2)));
__device__ __forceinline__ unsigned pk2(float lo, float hi) { const f32x2v v = {lo, hi}; const bf16x2v b = __builtin_convertvector(v, bf16x2v); return __builtin_bit_cast(unsigned, b); }
__device__ __forceinline__ float bflo(unsigned u) { return __uint_as_float(u << 16); }
__device__ __forceinline__ float bfhi(unsigned u) { return __uint_as_float(u & 0xffff0000u); }
__device__ __forceinline__ float bf2f(bf16_t b) { return __uint_as_float((unsigned)b << 16); }
__device__ __forceinline__ float wave_sum(float v) {
#pragma unroll
    for (int o = 1; o < 64; o <<= 1) v += __shfl_xor(v, o);
    return v;
}
__device__ __forceinline__ float wave_max(float v) {
#pragma unroll
    for (int o = 1; o < 64; o <<= 1) v = fmaxf(v, __shfl_xor(v, o));
    return v;
}
#define WAVE_LDS_SYNC() asm volatile("s_waitcnt lgkmcnt(0)" ::: "memory")
__device__ __forceinline__ float sigmoidf_(float x) { return 1.0f / (1.0f + __expf(-x)); }
__device__ __forceinline__ float gelu_tanh(float x) {
    const float u = 0.7978845608028654f * (x + 0.044715f * x * x * x);
    const float t = 1.0f - 2.0f / (__expf(2.0f * u) + 1.0f);
    return 0.5f * x * (1.0f + t);
}

#define XB_TMO      128
#define XB_XCNT(j)  (256  + 64 * (j))
#define XB_XSUB(j)  (1280 + 64 * (j))
#define XB_XGEN(j)  (2304 + 64 * (j))
#define XB_TOP      3328
#define XB_TOPGEN   3392
#define XCD_BAR_WORDS 3456
#define XB_SPIN_CAP (1u << 22)
__device__ __forceinline__ unsigned xb_ld(unsigned* p)              { return __hip_atomic_load(p, __ATOMIC_RELAXED, __HIP_MEMORY_SCOPE_AGENT); }
__device__ __forceinline__ unsigned xb_add(unsigned* p, unsigned v) { return __hip_atomic_fetch_add(p, v, __ATOMIC_RELAXED, __HIP_MEMORY_SCOPE_AGENT); }
__device__ __forceinline__ unsigned xb_xcc_id() { return (unsigned)__builtin_amdgcn_s_getreg((3 << 11) | 20) & 0xFu; }
#define XB_SPIN(cond, bar) do { unsigned _sp = 0; while (cond) { __builtin_amdgcn_s_sleep(1); \
    if ((++_sp & 255u) == 0u) { if (xb_ld(&(bar)[XB_TMO])) break; if (_sp > XB_SPIN_CAP) { atomicAdd(&(bar)[XB_TMO], 1u); break; } } } } while (0)
struct XcdBarrier { unsigned* bar; unsigned x; volatile LAS unsigned* st; };
__device__ __forceinline__ XcdBarrier xcd_barrier_post(unsigned* bar, volatile LAS unsigned* st) {
    XcdBarrier b; b.bar = bar; b.x = xb_xcc_id(); b.st = st;
    if (threadIdx.x == 0) (void)xb_add(&bar[XB_XCNT(b.x)], 1u);
    return b;
}
__device__ __forceinline__ void xcd_barrier_complete(unsigned* bar, unsigned x, unsigned& nloc, unsigned& nx) {
    const unsigned G = gridDim.x * gridDim.y * gridDim.z;
    unsigned sum, cnt, mine, sp = 0u;
    for (;;) {
        sum = 0u; cnt = 0u; mine = 0u;
#pragma unroll
        for (unsigned j = 0; j < 16; ++j) { const unsigned c = xb_ld(&bar[XB_XCNT(j)]); sum += c; cnt += (c > 0u) ? 1u : 0u; mine = (j == x) ? c : mine; }
        if (sum == G) break;
        __builtin_amdgcn_s_sleep(1);
        if ((++sp & 255u) == 0u) { if (xb_ld(&bar[XB_TMO])) break; if (sp > XB_SPIN_CAP) { atomicAdd(&bar[XB_TMO], 1u); break; } }
    }
    nloc = mine > 0u ? mine : 1u; nx = cnt > 0u ? cnt : 1u;
}
__device__ __forceinline__ void xcd_barrier(const XcdBarrier& b) {
    asm volatile("s_waitcnt vmcnt(0)" ::: "memory");
    __syncthreads();
    if (threadIdx.x == 0) {
        unsigned* bar = b.bar;
        __builtin_amdgcn_s_waitcnt(0);
        unsigned nloc = b.st[0], nx = b.st[1];
        if (nloc == 0u) { xcd_barrier_complete(bar, b.x, nloc, nx); b.st[0] = nloc; b.st[1] = nx; }
        const unsigned old = xb_add(&bar[XB_XSUB(b.x)], 1u);
        const unsigned gen = old / nloc;
        if (old + 1u == (gen + 1u) * nloc) {
            __builtin_amdgcn_fence(__ATOMIC_RELEASE, "agent");
            asm volatile("s_waitcnt vmcnt(0)" ::: "memory");
            const unsigned og = xb_add(&bar[XB_TOP], 1u);
            const unsigned tg = og / nx;
            if (og + 1u == (tg + 1u) * nx) xb_add(&bar[XB_TOPGEN], 1u);
            else XB_SPIN(xb_ld(&bar[XB_TOPGEN]) == tg, bar);
            __builtin_amdgcn_fence(__ATOMIC_ACQUIRE, "agent");
            xb_add(&bar[XB_XGEN(b.x)], 1u);
            asm volatile("s_waitcnt vmcnt(0)" ::: "memory");
        } else {
            XB_SPIN(xb_ld(&bar[XB_XGEN(b.x)]) == gen, bar);
            __builtin_amdgcn_fence(__ATOMIC_ACQUIRE, "agent");
            asm volatile("s_waitcnt vmcnt(0)" ::: "memory");
        }
    }
    __syncthreads();
}

struct Args { const float* in[18]; float* out; unsigned char* ws; int ph_lo, ph_hi; };
struct Ctx {
    const float* in[18]; float* out; unsigned char* ws; unsigned char* lds;
    int tid, lane, wave, bid, nb;
};
enum { I_X = 0, I_NSA_WIN, I_NSA_WOUT, I_CK_W1, I_CK_W2, I_CV_W1, I_CV_W2, I_CK_POS, I_CV_POS, I_MOBA_WIN, I_MOBA_WOUT, I_RW, I_RB, I_WG, I_WU, I_WD, I_LNG, I_LNB };

__device__ __forceinline__ int il64(int d) { return d < 32 ? 2 * d : 2 * (d - 32) + 1; }
__device__ __forceinline__ int rowmap(int kind, int n) {
    switch (kind) {
        case 1: { const bool r = (n < 1024) || (n >= 1536 && n < 1792) || (n >= 2048 && n < 2304); return r ? (n & ~63) + il64(n & 63) : n; }
        case 2: return n < 2048 ? (n & ~63) + il64(n & 63) : n;
        case 3: return 2 * n;
        case 4: return 2 * n + 1;
        default: return n;
    }
}
__device__ __forceinline__ void transpose_item(const float* W, int ldw, int ncols, bf16_t* WT, int K, int kb, int nbk, int kind, float* scr, int lane) {
    const int k0 = 64 * kb, n0 = 32 * nbk;
    const int cq = lane & 7, nn = n0 + 4 * cq;
#pragma unroll
    for (int i = 0; i < 8; ++i) { const int kk = 8 * i + (lane >> 3);
        *(f32x4*)(scr + kk * 36 + 4 * cq) = nn < ncols ? *(const f32x4*)(W + (size_t)(k0 + kk) * ldw + nn) : (f32x4){0.f, 0.f, 0.f, 0.f}; }
    WAVE_LDS_SYNC();
    const int c = lane & 7;
#pragma unroll
    for (int j = 0; j < 4; ++j) {
        const int n = (lane >> 3) + 8 * j; const float* s = scr + (8 * c) * 36 + n;
        u32x4 o; o.x = pk2(s[0 * 36], s[1 * 36]); o.y = pk2(s[2 * 36], s[3 * 36]); o.z = pk2(s[4 * 36], s[5 * 36]); o.w = pk2(s[6 * 36], s[7 * 36]);
        *(u32x4*)(WT + (size_t)rowmap(kind, n0 + n) * K + k0 + 8 * c) = o;
    }
    WAVE_LDS_SYNC();
}
constexpr int MOE_W_ITEMS = NE * 768;
__device__ __forceinline__ void moe_weight_item(const Ctx& C, int layer, int r, float* scr) {
    const int e = r / 768; int q = r % 768;
    bf16_t* gu = (bf16_t*)(C.ws + WS_WT_GU) + (size_t)e * 1024 * 1024;
    bf16_t* dn = (bf16_t*)(C.ws + WS_WT_DN) + (size_t)e * 1024 * 512;
    const size_t eo = (size_t)(layer * NE + e);
    if (q < 256) { transpose_item(C.in[I_WG] + eo * DM * DE, DE, DE, gu, DM, q / 16, q % 16, 3, scr, C.lane); return; } q -= 256;
    if (q < 256) { transpose_item(C.in[I_WU] + eo * DM * DE, DE, DE, gu, DM, q / 16, q % 16, 4, scr, C.lane); return; } q -= 256;
    transpose_item(C.in[I_WD] + eo * DE * DM, DM, DM, dn, DE, q / 32, q % 32, 0, scr, C.lane);
}

__device__ __forceinline__ void ph_prologue(const Ctx& C) {
    float* scr = (float*)(C.lds + C.wave * 9216);
    const int gw = C.bid * NWAVES + C.wave, NGW = C.nb * NWAVES;
    constexpr int I_A = 16 * 82, I_B = 16 * 32, I_C = 32 * 8, I_D = 16 * 96, I_E = 16 * 32;
    constexpr int NIT = I_A + I_B + 2 * I_C + I_D + I_E + MOE_W_ITEMS;
    for (int it = gw; it < NIT; it += NGW) {
        int r = it;
        if (r < I_A) { transpose_item(C.in[I_NSA_WIN], NSA_IN, NSA_IN, (bf16_t*)(C.ws + WS_WT_NSA_IN), DM, r / 82, r % 82, 1, scr, C.lane); continue; } r -= I_A;
        if (r < I_B) { transpose_item(C.in[I_NSA_WOUT], DM, DM, (bf16_t*)(C.ws + WS_WT_NSA_OUT), DM, r / 32, r % 32, 0, scr, C.lane); continue; } r -= I_B;
        if (r < I_C) { transpose_item(C.in[I_CK_W1], 256, 256, (bf16_t*)(C.ws + WS_WT_C1K), 2048, r / 8, r % 8, 0, scr, C.lane); continue; } r -= I_C;
        if (r < I_C) { transpose_item(C.in[I_CV_W1], 256, 256, (bf16_t*)(C.ws + WS_WT_C1V), 2048, r / 8, r % 8, 0, scr, C.lane); continue; } r -= I_C;
        if (r < I_D) { transpose_item(C.in[I_MOBA_WIN], 3072, 3072, (bf16_t*)(C.ws + WS_WT_MOBA_IN), DM, r / 96, r % 96, 2, scr, C.lane); continue; } r -= I_D;
        if (r < I_E) { transpose_item(C.in[I_MOBA_WOUT], DM, DM, (bf16_t*)(C.ws + WS_WT_MOBA_OUT), DM, r / 32, r % 32, 0, scr, C.lane); continue; } r -= I_E;
        moe_weight_item(C, 0, r, scr);
    }
    const int gt = C.bid * NTHREADS + C.tid, NGT = C.nb * NTHREADS;
    { u32x4* p = (u32x4*)((bf16_t*)(C.ws + WS_WT_NSA_IN) + (size_t)2624 * DM); const int n = (NSA_INP - 2624) * DM / 8;
      for (int i = gt; i < n; i += NGT) p[i] = (u32x4){0u, 0u, 0u, 0u}; }
    { const f32x4* x4 = (const f32x4*)C.in[I_X]; u32x4* o = (u32x4*)(C.ws + WS_XB); const int n = NTOK * DM / 8;
      for (int i = gt; i < n; i += NGT) { const f32x4 a = x4[2 * i], b = x4[2 * i + 1]; o[i] = (u32x4){pk2(a.x, a.y), pk2(a.z, a.w), pk2(b.x, b.y), pk2(b.z, b.w)}; } }
    { const float INV[32] = {1.000000000e+00f, 7.498942018e-01f, 5.623413324e-01f, 4.216965139e-01f, 3.162277639e-01f, 2.371373922e-01f, 1.778279394e-01f, 1.333521456e-01f,
                             1.000000015e-01f, 7.498941571e-02f, 5.623412877e-02f, 4.216964915e-02f, 3.162277862e-02f, 2.371373586e-02f, 1.778279431e-02f, 1.333521493e-02f,
                             9.999999776e-03f, 7.498942316e-03f, 5.623413250e-03f, 4.216964822e-03f, 3.162277862e-03f, 2.371373819e-03f, 1.778279431e-03f, 1.333521446e-03f,
                             1.000000047e-03f, 7.498941850e-04f, 5.623413017e-04f, 4.216965463e-04f, 3.162277862e-04f, 2.371373848e-04f, 1.778279402e-04f, 1.333521504e-04f};
      float2* tab = (float2*)(C.ws + WS_ROPE);
      for (int i = gt; i < SEQ * 32; i += NGT) {
          const int t = i >> 5, f = i & 31;
          float inv = INV[0];
#pragma unroll
          for (int q = 1; q < 32; ++q) inv = (f == q) ? INV[q] : inv;
          const float ang = (float)t * inv;
          const double a = (double)ang; const double k = __builtin_rint(a * 0.15915494309189535); const float rf = (float)(a - k * 6.283185307179586);
          tab[i] = make_float2(__cosf(rf), __sinf(rf));
      } }
    for (int i = gt; i < 2 * 64 * 256; i += NGT) { const int which = i >> 14, d = (i >> 8) & 63, c = i & 255;
        ((bf16_t*)(C.ws + WS_W2T))[i] = (bf16_t)f2bf(C.in[which ? I_CV_W2 : I_CK_W2][c * 64 + d]); }
    for (int o = gw; o < 512; o += NGW) {
        const int which = o >> 8, c = o & 255;
        const float* pos = C.in[which ? I_CV_POS : I_CK_POS]; const float* w1 = C.in[which ? I_CV_W1 : I_CK_W1];
        float s = 0.f;
        for (int k = C.lane; k < 2048; k += 64) s += pos[k] * w1[(size_t)k * 256 + c];
        s = wave_sum(s);
        if (C.lane == 0) ((float*)(C.ws + WS_BIAS1))[o] = s;
    }
}

__device__ __forceinline__ void mma_core(const bf16_t* a0, const bf16_t* a1, const bf16_t* b0, const bf16_t* b1, int K, f32x4 (&acc)[2][2]) {
#pragma unroll
    for (int i = 0; i < 2; ++i)
#pragma unroll
        for (int j = 0; j < 2; ++j) acc[i][j] = (f32x4){0.f, 0.f, 0.f, 0.f};
#pragma unroll 4
    for (int k = 0; k < K; k += 32) {
        const bf16x8 A0 = *(const bf16x8*)(a0 + k), A1 = *(const bf16x8*)(a1 + k), B0 = *(const bf16x8*)(b0 + k), B1 = *(const bf16x8*)(b1 + k);
        acc[0][0] = __builtin_amdgcn_mfma_f32_16x16x32_bf16(B0, A0, acc[0][0], 0, 0, 0);
        acc[0][1] = __builtin_amdgcn_mfma_f32_16x16x32_bf16(B1, A0, acc[0][1], 0, 0, 0);
        acc[1][0] = __builtin_amdgcn_mfma_f32_16x16x32_bf16(B0, A1, acc[1][0], 0, 0, 0);
        acc[1][1] = __builtin_amdgcn_mfma_f32_16x16x32_bf16(B1, A1, acc[1][1], 0, 0, 0);
    }
}
namespace g8 {
constexpr int BM = 256, BK = 64, HALF = 128, HTB = HALF * BK * 2, STAGE_BYTES = 8 * HTB, NXCD = 8, WGM = 8;
__device__ __forceinline__ int lds_byte(int r, int c) { const int st = (r >> 4) * 2 + (c >> 5), rr = r & 15, cc = c & 31, ob = rr * 64 + cc * 2; return st * 1024 + (ob ^ (((ob >> 9) & 1) << 5)); }
__device__ __forceinline__ void stage_rc(int b, int& R, int& C) { const int st = b / 1024, sb = b % 1024, swz = sb ^ (((sb >> 9) & 1) << 5); R = (st >> 1) * 16 + swz / 64; C = (st & 1) * 32 + (swz % 64) / 2; }
struct Unit { int pm, pn, bt, e; };
struct StaticOrder {
    int nM, nN, nwg, G, c;
    __device__ void init(int nM_, int nN_, int G_, int c_) { nM = nM_; nN = nN_; nwg = nM * nN; G = G_; c = c_; }
    __device__ bool next(int i, Unit& u) const {
        const long L = (long)i * G + c; if (L >= nwg) return false;
        int wgid = (int)L; { const int q = nwg / NXCD, r = nwg % NXCD, xcd = wgid % NXCD, off = wgid / NXCD; wgid = (xcd < r ? xcd * (q + 1) : r * (q + 1) + (xcd - r) * q) + off; }
        const int nig = WGM * nN, gid = wgid / nig, fm = gid * WGM, gsz = (nM - fm) < WGM ? (nM - fm) : WGM;
        u.pm = fm + ((wgid % nig) % gsz); u.pn = (wgid % nig) / gsz; u.bt = u.pn; u.e = 0; return true;
    }
};
struct GroupedOrder {
    StaticOrder so; const LAS int* sm;
    __device__ void init(const LAS int* sm_, int nN_, int G_, int c_) { sm = sm_; so.init(sm_[32] / BM, nN_, G_, c_); }
    __device__ bool next(int i, Unit& u) const {
        if (!so.next(i, u)) return false;
        const int rowt = u.pm * BM; int e = 0;
#pragma unroll
        for (int q = 1; q < NE; ++q) e = (rowt >= sm[16 + q]) ? q : e;
        u.e = e; u.bt = e * so.nN + u.pn; return true;
    }
};
struct GatherInfo { const int* rowlist; const LAS int* sm; };

__device__ __forceinline__ int perm32(int rho) { const int n = rho >> 4, i = rho & 15; return 8 * (i >> 2) + 4 * n + (i & 3); }
template <bool GATHER, class Epi, class Sched>
__device__ __forceinline__ void gemm8(LAS unsigned char* lds, const bf16_t* A, int lda, const bf16_t* Bt, int K, const Sched& S, const Epi& E, GatherInfo gi) {
    const int tid = threadIdx.x, wid = __builtin_amdgcn_readfirstlane(tid >> 6), lane = tid & 63, wr = wid >> 2, wc = wid & 3, fr = lane & 15, fq = lane >> 4;
    const int nt = K / BK;
    int Rr[2], Cc[2]; unsigned voffB[2]; unsigned vAc[2][2], vAn[2][2];
#pragma unroll
    for (int i = 0; i < 2; ++i) { stage_rc(tid * 16 + i * 8192, Rr[i], Cc[i]); voffB[i] = (unsigned)(((Rr[i] & ~31) + perm32(Rr[i] & 31)) * K + Cc[i]) * 2u;
#pragma unroll
        for (int h = 0; h < 2; ++h) { vAc[h][i] = (unsigned)((Rr[i] + HALF * h) * lda + Cc[i]) * 2u; vAn[h][i] = vAc[h][i]; } }
    const size_t kstep = (size_t)(BK * 2);
    const size_t hstepB = (size_t)HALF * K * 2, tstepB = 2 * hstepB, tstepA = (size_t)BM * lda * 2;
    const unsigned ldsw = (unsigned)wid * 1024u;
    const int aoff = lds_byte(wr * 64 + fr, fq * 8), boff = lds_byte(wc * 32 + fr, fq * 8);
#define G8_SA(b, h) (((b) * 2 + (h)) * HTB)
#define G8_SB(b, h) ((4 + (b) * 2 + (h)) * HTB)
#define G8_STAGEB(bufoff, gbase) do { _Pragma("unroll") for (int _i = 0; _i < 2; ++_i) \
        __builtin_amdgcn_global_load_lds((const unsigned*)((const char*)(gbase) + voffB[_i]), (LAS unsigned*)(lds + (bufoff) + ldsw + _i * 8192), 16, 0, 0); } while (0)
#define G8_STAGEA(bufoff, gbase, v0, v1) do { \
        __builtin_amdgcn_global_load_lds((const unsigned*)((const char*)(gbase) + (v0)), (LAS unsigned*)(lds + (bufoff) + ldsw), 16, 0, 0); \
        __builtin_amdgcn_global_load_lds((const unsigned*)((const char*)(gbase) + (v1)), (LAS unsigned*)(lds + (bufoff) + ldsw + 8192), 16, 0, 0); } while (0)
#define G8_LDA(dst, b, h) do { _Pragma("unroll") for (int m = 0; m < 4; ++m) _Pragma("unroll") for (int k = 0; k < 2; ++k) dst[m][k] = *(const LAS bf16x8*)(lds + G8_SA(b, h) + aoff + m * 2048 + k * 1024); } while (0)
#define G8_LDB(dst, b, h) do { _Pragma("unroll") for (int n = 0; n < 2; ++n) _Pragma("unroll") for (int k = 0; k < 2; ++k) dst[n][k] = *(const LAS bf16x8*)(lds + G8_SB(b, h) + boff + n * 2048 + k * 1024); } while (0)
#define G8_MMA(ai, bj, At, Bt_) do { __builtin_amdgcn_s_setprio(1); _Pragma("unroll") for (int m = 0; m < 4; ++m) _Pragma("unroll") for (int n = 0; n < 2; ++n) _Pragma("unroll") for (int k = 0; k < 2; ++k) \
        acc[ai][bj][m][n] = __builtin_amdgcn_mfma_f32_16x16x32_bf16(Bt_[n][k], At[m][k], acc[ai][bj][m][n], 0, 0, 0); __builtin_amdgcn_s_setprio(0); } while (0)
#define G8_WAIT_V(n) asm volatile("s_waitcnt vmcnt(" #n ")" ::: "memory")
#define G8_WAIT_L(n) asm volatile("s_waitcnt lgkmcnt(" #n ")" ::: "memory")
#define G8_BAR __builtin_amdgcn_s_barrier()
#define G8_SCHED __builtin_amdgcn_sched_barrier(0)
#define G8_GATHER(u, v) do { if (GATHER) { const int _eb = gi.sm[16 + (u).e], _ec = gi.sm[(u).e]; \
        _Pragma("unroll") for (int _h = 0; _h < 2; ++_h) _Pragma("unroll") for (int _i = 0; _i < 2; ++_i) { const int _s = (u).pm * BM + HALF * _h + Rr[_i] - _eb; \
            const int _t = gi.rowlist[(u).e * NTOK + (_s < _ec ? _s : 0)]; v[_h][_i] = (unsigned)(_t * K + Cc[_i]) * 2u; } } } while (0)
    Unit cur, nxt; int ui = 0;
    if (!S.next(0, cur)) return;
    f32x4 acc[2][2][4][2];
#pragma unroll
    for (int a = 0; a < 2; ++a)
#pragma unroll
        for (int b = 0; b < 2; ++b)
#pragma unroll
            for (int m = 0; m < 4; ++m)
#pragma unroll
                for (int n = 0; n < 2; ++n) acc[a][b][m][n] = (f32x4){0.f, 0.f, 0.f, 0.f};
    bf16x8 At[4][2], B0[2][2], B1[2][2];
    G8_GATHER(cur, vAc);
    const char* cA = GATHER ? (const char*)A : (const char*)A + (size_t)cur.pm * tstepA; const char* cB = (const char*)Bt + (size_t)cur.bt * tstepB;
    G8_STAGEB(G8_SB(0, 0), cB); G8_STAGEB(G8_SB(0, 1), cB + hstepB); G8_STAGEA(G8_SA(0, 0), cA, vAc[0][0], vAc[0][1]); G8_STAGEA(G8_SA(0, 1), cA, vAc[1][0], vAc[1][1]);
    if (wr == 1) G8_BAR;
    G8_WAIT_V(2); G8_BAR;
    G8_STAGEB(G8_SB(1, 0), cB + kstep); G8_STAGEA(G8_SA(1, 0), cA + kstep, vAc[0][0], vAc[0][1]); G8_STAGEB(G8_SB(1, 1), cB + hstepB + kstep);
    G8_WAIT_V(6); G8_BAR;
    for (;;) {
        const bool has_next = S.next(ui + 1, nxt);
        if (has_next) G8_GATHER(nxt, vAn);
        const char* nA = has_next ? (GATHER ? (const char*)A : (const char*)A + (size_t)nxt.pm * tstepA) : cA; const char* nB = has_next ? (const char*)Bt + (size_t)nxt.bt * tstepB : cB;
        for (int t = 0; t < nt; t += 2) {
            const bool last = (t == nt - 2);
            const char* a1 = cA + (size_t)(t + 1) * kstep;
            const char* a2 = last ? nA : cA + (size_t)(t + 2) * kstep; const char* b2 = last ? nB : cB + (size_t)(t + 2) * kstep;
            const char* a3 = a2 + kstep; const char* b3 = b2 + kstep;
            const bool usen = GATHER && last && has_next;
            const unsigned w00 = usen ? vAn[0][0] : vAc[0][0], w01 = usen ? vAn[0][1] : vAc[0][1], w10 = usen ? vAn[1][0] : vAc[1][0], w11 = usen ? vAn[1][1] : vAc[1][1];
            G8_LDB(B0, 0, 0); G8_LDB(B1, 0, 1); G8_SCHED; G8_LDA(At, 0, 0); G8_STAGEA(G8_SA(1, 1), a1, vAc[1][0], vAc[1][1]);
            G8_WAIT_V(8); G8_WAIT_L(0); G8_BAR; G8_MMA(0, 0, At, B0); G8_MMA(0, 1, At, B1); G8_BAR; G8_SCHED;
            G8_LDA(At, 0, 1); G8_STAGEB(G8_SB(0, 0), b2); G8_STAGEB(G8_SB(0, 1), b2 + hstepB); G8_STAGEA(G8_SA(0, 0), a2, w00, w01);
            G8_WAIT_V(8); G8_WAIT_L(0); G8_BAR; G8_MMA(1, 0, At, B0); G8_MMA(1, 1, At, B1); G8_BAR; G8_SCHED;
            G8_LDB(B0, 1, 0); G8_LDB(B1, 1, 1); G8_SCHED; G8_LDA(At, 1, 0); G8_STAGEA(G8_SA(0, 1), a2, w10, w11);
            G8_WAIT_V(8); G8_WAIT_L(0); G8_BAR; G8_MMA(0, 0, At, B0); G8_MMA(0, 1, At, B1); G8_BAR; G8_SCHED;
            G8_LDA(At, 1, 1); G8_STAGEB(G8_SB(1, 0), b3); G8_STAGEB(G8_SB(1, 1), b3 + hstepB); G8_STAGEA(G8_SA(1, 0), a3, w00, w01);
            G8_WAIT_V(8); G8_WAIT_L(0); G8_BAR; G8_MMA(1, 0, At, B0); G8_MMA(1, 1, At, B1); G8_BAR; G8_SCHED;
        }
        if (wr == 0) G8_BAR;
        E(acc, cur, wr, wc, fr, fq);
        if (!has_next) break;
#pragma unroll
        for (int a = 0; a < 2; ++a)
#pragma unroll
            for (int b = 0; b < 2; ++b)
#pragma unroll
                for (int m = 0; m < 4; ++m)
#pragma unroll
                    for (int n = 0; n < 2; ++n) acc[a][b][m][n] = (f32x4){0.f, 0.f, 0.f, 0.f};
        cur = nxt; cA = nA; cB = nB; ++ui;
#pragma unroll
        for (int h = 0; h < 2; ++h)
#pragma unroll
            for (int i = 0; i < 2; ++i) vAc[h][i] = vAn[h][i];
        if (wr == 1) G8_BAR;
    }
    G8_WAIT_V(0);
    G8_BAR;
    if constexpr (Epi::AFTER) E.after(acc, cur, lds, wr, wc, fr, fq, wid, lane);
#undef G8_SA
#undef G8_SB
#undef G8_STAGEA
#undef G8_STAGEB
#undef G8_LDA
#undef G8_LDB
#undef G8_MMA
#undef G8_WAIT_V
#undef G8_WAIT_L
#undef G8_BAR
#undef G8_SCHED
#undef G8_GATHER
}
template <class F> struct EpiEl {
    static constexpr bool AFTER = false;
    F f;
    __device__ __forceinline__ void operator()(const f32x4 (&acc)[2][2][4][2], const Unit& u, int wr, int wc, int fr, int fq) const {
#pragma unroll
        for (int ai = 0; ai < 2; ++ai)
#pragma unroll
            for (int m = 0; m < 4; ++m) { const int row = u.pm * BM + ai * HALF + wr * 64 + m * 16 + fr;
#pragma unroll
                for (int bj = 0; bj < 2; ++bj) f(row, u.pn * BM + bj * HALF + wc * 32 + 8 * fq, acc[ai][bj][m][0], acc[ai][bj][m][1]); }
    }
};
}

struct EpiNsaIn {
    bf16_t* Q; bf16_t* KV; float* gates; const float2* rope;
    __device__ __forceinline__ void operator()(int row, int c, f32x4 v) const {
        const int t = row & (SEQ - 1), b = row >> 13;
        if (c < 1024) {
            v = v * QSCALE;
            const int d = (c & 63) >> 1; const float2 c0 = rope[t * 32 + d], c1 = rope[t * 32 + d + 1];
            bf16_t* p = Q + (size_t)row * DM + (c & ~63);
            *(unsigned*)(p + d) = pk2(v[0] * c0.x - v[1] * c0.y, v[2] * c1.x - v[3] * c1.y);
            *(unsigned*)(p + d + 32) = pk2(v[1] * c0.x + v[0] * c0.y, v[3] * c1.x + v[2] * c1.y);
        } else if (c < 2560) {
            const int s = (c - 1024) >> 8, g = ((c - 1024) >> 6) & 3;
            bf16_t* p = KV + (size_t)s * (KVSEG / 2) + ((size_t)(b * NG + g) * SEQ + t) * DH;
            if (s == 2 || s == 4) {
                const int d = (c & 63) >> 1; const float2 c0 = rope[t * 32 + d], c1 = rope[t * 32 + d + 1];
                *(unsigned*)(p + d) = pk2(v[0] * c0.x - v[1] * c0.y, v[2] * c1.x - v[3] * c1.y);
                *(unsigned*)(p + d + 32) = pk2(v[1] * c0.x + v[0] * c0.y, v[3] * c1.x + v[2] * c1.y);
            } else {
                *(u32x2*)(p + (c & 63)) = (u32x2){pk2(v[0], v[1]), pk2(v[2], v[3])};
            }
        } else if (c < NSA_IN) {
            float* gp = gates + (size_t)row * 48 + (c - 2560);
            *(f32x4*)gp = (f32x4){sigmoidf_(v[0]), sigmoidf_(v[1]), sigmoidf_(v[2]), sigmoidf_(v[3])};
        }
    }
    __device__ __forceinline__ void operator()(int row, int c, f32x4 v, f32x4 w) const {
        const int t = row & (SEQ - 1), b = row >> 13;
        const int s = (c - 1024) >> 8;
        const bool isq = c < 1024, roped = isq || s == 2 || s == 4;
        if (roped) {
            if (isq) { v = v * QSCALE; w = w * QSCALE; }
            const int g = ((c - 1024) >> 6) & 3, d = (c & 63) >> 1;
            bf16_t* p = isq ? Q + (size_t)row * DM + (c & ~63) : KV + (size_t)s * (KVSEG / 2) + ((size_t)(b * NG + g) * SEQ + t) * DH;
            const f32x4 cs01 = *(const f32x4*)(rope + t * 32 + d), cs23 = *(const f32x4*)(rope + t * 32 + d + 2);
            *(u32x2*)(p + d) = (u32x2){pk2(v[0] * cs01[0] - v[1] * cs01[1], v[2] * cs01[2] - v[3] * cs01[3]), pk2(w[0] * cs23[0] - w[1] * cs23[1], w[2] * cs23[2] - w[3] * cs23[3])};
            *(u32x2*)(p + d + 32) = (u32x2){pk2(v[1] * cs01[0] + v[0] * cs01[1], v[3] * cs01[2] + v[2] * cs01[3]), pk2(w[1] * cs23[0] + w[0] * cs23[1], w[3] * cs23[2] + w[2] * cs23[3])};
        } else {
            const int g = ((c - 1024) >> 6) & 3;
            bf16_t* p = KV + (size_t)s * (KVSEG / 2) + ((size_t)(b * NG + g) * SEQ + t) * DH + (c & 63);
            *(u32x4*)p = (u32x4){pk2(v[0], v[1]), pk2(v[2], v[3]), pk2(w[0], w[1]), pk2(w[2], w[3])};
        }
    }
};
struct EpiMobaIn {
    bf16_t* Q; bf16_t* K; bf16_t* V; const float2* rope;
    __device__ __forceinline__ void operator()(int row, int c, f32x4 v) const {
        const int t = row & (SEQ - 1), b = row >> 13;
        if (c < 2048) {
            if (c < 1024) v = v * QSCALE;
            const int d = (c & 63) >> 1; const float2 c0 = rope[t * 32 + d], c1 = rope[t * 32 + d + 1];
            bf16_t* p = c < 1024 ? Q + (size_t)row * DM + (c & ~63) : K + ((size_t)(b * NH + ((c - 1024) >> 6)) * SEQ + t) * DH;
            *(unsigned*)(p + d) = pk2(v[0] * c0.x - v[1] * c0.y, v[2] * c1.x - v[3] * c1.y);
            *(unsigned*)(p + d + 32) = pk2(v[1] * c0.x + v[0] * c0.y, v[3] * c1.x + v[2] * c1.y);
        } else {
            bf16_t* p = V + ((size_t)(b * NH + ((c - 2048) >> 6)) * SEQ + t) * DH + (c & 63);
            *(u32x2*)p = (u32x2){pk2(v[0], v[1]), pk2(v[2], v[3])};
        }
    }
    __device__ __forceinline__ void operator()(int row, int c, f32x4 v, f32x4 w) const {
        const int t = row & (SEQ - 1), b = row >> 13;
        if (c < 2048) {
            if (c < 1024) { v = v * QSCALE; w = w * QSCALE; }
            const int d = (c & 63) >> 1;
            bf16_t* p = c < 1024 ? Q + (size_t)row * DM + (c & ~63) : K + ((size_t)(b * NH + ((c - 1024) >> 6)) * SEQ + t) * DH;
            const f32x4 cs01 = *(const f32x4*)(rope + t * 32 + d), cs23 = *(const f32x4*)(rope + t * 32 + d + 2);
            *(u32x2*)(p + d) = (u32x2){pk2(v[0] * cs01[0] - v[1] * cs01[1], v[2] * cs01[2] - v[3] * cs01[3]), pk2(w[0] * cs23[0] - w[1] * cs23[1], w[2] * cs23[2] - w[3] * cs23[3])};
            *(u32x2*)(p + d + 32) = (u32x2){pk2(v[1] * cs01[0] + v[0] * cs01[1], v[3] * cs01[2] + v[2] * cs01[3]), pk2(w[1] * cs23[0] + w[0] * cs23[1], w[3] * cs23[2] + w[2] * cs23[3])};
        } else {
            bf16_t* p = V + ((size_t)(b * NH + ((c - 2048) >> 6)) * SEQ + t) * DH + (c & 63);
            *(u32x4*)p = (u32x4){pk2(v[0], v[1]), pk2(v[2], v[3]), pk2(w[0], w[1]), pk2(w[2], w[3])};
        }
    }
};
struct EpiCmp {
    static constexpr bool AFTER = true;
    const float* bias; const bf16_t* W2T; const float2* rope; bf16_t* OUT;
    __device__ __forceinline__ void operator()(const f32x4 (&)[2][2][4][2], const g8::Unit&, int, int, int, int) const {}
    __device__ __forceinline__ void after(const f32x4 (&acc)[2][2][4][2], const g8::Unit& u, LAS unsigned char* lds, int wr, int wc, int fr, int fq, int wid, int lane) const {
#pragma unroll
        for (int bj = 0; bj < 2; ++bj) {
            const int c0 = bj * 128 + wc * 32 + 8 * fq;
            const f32x4 bv = *(const f32x4*)(bias + c0), bw = *(const f32x4*)(bias + c0 + 4);
#pragma unroll
            for (int ai = 0; ai < 2; ++ai)
#pragma unroll
                for (int m = 0; m < 4; ++m) { const int row = ai * 128 + wr * 64 + m * 16 + fr; const f32x4 v = acc[ai][bj][m][0] + bv, w = acc[ai][bj][m][1] + bw;
                    *(LAS u32x4*)(lds + row * 528 + c0 * 2) = (u32x4){pk2(gelu_tanh(v[0]), gelu_tanh(v[1])), pk2(gelu_tanh(v[2]), gelu_tanh(v[3])), pk2(gelu_tanh(w[0]), gelu_tanh(w[1])), pk2(gelu_tanh(w[2]), gelu_tanh(w[3]))}; }
        }
        asm volatile("s_waitcnt lgkmcnt(0)\n\ts_barrier" ::: "memory");
        f32x4 o[2][4];
#pragma unroll
        for (int rt = 0; rt < 2; ++rt)
#pragma unroll
            for (int dt = 0; dt < 4; ++dt) o[rt][dt] = (f32x4){0.f, 0.f, 0.f, 0.f};
#pragma unroll
        for (int s8 = 0; s8 < 8; ++s8) {
            bf16x8 hb[2], wa[4];
#pragma unroll
            for (int rt = 0; rt < 2; ++rt) hb[rt] = *(const LAS bf16x8*)(lds + (32 * wid + 16 * rt + fr) * 528 + (32 * s8 + 8 * fq) * 2);
#pragma unroll
            for (int dt = 0; dt < 4; ++dt) wa[dt] = *(const bf16x8*)(W2T + (16 * dt + fr) * 256 + 32 * s8 + 8 * fq);
#pragma unroll
            for (int rt = 0; rt < 2; ++rt)
#pragma unroll
                for (int dt = 0; dt < 4; ++dt) o[rt][dt] = __builtin_amdgcn_mfma_f32_16x16x32_bf16(wa[dt], hb[rt], o[rt][dt], 0, 0, 0);
        }
#pragma unroll
        for (int rt = 0; rt < 2; ++rt) {
            const int rg = u.pm * 256 + 32 * wid + 16 * rt + fr, ci = rg & 511;
            if (rope) {
#pragma unroll
                for (int dt = 0; dt < 2; ++dt) {
                    const f32x4 cs01 = *(const f32x4*)(rope + (16 * ci + 31) * 32 + 16 * dt + 4 * fq), cs23 = *(const f32x4*)(rope + (16 * ci + 31) * 32 + 16 * dt + 4 * fq + 2);
                    const f32x4 lo = o[rt][dt], hi = o[rt][dt + 2];
                    o[rt][dt] = (f32x4){lo[0] * cs01[0] - hi[0] * cs01[1], lo[1] * cs01[2] - hi[1] * cs01[3], lo[2] * cs23[0] - hi[2] * cs23[1], lo[3] * cs23[2] - hi[3] * cs23[3]};
                    o[rt][dt + 2] = (f32x4){hi[0] * cs01[0] + lo[0] * cs01[1], hi[1] * cs01[2] + lo[1] * cs01[3], hi[2] * cs23[0] + lo[2] * cs23[1], hi[3] * cs23[2] + lo[3] * cs23[3]};
                }
            }
            const float z = ci == 511 ? 0.f : 1.f;
#pragma unroll
            for (int dt = 0; dt < 4; ++dt) { const f32x4 x = o[rt][dt] * z; *(u32x2*)(OUT + (size_t)rg * 64 + 16 * dt + 4 * fq) = (u32x2){pk2(x[0], x[1]), pk2(x[2], x[3])}; }
        }
    }
};
struct EpiSwiGLU {
    bf16_t* H;
    __device__ __forceinline__ void operator()(int row, int c, f32x4 v) const {
        const float h0 = v[0] * sigmoidf_(v[0]) * v[1], h1 = v[2] * sigmoidf_(v[2]) * v[3];
        *(unsigned*)(H + (size_t)row * DE + (c >> 1)) = pk2(h0, h1);
    }
    __device__ __forceinline__ void operator()(int row, int c, f32x4 v, f32x4 w) const {
        *(u32x2*)(H + (size_t)row * DE + (c >> 1)) = (u32x2){pk2(v[0] * sigmoidf_(v[0]) * v[1], v[2] * sigmoidf_(v[2]) * v[3]), pk2(w[0] * sigmoidf_(w[0]) * w[1], w[2] * sigmoidf_(w[2]) * w[3])};
    }
};
struct EpiBf16 {
    bf16_t* Y;
    __device__ __forceinline__ void operator()(int row, int c, f32x4 v) const { *(u32x2*)(Y + (size_t)row * DM + c) = (u32x2){pk2(v[0], v[1]), pk2(v[2], v[3])}; }
    __device__ __forceinline__ void operator()(int row, int c, f32x4 v, f32x4 w) const { *(u32x4*)(Y + (size_t)row * DM + c) = (u32x4){pk2(v[0], v[1]), pk2(v[2], v[3]), pk2(w[0], w[1]), pk2(w[2], w[3])}; }
};

struct ExpertMap { int cnt[NE]; int base[NE + 1]; };
__device__ __forceinline__ void load_expert_map(const Ctx& C, int cw, LAS int* sm  ) {
    if (C.tid == 0) {
        const unsigned* ctl = (const unsigned*)(C.ws + WS_CTL); int acc = 0;
        for (int e = 0; e < NE; ++e) { const int c = (int)__hip_atomic_load(ctl + cw + 64 * e, __ATOMIC_RELAXED, __HIP_MEMORY_SCOPE_AGENT); sm[e] = c; sm[16 + e] = acc; acc += (c + 255) & ~255; }
        sm[32] = acc;
    }
    __syncthreads();
}

__device__ __forceinline__ void load_qh(const bf16_t* qp, float (&qh)[64]) {
    const uint4* q4 = (const uint4*)qp;
#pragma unroll
    for (int c = 0; c < 8; ++c) { const uint4 w = q4[c]; qh[8 * c] = bflo(w.x); qh[8 * c + 1] = bfhi(w.x); qh[8 * c + 2] = bflo(w.y); qh[8 * c + 3] = bfhi(w.y);
        qh[8 * c + 4] = bflo(w.z); qh[8 * c + 5] = bfhi(w.z); qh[8 * c + 6] = bflo(w.w); qh[8 * c + 7] = bfhi(w.w); }
}
namespace fa {
constexpr int SLOT = 16384, NSLOT = 4;
constexpr float C2 = 0.125f * 1.4426950408889634f;
constexpr float NEGBIG = -1e30f;
typedef short v4i16 __attribute__((ext_vector_type(4)));
__device__ __forceinline__ void dma_block(LAS unsigned char* slot, const bf16_t* Kg, const bf16_t* Vg, int wave, int lane) {
    { const int key = 8 * wave + (lane >> 3), c = (lane & 7) ^ ((key >> 1) & 7);
      __builtin_amdgcn_global_load_lds((const unsigned*)(Kg + key * 64 + 8 * c), (LAS unsigned*)(slot + wave * 1024), 16, 0, 0); }
    { const int key = 16 * (wave & 3) + (lane >> 2), cp = lane & 3, d = (wave >> 2) * 32 + ((((cp >> 1) ^ ((key >> 2) & 1))) << 4) + ((cp & 1) << 3);
      __builtin_amdgcn_global_load_lds((const unsigned*)(Vg + key * 64 + d), (LAS unsigned*)(slot + 8192 + wave * 1024), 16, 0, 0); }
}
__device__ __forceinline__ unsigned cvt_pk_bf16(float lo, float hi) { const f32x2v v = {lo, hi}; const bf16x2v b = __builtin_convertvector(v, bf16x2v); return __builtin_bit_cast(unsigned, b); }
struct Task { bf16x8 q[2]; int kmin, kmax; float m, l, cinit; f32x4 O[4]; f32x4 L; unsigned fw0; const LAS unsigned* fwp; int imptok; };
template <int FM> __device__ __forceinline__ bool row_flag(const Task& t, int jb) {
    if (FM == 0) return true;
    if (FM == 1) { const unsigned w = t.fwp[jb >> 5]; return ((w >> (jb & 31)) & 1u) != 0u; }
    return ((t.fw0 >> (jb >> 2)) & 1u) != 0u;
}
struct LaneC { int fq, koff0, koff1, voffA, voffB; };
__device__ __forceinline__ LaneC lane_consts(int lane) {
    const int i16 = lane & 15, fq = lane >> 4, kx = (i16 >> 1) & 7, q4 = i16 >> 2, p4 = lane & 3;
    LaneC lc; lc.fq = fq; lc.koff0 = i16 * 128 + ((fq ^ kx) << 4); lc.koff1 = i16 * 128 + (((4 + fq) ^ kx) << 4);
    lc.voffA = 8192 + (4 * fq + q4) * 64 + ((0 ^ (fq & 1)) << 5) + 8 * p4; lc.voffB = 8192 + (4 * fq + q4) * 64 + ((1 ^ (fq & 1)) << 5) + 8 * p4;
    return lc;
}
__device__ __forceinline__ float xrow16_max(float x) {
    auto s = __builtin_amdgcn_permlane16_swap(__float_as_uint(x), __float_as_uint(x), false, false);
    x = fmaxf(__uint_as_float(s[0]), __uint_as_float(s[1]));
    auto t = __builtin_amdgcn_permlane32_swap(__float_as_uint(x), __float_as_uint(x), false, false);
    return fmaxf(__uint_as_float(t[0]), __uint_as_float(t[1]));
}
__device__ __forceinline__ float xrow16_sum(float x) {
    auto s = __builtin_amdgcn_permlane16_swap(__float_as_uint(x), __float_as_uint(x), false, false);
    x = __uint_as_float(s[0]) + __uint_as_float(s[1]);
    auto t = __builtin_amdgcn_permlane32_swap(__float_as_uint(x), __float_as_uint(x), false, false);
    return __uint_as_float(t[0]) + __uint_as_float(t[1]);
}
__device__ __forceinline__ void t_mask(const Task& t, f32x4 (&s)[4], int kb, int fq) {
#pragma unroll
    for (int kt = 0; kt < 4; ++kt)
#pragma unroll
        for (int r = 0; r < 4; ++r) { const int key = kb + 16 * kt + 4 * fq + r; s[kt][r] = (key >= t.kmin && key <= t.kmax) ? s[kt][r] : NEGBIG; }
}
template <int MODE> __device__ __forceinline__ float t_stats(Task& t, f32x4 (&s)[4], bool rf) {
    float bm = fmaxf(fmaxf(fmaxf(s[0][0], s[0][1]), fmaxf(s[0][2], s[0][3])), fmaxf(fmaxf(s[1][0], s[1][1]), fmaxf(s[1][2], s[1][3])));
    bm = fmaxf(bm, fmaxf(fmaxf(fmaxf(s[2][0], s[2][1]), fmaxf(s[2][2], s[2][3])), fmaxf(fmaxf(s[3][0], s[3][1]), fmaxf(s[3][2], s[3][3]))));
    bm = xrow16_max(bm);
    if (!rf) bm = NEGBIG;
    const float mnew = fmaxf(t.m, bm);
    const float alpha = __builtin_amdgcn_exp2f(t.m - mnew);
    t.m = mnew;
    const float msub = (rf && mnew > -1e29f) ? mnew : __builtin_inff();
#pragma unroll
    for (int kt = 0; kt < 4; ++kt) s[kt] = s[kt] - msub;
    if (MODE == 1) t.l *= alpha;
    return alpha;
}
__device__ __forceinline__ void t_exp(f32x4 (&s)[4]) {
#pragma unroll
    for (int kt = 0; kt < 4; ++kt)
#pragma unroll
        for (int r = 0; r < 4; ++r) s[kt][r] = __builtin_amdgcn_exp2f(s[kt][r]);
}
__device__ __forceinline__ float quad_sum(float x) {
    x += __builtin_bit_cast(float, __builtin_amdgcn_mov_dpp(__builtin_bit_cast(int, x), 0xB1, 0xf, 0xf, true));
    x += __builtin_bit_cast(float, __builtin_amdgcn_mov_dpp(__builtin_bit_cast(int, x), 0x4E, 0xf, 0xf, true));
    return x;
}
__device__ __forceinline__ void t_imp(const Task& t, const f32x4 (&s)[4], int kb, int fq, LAS float* impbase) {
    float ga[4], gb[4];
#pragma unroll
    for (int kt = 0; kt < 4; ++kt) { ga[kt] = quad_sum((s[kt][0] + s[kt][1]) + (s[kt][2] + s[kt][3])); gb[kt] = quad_sum(s[kt][3]); }
    if ((t.imptok & 0x10000) == 0) return;
    LAS float* ip = impbase + (t.imptok & 0xffff) * 130 + (kb >> 2) + fq;
#pragma unroll
    for (int kt = 0; kt < 4; ++kt) { ip[4 * kt] = ga[kt]; ip[64 * 130 + 4 * kt] = gb[kt]; }
}
__device__ __forceinline__ bf16x8 t_pack(const f32x4 (&s)[4], int u) {
    u32x4 pw; pw.x = cvt_pk_bf16(s[2 * u][0], s[2 * u][1]); pw.y = cvt_pk_bf16(s[2 * u][2], s[2 * u][3]); pw.z = cvt_pk_bf16(s[2 * u + 1][0], s[2 * u + 1][1]); pw.w = cvt_pk_bf16(s[2 * u + 1][2], s[2 * u + 1][3]);
    return __builtin_bit_cast(bf16x8, pw);
}
template <int MODE, bool DA, bool DB>
__device__ __forceinline__ void do_blk(Task& a, Task& b, bool rfa, bool rfb, bool masked, LAS unsigned char* slot, int kb, LAS float* impbase, const LaneC& lc) {
    f32x4 sa[4], sb[4];
    const float xa = (MODE >= 2) ? (rfa ? a.cinit : -__builtin_inff()) : 0.f, xb = (MODE >= 2) ? (rfb ? b.cinit : -__builtin_inff()) : 0.f;
    const f32x4 ca = (f32x4){xa, xa, xa, xa}, cb = (f32x4){xb, xb, xb, xb};
#pragma unroll
    for (int kt = 0; kt < 4; ++kt) {
        const bf16x8 k0 = *(const LAS bf16x8*)(slot + lc.koff0 + kt * 2048), k1 = *(const LAS bf16x8*)(slot + lc.koff1 + kt * 2048);
        if (DA) { sa[kt] = __builtin_amdgcn_mfma_f32_16x16x32_bf16(k0, a.q[0], ca, 0, 0, 0); sa[kt] = __builtin_amdgcn_mfma_f32_16x16x32_bf16(k1, a.q[1], sa[kt], 0, 0, 0); }
        if (DB) { sb[kt] = __builtin_amdgcn_mfma_f32_16x16x32_bf16(k0, b.q[0], cb, 0, 0, 0); sb[kt] = __builtin_amdgcn_mfma_f32_16x16x32_bf16(k1, b.q[1], sb[kt], 0, 0, 0); }
    }
    if (masked) { if (DA) t_mask(a, sa, kb, lc.fq); if (DB) t_mask(b, sb, kb, lc.fq); }
    if (MODE < 2) {
        float ala = 1.0f, alb = 1.0f;
        if (DA) ala = t_stats<MODE>(a, sa, rfa);
        if (DB) alb = t_stats<MODE>(b, sb, rfb);
        if (MODE == 0) {
            if (__ballot((DA && ala != 1.0f) || (DB && alb != 1.0f)) != 0ull) {
#pragma unroll
                for (int dt = 0; dt < 4; ++dt) { if (DA) a.O[dt] = a.O[dt] * ala; if (DB) b.O[dt] = b.O[dt] * alb; }
                if (DA) a.L = a.L * ala; if (DB) b.L = b.L * alb;
            }
        }
    }
    if (DA) t_exp(sa);
    if (DB) t_exp(sb);
    if (MODE == 1) {
        if (DA) a.l += ((sa[0][0] + sa[0][1]) + (sa[0][2] + sa[0][3])) + ((sa[1][0] + sa[1][1]) + (sa[1][2] + sa[1][3])) + ((sa[2][0] + sa[2][1]) + (sa[2][2] + sa[2][3])) + ((sa[3][0] + sa[3][1]) + (sa[3][2] + sa[3][3]));
        if (DB) b.l += ((sb[0][0] + sb[0][1]) + (sb[0][2] + sb[0][3])) + ((sb[1][0] + sb[1][1]) + (sb[1][2] + sb[1][3])) + ((sb[2][0] + sb[2][1]) + (sb[2][2] + sb[2][3])) + ((sb[3][0] + sb[3][1]) + (sb[3][2] + sb[3][3]));
    }
    if (MODE == 2) { if (DA) t_imp(a, sa, kb, lc.fq, impbase); if (DB) t_imp(b, sb, kb, lc.fq, impbase); }
    if (MODE != 1) {
        const bf16x8 ones = (bf16x8){0x3F80, 0x3F80, 0x3F80, 0x3F80, 0x3F80, 0x3F80, 0x3F80, 0x3F80};
#pragma unroll
        for (int u = 0; u < 2; ++u) {
            bf16x8 pa, pb; if (DA) pa = t_pack(sa, u); if (DB) pb = t_pack(sb, u);
            if (MODE != 2) { if (DA) a.L = __builtin_amdgcn_mfma_f32_16x16x32_bf16(ones, pa, a.L, 0, 0, 0); if (DB) b.L = __builtin_amdgcn_mfma_f32_16x16x32_bf16(ones, pb, b.L, 0, 0, 0); }
#pragma unroll
            for (int dt = 0; dt < 4; ++dt) {
                const int vo = ((dt & 1) ? lc.voffB : lc.voffA) + (dt >> 1) * 4096 + u * 2048;
                const v4i16 a0 = __builtin_amdgcn_ds_read_tr16_b64_v4i16((LAS v4i16*)(slot + vo)), a1 = __builtin_amdgcn_ds_read_tr16_b64_v4i16((LAS v4i16*)(slot + vo + 1024));
                const bf16x8 vf = (bf16x8){a0[0], a0[1], a0[2], a0[3], a1[0], a1[1], a1[2], a1[3]};
                if (DA) a.O[dt] = __builtin_amdgcn_mfma_f32_16x16x32_bf16(vf, pa, a.O[dt], 0, 0, 0);
                if (DB) b.O[dt] = __builtin_amdgcn_mfma_f32_16x16x32_bf16(vf, pb, b.O[dt], 0, 0, 0);
            }
        }
    }
}
template <int MODE, int FM>
__device__ __forceinline__ void flash_loop(LAS unsigned char* ring, const bf16_t* Kg, const bf16_t* Vg, int nblk, Task& Ta, Task& Tb, LAS float* impbase, int wave, int lane) {
    const int i16 = lane & 15, fq = lane >> 4;
    const int kx = (i16 >> 1) & 7;
    const int q4 = i16 >> 2, p4 = lane & 3;
    LaneC lc; lc.fq = fq; lc.koff0 = i16 * 128 + ((fq ^ kx) << 4); lc.koff1 = i16 * 128 + (((4 + fq) ^ kx) << 4);
    lc.voffA = 8192 + (4 * fq + q4) * 64 + ((0 ^ (fq & 1)) << 5) + 8 * p4; lc.voffB = 8192 + (4 * fq + q4) * 64 + ((1 ^ (fq & 1)) << 5) + 8 * p4;
    const int amin = __builtin_amdgcn_readlane(Ta.kmin, 15), amax = __builtin_amdgcn_readlane(Ta.kmax, 0), bmin = __builtin_amdgcn_readlane(Tb.kmin, 15), bmax = __builtin_amdgcn_readlane(Tb.kmax, 0);
#pragma unroll
    for (int j = 0; j < NSLOT - 1; ++j) { const int jj = j < nblk ? j : nblk - 1; dma_block(ring + j * SLOT, Kg + (size_t)jj * 4096, Vg + (size_t)jj * 4096, wave, lane); }
    for (int jb = 0; jb < nblk; ++jb) {
        asm volatile("s_waitcnt vmcnt(4) lgkmcnt(0)\n\ts_barrier" ::: "memory");
        { const int jn = jb + 3 < nblk ? jb + 3 : nblk - 1; dma_block(ring + ((jb + 3) & 3) * SLOT, Kg + (size_t)jn * 4096, Vg + (size_t)jn * 4096, wave, lane); }
        LAS unsigned char* slot = ring + (jb & 3) * SLOT;
        const int kb = jb * 64;
        const bool rfa = row_flag<FM>(Ta, jb), rfb = row_flag<FM>(Tb, jb);
        const bool na = __ballot(rfa && Ta.kmax >= kb && Ta.kmin <= kb + 63) != 0ull, nb2 = __ballot(rfb && Tb.kmax >= kb && Tb.kmin <= kb + 63) != 0ull;
        const bool masked = !((!na || (kb >= amin && kb + 63 <= amax)) && (!nb2 || (kb >= bmin && kb + 63 <= bmax)));
        if (FM == 1) {
            if (na) do_blk<MODE, true, false>(Ta, Tb, rfa, rfb, masked, slot, kb, impbase, lc);
            if (nb2) do_blk<MODE, false, true>(Ta, Tb, rfa, rfb, masked, slot, kb, impbase, lc);
        } else {
            if (na || nb2) do_blk<MODE, true, true>(Ta, Tb, rfa, rfb, masked, slot, kb, impbase, lc);
        }
    }
    asm volatile("s_waitcnt vmcnt(0) lgkmcnt(0)\n\ts_barrier" ::: "memory");
}
template <int MODE, int FM>
__device__ __forceinline__ void flash_loop2(LAS unsigned char* ring, const bf16_t* Kg, const bf16_t* Vg, int nblk, Task& Ta, Task& Tb, LAS float* impbase, int wave, int lane) {
    const int i16 = lane & 15, fq = lane >> 4;
    const int kx = (i16 >> 1) & 7;
    const int q4 = i16 >> 2, p4 = lane & 3;
    LaneC lc; lc.fq = fq; lc.koff0 = i16 * 128 + ((fq ^ kx) << 4); lc.koff1 = i16 * 128 + (((4 + fq) ^ kx) << 4);
    lc.voffA = 8192 + (4 * fq + q4) * 64 + ((0 ^ (fq & 1)) << 5) + 8 * p4; lc.voffB = 8192 + (4 * fq + q4) * 64 + ((1 ^ (fq & 1)) << 5) + 8 * p4;
    const int amin = __builtin_amdgcn_readlane(Ta.kmin, 15), amax = __builtin_amdgcn_readlane(Ta.kmax, 0), bmin = __builtin_amdgcn_readlane(Tb.kmin, 15), bmax = __builtin_amdgcn_readlane(Tb.kmax, 0);
    const int nit = (nblk + 1) >> 1;
#pragma unroll
    for (int j = 0; j < 2; ++j) { const int jj = j < nblk ? j : nblk - 1; dma_block(ring + j * SLOT, Kg + (size_t)jj * 4096, Vg + (size_t)jj * 4096, wave, lane); }
    for (int i = 0; i < nit; ++i) {
        asm volatile("s_waitcnt vmcnt(0) lgkmcnt(0)\n\ts_barrier" ::: "memory");
#pragma unroll
        for (int j = 0; j < 2; ++j) { const int jn = 2 * i + 2 + j < nblk ? 2 * i + 2 + j : nblk - 1; dma_block(ring + ((2 * i + 2 + j) & 3) * SLOT, Kg + (size_t)jn * 4096, Vg + (size_t)jn * 4096, wave, lane); }
        if (FM == 1 && !SEL_FUSED) {
#pragma unroll
        for (int k = 0; k < 2; ++k) {
            const int jb = 2 * i + k;
            if (jb < nblk) {
                LAS unsigned char* slot = ring + (jb & 3) * SLOT;
                const int kb = jb * 64;
                const bool rfa = row_flag<FM>(Ta, jb), rfb = row_flag<FM>(Tb, jb);
                const bool na = __ballot(rfa && Ta.kmax >= kb && Ta.kmin <= kb + 63) != 0ull, nb2 = __ballot(rfb && Tb.kmax >= kb && Tb.kmin <= kb + 63) != 0ull;
                const bool masked = !((!na || (kb >= amin && kb + 63 <= amax)) && (!nb2 || (kb >= bmin && kb + 63 <= bmax)));
                if (na) do_blk<MODE, true, false>(Ta, Tb, rfa, rfb, masked, slot, kb, impbase, lc);
                if (nb2) do_blk<MODE, false, true>(Ta, Tb, rfa, rfb, masked, slot, kb, impbase, lc);
            }
        }
        } else {
            const int j0 = 2 * i, j1 = 2 * i + 1;
            const bool ra0 = row_flag<FM>(Ta, j0), rb0 = row_flag<FM>(Tb, j0), ra1 = j1 < nblk && row_flag<FM>(Ta, j1), rb1 = j1 < nblk && row_flag<FM>(Tb, j1);
            if (__ballot(ra0 || rb0 || ra1 || rb1) != 0ull) {
                const int k0 = j0 * 64, k1 = j1 * 64;
                const bool mk = (FM == 0) && !(k0 >= amin && k1 + 63 <= amax && k0 >= bmin && k1 + 63 <= bmax);
                if (!mk) {
                    do_blk<MODE, true, true>(Ta, Tb, ra0, rb0, false, ring + (j0 & 3) * SLOT, k0, impbase, lc);
                    if (FM == 0) __builtin_amdgcn_sched_barrier(0);
                    do_blk<MODE, true, true>(Ta, Tb, ra1, rb1, false, ring + (j1 & 3) * SLOT, k1, impbase, lc);
                } else {
                    do_blk<MODE, true, true>(Ta, Tb, ra0, rb0, true, ring + (j0 & 3) * SLOT, k0, impbase, lc);
                    __builtin_amdgcn_sched_barrier(0);
                    do_blk<MODE, true, true>(Ta, Tb, ra1, rb1, true, ring + (j1 & 3) * SLOT, k1, impbase, lc);
                }
            }
        }
    }
    asm volatile("s_waitcnt vmcnt(0) lgkmcnt(0)\n\ts_barrier" ::: "memory");
}
__device__ __forceinline__ void task_reset(Task& t) { t.m = NEGBIG; t.l = 0.f; t.cinit = 0.f; t.L = (f32x4){0.f, 0.f, 0.f, 0.f};
#pragma unroll
    for (int dt = 0; dt < 4; ++dt) t.O[dt] = (f32x4){0.f, 0.f, 0.f, 0.f}; }
__device__ __forceinline__ float task_rowsum(const Task& t) { return t.L[0]; }
__device__ __forceinline__ float task_rowsum_stats(const Task& t) { return xrow16_sum(t.l); }
constexpr float REF_DELTA = 32.f;
__device__ __forceinline__ void task_fix_ref(Task& t) {
    t.cinit = -(t.m + REF_DELTA);
    const float sc = __builtin_amdgcn_exp2f(-REF_DELTA);
    t.L = t.L * sc;
#pragma unroll
    for (int dt = 0; dt < 4; ++dt) t.O[dt] = t.O[dt] * sc;
}
}

struct NsaRow { int RI, c, b; u32x2 out[4];
    __device__ __forceinline__ int tokl() const { return RI >> 2; }
    __device__ __forceinline__ int head() const { return RI & 3; }
    __device__ __forceinline__ int tt() const { return 64 * c + (RI >> 2); }
    __device__ __forceinline__ size_t grow() const { return (size_t)(b * SEQ + 64 * c + (RI >> 2)); }
};
__device__ __forceinline__ void nsa_row_init(NsaRow& r, fa::Task& t, const bf16_t* Q, int b, int g, int c, int R, int fq) {
    r.RI = R; r.c = c; r.b = b;
    const bf16_t* qp = Q + r.grow() * DM + (g * 4 + r.head()) * DH + 8 * fq;
    t.q[0] = *(const bf16x8*)qp; t.q[1] = *(const bf16x8*)(qp + 32);
    t.imptok = r.tokl() | (r.head() == 0 ? 0x10000 : 0); t.fw0 = 0u; t.fwp = nullptr;
#pragma unroll
    for (int dt = 0; dt < 4; ++dt) r.out[dt] = (u32x2){0u, 0u};
}
__device__ __forceinline__ void nsa_cmp_setup(const NsaRow& r, fa::Task& t) {
    const int tt_ = r.tt(); const int nv = tt_ >= 31 ? (((tt_ - 31) >> 4) + 1 > 511 ? 511 : ((tt_ - 31) >> 4) + 1) : 0;
    t.kmin = 0; t.kmax = nv - 1; fa::task_reset(t);
}
__device__ __forceinline__ void nsa_accum(NsaRow& r, const fa::Task& t, float sc) {
#pragma unroll
    for (int dt = 0; dt < 4; ++dt) { const f32x4 o = t.O[dt] * sc; const u32x2 w = r.out[dt];
        r.out[dt] = (u32x2){pk2(bflo(w.x) + o[0], bfhi(w.x) + o[1]), pk2(bflo(w.y) + o[2], bfhi(w.y) + o[3])}; }
}
__device__ __forceinline__ void nsa_store(const NsaRow& r, bf16_t* AO, int g, int fq) {
    bf16_t* op = AO + r.grow() * DM + (g * 4 + r.head()) * DH + 4 * fq;
#pragma unroll
    for (int dt = 0; dt < 4; ++dt) *(u32x2*)(op + 16 * dt) = r.out[dt];
}
__device__ __forceinline__ void ph_nsa_fa(const Ctx& C) {
    LAS unsigned char* L = (LAS unsigned char*)C.lds;
    LAS unsigned char* ring = L;
    LAS float* imp = (LAS float*)(L + 65536);
    LAS unsigned* selm = (LAS unsigned*)(L + 135168);
    const bf16_t* Q = (const bf16_t*)(C.ws + WS_Q); const bf16_t* KC = (const bf16_t*)(C.ws + WS_KC); const bf16_t* VC = (const bf16_t*)(C.ws + WS_VC);
    const bf16_t* KS = (const bf16_t*)(C.ws + WS_KV0 + 2 * KVSEG); const bf16_t* VS = (const bf16_t*)(C.ws + WS_KV0 + 3 * KVSEG);
    const bf16_t* KW = (const bf16_t*)(C.ws + WS_KV0 + 4 * KVSEG); const bf16_t* VW = (const bf16_t*)(C.ws + WS_KV0 + 5 * KVSEG);
    const float* gates = (const float*)(C.ws + WS_GATES); bf16_t* AO = (bf16_t*)(C.ws + WS_Q);
    const int wave = C.wave;
    for (int u = C.bid; u < NB * NG * (SEQ / 64); u += C.nb) {
        int lane = C.lane; asm volatile("" : "+v"(lane));
        const int i16 = lane & 15, fq = lane >> 4;
        const int rnd = u / C.nb, idx = (u % C.nb) >> 4, bg = u & 15, b = bg >> 2, g = bg & 3;
        const int c = (C.nb == 256) ? 127 - 16 * rnd - ((rnd & 1) ? 15 - idx : idx) : 127 - (u >> 4);
        fa::Task T0, T1; NsaRow R0, R1;
        nsa_row_init(R0, T0, Q, b, g, c, 32 * wave + i16, fq);
        nsa_row_init(R1, T1, Q, b, g, c, 32 * wave + 16 + i16, fq);
        for (int i = C.tid; i < 2 * 64 * 130; i += NTHREADS) imp[i] = 0.f;
        if (C.tid < 256) selm[C.tid] = 0u;
        const int nvm = ((64 * c + 63 - 31) >> 4) + 1;
        const int nvmax = nvm > 511 ? 511 : nvm;
        const int nblkc = (nvmax + 63) >> 6;
        nsa_cmp_setup(R0, T0); nsa_cmp_setup(R1, T1);
        fa::flash_loop<1, 0>(ring, KC + (size_t)bg * 512 * DH, VC + (size_t)bg * 512 * DH, nblkc, T0, T1, imp, wave, lane);
        { const float l0 = fa::task_rowsum_stats(T0), l1 = fa::task_rowsum_stats(T1);
          T0.cinit = l0 > 0.f ? -T0.m - __builtin_amdgcn_logf(l0) : -__builtin_inff(); T1.cinit = l1 > 0.f ? -T1.m - __builtin_amdgcn_logf(l1) : -__builtin_inff(); }
        fa::flash_loop<2, 0>(ring, KC + (size_t)bg * 512 * DH, VC + (size_t)bg * 512 * DH, nblkc, T0, T1, imp, wave, lane);
        nsa_accum(R0, T0, gates[R0.grow() * 48 + g * 4 + R0.head()]);
        nsa_accum(R1, T1, gates[R1.grow() * 48 + g * 4 + R1.head()]);
        {
            const int jq = c, ncand = jq - 2 > 0 ? jq - 2 : 0, nforced = jq == 0 ? 1 : (jq == 1 ? 2 : 3), need = 16 - nforced;
#pragma unroll
            for (int g2 = 0; g2 < 2; ++g2) {
                const int tk = 8 * wave + 4 * g2 + (lane >> 4);
                unsigned key[8]; unsigned selb = 0u;
#pragma unroll
                for (int k = 0; k < 8; ++k) { const int j = i16 + 16 * k; const bool cand = j >= 1 && j <= jq - 2;
                    key[k] = cand ? ((__float_as_uint(imp[tk * 130 + j] + imp[64 * 130 + tk * 130 + j - 1]) & 0xFFFFFF80u) | (unsigned)(127 - j)) : 0u; }
                if (ncand <= need) {
#pragma unroll
                    for (int k = 0; k < 8; ++k) selb |= (key[k] != 0u) ? (1u << k) : 0u;
                } else {
                    for (int r = 0; r < need; ++r) {
                        unsigned m = max(max(max(key[0], key[1]), max(key[2], key[3])), max(max(key[4], key[5]), max(key[6], key[7])));
                        m = max(m, (unsigned)__builtin_amdgcn_mov_dpp((int)m, 0xB1, 0xf, 0xf, true));
                        m = max(m, (unsigned)__builtin_amdgcn_mov_dpp((int)m, 0x4E, 0xf, 0xf, true));
                        m = max(m, (unsigned)__builtin_amdgcn_mov_dpp((int)m, 0x141, 0xf, 0xf, true));
                        m = max(m, (unsigned)__builtin_amdgcn_mov_dpp((int)m, 0x140, 0xf, 0xf, true));
#pragma unroll
                        for (int k = 0; k < 8; ++k) { const bool hit = key[k] == m; selb |= hit ? (1u << k) : 0u; key[k] = hit ? 0u : key[k]; }
                    }
                }
#pragma unroll
                for (int k = 0; k < 8; ++k) { const int j = i16 + 16 * k; if (j == 0 || j == jq || j == jq - 1) selb |= 1u << k; }
#pragma unroll
                for (int w2 = 0; w2 < 4; ++w2) {
                    const unsigned bits = (((selb >> (2 * w2)) & 1u) << i16) | (((selb >> (2 * w2 + 1)) & 1u) << (16 + i16));
                    if (bits) __hip_atomic_fetch_or(selm + tk * 4 + w2, bits, __ATOMIC_RELAXED, __HIP_MEMORY_SCOPE_WORKGROUP);
                }
            }
        }
        asm volatile("s_waitcnt lgkmcnt(0)\n\ts_barrier" ::: "memory");
        {
            const int jlo = c - 8 > 0 ? c - 8 : 0;
            T0.kmin = 0; T0.kmax = R0.tokl(); fa::task_reset(T0); T1.kmin = 0; T1.kmax = R1.tokl(); fa::task_reset(T1);
            fa::flash_loop<0, 0>(ring, KW + ((size_t)bg * SEQ + 64 * c) * DH, VW + ((size_t)bg * SEQ + 64 * c) * DH, 1, T0, T1, imp, wave, lane);
            fa::task_fix_ref(T0); fa::task_fix_ref(T1);
            T0.kmin = R0.tt() - 511 - 64 * jlo; T0.kmax = R0.tt() - 64 * jlo; T1.kmin = R1.tt() - 511 - 64 * jlo; T1.kmax = R1.tt() - 64 * jlo;
            if (c > jlo) fa::flash_loop2<3, 0>(ring, KW + ((size_t)bg * SEQ + 64 * jlo) * DH, VW + ((size_t)bg * SEQ + 64 * jlo) * DH, c - jlo, T0, T1, imp, wave, lane);
            const float l0 = fa::task_rowsum(T0), l1 = fa::task_rowsum(T1);
            nsa_accum(R0, T0, (l0 > 0.f ? 1.0f / l0 : 0.f) * gates[R0.grow() * 48 + 32 + g * 4 + R0.head()]);
            nsa_accum(R1, T1, (l1 > 0.f ? 1.0f / l1 : 0.f) * gates[R1.grow() * 48 + 32 + g * 4 + R1.head()]);
        }
        {
            T0.fwp = selm + R0.tokl() * 4; T1.fwp = selm + R1.tokl() * 4;
            T0.kmin = 0; T0.kmax = R0.tokl(); fa::task_reset(T0); T1.kmin = 0; T1.kmax = R1.tokl(); fa::task_reset(T1);
            fa::flash_loop<0, 0>(ring, KS + ((size_t)bg * SEQ + 64 * c) * DH, VS + ((size_t)bg * SEQ + 64 * c) * DH, 1, T0, T1, imp, wave, lane);
            T0.kmax = R0.tt(); T1.kmax = R1.tt(); fa::task_fix_ref(T0); fa::task_fix_ref(T1);
            if (c > 0) fa::flash_loop2<3, 1>(ring, KS + (size_t)bg * SEQ * DH, VS + (size_t)bg * SEQ * DH, c, T0, T1, imp, wave, lane);
            const float l0 = fa::task_rowsum(T0), l1 = fa::task_rowsum(T1);
            nsa_accum(R0, T0, (l0 > 0.f ? 1.0f / l0 : 0.f) * gates[R0.grow() * 48 + 16 + g * 4 + R0.head()]);
            nsa_accum(R1, T1, (l1 > 0.f ? 1.0f / l1 : 0.f) * gates[R1.grow() * 48 + 16 + g * 4 + R1.head()]);
        }
        nsa_store(R0, AO, g, fq); nsa_store(R1, AO, g, fq);
    }
}

constexpr size_t WS_MMASK = 6 * MiB;
constexpr size_t WS_MCINIT = 8 * MiB;
constexpr size_t WS_MPL = 10 * MiB;
__device__ __forceinline__ size_t moba_po_off(int s, int b) {
    const int p = s * 4 + b;
    return p < 8 ? (353 + 16 * (size_t)p) * MiB : (p < 11 ? (45 + 16 * (size_t)(p - 8)) * MiB : 16 * MiB);
}
__device__ __forceinline__ void ph_moba_sel(const Ctx& C) {
    LAS unsigned char* L = (LAS unsigned char*)C.lds;
    LAS unsigned char* ring = L;
    LAS unsigned char* kmt = L + 65536;
    const bf16_t* Q = (const bf16_t*)(C.ws + WS_Q); const bf16_t* K1 = (const bf16_t*)(C.ws + WS_K1); const bf16_t* V1 = (const bf16_t*)(C.ws + WS_V1);
    const float* KM = (const float*)(C.ws + WS_KMEAN); unsigned* MM = (unsigned*)(C.ws + WS_MMASK); float* CI = (float*)(C.ws + WS_MCINIT);
    const int wave = C.wave;
    for (int u = C.bid; u < NB * NH * 32; u += C.nb) {
        int lane = C.lane; asm volatile("" : "+v"(lane));
        const int i16 = lane & 15, fq = lane >> 4;
        const int bh = u & 63, b = bh >> 4, h = bh & 15, cb = 31 - (u >> 6);
#pragma unroll
        for (int sb = 0; sb < 4; ++sb) fa::dma_block(ring + sb * fa::SLOT, K1 + ((size_t)bh * SEQ + 256 * cb + 64 * sb) * DH, V1 + ((size_t)bh * SEQ + 256 * cb + 64 * sb) * DH, wave, lane);
        if (C.tid < 256) {
            const int n = C.tid >> 3, c8 = C.tid & 7;
            const f32x4 a = *(const f32x4*)(KM + (size_t)bh * 2048 + n * 64 + 8 * c8), b2 = *(const f32x4*)(KM + (size_t)bh * 2048 + n * 64 + 8 * c8 + 4);
            u32x4 hi, lo;
            hi.x = pk2(a[0], a[1]); hi.y = pk2(a[2], a[3]); hi.z = pk2(b2[0], b2[1]); hi.w = pk2(b2[2], b2[3]);
            lo.x = pk2(a[0] - bflo(hi.x), a[1] - bfhi(hi.x)); lo.y = pk2(a[2] - bflo(hi.y), a[3] - bfhi(hi.y)); lo.z = pk2(b2[0] - bflo(hi.z), b2[1] - bfhi(hi.z)); lo.w = pk2(b2[2] - bflo(hi.w), b2[3] - bfhi(hi.w));
            const int off = n * 128 + ((c8 ^ ((n >> 1) & 7)) << 4);
            *(LAS u32x4*)(kmt + off) = hi; *(LAS u32x4*)(kmt + 4096 + off) = lo;
        }
        fa::Task T[2]; int tt[2];
#pragma unroll
        for (int ti = 0; ti < 2; ++ti) {
            const int R = 32 * wave + 16 * ti + i16; tt[ti] = 256 * cb + R; T[ti].imptok = 0;
            const bf16_t* qp = Q + (size_t)(b * SEQ + tt[ti]) * DM + h * DH + 8 * fq;
            T[ti].q[0] = *(const bf16x8*)qp; T[ti].q[1] = *(const bf16x8*)(qp + 32);
            T[ti].kmin = 0; T[ti].kmax = R; fa::task_reset(T[ti]);
        }
        asm volatile("s_waitcnt vmcnt(0) lgkmcnt(0)\n\ts_barrier" ::: "memory");
#pragma unroll
        for (int ti = 0; ti < 2; ++ti) {
            const int kx = (i16 >> 1) & 7, ko0 = i16 * 128 + ((fq ^ kx) << 4), ko1 = i16 * 128 + (((4 + fq) ^ kx) << 4);
            float bv0 = -3e38f, bv1 = -3e38f, bv2 = -3e38f; int j0 = 99, j1 = 99, j2 = 99;
#define INS3(a, n) do { if ((a) > bv0 || ((a) == bv0 && (n) < j0)) { bv2 = bv1; j2 = j1; bv1 = bv0; j1 = j0; bv0 = (a); j0 = (n); } \
                else if ((a) > bv1 || ((a) == bv1 && (n) < j1)) { bv2 = bv1; j2 = j1; bv1 = (a); j1 = (n); } \
                else if ((a) > bv2 || ((a) == bv2 && (n) < j2)) { bv2 = (a); j2 = (n); } } while (0)
#pragma unroll
            for (int kt2 = 0; kt2 < 2; ++kt2) {
                const bf16x8 h0 = *(const LAS bf16x8*)(kmt + ko0 + kt2 * 2048), h1 = *(const LAS bf16x8*)(kmt + ko1 + kt2 * 2048);
                const bf16x8 l0 = *(const LAS bf16x8*)(kmt + 4096 + ko0 + kt2 * 2048), l1 = *(const LAS bf16x8*)(kmt + 4096 + ko1 + kt2 * 2048);
                f32x4 g = __builtin_amdgcn_mfma_f32_16x16x32_bf16(l0, T[ti].q[0], (f32x4){0.f, 0.f, 0.f, 0.f}, 0, 0, 0);
                g = __builtin_amdgcn_mfma_f32_16x16x32_bf16(l1, T[ti].q[1], g, 0, 0, 0);
                g = __builtin_amdgcn_mfma_f32_16x16x32_bf16(h0, T[ti].q[0], g, 0, 0, 0);
                g = __builtin_amdgcn_mfma_f32_16x16x32_bf16(h1, T[ti].q[1], g, 0, 0, 0);
#pragma unroll
                for (int r = 0; r < 4; ++r) { const int n = 16 * kt2 + 4 * fq + r; const float a = n < cb ? g[r] : -3e38f; INS3(a, n); }
            }
#pragma unroll
            for (int o = 16; o <= 32; o <<= 1) {
                const float ov0 = __shfl_xor(bv0, o), ov1 = __shfl_xor(bv1, o), ov2 = __shfl_xor(bv2, o); const int oj0 = __shfl_xor(j0, o), oj1 = __shfl_xor(j1, o), oj2 = __shfl_xor(j2, o);
                INS3(ov0, oj0); INS3(ov1, oj1); INS3(ov2, oj2);
            }
#undef INS3
            unsigned mk = 0u;
            if (j0 < cb && bv0 > -1e38f) mk |= 1u << j0; if (j1 < cb && bv1 > -1e38f) mk |= 1u << j1; if (j2 < cb && bv2 > -1e38f) mk |= 1u << j2;
            T[ti].fw0 = mk;
        }
        { const fa::LaneC lc = fa::lane_consts(lane);
#pragma unroll
          for (int sb = 0; sb < 4; ++sb) if (64 * sb <= 32 * wave + 31) fa::do_blk<1, true, true>(T[0], T[1], true, true, 64 * sb + 63 > 32 * wave, ring + sb * fa::SLOT, 64 * sb, nullptr, lc); }
        if (fq == 0) {
#pragma unroll
            for (int ti = 0; ti < 2; ++ti) { MM[(size_t)bh * SEQ + tt[ti]] = T[ti].fw0; CI[(size_t)bh * SEQ + tt[ti]] = -(T[ti].m + fa::REF_DELTA); }
        }
        asm volatile("s_waitcnt lgkmcnt(0)\n\ts_barrier" ::: "memory");
    }
}
__device__ __forceinline__ void ph_moba_gather(const Ctx& C) {
    LAS unsigned char* L = (LAS unsigned char*)C.lds;
    LAS unsigned char* ring = L;
    LAS unsigned short* list = (LAS unsigned short*)(L + 65536);
    LAS unsigned* cnt = (LAS unsigned*)(L + 65536 + 16384);
    const bf16_t* Q = (const bf16_t*)(C.ws + WS_Q); const bf16_t* K1 = (const bf16_t*)(C.ws + WS_K1); const bf16_t* V1 = (const bf16_t*)(C.ws + WS_V1);
    const unsigned* MM = (const unsigned*)(C.ws + WS_MMASK); const float* CI = (const float*)(C.ws + WS_MCINIT); float* PL = (float*)(C.ws + WS_MPL);
    const int wave = C.wave;
    if (C.tid < 2) cnt[C.tid] = 0u;
    __syncthreads();
    int par = 0;
    for (int u = C.bid; u < NB * NH * 32; u += C.nb) {
        int lane = C.lane; asm volatile("" : "+v"(lane));
        const int i16 = lane & 15, fq = lane >> 4, tid = 64 * wave + lane;
        const int rnd = u / C.nb, idx = (u % C.nb) >> 6, bh = u & 63, b = bh >> 4, h = bh & 15;
        const int j = (C.nb == 256) ? 4 * rnd + ((rnd & 1) ? 3 - idx : idx) : (u >> 6);
        if (j >= 31) continue;
#pragma unroll
        for (int sb = 0; sb < 4; ++sb) fa::dma_block(ring + sb * fa::SLOT, K1 + ((size_t)bh * SEQ + 256 * j + 64 * sb) * DH, V1 + ((size_t)bh * SEQ + 256 * j + 64 * sb) * DH, wave, lane);
        { const int r0 = 256 * (j + 1), N = SEQ - r0;
          const unsigned* mp = MM + (size_t)bh * SEQ + r0;
          u32x4 mv[4];
#pragma unroll
          for (int i = 0; i < 4; ++i) { const int i4 = 4 * tid + 2048 * i; mv[i] = (u32x4){0u, 0u, 0u, 0u}; if (i4 < N) mv[i] = *(const u32x4*)(mp + i4); }
          const unsigned long long lt = (1ull << lane) - 1ull;
#pragma unroll
          for (int i = 0; i < 4; ++i) {
              const bool s0 = (mv[i].x >> j) & 1u, s1 = (mv[i].y >> j) & 1u, s2 = (mv[i].z >> j) & 1u, s3 = (mv[i].w >> j) & 1u;
              const unsigned long long b0 = __ballot(s0), b1 = __ballot(s1), b2 = __ballot(s2), b3 = __ballot(s3);
              const int c0 = __popcll(b0), c1 = __popcll(b1), c2 = __popcll(b2), c3 = __popcll(b3), tot = c0 + c1 + c2 + c3;
              if (tot) {
                  unsigned base = 0u;
                  if (lane == 0) base = __hip_atomic_fetch_add(cnt + par, (unsigned)tot, __ATOMIC_RELAXED, __HIP_MEMORY_SCOPE_WORKGROUP);
                  base = __builtin_amdgcn_readfirstlane(base);
                  const int rb = r0 + 4 * tid + 2048 * i;
                  if (s0) list[base + __popcll(b0 & lt)] = (unsigned short)rb;
                  if (s1) list[base + c0 + __popcll(b1 & lt)] = (unsigned short)(rb + 1);
                  if (s2) list[base + c0 + c1 + __popcll(b2 & lt)] = (unsigned short)(rb + 2);
                  if (s3) list[base + c0 + c1 + c2 + __popcll(b3 & lt)] = (unsigned short)(rb + 3);
              }
          } }
        asm volatile("s_waitcnt vmcnt(0) lgkmcnt(0)\n\ts_barrier" ::: "memory");
        if (tid == 0) cnt[par ^ 1] = 0u;
        const int n = (int)cnt[par], npair = (n + 31) >> 5;
        const fa::LaneC lc = fa::lane_consts(lane);
        for (int p = wave; p < npair; p += NWAVES) {
            fa::Task Ta, Tb;
            const int ia = 32 * p + i16, ib = ia + 16; const bool va = ia < n, vb = ib < n;
            const int rowa = list[va ? ia : 0], rowb = list[vb ? ib : 0];
            { const bf16_t* qp = Q + (size_t)(b * SEQ + rowa) * DM + h * DH + 8 * fq; Ta.q[0] = *(const bf16x8*)qp; Ta.q[1] = *(const bf16x8*)(qp + 32); }
            { const bf16_t* qp = Q + (size_t)(b * SEQ + rowb) * DM + h * DH + 8 * fq; Tb.q[0] = *(const bf16x8*)qp; Tb.q[1] = *(const bf16x8*)(qp + 32); }
            fa::task_reset(Ta); fa::task_reset(Tb); Ta.kmin = 0; Ta.kmax = 0x7fffffff; Tb.kmin = 0; Tb.kmax = 0x7fffffff; Ta.imptok = 0; Tb.imptok = 0;
            Ta.cinit = CI[(size_t)bh * SEQ + rowa]; Tb.cinit = CI[(size_t)bh * SEQ + rowb];
            const unsigned ma = MM[(size_t)bh * SEQ + rowa], mb = MM[(size_t)bh * SEQ + rowb];
#pragma unroll
            for (int sb = 0; sb < 4; ++sb) fa::do_blk<3, true, true>(Ta, Tb, va, vb, false, ring + sb * fa::SLOT, 0, nullptr, lc);
            if (va) { const int s = __popc(ma & ((1u << j) - 1u));
                bf16_t* op = (bf16_t*)(C.ws + moba_po_off(s, b)) + ((size_t)h * SEQ + rowa) * DH + 4 * fq;
#pragma unroll
                for (int dt = 0; dt < 4; ++dt) *(u32x2*)(op + 16 * dt) = (u32x2){pk2(Ta.O[dt][0], Ta.O[dt][1]), pk2(Ta.O[dt][2], Ta.O[dt][3])};
                if (fq == 0) PL[((size_t)s * 64 + bh) * SEQ + rowa] = Ta.L[0]; }
            if (vb) { const int s = __popc(mb & ((1u << j) - 1u));
                bf16_t* op = (bf16_t*)(C.ws + moba_po_off(s, b)) + ((size_t)h * SEQ + rowb) * DH + 4 * fq;
#pragma unroll
                for (int dt = 0; dt < 4; ++dt) *(u32x2*)(op + 16 * dt) = (u32x2){pk2(Tb.O[dt][0], Tb.O[dt][1]), pk2(Tb.O[dt][2], Tb.O[dt][3])};
                if (fq == 0) PL[((size_t)s * 64 + bh) * SEQ + rowb] = Tb.L[0]; }
        }
        asm volatile("s_waitcnt lgkmcnt(0)\n\ts_barrier" ::: "memory");
        par ^= 1;
    }
}
__device__ __forceinline__ void ph_moba_own(const Ctx& C) {
    LAS unsigned char* L = (LAS unsigned char*)C.lds;
    LAS unsigned char* ring = L;
    const bf16_t* Q = (const bf16_t*)(C.ws + WS_Q); const bf16_t* K1 = (const bf16_t*)(C.ws + WS_K1); const bf16_t* V1 = (const bf16_t*)(C.ws + WS_V1);
    const unsigned* MM = (const unsigned*)(C.ws + WS_MMASK); const float* CI = (const float*)(C.ws + WS_MCINIT); const float* PL = (const float*)(C.ws + WS_MPL);
    bf16_t* AO = (bf16_t*)(C.ws + WS_Q);
    const int wave = C.wave;
    for (int u = C.bid; u < NB * NH * 32; u += C.nb) {
        int lane = C.lane; asm volatile("" : "+v"(lane));
        const int i16 = lane & 15, fq = lane >> 4;
        const int bh = u & 63, b = bh >> 4, h = bh & 15, cb = 31 - (u >> 6);
#pragma unroll
        for (int sb = 0; sb < 4; ++sb) fa::dma_block(ring + sb * fa::SLOT, K1 + ((size_t)bh * SEQ + 256 * cb + 64 * sb) * DH, V1 + ((size_t)bh * SEQ + 256 * cb + 64 * sb) * DH, wave, lane);
        fa::Task T[2]; int tt[2]; unsigned mk[2];
#pragma unroll
        for (int ti = 0; ti < 2; ++ti) {
            const int R = 32 * wave + 16 * ti + i16; tt[ti] = 256 * cb + R; T[ti].imptok = 0;
            const bf16_t* qp = Q + (size_t)(b * SEQ + tt[ti]) * DM + h * DH + 8 * fq;
            T[ti].q[0] = *(const bf16x8*)qp; T[ti].q[1] = *(const bf16x8*)(qp + 32);
            T[ti].kmin = 0; T[ti].kmax = R; fa::task_reset(T[ti]);
            T[ti].cinit = CI[(size_t)bh * SEQ + tt[ti]]; mk[ti] = MM[(size_t)bh * SEQ + tt[ti]];
        }
        asm volatile("s_waitcnt vmcnt(0) lgkmcnt(0)\n\ts_barrier" ::: "memory");
        { const fa::LaneC lc = fa::lane_consts(lane);
#pragma unroll
          for (int sb = 0; sb < 4; ++sb) if (64 * sb <= 32 * wave + 31) fa::do_blk<3, true, true>(T[0], T[1], true, true, 64 * sb + 63 > 32 * wave, ring + sb * fa::SLOT, 64 * sb, nullptr, lc); }
#pragma unroll
        for (int ti = 0; ti < 2; ++ti) {
            const int ns = __popc(mk[ti]); float l = fa::task_rowsum(T[ti]);
#pragma unroll
            for (int s = 0; s < 3; ++s) if (s < ns) {
                const bf16_t* pp = (const bf16_t*)(C.ws + moba_po_off(s, b)) + ((size_t)h * SEQ + tt[ti]) * DH + 4 * fq;
#pragma unroll
                for (int dt = 0; dt < 4; ++dt) { const u32x2 w = *(const u32x2*)(pp + 16 * dt); T[ti].O[dt] = T[ti].O[dt] + (f32x4){bflo(w.x), bfhi(w.x), bflo(w.y), bfhi(w.y)}; }
                l += PL[((size_t)s * 64 + bh) * SEQ + tt[ti]];
            }
            const float sc_ = l > 0.f ? 1.0f / l : 0.f;
            bf16_t* op = AO + (size_t)(b * SEQ + tt[ti]) * DM + h * DH + 4 * fq;
#pragma unroll
            for (int dt = 0; dt < 4; ++dt) { const f32x4 o = T[ti].O[dt] * sc_; *(u32x2*)(op + 16 * dt) = (u32x2){pk2(o[0], o[1]), pk2(o[2], o[3])}; }
        }
        asm volatile("s_waitcnt lgkmcnt(0)\n\ts_barrier" ::: "memory");
    }
}

struct Route { int e0, s0, e1, s1; float w0, w1; int pad0, pad1; };
__device__ __forceinline__ void ph_ln_route(const Ctx& C, int layer) {
    const float* resid = C.in[I_X]; const bf16_t* residb = (const bf16_t*)(C.ws + WS_XB)  ; const bf16_t* MIX = (const bf16_t*)(C.ws + WS_MIX);
    bf16_t* X1B = (bf16_t*)(C.ws + WS_X1B); Route* RT = (Route*)(C.ws + WS_ROUTE);
    int* rowlist = (int*)(C.ws + WS_ROWLIST); unsigned* cnt = (unsigned*)(C.ws + WS_CTL) + (layer ? CW_CNT1 : CW_CNT0);
    const float* lg = C.in[I_LNG] + (size_t)(layer * 2 + 0) * DM; const float* lb = C.in[I_LNB] + (size_t)(layer * 2 + 0) * DM;
    const float* rw = C.in[I_RW]; const float* rb = C.in[I_RB];
    LAS unsigned* lcnt = (LAS unsigned*)C.lds;
    LAS float* rec = (LAS float*)(C.lds + 256);
    LAS float* lsb = (LAS float*)(C.lds + 4096 + C.wave * 512);
    const int lane = C.lane;
    LAS unsigned char* rwl = (LAS unsigned char*)(C.lds + 8192);
    for (int gi = C.tid; gi < DM * NE / 4; gi += NTHREADS) { const int c = gi >> 2, e4 = gi & 3;
        *(LAS f32x4*)(rwl + (c >> 8) * 17408 + ((c & 255) >> 2) * 272 + (c & 3) * 64 + e4 * 16) = ((const f32x4*)rw)[gi]; }
    __syncthreads();
    for (int chunk = C.bid; chunk < NTOK / 128; chunk += C.nb) {
        if (C.tid < 16) lcnt[C.tid] = 0u;
        __syncthreads();
        for (int i2 = 0; i2 < 8; ++i2) {
            const int rl0 = C.wave * 16 + i2 * 2, row0 = chunk * 128 + rl0;
            f32x4 v[2][4]; float s[2], s2[2];
#pragma unroll
            for (int r = 0; r < 2; ++r) { const f32x4* xr = (const f32x4*)(resid + (size_t)(row0 + r) * DM) + lane; const u32x2* xb = (const u32x2*)(residb + (size_t)(row0 + r) * DM) + lane;
                const u32x2* mr = (const u32x2*)(MIX + (size_t)(row0 + r) * DM) + lane; s[r] = 0.f;
#pragma unroll
                for (int j = 0; j < 4; ++j) { const u32x2 w = mr[64 * j]; f32x4 xv;
                    if (layer) { const u32x2 q = xb[64 * j]; xv = (f32x4){bflo(q.x), bfhi(q.x), bflo(q.y), bfhi(q.y)}; } else xv = xr[64 * j];
                    v[r][j] = xv * DN_ALPHA + (f32x4){bflo(w.x), bfhi(w.x), bflo(w.y), bfhi(w.y)};
                    s[r] += (v[r][j][0] + v[r][j][1]) + (v[r][j][2] + v[r][j][3]); } }
#pragma unroll
            for (int o = 1; o < 64; o <<= 1) { s[0] += __shfl_xor(s[0], o); s[1] += __shfl_xor(s[1], o); }
#pragma unroll
            for (int r = 0; r < 2; ++r) { const float mean = s[r] * (1.f / DM); s2[r] = 0.f;
#pragma unroll
                for (int j = 0; j < 4; ++j) { v[r][j] = v[r][j] - mean; s2[r] += (v[r][j][0] * v[r][j][0] + v[r][j][1] * v[r][j][1]) + (v[r][j][2] * v[r][j][2] + v[r][j][3] * v[r][j][3]); } }
#pragma unroll
            for (int o = 1; o < 64; o <<= 1) { s2[0] += __shfl_xor(s2[0], o); s2[1] += __shfl_xor(s2[1], o); }
            const float rstd0 = 1.f / sqrtf(s2[0] * (1.f / DM) + LN_EPS), rstd1 = 1.f / sqrtf(s2[1] * (1.f / DM) + LN_EPS);
            float p[32];
#pragma unroll
            for (int q = 0; q < 32; ++q) p[q] = 0.f;
#pragma unroll
            for (int j = 0; j < 4; ++j) {
                const int c0 = 4 * lane + 256 * j;
                const f32x4 gg = *(const f32x4*)(lg + c0), bb = *(const f32x4*)(lb + c0);
#pragma unroll
                for (int r = 0; r < 2; ++r) {
                    v[r][j] = v[r][j] * (r ? rstd1 : rstd0) * gg + bb;
                    *(u32x2*)(X1B + (size_t)(row0 + r) * DM + c0) = (u32x2){pk2(v[r][j][0], v[r][j][1]), pk2(v[r][j][2], v[r][j][3])}; }
#pragma unroll
                for (int q = 0; q < 4; ++q) {
                    const LAS f32x4* wr = (const LAS f32x4*)(rwl + j * 17408 + lane * 272 + q * 64);
                    const f32x4 w0 = wr[0], w1 = wr[1], w2 = wr[2], w3 = wr[3];
#pragma unroll
                    for (int r = 0; r < 2; ++r) { const float x = v[r][j][q];
                        p[16 * r + 0] += x * w0[0]; p[16 * r + 1] += x * w0[1]; p[16 * r + 2] += x * w0[2]; p[16 * r + 3] += x * w0[3];
                        p[16 * r + 4] += x * w1[0]; p[16 * r + 5] += x * w1[1]; p[16 * r + 6] += x * w1[2]; p[16 * r + 7] += x * w1[3];
                        p[16 * r + 8] += x * w2[0]; p[16 * r + 9] += x * w2[1]; p[16 * r + 10] += x * w2[2]; p[16 * r + 11] += x * w2[3];
                        p[16 * r + 12] += x * w3[0]; p[16 * r + 13] += x * w3[1]; p[16 * r + 14] += x * w3[2]; p[16 * r + 15] += x * w3[3]; }
                    if (q == 3) asm volatile("" ::: "memory");
                }
            }
#define TRED(N, M) { const bool up = (lane & (M)) != 0; _Pragma("unroll") for (int q = 0; q < (N); ++q) { const float keep = up ? p[q + (N)] : p[q], send = up ? p[q] : p[q + (N)]; p[q] = keep + __shfl_xor(send, (M)); } }
            TRED(16, 32) TRED(8, 16) TRED(4, 8) TRED(2, 4) TRED(1, 2)
#undef TRED
            p[0] += __shfl_xor(p[0], 1);
            const float sc_own = 1.0f / (1.0f + expf(-p[0]));
            if ((lane & 1) == 0) { lsb[lane >> 1] = sc_own; lsb[32 + (lane >> 1)] = sc_own + rb[(lane >> 1) & 15]; }
            WAVE_LDS_SYNC();
            float sc[16], bi[16];
            { const LAS f32x4* a4 = (const LAS f32x4*)(lsb + ((lane >> 5) << 4)); const LAS f32x4* b4 = (const LAS f32x4*)(lsb + 32 + ((lane >> 5) << 4));
#pragma unroll
              for (int q = 0; q < 4; ++q) { const f32x4 x = a4[q], y = b4[q]; sc[4 * q] = x[0]; sc[4 * q + 1] = x[1]; sc[4 * q + 2] = x[2]; sc[4 * q + 3] = x[3]; bi[4 * q] = y[0]; bi[4 * q + 1] = y[1]; bi[4 * q + 2] = y[2]; bi[4 * q + 3] = y[3]; } }
            WAVE_LDS_SYNC();
            int gsel = 0; float gbest = -3e38f;
#pragma unroll
            for (int gq = 0; gq < 4; ++gq) {
                float m1 = -3e38f, m2 = -3e38f;
#pragma unroll
                for (int q = 0; q < 4; ++q) { const float x = bi[4 * gq + q]; if (x > m1) { m2 = m1; m1 = x; } else if (x > m2) m2 = x; }
                const float gs = m1 + m2; if (gs > gbest) { gbest = gs; gsel = gq; }
            }
            int e0 = 0, e1 = 0; float b0 = -3e38f, b1 = -3e38f, w0 = 0.f, w1 = 0.f;
#pragma unroll
            for (int e = 0; e < 16; ++e) {
                if ((e >> 2) == gsel) {
                    const float x = bi[e];
                    if (x > b0) { b1 = b0; e1 = e0; w1 = w0; b0 = x; e0 = e; w0 = sc[e]; }
                    else if (x > b1) { b1 = x; e1 = e; w1 = sc[e]; }
                }
            }
            if ((lane & 31) == 0) {
                const int rl = rl0 + (lane >> 5);
                const float ws_ = w0 + w1;
                const unsigned l0 = __hip_atomic_fetch_add(lcnt + e0, 1u, __ATOMIC_RELAXED, __HIP_MEMORY_SCOPE_WORKGROUP), l1 = __hip_atomic_fetch_add(lcnt + e1, 1u, __ATOMIC_RELAXED, __HIP_MEMORY_SCOPE_WORKGROUP);
                LAS float* r = rec + rl * 6; r[0] = __int_as_float(e0); r[1] = __int_as_float(e1); r[2] = __uint_as_float(l0); r[3] = __uint_as_float(l1); r[4] = w0 / ws_; r[5] = w1 / ws_;
            }
        }
        __syncthreads();
        if (C.tid < 16) lcnt[16 + C.tid] = atomicAdd(cnt + 64 * C.tid, lcnt[C.tid]);
        __syncthreads();
        if (C.tid < 128) {
            const LAS float* r = rec + C.tid * 6; const int row = chunk * 128 + C.tid;
            const int e0 = __float_as_int(r[0]), e1 = __float_as_int(r[1]);
            const int s0 = (int)(lcnt[16 + e0] + __float_as_uint(r[2])), s1 = (int)(lcnt[16 + e1] + __float_as_uint(r[3]));
            rowlist[e0 * NTOK + s0] = row; rowlist[e1 * NTOK + s1] = row;
            Route rr; rr.e0 = e0; rr.s0 = s0; rr.e1 = e1; rr.s1 = s1; rr.w0 = r[4]; rr.w1 = r[5]; rr.pad0 = 0; rr.pad1 = 0;
            RT[row] = rr;
        }
        __syncthreads();
    }
}
__device__ __forceinline__ void ph_combine(const Ctx& C, int layer, float* outp, LAS int* sm) {
    const bf16_t* X1B = (const bf16_t*)(C.ws + WS_X1B); const bf16_t* Y2 = (const bf16_t*)(C.ws + WS_Y2); const Route* RT = (const Route*)(C.ws + WS_ROUTE);
    bf16_t* XB = (bf16_t*)(C.ws + WS_XB);
    const float* lg = C.in[I_LNG] + (size_t)(layer * 2 + 1) * DM; const float* lb = C.in[I_LNB] + (size_t)(layer * 2 + 1) * DM;
    const int gw = C.bid * NWAVES + C.wave, NGW = C.nb * NWAVES, lane = C.lane;
    for (int row = gw; row < NTOK; row += NGW) {
        const Route r = RT[row];
        const bf16_t* y0 = Y2 + (size_t)(sm[16 + r.e0] + r.s0) * DM; const bf16_t* y1 = Y2 + (size_t)(sm[16 + r.e1] + r.s1) * DM;
        const u32x2* xr = (const u32x2*)(X1B + (size_t)row * DM) + lane;
        f32x4 v[4]; float s = 0.f;
#pragma unroll
        for (int j = 0; j < 4; ++j) {
            const int c0 = 4 * lane + 256 * j;
            const u32x2 a = *(const u32x2*)(y0 + c0), b = *(const u32x2*)(y1 + c0), x = xr[64 * j];
            const f32x4 ya = (f32x4){bflo(a.x), bfhi(a.x), bflo(a.y), bfhi(a.y)}, yb = (f32x4){bflo(b.x), bfhi(b.x), bflo(b.y), bfhi(b.y)}, xv = (f32x4){bflo(x.x), bfhi(x.x), bflo(x.y), bfhi(x.y)};
            v[j] = xv * DN_ALPHA + ya * r.w0 + yb * r.w1;
            s += (v[j][0] + v[j][1]) + (v[j][2] + v[j][3]);
        }
        const float mean = wave_sum(s) * (1.f / DM); float s2 = 0.f;
#pragma unroll
        for (int j = 0; j < 4; ++j) { v[j] = v[j] - mean; s2 += (v[j][0] * v[j][0] + v[j][1] * v[j][1]) + (v[j][2] * v[j][2] + v[j][3] * v[j][3]); }
        const float rstd = 1.f / sqrtf(wave_sum(s2) * (1.f / DM) + LN_EPS);
#pragma unroll
        for (int j = 0; j < 4; ++j) {
            const int c0 = 4 * lane + 256 * j;
            const f32x4 gg = *(const f32x4*)(lg + c0), bb = *(const f32x4*)(lb + c0);
            v[j] = v[j] * rstd * gg + bb;
            if (layer) *(f32x4*)(outp + (size_t)row * DM + c0) = v[j];
            else *(u32x2*)(XB + (size_t)row * DM + c0) = (u32x2){pk2(v[j][0], v[j][1]), pk2(v[j][2], v[j][3])};
        }
    }
}

__device__ __forceinline__ void ph_kmean(const Ctx& C) {
    const bf16_t* K1 = (const bf16_t*)(C.ws + WS_K1); float* KM = (float*)(C.ws + WS_KMEAN);
    const int gw = C.bid * NWAVES + C.wave, NGW = C.nb * NWAVES, lane = C.lane;
    for (int it = gw; it < NB * NH * 32; it += NGW) {
        const bf16_t* p = K1 + (size_t)it * 256 * DH + lane; float s = 0.f;
#pragma unroll 8
        for (int j = 0; j < 256; ++j) s += bf2f(p[j * DH]);
        KM[(size_t)it * DH + lane] = s * (1.0f / 256.0f);
    }
}
constexpr int NPHASE = 21;
__global__ void __launch_bounds__(NTHREADS, 2) fwd(Args args) {
    extern __shared__ __attribute__((aligned(16))) unsigned char lds[];
    Ctx C;
#pragma unroll
    for (int i = 0; i < 18; ++i) C.in[i] = args.in[i];
    C.out = args.out; C.ws = args.ws; C.lds = lds;
    C.tid = threadIdx.x; C.lane = C.tid & 63; C.wave = __builtin_amdgcn_readfirstlane(C.tid >> 6); C.bid = blockIdx.x; C.nb = gridDim.x;
    LAS unsigned* misc = (LAS unsigned*)(lds + LDS_BYTES - 512);
    LAS int* sm = (LAS int*)(misc + 16);
    if (C.tid < 4) misc[C.tid] = 0u;
    __syncthreads();
#if MK_SINGLE
    XcdBarrier bar = xcd_barrier_post((unsigned*)(C.ws + WS_CTL) + CW_BAR, (volatile LAS unsigned*)misc);
#define SEAM() xcd_barrier(bar)
#else
#define SEAM() do {} while (0)
#endif
    const int lo = args.ph_lo, hi = args.ph_hi;
#ifndef PH_MASK
#define PH_MASK 0xFFFFFFFFu
#endif
#define IN(k) (((PH_MASK >> (k)) & 1u) && lo <= (k) && (k) < hi)
#define BOTH(k) (IN(k) && IN((k) + 1))
    unsigned char* ws = C.ws;
    const float2* rope = (const float2*)(ws + WS_ROPE);
    LAS unsigned char* L = (LAS unsigned char*)lds;

    if (IN(0)) { ph_prologue(C); if (BOTH(0)) SEAM(); }
    if (IN(1)) {
        EpiNsaIn E{(bf16_t*)(ws + WS_Q), (bf16_t*)(ws + WS_KV0), (float*)(ws + WS_GATES), rope};
        g8::StaticOrder S; S.init(NTOK / 256, 2560 / 256, C.nb, C.bid);
        g8::gemm8<false>(L, (const bf16_t*)(ws + WS_XB), DM, (const bf16_t*)(ws + WS_WT_NSA_IN), DM, S, g8::EpiEl<EpiNsaIn>{E}, g8::GatherInfo{nullptr, sm});
        if (BOTH(1)) SEAM();
    }
    if (IN(2)) {
        EpiCmp EK{(const float*)(ws + WS_BIAS1), (const bf16_t*)(ws + WS_W2T), rope, (bf16_t*)(ws + WS_KC)}, EV{(const float*)(ws + WS_BIAS1) + 256, (const bf16_t*)(ws + WS_W2T) + 64 * 256, nullptr, (bf16_t*)(ws + WS_VC)};
        g8::StaticOrder SK, SV; SK.init(32, 1, C.nb, C.bid); SV.init(32, 1, C.nb, (C.bid + C.nb / 2) % C.nb);
        g8::gemm8<false>(L, (const bf16_t*)(ws + WS_KV0), 1024, (const bf16_t*)(ws + WS_WT_C1K), 2048, SK, EK, g8::GatherInfo{nullptr, sm});
        g8::gemm8<false>(L, (const bf16_t*)(ws + WS_KV0 + KVSEG), 1024, (const bf16_t*)(ws + WS_WT_C1V), 2048, SV, EV, g8::GatherInfo{nullptr, sm});
        if (C.nb == 256 && !((C.bid < 32) || (C.bid >= 128 && C.bid < 160))) {
            EpiNsaIn E{(bf16_t*)(ws + WS_Q), (bf16_t*)(ws + WS_KV0), (float*)(ws + WS_GATES), rope};
            const int gidx = C.bid < 128 ? C.bid - 32 : C.bid - 64, fr = C.lane & 15, fq = C.lane >> 4;
            for (int tile = gidx * NWAVES + C.wave; tile < 2048; tile += 192 * NWAVES) {
                const int row0 = (tile >> 1) * 32, col0 = 2560 + (tile & 1) * 32;
                const bf16_t* a0 = (const bf16_t*)(ws + WS_XB) + (size_t)(row0 + fr) * DM + fq * 8; const bf16_t* a1 = a0 + (size_t)16 * DM;
                const bf16_t* b0 = (const bf16_t*)(ws + WS_WT_NSA_IN) + (size_t)(col0 + fr) * DM + fq * 8; const bf16_t* b1 = b0 + (size_t)16 * DM;
                f32x4 acc[2][2]; mma_core(a0, a1, b0, b1, DM, acc);
#pragma unroll
                for (int mi = 0; mi < 2; ++mi)
#pragma unroll
                    for (int ni = 0; ni < 2; ++ni) E(row0 + 16 * mi + fr, col0 + 16 * ni + 4 * fq, acc[mi][ni]);
            }
        } else if (C.nb != 256) {
            EpiNsaIn E{(bf16_t*)(ws + WS_Q), (bf16_t*)(ws + WS_KV0), (float*)(ws + WS_GATES), rope};
            const int fr = C.lane & 15, fq = C.lane >> 4;
            for (int tile = C.bid * NWAVES + C.wave; tile < 2048; tile += C.nb * NWAVES) {
                const int row0 = (tile >> 1) * 32, col0 = 2560 + (tile & 1) * 32;
                const bf16_t* a0 = (const bf16_t*)(ws + WS_XB) + (size_t)(row0 + fr) * DM + fq * 8; const bf16_t* a1 = a0 + (size_t)16 * DM;
                const bf16_t* b0 = (const bf16_t*)(ws + WS_WT_NSA_IN) + (size_t)(col0 + fr) * DM + fq * 8; const bf16_t* b1 = b0 + (size_t)16 * DM;
                f32x4 acc[2][2]; mma_core(a0, a1, b0, b1, DM, acc);
#pragma unroll
                for (int mi = 0; mi < 2; ++mi)
#pragma unroll
                    for (int ni = 0; ni < 2; ++ni) E(row0 + 16 * mi + fr, col0 + 16 * ni + 4 * fq, acc[mi][ni]);
            }
        }
        if (BOTH(2)) SEAM();
    }
    if (IN(4)) { ph_nsa_fa(C); if (BOTH(4)) SEAM(); }
    if (IN(6)) {
        EpiBf16 E{(bf16_t*)(ws + WS_MIX)};
        g8::StaticOrder S; S.init(NTOK / 256, DM / 256, C.nb, C.bid);
        g8::gemm8<false>(L, (const bf16_t*)(ws + WS_Q), DM, (const bf16_t*)(ws + WS_WT_NSA_OUT), DM, S, g8::EpiEl<EpiBf16>{E}, g8::GatherInfo{nullptr, sm});
        if (BOTH(6)) SEAM();
    }
    if (IN(7)) { ph_ln_route(C, 0); if (BOTH(7)) SEAM(); }
    if (IN(8)) {
        load_expert_map(C, CW_CNT0, sm);
        EpiSwiGLU E{(bf16_t*)(ws + WS_HBUF)};
        g8::GroupedOrder S; S.init(sm, 4, C.nb, C.bid);
        g8::gemm8<true>(L, (const bf16_t*)(ws + WS_X1B), DM, (const bf16_t*)(ws + WS_WT_GU), 1024, S, g8::EpiEl<EpiSwiGLU>{E}, g8::GatherInfo{(const int*)(ws + WS_ROWLIST), sm});
        if (BOTH(8)) SEAM();
    }
    if (IN(9)) {
        load_expert_map(C, CW_CNT0, sm);
        EpiBf16 E{(bf16_t*)(ws + WS_Y2)};
        g8::GroupedOrder S; S.init(sm, 4, C.nb, C.bid);
        g8::gemm8<false>(L, (const bf16_t*)(ws + WS_HBUF), DE, (const bf16_t*)(ws + WS_WT_DN), DE, S, g8::EpiEl<EpiBf16>{E}, g8::GatherInfo{nullptr, sm});
        if (BOTH(9)) SEAM();
    }
    if (IN(10)) {
        load_expert_map(C, CW_CNT0, sm);
        ph_combine(C, 0, (float*)(ws + WS_XR), sm);
        if (BOTH(10)) SEAM();
    }
    if (IN(11)) {
        EpiMobaIn E{(bf16_t*)(ws + WS_Q), (bf16_t*)(ws + WS_K1), (bf16_t*)(ws + WS_V1), rope};
        g8::StaticOrder S; S.init(NTOK / 256, 3072 / 256, C.nb, C.bid);
        g8::gemm8<false>(L, (const bf16_t*)(ws + WS_XB), DM, (const bf16_t*)(ws + WS_WT_MOBA_IN), DM, S, g8::EpiEl<EpiMobaIn>{E}, g8::GatherInfo{nullptr, sm});
        if (BOTH(11)) SEAM();
    }
    if (IN(12)) { ph_kmean(C); if (BOTH(12)) SEAM(); }
    if (IN(13)) { ph_moba_sel(C); if (BOTH(13)) SEAM(); }
    if (IN(14)) { ph_moba_gather(C); if (BOTH(14)) SEAM(); }
    if (IN(15)) { ph_moba_own(C); if (BOTH(15)) SEAM(); }
    if (IN(16)) {
        EpiBf16 E{(bf16_t*)(ws + WS_MIX)};
        g8::StaticOrder S; S.init(NTOK / 256, DM / 256, C.nb, C.bid);
        g8::gemm8<false>(L, (const bf16_t*)(ws + WS_Q), DM, (const bf16_t*)(ws + WS_WT_MOBA_OUT), DM, S, g8::EpiEl<EpiBf16>{E}, g8::GatherInfo{nullptr, sm});
        if (BOTH(16)) SEAM();
    }
    if (IN(17)) {
        ph_ln_route(C, 1);
        __syncthreads();
        { float* scr = (float*)(C.lds + C.wave * 9216); const int gw = C.bid * NWAVES + C.wave, NGW = C.nb * NWAVES;
          for (int it = gw; it < MOE_W_ITEMS; it += NGW) moe_weight_item(C, 1, it, scr); }
        if (BOTH(17)) SEAM();
    }
    if (IN(18)) {
        load_expert_map(C, CW_CNT1, sm);
        EpiSwiGLU E{(bf16_t*)(ws + WS_HBUF)};
        g8::GroupedOrder S; S.init(sm, 4, C.nb, C.bid);
        g8::gemm8<true>(L, (const bf16_t*)(ws + WS_X1B), DM, (const bf16_t*)(ws + WS_WT_GU), 1024, S, g8::EpiEl<EpiSwiGLU>{E}, g8::GatherInfo{(const int*)(ws + WS_ROWLIST), sm});
        if (BOTH(18)) SEAM();
    }
    if (IN(19)) {
        load_expert_map(C, CW_CNT1, sm);
        EpiBf16 E{(bf16_t*)(ws + WS_Y2)};
        g8::GroupedOrder S; S.init(sm, 4, C.nb, C.bid);
        g8::gemm8<false>(L, (const bf16_t*)(ws + WS_HBUF), DE, (const bf16_t*)(ws + WS_WT_DN), DE, S, g8::EpiEl<EpiBf16>{E}, g8::GatherInfo{nullptr, sm});
        if (BOTH(19)) SEAM();
    }
    if (IN(20)) {
        load_expert_map(C, CW_CNT1, sm);
        ph_combine(C, 1, C.out, sm);
    }
#undef IN
#undef BOTH
}

extern "C" void kernel_launch(void* const* d_in, const int* in_sizes, int n_in, void* d_out, int out_size, void* d_ws, size_t ws_size, hipStream_t stream) {
    static int grid = 0;
    if (grid == 0) {
        if (n_in != 18 || in_sizes[0] != NTOK * DM || out_size != NTOK * DM || ws_size < WS_END) {
            fprintf(stderr, "kernel_launch: unexpected shapes (n_in %d, in0 %d, out %d, ws %zu; need ws >= %zu); nothing launched\n", n_in, n_in > 0 ? in_sizes[0] : -1, out_size, ws_size, (size_t)WS_END);
            grid = -1; return;
        }
        int dev = 0, cus = 0, per_cu = 0;
        if (hipGetDevice(&dev) != hipSuccess || hipDeviceGetAttribute(&cus, hipDeviceAttributeMultiprocessorCount, dev) != hipSuccess) { grid = -1; return; }
        if (hipFuncSetAttribute((const void*)fwd, hipFuncAttributeMaxDynamicSharedMemorySize, LDS_BYTES) != hipSuccess) { fprintf(stderr, "kernel_launch: hipFuncSetAttribute failed\n"); grid = -1; return; }
        if (hipOccupancyMaxActiveBlocksPerMultiprocessor(&per_cu, (const void*)fwd, NTHREADS, LDS_BYTES) != hipSuccess || per_cu < 1)
            fprintf(stderr, "kernel_launch: occupancy query reports %d blocks per CU\n", per_cu);
        (void)hipGetLastError();
        grid = cus;
        if (grid != 256) { fprintf(stderr, "kernel_launch: built for a 256-CU device (got %d CUs); nothing launched\n", cus); grid = -1; return; }
    }
    if (grid < 0) return;
    if (hipMemsetAsync((char*)d_ws + WS_CTL, 0, CTL_BYTES, stream) != hipSuccess) { fprintf(stderr, "kernel_launch: memset failed\n"); return; }
    Args a{};
    for (int i = 0; i < 18; ++i) a.in[i] = (const float*)d_in[i];
    a.out = (float*)d_out; a.ws = (unsigned char*)d_ws;
#if defined(PROBE_PH)
    { const int lo3[3] = {0, PROBE_PH, PROBE_PH + 1}, hi3[3] = {PROBE_PH + 1, PROBE_PH + 1, NPHASE};
      for (int q = 0; q < 3; ++q) { if (lo3[q] >= hi3[q]) continue;
          if (q) (void)hipMemsetAsync((char*)d_ws + WS_CTL + CW_BAR * 4, 0, XCD_BAR_WORDS * 4, stream);
          a.ph_lo = lo3[q]; a.ph_hi = hi3[q]; hipLaunchKernelGGL(fwd, dim3(grid), dim3(NTHREADS), LDS_BYTES, stream, a); } }
#elif MK_SINGLE
    a.ph_lo = 0; a.ph_hi = NPHASE;
    hipLaunchKernelGGL(fwd, dim3(grid), dim3(NTHREADS), LDS_BYTES, stream, a);
#else
    for (int p = 0; p < NPHASE; ++p) { a.ph_lo = p; a.ph_hi = p + 1; hipLaunchKernelGGL(fwd, dim3(grid), dim3(NTHREADS), LDS_BYTES, stream, a); }
#endif
    const hipError_t le = hipPeekAtLastError();
    if (le != hipSuccess) fprintf(stderr, "kernel_launch: launch failed: %s\n", hipGetErrorName(le));
}
```

```cpp
#include <hip/hip_runtime.h>
#include <cstdio>
#include <cstdint>

#ifndef SEL_FUSED
#define SEL_FUSED 1
#endif
#ifndef MK_SINGLE
#define MK_SINGLE 1
#endif

#define LAS __attribute__((address_space(3)))
typedef unsigned short bf16_t;
typedef short bf16x8 __attribute__((ext_vector_type(8)));
typedef float f32x4 __attribute__((ext_vector_type(4)));
typedef unsigned u32x4 __attribute__((ext_vector_type(4)));
typedef unsigned u32x2 __attribute__((ext_vector_type(2)));

constexpr int NB = 4, SEQ = 8192, NTOK = NB * SEQ, DM = 1024, NH = 16, DH = 64, NG = 4;
constexpr int NSA_IN = 2608, NSA_INP = 2816;
constexpr int NE = 16, DE = 512;
constexpr float DN_ALPHA = 1.4142135623730951f;
constexpr float LN_EPS = 1e-5f;
constexpr int NWAVES = 8, NTHREADS = 512;
constexpr float QSCALE = 0.125f * 1.4426950408889634f;
constexpr int LDS_BYTES = 163840;
constexpr int ROWCAP = 2 * NTOK + NE * 256;

constexpr size_t MiB = 1u << 20;
constexpr size_t WS_CTL = 0, CTL_BYTES = 1 * MiB;
constexpr size_t WS_ROPE = 1 * MiB;
constexpr size_t WS_BIAS1 = 3 * MiB;
constexpr size_t WS_W2T = 3 * MiB + 4096;
constexpr size_t WS_KMEAN = 4 * MiB;
constexpr size_t WS_ROUTE = 5 * MiB;
constexpr size_t WS_ROWLIST = 6 * MiB;
constexpr size_t WS_SEL = 8 * MiB;
constexpr size_t WS_GATES = 10 * MiB;
constexpr size_t WS_KC = 25 * MiB, WS_VC = 26 * MiB;
constexpr size_t WS_WT_NSA_IN = 27 * MiB;
constexpr size_t WS_WT_NSA_OUT = 33 * MiB;
constexpr size_t WS_WT_C1K = 35 * MiB, WS_WT_C1V = 36 * MiB;
constexpr size_t WS_WT_MOBA_IN = 37 * MiB;
constexpr size_t WS_WT_MOBA_OUT = 43 * MiB;
constexpr size_t WS_WT_GU = 45 * MiB;
constexpr size_t WS_WT_DN = 77 * MiB;
constexpr size_t WS_XB = 93 * MiB;
constexpr size_t WS_ATTN = 161 * MiB;
constexpr size_t WS_Q = WS_ATTN;
constexpr size_t WS_KV0 = WS_ATTN + 64 * MiB;
constexpr size_t KVSEG = 16 * MiB;
constexpr size_t WS_K1 = WS_ATTN + 64 * MiB, WS_V1 = WS_ATTN + 128 * MiB;
constexpr size_t WS_X1B = 353 * MiB;
constexpr size_t WS_MIX = WS_ATTN + 64 * MiB;
constexpr size_t WS_Y2 = WS_ATTN;
constexpr size_t WS_HBUF = WS_XB;
constexpr size_t WS_XR = 353 * MiB;
constexpr size_t WS_END = 481 * MiB;
static_assert((size_t)ROWCAP * 512 * 2 <= 68 * MiB && (size_t)ROWCAP * 1024 * 2 <= 192 * MiB, "overlay sizes");

constexpr int CW_TMO = 0;
constexpr int CW_CNT0 = 1024, CW_CNT1 = 2048;
constexpr int CW_BAR = 8192;

__device__ __forceinline__ unsigned f2bf(float f) { unsigned u = __float_as_uint(f); return (u + 0x7fffu + ((u >> 16) & 1u)) >> 16; }
typedef float f32x2v __attribute__((ext_vector_type(2)));
typedef __bf16 bf16x2v __attribute__((ext_vector_type(2)));
__device__ __forceinline__ unsigned pk2(float lo, float hi) { const f32x2v v = {lo, hi}; const bf16x2v b = __builtin_convertvector(v, bf16x2v); return __builtin_bit_cast(unsigned, b); }
__device__ __forceinline__ float bflo(unsigned u) { return __uint_as_float(u << 16); }
__device__ __forceinline__ float bfhi(unsigned u) { return __uint_as_float(u & 0xffff0000u); }
__device__ __forceinline__ float bf2f(bf16_t b) { return __uint_as_float((unsigned)b << 16); }
__device__ __forceinline__ float wave_sum(float v) {
#pragma unroll
    for (int o = 1; o < 64; o <<= 1) v += __shfl_xor(v, o);
    return v;
}
__device__ __forceinline__ float wave_max(float v) {
#pragma unroll
    for (int o = 1; o < 64; o <<= 1) v = fmaxf(v, __shfl_xor(v, o));
    return v;
}
#define WAVE_LDS_SYNC() asm volatile("s_waitcnt lgkmcnt(0)" ::: "memory")
__device__ __forceinline__ float sigmoidf_(float x) { return 1.0f / (1.0f + __expf(-x)); }
__device__ __forceinline__ float gelu_tanh(float x) {
    const float u = 0.7978845608028654f * (x + 0.044715f * x * x * x);
    const float t = 1.0f - 2.0f / (__expf(2.0f * u) + 1.0f);
    return 0.5f * x * (1.0f + t);
}

#define XB_TMO      128
#define XB_XCNT(j)  (256  + 64 * (j))
#define XB_XSUB(j)  (1280 + 64 * (j))
#define XB_XGEN(j)  (2304 + 64 * (j))
#define XB_TOP      3328
#define XB_TOPGEN   3392
#define XCD_BAR_WORDS 3456
#define XB_SPIN_CAP (1u << 22)
__device__ __forceinline__ unsigned xb_ld(unsigned* p)              { return __hip_atomic_load(p, __ATOMIC_RELAXED, __HIP_MEMORY_SCOPE_AGENT); }
__device__ __forceinline__ unsigned xb_add(unsigned* p, unsigned v) { return __hip_atomic_fetch_add(p, v, __ATOMIC_RELAXED, __HIP_MEMORY_SCOPE_AGENT); }
__device__ __forceinline__ unsigned xb_xcc_id() { return (unsigned)__builtin_amdgcn_s_getreg((3 << 11) | 20) & 0xFu; }
#define XB_SPIN(cond, bar) do { unsigned _sp = 0; while (cond) { __builtin_amdgcn_s_sleep(1); \
    if ((++_sp & 255u) == 0u) { if (xb_ld(&(bar)[XB_TMO])) break; if (_sp > XB_SPIN_CAP) { atomicAdd(&(bar)[XB_TMO], 1u); break; } } } } while (0)
struct XcdBarrier { unsigned* bar; unsigned x; volatile LAS unsigned* st; };
__device__ __forceinline__ XcdBarrier xcd_barrier_post(unsigned* bar, volatile LAS unsigned* st) {
    XcdBarrier b; b.bar = bar; b.x = xb_xcc_id(); b.st = st;
    if (threadIdx.x == 0) (void)xb_add(&bar[XB_XCNT(b.x)], 1u);
    return b;
}
__device__ __forceinline__ void xcd_barrier_complete(unsigned* bar, unsigned x, unsigned& nloc, unsigned& nx) {
    const unsigned G = gridDim.x * gridDim.y * gridDim.z;
    unsigned sum, cnt, mine, sp = 0u;
    for (;;) {
        sum = 0u; cnt = 0u; mine = 0u;
#pragma unroll
        for (unsigned j = 0; j < 16; ++j) { const unsigned c = xb_ld(&bar[XB_XCNT(j)]); sum += c; cnt += (c > 0u) ? 1u : 0u; mine = (j == x) ? c : mine; }
        if (sum == G) break;
        __builtin_amdgcn_s_sleep(1);
        if ((++sp & 255u) == 0u) { if (xb_ld(&bar[XB_TMO])) break; if (sp > XB_SPIN_CAP) { atomicAdd(&bar[XB_TMO], 1u); break; } }
    }
    nloc = mine > 0u ? mine : 1u; nx = cnt > 0u ? cnt : 1u;
}
__device__ __forceinline__ void xcd_barrier(const XcdBarrier& b) {
    asm volatile("s_waitcnt vmcnt(0)" ::: "memory");
    __syncthreads();
    if (threadIdx.x == 0) {
        unsigned* bar = b.bar;
        __builtin_amdgcn_s_waitcnt(0);
        unsigned nloc = b.st[0], nx = b.st[1];
        if (nloc == 0u) { xcd_barrier_complete(bar, b.x, nloc, nx); b.st[0] = nloc; b.st[1] = nx; }
        const unsigned old = xb_add(&bar[XB_XSUB(b.x)], 1u);
        const unsigned gen = old / nloc;
        if (old + 1u == (gen + 1u) * nloc) {
            __builtin_amdgcn_fence(__ATOMIC_RELEASE, "agent");
            asm volatile("s_waitcnt vmcnt(0)" ::: "memory");
            const unsigned og = xb_add(&bar[XB_TOP], 1u);
            const unsigned tg = og / nx;
            if (og + 1u == (tg + 1u) * nx) xb_add(&bar[XB_TOPGEN], 1u);
            else XB_SPIN(xb_ld(&bar[XB_TOPGEN]) == tg, bar);
            __builtin_amdgcn_fence(__ATOMIC_ACQUIRE, "agent");
            xb_add(&bar[XB_XGEN(b.x)], 1u);
            asm volatile("s_waitcnt vmcnt(0)" ::: "memory");
        } else {
            XB_SPIN(xb_ld(&bar[XB_XGEN(b.x)]) == gen, bar);
            __builtin_amdgcn_fence(__ATOMIC_ACQUIRE, "agent");
            asm volatile("s_waitcnt vmcnt(0)" ::: "memory");
        }
    }
    __syncthreads();
}

struct Args { const float* in[18]; float* out; unsigned char* ws; int ph_lo, ph_hi; };
struct Ctx {
    const float* in[18]; float* out; unsigned char* ws; unsigned char* lds;
    int tid, lane, wave, bid, nb;
};
enum { I_X = 0, I_NSA_WIN, I_NSA_WOUT, I_CK_W1, I_CK_W2, I_CV_W1, I_CV_W2, I_CK_POS, I_CV_POS, I_MOBA_WIN, I_MOBA_WOUT, I_RW, I_RB, I_WG, I_WU, I_WD, I_LNG, I_LNB };

__device__ __forceinline__ int il64(int d) { return d < 32 ? 2 * d : 2 * (d - 32) + 1; }
__device__ __forceinline__ int rowmap(int kind, int n) {
    switch (kind) {
        case 1: { const bool r = (n < 1024) || (n >= 1536 && n < 1792) || (n >= 2048 && n < 2304); return r ? (n & ~63) + il64(n & 63) : n; }
        case 2: return n < 2048 ? (n & ~63) + il64(n & 63) : n;
        case 3: return 2 * n;
        case 4: return 2 * n + 1;
        default: return n;
    }
}
__device__ __forceinline__ void transpose_item(const float* W, int ldw, int ncols, bf16_t* WT, int K, int kb, int nbk, int kind, float* scr, int lane) {
    const int k0 = 64 * kb, n0 = 32 * nbk;
    const int cq = lane & 7, nn = n0 + 4 * cq;
#pragma unroll
    for (int i = 0; i < 8; ++i) { const int kk = 8 * i + (lane >> 3);
        *(f32x4*)(scr + kk * 36 + 4 * cq) = nn < ncols ? *(const f32x4*)(W + (size_t)(k0 + kk) * ldw + nn) : (f32x4){0.f, 0.f, 0.f, 0.f}; }
    WAVE_LDS_SYNC();
    const int c = lane & 7;
#pragma unroll
    for (int j = 0; j < 4; ++j) {
        const int n = (lane >> 3) + 8 * j; const float* s = scr + (8 * c) * 36 + n;
        u32x4 o; o.x = pk2(s[0 * 36], s[1 * 36]); o.y = pk2(s[2 * 36], s[3 * 36]); o.z = pk2(s[4 * 36], s[5 * 36]); o.w = pk2(s[6 * 36], s[7 * 36]);
        *(u32x4*)(WT + (size_t)rowmap(kind, n0 + n) * K + k0 + 8 * c) = o;
    }
    WAVE_LDS_SYNC();
}
constexpr int MOE_W_ITEMS = NE * 768;
__device__ __forceinline__ void moe_weight_item(const Ctx& C, int layer, int r, float* scr) {
    const int e = r / 768; int q = r % 768;
    bf16_t* gu = (bf16_t*)(C.ws + WS_WT_GU) + (size_t)e * 1024 * 1024;
    bf16_t* dn = (bf16_t*)(C.ws + WS_WT_DN) + (size_t)e * 1024 * 512;
    const size_t eo = (size_t)(layer * NE + e);
    if (q < 256) { transpose_item(C.in[I_WG] + eo * DM * DE, DE, DE, gu, DM, q / 16, q % 16, 3, scr, C.lane); return; } q -= 256;
    if (q < 256) { transpose_item(C.in[I_WU] + eo * DM * DE, DE, DE, gu, DM, q / 16, q % 16, 4, scr, C.lane); return; } q -= 256;
    transpose_item(C.in[I_WD] + eo * DE * DM, DM, DM, dn, DE, q / 32, q % 32, 0, scr, C.lane);
}

__device__ __forceinline__ void ph_prologue(const Ctx& C) {
    float* scr = (float*)(C.lds + C.wave * 9216);
    const int gw = C.bid * NWAVES + C.wave, NGW = C.nb * NWAVES;
    constexpr int I_A = 16 * 82, I_B = 16 * 32, I_C = 32 * 8, I_D = 16 * 96, I_E = 16 * 32;
    constexpr int NIT = I_A + I_B + 2 * I_C + I_D + I_E + MOE_W_ITEMS;
    for (int it = gw; it < NIT; it += NGW) {
        int r = it;
        if (r < I_A) { transpose_item(C.in[I_NSA_WIN], NSA_IN, NSA_IN, (bf16_t*)(C.ws + WS_WT_NSA_IN), DM, r / 82, r % 82, 1, scr, C.lane); continue; } r -= I_A;
        if (r < I_B) { transpose_item(C.in[I_NSA_WOUT], DM, DM, (bf16_t*)(C.ws + WS_WT_NSA_OUT), DM, r / 32, r % 32, 0, scr, C.lane); continue; } r -= I_B;
        if (r < I_C) { transpose_item(C.in[I_CK_W1], 256, 256, (bf16_t*)(C.ws + WS_WT_C1K), 2048, r / 8, r % 8, 0, scr, C.lane); continue; } r -= I_C;
        if (r < I_C) { transpose_item(C.in[I_CV_W1], 256, 256, (bf16_t*)(C.ws + WS_WT_C1V), 2048, r / 8, r % 8, 0, scr, C.lane); continue; } r -= I_C;
        if (r < I_D) { transpose_item(C.in[I_MOBA_WIN], 3072, 3072, (bf16_t*)(C.ws + WS_WT_MOBA_IN), DM, r / 96, r % 96, 2, scr, C.lane); continue; } r -= I_D;
        if (r < I_E) { transpose_item(C.in[I_MOBA_WOUT], DM, DM, (bf16_t*)(C.ws + WS_WT_MOBA_OUT), DM, r / 32, r % 32, 0, scr, C.lane); continue; } r -= I_E;
        moe_weight_item(C, 0, r, scr);
    }
    const int gt = C.bid * NTHREADS + C.tid, NGT = C.nb * NTHREADS;
    { u32x4* p = (u32x4*)((bf16_t*)(C.ws + WS_WT_NSA_IN) + (size_t)2624 * DM); const int n = (NSA_INP - 2624) * DM / 8;
      for (int i = gt; i < n; i += NGT) p[i] = (u32x4){0u, 0u, 0u, 0u}; }
    { const f32x4* x4 = (const f32x4*)C.in[I_X]; u32x4* o = (u32x4*)(C.ws + WS_XB); const int n = NTOK * DM / 8;
      for (int i = gt; i < n; i += NGT) { const f32x4 a = x4[2 * i], b = x4[2 * i + 1]; o[i] = (u32x4){pk2(a.x, a.y), pk2(a.z, a.w), pk2(b.x, b.y), pk2(b.z, b.w)}; } }
    { const float INV[32] = {1.000000000e+00f, 7.498942018e-01f, 5.623413324e-01f, 4.216965139e-01f, 3.162277639e-01f, 2.371373922e-01f, 1.778279394e-01f, 1.333521456e-01f,
                             1.000000015e-01f, 7.498941571e-02f, 5.623412877e-02f, 4.216964915e-02f, 3.162277862e-02f, 2.371373586e-02f, 1.778279431e-02f, 1.333521493e-02f,
                             9.999999776e-03f, 7.498942316e-03f, 5.623413250e-03f, 4.216964822e-03f, 3.162277862e-03f, 2.371373819e-03f, 1.778279431e-03f, 1.333521446e-03f,
                             1.000000047e-03f, 7.498941850e-04f, 5.623413017e-04f, 4.216965463e-04f, 3.162277862e-04f, 2.371373848e-04f, 1.778279402e-04f, 1.333521504e-04f};
      float2* tab = (float2*)(C.ws + WS_ROPE);
      for (int i = gt; i < SEQ * 32; i += NGT) {
          const int t = i >> 5, f = i & 31;
          float inv = INV[0];
#pragma unroll
          for (int q = 1; q < 32; ++q) inv = (f == q) ? INV[q] : inv;
          const float ang = (float)t * inv;
          const double a = (double)ang; const double k = __builtin_rint(a * 0.15915494309189535); const float rf = (float)(a - k * 6.283185307179586);
          tab[i] = make_float2(__cosf(rf), __sinf(rf));
      } }
    for (int i = gt; i < 2 * 64 * 256; i += NGT) { const int which = i >> 14, d = (i >> 8) & 63, c = i & 255;
        ((bf16_t*)(C.ws + WS_W2T))[i] = (bf16_t)f2bf(C.in[which ? I_CV_W2 : I_CK_W2][c * 64 + d]); }
    for (int o = gw; o < 512; o += NGW) {
        const int which = o >> 8, c = o & 255;
        const float* pos = C.in[which ? I_CV_POS : I_CK_POS]; const float* w1 = C.in[which ? I_CV_W1 : I_CK_W1];
        float s = 0.f;
        for (int k = C.lane; k < 2048; k += 64) s += pos[k] * w1[(size_t)k * 256 + c];
        s = wave_sum(s);
        if (C.lane == 0) ((float*)(C.ws + WS_BIAS1))[o] = s;
    }
}

__device__ __forceinline__ void mma_core(const bf16_t* a0, const bf16_t* a1, const bf16_t* b0, const bf16_t* b1, int K, f32x4 (&acc)[2][2]) {
#pragma unroll
    for (int i = 0; i < 2; ++i)
#pragma unroll
        for (int j = 0; j < 2; ++j) acc[i][j] = (f32x4){0.f, 0.f, 0.f, 0.f};
#pragma unroll 4
    for (int k = 0; k < K; k += 32) {
        const bf16x8 A0 = *(const bf16x8*)(a0 + k), A1 = *(const bf16x8*)(a1 + k), B0 = *(const bf16x8*)(b0 + k), B1 = *(const bf16x8*)(b1 + k);
        acc[0][0] = __builtin_amdgcn_mfma_f32_16x16x32_bf16(B0, A0, acc[0][0], 0, 0, 0);
        acc[0][1] = __builtin_amdgcn_mfma_f32_16x16x32_bf16(B1, A0, acc[0][1], 0, 0, 0);
        acc[1][0] = __builtin_amdgcn_mfma_f32_16x16x32_bf16(B0, A1, acc[1][0], 0, 0, 0);
        acc[1][1] = __builtin_amdgcn_mfma_f32_16x16x32_bf16(B1, A1, acc[1][1], 0, 0, 0);
    }
}
namespace g8 {
constexpr int BM = 256, BK = 64, HALF = 128, HTB = HALF * BK * 2, STAGE_BYTES = 8 * HTB, NXCD = 8, WGM = 8;
__device__ __forceinline__ int lds_byte(int r, int c) { const int st = (r >> 4) * 2 + (c >> 5), rr = r & 15, cc = c & 31, ob = rr * 64 + cc * 2; return st * 1024 + (ob ^ (((ob >> 9) & 1) << 5)); }
__device__ __forceinline__ void stage_rc(int b, int& R, int& C) { const int st = b / 1024, sb = b % 1024, swz = sb ^ (((sb >> 9) & 1) << 5); R = (st >> 1) * 16 + swz / 64; C = (st & 1) * 32 + (swz % 64) / 2; }
struct Unit { int pm, pn, bt, e; };
struct StaticOrder {
    int nM, nN, nwg, G, c;
    __device__ void init(int nM_, int nN_, int G_, int c_) { nM = nM_; nN = nN_; nwg = nM * nN; G = G_; c = c_; }
    __device__ bool next(int i, Unit& u) const {
        const long L = (long)i * G + c; if (L >= nwg) return false;
        int wgid = (int)L; { const int q = nwg / NXCD, r = nwg % NXCD, xcd = wgid % NXCD, off = wgid / NXCD; wgid = (xcd < r ? xcd * (q + 1) : r * (q + 1) + (xcd - r) * q) + off; }
        const int nig = WGM * nN, gid = wgid / nig, fm = gid * WGM, gsz = (nM - fm) < WGM ? (nM - fm) : WGM;
        u.pm = fm + ((wgid % nig) % gsz); u.pn = (wgid % nig) / gsz; u.bt = u.pn; u.e = 0; return true;
    }
};
struct GroupedOrder {
    StaticOrder so; const LAS int* sm;
    __device__ void init(const LAS int* sm_, int nN_, int G_, int c_) { sm = sm_; so.init(sm_[32] / BM, nN_, G_, c_); }
    __device__ bool next(int i, Unit& u) const {
        if (!so.next(i, u)) return false;
        const int rowt = u.pm * BM; int e = 0;
#pragma unroll
        for (int q = 1; q < NE; ++q) e = (rowt >= sm[16 + q]) ? q : e;
        u.e = e; u.bt = e * so.nN + u.pn; return true;
    }
};
struct GatherInfo { const int* rowlist; const LAS int* sm; };

__device__ __forceinline__ int perm32(int rho) { const int n = rho >> 4, i = rho & 15; return 8 * (i >> 2) + 4 * n + (i & 3); }
template <bool GATHER, class Epi, class Sched>
__device__ __forceinline__ void gemm8(LAS unsigned char* lds, const bf16_t* A, int lda, const bf16_t* Bt, int K, const Sched& S, const Epi& E, GatherInfo gi) {
    const int tid = threadIdx.x, wid = __builtin_amdgcn_readfirstlane(tid >> 6), lane = tid & 63, wr = wid >> 2, wc = wid & 3, fr = lane & 15, fq = lane >> 4;
    const int nt = K / BK;
    int Rr[2], Cc[2]; unsigned voffB[2]; unsigned vAc[2][2], vAn[2][2];
#pragma unroll
    for (int i = 0; i < 2; ++i) { stage_rc(tid * 16 + i * 8192, Rr[i], Cc[i]); voffB[i] = (unsigned)(((Rr[i] & ~31) + perm32(Rr[i] & 31)) * K + Cc[i]) * 2u;
#pragma unroll
        for (int h = 0; h < 2; ++h) { vAc[h][i] = (unsigned)((Rr[i] + HALF * h) * lda + Cc[i]) * 2u; vAn[h][i] = vAc[h][i]; } }
    const size_t kstep = (size_t)(BK * 2);
    const size_t hstepB = (size_t)HALF * K * 2, tstepB = 2 * hstepB, tstepA = (size_t)BM * lda * 2;
    const unsigned ldsw = (unsigned)wid * 1024u;
    const int aoff = lds_byte(wr * 64 + fr, fq * 8), boff = lds_byte(wc * 32 + fr, fq * 8);
#define G8_SA(b, h) (((b) * 2 + (h)) * HTB)
#define G8_SB(b, h) ((4 + (b) * 2 + (h)) * HTB)
#define G8_STAGEB(bufoff, gbase) do { _Pragma("unroll") for (int _i = 0; _i < 2; ++_i) \
        __builtin_amdgcn_global_load_lds((const unsigned*)((const char*)(gbase) + voffB[_i]), (LAS unsigned*)(lds + (bufoff) + ldsw + _i * 8192), 16, 0, 0); } while (0)
#define G8_STAGEA(bufoff, gbase, v0, v1) do { \
        __builtin_amdgcn_global_load_lds((const unsigned*)((const char*)(gbase) + (v0)), (LAS unsigned*)(lds + (bufoff) + ldsw), 16, 0, 0); \
        __builtin_amdgcn_global_load_lds((const unsigned*)((const char*)(gbase) + (v1)), (LAS unsigned*)(lds + (bufoff) + ldsw + 8192), 16, 0, 0); } while (0)
#define G8_LDA(dst, b, h) do { _Pragma("unroll") for (int m = 0; m < 4; ++m) _Pragma("unroll") for (int k = 0; k < 2; ++k) dst[m][k] = *(const LAS bf16x8*)(lds + G8_SA(b, h) + aoff + m * 2048 + k * 1024); } while (0)
#define G8_LDB(dst, b, h) do { _Pragma("unroll") for (int n = 0; n < 2; ++n) _Pragma("unroll") for (int k = 0; k < 2; ++k) dst[n][k] = *(const LAS bf16x8*)(lds + G8_SB(b, h) + boff + n * 2048 + k * 1024); } while (0)
#define G8_MMA(ai, bj, At, Bt_) do { __builtin_amdgcn_s_setprio(1); _Pragma("unroll") for (int m = 0; m < 4; ++m) _Pragma("unroll") for (int n = 0; n < 2; ++n) _Pragma("unroll") for (int k = 0; k < 2; ++k) \
        acc[ai][bj][m][n] = __builtin_amdgcn_mfma_f32_16x16x32_bf16(Bt_[n][k], At[m][k], acc[ai][bj][m][n], 0, 0, 0); __builtin_amdgcn_s_setprio(0); } while (0)
#define G8_WAIT_V(n) asm volatile("s_waitcnt vmcnt(" #n ")" ::: "memory")
#define G8_WAIT_L(n) asm volatile("s_waitcnt lgkmcnt(" #n ")" ::: "memory")
#define G8_BAR __builtin_amdgcn_s_barrier()
#define G8_SCHED __builtin_amdgcn_sched_barrier(0)
#define G8_GATHER(u, v) do { if (GATHER) { const int _eb = gi.sm[16 + (u).e], _ec = gi.sm[(u).e]; \
        _Pragma("unroll") for (int _h = 0; _h < 2; ++_h) _Pragma("unroll") for (int _i = 0; _i < 2; ++_i) { const int _s = (u).pm * BM + HALF * _h + Rr[_i] - _eb; \
            const int _t = gi.rowlist[(u).e * NTOK + (_s < _ec ? _s : 0)]; v[_h][_i] = (unsigned)(_t * K + Cc[_i]) * 2u; } } } while (0)
    Unit cur, nxt; int ui = 0;
    if (!S.next(0, cur)) return;
    f32x4 acc[2][2][4][2];
#pragma unroll
    for (int a = 0; a < 2; ++a)
#pragma unroll
        for (int b = 0; b < 2; ++b)
#pragma unroll
            for (int m = 0; m < 4; ++m)
#pragma unroll
                for (int n = 0; n < 2; ++n) acc[a][b][m][n] = (f32x4){0.f, 0.f, 0.f, 0.f};
    bf16x8 At[4][2], B0[2][2], B1[2][2];
    G8_GATHER(cur, vAc);
    const char* cA = GATHER ? (const char*)A : (const char*)A + (size_t)cur.pm * tstepA; const char* cB = (const char*)Bt + (size_t)cur.bt * tstepB;
    G8_STAGEB(G8_SB(0, 0), cB); G8_STAGEB(G8_SB(0, 1), cB + hstepB); G8_STAGEA(G8_SA(0, 0), cA, vAc[0][0], vAc[0][1]); G8_STAGEA(G8_SA(0, 1), cA, vAc[1][0], vAc[1][1]);
    if (wr == 1) G8_BAR;
    G8_WAIT_V(2); G8_BAR;
    G8_STAGEB(G8_SB(1, 0), cB + kstep); G8_STAGEA(G8_SA(1, 0), cA + kstep, vAc[0][0], vAc[0][1]); G8_STAGEB(G8_SB(1, 1), cB + hstepB + kstep);
    G8_WAIT_V(6); G8_BAR;
    for (;;) {
        const bool has_next = S.next(ui + 1, nxt);
        if (has_next) G8_GATHER(nxt, vAn);
        const char* nA = has_next ? (GATHER ? (const char*)A : (const char*)A + (size_t)nxt.pm * tstepA) : cA; const char* nB = has_next ? (const char*)Bt + (size_t)nxt.bt * tstepB : cB;
        for (int t = 0; t < nt; t += 2) {
            const bool last = (t == nt - 2);
            const char* a1 = cA + (size_t)(t + 1) * kstep;
            const char* a2 = last ? nA : cA + (size_t)(t + 2) * kstep; const char* b2 = last ? nB : cB + (size_t)(t + 2) * kstep;
            const char* a3 = a2 + kstep; const char* b3 = b2 + kstep;
            const bool usen = GATHER && last && has_next;
            const unsigned w00 = usen ? vAn[0][0] : vAc[0][0], w01 = usen ? vAn[0][1] : vAc[0][1], w10 = usen ? vAn[1][0] : vAc[1][0], w11 = usen ? vAn[1][1] : vAc[1][1];
            G8_LDB(B0, 0, 0); G8_LDB(B1, 0, 1); G8_SCHED; G8_LDA(At, 0, 0); G8_STAGEA(G8_SA(1, 1), a1, vAc[1][0], vAc[1][1]);
            G8_WAIT_V(8); G8_WAIT_L(0); G8_BAR; G8_MMA(0, 0, At, B0); G8_MMA(0, 1, At, B1); G8_BAR; G8_SCHED;
            G8_LDA(At, 0, 1); G8_STAGEB(G8_SB(0, 0), b2); G8_STAGEB(G8_SB(0, 1), b2 + hstepB); G8_STAGEA(G8_SA(0, 0), a2, w00, w01);
            G8_WAIT_V(8); G8_WAIT_L(0); G8_BAR; G8_MMA(1, 0, At, B0); G8_MMA(1, 1, At, B1); G8_BAR; G8_SCHED;
            G8_LDB(B0, 1, 0); G8_LDB(B1, 1, 1); G8_SCHED; G8_LDA(At, 1, 0); G8_STAGEA(G8_SA(0, 1), a2, w10, w11);
            G8_WAIT_V(8); G8_WAIT_L(0); G8_BAR; G8_MMA(0, 0, At, B0); G8_MMA(0, 1, At, B1); G8_BAR; G8_SCHED;
            G8_LDA(At, 1, 1); G8_STAGEB(G8_SB(1, 0), b3); G8_STAGEB(G8_SB(1, 1), b3 + hstepB); G8_STAGEA(G8_SA(1, 0), a3, w00, w01);
            G8_WAIT_V(8); G8_WAIT_L(0); G8_BAR; G8_MMA(1, 0, At, B0); G8_MMA(1, 1, At, B1); G8_BAR; G8_SCHED;
        }
        if (wr == 0) G8_BAR;
        E(acc, cur, wr, wc, fr, fq);
        if (!has_next) break;
#pragma unroll
        for (int a = 0; a < 2; ++a)
#pragma unroll
            for (int b = 0; b < 2; ++b)
#pragma unroll
                for (int m = 0; m < 4; ++m)
#pragma unroll
                    for (int n = 0; n < 2; ++n) acc[a][b][m][n] = (f32x4){0.f, 0.f, 0.f, 0.f};
        cur = nxt; cA = nA; cB = nB; ++ui;
#pragma unroll
        for (int h = 0; h < 2; ++h)
#pragma unroll
            for (int i = 0; i < 2; ++i) vAc[h][i] = vAn[h][i];
        if (wr == 1) G8_BAR;
    }
    G8_WAIT_V(0);
    G8_BAR;
    if constexpr (Epi::AFTER) E.after(acc, cur, lds, wr, wc, fr, fq, wid, lane);
#undef G8_SA
#undef G8_SB
#undef G8_STAGEA
#undef G8_STAGEB
#undef G8_LDA
#undef G8_LDB
#undef G8_MMA
#undef G8_WAIT_V
#undef G8_WAIT_L
#undef G8_BAR
#undef G8_SCHED
#undef G8_GATHER
}
template <class F> struct EpiEl {
    static constexpr bool AFTER = false;
    F f;
    __device__ __forceinline__ void operator()(const f32x4 (&acc)[2][2][4][2], const Unit& u, int wr, int wc, int fr, int fq) const {
#pragma unroll
        for (int ai = 0; ai < 2; ++ai)
#pragma unroll
            for (int m = 0; m < 4; ++m) { const int row = u.pm * BM + ai * HALF + wr * 64 + m * 16 + fr;
#pragma unroll
                for (int bj = 0; bj < 2; ++bj) f(row, u.pn * BM + bj * HALF + wc * 32 + 8 * fq, acc[ai][bj][m][0], acc[ai][bj][m][1]); }
    }
};
}

struct EpiNsaIn {
    bf16_t* Q; bf16_t* KV; float* gates; const float2* rope;
    __device__ __forceinline__ void operator()(int row, int c, f32x4 v) const {
        const int t = row & (SEQ - 1), b = row >> 13;
        if (c < 1024) {
            v = v * QSCALE;
            const int d = (c & 63) >> 1; const float2 c0 = rope[t * 32 + d], c1 = rope[t * 32 + d + 1];
            bf16_t* p = Q + (size_t)row * DM + (c & ~63);
            *(unsigned*)(p + d) = pk2(v[0] * c0.x - v[1] * c0.y, v[2] * c1.x - v[3] * c1.y);
            *(unsigned*)(p + d + 32) = pk2(v[1] * c0.x + v[0] * c0.y, v[3] * c1.x + v[2] * c1.y);
        } else if (c < 2560) {
            const int s = (c - 1024) >> 8, g = ((c - 1024) >> 6) & 3;
            bf16_t* p = KV + (size_t)s * (KVSEG / 2) + ((size_t)(b * NG + g) * SEQ + t) * DH;
            if (s == 2 || s == 4) {
                const int d = (c & 63) >> 1; const float2 c0 = rope[t * 32 + d], c1 = rope[t * 32 + d + 1];
                *(unsigned*)(p + d) = pk2(v[0] * c0.x - v[1] * c0.y, v[2] * c1.x - v[3] * c1.y);
                *(unsigned*)(p + d + 32) = pk2(v[1] * c0.x + v[0] * c0.y, v[3] * c1.x + v[2] * c1.y);
            } else {
                *(u32x2*)(p + (c & 63)) = (u32x2){pk2(v[0], v[1]), pk2(v[2], v[3])};
            }
        } else if (c < NSA_IN) {
            float* gp = gates + (size_t)row * 48 + (c - 2560);
            *(f32x4*)gp = (f32x4){sigmoidf_(v[0]), sigmoidf_(v[1]), sigmoidf_(v[2]), sigmoidf_(v[3])};
        }
    }
    __device__ __forceinline__ void operator()(int row, int c, f32x4 v, f32x4 w) const {
        const int t = row & (SEQ - 1), b = row >> 13;
        const int s = (c - 1024) >> 8;
        const bool isq = c < 1024, roped = isq || s == 2 || s == 4;
        if (roped) {
            if (isq) { v = v * QSCALE; w = w * QSCALE; }
            const int g = ((c - 1024) >> 6) & 3, d = (c & 63) >> 1;
            bf16_t* p = isq ? Q + (size_t)row * DM + (c & ~63) : KV + (size_t)s * (KVSEG / 2) + ((size_t)(b * NG + g) * SEQ + t) * DH;
            const f32x4 cs01 = *(const f32x4*)(rope + t * 32 + d), cs23 = *(const f32x4*)(rope + t * 32 + d + 2);
            *(u32x2*)(p + d) = (u32x2){pk2(v[0] * cs01[0] - v[1] * cs01[1], v[2] * cs01[2] - v[3] * cs01[3]), pk2(w[0] * cs23[0] - w[1] * cs23[1], w[2] * cs23[2] - w[3] * cs23[3])};
            *(u32x2*)(p + d + 32) = (u32x2){pk2(v[1] * cs01[0] + v[0] * cs01[1], v[3] * cs01[2] + v[2] * cs01[3]), pk2(w[1] * cs23[0] + w[0] * cs23[1], w[3] * cs23[2] + w[2] * cs23[3])};
        } else {
            const int g = ((c - 1024) >> 6) & 3;
            bf16_t* p = KV + (size_t)s * (KVSEG / 2) + ((size_t)(b * NG + g) * SEQ + t) * DH + (c & 63);
            *(u32x4*)p = (u32x4){pk2(v[0], v[1]), pk2(v[2], v[3]), pk2(w[0], w[1]), pk2(w[2], w[3])};
        }
    }
};
struct EpiMobaIn {
    bf16_t* Q; bf16_t* K; bf16_t* V; const float2* rope;
    __device__ __forceinline__ void operator()(int row, int c, f32x4 v) const {
        const int t = row & (SEQ - 1), b = row >> 13;
        if (c < 2048) {
            if (c < 1024) v = v * QSCALE;
            const int d = (c & 63) >> 1; const float2 c0 = rope[t * 32 + d], c1 = rope[t * 32 + d + 1];
            bf16_t* p = c < 1024 ? Q + (size_t)row * DM + (c & ~63) : K + ((size_t)(b * NH + ((c - 1024) >> 6)) * SEQ + t) * DH;
            *(unsigned*)(p + d) = pk2(v[0] * c0.x - v[1] * c0.y, v[2] * c1.x - v[3] * c1.y);
            *(unsigned*)(p + d + 32) = pk2(v[1] * c0.x + v[0] * c0.y, v[3] * c1.x + v[2] * c1.y);
        } else {
            bf16_t* p = V + ((size_t)(b * NH + ((c - 2048) >> 6)) * SEQ + t) * DH + (c & 63);
            *(u32x2*)p = (u32x2){pk2(v[0], v[1]), pk2(v[2], v[3])};
        }
    }
    __device__ __forceinline__ void operator()(int row, int c, f32x4 v, f32x4 w) const {
        const int t = row & (SEQ - 1), b = row >> 13;
        if (c < 2048) {
            if (c < 1024) { v = v * QSCALE; w = w * QSCALE; }
            const int d = (c & 63) >> 1;
            bf16_t* p = c < 1024 ? Q + (size_t)row * DM + (c & ~63) : K + ((size_t)(b * NH + ((c - 1024) >> 6)) * SEQ + t) * DH;
            const f32x4 cs01 = *(const f32x4*)(rope + t * 32 + d), cs23 = *(const f32x4*)(rope + t * 32 + d + 2);
            *(u32x2*)(p + d) = (u32x2){pk2(v[0] * cs01[0] - v[1] * cs01[1], v[2] * cs01[2] - v[3] * cs01[3]), pk2(w[0] * cs23[0] - w[1] * cs23[1], w[2] * cs23[2] - w[3] * cs23[3])};
            *(u32x2*)(p + d + 32) = (u32x2){pk2(v[1] * cs01[0] + v[0] * cs01[1], v[3] * cs01[2] + v[2] * cs01[3]), pk2(w[1] * cs23[0] + w[0] * cs23[1], w[3] * cs23[2] + w[2] * cs23[3])};
        } else {
            bf16_t* p = V + ((size_t)(b * NH + ((c - 2048) >> 6)) * SEQ + t) * DH + (c & 63);
            *(u32x4*)p = (u32x4){pk2(v[0], v[1]), pk2(v[2], v[3]), pk2(w[0], w[1]), pk2(w[2], w[3])};
        }
    }
};
struct EpiCmp {
    static constexpr bool AFTER = true;
    const float* bias; const bf16_t* W2T; const float2* rope; bf16_t* OUT;
    __device__ __forceinline__ void operator()(const f32x4 (&)[2][2][4][2], const g8::Unit&, int, int, int, int) const {}
    __device__ __forceinline__ void after(const f32x4 (&acc)[2][2][4][2], const g8::Unit& u, LAS unsigned char* lds, int wr, int wc, int fr, int fq, int wid, int lane) const {
#pragma unroll
        for (int bj = 0; bj < 2; ++bj) {
            const int c0 = bj * 128 + wc * 32 + 8 * fq;
            const f32x4 bv = *(const f32x4*)(bias + c0), bw = *(const f32x4*)(bias + c0 + 4);
#pragma unroll
            for (int ai = 0; ai < 2; ++ai)
#pragma unroll
                for (int m = 0; m < 4; ++m) { const int row = ai * 128 + wr * 64 + m * 16 + fr; const f32x4 v = acc[ai][bj][m][0] + bv, w = acc[ai][bj][m][1] + bw;
                    *(LAS u32x4*)(lds + row * 528 + c0 * 2) = (u32x4){pk2(gelu_tanh(v[0]), gelu_tanh(v[1])), pk2(gelu_tanh(v[2]), gelu_tanh(v[3])), pk2(gelu_tanh(w[0]), gelu_tanh(w[1])), pk2(gelu_tanh(w[2]), gelu_tanh(w[3]))}; }
        }
        asm volatile("s_waitcnt lgkmcnt(0)\n\ts_barrier" ::: "memory");
        f32x4 o[2][4];
#pragma unroll
        for (int rt = 0; rt < 2; ++rt)
#pragma unroll
            for (int dt = 0; dt < 4; ++dt) o[rt][dt] = (f32x4){0.f, 0.f, 0.f, 0.f};
#pragma unroll
        for (int s8 = 0; s8 < 8; ++s8) {
            bf16x8 hb[2], wa[4];
#pragma unroll
            for (int rt = 0; rt < 2; ++rt) hb[rt] = *(const LAS bf16x8*)(lds + (32 * wid + 16 * rt + fr) * 528 + (32 * s8 + 8 * fq) * 2);
#pragma unroll
            for (int dt = 0; dt < 4; ++dt) wa[dt] = *(const bf16x8*)(W2T + (16 * dt + fr) * 256 + 32 * s8 + 8 * fq);
#pragma unroll
            for (int rt = 0; rt < 2; ++rt)
#pragma unroll
                for (int dt = 0; dt < 4; ++dt) o[rt][dt] = __builtin_amdgcn_mfma_f32_16x16x32_bf16(wa[dt], hb[rt], o[rt][dt], 0, 0, 0);
        }
#pragma unroll
        for (int rt = 0; rt < 2; ++rt) {
            const int rg = u.pm * 256 + 32 * wid + 16 * rt + fr, ci = rg & 511;
            if (rope) {
#pragma unroll
                for (int dt = 0; dt < 2; ++dt) {
                    const f32x4 cs01 = *(const f32x4*)(rope + (16 * ci + 31) * 32 + 16 * dt + 4 * fq), cs23 = *(const f32x4*)(rope + (16 * ci + 31) * 32 + 16 * dt + 4 * fq + 2);
                    const f32x4 lo = o[rt][dt], hi = o[rt][dt + 2];
                    o[rt][dt] = (f32x4){lo[0] * cs01[0] - hi[0] * cs01[1], lo[1] * cs01[2] - hi[1] * cs01[3], lo[2] * cs23[0] - hi[2] * cs23[1], lo[3] * cs23[2] - hi[3] * cs23[3]};
                    o[rt][dt + 2] = (f32x4){hi[0] * cs01[0] + lo[0] * cs01[1], hi[1] * cs01[2] + lo[1] * cs01[3], hi[2] * cs23[0] + lo[2] * cs23[1], hi[3] * cs23[2] + lo[3] * cs23[3]};
                }
            }
            const float z = ci == 511 ? 0.f : 1.f;
#pragma unroll
            for (int dt = 0; dt < 4; ++dt) { const f32x4 x = o[rt][dt] * z; *(u32x2*)(OUT + (size_t)rg * 64 + 16 * dt + 4 * fq) = (u32x2){pk2(x[0], x[1]), pk2(x[2], x[3])}; }
        }
    }
};
struct EpiSwiGLU {
    bf16_t* H;
    __device__ __forceinline__ void operator()(int row, int c, f32x4 v) const {
        const float h0 = v[0] * sigmoidf_(v[0]) * v[1], h1 = v[2] * sigmoidf_(v[2]) * v[3];
        *(unsigned*)(H + (size_t)row * DE + (c >> 1)) = pk2(h0, h1);
    }
    __device__ __forceinline__ void operator()(int row, int c, f32x4 v, f32x4 w) const {
        *(u32x2*)(H + (size_t)row * DE + (c >> 1)) = (u32x2){pk2(v[0] * sigmoidf_(v[0]) * v[1], v[2] * sigmoidf_(v[2]) * v[3]), pk2(w[0] * sigmoidf_(w[0]) * w[1], w[2] * sigmoidf_(w[2]) * w[3])};
    }
};
struct EpiBf16 {
    bf16_t* Y;
    __device__ __forceinline__ void operator()(int row, int c, f32x4 v) const { *(u32x2*)(Y + (size_t)row * DM + c) = (u32x2){pk2(v[0], v[1]), pk2(v[2], v[3])}; }
    __device__ __forceinline__ void operator()(int row, int c, f32x4 v, f32x4 w) const { *(u32x4*)(Y + (size_t)row * DM + c) = (u32x4){pk2(v[0], v[1]), pk2(v[2], v[3]), pk2(w[0], w[1]), pk2(w[2], w[3])}; }
};

struct ExpertMap { int cnt[NE]; int base[NE + 1]; };
__device__ __forceinline__ void load_expert_map(const Ctx& C, int cw, LAS int* sm  ) {
    if (C.tid == 0) {
        const unsigned* ctl = (const unsigned*)(C.ws + WS_CTL); int acc = 0;
        for (int e = 0; e < NE; ++e) { const int c = (int)__hip_atomic_load(ctl + cw + 64 * e, __ATOMIC_RELAXED, __HIP_MEMORY_SCOPE_AGENT); sm[e] = c; sm[16 + e] = acc; acc += (c + 255) & ~255; }
        sm[32] = acc;
    }
    __syncthreads();
}

__device__ __forceinline__ void load_qh(const bf16_t* qp, float (&qh)[64]) {
    const uint4* q4 = (const uint4*)qp;
#pragma unroll
    for (int c = 0; c < 8; ++c) { const uint4 w = q4[c]; qh[8 * c] = bflo(w.x); qh[8 * c + 1] = bfhi(w.x); qh[8 * c + 2] = bflo(w.y); qh[8 * c + 3] = bfhi(w.y);
        qh[8 * c + 4] = bflo(w.z); qh[8 * c + 5] = bfhi(w.z); qh[8 * c + 6] = bflo(w.w); qh[8 * c + 7] = bfhi(w.w); }
}
namespace fa {
constexpr int SLOT = 16384, NSLOT = 4;
constexpr float C2 = 0.125f * 1.4426950408889634f;
constexpr float NEGBIG = -1e30f;
typedef short v4i16 __attribute__((ext_vector_type(4)));
template <bool WITH_V = true>
__device__ __forceinline__ void dma_block(LAS unsigned char* slot, const bf16_t* Kg, const bf16_t* Vg, int wave, int lane) {
    { const int key = 8 * wave + (lane >> 3), c = (lane & 7) ^ ((key >> 1) & 7);
      __builtin_amdgcn_global_load_lds((const unsigned*)(Kg + key * 64 + 8 * c), (LAS unsigned*)(slot + wave * 1024), 16, 0, 0); }
    if (WITH_V) { const int key = 16 * (wave & 3) + (lane >> 2), cp = lane & 3, d = (wave >> 2) * 32 + ((((cp >> 1) ^ ((key >> 2) & 1))) << 4) + ((cp & 1) << 3);
      __builtin_amdgcn_global_load_lds((const unsigned*)(Vg + key * 64 + d), (LAS unsigned*)(slot + 8192 + wave * 1024), 16, 0, 0); }
}
__device__ __forceinline__ unsigned cvt_pk_bf16(float lo, float hi) { const f32x2v v = {lo, hi}; const bf16x2v b = __builtin_convertvector(v, bf16x2v); return __builtin_bit_cast(unsigned, b); }
struct Task { bf16x8 q[2]; int kmin, kmax; float m, l, cinit; f32x4 O[4]; f32x4 L; unsigned fw0; const LAS unsigned* fwp; int imptok; };
template <int FM> __device__ __forceinline__ bool row_flag(const Task& t, int jb) {
    if (FM == 0) return true;
    if (FM == 1) { const unsigned w = t.fwp[jb >> 5]; return ((w >> (jb & 31)) & 1u) != 0u; }
    return ((t.fw0 >> (jb >> 2)) & 1u) != 0u;
}
struct LaneC { int fq, koff0, koff1, voffA, voffB; };
__device__ __forceinline__ LaneC lane_consts(int lane) {
    const int i16 = lane & 15, fq = lane >> 4, kx = (i16 >> 1) & 7, q4 = i16 >> 2, p4 = lane & 3;
    LaneC lc; lc.fq = fq; lc.koff0 = i16 * 128 + ((fq ^ kx) << 4); lc.koff1 = i16 * 128 + (((4 + fq) ^ kx) << 4);
    lc.voffA = 8192 + (4 * fq + q4) * 64 + ((0 ^ (fq & 1)) << 5) + 8 * p4; lc.voffB = 8192 + (4 * fq + q4) * 64 + ((1 ^ (fq & 1)) << 5) + 8 * p4;
    return lc;
}
__device__ __forceinline__ float xrow16_max(float x) {
    auto s = __builtin_amdgcn_permlane16_swap(__float_as_uint(x), __float_as_uint(x), false, false);
    x = fmaxf(__uint_as_float(s[0]), __uint_as_float(s[1]));
    auto t = __builtin_amdgcn_permlane32_swap(__float_as_uint(x), __float_as_uint(x), false, false);
    return fmaxf(__uint_as_float(t[0]), __uint_as_float(t[1]));
}
__device__ __forceinline__ float xrow16_sum(float x) {
    auto s = __builtin_amdgcn_permlane16_swap(__float_as_uint(x), __float_as_uint(x), false, false);
    x = __uint_as_float(s[0]) + __uint_as_float(s[1]);
    auto t = __builtin_amdgcn_permlane32_swap(__float_as_uint(x), __float_as_uint(x), false, false);
    return __uint_as_float(t[0]) + __uint_as_float(t[1]);
}
__device__ __forceinline__ void t_mask(const Task& t, f32x4 (&s)[4], int kb, int fq) {
#pragma unroll
    for (int kt = 0; kt < 4; ++kt)
#pragma unroll
        for (int r = 0; r < 4; ++r) { const int key = kb + 16 * kt + 4 * fq + r; s[kt][r] = (key >= t.kmin && key <= t.kmax) ? s[kt][r] : NEGBIG; }
}
template <int MODE> __device__ __forceinline__ float t_stats(Task& t, f32x4 (&s)[4], bool rf) {
    float bm = fmaxf(fmaxf(fmaxf(s[0][0], s[0][1]), fmaxf(s[0][2], s[0][3])), fmaxf(fmaxf(s[1][0], s[1][1]), fmaxf(s[1][2], s[1][3])));
    bm = fmaxf(bm, fmaxf(fmaxf(fmaxf(s[2][0], s[2][1]), fmaxf(s[2][2], s[2][3])), fmaxf(fmaxf(s[3][0], s[3][1]), fmaxf(s[3][2], s[3][3]))));
    bm = xrow16_max(bm);
    if (!rf) bm = NEGBIG;
    const float mnew = fmaxf(t.m, bm);
    const float alpha = __builtin_amdgcn_exp2f(t.m - mnew);
    t.m = mnew;
    const float msub = (rf && mnew > -1e29f) ? mnew : __builtin_inff();
#pragma unroll
    for (int kt = 0; kt < 4; ++kt) s[kt] = s[kt] - msub;
    if (MODE == 1) t.l *= alpha;
    return alpha;
}
__device__ __forceinline__ void t_exp(f32x4 (&s)[4]) {
#pragma unroll
    for (int kt = 0; kt < 4; ++kt)
#pragma unroll
        for (int r = 0; r < 4; ++r) s[kt][r] = __builtin_amdgcn_exp2f(s[kt][r]);
}
__device__ __forceinline__ float quad_sum(float x) {
    x += __builtin_bit_cast(float, __builtin_amdgcn_mov_dpp(__builtin_bit_cast(int, x), 0xB1, 0xf, 0xf, true));
    x += __builtin_bit_cast(float, __builtin_amdgcn_mov_dpp(__builtin_bit_cast(int, x), 0x4E, 0xf, 0xf, true));
    return x;
}
__device__ __forceinline__ void t_imp(const Task& t, const f32x4 (&s)[4], int kb, int fq, LAS float* impbase) {
    float ga[4], gb[4];
#pragma unroll
    for (int kt = 0; kt < 4; ++kt) { ga[kt] = quad_sum((s[kt][0] + s[kt][1]) + (s[kt][2] + s[kt][3])); gb[kt] = quad_sum(s[kt][3]); }
    if ((t.imptok & 0x10000) == 0) return;
    LAS float* ip = impbase + (t.imptok & 0xffff) * 130 + (kb >> 2) + fq;
#pragma unroll
    for (int kt = 0; kt < 4; ++kt) { ip[4 * kt] = ga[kt]; ip[64 * 130 + 4 * kt] = gb[kt]; }
}
__device__ __forceinline__ bf16x8 t_pack(const f32x4 (&s)[4], int u) {
    u32x4 pw; pw.x = cvt_pk_bf16(s[2 * u][0], s[2 * u][1]); pw.y = cvt_pk_bf16(s[2 * u][2], s[2 * u][3]); pw.z = cvt_pk_bf16(s[2 * u + 1][0], s[2 * u + 1][1]); pw.w = cvt_pk_bf16(s[2 * u + 1][2], s[2 * u + 1][3]);
    return __builtin_bit_cast(bf16x8, pw);
}
template <int MODE, bool DA, bool DB>
__device__ __forceinline__ void do_blk(Task& a, Task& b, bool rfa, bool rfb, bool masked, LAS unsigned char* slot, int kb, LAS float* impbase, const LaneC& lc) {
    f32x4 sa[4], sb[4];
    const float xa = (MODE >= 2) ? (rfa ? a.cinit : -__builtin_inff()) : 0.f, xb = (MODE >= 2) ? (rfb ? b.cinit : -__builtin_inff()) : 0.f;
    const f32x4 ca = (f32x4){xa, xa, xa, xa}, cb = (f32x4){xb, xb, xb, xb};
#pragma unroll
    for (int kt = 0; kt < 4; ++kt) {
        const bf16x8 k0 = *(const LAS bf16x8*)(slot + lc.koff0 + kt * 2048), k1 = *(const LAS bf16x8*)(slot + lc.koff1 + kt * 2048);
        if (DA) { sa[kt] = __builtin_amdgcn_mfma_f32_16x16x32_bf16(k0, a.q[0], ca, 0, 0, 0); sa[kt] = __builtin_amdgcn_mfma_f32_16x16x32_bf16(k1, a.q[1], sa[kt], 0, 0, 0); }
        if (DB) { sb[kt] = __builtin_amdgcn_mfma_f32_16x16x32_bf16(k0, b.q[0], cb, 0, 0, 0); sb[kt] = __builtin_amdgcn_mfma_f32_16x16x32_bf16(k1, b.q[1], sb[kt], 0, 0, 0); }
    }
    if (masked) { if (DA) t_mask(a, sa, kb, lc.fq); if (DB) t_mask(b, sb, kb, lc.fq); }
    if (MODE < 2) {
        float ala = 1.0f, alb = 1.0f;
        if (DA) ala = t_stats<MODE>(a, sa, rfa);
        if (DB) alb = t_stats<MODE>(b, sb, rfb);
        if (MODE == 0) {
            if (__ballot((DA && ala != 1.0f) || (DB && alb != 1.0f)) != 0ull) {
#pragma unroll
                for (int dt = 0; dt < 4; ++dt) { if (DA) a.O[dt] = a.O[dt] * ala; if (DB) b.O[dt] = b.O[dt] * alb; }
                if (DA) a.L = a.L * ala; if (DB) b.L = b.L * alb;
            }
        }
    }
    if (DA) t_exp(sa);
    if (DB) t_exp(sb);
    if (MODE == 1) {
        if (DA) a.l += ((sa[0][0] + sa[0][1]) + (sa[0][2] + sa[0][3])) + ((sa[1][0] + sa[1][1]) + (sa[1][2] + sa[1][3])) + ((sa[2][0] + sa[2][1]) + (sa[2][2] + sa[2][3])) + ((sa[3][0] + sa[3][1]) + (sa[3][2] + sa[3][3]));
        if (DB) b.l += ((sb[0][0] + sb[0][1]) + (sb[0][2] + sb[0][3])) + ((sb[1][0] + sb[1][1]) + (sb[1][2] + sb[1][3])) + ((sb[2][0] + sb[2][1]) + (sb[2][2] + sb[2][3])) + ((sb[3][0] + sb[3][1]) + (sb[3][2] + sb[3][3]));
    }
    if (MODE == 2) { if (DA) t_imp(a, sa, kb, lc.fq, impbase); if (DB) t_imp(b, sb, kb, lc.fq, impbase); }
    if (MODE != 1) {
        const bf16x8 ones = (bf16x8){0x3F80, 0x3F80, 0x3F80, 0x3F80, 0x3F80, 0x3F80, 0x3F80, 0x3F80};
#pragma unroll
        for (int u = 0; u < 2; ++u) {
            bf16x8 pa, pb; if (DA) pa = t_pack(sa, u); if (DB) pb = t_pack(sb, u);
            if (MODE != 2) { if (DA) a.L = __builtin_amdgcn_mfma_f32_16x16x32_bf16(ones, pa, a.L, 0, 0, 0); if (DB) b.L = __builtin_amdgcn_mfma_f32_16x16x32_bf16(ones, pb, b.L, 0, 0, 0); }
#pragma unroll
            for (int dt = 0; dt < 4; ++dt) {
                const int vo = ((dt & 1) ? lc.voffB : lc.voffA) + (dt >> 1) * 4096 + u * 2048;
                const v4i16 a0 = __builtin_amdgcn_ds_read_tr16_b64_v4i16((LAS v4i16*)(slot + vo)), a1 = __builtin_amdgcn_ds_read_tr16_b64_v4i16((LAS v4i16*)(slot + vo + 1024));
                const bf16x8 vf = (bf16x8){a0[0], a0[1], a0[2], a0[3], a1[0], a1[1], a1[2], a1[3]};
                if (DA) a.O[dt] = __builtin_amdgcn_mfma_f32_16x16x32_bf16(vf, pa, a.O[dt], 0, 0, 0);
                if (DB) b.O[dt] = __builtin_amdgcn_mfma_f32_16x16x32_bf16(vf, pb, b.O[dt], 0, 0, 0);
            }
        }
    }
}
template <int MODE, int FM>
__device__ __forceinline__ void flash_loop(LAS unsigned char* ring, const bf16_t* Kg, const bf16_t* Vg, int nblk, Task& Ta, Task& Tb, LAS float* impbase, int wave, int lane) {
    const int i16 = lane & 15, fq = lane >> 4;
    const int kx = (i16 >> 1) & 7;
    const int q4 = i16 >> 2, p4 = lane & 3;
    LaneC lc; lc.fq = fq; lc.koff0 = i16 * 128 + ((fq ^ kx) << 4); lc.koff1 = i16 * 128 + (((4 + fq) ^ kx) << 4);
    lc.voffA = 8192 + (4 * fq + q4) * 64 + ((0 ^ (fq & 1)) << 5) + 8 * p4; lc.voffB = 8192 + (4 * fq + q4) * 64 + ((1 ^ (fq & 1)) << 5) + 8 * p4;
    const int amin = __builtin_amdgcn_readlane(Ta.kmin, 15), amax = __builtin_amdgcn_readlane(Ta.kmax, 0), bmin = __builtin_amdgcn_readlane(Tb.kmin, 15), bmax = __builtin_amdgcn_readlane(Tb.kmax, 0);
#pragma unroll
    for (int j = 0; j < NSLOT - 1; ++j) { const int jj = j < nblk ? j : nblk - 1; dma_block(ring + j * SLOT, Kg + (size_t)jj * 4096, Vg + (size_t)jj * 4096, wave, lane); }
    for (int jb = 0; jb < nblk; ++jb) {
        asm volatile("s_waitcnt vmcnt(4) lgkmcnt(0)\n\ts_barrier" ::: "memory");
        { const int jn = jb + 3 < nblk ? jb + 3 : nblk - 1; dma_block(ring + ((jb + 3) & 3) * SLOT, Kg + (size_t)jn * 4096, Vg + (size_t)jn * 4096, wave, lane); }
        LAS unsigned char* slot = ring + (jb & 3) * SLOT;
        const int kb = jb * 64;
        const bool rfa = row_flag<FM>(Ta, jb), rfb = row_flag<FM>(Tb, jb);
        const bool na = __ballot(rfa && Ta.kmax >= kb && Ta.kmin <= kb + 63) != 0ull, nb2 = __ballot(rfb && Tb.kmax >= kb && Tb.kmin <= kb + 63) != 0ull;
        const bool masked = !((!na || (kb >= amin && kb + 63 <= amax)) && (!nb2 || (kb >= bmin && kb + 63 <= bmax)));
        if (FM == 1) {
            if (na) do_blk<MODE, true, false>(Ta, Tb, rfa, rfb, masked, slot, kb, impbase, lc);
            if (nb2) do_blk<MODE, false, true>(Ta, Tb, rfa, rfb, masked, slot, kb, impbase, lc);
        } else {
            if (na || nb2) do_blk<MODE, true, true>(Ta, Tb, rfa, rfb, masked, slot, kb, impbase, lc);
        }
    }
    asm volatile("s_waitcnt vmcnt(0) lgkmcnt(0)\n\ts_barrier" ::: "memory");
}
template <int MODE, int FM>
__device__ __forceinline__ void flash_loop2(LAS unsigned char* ring, const bf16_t* Kg, const bf16_t* Vg, int nblk, Task& Ta, Task& Tb, LAS float* impbase, int wave, int lane) {
    const int i16 = lane & 15, fq = lane >> 4;
    const int kx = (i16 >> 1) & 7;
    const int q4 = i16 >> 2, p4 = lane & 3;
    LaneC lc; lc.fq = fq; lc.koff0 = i16 * 128 + ((fq ^ kx) << 4); lc.koff1 = i16 * 128 + (((4 + fq) ^ kx) << 4);
    lc.voffA = 8192 + (4 * fq + q4) * 64 + ((0 ^ (fq & 1)) << 5) + 8 * p4; lc.voffB = 8192 + (4 * fq + q4) * 64 + ((1 ^ (fq & 1)) << 5) + 8 * p4;
    const int amin = __builtin_amdgcn_readlane(Ta.kmin, 15), amax = __builtin_amdgcn_readlane(Ta.kmax, 0), bmin = __builtin_amdgcn_readlane(Tb.kmin, 15), bmax = __builtin_amdgcn_readlane(Tb.kmax, 0);
    const int nit = (nblk + 1) >> 1;
#pragma unroll
    for (int j = 0; j < 2; ++j) { const int jj = j < nblk ? j : nblk - 1; dma_block(ring + j * SLOT, Kg + (size_t)jj * 4096, Vg + (size_t)jj * 4096, wave, lane); }
    for (int i = 0; i < nit; ++i) {
        asm volatile("s_waitcnt vmcnt(0) lgkmcnt(0)\n\ts_barrier" ::: "memory");
#pragma unroll
        for (int j = 0; j < 2; ++j) { const int jn = 2 * i + 2 + j < nblk ? 2 * i + 2 + j : nblk - 1; dma_block(ring + ((2 * i + 2 + j) & 3) * SLOT, Kg + (size_t)jn * 4096, Vg + (size_t)jn * 4096, wave, lane); }
        if (FM == 1 && !SEL_FUSED) {
#pragma unroll
        for (int k = 0; k < 2; ++k) {
            const int jb = 2 * i + k;
            if (jb < nblk) {
                LAS unsigned char* slot = ring + (jb & 3) * SLOT;
                const int kb = jb * 64;
                const bool rfa = row_flag<FM>(Ta, jb), rfb = row_flag<FM>(Tb, jb);
                const bool na = __ballot(rfa && Ta.kmax >= kb && Ta.kmin <= kb + 63) != 0ull, nb2 = __ballot(rfb && Tb.kmax >= kb && Tb.kmin <= kb + 63) != 0ull;
                const bool masked = !((!na || (kb >= amin && kb + 63 <= amax)) && (!nb2 || (kb >= bmin && kb + 63 <= bmax)));
                if (na) do_blk<MODE, true, false>(Ta, Tb, rfa, rfb, masked, slot, kb, impbase, lc);
                if (nb2) do_blk<MODE, false, true>(Ta, Tb, rfa, rfb, masked, slot, kb, impbase, lc);
            }
        }
        } else {
            const int j0 = 2 * i, j1 = 2 * i + 1;
            const bool ra0 = row_flag<FM>(Ta, j0), rb0 = row_flag<FM>(Tb, j0), ra1 = j1 < nblk && row_flag<FM>(Ta, j1), rb1 = j1 < nblk && row_flag<FM>(Tb, j1);
            if (__ballot(ra0 || rb0 || ra1 || rb1) != 0ull) {
                const int k0 = j0 * 64, k1 = j1 * 64;
                const bool mk = (FM == 0) && !(k0 >= amin && k1 + 63 <= amax && k0 >= bmin && k1 + 63 <= bmax);
                if (!mk) {
                    do_blk<MODE, true, true>(Ta, Tb, ra0, rb0, false, ring + (j0 & 3) * SLOT, k0, impbase, lc);
                    if (FM == 0) __builtin_amdgcn_sched_barrier(0);
                    do_blk<MODE, true, true>(Ta, Tb, ra1, rb1, false, ring + (j1 & 3) * SLOT, k1, impbase, lc);
                } else {
                    do_blk<MODE, true, true>(Ta, Tb, ra0, rb0, true, ring + (j0 & 3) * SLOT, k0, impbase, lc);
                    __builtin_amdgcn_sched_barrier(0);
                    do_blk<MODE, true, true>(Ta, Tb, ra1, rb1, true, ring + (j1 & 3) * SLOT, k1, impbase, lc);
                }
            }
        }
    }
    asm volatile("s_waitcnt vmcnt(0) lgkmcnt(0)\n\ts_barrier" ::: "memory");
}
__device__ __forceinline__ void task_reset(Task& t) { t.m = NEGBIG; t.l = 0.f; t.cinit = 0.f; t.L = (f32x4){0.f, 0.f, 0.f, 0.f};
#pragma unroll
    for (int dt = 0; dt < 4; ++dt) t.O[dt] = (f32x4){0.f, 0.f, 0.f, 0.f}; }
__device__ __forceinline__ float task_rowsum(const Task& t) { return t.L[0]; }
__device__ __forceinline__ float task_rowsum_stats(const Task& t) { return xrow16_sum(t.l); }
constexpr float REF_DELTA = 32.f;
__device__ __forceinline__ void task_fix_ref(Task& t) {
    t.cinit = -(t.m + REF_DELTA);
    const float sc = __builtin_amdgcn_exp2f(-REF_DELTA);
    t.L = t.L * sc;
#pragma unroll
    for (int dt = 0; dt < 4; ++dt) t.O[dt] = t.O[dt] * sc;
}
}

struct NsaRow { int RI, c, b; u32x2 out[4];
    __device__ __forceinline__ int tokl() const { return RI >> 2; }
    __device__ __forceinline__ int head() const { return RI & 3; }
    __device__ __forceinline__ int tt() const { return 64 * c + (RI >> 2); }
    __device__ __forceinline__ size_t grow() const { return (size_t)(b * SEQ + 64 * c + (RI >> 2)); }
};
__device__ __forceinline__ void nsa_row_init(NsaRow& r, fa::Task& t, const bf16_t* Q, int b, int g, int c, int R, int fq) {
    r.RI = R; r.c = c; r.b = b;
    const bf16_t* qp = Q + r.grow() * DM + (g * 4 + r.head()) * DH + 8 * fq;
    t.q[0] = *(const bf16x8*)qp; t.q[1] = *(const bf16x8*)(qp + 32);
    t.imptok = r.tokl() | (r.head() == 0 ? 0x10000 : 0); t.fw0 = 0u; t.fwp = nullptr;
#pragma unroll
    for (int dt = 0; dt < 4; ++dt) r.out[dt] = (u32x2){0u, 0u};
}
__device__ __forceinline__ void nsa_cmp_setup(const NsaRow& r, fa::Task& t) {
    const int tt_ = r.tt(); const int nv = tt_ >= 31 ? (((tt_ - 31) >> 4) + 1 > 511 ? 511 : ((tt_ - 31) >> 4) + 1) : 0;
    t.kmin = 0; t.kmax = nv - 1; fa::task_reset(t);
}
__device__ __forceinline__ void nsa_accum(NsaRow& r, const fa::Task& t, float sc) {
#pragma unroll
    for (int dt = 0; dt < 4; ++dt) { const f32x4 o = t.O[dt] * sc; const u32x2 w = r.out[dt];
        r.out[dt] = (u32x2){pk2(bflo(w.x) + o[0], bfhi(w.x) + o[1]), pk2(bflo(w.y) + o[2], bfhi(w.y) + o[3])}; }
}
__device__ __forceinline__ void nsa_store(const NsaRow& r, bf16_t* AO, int g, int fq) {
    bf16_t* op = AO + r.grow() * DM + (g * 4 + r.head()) * DH + 4 * fq;
#pragma unroll
    for (int dt = 0; dt < 4; ++dt) *(u32x2*)(op + 16 * dt) = r.out[dt];
}
__device__ __forceinline__ void ph_nsa_fa(const Ctx& C) {
    LAS unsigned char* L = (LAS unsigned char*)C.lds;
    LAS unsigned char* ring = L;
    LAS float* imp = (LAS float*)(L + 65536);
    LAS unsigned* selm = (LAS unsigned*)(L + 135168);
    const bf16_t* Q = (const bf16_t*)(C.ws + WS_Q); const bf16_t* KC = (const bf16_t*)(C.ws + WS_KC); const bf16_t* VC = (const bf16_t*)(C.ws + WS_VC);
    const bf16_t* KS = (const bf16_t*)(C.ws + WS_KV0 + 2 * KVSEG); const bf16_t* VS = (const bf16_t*)(C.ws + WS_KV0 + 3 * KVSEG);
    const bf16_t* KW = (const bf16_t*)(C.ws + WS_KV0 + 4 * KVSEG); const bf16_t* VW = (const bf16_t*)(C.ws + WS_KV0 + 5 * KVSEG);
    const float* gates = (const float*)(C.ws + WS_GATES); bf16_t* AO = (bf16_t*)(C.ws + WS_Q);
    const int wave = C.wave;
    for (int u = C.bid; u < NB * NG * (SEQ / 64); u += C.nb) {
        int lane = C.lane; asm volatile("" : "+v"(lane));
        const int i16 = lane & 15, fq = lane >> 4;
        const int rnd = u / C.nb, idx = (u % C.nb) >> 4, bg = u & 15, b = bg >> 2, g = bg & 3;
        const int c = (C.nb == 256) ? 127 - 16 * rnd - ((rnd & 1) ? 15 - idx : idx) : 127 - (u >> 4);
        fa::Task T0, T1; NsaRow R0, R1;
        nsa_row_init(R0, T0, Q, b, g, c, 32 * wave + i16, fq);
        nsa_row_init(R1, T1, Q, b, g, c, 32 * wave + 16 + i16, fq);
        for (int i = C.tid; i < 2 * 64 * 130; i += NTHREADS) imp[i] = 0.f;
        if (C.tid < 256) selm[C.tid] = 0u;
        const int nvm = ((64 * c + 63 - 31) >> 4) + 1;
        const int nvmax = nvm > 511 ? 511 : nvm;
        const int nblkc = (nvmax + 63) >> 6;
        nsa_cmp_setup(R0, T0); nsa_cmp_setup(R1, T1);
        fa::flash_loop<1, 0>(ring, KC + (size_t)bg * 512 * DH, VC + (size_t)bg * 512 * DH, nblkc, T0, T1, imp, wave, lane);
        { const float l0 = fa::task_rowsum_stats(T0), l1 = fa::task_rowsum_stats(T1);
          T0.cinit = l0 > 0.f ? -T0.m - __builtin_amdgcn_logf(l0) : -__builtin_inff(); T1.cinit = l1 > 0.f ? -T1.m - __builtin_amdgcn_logf(l1) : -__builtin_inff(); }
        fa::flash_loop<2, 0>(ring, KC + (size_t)bg * 512 * DH, VC + (size_t)bg * 512 * DH, nblkc, T0, T1, imp, wave, lane);
        nsa_accum(R0, T0, gates[R0.grow() * 48 + g * 4 + R0.head()]);
        nsa_accum(R1, T1, gates[R1.grow() * 48 + g * 4 + R1.head()]);
        {
            const int jq = c, ncand = jq - 2 > 0 ? jq - 2 : 0, nforced = jq == 0 ? 1 : (jq == 1 ? 2 : 3), need = 16 - nforced;
#pragma unroll
            for (int g2 = 0; g2 < 2; ++g2) {
                const int tk = 8 * wave + 4 * g2 + (lane >> 4);
                unsigned key[8]; unsigned selb = 0u;
#pragma unroll
                for (int k = 0; k < 8; ++k) { const int j = i16 + 16 * k; const bool cand = j >= 1 && j <= jq - 2;
                    key[k] = cand ? ((__float_as_uint(imp[tk * 130 + j] + imp[64 * 130 + tk * 130 + j - 1]) & 0xFFFFFF80u) | (unsigned)(127 - j)) : 0u; }
                if (ncand <= need) {
#pragma unroll
                    for (int k = 0; k < 8; ++k) selb |= (key[k] != 0u) ? (1u << k) : 0u;
                } else {
                    for (int r = 0; r < need; ++r) {
                        unsigned m = max(max(max(key[0], key[1]), max(key[2], key[3])), max(max(key[4], key[5]), max(key[6], key[7])));
                        m = max(m, (unsigned)__builtin_amdgcn_mov_dpp((int)m, 0xB1, 0xf, 0xf, true));
                        m = max(m, (unsigned)__builtin_amdgcn_mov_dpp((int)m, 0x4E, 0xf, 0xf, true));
                        m = max(m, (unsigned)__builtin_amdgcn_mov_dpp((int)m, 0x141, 0xf, 0xf, true));
                        m = max(m, (unsigned)__builtin_amdgcn_mov_dpp((int)m, 0x140, 0xf, 0xf, true));
#pragma unroll
                        for (int k = 0; k < 8; ++k) { const bool hit = key[k] == m; selb |= hit ? (1u << k) : 0u; key[k] = hit ? 0u : key[k]; }
                    }
                }
#pragma unroll
                for (int k = 0; k < 8; ++k) { const int j = i16 + 16 * k; if (j == 0 || j == jq || j == jq - 1) selb |= 1u << k; }
#pragma unroll
                for (int w2 = 0; w2 < 4; ++w2) {
                    const unsigned bits = (((selb >> (2 * w2)) & 1u) << i16) | (((selb >> (2 * w2 + 1)) & 1u) << (16 + i16));
                    if (bits) __hip_atomic_fetch_or(selm + tk * 4 + w2, bits, __ATOMIC_RELAXED, __HIP_MEMORY_SCOPE_WORKGROUP);
                }
            }
        }
        asm volatile("s_waitcnt lgkmcnt(0)\n\ts_barrier" ::: "memory");
        {
            const int jlo = c - 8 > 0 ? c - 8 : 0;
            T0.kmin = 0; T0.kmax = R0.tokl(); fa::task_reset(T0); T1.kmin = 0; T1.kmax = R1.tokl(); fa::task_reset(T1);
            fa::flash_loop<0, 0>(ring, KW + ((size_t)bg * SEQ + 64 * c) * DH, VW + ((size_t)bg * SEQ + 64 * c) * DH, 1, T0, T1, imp, wave, lane);
            fa::task_fix_ref(T0); fa::task_fix_ref(T1);
            T0.kmin = R0.tt() - 511 - 64 * jlo; T0.kmax = R0.tt() - 64 * jlo; T1.kmin = R1.tt() - 511 - 64 * jlo; T1.kmax = R1.tt() - 64 * jlo;
            if (c > jlo) fa::flash_loop2<3, 0>(ring, KW + ((size_t)bg * SEQ + 64 * jlo) * DH, VW + ((size_t)bg * SEQ + 64 * jlo) * DH, c - jlo, T0, T1, imp, wave, lane);
            const float l0 = fa::task_rowsum(T0), l1 = fa::task_rowsum(T1);
            nsa_accum(R0, T0, (l0 > 0.f ? 1.0f / l0 : 0.f) * gates[R0.grow() * 48 + 32 + g * 4 + R0.head()]);
            nsa_accum(R1, T1, (l1 > 0.f ? 1.0f / l1 : 0.f) * gates[R1.grow() * 48 + 32 + g * 4 + R1.head()]);
        }
        {
            T0.fwp = selm + R0.tokl() * 4; T1.fwp = selm + R1.tokl() * 4;
            T0.kmin = 0; T0.kmax = R0.tokl(); fa::task_reset(T0); T1.kmin = 0; T1.kmax = R1.tokl(); fa::task_reset(T1);
            fa::flash_loop<0, 0>(ring, KS + ((size_t)bg * SEQ + 64 * c) * DH, VS + ((size_t)bg * SEQ + 64 * c) * DH, 1, T0, T1, imp, wave, lane);
            T0.kmax = R0.tt(); T1.kmax = R1.tt(); fa::task_fix_ref(T0); fa::task_fix_ref(T1);
            if (c > 0) fa::flash_loop2<3, 1>(ring, KS + (size_t)bg * SEQ * DH, VS + (size_t)bg * SEQ * DH, c, T0, T1, imp, wave, lane);
            const float l0 = fa::task_rowsum(T0), l1 = fa::task_rowsum(T1);
            nsa_accum(R0, T0, (l0 > 0.f ? 1.0f / l0 : 0.f) * gates[R0.grow() * 48 + 16 + g * 4 + R0.head()]);
            nsa_accum(R1, T1, (l1 > 0.f ? 1.0f / l1 : 0.f) * gates[R1.grow() * 48 + 16 + g * 4 + R1.head()]);
        }
        nsa_store(R0, AO, g, fq); nsa_store(R1, AO, g, fq);
    }
}

constexpr size_t WS_MMASK = 6 * MiB;
constexpr size_t WS_MCINIT = 8 * MiB;
constexpr size_t WS_MPL = 10 * MiB;
__device__ __forceinline__ size_t moba_po_off(int s, int b) {
    const int p = s * 4 + b;
    return p < 8 ? (353 + 16 * (size_t)p) * MiB : (p < 11 ? (45 + 16 * (size_t)(p - 8)) * MiB : 16 * MiB);
}
template <bool WITH_V>
__device__ __forceinline__ void moba_dma256(LAS unsigned char* ring, const bf16_t* K1, const bf16_t* V1, int bh, int blk, int wave, int lane) {
#pragma unroll
    for (int sb = 0; sb < 4; ++sb) fa::dma_block<WITH_V>(ring + sb * fa::SLOT, K1 + ((size_t)bh * SEQ + 256 * blk + 64 * sb) * DH, V1 + ((size_t)bh * SEQ + 256 * blk + 64 * sb) * DH, wave, lane);
}
__device__ __forceinline__ void moba_stage_kmt(LAS unsigned char* kmt, const float* KM, int bh, int tid) {
    if (tid < 256) {
        const int n = tid >> 3, c8 = tid & 7;
        const f32x4 a = *(const f32x4*)(KM + (size_t)bh * 2048 + n * 64 + 8 * c8), b2 = *(const f32x4*)(KM + (size_t)bh * 2048 + n * 64 + 8 * c8 + 4);
        u32x4 hi, lo;
        hi.x = pk2(a[0], a[1]); hi.y = pk2(a[2], a[3]); hi.z = pk2(b2[0], b2[1]); hi.w = pk2(b2[2], b2[3]);
        lo.x = pk2(a[0] - bflo(hi.x), a[1] - bfhi(hi.x)); lo.y = pk2(a[2] - bflo(hi.y), a[3] - bfhi(hi.y)); lo.z = pk2(b2[0] - bflo(hi.z), b2[1] - bfhi(hi.z)); lo.w = pk2(b2[2] - bflo(hi.w), b2[3] - bfhi(hi.w));
        const int off = n * 128 + ((c8 ^ ((n >> 1) & 7)) << 4);
        *(LAS u32x4*)(kmt + off) = hi; *(LAS u32x4*)(kmt + 4096 + off) = lo;
    }
}
__device__ __forceinline__ void ph_moba_sel(const Ctx& C) {
    LAS unsigned char* L = (LAS unsigned char*)C.lds;
    LAS unsigned char* kmt = L + 131072;
    const bf16_t* Q = (const bf16_t*)(C.ws + WS_Q); const bf16_t* K1 = (const bf16_t*)(C.ws + WS_K1); const bf16_t* V1 = (const bf16_t*)(C.ws + WS_V1);
    const float* KM = (const float*)(C.ws + WS_KMEAN); unsigned* MM = (unsigned*)(C.ws + WS_MMASK); float* CI = (float*)(C.ws + WS_MCINIT);
    const int wave = C.wave;
    const int nk = (NB * NH * 32 - C.bid + C.nb - 1) / C.nb;
    const bool bh_const = (C.nb & 63) == 0;
    if (nk > 0) { moba_dma256<false>(L, K1, V1, C.bid & 63, 31 - (C.bid >> 6), wave, C.lane); if (bh_const) moba_stage_kmt(kmt, KM, C.bid & 63, C.tid); }
    for (int k = 0; k < nk; ++k) {
        const int u = C.bid + k * C.nb;
        int lane = C.lane; asm volatile("" : "+v"(lane));
        const int i16 = lane & 15, fq = lane >> 4;
        const int bh = u & 63, b = bh >> 4, h = bh & 15, cb = 31 - (u >> 6);
        LAS unsigned char* ring = L + (k & 1) * 65536;
        if (!bh_const) { asm volatile("s_waitcnt lgkmcnt(0)\n\ts_barrier" ::: "memory"); moba_stage_kmt(kmt, KM, bh, C.tid); }
        fa::Task T[2]; int tt[2];
#pragma unroll
        for (int ti = 0; ti < 2; ++ti) {
            const int R = 32 * wave + 16 * ti + i16; tt[ti] = 256 * cb + R; T[ti].imptok = 0;
            const bf16_t* qp = Q + (size_t)(b * SEQ + tt[ti]) * DM + h * DH + 8 * fq;
            T[ti].q[0] = *(const bf16x8*)qp; T[ti].q[1] = *(const bf16x8*)(qp + 32);
            T[ti].kmin = 0; T[ti].kmax = R; fa::task_reset(T[ti]);
        }
        asm volatile("s_waitcnt vmcnt(0) lgkmcnt(0)\n\ts_barrier" ::: "memory");
        if (k + 1 < nk) { const int un = u + C.nb; moba_dma256<false>(L + ((k + 1) & 1) * 65536, K1, V1, un & 63, 31 - (un >> 6), wave, lane); }
#pragma unroll
        for (int ti = 0; ti < 2; ++ti) {
            const int kx = (i16 >> 1) & 7, ko0 = i16 * 128 + ((fq ^ kx) << 4), ko1 = i16 * 128 + (((4 + fq) ^ kx) << 4);
            float bv0 = -3e38f, bv1 = -3e38f, bv2 = -3e38f; int j0 = 99, j1 = 99, j2 = 99;
#define INS3(a, n) do { if ((a) > bv0 || ((a) == bv0 && (n) < j0)) { bv2 = bv1; j2 = j1; bv1 = bv0; j1 = j0; bv0 = (a); j0 = (n); } \
                else if ((a) > bv1 || ((a) == bv1 && (n) < j1)) { bv2 = bv1; j2 = j1; bv1 = (a); j1 = (n); } \
                else if ((a) > bv2 || ((a) == bv2 && (n) < j2)) { bv2 = (a); j2 = (n); } } while (0)
#pragma unroll
            for (int kt2 = 0; kt2 < 2; ++kt2) {
                const bf16x8 h0 = *(const LAS bf16x8*)(kmt + ko0 + kt2 * 2048), h1 = *(const LAS bf16x8*)(kmt + ko1 + kt2 * 2048);
                const bf16x8 l0 = *(const LAS bf16x8*)(kmt + 4096 + ko0 + kt2 * 2048), l1 = *(const LAS bf16x8*)(kmt + 4096 + ko1 + kt2 * 2048);
                f32x4 g = __builtin_amdgcn_mfma_f32_16x16x32_bf16(l0, T[ti].q[0], (f32x4){0.f, 0.f, 0.f, 0.f}, 0, 0, 0);
                g = __builtin_amdgcn_mfma_f32_16x16x32_bf16(l1, T[ti].q[1], g, 0, 0, 0);
                g = __builtin_amdgcn_mfma_f32_16x16x32_bf16(h0, T[ti].q[0], g, 0, 0, 0);
                g = __builtin_amdgcn_mfma_f32_16x16x32_bf16(h1, T[ti].q[1], g, 0, 0, 0);
#pragma unroll
                for (int r = 0; r < 4; ++r) { const int n = 16 * kt2 + 4 * fq + r; const float a = n < cb ? g[r] : -3e38f; INS3(a, n); }
            }
#pragma unroll
            for (int o = 16; o <= 32; o <<= 1) {
                const float ov0 = __shfl_xor(bv0, o), ov1 = __shfl_xor(bv1, o), ov2 = __shfl_xor(bv2, o); const int oj0 = __shfl_xor(j0, o), oj1 = __shfl_xor(j1, o), oj2 = __shfl_xor(j2, o);
                INS3(ov0, oj0); INS3(ov1, oj1); INS3(ov2, oj2);
            }
#undef INS3
            unsigned mk = 0u;
            if (j0 < cb && bv0 > -1e38f) mk |= 1u << j0; if (j1 < cb && bv1 > -1e38f) mk |= 1u << j1; if (j2 < cb && bv2 > -1e38f) mk |= 1u << j2;
            T[ti].fw0 = mk;
        }
        { const fa::LaneC lc = fa::lane_consts(lane);
#pragma unroll
          for (int sb = 0; sb < 4; ++sb) if (64 * sb <= 32 * wave + 31) fa::do_blk<1, true, true>(T[0], T[1], true, true, 64 * sb + 63 > 32 * wave, ring + sb * fa::SLOT, 64 * sb, nullptr, lc); }
        if (fq == 0) {
#pragma unroll
            for (int ti = 0; ti < 2; ++ti) { MM[(size_t)bh * SEQ + tt[ti]] = T[ti].fw0; CI[(size_t)bh * SEQ + tt[ti]] = -(T[ti].m + fa::REF_DELTA); }
        }
    }
    asm volatile("s_waitcnt vmcnt(0) lgkmcnt(0)\n\ts_barrier" ::: "memory");
}
struct MobaPair { bf16x8 qa0, qa1, qb0, qb1; float ca, cb; unsigned ma, mb; int rowa, rowb; bool va, vb; };
__device__ __forceinline__ void ph_moba_gather(const Ctx& C) {
    LAS unsigned char* L = (LAS unsigned char*)C.lds;
    LAS unsigned* cnt = (LAS unsigned*)(L + 131072 + 2 * 15872);
    const bf16_t* Q = (const bf16_t*)(C.ws + WS_Q); const bf16_t* K1 = (const bf16_t*)(C.ws + WS_K1); const bf16_t* V1 = (const bf16_t*)(C.ws + WS_V1);
    const unsigned* MM = (const unsigned*)(C.ws + WS_MMASK); const float* CI = (const float*)(C.ws + WS_MCINIT); float* PL = (float*)(C.ws + WS_MPL);
    const int wave = C.wave;
    const int nk = (NB * NH * 32 - C.bid + C.nb - 1) / C.nb;
    if (C.tid < 3) cnt[C.tid] = 0u;
    __syncthreads();
#define MOBA_UNIT(k_, bh_, j_) do { const int u_ = C.bid + (k_) * C.nb, rnd_ = u_ / C.nb, idx_ = (u_ % C.nb) >> 6; bh_ = u_ & 63; j_ = (C.nb == 256) ? 4 * rnd_ + ((rnd_ & 1) ? 3 - idx_ : idx_) : (u_ >> 6); } while (0)
#define MOBA_MASKS(mv_, bh_, j_, tid_) do { const int r0_ = 256 * ((j_) + 1), N_ = SEQ - r0_; const unsigned* mp_ = MM + (size_t)(bh_) * SEQ + r0_; \
        _Pragma("unroll") for (int i_ = 0; i_ < 4; ++i_) { const int i4_ = 4 * (tid_) + 2048 * i_; mv_[i_] = (u32x4){0u, 0u, 0u, 0u}; if (i4_ < N_) mv_[i_] = *(const u32x4*)(mp_ + i4_); } } while (0)
    int bhc = 0, jc = 31; u32x4 mv[4];
    if (nk > 0) { MOBA_UNIT(0, bhc, jc); }
    if (jc < 31) { moba_dma256<true>(L, K1, V1, bhc, jc, wave, C.lane); MOBA_MASKS(mv, bhc, jc, C.tid); }
    int c3 = 0;
    for (int k = 0; k < nk; ++k) {
        int lane = C.lane; asm volatile("" : "+v"(lane));
        const int i16 = lane & 15, fq = lane >> 4, tid = 64 * wave + lane;
        LAS unsigned char* ring = L + (k & 1) * 65536;
        LAS unsigned short* list = (LAS unsigned short*)(L + 131072 + (k & 1) * 15872);
        const int bh = bhc, j = jc, b = bh >> 4, h = bh & 15;
        int bhn = 0, jn = 31;
        if (k + 1 < nk) { MOBA_UNIT(k + 1, bhn, jn); }
        if (j < 31) {
          const int r0 = 256 * (j + 1);
          const unsigned long long lt = (1ull << lane) - 1ull;
#pragma unroll
          for (int i = 0; i < 4; ++i) {
              const bool s0 = (mv[i].x >> j) & 1u, s1 = (mv[i].y >> j) & 1u, s2 = (mv[i].z >> j) & 1u, s3 = (mv[i].w >> j) & 1u;
              const unsigned long long b0 = __ballot(s0), b1 = __ballot(s1), b2 = __ballot(s2), b3 = __ballot(s3);
              const int c0 = __popcll(b0), c1 = __popcll(b1), c2 = __popcll(b2), c3_ = __popcll(b3), tot = c0 + c1 + c2 + c3_;
              if (tot) {
                  unsigned base = 0u;
                  if (lane == 0) base = __hip_atomic_fetch_add(cnt + c3, (unsigned)tot, __ATOMIC_RELAXED, __HIP_MEMORY_SCOPE_WORKGROUP);
                  base = __builtin_amdgcn_readfirstlane(base);
                  const int rb = r0 + 4 * tid + 2048 * i;
                  if (s0) list[base + __popcll(b0 & lt)] = (unsigned short)rb;
                  if (s1) list[base + c0 + __popcll(b1 & lt)] = (unsigned short)(rb + 1);
                  if (s2) list[base + c0 + c1 + __popcll(b2 & lt)] = (unsigned short)(rb + 2);
                  if (s3) list[base + c0 + c1 + c2 + __popcll(b3 & lt)] = (unsigned short)(rb + 3);
              }
          } }
        asm volatile("s_waitcnt vmcnt(0) lgkmcnt(0)\n\ts_barrier" ::: "memory");
        if (tid == 0) cnt[c3 == 0 ? 2 : c3 - 1] = 0u;
        if (jn < 31) { moba_dma256<true>(L + ((k + 1) & 1) * 65536, K1, V1, bhn, jn, wave, lane); MOBA_MASKS(mv, bhn, jn, tid); }
        if (j < 31) {
            const int n = (int)cnt[c3], npair = (n + 31) >> 5;
            const fa::LaneC lc = fa::lane_consts(lane);
#define MOBA_LOAD_PAIR(P_, p_) do { const int ia_ = 32 * (p_) + i16, ib_ = ia_ + 16; P_.va = ia_ < n; P_.vb = ib_ < n; P_.rowa = list[P_.va ? ia_ : 0]; P_.rowb = list[P_.vb ? ib_ : 0]; \
            { const bf16_t* qp_ = Q + (size_t)(b * SEQ + P_.rowa) * DM + h * DH + 8 * fq; P_.qa0 = *(const bf16x8*)qp_; P_.qa1 = *(const bf16x8*)(qp_ + 32); } \
            { const bf16_t* qp_ = Q + (size_t)(b * SEQ + P_.rowb) * DM + h * DH + 8 * fq; P_.qb0 = *(const bf16x8*)qp_; P_.qb1 = *(const bf16x8*)(qp_ + 32); } \
            P_.ca = CI[(size_t)bh * SEQ + P_.rowa]; P_.cb = CI[(size_t)bh * SEQ + P_.rowb]; P_.ma = MM[(size_t)bh * SEQ + P_.rowa]; P_.mb = MM[(size_t)bh * SEQ + P_.rowb]; } while (0)
            MobaPair cur, nxt;
            if (wave < npair) MOBA_LOAD_PAIR(cur, wave);
            for (int p = wave; p < npair; p += NWAVES) {
                if (p + NWAVES < npair) MOBA_LOAD_PAIR(nxt, p + NWAVES);
                fa::Task Ta, Tb;
                fa::task_reset(Ta); fa::task_reset(Tb); Ta.kmin = 0; Ta.kmax = 0x7fffffff; Tb.kmin = 0; Tb.kmax = 0x7fffffff; Ta.imptok = 0; Tb.imptok = 0;
                Ta.q[0] = cur.qa0; Ta.q[1] = cur.qa1; Tb.q[0] = cur.qb0; Tb.q[1] = cur.qb1; Ta.cinit = cur.ca; Tb.cinit = cur.cb;
#pragma unroll
                for (int sb = 0; sb < 4; ++sb) { fa::do_blk<3, true, true>(Ta, Tb, cur.va, cur.vb, false, ring + sb * fa::SLOT, 0, nullptr, lc); if (sb & 1) __builtin_amdgcn_sched_barrier(0); }
                if (cur.va) { const int s = __popc(cur.ma & ((1u << j) - 1u));
                    bf16_t* op = (bf16_t*)(C.ws + moba_po_off(s, b)) + ((size_t)h * SEQ + cur.rowa) * DH + 4 * fq;
#pragma unroll
                    for (int dt = 0; dt < 4; ++dt) *(u32x2*)(op + 16 * dt) = (u32x2){pk2(Ta.O[dt][0], Ta.O[dt][1]), pk2(Ta.O[dt][2], Ta.O[dt][3])};
                    if (fq == 0) PL[((size_t)s * 64 + bh) * SEQ + cur.rowa] = Ta.L[0]; }
                if (cur.vb) { const int s = __popc(cur.mb & ((1u << j) - 1u));
                    bf16_t* op = (bf16_t*)(C.ws + moba_po_off(s, b)) + ((size_t)h * SEQ + cur.rowb) * DH + 4 * fq;
#pragma unroll
                    for (int dt = 0; dt < 4; ++dt) *(u32x2*)(op + 16 * dt) = (u32x2){pk2(Tb.O[dt][0], Tb.O[dt][1]), pk2(Tb.O[dt][2], Tb.O[dt][3])};
                    if (fq == 0) PL[((size_t)s * 64 + bh) * SEQ + cur.rowb] = Tb.L[0]; }
                cur = nxt;
            }
#undef MOBA_LOAD_PAIR
        }
        bhc = bhn; jc = jn; c3 = c3 == 2 ? 0 : c3 + 1;
    }
#undef MOBA_UNIT
#undef MOBA_MASKS
    asm volatile("s_waitcnt vmcnt(0) lgkmcnt(0)\n\ts_barrier" ::: "memory");
}
__device__ __forceinline__ void ph_moba_own(const Ctx& C) {
    LAS unsigned char* L = (LAS unsigned char*)C.lds;
    const bf16_t* Q = (const bf16_t*)(C.ws + WS_Q); const bf16_t* K1 = (const bf16_t*)(C.ws + WS_K1); const bf16_t* V1 = (const bf16_t*)(C.ws + WS_V1);
    const unsigned* MM = (const unsigned*)(C.ws + WS_MMASK); const float* CI = (const float*)(C.ws + WS_MCINIT); const float* PL = (const float*)(C.ws + WS_MPL);
    bf16_t* AO = (bf16_t*)(C.ws + WS_Q);
    const int wave = C.wave;
    const int nk = (NB * NH * 32 - C.bid + C.nb - 1) / C.nb;
    if (nk > 0) moba_dma256<true>(L, K1, V1, C.bid & 63, 31 - (C.bid >> 6), wave, C.lane);
    for (int k = 0; k < nk; ++k) {
        const int u = C.bid + k * C.nb;
        int lane = C.lane; asm volatile("" : "+v"(lane));
        const int i16 = lane & 15, fq = lane >> 4;
        const int bh = u & 63, b = bh >> 4, h = bh & 15, cb = 31 - (u >> 6);
        LAS unsigned char* ring = L + (k & 1) * 65536;
        fa::Task T[2]; int tt[2]; unsigned mk[2];
#pragma unroll
        for (int ti = 0; ti < 2; ++ti) {
            const int R = 32 * wave + 16 * ti + i16; tt[ti] = 256 * cb + R; T[ti].imptok = 0;
            const bf16_t* qp = Q + (size_t)(b * SEQ + tt[ti]) * DM + h * DH + 8 * fq;
            T[ti].q[0] = *(const bf16x8*)qp; T[ti].q[1] = *(const bf16x8*)(qp + 32);
            T[ti].kmin = 0; T[ti].kmax = R; fa::task_reset(T[ti]);
            T[ti].cinit = CI[(size_t)bh * SEQ + tt[ti]]; mk[ti] = MM[(size_t)bh * SEQ + tt[ti]];
        }
        asm volatile("s_waitcnt vmcnt(0) lgkmcnt(0)\n\ts_barrier" ::: "memory");
        if (k + 1 < nk) { const int un = u + C.nb; moba_dma256<true>(L + ((k + 1) & 1) * 65536, K1, V1, un & 63, 31 - (un >> 6), wave, lane); }
        { const fa::LaneC lc = fa::lane_consts(lane);
#pragma unroll
          for (int sb = 0; sb < 4; ++sb) if (64 * sb <= 32 * wave + 31) fa::do_blk<3, true, true>(T[0], T[1], true, true, 64 * sb + 63 > 32 * wave, ring + sb * fa::SLOT, 64 * sb, nullptr, lc); }
#pragma unroll
        for (int ti = 0; ti < 2; ++ti) {
            const int ns = __popc(mk[ti]); float l = fa::task_rowsum(T[ti]);
#pragma unroll
            for (int s = 0; s < 3; ++s) if (s < ns) {
                const bf16_t* pp = (const bf16_t*)(C.ws + moba_po_off(s, b)) + ((size_t)h * SEQ + tt[ti]) * DH + 4 * fq;
#pragma unroll
                for (int dt = 0; dt < 4; ++dt) { const u32x2 w = *(const u32x2*)(pp + 16 * dt); T[ti].O[dt] = T[ti].O[dt] + (f32x4){bflo(w.x), bfhi(w.x), bflo(w.y), bfhi(w.y)}; }
                l += PL[((size_t)s * 64 + bh) * SEQ + tt[ti]];
            }
            const float sc_ = l > 0.f ? 1.0f / l : 0.f;
            bf16_t* op = AO + (size_t)(b * SEQ + tt[ti]) * DM + h * DH + 4 * fq;
#pragma unroll
            for (int dt = 0; dt < 4; ++dt) { const f32x4 o = T[ti].O[dt] * sc_; *(u32x2*)(op + 16 * dt) = (u32x2){pk2(o[0], o[1]), pk2(o[2], o[3])}; }
        }
    }
    asm volatile("s_waitcnt vmcnt(0) lgkmcnt(0)\n\ts_barrier" ::: "memory");
}

struct Route { int e0, s0, e1, s1; float w0, w1; int pad0, pad1; };
__device__ __forceinline__ void ph_ln_route(const Ctx& C, int layer) {
    const float* resid = C.in[I_X]; const bf16_t* residb = (const bf16_t*)(C.ws + WS_XB)  ; const bf16_t* MIX = (const bf16_t*)(C.ws + WS_MIX);
    bf16_t* X1B = (bf16_t*)(C.ws + WS_X1B); Route* RT = (Route*)(C.ws + WS_ROUTE);
    int* rowlist = (int*)(C.ws + WS_ROWLIST); unsigned* cnt = (unsigned*)(C.ws + WS_CTL) + (layer ? CW_CNT1 : CW_CNT0);
    const float* lg = C.in[I_LNG] + (size_t)(layer * 2 + 0) * DM; const float* lb = C.in[I_LNB] + (size_t)(layer * 2 + 0) * DM;
    const float* rw = C.in[I_RW]; const float* rb = C.in[I_RB];
    LAS unsigned* lcnt = (LAS unsigned*)C.lds;
    LAS float* rec = (LAS float*)(C.lds + 256);
    LAS float* lsb = (LAS float*)(C.lds + 4096 + C.wave * 512);
    const int lane = C.lane;
    LAS unsigned char* rwl = (LAS unsigned char*)(C.lds + 8192);
    for (int gi = C.tid; gi < DM * NE / 4; gi += NTHREADS) { const int c = gi >> 2, e4 = gi & 3;
        *(LAS f32x4*)(rwl + (c >> 8) * 17408 + ((c & 255) >> 2) * 272 + (c & 3) * 64 + e4 * 16) = ((const f32x4*)rw)[gi]; }
    __syncthreads();
    for (int chunk = C.bid; chunk < NTOK / 128; chunk += C.nb) {
        if (C.tid < 16) lcnt[C.tid] = 0u;
        __syncthreads();
        for (int i2 = 0; i2 < 8; ++i2) {
            const int rl0 = C.wave * 16 + i2 * 2, row0 = chunk * 128 + rl0;
            f32x4 v[2][4]; float s[2], s2[2];
#pragma unroll
            for (int r = 0; r < 2; ++r) { const f32x4* xr = (const f32x4*)(resid + (size_t)(row0 + r) * DM) + lane; const u32x2* xb = (const u32x2*)(residb + (size_t)(row0 + r) * DM) + lane;
                const u32x2* mr = (const u32x2*)(MIX + (size_t)(row0 + r) * DM) + lane; s[r] = 0.f;
#pragma unroll
                for (int j = 0; j < 4; ++j) { const u32x2 w = mr[64 * j]; f32x4 xv;
                    if (layer) { const u32x2 q = xb[64 * j]; xv = (f32x4){bflo(q.x), bfhi(q.x), bflo(q.y), bfhi(q.y)}; } else xv = xr[64 * j];
                    v[r][j] = xv * DN_ALPHA + (f32x4){bflo(w.x), bfhi(w.x), bflo(w.y), bfhi(w.y)};
                    s[r] += (v[r][j][0] + v[r][j][1]) + (v[r][j][2] + v[r][j][3]); } }
#pragma unroll
            for (int o = 1; o < 64; o <<= 1) { s[0] += __shfl_xor(s[0], o); s[1] += __shfl_xor(s[1], o); }
#pragma unroll
            for (int r = 0; r < 2; ++r) { const float mean = s[r] * (1.f / DM); s2[r] = 0.f;
#pragma unroll
                for (int j = 0; j < 4; ++j) { v[r][j] = v[r][j] - mean; s2[r] += (v[r][j][0] * v[r][j][0] + v[r][j][1] * v[r][j][1]) + (v[r][j][2] * v[r][j][2] + v[r][j][3] * v[r][j][3]); } }
#pragma unroll
            for (int o = 1; o < 64; o <<= 1) { s2[0] += __shfl_xor(s2[0], o); s2[1] += __shfl_xor(s2[1], o); }
            const float rstd0 = 1.f / sqrtf(s2[0] * (1.f / DM) + LN_EPS), rstd1 = 1.f / sqrtf(s2[1] * (1.f / DM) + LN_EPS);
            float p[32];
#pragma unroll
            for (int q = 0; q < 32; ++q) p[q] = 0.f;
#pragma unroll
            for (int j = 0; j < 4; ++j) {
                const int c0 = 4 * lane + 256 * j;
                const f32x4 gg = *(const f32x4*)(lg + c0), bb = *(const f32x4*)(lb + c0);
#pragma unroll
                for (int r = 0; r < 2; ++r) {
                    v[r][j] = v[r][j] * (r ? rstd1 : rstd0) * gg + bb;
                    *(u32x2*)(X1B + (size_t)(row0 + r) * DM + c0) = (u32x2){pk2(v[r][j][0], v[r][j][1]), pk2(v[r][j][2], v[r][j][3])}; }
#pragma unroll
                for (int q = 0; q < 4; ++q) {
                    const LAS f32x4* wr = (const LAS f32x4*)(rwl + j * 17408 + lane * 272 + q * 64);
                    const f32x4 w0 = wr[0], w1 = wr[1], w2 = wr[2], w3 = wr[3];
#pragma unroll
                    for (int r = 0; r < 2; ++r) { const float x = v[r][j][q];
                        p[16 * r + 0] += x * w0[0]; p[16 * r + 1] += x * w0[1]; p[16 * r + 2] += x * w0[2]; p[16 * r + 3] += x * w0[3];
                        p[16 * r + 4] += x * w1[0]; p[16 * r + 5] += x * w1[1]; p[16 * r + 6] += x * w1[2]; p[16 * r + 7] += x * w1[3];
                        p[16 * r + 8] += x * w2[0]; p[16 * r + 9] += x * w2[1]; p[16 * r + 10] += x * w2[2]; p[16 * r + 11] += x * w2[3];
                        p[16 * r + 12] += x * w3[0]; p[16 * r + 13] += x * w3[1]; p[16 * r + 14] += x * w3[2]; p[16 * r + 15] += x * w3[3]; }
                    if (q == 3) asm volatile("" ::: "memory");
                }
            }
#define TRED(N, M) { const bool up = (lane & (M)) != 0; _Pragma("unroll") for (int q = 0; q < (N); ++q) { const float keep = up ? p[q + (N)] : p[q], send = up ? p[q] : p[q + (N)]; p[q] = keep + __shfl_xor(send, (M)); } }
            TRED(16, 32) TRED(8, 16) TRED(4, 8) TRED(2, 4) TRED(1, 2)
#undef TRED
            p[0] += __shfl_xor(p[0], 1);
            const float sc_own = 1.0f / (1.0f + expf(-p[0]));
            if ((lane & 1) == 0) { lsb[lane >> 1] = sc_own; lsb[32 + (lane >> 1)] = sc_own + rb[(lane >> 1) & 15]; }
            WAVE_LDS_SYNC();
            float sc[16], bi[16];
            { const LAS f32x4* a4 = (const LAS f32x4*)(lsb + ((lane >> 5) << 4)); const LAS f32x4* b4 = (const LAS f32x4*)(lsb + 32 + ((lane >> 5) << 4));
#pragma unroll
              for (int q = 0; q < 4; ++q) { const f32x4 x = a4[q], y = b4[q]; sc[4 * q] = x[0]; sc[4 * q + 1] = x[1]; sc[4 * q + 2] = x[2]; sc[4 * q + 3] = x[3]; bi[4 * q] = y[0]; bi[4 * q + 1] = y[1]; bi[4 * q + 2] = y[2]; bi[4 * q + 3] = y[3]; } }
            WAVE_LDS_SYNC();
            int gsel = 0; float gbest = -3e38f;
#pragma unroll
            for (int gq = 0; gq < 4; ++gq) {
                float m1 = -3e38f, m2 = -3e38f;
#pragma unroll
                for (int q = 0; q < 4; ++q) { const float x = bi[4 * gq + q]; if (x > m1) { m2 = m1; m1 = x; } else if (x > m2) m2 = x; }
                const float gs = m1 + m2; if (gs > gbest) { gbest = gs; gsel = gq; }
            }
            int e0 = 0, e1 = 0; float b0 = -3e38f, b1 = -3e38f, w0 = 0.f, w1 = 0.f;
#pragma unroll
            for (int e = 0; e < 16; ++e) {
                if ((e >> 2) == gsel) {
                    const float x = bi[e];
                    if (x > b0) { b1 = b0; e1 = e0; w1 = w0; b0 = x; e0 = e; w0 = sc[e]; }
                    else if (x > b1) { b1 = x; e1 = e; w1 = sc[e]; }
                }
            }
            if ((lane & 31) == 0) {
                const int rl = rl0 + (lane >> 5);
                const float ws_ = w0 + w1;
                const unsigned l0 = __hip_atomic_fetch_add(lcnt + e0, 1u, __ATOMIC_RELAXED, __HIP_MEMORY_SCOPE_WORKGROUP), l1 = __hip_atomic_fetch_add(lcnt + e1, 1u, __ATOMIC_RELAXED, __HIP_MEMORY_SCOPE_WORKGROUP);
                LAS float* r = rec + rl * 6; r[0] = __int_as_float(e0); r[1] = __int_as_float(e1); r[2] = __uint_as_float(l0); r[3] = __uint_as_float(l1); r[4] = w0 / ws_; r[5] = w1 / ws_;
            }
        }
        __syncthreads();
        if (C.tid < 16) lcnt[16 + C.tid] = atomicAdd(cnt + 64 * C.tid, lcnt[C.tid]);
        __syncthreads();
        if (C.tid < 128) {
            const LAS float* r = rec + C.tid * 6; const int row = chunk * 128 + C.tid;
            const int e0 = __float_as_int(r[0]), e1 = __float_as_int(r[1]);
            const int s0 = (int)(lcnt[16 + e0] + __float_as_uint(r[2])), s1 = (int)(lcnt[16 + e1] + __float_as_uint(r[3]));
            rowlist[e0 * NTOK + s0] = row; rowlist[e1 * NTOK + s1] = row;
            Route rr; rr.e0 = e0; rr.s0 = s0; rr.e1 = e1; rr.s1 = s1; rr.w0 = r[4]; rr.w1 = r[5]; rr.pad0 = 0; rr.pad1 = 0;
            RT[row] = rr;
        }
        __syncthreads();
    }
}
__device__ __forceinline__ void ph_combine(const Ctx& C, int layer, float* outp, LAS int* sm) {
    const bf16_t* X1B = (const bf16_t*)(C.ws + WS_X1B); const bf16_t* Y2 = (const bf16_t*)(C.ws + WS_Y2); const Route* RT = (const Route*)(C.ws + WS_ROUTE);
    bf16_t* XB = (bf16_t*)(C.ws + WS_XB);
    const float* lg = C.in[I_LNG] + (size_t)(layer * 2 + 1) * DM; const float* lb = C.in[I_LNB] + (size_t)(layer * 2 + 1) * DM;
    const int gw = C.bid * NWAVES + C.wave, NGW = C.nb * NWAVES, lane = C.lane;
    for (int row = gw; row < NTOK; row += NGW) {
        const Route r = RT[row];
        const bf16_t* y0 = Y2 + (size_t)(sm[16 + r.e0] + r.s0) * DM; const bf16_t* y1 = Y2 + (size_t)(sm[16 + r.e1] + r.s1) * DM;
        const u32x2* xr = (const u32x2*)(X1B + (size_t)row * DM) + lane;
        f32x4 v[4]; float s = 0.f;
#pragma unroll
        for (int j = 0; j < 4; ++j) {
            const int c0 = 4 * lane + 256 * j;
            const u32x2 a = *(const u32x2*)(y0 + c0), b = *(const u32x2*)(y1 + c0), x = xr[64 * j];
            const f32x4 ya = (f32x4){bflo(a.x), bfhi(a.x), bflo(a.y), bfhi(a.y)}, yb = (f32x4){bflo(b.x), bfhi(b.x), bflo(b.y), bfhi(b.y)}, xv = (f32x4){bflo(x.x), bfhi(x.x), bflo(x.y), bfhi(x.y)};
            v[j] = xv * DN_ALPHA + ya * r.w0 + yb * r.w1;
            s += (v[j][0] + v[j][1]) + (v[j][2] + v[j][3]);
        }
        const float mean = wave_sum(s) * (1.f / DM); float s2 = 0.f;
#pragma unroll
        for (int j = 0; j < 4; ++j) { v[j] = v[j] - mean; s2 += (v[j][0] * v[j][0] + v[j][1] * v[j][1]) + (v[j][2] * v[j][2] + v[j][3] * v[j][3]); }
        const float rstd = 1.f / sqrtf(wave_sum(s2) * (1.f / DM) + LN_EPS);
#pragma unroll
        for (int j = 0; j < 4; ++j) {
            const int c0 = 4 * lane + 256 * j;
            const f32x4 gg = *(const f32x4*)(lg + c0), bb = *(const f32x4*)(lb + c0);
            v[j] = v[j] * rstd * gg + bb;
            if (layer) *(f32x4*)(outp + (size_t)row * DM + c0) = v[j];
            else *(u32x2*)(XB + (size_t)row * DM + c0) = (u32x2){pk2(v[j][0], v[j][1]), pk2(v[j][2], v[j][3])};
        }
    }
}

__device__ __forceinline__ void ph_kmean(const Ctx& C) {
    const bf16_t* K1 = (const bf16_t*)(C.ws + WS_K1); float* KM = (float*)(C.ws + WS_KMEAN);
    const int gw = C.bid * NWAVES + C.wave, NGW = C.nb * NWAVES, lane = C.lane;
    for (int it = gw; it < NB * NH * 32; it += NGW) {
        const bf16_t* p = K1 + (size_t)it * 256 * DH + lane; float s = 0.f;
#pragma unroll 8
        for (int j = 0; j < 256; ++j) s += bf2f(p[j * DH]);
        KM[(size_t)it * DH + lane] = s * (1.0f / 256.0f);
    }
}
constexpr int NPHASE = 21;
__global__ void __launch_bounds__(NTHREADS, 2) fwd(Args args) {
    extern __shared__ __attribute__((aligned(16))) unsigned char lds[];
    Ctx C;
#pragma unroll
    for (int i = 0; i < 18; ++i) C.in[i] = args.in[i];
    C.out = args.out; C.ws = args.ws; C.lds = lds;
    C.tid = threadIdx.x; C.lane = C.tid & 63; C.wave = __builtin_amdgcn_readfirstlane(C.tid >> 6); C.bid = blockIdx.x; C.nb = gridDim.x;
    LAS unsigned* misc = (LAS unsigned*)(lds + LDS_BYTES - 512);
    LAS int* sm = (LAS int*)(misc + 16);
    if (C.tid < 4) misc[C.tid] = 0u;
    __syncthreads();
#if MK_SINGLE
    XcdBarrier bar = xcd_barrier_post((unsigned*)(C.ws + WS_CTL) + CW_BAR, (volatile LAS unsigned*)misc);
#define SEAM() xcd_barrier(bar)
#else
#define SEAM() do {} while (0)
#endif
    const int lo = args.ph_lo, hi = args.ph_hi;
#ifndef PH_MASK
#define PH_MASK 0xFFFFFFFFu
#endif
#define IN(k) (((PH_MASK >> (k)) & 1u) && lo <= (k) && (k) < hi)
#define BOTH(k) (IN(k) && IN((k) + 1))
    unsigned char* ws = C.ws;
    const float2* rope = (const float2*)(ws + WS_ROPE);
    LAS unsigned char* L = (LAS unsigned char*)lds;

    if (IN(0)) { ph_prologue(C); if (BOTH(0)) SEAM(); }
    if (IN(1)) {
        EpiNsaIn E{(bf16_t*)(ws + WS_Q), (bf16_t*)(ws + WS_KV0), (float*)(ws + WS_GATES), rope};
        g8::StaticOrder S; S.init(NTOK / 256, 2560 / 256, C.nb, C.bid);
        g8::gemm8<false>(L, (const bf16_t*)(ws + WS_XB), DM, (const bf16_t*)(ws + WS_WT_NSA_IN), DM, S, g8::EpiEl<EpiNsaIn>{E}, g8::GatherInfo{nullptr, sm});
        if (BOTH(1)) SEAM();
    }
    if (IN(2)) {
        EpiCmp EK{(const float*)(ws + WS_BIAS1), (const bf16_t*)(ws + WS_W2T), rope, (bf16_t*)(ws + WS_KC)}, EV{(const float*)(ws + WS_BIAS1) + 256, (const bf16_t*)(ws + WS_W2T) + 64 * 256, nullptr, (bf16_t*)(ws + WS_VC)};
        g8::StaticOrder SK, SV; SK.init(32, 1, C.nb, C.bid); SV.init(32, 1, C.nb, (C.bid + C.nb / 2) % C.nb);
        g8::gemm8<false>(L, (const bf16_t*)(ws + WS_KV0), 1024, (const bf16_t*)(ws + WS_WT_C1K), 2048, SK, EK, g8::GatherInfo{nullptr, sm});
        g8::gemm8<false>(L, (const bf16_t*)(ws + WS_KV0 + KVSEG), 1024, (const bf16_t*)(ws + WS_WT_C1V), 2048, SV, EV, g8::GatherInfo{nullptr, sm});
        if (C.nb == 256 && !((C.bid < 32) || (C.bid >= 128 && C.bid < 160))) {
            EpiNsaIn E{(bf16_t*)(ws + WS_Q), (bf16_t*)(ws + WS_KV0), (float*)(ws + WS_GATES), rope};
            const int gidx = C.bid < 128 ? C.bid - 32 : C.bid - 64, fr = C.lane & 15, fq = C.lane >> 4;
            for (int tile = gidx * NWAVES + C.wave; tile < 2048; tile += 192 * NWAVES) {
                const int row0 = (tile >> 1) * 32, col0 = 2560 + (tile & 1) * 32;
                const bf16_t* a0 = (const bf16_t*)(ws + WS_XB) + (size_t)(row0 + fr) * DM + fq * 8; const bf16_t* a1 = a0 + (size_t)16 * DM;
                const bf16_t* b0 = (const bf16_t*)(ws + WS_WT_NSA_IN) + (size_t)(col0 + fr) * DM + fq * 8; const bf16_t* b1 = b0 + (size_t)16 * DM;
                f32x4 acc[2][2]; mma_core(a0, a1, b0, b1, DM, acc);
#pragma unroll
                for (int mi = 0; mi < 2; ++mi)
#pragma unroll
                    for (int ni = 0; ni < 2; ++ni) E(row0 + 16 * mi + fr, col0 + 16 * ni + 4 * fq, acc[mi][ni]);
            }
        } else if (C.nb != 256) {
            EpiNsaIn E{(bf16_t*)(ws + WS_Q), (bf16_t*)(ws + WS_KV0), (float*)(ws + WS_GATES), rope};
            const int fr = C.lane & 15, fq = C.lane >> 4;
            for (int tile = C.bid * NWAVES + C.wave; tile < 2048; tile += C.nb * NWAVES) {
                const int row0 = (tile >> 1) * 32, col0 = 2560 + (tile & 1) * 32;
                const bf16_t* a0 = (const bf16_t*)(ws + WS_XB) + (size_t)(row0 + fr) * DM + fq * 8; const bf16_t* a1 = a0 + (size_t)16 * DM;
                const bf16_t* b0 = (const bf16_t*)(ws + WS_WT_NSA_IN) + (size_t)(col0 + fr) * DM + fq * 8; const bf16_t* b1 = b0 + (size_t)16 * DM;
                f32x4 acc[2][2]; mma_core(a0, a1, b0, b1, DM, acc);
#pragma unroll
                for (int mi = 0; mi < 2; ++mi)
#pragma unroll
                    for (int ni = 0; ni < 2; ++ni) E(row0 + 16 * mi + fr, col0 + 16 * ni + 4 * fq, acc[mi][ni]);
            }
        }
        if (BOTH(2)) SEAM();
    }
    if (IN(4)) { ph_nsa_fa(C); if (BOTH(4)) SEAM(); }
    if (IN(6)) {
        EpiBf16 E{(bf16_t*)(ws + WS_MIX)};
        g8::StaticOrder S; S.init(NTOK / 256, DM / 256, C.nb, C.bid);
        g8::gemm8<false>(L, (const bf16_t*)(ws + WS_Q), DM, (const bf16_t*)(ws + WS_WT_NSA_OUT), DM, S, g8::EpiEl<EpiBf16>{E}, g8::GatherInfo{nullptr, sm});
        if (BOTH(6)) SEAM();
    }
    if (IN(7)) { ph_ln_route(C, 0); if (BOTH(7)) SEAM(); }
    if (IN(8)) {
        load_expert_map(C, CW_CNT0, sm);
        EpiSwiGLU E{(bf16_t*)(ws + WS_HBUF)};
        g8::GroupedOrder S; S.init(sm, 4, C.nb, C.bid);
        g8::gemm8<true>(L, (const bf16_t*)(ws + WS_X1B), DM, (const bf16_t*)(ws + WS_WT_GU), 1024, S, g8::EpiEl<EpiSwiGLU>{E}, g8::GatherInfo{(const int*)(ws + WS_ROWLIST), sm});
        if (BOTH(8)) SEAM();
    }
    if (IN(9)) {
        load_expert_map(C, CW_CNT0, sm);
        EpiBf16 E{(bf16_t*)(ws + WS_Y2)};
        g8::GroupedOrder S; S.init(sm, 4, C.nb, C.bid);
        g8::gemm8<false>(L, (const bf16_t*)(ws + WS_HBUF), DE, (const bf16_t*)(ws + WS_WT_DN), DE, S, g8::EpiEl<EpiBf16>{E}, g8::GatherInfo{nullptr, sm});
        if (BOTH(9)) SEAM();
    }
    if (IN(10)) {
        load_expert_map(C, CW_CNT0, sm);
        ph_combine(C, 0, (float*)(ws + WS_XR), sm);
        if (BOTH(10)) SEAM();
    }
    if (IN(11)) {
        EpiMobaIn E{(bf16_t*)(ws + WS_Q), (bf16_t*)(ws + WS_K1), (bf16_t*)(ws + WS_V1), rope};
        g8::StaticOrder S; S.init(NTOK / 256, 3072 / 256, C.nb, C.bid);
        g8::gemm8<false>(L, (const bf16_t*)(ws + WS_XB), DM, (const bf16_t*)(ws + WS_WT_MOBA_IN), DM, S, g8::EpiEl<EpiMobaIn>{E}, g8::GatherInfo{nullptr, sm});
        if (BOTH(11)) SEAM();
    }
    if (IN(12)) { ph_kmean(C); if (BOTH(12)) SEAM(); }
    if (IN(13)) { ph_moba_sel(C); if (BOTH(13)) SEAM(); }
    if (IN(14)) { ph_moba_gather(C); if (BOTH(14)) SEAM(); }
    if (IN(15)) { ph_moba_own(C); if (BOTH(15)) SEAM(); }
    if (IN(16)) {
        EpiBf16 E{(bf16_t*)(ws + WS_MIX)};
        g8::StaticOrder S; S.init(NTOK / 256, DM / 256, C.nb, C.bid);
        g8::gemm8<false>(L, (const bf16_t*)(ws + WS_Q), DM, (const bf16_t*)(ws + WS_WT_MOBA_OUT), DM, S, g8::EpiEl<EpiBf16>{E}, g8::GatherInfo{nullptr, sm});
        if (BOTH(16)) SEAM();
    }
    if (IN(17)) {
        ph_ln_route(C, 1);
        __syncthreads();
        { float* scr = (float*)(C.lds + C.wave * 9216); const int gw = C.bid * NWAVES + C.wave, NGW = C.nb * NWAVES;
          for (int it = gw; it < MOE_W_ITEMS; it += NGW) moe_weight_item(C, 1, it, scr); }
        if (BOTH(17)) SEAM();
    }
    if (IN(18)) {
        load_expert_map(C, CW_CNT1, sm);
        EpiSwiGLU E{(bf16_t*)(ws + WS_HBUF)};
        g8::GroupedOrder S; S.init(sm, 4, C.nb, C.bid);
        g8::gemm8<true>(L, (const bf16_t*)(ws + WS_X1B), DM, (const bf16_t*)(ws + WS_WT_GU), 1024, S, g8::EpiEl<EpiSwiGLU>{E}, g8::GatherInfo{(const int*)(ws + WS_ROWLIST), sm});
        if (BOTH(18)) SEAM();
    }
    if (IN(19)) {
        load_expert_map(C, CW_CNT1, sm);
        EpiBf16 E{(bf16_t*)(ws + WS_Y2)};
        g8::GroupedOrder S; S.init(sm, 4, C.nb, C.bid);
        g8::gemm8<false>(L, (const bf16_t*)(ws + WS_HBUF), DE, (const bf16_t*)(ws + WS_WT_DN), DE, S, g8::EpiEl<EpiBf16>{E}, g8::GatherInfo{nullptr, sm});
        if (BOTH(19)) SEAM();
    }
    if (IN(20)) {
        load_expert_map(C, CW_CNT1, sm);
        ph_combine(C, 1, C.out, sm);
    }
#undef IN
#undef BOTH
}

extern "C" void kernel_launch(void* const* d_in, const int* in_sizes, int n_in, void* d_out, int out_size, void* d_ws, size_t ws_size, hipStream_t stream) {
    static int grid = 0;
    if (grid == 0) {
        if (n_in != 18 || in_sizes[0] != NTOK * DM || out_size != NTOK * DM || ws_size < WS_END) {
            fprintf(stderr, "kernel_launch: unexpected shapes (n_in %d, in0 %d, out %d, ws %zu; need ws >= %zu); nothing launched\n", n_in, n_in > 0 ? in_sizes[0] : -1, out_size, ws_size, (size_t)WS_END);
            grid = -1; return;
        }
        int dev = 0, cus = 0, per_cu = 0;
        if (hipGetDevice(&dev) != hipSuccess || hipDeviceGetAttribute(&cus, hipDeviceAttributeMultiprocessorCount, dev) != hipSuccess) { grid = -1; return; }
        if (hipFuncSetAttribute((const void*)fwd, hipFuncAttributeMaxDynamicSharedMemorySize, LDS_BYTES) != hipSuccess) { fprintf(stderr, "kernel_launch: hipFuncSetAttribute failed\n"); grid = -1; return; }
        if (hipOccupancyMaxActiveBlocksPerMultiprocessor(&per_cu, (const void*)fwd, NTHREADS, LDS_BYTES) != hipSuccess || per_cu < 1)
            fprintf(stderr, "kernel_launch: occupancy query reports %d blocks per CU\n", per_cu);
        (void)hipGetLastError();
        grid = cus;
        if (grid != 256) { fprintf(stderr, "kernel_launch: built for a 256-CU device (got %d CUs); nothing launched\n", cus); grid = -1; return; }
    }
    if (grid < 0) return;
    if (hipMemsetAsync((char*)d_ws + WS_CTL, 0, CTL_BYTES, stream) != hipSuccess) { fprintf(stderr, "kernel_launch: memset failed\n"); return; }
    Args a{};
    for (int i = 0; i < 18; ++i) a.in[i] = (const float*)d_in[i];
    a.out = (float*)d_out; a.ws = (unsigned char*)d_ws;
#if defined(PROBE_PH)
    { const int lo3[3] = {0, PROBE_PH, PROBE_PH + 1}, hi3[3] = {PROBE_PH + 1, PROBE_PH + 1, NPHASE};
      for (int q = 0; q < 3; ++q) { if (lo3[q] >= hi3[q]) continue;
          if (q) (void)hipMemsetAsync((char*)d_ws + WS_CTL + CW_BAR * 4, 0, XCD_BAR_WORDS * 4, stream);
          a.ph_lo = lo3[q]; a.ph_hi = hi3[q]; hipLaunchKernelGGL(fwd, dim3(grid), dim3(NTHREADS), LDS_BYTES, stream, a); } }
#elif MK_SINGLE
    a.ph_lo = 0; a.ph_hi = NPHASE;
    hipLaunchKernelGGL(fwd, dim3(grid), dim3(NTHREADS), LDS_BYTES, stream, a);
#else
    for (int p = 0; p < NPHASE; ++p) { a.ph_lo = p; a.ph_hi = p + 1; hipLaunchKernelGGL(fwd, dim3(grid), dim3(NTHREADS), LDS_BYTES, stream, a); }
#endif
    const hipError_t le = hipPeekAtLastError();
    if (le != hipSuccess) fprintf(stderr, "kernel_launch: launch failed: %s\n", hipGetErrorName(le));
}
```

```cpp
#include <hip/hip_runtime.h>
#include <cstdio>
#include <cstdint>

#ifndef SEL_FUSED
#define SEL_FUSED 1
#endif
#ifndef MK_SINGLE
#define MK_SINGLE 1
#endif

#define LAS __attribute__((address_space(3)))
typedef unsigned short bf16_t;
typedef short bf16x8 __attribute__((ext_vector_type(8)));
typedef float f32x4 __attribute__((ext_vector_type(4)));
typedef unsigned u32x4 __attribute__((ext_vector_type(4)));
typedef unsigned u32x2 __attribute__((ext_vector_type(2)));

constexpr int NB = 4, SEQ = 8192, NTOK = NB * SEQ, DM = 1024, NH = 16, DH = 64, NG = 4;
constexpr int NSA_IN = 2608, NSA_INP = 2816;
constexpr int NE = 16, DE = 512;
constexpr float DN_ALPHA = 1.4142135623730951f;
constexpr float LN_EPS = 1e-5f;
constexpr int NWAVES = 8, NTHREADS = 512;
constexpr float QSCALE = 0.125f * 1.4426950408889634f;
constexpr int LDS_BYTES = 163840;
constexpr int ROWCAP = 2 * NTOK + NE * 256;

constexpr size_t MiB = 1u << 20;
constexpr size_t WS_CTL = 0, CTL_BYTES = 1 * MiB;
constexpr size_t WS_ROPE = 1 * MiB;
constexpr size_t WS_BIAS1 = 3 * MiB;
constexpr size_t WS_W2T = 3 * MiB + 4096;
constexpr size_t WS_KMEAN = 4 * MiB;
constexpr size_t WS_KB2 = 4 * MiB + 512 * 1024;
constexpr size_t WS_ROUTE = 5 * MiB;
constexpr size_t WS_ROWLIST = 6 * MiB;
constexpr size_t WS_SEL = 8 * MiB;
constexpr size_t WS_GATES = 10 * MiB;
constexpr size_t WS_KC = 25 * MiB, WS_VC = 26 * MiB;
constexpr size_t WS_WT_NSA_IN = 27 * MiB;
constexpr size_t WS_WT_NSA_OUT = 33 * MiB;
constexpr size_t WS_WT_C1K = 35 * MiB, WS_WT_C1V = 36 * MiB;
constexpr size_t WS_WT_MOBA_IN = 37 * MiB;
constexpr size_t WS_WT_MOBA_OUT = 43 * MiB;
constexpr size_t WS_WT_GU = 45 * MiB;
constexpr size_t WS_WT_DN = 77 * MiB;
constexpr size_t WS_XB = 93 * MiB;
constexpr size_t WS_ATTN = 161 * MiB;
constexpr size_t WS_Q = WS_ATTN;
constexpr size_t WS_KV0 = WS_ATTN + 64 * MiB;
constexpr size_t KVSEG = 16 * MiB;
constexpr size_t WS_K1 = WS_ATTN + 64 * MiB, WS_V1 = WS_ATTN + 128 * MiB;
constexpr size_t WS_X1B = 353 * MiB;
constexpr size_t WS_MIX = WS_ATTN + 64 * MiB;
constexpr size_t WS_Y2 = WS_ATTN;
constexpr size_t WS_HBUF = WS_XB;
constexpr size_t WS_XR = 353 * MiB;
constexpr size_t WS_END = 481 * MiB;
static_assert((size_t)ROWCAP * 512 * 2 <= 68 * MiB && (size_t)ROWCAP * 1024 * 2 <= 192 * MiB, "overlay sizes");

constexpr int CW_TMO = 0;
constexpr int CW_CNT0 = 1024, CW_CNT1 = 2048;
constexpr int CW_BAR = 8192;

__device__ __forceinline__ unsigned f2bf(float f) { unsigned u = __float_as_uint(f); return (u + 0x7fffu + ((u >> 16) & 1u)) >> 16; }
typedef float f32x2v __attribute__((ext_vector_type(2)));
typedef __bf16 bf16x2v __attribute__((ext_vector_type(2)));
__device__ __forceinline__ unsigned pk2(float lo, float hi) { const f32x2v v = {lo, hi}; const bf16x2v b = __builtin_convertvector(v, bf16x2v); return __builtin_bit_cast(unsigned, b); }
__device__ __forceinline__ float bflo(unsigned u) { return __uint_as_float(u << 16); }
__device__ __forceinline__ float bfhi(unsigned u) { return __uint_as_float(u & 0xffff0000u); }
__device__ __forceinline__ float bf2f(bf16_t b) { return __uint_as_float((unsigned)b << 16); }
__device__ __forceinline__ float wave_sum(float v) {
#pragma unroll
    for (int o = 1; o < 64; o <<= 1) v += __shfl_xor(v, o);
    return v;
}
__device__ __forceinline__ float wave_max(float v) {
#pragma unroll
    for (int o = 1; o < 64; o <<= 1) v = fmaxf(v, __shfl_xor(v, o));
    return v;
}
#define WAVE_LDS_SYNC() asm volatile("s_waitcnt lgkmcnt(0)" ::: "memory")
__device__ __forceinline__ float sigmoidf_(float x) { return 1.0f / (1.0f + __expf(-x)); }
__device__ __forceinline__ float gelu_tanh(float x) {
    const float u = 0.7978845608028654f * (x + 0.044715f * x * x * x);
    const float t = 1.0f - 2.0f / (__expf(2.0f * u) + 1.0f);
    return 0.5f * x * (1.0f + t);
}

#define XB_TMO      128
#define XB_XCNT(j)  (256  + 64 * (j))
#define XB_XSUB(j)  (1280 + 64 * (j))
#define XB_XGEN(j)  (2304 + 64 * (j))
#define XB_TOP      3328
#define XB_TOPGEN   3392
#define XCD_BAR_WORDS 3456
#define XB_SPIN_CAP (1u << 22)
__device__ __forceinline__ unsigned xb_ld(unsigned* p)              { return __hip_atomic_load(p, __ATOMIC_RELAXED, __HIP_MEMORY_SCOPE_AGENT); }
__device__ __forceinline__ unsigned xb_add(unsigned* p, unsigned v) { return __hip_atomic_fetch_add(p, v, __ATOMIC_RELAXED, __HIP_MEMORY_SCOPE_AGENT); }
__device__ __forceinline__ unsigned xb_xcc_id() { return (unsigned)__builtin_amdgcn_s_getreg((3 << 11) | 20) & 0xFu; }
#define XB_SPIN(cond, bar) do { unsigned _sp = 0; while (cond) { __builtin_amdgcn_s_sleep(1); \
    if ((++_sp & 255u) == 0u) { if (xb_ld(&(bar)[XB_TMO])) break; if (_sp > XB_SPIN_CAP) { atomicAdd(&(bar)[XB_TMO], 1u); break; } } } } while (0)
struct XcdBarrier { unsigned* bar; unsigned x; volatile LAS unsigned* st; };
__device__ __forceinline__ XcdBarrier xcd_barrier_post(unsigned* bar, volatile LAS unsigned* st) {
    XcdBarrier b; b.bar = bar; b.x = xb_xcc_id(); b.st = st;
    if (threadIdx.x == 0) (void)xb_add(&bar[XB_XCNT(b.x)], 1u);
    return b;
}
__device__ __forceinline__ void xcd_barrier_complete(unsigned* bar, unsigned x, unsigned& nloc, unsigned& nx) {
    const unsigned G = gridDim.x * gridDim.y * gridDim.z;
    unsigned sum, cnt, mine, sp = 0u;
    for (;;) {
        sum = 0u; cnt = 0u; mine = 0u;
#pragma unroll
        for (unsigned j = 0; j < 16; ++j) { const unsigned c = xb_ld(&bar[XB_XCNT(j)]); sum += c; cnt += (c > 0u) ? 1u : 0u; mine = (j == x) ? c : mine; }
        if (sum == G) break;
        __builtin_amdgcn_s_sleep(1);
        if ((++sp & 255u) == 0u) { if (xb_ld(&bar[XB_TMO])) break; if (sp > XB_SPIN_CAP) { atomicAdd(&bar[XB_TMO], 1u); break; } }
    }
    nloc = mine > 0u ? mine : 1u; nx = cnt > 0u ? cnt : 1u;
}
__device__ __forceinline__ void xcd_barrier(const XcdBarrier& b) {
    asm volatile("s_waitcnt vmcnt(0)" ::: "memory");
    __syncthreads();
    if (threadIdx.x == 0) {
        unsigned* bar = b.bar;
        __builtin_amdgcn_s_waitcnt(0);
        unsigned nloc = b.st[0], nx = b.st[1];
        if (nloc == 0u) { xcd_barrier_complete(bar, b.x, nloc, nx); b.st[0] = nloc; b.st[1] = nx; }
        const unsigned old = xb_add(&bar[XB_XSUB(b.x)], 1u);
        const unsigned gen = old / nloc;
        if (old + 1u == (gen + 1u) * nloc) {
            __builtin_amdgcn_fence(__ATOMIC_RELEASE, "agent");
            asm volatile("s_waitcnt vmcnt(0)" ::: "memory");
            const unsigned og = xb_add(&bar[XB_TOP], 1u);
            const unsigned tg = og / nx;
            if (og + 1u == (tg + 1u) * nx) xb_add(&bar[XB_TOPGEN], 1u);
            else XB_SPIN(xb_ld(&bar[XB_TOPGEN]) == tg, bar);
            __builtin_amdgcn_fence(__ATOMIC_ACQUIRE, "agent");
            xb_add(&bar[XB_XGEN(b.x)], 1u);
            asm volatile("s_waitcnt vmcnt(0)" ::: "memory");
        } else {
            XB_SPIN(xb_ld(&bar[XB_XGEN(b.x)]) == gen, bar);
            __builtin_amdgcn_fence(__ATOMIC_ACQUIRE, "agent");
            asm volatile("s_waitcnt vmcnt(0)" ::: "memory");
        }
    }
    __syncthreads();
}

struct Args { const float* in[18]; float* out; unsigned char* ws; int ph_lo, ph_hi; };
struct Ctx {
    const float* in[18]; float* out; unsigned char* ws; unsigned char* lds;
    int tid, lane, wave, bid, nb;
};
enum { I_X = 0, I_NSA_WIN, I_NSA_WOUT, I_CK_W1, I_CK_W2, I_CV_W1, I_CV_W2, I_CK_POS, I_CV_POS, I_MOBA_WIN, I_MOBA_WOUT, I_RW, I_RB, I_WG, I_WU, I_WD, I_LNG, I_LNB };

__device__ __forceinline__ int il64(int d) { return d < 32 ? 2 * d : 2 * (d - 32) + 1; }
__device__ __forceinline__ int rowmap(int kind, int n) {
    switch (kind) {
        case 1: { const bool r = (n < 1024) || (n >= 1536 && n < 1792) || (n >= 2048 && n < 2304); return r ? (n & ~63) + il64(n & 63) : n; }
        case 2: return n < 2048 ? (n & ~63) + il64(n & 63) : n;
        case 3: return 2 * n;
        case 4: return 2 * n + 1;
        default: return n;
    }
}
__device__ __forceinline__ void transpose_item(const float* W, int ldw, int ncols, bf16_t* WT, int K, int kb, int nbk, int kind, float* scr, int lane) {
    const int k0 = 64 * kb, n0 = 32 * nbk;
    const int cq = lane & 7, nn = n0 + 4 * cq;
#pragma unroll
    for (int i = 0; i < 8; ++i) { const int kk = 8 * i + (lane >> 3);
        *(f32x4*)(scr + kk * 36 + 4 * cq) = nn < ncols ? *(const f32x4*)(W + (size_t)(k0 + kk) * ldw + nn) : (f32x4){0.f, 0.f, 0.f, 0.f}; }
    WAVE_LDS_SYNC();
    const int c = lane & 7;
#pragma unroll
    for (int j = 0; j < 4; ++j) {
        const int n = (lane >> 3) + 8 * j; const float* s = scr + (8 * c) * 36 + n;
        u32x4 o; o.x = pk2(s[0 * 36], s[1 * 36]); o.y = pk2(s[2 * 36], s[3 * 36]); o.z = pk2(s[4 * 36], s[5 * 36]); o.w = pk2(s[6 * 36], s[7 * 36]);
        *(u32x4*)(WT + (size_t)rowmap(kind, n0 + n) * K + k0 + 8 * c) = o;
    }
    WAVE_LDS_SYNC();
}
constexpr int MOE_W_ITEMS = NE * 768;
__device__ __forceinline__ void moe_weight_item(const Ctx& C, int layer, int r, float* scr) {
    const int e = r / 768; int q = r % 768;
    bf16_t* gu = (bf16_t*)(C.ws + WS_WT_GU) + (size_t)e * 1024 * 1024;
    bf16_t* dn = (bf16_t*)(C.ws + WS_WT_DN) + (size_t)e * 1024 * 512;
    const size_t eo = (size_t)(layer * NE + e);
    if (q < 256) { transpose_item(C.in[I_WG] + eo * DM * DE, DE, DE, gu, DM, q / 16, q % 16, 3, scr, C.lane); return; } q -= 256;
    if (q < 256) { transpose_item(C.in[I_WU] + eo * DM * DE, DE, DE, gu, DM, q / 16, q % 16, 4, scr, C.lane); return; } q -= 256;
    transpose_item(C.in[I_WD] + eo * DE * DM, DM, DM, dn, DE, q / 32, q % 32, 0, scr, C.lane);
}

__device__ __forceinline__ void ph_prologue(const Ctx& C) {
    float* scr = (float*)(C.lds + C.wave * 9216);
    const int gw = C.bid * NWAVES + C.wave, NGW = C.nb * NWAVES;
    constexpr int I_A = 16 * 82, I_B = 16 * 32, I_C = 32 * 8, I_D = 16 * 96, I_E = 16 * 32;
    constexpr int NIT = I_A + I_B + 2 * I_C + I_D + I_E + MOE_W_ITEMS;
    for (int it = gw; it < NIT; it += NGW) {
        int r = it;
        if (r < I_A) { transpose_item(C.in[I_NSA_WIN], NSA_IN, NSA_IN, (bf16_t*)(C.ws + WS_WT_NSA_IN), DM, r / 82, r % 82, 1, scr, C.lane); continue; } r -= I_A;
        if (r < I_B) { transpose_item(C.in[I_NSA_WOUT], DM, DM, (bf16_t*)(C.ws + WS_WT_NSA_OUT), DM, r / 32, r % 32, 0, scr, C.lane); continue; } r -= I_B;
        if (r < I_C) { transpose_item(C.in[I_CK_W1], 256, 256, (bf16_t*)(C.ws + WS_WT_C1K), 2048, r / 8, r % 8, 0, scr, C.lane); continue; } r -= I_C;
        if (r < I_C) { transpose_item(C.in[I_CV_W1], 256, 256, (bf16_t*)(C.ws + WS_WT_C1V), 2048, r / 8, r % 8, 0, scr, C.lane); continue; } r -= I_C;
        if (r < I_D) { transpose_item(C.in[I_MOBA_WIN], 3072, 3072, (bf16_t*)(C.ws + WS_WT_MOBA_IN), DM, r / 96, r % 96, 2, scr, C.lane); continue; } r -= I_D;
        if (r < I_E) { transpose_item(C.in[I_MOBA_WOUT], DM, DM, (bf16_t*)(C.ws + WS_WT_MOBA_OUT), DM, r / 32, r % 32, 0, scr, C.lane); continue; } r -= I_E;
        moe_weight_item(C, 0, r, scr);
    }
    const int gt = C.bid * NTHREADS + C.tid, NGT = C.nb * NTHREADS;
    { u32x4* p = (u32x4*)((bf16_t*)(C.ws + WS_WT_NSA_IN) + (size_t)2624 * DM); const int n = (NSA_INP - 2624) * DM / 8;
      for (int i = gt; i < n; i += NGT) p[i] = (u32x4){0u, 0u, 0u, 0u}; }
    { const f32x4* x4 = (const f32x4*)C.in[I_X]; u32x4* o = (u32x4*)(C.ws + WS_XB); const int n = NTOK * DM / 8;
      for (int i = gt; i < n; i += NGT) { const f32x4 a = x4[2 * i], b = x4[2 * i + 1]; o[i] = (u32x4){pk2(a.x, a.y), pk2(a.z, a.w), pk2(b.x, b.y), pk2(b.z, b.w)}; } }
    { const float INV[32] = {1.000000000e+00f, 7.498942018e-01f, 5.623413324e-01f, 4.216965139e-01f, 3.162277639e-01f, 2.371373922e-01f, 1.778279394e-01f, 1.333521456e-01f,
                             1.000000015e-01f, 7.498941571e-02f, 5.623412877e-02f, 4.216964915e-02f, 3.162277862e-02f, 2.371373586e-02f, 1.778279431e-02f, 1.333521493e-02f,
                             9.999999776e-03f, 7.498942316e-03f, 5.623413250e-03f, 4.216964822e-03f, 3.162277862e-03f, 2.371373819e-03f, 1.778279431e-03f, 1.333521446e-03f,
                             1.000000047e-03f, 7.498941850e-04f, 5.623413017e-04f, 4.216965463e-04f, 3.162277862e-04f, 2.371373848e-04f, 1.778279402e-04f, 1.333521504e-04f};
      float2* tab = (float2*)(C.ws + WS_ROPE);
      for (int i = gt; i < SEQ * 32; i += NGT) {
          const int t = i >> 5, f = i & 31;
          float inv = INV[0];
#pragma unroll
          for (int q = 1; q < 32; ++q) inv = (f == q) ? INV[q] : inv;
          const float ang = (float)t * inv;
          const double a = (double)ang; const double k = __builtin_rint(a * 0.15915494309189535); const float rf = (float)(a - k * 6.283185307179586);
          tab[i] = make_float2(__cosf(rf), __sinf(rf));
      } }
    for (int i = gt; i < 2 * 64 * 256; i += NGT) { const int which = i >> 14, d = (i >> 8) & 63, c = i & 255;
        ((bf16_t*)(C.ws + WS_W2T))[i] = (bf16_t)f2bf(C.in[which ? I_CV_W2 : I_CK_W2][c * 64 + d]); }
    for (int o = gw; o < 512; o += NGW) {
        const int which = o >> 8, c = o & 255;
        const float* pos = C.in[which ? I_CV_POS : I_CK_POS]; const float* w1 = C.in[which ? I_CV_W1 : I_CK_W1];
        float s = 0.f;
        for (int k = C.lane; k < 2048; k += 64) s += pos[k] * w1[(size_t)k * 256 + c];
        s = wave_sum(s);
        if (C.lane == 0) ((float*)(C.ws + WS_BIAS1))[o] = s;
    }
}

__device__ __forceinline__ void mma_core(const bf16_t* a0, const bf16_t* a1, const bf16_t* b0, const bf16_t* b1, int K, f32x4 (&acc)[2][2]) {
#pragma unroll
    for (int i = 0; i < 2; ++i)
#pragma unroll
        for (int j = 0; j < 2; ++j) acc[i][j] = (f32x4){0.f, 0.f, 0.f, 0.f};
#pragma unroll 4
    for (int k = 0; k < K; k += 32) {
        const bf16x8 A0 = *(const bf16x8*)(a0 + k), A1 = *(const bf16x8*)(a1 + k), B0 = *(const bf16x8*)(b0 + k), B1 = *(const bf16x8*)(b1 + k);
        acc[0][0] = __builtin_amdgcn_mfma_f32_16x16x32_bf16(B0, A0, acc[0][0], 0, 0, 0);
        acc[0][1] = __builtin_amdgcn_mfma_f32_16x16x32_bf16(B1, A0, acc[0][1], 0, 0, 0);
        acc[1][0] = __builtin_amdgcn_mfma_f32_16x16x32_bf16(B0, A1, acc[1][0], 0, 0, 0);
        acc[1][1] = __builtin_amdgcn_mfma_f32_16x16x32_bf16(B1, A1, acc[1][1], 0, 0, 0);
    }
}
namespace g8 {
constexpr int BM = 256, BK = 64, HALF = 128, HTB = HALF * BK * 2, STAGE_BYTES = 8 * HTB, NXCD = 8, WGM = 8;
__device__ __forceinline__ int lds_byte(int r, int c) { const int st = (r >> 4) * 2 + (c >> 5), rr = r & 15, cc = c & 31, ob = rr * 64 + cc * 2; return st * 1024 + (ob ^ (((ob >> 9) & 1) << 5)); }
__device__ __forceinline__ void stage_rc(int b, int& R, int& C) { const int st = b / 1024, sb = b % 1024, swz = sb ^ (((sb >> 9) & 1) << 5); R = (st >> 1) * 16 + swz / 64; C = (st & 1) * 32 + (swz % 64) / 2; }
struct Unit { int pm, pn, bt, e; };
struct StaticOrder {
    int nM, nN, nwg, G, c;
    __device__ void init(int nM_, int nN_, int G_, int c_) { nM = nM_; nN = nN_; nwg = nM * nN; G = G_; c = c_; }
    __device__ bool next(int i, Unit& u) const {
        const long L = (long)i * G + c; if (L >= nwg) return false;
        int wgid = (int)L; { const int q = nwg / NXCD, r = nwg % NXCD, xcd = wgid % NXCD, off = wgid / NXCD; wgid = (xcd < r ? xcd * (q + 1) : r * (q + 1) + (xcd - r) * q) + off; }
        const int nig = WGM * nN, gid = wgid / nig, fm = gid * WGM, gsz = (nM - fm) < WGM ? (nM - fm) : WGM;
        u.pm = fm + ((wgid % nig) % gsz); u.pn = (wgid % nig) / gsz; u.bt = u.pn; u.e = 0; return true;
    }
};
struct GroupedOrder {
    StaticOrder so; const LAS int* sm;
    __device__ void init(const LAS int* sm_, int nN_, int G_, int c_) { sm = sm_; so.init(sm_[32] / BM, nN_, G_, c_); }
    __device__ bool next(int i, Unit& u) const {
        if (!so.next(i, u)) return false;
        const int rowt = u.pm * BM; int e = 0;
#pragma unroll
        for (int q = 1; q < NE; ++q) e = (rowt >= sm[16 + q]) ? q : e;
        u.e = e; u.bt = e * so.nN + u.pn; return true;
    }
};
struct GatherInfo { const int* rowlist; const LAS int* sm; };

__device__ __forceinline__ int perm32(int rho) { const int n = rho >> 4, i = rho & 15; return 8 * (i >> 2) + 4 * n + (i & 3); }
template <bool GATHER, class Epi, class Sched>
__device__ __forceinline__ void gemm8(LAS unsigned char* lds, const bf16_t* A, int lda, const bf16_t* Bt, int K, const Sched& S, const Epi& E, GatherInfo gi) {
    const int tid = threadIdx.x, wid = __builtin_amdgcn_readfirstlane(tid >> 6), lane = tid & 63, wr = wid >> 2, wc = wid & 3, fr = lane & 15, fq = lane >> 4;
    const int nt = K / BK;
    int Rr[2], Cc[2]; unsigned voffB[2]; unsigned vAc[2][2], vAn[2][2];
#pragma unroll
    for (int i = 0; i < 2; ++i) { stage_rc(tid * 16 + i * 8192, Rr[i], Cc[i]); voffB[i] = (unsigned)(((Rr[i] & ~31) + perm32(Rr[i] & 31)) * K + Cc[i]) * 2u;
#pragma unroll
        for (int h = 0; h < 2; ++h) { vAc[h][i] = (unsigned)((Rr[i] + HALF * h) * lda + Cc[i]) * 2u; vAn[h][i] = vAc[h][i]; } }
    const size_t kstep = (size_t)(BK * 2);
    const size_t hstepB = (size_t)HALF * K * 2, tstepB = 2 * hstepB, tstepA = (size_t)BM * lda * 2;
    const unsigned ldsw = (unsigned)wid * 1024u;
    const int aoff = lds_byte(wr * 64 + fr, fq * 8), boff = lds_byte(wc * 32 + fr, fq * 8);
#define G8_SA(b, h) (((b) * 2 + (h)) * HTB)
#define G8_SB(b, h) ((4 + (b) * 2 + (h)) * HTB)
#define G8_STAGEB(bufoff, gbase) do { _Pragma("unroll") for (int _i = 0; _i < 2; ++_i) \
        __builtin_amdgcn_global_load_lds((const unsigned*)((const char*)(gbase) + voffB[_i]), (LAS unsigned*)(lds + (bufoff) + ldsw + _i * 8192), 16, 0, 0); } while (0)
#define G8_STAGEA(bufoff, gbase, v0, v1) do { \
        __builtin_amdgcn_global_load_lds((const unsigned*)((const char*)(gbase) + (v0)), (LAS unsigned*)(lds + (bufoff) + ldsw), 16, 0, 0); \
        __builtin_amdgcn_global_load_lds((const unsigned*)((const char*)(gbase) + (v1)), (LAS unsigned*)(lds + (bufoff) + ldsw + 8192), 16, 0, 0); } while (0)
#define G8_LDA(dst, b, h) do { _Pragma("unroll") for (int m = 0; m < 4; ++m) _Pragma("unroll") for (int k = 0; k < 2; ++k) dst[m][k] = *(const LAS bf16x8*)(lds + G8_SA(b, h) + aoff + m * 2048 + k * 1024); } while (0)
#define G8_LDB(dst, b, h) do { _Pragma("unroll") for (int n = 0; n < 2; ++n) _Pragma("unroll") for (int k = 0; k < 2; ++k) dst[n][k] = *(const LAS bf16x8*)(lds + G8_SB(b, h) + boff + n * 2048 + k * 1024); } while (0)
#define G8_MMA(ai, bj, At, Bt_) do { __builtin_amdgcn_s_setprio(1); _Pragma("unroll") for (int m = 0; m < 4; ++m) _Pragma("unroll") for (int n = 0; n < 2; ++n) _Pragma("unroll") for (int k = 0; k < 2; ++k) \
        acc[ai][bj][m][n] = __builtin_amdgcn_mfma_f32_16x16x32_bf16(Bt_[n][k], At[m][k], acc[ai][bj][m][n], 0, 0, 0); __builtin_amdgcn_s_setprio(0); } while (0)
#define G8_WAIT_V(n) asm volatile("s_waitcnt vmcnt(" #n ")" ::: "memory")
#define G8_WAIT_L(n) asm volatile("s_waitcnt lgkmcnt(" #n ")" ::: "memory")
#define G8_BAR __builtin_amdgcn_s_barrier()
#define G8_SCHED __builtin_amdgcn_sched_barrier(0)
#define G8_GATHER(u, v) do { if (GATHER) { const int _eb = gi.sm[16 + (u).e], _ec = gi.sm[(u).e]; \
        _Pragma("unroll") for (int _h = 0; _h < 2; ++_h) _Pragma("unroll") for (int _i = 0; _i < 2; ++_i) { const int _s = (u).pm * BM + HALF * _h + Rr[_i] - _eb; \
            const int _t = gi.rowlist[(u).e * NTOK + (_s < _ec ? _s : 0)]; v[_h][_i] = (unsigned)(_t * K + Cc[_i]) * 2u; } } } while (0)
    Unit cur, nxt; int ui = 0;
    if (!S.next(0, cur)) return;
    f32x4 acc[2][2][4][2];
#pragma unroll
    for (int a = 0; a < 2; ++a)
#pragma unroll
        for (int b = 0; b < 2; ++b)
#pragma unroll
            for (int m = 0; m < 4; ++m)
#pragma unroll
                for (int n = 0; n < 2; ++n) acc[a][b][m][n] = (f32x4){0.f, 0.f, 0.f, 0.f};
    bf16x8 At[4][2], B0[2][2], B1[2][2];
    G8_GATHER(cur, vAc);
    const char* cA = GATHER ? (const char*)A : (const char*)A + (size_t)cur.pm * tstepA; const char* cB = (const char*)Bt + (size_t)cur.bt * tstepB;
    G8_STAGEB(G8_SB(0, 0), cB); G8_STAGEB(G8_SB(0, 1), cB + hstepB); G8_STAGEA(G8_SA(0, 0), cA, vAc[0][0], vAc[0][1]); G8_STAGEA(G8_SA(0, 1), cA, vAc[1][0], vAc[1][1]);
    if (wr == 1) G8_BAR;
    G8_WAIT_V(2); G8_BAR;
    G8_STAGEB(G8_SB(1, 0), cB + kstep); G8_STAGEA(G8_SA(1, 0), cA + kstep, vAc[0][0], vAc[0][1]); G8_STAGEB(G8_SB(1, 1), cB + hstepB + kstep);
    G8_WAIT_V(6); G8_BAR;
    for (;;) {
        const bool has_next = S.next(ui + 1, nxt);
        if (has_next) G8_GATHER(nxt, vAn);
        const char* nA = has_next ? (GATHER ? (const char*)A : (const char*)A + (size_t)nxt.pm * tstepA) : cA; const char* nB = has_next ? (const char*)Bt + (size_t)nxt.bt * tstepB : cB;
        for (int t = 0; t < nt; t += 2) {
            const bool last = (t == nt - 2);
            const char* a1 = cA + (size_t)(t + 1) * kstep;
            const char* a2 = last ? nA : cA + (size_t)(t + 2) * kstep; const char* b2 = last ? nB : cB + (size_t)(t + 2) * kstep;
            const char* a3 = a2 + kstep; const char* b3 = b2 + kstep;
            const bool usen = GATHER && last && has_next;
            const unsigned w00 = usen ? vAn[0][0] : vAc[0][0], w01 = usen ? vAn[0][1] : vAc[0][1], w10 = usen ? vAn[1][0] : vAc[1][0], w11 = usen ? vAn[1][1] : vAc[1][1];
            G8_LDB(B0, 0, 0); G8_LDB(B1, 0, 1); G8_SCHED; G8_LDA(At, 0, 0); G8_STAGEA(G8_SA(1, 1), a1, vAc[1][0], vAc[1][1]);
            G8_WAIT_V(8); G8_WAIT_L(0); G8_BAR; G8_MMA(0, 0, At, B0); G8_MMA(0, 1, At, B1); G8_BAR; G8_SCHED;
            G8_LDA(At, 0, 1); G8_STAGEB(G8_SB(0, 0), b2); G8_STAGEB(G8_SB(0, 1), b2 + hstepB); G8_STAGEA(G8_SA(0, 0), a2, w00, w01);
            G8_WAIT_V(8); G8_WAIT_L(0); G8_BAR; G8_MMA(1, 0, At, B0); G8_MMA(1, 1, At, B1); G8_BAR; G8_SCHED;
            G8_LDB(B0, 1, 0); G8_LDB(B1, 1, 1); G8_SCHED; G8_LDA(At, 1, 0); G8_STAGEA(G8_SA(0, 1), a2, w10, w11);
            G8_WAIT_V(8); G8_WAIT_L(0); G8_BAR; G8_MMA(0, 0, At, B0); G8_MMA(0, 1, At, B1); G8_BAR; G8_SCHED;
            G8_LDA(At, 1, 1); G8_STAGEB(G8_SB(1, 0), b3); G8_STAGEB(G8_SB(1, 1), b3 + hstepB); G8_STAGEA(G8_SA(1, 0), a3, w00, w01);
            G8_WAIT_V(8); G8_WAIT_L(0); G8_BAR; G8_MMA(1, 0, At, B0); G8_MMA(1, 1, At, B1); G8_BAR; G8_SCHED;
        }
        if (wr == 0) G8_BAR;
        E(acc, cur, wr, wc, fr, fq);
        if (!has_next) break;
#pragma unroll
        for (int a = 0; a < 2; ++a)
#pragma unroll
            for (int b = 0; b < 2; ++b)
#pragma unroll
                for (int m = 0; m < 4; ++m)
#pragma unroll
                    for (int n = 0; n < 2; ++n) acc[a][b][m][n] = (f32x4){0.f, 0.f, 0.f, 0.f};
        cur = nxt; cA = nA; cB = nB; ++ui;
#pragma unroll
        for (int h = 0; h < 2; ++h)
#pragma unroll
            for (int i = 0; i < 2; ++i) vAc[h][i] = vAn[h][i];
        if (wr == 1) G8_BAR;
    }
    G8_WAIT_V(0);
    G8_BAR;
    if constexpr (Epi::AFTER) E.after(acc, cur, lds, wr, wc, fr, fq, wid, lane);
#undef G8_SA
#undef G8_SB
#undef G8_STAGEA
#undef G8_STAGEB
#undef G8_LDA
#undef G8_LDB
#undef G8_MMA
#undef G8_WAIT_V
#undef G8_WAIT_L
#undef G8_BAR
#undef G8_SCHED
#undef G8_GATHER
}
template <class F> struct EpiEl {
    static constexpr bool AFTER = false;
    F f;
    __device__ __forceinline__ void operator()(const f32x4 (&acc)[2][2][4][2], const Unit& u, int wr, int wc, int fr, int fq) const {
#pragma unroll
        for (int ai = 0; ai < 2; ++ai)
#pragma unroll
            for (int m = 0; m < 4; ++m) { const int row = u.pm * BM + ai * HALF + wr * 64 + m * 16 + fr;
#pragma unroll
                for (int bj = 0; bj < 2; ++bj) f(row, u.pn * BM + bj * HALF + wc * 32 + 8 * fq, acc[ai][bj][m][0], acc[ai][bj][m][1]); }
    }
};
}

struct EpiNsaIn {
    bf16_t* Q; bf16_t* KV; float* gates; const float2* rope;
    __device__ __forceinline__ void operator()(int row, int c, f32x4 v) const {
        const int t = row & (SEQ - 1), b = row >> 13;
        if (c < 1024) {
            v = v * QSCALE;
            const int d = (c & 63) >> 1; const float2 c0 = rope[t * 32 + d], c1 = rope[t * 32 + d + 1];
            bf16_t* p = Q + (size_t)row * DM + (c & ~63);
            *(unsigned*)(p + d) = pk2(v[0] * c0.x - v[1] * c0.y, v[2] * c1.x - v[3] * c1.y);
            *(unsigned*)(p + d + 32) = pk2(v[1] * c0.x + v[0] * c0.y, v[3] * c1.x + v[2] * c1.y);
        } else if (c < 2560) {
            const int s = (c - 1024) >> 8, g = ((c - 1024) >> 6) & 3;
            bf16_t* p = KV + (size_t)s * (KVSEG / 2) + ((size_t)(b * NG + g) * SEQ + t) * DH;
            if (s == 2 || s == 4) {
                const int d = (c & 63) >> 1; const float2 c0 = rope[t * 32 + d], c1 = rope[t * 32 + d + 1];
                *(unsigned*)(p + d) = pk2(v[0] * c0.x - v[1] * c0.y, v[2] * c1.x - v[3] * c1.y);
                *(unsigned*)(p + d + 32) = pk2(v[1] * c0.x + v[0] * c0.y, v[3] * c1.x + v[2] * c1.y);
            } else {
                *(u32x2*)(p + (c & 63)) = (u32x2){pk2(v[0], v[1]), pk2(v[2], v[3])};
            }
        } else if (c < NSA_IN) {
            float* gp = gates + (size_t)row * 48 + (c - 2560);
            *(f32x4*)gp = (f32x4){sigmoidf_(v[0]), sigmoidf_(v[1]), sigmoidf_(v[2]), sigmoidf_(v[3])};
        }
    }
    __device__ __forceinline__ void operator()(int row, int c, f32x4 v, f32x4 w) const {
        const int t = row & (SEQ - 1), b = row >> 13;
        const int s = (c - 1024) >> 8;
        const bool isq = c < 1024, roped = isq || s == 2 || s == 4;
        if (roped) {
            if (isq) { v = v * QSCALE; w = w * QSCALE; }
            const int g = ((c - 1024) >> 6) & 3, d = (c & 63) >> 1;
            bf16_t* p = isq ? Q + (size_t)row * DM + (c & ~63) : KV + (size_t)s * (KVSEG / 2) + ((size_t)(b * NG + g) * SEQ + t) * DH;
            const f32x4 cs01 = *(const f32x4*)(rope + t * 32 + d), cs23 = *(const f32x4*)(rope + t * 32 + d + 2);
            *(u32x2*)(p + d) = (u32x2){pk2(v[0] * cs01[0] - v[1] * cs01[1], v[2] * cs01[2] - v[3] * cs01[3]), pk2(w[0] * cs23[0] - w[1] * cs23[1], w[2] * cs23[2] - w[3] * cs23[3])};
            *(u32x2*)(p + d + 32) = (u32x2){pk2(v[1] * cs01[0] + v[0] * cs01[1], v[3] * cs01[2] + v[2] * cs01[3]), pk2(w[1] * cs23[0] + w[0] * cs23[1], w[3] * cs23[2] + w[2] * cs23[3])};
        } else {
            const int g = ((c - 1024) >> 6) & 3;
            bf16_t* p = KV + (size_t)s * (KVSEG / 2) + ((size_t)(b * NG + g) * SEQ + t) * DH + (c & 63);
            *(u32x4*)p = (u32x4){pk2(v[0], v[1]), pk2(v[2], v[3]), pk2(w[0], w[1]), pk2(w[2], w[3])};
        }
    }
};
struct EpiMobaIn {
    bf16_t* Q; bf16_t* K; bf16_t* V; const float2* rope;
    __device__ __forceinline__ void operator()(int row, int c, f32x4 v) const {
        const int t = row & (SEQ - 1), b = row >> 13;
        if (c < 2048) {
            if (c < 1024) v = v * QSCALE;
            const int d = (c & 63) >> 1; const float2 c0 = rope[t * 32 + d], c1 = rope[t * 32 + d + 1];
            bf16_t* p = c < 1024 ? Q + (size_t)row * DM + (c & ~63) : K + ((size_t)(b * NH + ((c - 1024) >> 6)) * SEQ + t) * DH;
            *(unsigned*)(p + d) = pk2(v[0] * c0.x - v[1] * c0.y, v[2] * c1.x - v[3] * c1.y);
            *(unsigned*)(p + d + 32) = pk2(v[1] * c0.x + v[0] * c0.y, v[3] * c1.x + v[2] * c1.y);
        } else {
            bf16_t* p = V + ((size_t)(b * NH + ((c - 2048) >> 6)) * SEQ + t) * DH + (c & 63);
            *(u32x2*)p = (u32x2){pk2(v[0], v[1]), pk2(v[2], v[3])};
        }
    }
    __device__ __forceinline__ void operator()(int row, int c, f32x4 v, f32x4 w) const {
        const int t = row & (SEQ - 1), b = row >> 13;
        if (c < 2048) {
            if (c < 1024) { v = v * QSCALE; w = w * QSCALE; }
            const int d = (c & 63) >> 1;
            bf16_t* p = c < 1024 ? Q + (size_t)row * DM + (c & ~63) : K + ((size_t)(b * NH + ((c - 1024) >> 6)) * SEQ + t) * DH;
            const f32x4 cs01 = *(const f32x4*)(rope + t * 32 + d), cs23 = *(const f32x4*)(rope + t * 32 + d + 2);
            *(u32x2*)(p + d) = (u32x2){pk2(v[0] * cs01[0] - v[1] * cs01[1], v[2] * cs01[2] - v[3] * cs01[3]), pk2(w[0] * cs23[0] - w[1] * cs23[1], w[2] * cs23[2] - w[3] * cs23[3])};
            *(u32x2*)(p + d + 32) = (u32x2){pk2(v[1] * cs01[0] + v[0] * cs01[1], v[3] * cs01[2] + v[2] * cs01[3]), pk2(w[1] * cs23[0] + w[0] * cs23[1], w[3] * cs23[2] + w[2] * cs23[3])};
        } else {
            bf16_t* p = V + ((size_t)(b * NH + ((c - 2048) >> 6)) * SEQ + t) * DH + (c & 63);
            *(u32x4*)p = (u32x4){pk2(v[0], v[1]), pk2(v[2], v[3]), pk2(w[0], w[1]), pk2(w[2], w[3])};
        }
    }
};
struct EpiCmp {
    static constexpr bool AFTER = true;
    const float* bias; const bf16_t* W2T; const float2* rope; bf16_t* OUT;
    __device__ __forceinline__ void operator()(const f32x4 (&)[2][2][4][2], const g8::Unit&, int, int, int, int) const {}
    __device__ __forceinline__ void after(const f32x4 (&acc)[2][2][4][2], const g8::Unit& u, LAS unsigned char* lds, int wr, int wc, int fr, int fq, int wid, int lane) const {
#pragma unroll
        for (int bj = 0; bj < 2; ++bj) {
            const int c0 = bj * 128 + wc * 32 + 8 * fq;
            const f32x4 bv = *(const f32x4*)(bias + c0), bw = *(const f32x4*)(bias + c0 + 4);
#pragma unroll
            for (int ai = 0; ai < 2; ++ai)
#pragma unroll
                for (int m = 0; m < 4; ++m) { const int row = ai * 128 + wr * 64 + m * 16 + fr; const f32x4 v = acc[ai][bj][m][0] + bv, w = acc[ai][bj][m][1] + bw;
                    *(LAS u32x4*)(lds + row * 528 + c0 * 2) = (u32x4){pk2(gelu_tanh(v[0]), gelu_tanh(v[1])), pk2(gelu_tanh(v[2]), gelu_tanh(v[3])), pk2(gelu_tanh(w[0]), gelu_tanh(w[1])), pk2(gelu_tanh(w[2]), gelu_tanh(w[3]))}; }
        }
        asm volatile("s_waitcnt lgkmcnt(0)\n\ts_barrier" ::: "memory");
        f32x4 o[2][4];
#pragma unroll
        for (int rt = 0; rt < 2; ++rt)
#pragma unroll
            for (int dt = 0; dt < 4; ++dt) o[rt][dt] = (f32x4){0.f, 0.f, 0.f, 0.f};
#pragma unroll
        for (int s8 = 0; s8 < 8; ++s8) {
            bf16x8 hb[2], wa[4];
#pragma unroll
            for (int rt = 0; rt < 2; ++rt) hb[rt] = *(const LAS bf16x8*)(lds + (32 * wid + 16 * rt + fr) * 528 + (32 * s8 + 8 * fq) * 2);
#pragma unroll
            for (int dt = 0; dt < 4; ++dt) wa[dt] = *(const bf16x8*)(W2T + (16 * dt + fr) * 256 + 32 * s8 + 8 * fq);
#pragma unroll
            for (int rt = 0; rt < 2; ++rt)
#pragma unroll
                for (int dt = 0; dt < 4; ++dt) o[rt][dt] = __builtin_amdgcn_mfma_f32_16x16x32_bf16(wa[dt], hb[rt], o[rt][dt], 0, 0, 0);
        }
#pragma unroll
        for (int rt = 0; rt < 2; ++rt) {
            const int rg = u.pm * 256 + 32 * wid + 16 * rt + fr, ci = rg & 511;
            if (rope) {
#pragma unroll
                for (int dt = 0; dt < 2; ++dt) {
                    const f32x4 cs01 = *(const f32x4*)(rope + (16 * ci + 31) * 32 + 16 * dt + 4 * fq), cs23 = *(const f32x4*)(rope + (16 * ci + 31) * 32 + 16 * dt + 4 * fq + 2);
                    const f32x4 lo = o[rt][dt], hi = o[rt][dt + 2];
                    o[rt][dt] = (f32x4){lo[0] * cs01[0] - hi[0] * cs01[1], lo[1] * cs01[2] - hi[1] * cs01[3], lo[2] * cs23[0] - hi[2] * cs23[1], lo[3] * cs23[2] - hi[3] * cs23[3]};
                    o[rt][dt + 2] = (f32x4){hi[0] * cs01[0] + lo[0] * cs01[1], hi[1] * cs01[2] + lo[1] * cs01[3], hi[2] * cs23[0] + lo[2] * cs23[1], hi[3] * cs23[2] + lo[3] * cs23[3]};
                }
            }
            const float z = ci == 511 ? 0.f : 1.f;
#pragma unroll
            for (int dt = 0; dt < 4; ++dt) { const f32x4 x = o[rt][dt] * z; *(u32x2*)(OUT + (size_t)rg * 64 + 16 * dt + 4 * fq) = (u32x2){pk2(x[0], x[1]), pk2(x[2], x[3])}; }
        }
    }
};
struct EpiSwiGLU {
    bf16_t* H;
    __device__ __forceinline__ void operator()(int row, int c, f32x4 v) const {
        const float h0 = v[0] * sigmoidf_(v[0]) * v[1], h1 = v[2] * sigmoidf_(v[2]) * v[3];
        *(unsigned*)(H + (size_t)row * DE + (c >> 1)) = pk2(h0, h1);
    }
    __device__ __forceinline__ void operator()(int row, int c, f32x4 v, f32x4 w) const {
        *(u32x2*)(H + (size_t)row * DE + (c >> 1)) = (u32x2){pk2(v[0] * sigmoidf_(v[0]) * v[1], v[2] * sigmoidf_(v[2]) * v[3]), pk2(w[0] * sigmoidf_(w[0]) * w[1], w[2] * sigmoidf_(w[2]) * w[3])};
    }
};
struct EpiBf16 {
    bf16_t* Y;
    __device__ __forceinline__ void operator()(int row, int c, f32x4 v) const { *(u32x2*)(Y + (size_t)row * DM + c) = (u32x2){pk2(v[0], v[1]), pk2(v[2], v[3])}; }
    __device__ __forceinline__ void operator()(int row, int c, f32x4 v, f32x4 w) const { *(u32x4*)(Y + (size_t)row * DM + c) = (u32x4){pk2(v[0], v[1]), pk2(v[2], v[3]), pk2(w[0], w[1]), pk2(w[2], w[3])}; }
};

struct ExpertMap { int cnt[NE]; int base[NE + 1]; };
__device__ __forceinline__ void load_expert_map(const Ctx& C, int cw, LAS int* sm  ) {
    if (C.tid == 0) {
        const unsigned* ctl = (const unsigned*)(C.ws + WS_CTL); int acc = 0;
        for (int e = 0; e < NE; ++e) { const int c = (int)__hip_atomic_load(ctl + cw + 64 * e, __ATOMIC_RELAXED, __HIP_MEMORY_SCOPE_AGENT); sm[e] = c; sm[16 + e] = acc; acc += (c + 255) & ~255; }
        sm[32] = acc;
    }
    __syncthreads();
}

__device__ __forceinline__ void load_qh(const bf16_t* qp, float (&qh)[64]) {
    const uint4* q4 = (const uint4*)qp;
#pragma unroll
    for (int c = 0; c < 8; ++c) { const uint4 w = q4[c]; qh[8 * c] = bflo(w.x); qh[8 * c + 1] = bfhi(w.x); qh[8 * c + 2] = bflo(w.y); qh[8 * c + 3] = bfhi(w.y);
        qh[8 * c + 4] = bflo(w.z); qh[8 * c + 5] = bfhi(w.z); qh[8 * c + 6] = bflo(w.w); qh[8 * c + 7] = bfhi(w.w); }
}
namespace fa {
constexpr int SLOT = 16384, NSLOT = 4;
constexpr float C2 = 0.125f * 1.4426950408889634f;
constexpr float NEGBIG = -1e30f;
typedef short v4i16 __attribute__((ext_vector_type(4)));
template <bool WITH_V = true>
__device__ __forceinline__ void dma_block(LAS unsigned char* slot, const bf16_t* Kg, const bf16_t* Vg, int wave, int lane) {
    { const int key = 8 * wave + (lane >> 3), c = (lane & 7) ^ ((key >> 1) & 7);
      __builtin_amdgcn_global_load_lds((const unsigned*)(Kg + key * 64 + 8 * c), (LAS unsigned*)(slot + wave * 1024), 16, 0, 0); }
    if (WITH_V) { const int key = 16 * (wave & 3) + (lane >> 2), cp = lane & 3, d = (wave >> 2) * 32 + ((((cp >> 1) ^ ((key >> 2) & 1))) << 4) + ((cp & 1) << 3);
      __builtin_amdgcn_global_load_lds((const unsigned*)(Vg + key * 64 + d), (LAS unsigned*)(slot + 8192 + wave * 1024), 16, 0, 0); }
}
__device__ __forceinline__ v4i16 tr_read(LAS v4i16* __restrict__ p) { return __builtin_amdgcn_ds_read_tr16_b64_v4i16(p); }
__device__ __forceinline__ void xpose_dt_fq(unsigned& x0, unsigned& x1, unsigned& x2, unsigned& x3) {
    const auto s = __builtin_amdgcn_permlane32_swap(x0, x2, false, false); x0 = s[0]; x2 = s[1];
    const auto t = __builtin_amdgcn_permlane32_swap(x1, x3, false, false); x1 = t[0]; x3 = t[1];
    const auto p = __builtin_amdgcn_permlane16_swap(x0, x1, false, false); x0 = p[0]; x1 = p[1];
    const auto q = __builtin_amdgcn_permlane16_swap(x2, x3, false, false); x2 = q[0]; x3 = q[1];
}
__device__ __forceinline__ void xpose_dt_fq(u32x2 (&x)[4]) {
    unsigned a = x[0].x, b = x[1].x, c = x[2].x, d = x[3].x; xpose_dt_fq(a, b, c, d);
    unsigned e = x[0].y, f = x[1].y, g = x[2].y, h = x[3].y; xpose_dt_fq(e, f, g, h);
    x[0] = (u32x2){a, e}; x[1] = (u32x2){b, f}; x[2] = (u32x2){c, g}; x[3] = (u32x2){d, h};
}
__device__ __forceinline__ void xpose_dt_fq(f32x4 (&x)[4]) {
#pragma unroll
    for (int r = 0; r < 4; ++r) { unsigned a = __float_as_uint(x[0][r]), b = __float_as_uint(x[1][r]), c = __float_as_uint(x[2][r]), d = __float_as_uint(x[3][r]); xpose_dt_fq(a, b, c, d);
        x[0][r] = __uint_as_float(a); x[1][r] = __uint_as_float(b); x[2][r] = __uint_as_float(c); x[3][r] = __uint_as_float(d); }
}
__device__ __forceinline__ unsigned cvt_pk_bf16(float lo, float hi) { const f32x2v v = {lo, hi}; const bf16x2v b = __builtin_convertvector(v, bf16x2v); return __builtin_bit_cast(unsigned, b); }
struct Task { bf16x8 q[2]; int kmin, kmax; float m, l, cinit; f32x4 O[4]; f32x4 L; unsigned fw0; const LAS unsigned* fwp; int imptok; };
template <int FM> __device__ __forceinline__ bool row_flag(const Task& t, int jb) {
    if (FM == 0) return true;
    if (FM == 1) { const unsigned w = t.fwp[jb >> 5]; return ((w >> (jb & 31)) & 1u) != 0u; }
    return ((t.fw0 >> (jb >> 2)) & 1u) != 0u;
}
struct LaneC { int fq, koff0, koff1, voffA, voffB; };
__device__ __forceinline__ LaneC lane_consts(int lane) {
    const int i16 = lane & 15, fq = lane >> 4, kx = (i16 >> 1) & 7, q4 = i16 >> 2, p4 = lane & 3;
    LaneC lc; lc.fq = fq; lc.koff0 = i16 * 128 + ((fq ^ kx) << 4); lc.koff1 = i16 * 128 + (((4 + fq) ^ kx) << 4);
    lc.voffA = 8192 + (4 * fq + q4) * 64 + ((0 ^ (fq & 1)) << 5) + 8 * p4; lc.voffB = 8192 + (4 * fq + q4) * 64 + ((1 ^ (fq & 1)) << 5) + 8 * p4;
    return lc;
}
__device__ __forceinline__ float xrow16_max(float x) {
    auto s = __builtin_amdgcn_permlane16_swap(__float_as_uint(x), __float_as_uint(x), false, false);
    x = fmaxf(__uint_as_float(s[0]), __uint_as_float(s[1]));
    auto t = __builtin_amdgcn_permlane32_swap(__float_as_uint(x), __float_as_uint(x), false, false);
    return fmaxf(__uint_as_float(t[0]), __uint_as_float(t[1]));
}
__device__ __forceinline__ float xrow16_sum(float x) {
    auto s = __builtin_amdgcn_permlane16_swap(__float_as_uint(x), __float_as_uint(x), false, false);
    x = __uint_as_float(s[0]) + __uint_as_float(s[1]);
    auto t = __builtin_amdgcn_permlane32_swap(__float_as_uint(x), __float_as_uint(x), false, false);
    return __uint_as_float(t[0]) + __uint_as_float(t[1]);
}
__device__ __forceinline__ void t_mask(const Task& t, f32x4 (&s)[4], int kb, int fq) {
#pragma unroll
    for (int kt = 0; kt < 4; ++kt)
#pragma unroll
        for (int r = 0; r < 4; ++r) { const int key = kb + 16 * kt + 4 * fq + r; s[kt][r] = (key >= t.kmin && key <= t.kmax) ? s[kt][r] : NEGBIG; }
}
template <int MODE> __device__ __forceinline__ float t_stats(Task& t, f32x4 (&s)[4], bool rf) {
    float bm = fmaxf(fmaxf(fmaxf(s[0][0], s[0][1]), fmaxf(s[0][2], s[0][3])), fmaxf(fmaxf(s[1][0], s[1][1]), fmaxf(s[1][2], s[1][3])));
    bm = fmaxf(bm, fmaxf(fmaxf(fmaxf(s[2][0], s[2][1]), fmaxf(s[2][2], s[2][3])), fmaxf(fmaxf(s[3][0], s[3][1]), fmaxf(s[3][2], s[3][3]))));
    bm = xrow16_max(bm);
    if (!rf) bm = NEGBIG;
    const float mnew = fmaxf(t.m, bm);
    const float alpha = __builtin_amdgcn_exp2f(t.m - mnew);
    t.m = mnew;
    const float msub = (rf && mnew > -1e29f) ? mnew : __builtin_inff();
#pragma unroll
    for (int kt = 0; kt < 4; ++kt) s[kt] = s[kt] - msub;
    if (MODE == 1) t.l *= alpha;
    return alpha;
}
__device__ __forceinline__ void t_exp(f32x4 (&s)[4]) {
#pragma unroll
    for (int kt = 0; kt < 4; ++kt)
#pragma unroll
        for (int r = 0; r < 4; ++r) s[kt][r] = __builtin_amdgcn_exp2f(s[kt][r]);
}
__device__ __forceinline__ float quad_sum(float x) {
    x += __builtin_bit_cast(float, __builtin_amdgcn_mov_dpp(__builtin_bit_cast(int, x), 0xB1, 0xf, 0xf, true));
    x += __builtin_bit_cast(float, __builtin_amdgcn_mov_dpp(__builtin_bit_cast(int, x), 0x4E, 0xf, 0xf, true));
    return x;
}
__device__ __forceinline__ void t_imp(const Task& t, const f32x4 (&s)[4], int kb, int fq, LAS float* impbase) {
    float ga[4], gb[4];
#pragma unroll
    for (int kt = 0; kt < 4; ++kt) { ga[kt] = quad_sum((s[kt][0] + s[kt][1]) + (s[kt][2] + s[kt][3])); gb[kt] = quad_sum(s[kt][3]); }
    if ((t.imptok & 0x10000) == 0) return;
    LAS float* ip = impbase + (t.imptok & 0xffff) * 130 + (kb >> 2) + fq;
#pragma unroll
    for (int kt = 0; kt < 4; ++kt) { ip[4 * kt] = ga[kt]; ip[64 * 130 + 4 * kt] = gb[kt]; }
}
__device__ __forceinline__ bf16x8 t_pack(const f32x4 (&s)[4], int u) {
    u32x4 pw; pw.x = cvt_pk_bf16(s[2 * u][0], s[2 * u][1]); pw.y = cvt_pk_bf16(s[2 * u][2], s[2 * u][3]); pw.z = cvt_pk_bf16(s[2 * u + 1][0], s[2 * u + 1][1]); pw.w = cvt_pk_bf16(s[2 * u + 1][2], s[2 * u + 1][3]);
    return __builtin_bit_cast(bf16x8, pw);
}
template <int MODE, bool DA, bool DB>
__device__ __forceinline__ void do_blk(Task& a, Task& b, bool rfa, bool rfb, bool masked, LAS unsigned char* slot, int kb, LAS float* impbase, const LaneC& lc) {
    f32x4 sa[4], sb[4];
    const float xa = (MODE >= 2) ? (rfa ? a.cinit : -__builtin_inff()) : 0.f, xb = (MODE >= 2) ? (rfb ? b.cinit : -__builtin_inff()) : 0.f;
    const f32x4 ca = (f32x4){xa, xa, xa, xa}, cb = (f32x4){xb, xb, xb, xb};
#pragma unroll
    for (int kt = 0; kt < 4; ++kt) {
        const bf16x8 k0 = *(const LAS bf16x8*)(slot + lc.koff0 + kt * 2048), k1 = *(const LAS bf16x8*)(slot + lc.koff1 + kt * 2048);
        if (DA) { sa[kt] = __builtin_amdgcn_mfma_f32_16x16x32_bf16(k0, a.q[0], ca, 0, 0, 0); sa[kt] = __builtin_amdgcn_mfma_f32_16x16x32_bf16(k1, a.q[1], sa[kt], 0, 0, 0); }
        if (DB) { sb[kt] = __builtin_amdgcn_mfma_f32_16x16x32_bf16(k0, b.q[0], cb, 0, 0, 0); sb[kt] = __builtin_amdgcn_mfma_f32_16x16x32_bf16(k1, b.q[1], sb[kt], 0, 0, 0); }
    }
    if (masked) { if (DA) t_mask(a, sa, kb, lc.fq); if (DB) t_mask(b, sb, kb, lc.fq); }
    if (MODE < 2) {
        float ala = 1.0f, alb = 1.0f;
        if (DA) ala = t_stats<MODE>(a, sa, rfa);
        if (DB) alb = t_stats<MODE>(b, sb, rfb);
        if (MODE == 0) {
            if (__ballot((DA && ala != 1.0f) || (DB && alb != 1.0f)) != 0ull) {
#pragma unroll
                for (int dt = 0; dt < 4; ++dt) { if (DA) a.O[dt] = a.O[dt] * ala; if (DB) b.O[dt] = b.O[dt] * alb; }
                if (DA) a.L = a.L * ala; if (DB) b.L = b.L * alb;
            }
        }
    }
    if (DA) t_exp(sa);
    if (DB) t_exp(sb);
    if (MODE == 1) {
        if (DA) a.l += ((sa[0][0] + sa[0][1]) + (sa[0][2] + sa[0][3])) + ((sa[1][0] + sa[1][1]) + (sa[1][2] + sa[1][3])) + ((sa[2][0] + sa[2][1]) + (sa[2][2] + sa[2][3])) + ((sa[3][0] + sa[3][1]) + (sa[3][2] + sa[3][3]));
        if (DB) b.l += ((sb[0][0] + sb[0][1]) + (sb[0][2] + sb[0][3])) + ((sb[1][0] + sb[1][1]) + (sb[1][2] + sb[1][3])) + ((sb[2][0] + sb[2][1]) + (sb[2][2] + sb[2][3])) + ((sb[3][0] + sb[3][1]) + (sb[3][2] + sb[3][3]));
    }
    if (MODE == 2) { if (DA) t_imp(a, sa, kb, lc.fq, impbase); if (DB) t_imp(b, sb, kb, lc.fq, impbase); }
    if (MODE != 1) {
        const bf16x8 ones = (bf16x8){0x3F80, 0x3F80, 0x3F80, 0x3F80, 0x3F80, 0x3F80, 0x3F80, 0x3F80};
#pragma unroll
        for (int u = 0; u < 2; ++u) {
            bf16x8 pa, pb; if (DA) pa = t_pack(sa, u); if (DB) pb = t_pack(sb, u);
            if (MODE != 2) { if (DA) a.L = __builtin_amdgcn_mfma_f32_16x16x32_bf16(ones, pa, a.L, 0, 0, 0); if (DB) b.L = __builtin_amdgcn_mfma_f32_16x16x32_bf16(ones, pb, b.L, 0, 0, 0); }
#pragma unroll
            for (int dt = 0; dt < 4; ++dt) {
                const int vo = ((dt & 1) ? lc.voffB : lc.voffA) + (dt >> 1) * 4096 + u * 2048;
                const v4i16 a0 = tr_read((LAS v4i16*)(slot + vo)), a1 = tr_read((LAS v4i16*)(slot + vo + 1024));
                const bf16x8 vf = (bf16x8){a0[0], a0[1], a0[2], a0[3], a1[0], a1[1], a1[2], a1[3]};
                if (DA) a.O[dt] = __builtin_amdgcn_mfma_f32_16x16x32_bf16(vf, pa, a.O[dt], 0, 0, 0);
                if (DB) b.O[dt] = __builtin_amdgcn_mfma_f32_16x16x32_bf16(vf, pb, b.O[dt], 0, 0, 0);
            }
        }
    }
}
template <int MODE, int FM>
__device__ __forceinline__ void flash_loop(LAS unsigned char* ring, const bf16_t* Kg, const bf16_t* Vg, int nblk, Task& Ta, Task& Tb, LAS float* impbase, int wave, int lane) {
    const int i16 = lane & 15, fq = lane >> 4;
    const int kx = (i16 >> 1) & 7;
    const int q4 = i16 >> 2, p4 = lane & 3;
    LaneC lc; lc.fq = fq; lc.koff0 = i16 * 128 + ((fq ^ kx) << 4); lc.koff1 = i16 * 128 + (((4 + fq) ^ kx) << 4);
    lc.voffA = 8192 + (4 * fq + q4) * 64 + ((0 ^ (fq & 1)) << 5) + 8 * p4; lc.voffB = 8192 + (4 * fq + q4) * 64 + ((1 ^ (fq & 1)) << 5) + 8 * p4;
    const int amin = __builtin_amdgcn_readlane(Ta.kmin, 15), amax = __builtin_amdgcn_readlane(Ta.kmax, 0), bmin = __builtin_amdgcn_readlane(Tb.kmin, 15), bmax = __builtin_amdgcn_readlane(Tb.kmax, 0);
#pragma unroll
    for (int j = 0; j < NSLOT - 1; ++j) { const int jj = j < nblk ? j : nblk - 1; dma_block(ring + j * SLOT, Kg + (size_t)jj * 4096, Vg + (size_t)jj * 4096, wave, lane); }
    for (int jb = 0; jb < nblk; ++jb) {
        asm volatile("s_waitcnt vmcnt(4) lgkmcnt(0)\n\ts_barrier" ::: "memory");
        { const int jn = jb + 3 < nblk ? jb + 3 : nblk - 1; dma_block(ring + ((jb + 3) & 3) * SLOT, Kg + (size_t)jn * 4096, Vg + (size_t)jn * 4096, wave, lane); }
        LAS unsigned char* slot = ring + (jb & 3) * SLOT;
        const int kb = jb * 64;
        const bool rfa = row_flag<FM>(Ta, jb), rfb = row_flag<FM>(Tb, jb);
        const bool na = __ballot(rfa && Ta.kmax >= kb && Ta.kmin <= kb + 63) != 0ull, nb2 = __ballot(rfb && Tb.kmax >= kb && Tb.kmin <= kb + 63) != 0ull;
        const bool masked = !((!na || (kb >= amin && kb + 63 <= amax)) && (!nb2 || (kb >= bmin && kb + 63 <= bmax)));
        if (FM == 1) {
            if (na) do_blk<MODE, true, false>(Ta, Tb, rfa, rfb, masked, slot, kb, impbase, lc);
            if (nb2) do_blk<MODE, false, true>(Ta, Tb, rfa, rfb, masked, slot, kb, impbase, lc);
        } else {
            if (na || nb2) do_blk<MODE, true, true>(Ta, Tb, rfa, rfb, masked, slot, kb, impbase, lc);
        }
    }
    asm volatile("s_waitcnt vmcnt(0) lgkmcnt(0)\n\ts_barrier" ::: "memory");
}
template <int MODE, int FM>
__device__ __forceinline__ void flash_loop2(LAS unsigned char* ring, const bf16_t* Kg, const bf16_t* Vg, int nblk, Task& Ta, Task& Tb, LAS float* impbase, int wave, int lane) {
    const int i16 = lane & 15, fq = lane >> 4;
    const int kx = (i16 >> 1) & 7;
    const int q4 = i16 >> 2, p4 = lane & 3;
    LaneC lc; lc.fq = fq; lc.koff0 = i16 * 128 + ((fq ^ kx) << 4); lc.koff1 = i16 * 128 + (((4 + fq) ^ kx) << 4);
    lc.voffA = 8192 + (4 * fq + q4) * 64 + ((0 ^ (fq & 1)) << 5) + 8 * p4; lc.voffB = 8192 + (4 * fq + q4) * 64 + ((1 ^ (fq & 1)) << 5) + 8 * p4;
    const int amin = __builtin_amdgcn_readlane(Ta.kmin, 15), amax = __builtin_amdgcn_readlane(Ta.kmax, 0), bmin = __builtin_amdgcn_readlane(Tb.kmin, 15), bmax = __builtin_amdgcn_readlane(Tb.kmax, 0);
    const int nit = (nblk + 1) >> 1;
#pragma unroll
    for (int j = 0; j < 2; ++j) { const int jj = j < nblk ? j : nblk - 1; dma_block(ring + j * SLOT, Kg + (size_t)jj * 4096, Vg + (size_t)jj * 4096, wave, lane); }
    for (int i = 0; i < nit; ++i) {
        asm volatile("s_waitcnt vmcnt(0) lgkmcnt(0)\n\ts_barrier" ::: "memory");
#pragma unroll
        for (int j = 0; j < 2; ++j) { const int jn = 2 * i + 2 + j < nblk ? 2 * i + 2 + j : nblk - 1; dma_block(ring + ((2 * i + 2 + j) & 3) * SLOT, Kg + (size_t)jn * 4096, Vg + (size_t)jn * 4096, wave, lane); }
        if (FM == 1 && !SEL_FUSED) {
#pragma unroll
        for (int k = 0; k < 2; ++k) {
            const int jb = 2 * i + k;
            if (jb < nblk) {
                LAS unsigned char* slot = ring + (jb & 3) * SLOT;
                const int kb = jb * 64;
                const bool rfa = row_flag<FM>(Ta, jb), rfb = row_flag<FM>(Tb, jb);
                const bool na = __ballot(rfa && Ta.kmax >= kb && Ta.kmin <= kb + 63) != 0ull, nb2 = __ballot(rfb && Tb.kmax >= kb && Tb.kmin <= kb + 63) != 0ull;
                const bool masked = !((!na || (kb >= amin && kb + 63 <= amax)) && (!nb2 || (kb >= bmin && kb + 63 <= bmax)));
                if (na) do_blk<MODE, true, false>(Ta, Tb, rfa, rfb, masked, slot, kb, impbase, lc);
                if (nb2) do_blk<MODE, false, true>(Ta, Tb, rfa, rfb, masked, slot, kb, impbase, lc);
            }
        }
        } else {
            const int j0 = 2 * i, j1 = 2 * i + 1;
            const bool ra0 = row_flag<FM>(Ta, j0), rb0 = row_flag<FM>(Tb, j0), ra1 = j1 < nblk && row_flag<FM>(Ta, j1), rb1 = j1 < nblk && row_flag<FM>(Tb, j1);
            if (__ballot(ra0 || rb0 || ra1 || rb1) != 0ull) {
                const int k0 = j0 * 64, k1 = j1 * 64;
                const bool mk = (FM == 0) && !(k0 >= amin && k1 + 63 <= amax && k0 >= bmin && k1 + 63 <= bmax);
                if (!mk) {
                    do_blk<MODE, true, true>(Ta, Tb, ra0, rb0, false, ring + (j0 & 3) * SLOT, k0, impbase, lc);
                    if (FM == 0) __builtin_amdgcn_sched_barrier(0);
                    do_blk<MODE, true, true>(Ta, Tb, ra1, rb1, false, ring + (j1 & 3) * SLOT, k1, impbase, lc);
                } else {
                    do_blk<MODE, true, true>(Ta, Tb, ra0, rb0, true, ring + (j0 & 3) * SLOT, k0, impbase, lc);
                    __builtin_amdgcn_sched_barrier(0);
                    do_blk<MODE, true, true>(Ta, Tb, ra1, rb1, true, ring + (j1 & 3) * SLOT, k1, impbase, lc);
                }
            }
        }
    }
    asm volatile("s_waitcnt vmcnt(0) lgkmcnt(0)\n\ts_barrier" ::: "memory");
}
__device__ __forceinline__ void task_reset(Task& t) { t.m = NEGBIG; t.l = 0.f; t.cinit = 0.f; t.L = (f32x4){0.f, 0.f, 0.f, 0.f};
#pragma unroll
    for (int dt = 0; dt < 4; ++dt) t.O[dt] = (f32x4){0.f, 0.f, 0.f, 0.f}; }
__device__ __forceinline__ float task_rowsum(const Task& t) { return t.L[0]; }
__device__ __forceinline__ float task_rowsum_stats(const Task& t) { return xrow16_sum(t.l); }
constexpr float REF_DELTA = 32.f;
__device__ __forceinline__ void task_fix_ref(Task& t) {
    t.cinit = -(t.m + REF_DELTA);
    const float sc = __builtin_amdgcn_exp2f(-REF_DELTA);
    t.L = t.L * sc;
#pragma unroll
    for (int dt = 0; dt < 4; ++dt) t.O[dt] = t.O[dt] * sc;
}
}

struct NsaRow { int RI, c, b; u32x2 out[4];
    __device__ __forceinline__ int tokl() const { return RI >> 2; }
    __device__ __forceinline__ int head() const { return RI & 3; }
    __device__ __forceinline__ int tt() const { return 64 * c + (RI >> 2); }
    __device__ __forceinline__ size_t grow() const { return (size_t)(b * SEQ + 64 * c + (RI >> 2)); }
};
__device__ __forceinline__ void nsa_row_init(NsaRow& r, fa::Task& t, const bf16_t* Q, int b, int g, int c, int R, int fq) {
    r.RI = R; r.c = c; r.b = b;
    const bf16_t* qp = Q + r.grow() * DM + (g * 4 + r.head()) * DH + 8 * fq;
    t.q[0] = *(const bf16x8*)qp; t.q[1] = *(const bf16x8*)(qp + 32);
    t.imptok = r.tokl() | (r.head() == 0 ? 0x10000 : 0); t.fw0 = 0u; t.fwp = nullptr;
#pragma unroll
    for (int dt = 0; dt < 4; ++dt) r.out[dt] = (u32x2){0u, 0u};
}
__device__ __forceinline__ void nsa_cmp_setup(const NsaRow& r, fa::Task& t) {
    const int tt_ = r.tt(); const int nv = tt_ >= 31 ? (((tt_ - 31) >> 4) + 1 > 511 ? 511 : ((tt_ - 31) >> 4) + 1) : 0;
    t.kmin = 0; t.kmax = nv - 1; fa::task_reset(t);
}
__device__ __forceinline__ void nsa_accum(NsaRow& r, const fa::Task& t, float sc) {
#pragma unroll
    for (int dt = 0; dt < 4; ++dt) { const f32x4 o = t.O[dt] * sc; const u32x2 w = r.out[dt];
        r.out[dt] = (u32x2){pk2(bflo(w.x) + o[0], bfhi(w.x) + o[1]), pk2(bflo(w.y) + o[2], bfhi(w.y) + o[3])}; }
}
__device__ __forceinline__ void nsa_store(const NsaRow& r, bf16_t* AO, int g, int fq) {
    bf16_t* op = AO + r.grow() * DM + (g * 4 + r.head()) * DH + 4 * fq;
#pragma unroll
    for (int dt = 0; dt < 4; ++dt) *(u32x2*)(op + 16 * dt) = r.out[dt];
}
__device__ __forceinline__ void ph_nsa_fa(const Ctx& C) {
    LAS unsigned char* L = (LAS unsigned char*)C.lds;
    LAS unsigned char* ring = L;
    LAS float* imp = (LAS float*)(L + 65536);
    LAS unsigned* selm = (LAS unsigned*)(L + 135168);
    const bf16_t* Q = (const bf16_t*)(C.ws + WS_Q); const bf16_t* KC = (const bf16_t*)(C.ws + WS_KC); const bf16_t* VC = (const bf16_t*)(C.ws + WS_VC);
    const bf16_t* KS = (const bf16_t*)(C.ws + WS_KV0 + 2 * KVSEG); const bf16_t* VS = (const bf16_t*)(C.ws + WS_KV0 + 3 * KVSEG);
    const bf16_t* KW = (const bf16_t*)(C.ws + WS_KV0 + 4 * KVSEG); const bf16_t* VW = (const bf16_t*)(C.ws + WS_KV0 + 5 * KVSEG);
    const float* gates = (const float*)(C.ws + WS_GATES); bf16_t* AO = (bf16_t*)(C.ws + WS_Q);
    const int wave = C.wave;
    for (int u = C.bid; u < NB * NG * (SEQ / 64); u += C.nb) {
        int lane = C.lane; asm volatile("" : "+v"(lane));
        const int i16 = lane & 15, fq = lane >> 4;
        const int rnd = u / C.nb, idx = (u % C.nb) >> 4, bg = u & 15, b = bg >> 2, g = bg & 3;
        const int c = (C.nb == 256) ? 127 - 16 * rnd - ((rnd & 1) ? 15 - idx : idx) : 127 - (u >> 4);
        fa::Task T0, T1; NsaRow R0, R1;
        nsa_row_init(R0, T0, Q, b, g, c, 32 * wave + i16, fq);
        nsa_row_init(R1, T1, Q, b, g, c, 32 * wave + 16 + i16, fq);
        for (int i = C.tid; i < 2 * 64 * 130; i += NTHREADS) imp[i] = 0.f;
        if (C.tid < 256) selm[C.tid] = 0u;
        const int nvm = ((64 * c + 63 - 31) >> 4) + 1;
        const int nvmax = nvm > 511 ? 511 : nvm;
        const int nblkc = (nvmax + 63) >> 6;
        nsa_cmp_setup(R0, T0); nsa_cmp_setup(R1, T1);
        fa::flash_loop<1, 0>(ring, KC + (size_t)bg * 512 * DH, VC + (size_t)bg * 512 * DH, nblkc, T0, T1, imp, wave, lane);
        { const float l0 = fa::task_rowsum_stats(T0), l1 = fa::task_rowsum_stats(T1);
          T0.cinit = l0 > 0.f ? -T0.m - __builtin_amdgcn_logf(l0) : -__builtin_inff(); T1.cinit = l1 > 0.f ? -T1.m - __builtin_amdgcn_logf(l1) : -__builtin_inff(); }
        fa::flash_loop<2, 0>(ring, KC + (size_t)bg * 512 * DH, VC + (size_t)bg * 512 * DH, nblkc, T0, T1, imp, wave, lane);
        nsa_accum(R0, T0, gates[R0.grow() * 48 + g * 4 + R0.head()]);
        nsa_accum(R1, T1, gates[R1.grow() * 48 + g * 4 + R1.head()]);
        {
            const int jq = c, ncand = jq - 2 > 0 ? jq - 2 : 0, nforced = jq == 0 ? 1 : (jq == 1 ? 2 : 3), need = 16 - nforced;
#pragma unroll
            for (int g2 = 0; g2 < 2; ++g2) {
                const int tk = 8 * wave + 4 * g2 + (lane >> 4);
                unsigned key[8]; unsigned selb = 0u;
#pragma unroll
                for (int k = 0; k < 8; ++k) { const int j = i16 + 16 * k; const bool cand = j >= 1 && j <= jq - 2;
                    key[k] = cand ? ((__float_as_uint(imp[tk * 130 + j] + imp[64 * 130 + tk * 130 + j - 1]) & 0xFFFFFF80u) | (unsigned)(127 - j)) : 0u; }
                if (ncand <= need) {
#pragma unroll
                    for (int k = 0; k < 8; ++k) selb |= (key[k] != 0u) ? (1u << k) : 0u;
                } else {
                    for (int r = 0; r < need; ++r) {
                        unsigned m = max(max(max(key[0], key[1]), max(key[2], key[3])), max(max(key[4], key[5]), max(key[6], key[7])));
                        m = max(m, (unsigned)__builtin_amdgcn_mov_dpp((int)m, 0xB1, 0xf, 0xf, true));
                        m = max(m, (unsigned)__builtin_amdgcn_mov_dpp((int)m, 0x4E, 0xf, 0xf, true));
                        m = max(m, (unsigned)__builtin_amdgcn_mov_dpp((int)m, 0x141, 0xf, 0xf, true));
                        m = max(m, (unsigned)__builtin_amdgcn_mov_dpp((int)m, 0x140, 0xf, 0xf, true));
#pragma unroll
                        for (int k = 0; k < 8; ++k) { const bool hit = key[k] == m; selb |= hit ? (1u << k) : 0u; key[k] = hit ? 0u : key[k]; }
                    }
                }
#pragma unroll
                for (int k = 0; k < 8; ++k) { const int j = i16 + 16 * k; if (j == 0 || j == jq || j == jq - 1) selb |= 1u << k; }
#pragma unroll
                for (int w2 = 0; w2 < 4; ++w2) {
                    const unsigned bits = (((selb >> (2 * w2)) & 1u) << i16) | (((selb >> (2 * w2 + 1)) & 1u) << (16 + i16));
                    if (bits) __hip_atomic_fetch_or(selm + tk * 4 + w2, bits, __ATOMIC_RELAXED, __HIP_MEMORY_SCOPE_WORKGROUP);
                }
            }
        }
        asm volatile("s_waitcnt lgkmcnt(0)\n\ts_barrier" ::: "memory");
        {
            const int jlo = c - 8 > 0 ? c - 8 : 0;
            T0.kmin = 0; T0.kmax = R0.tokl(); fa::task_reset(T0); T1.kmin = 0; T1.kmax = R1.tokl(); fa::task_reset(T1);
            fa::flash_loop<0, 0>(ring, KW + ((size_t)bg * SEQ + 64 * c) * DH, VW + ((size_t)bg * SEQ + 64 * c) * DH, 1, T0, T1, imp, wave, lane);
            fa::task_fix_ref(T0); fa::task_fix_ref(T1);
            T0.kmin = R0.tt() - 511 - 64 * jlo; T0.kmax = R0.tt() - 64 * jlo; T1.kmin = R1.tt() - 511 - 64 * jlo; T1.kmax = R1.tt() - 64 * jlo;
            if (c > jlo) fa::flash_loop2<3, 0>(ring, KW + ((size_t)bg * SEQ + 64 * jlo) * DH, VW + ((size_t)bg * SEQ + 64 * jlo) * DH, c - jlo, T0, T1, imp, wave, lane);
            const float l0 = fa::task_rowsum(T0), l1 = fa::task_rowsum(T1);
            nsa_accum(R0, T0, (l0 > 0.f ? 1.0f / l0 : 0.f) * gates[R0.grow() * 48 + 32 + g * 4 + R0.head()]);
            nsa_accum(R1, T1, (l1 > 0.f ? 1.0f / l1 : 0.f) * gates[R1.grow() * 48 + 32 + g * 4 + R1.head()]);
        }
        {
            T0.fwp = selm + R0.tokl() * 4; T1.fwp = selm + R1.tokl() * 4;
            T0.kmin = 0; T0.kmax = R0.tokl(); fa::task_reset(T0); T1.kmin = 0; T1.kmax = R1.tokl(); fa::task_reset(T1);
            fa::flash_loop<0, 0>(ring, KS + ((size_t)bg * SEQ + 64 * c) * DH, VS + ((size_t)bg * SEQ + 64 * c) * DH, 1, T0, T1, imp, wave, lane);
            T0.kmax = R0.tt(); T1.kmax = R1.tt(); fa::task_fix_ref(T0); fa::task_fix_ref(T1);
            if (c > 0) fa::flash_loop2<3, 1>(ring, KS + (size_t)bg * SEQ * DH, VS + (size_t)bg * SEQ * DH, c, T0, T1, imp, wave, lane);
            const float l0 = fa::task_rowsum(T0), l1 = fa::task_rowsum(T1);
            nsa_accum(R0, T0, (l0 > 0.f ? 1.0f / l0 : 0.f) * gates[R0.grow() * 48 + 16 + g * 4 + R0.head()]);
            nsa_accum(R1, T1, (l1 > 0.f ? 1.0f / l1 : 0.f) * gates[R1.grow() * 48 + 16 + g * 4 + R1.head()]);
        }
        nsa_store(R0, AO, g, fq); nsa_store(R1, AO, g, fq);
    }
}

constexpr size_t WS_MMASK = 6 * MiB;
constexpr size_t WS_MCINIT = 8 * MiB;
constexpr size_t WS_MPL = 10 * MiB;
__device__ __forceinline__ size_t moba_po_off(int s, int b) {
    const int p = s * 4 + b;
    return p < 8 ? (353 + 16 * (size_t)p) * MiB : (p < 11 ? (45 + 16 * (size_t)(p - 8)) * MiB : 16 * MiB);
}
template <bool WITH_V>
__device__ __forceinline__ void moba_dma256(LAS unsigned char* ring, const bf16_t* K1, const bf16_t* V1, int bh, int blk, int wave, int lane) {
#pragma unroll
    for (int sb = 0; sb < 4; ++sb) fa::dma_block<WITH_V>(ring + sb * fa::SLOT, K1 + ((size_t)bh * SEQ + 256 * blk + 64 * sb) * DH, V1 + ((size_t)bh * SEQ + 256 * blk + 64 * sb) * DH, wave, lane);
}
__device__ __forceinline__ void moba_stage_kmt(LAS unsigned char* kmt, const float* KM, int bh, int tid) {
    if (tid < 256) {
        const int n = tid >> 3, c8 = tid & 7;
        const f32x4 a = *(const f32x4*)(KM + (size_t)bh * 2048 + n * 64 + 8 * c8), b2 = *(const f32x4*)(KM + (size_t)bh * 2048 + n * 64 + 8 * c8 + 4);
        u32x4 hi, lo;
        hi.x = pk2(a[0], a[1]); hi.y = pk2(a[2], a[3]); hi.z = pk2(b2[0], b2[1]); hi.w = pk2(b2[2], b2[3]);
        lo.x = pk2(a[0] - bflo(hi.x), a[1] - bfhi(hi.x)); lo.y = pk2(a[2] - bflo(hi.y), a[3] - bfhi(hi.y)); lo.z = pk2(b2[0] - bflo(hi.z), b2[1] - bfhi(hi.z)); lo.w = pk2(b2[2] - bflo(hi.w), b2[3] - bfhi(hi.w));
        const int off = n * 128 + ((c8 ^ ((n >> 1) & 7)) << 4);
        *(LAS u32x4*)(kmt + off) = hi; *(LAS u32x4*)(kmt + 4096 + off) = lo;
    }
}
__device__ __forceinline__ void ph_moba_sel(const Ctx& C) {
    LAS unsigned char* L = (LAS unsigned char*)C.lds;
    LAS unsigned char* kmt = L + 131072;
    const bf16_t* Q = (const bf16_t*)(C.ws + WS_Q); const bf16_t* K1 = (const bf16_t*)(C.ws + WS_K1);
    const float* KM = (const float*)(C.ws + WS_KMEAN); const float* KB2 = (const float*)(C.ws + WS_KB2); unsigned* MM = (unsigned*)(C.ws + WS_MMASK); float* CI = (float*)(C.ws + WS_MCINIT);
    const int wave = C.wave;
    const int nk = (NB * NH * 32 - C.bid + C.nb - 1) / C.nb;
    const bool bh_const = (C.nb & 63) == 0;
    if (nk > 0 && bh_const) { moba_stage_kmt(kmt, KM, C.bid & 63, C.tid); __syncthreads(); }
    bf16x8 nq[2][2], nkk[2][2];
#define MOBA_SEL_LOAD(u_) do { int lane_ = C.lane; asm volatile("" : "+v"(lane_)); const int bh_ = (u_) & 63, cb_ = 31 - ((u_) >> 6); \
        _Pragma("unroll") for (int ti = 0; ti < 2; ++ti) { const int t_ = 256 * cb_ + 32 * wave + 16 * ti + (lane_ & 15); \
            const bf16_t* qp_ = Q + (size_t)((bh_ >> 4) * SEQ + t_) * DM + (bh_ & 15) * DH + 8 * (lane_ >> 4); nq[ti][0] = *(const bf16x8*)qp_; nq[ti][1] = *(const bf16x8*)(qp_ + 32); \
            const bf16_t* kp_ = K1 + ((size_t)bh_ * SEQ + t_) * DH + 8 * (lane_ >> 4); nkk[ti][0] = *(const bf16x8*)kp_; nkk[ti][1] = *(const bf16x8*)(kp_ + 32); } } while (0)
    if (nk > 0) MOBA_SEL_LOAD(C.bid);
    for (int k = 0; k < nk; ++k) {
        const int u = C.bid + k * C.nb;
        int lane = C.lane; asm volatile("" : "+v"(lane));
        const int i16 = lane & 15, fq = lane >> 4;
        const int bh = u & 63, cb = 31 - (u >> 6);
        if (!bh_const) { __syncthreads(); moba_stage_kmt(kmt, KM, bh, C.tid); __syncthreads(); }
        float kmax2 = (lane <= cb) ? KB2[bh * 32 + lane] : 0.f;
        kmax2 = wave_max(kmax2);
        bf16x8 q[2][2], ks[2][2];
#pragma unroll
        for (int ti = 0; ti < 2; ++ti) { q[ti][0] = nq[ti][0]; q[ti][1] = nq[ti][1]; ks[ti][0] = nkk[ti][0]; ks[ti][1] = nkk[ti][1]; }
        if (k + 1 < nk) MOBA_SEL_LOAD(u + C.nb);
#pragma unroll
        for (int ti = 0; ti < 2; ++ti) {
            const int tt = 256 * cb + 32 * wave + 16 * ti + i16;
            const int kx = (i16 >> 1) & 7, ko0 = i16 * 128 + ((fq ^ kx) << 4), ko1 = i16 * 128 + (((4 + fq) ^ kx) << 4);
            float bv0 = -3e38f, bv1 = -3e38f, bv2 = -3e38f; int j0 = 99, j1 = 99, j2 = 99;
#define INS3(a, n) do { if ((a) > bv0 || ((a) == bv0 && (n) < j0)) { bv2 = bv1; j2 = j1; bv1 = bv0; j1 = j0; bv0 = (a); j0 = (n); } \
                else if ((a) > bv1 || ((a) == bv1 && (n) < j1)) { bv2 = bv1; j2 = j1; bv1 = (a); j1 = (n); } \
                else if ((a) > bv2 || ((a) == bv2 && (n) < j2)) { bv2 = (a); j2 = (n); } } while (0)
#pragma unroll
            for (int kt2 = 0; kt2 < 2; ++kt2) {
                const bf16x8 h0 = *(const LAS bf16x8*)(kmt + ko0 + kt2 * 2048), h1 = *(const LAS bf16x8*)(kmt + ko1 + kt2 * 2048);
                const bf16x8 l0 = *(const LAS bf16x8*)(kmt + 4096 + ko0 + kt2 * 2048), l1 = *(const LAS bf16x8*)(kmt + 4096 + ko1 + kt2 * 2048);
                f32x4 g = __builtin_amdgcn_mfma_f32_16x16x32_bf16(l0, q[ti][0], (f32x4){0.f, 0.f, 0.f, 0.f}, 0, 0, 0);
                g = __builtin_amdgcn_mfma_f32_16x16x32_bf16(l1, q[ti][1], g, 0, 0, 0);
                g = __builtin_amdgcn_mfma_f32_16x16x32_bf16(h0, q[ti][0], g, 0, 0, 0);
                g = __builtin_amdgcn_mfma_f32_16x16x32_bf16(h1, q[ti][1], g, 0, 0, 0);
#pragma unroll
                for (int r = 0; r < 4; ++r) { const int n = 16 * kt2 + 4 * fq + r; const float a = n < cb ? g[r] : -3e38f; INS3(a, n); }
            }
#pragma unroll
            for (int o = 16; o <= 32; o <<= 1) {
                const float ov0 = __shfl_xor(bv0, o), ov1 = __shfl_xor(bv1, o), ov2 = __shfl_xor(bv2, o); const int oj0 = __shfl_xor(j0, o), oj1 = __shfl_xor(j1, o), oj2 = __shfl_xor(j2, o);
                INS3(ov0, oj0); INS3(ov1, oj1); INS3(ov2, oj2);
            }
#undef INS3
            unsigned mk = 0u;
            if (j0 < cb && bv0 > -1e38f) mk |= 1u << j0; if (j1 < cb && bv1 > -1e38f) mk |= 1u << j1; if (j2 < cb && bv2 > -1e38f) mk |= 1u << j2;
            float qq = 0.f, qk = 0.f;
#pragma unroll
            for (int w2 = 0; w2 < 2; ++w2)
#pragma unroll
                for (int e = 0; e < 8; ++e) { const float a = bf2f((bf16_t)q[ti][w2][e]), b2 = bf2f((bf16_t)ks[ti][w2][e]); qq += a * a; qk += a * b2; }
            qq = fa::xrow16_sum(qq); qk = fa::xrow16_sum(qk);
            const float bound = sqrtf(qq * kmax2) * 1.0001f + 1e-3f;
            const float mlo = (j0 < cb && bv0 > -1e38f) ? fmaxf(qk, bv0) : qk;
            const float ref = fminf(bound, mlo + 100.f);
            if (fq == 0) { MM[(size_t)bh * SEQ + tt] = mk; CI[(size_t)bh * SEQ + tt] = -ref; }
        }
    }
#undef MOBA_SEL_LOAD
    asm volatile("s_waitcnt vmcnt(0) lgkmcnt(0)\n\ts_barrier" ::: "memory");
}
struct MobaPair { bf16x8 qa0, qa1, qb0, qb1; float ca, cb; unsigned ma, mb; int rowa, rowb; bool va, vb; };
__device__ __forceinline__ void ph_moba_gather(const Ctx& C) {
    LAS unsigned char* L = (LAS unsigned char*)C.lds;
    LAS unsigned* cnt = (LAS unsigned*)(L + 131072 + 2 * 15872);
    const bf16_t* Q = (const bf16_t*)(C.ws + WS_Q); const bf16_t* K1 = (const bf16_t*)(C.ws + WS_K1); const bf16_t* V1 = (const bf16_t*)(C.ws + WS_V1);
    const unsigned* MM = (const unsigned*)(C.ws + WS_MMASK); const float* CI = (const float*)(C.ws + WS_MCINIT); float* PL = (float*)(C.ws + WS_MPL);
    const int wave = C.wave;
    const int nk = (NB * NH * 32 - C.bid + C.nb - 1) / C.nb;
    if (C.tid < 3) cnt[C.tid] = 0u;
    __syncthreads();
#define MOBA_UNIT(k_, bh_, j_) do { const int u_ = C.bid + (k_) * C.nb, rnd_ = u_ / C.nb, idx_ = (u_ % C.nb) >> 6; bh_ = u_ & 63; j_ = (C.nb == 256) ? 4 * rnd_ + ((rnd_ & 1) ? 3 - idx_ : idx_) : (u_ >> 6); } while (0)
#define MOBA_MASKS(mv_, bh_, j_, tid_) do { const int r0_ = 256 * ((j_) + 1), N_ = SEQ - r0_; const unsigned* mp_ = MM + (size_t)(bh_) * SEQ + r0_; \
        _Pragma("unroll") for (int i_ = 0; i_ < 4; ++i_) { const int i4_ = 4 * (tid_) + 2048 * i_; mv_[i_] = (u32x4){0u, 0u, 0u, 0u}; if (i4_ < N_) mv_[i_] = *(const u32x4*)(mp_ + i4_); } } while (0)
    int bhc = 0, jc = 31; u32x4 mv[4];
    if (nk > 0) { MOBA_UNIT(0, bhc, jc); }
    if (jc < 31) { moba_dma256<true>(L, K1, V1, bhc, jc, wave, C.lane); MOBA_MASKS(mv, bhc, jc, C.tid); }
    int c3 = 0;
    for (int k = 0; k < nk; ++k) {
        int lane = C.lane; asm volatile("" : "+v"(lane));
        const int i16 = lane & 15, fq = lane >> 4, tid = 64 * wave + lane;
        LAS unsigned char* ring = L + (k & 1) * 65536;
        LAS unsigned short* list = (LAS unsigned short*)(L + 131072 + (k & 1) * 15872);
        const int bh = bhc, j = jc, b = bh >> 4, h = bh & 15;
        int bhn = 0, jn = 31;
        if (k + 1 < nk) { MOBA_UNIT(k + 1, bhn, jn); }
        if (j < 31) {
          const int r0 = 256 * (j + 1);
          const unsigned long long lt = (1ull << lane) - 1ull;
#pragma unroll
          for (int i = 0; i < 4; ++i) {
              const bool s0 = (mv[i].x >> j) & 1u, s1 = (mv[i].y >> j) & 1u, s2 = (mv[i].z >> j) & 1u, s3 = (mv[i].w >> j) & 1u;
              const unsigned long long b0 = __ballot(s0), b1 = __ballot(s1), b2 = __ballot(s2), b3 = __ballot(s3);
              const int c0 = __popcll(b0), c1 = __popcll(b1), c2 = __popcll(b2), c3_ = __popcll(b3), tot = c0 + c1 + c2 + c3_;
              if (tot) {
                  unsigned base = 0u;
                  if (lane == 0) base = __hip_atomic_fetch_add(cnt + c3, (unsigned)tot, __ATOMIC_RELAXED, __HIP_MEMORY_SCOPE_WORKGROUP);
                  base = __builtin_amdgcn_readfirstlane(base);
                  const int rb = r0 + 4 * tid + 2048 * i;
                  if (s0) list[base + __popcll(b0 & lt)] = (unsigned short)rb;
                  if (s1) list[base + c0 + __popcll(b1 & lt)] = (unsigned short)(rb + 1);
                  if (s2) list[base + c0 + c1 + __popcll(b2 & lt)] = (unsigned short)(rb + 2);
                  if (s3) list[base + c0 + c1 + c2 + __popcll(b3 & lt)] = (unsigned short)(rb + 3);
              }
          } }
        asm volatile("s_waitcnt vmcnt(0) lgkmcnt(0)\n\ts_barrier" ::: "memory");
        if (tid == 0) cnt[c3 == 0 ? 2 : c3 - 1] = 0u;
        if (jn < 31) { moba_dma256<true>(L + ((k + 1) & 1) * 65536, K1, V1, bhn, jn, wave, lane); MOBA_MASKS(mv, bhn, jn, tid); }
        if (j < 31) {
            const int n = (int)cnt[c3], npair = (n + 31) >> 5;
            const fa::LaneC lc = fa::lane_consts(lane);
#define MOBA_LOAD_PAIR(P_, p_) do { const int ia_ = 32 * (p_) + i16, ib_ = ia_ + 16; P_.va = ia_ < n; P_.vb = ib_ < n; P_.rowa = list[P_.va ? ia_ : 0]; P_.rowb = list[P_.vb ? ib_ : 0]; \
            { const bf16_t* qp_ = Q + (size_t)(b * SEQ + P_.rowa) * DM + h * DH + 8 * fq; P_.qa0 = *(const bf16x8*)qp_; P_.qa1 = *(const bf16x8*)(qp_ + 32); } \
            { const bf16_t* qp_ = Q + (size_t)(b * SEQ + P_.rowb) * DM + h * DH + 8 * fq; P_.qb0 = *(const bf16x8*)qp_; P_.qb1 = *(const bf16x8*)(qp_ + 32); } \
            P_.ca = CI[(size_t)bh * SEQ + P_.rowa]; P_.cb = CI[(size_t)bh * SEQ + P_.rowb]; P_.ma = MM[(size_t)bh * SEQ + P_.rowa]; P_.mb = MM[(size_t)bh * SEQ + P_.rowb]; } while (0)
            MobaPair cur, nxt;
            u32x2 sta[4], stb[4]; float sla = 0.f, slb = 0.f; int srowa = 0, srowb = 0, ssa = 0, ssb = 0; bool sva = false, svb = false;
#pragma unroll
            for (int dt = 0; dt < 4; ++dt) { sta[dt] = (u32x2){0u, 0u}; stb[dt] = (u32x2){0u, 0u}; }
#define MOBA_STORE_STASH() do { \
                if (sva) { bf16_t* op_ = (bf16_t*)(C.ws + moba_po_off(ssa, b)) + ((size_t)h * SEQ + srowa) * DH + 16 * fq; \
                    *(u32x4*)op_ = (u32x4){sta[0].x, sta[0].y, sta[1].x, sta[1].y}; *(u32x4*)(op_ + 8) = (u32x4){sta[2].x, sta[2].y, sta[3].x, sta[3].y}; \
                    if (fq == 0) PL[((size_t)ssa * 64 + bh) * SEQ + srowa] = sla; } \
                if (svb) { bf16_t* op_ = (bf16_t*)(C.ws + moba_po_off(ssb, b)) + ((size_t)h * SEQ + srowb) * DH + 16 * fq; \
                    *(u32x4*)op_ = (u32x4){stb[0].x, stb[0].y, stb[1].x, stb[1].y}; *(u32x4*)(op_ + 8) = (u32x4){stb[2].x, stb[2].y, stb[3].x, stb[3].y}; \
                    if (fq == 0) PL[((size_t)ssb * 64 + bh) * SEQ + srowb] = slb; } } while (0)
            if (wave < npair) { MOBA_LOAD_PAIR(cur, wave);
                asm volatile("" :: "v"(cur.qa0), "v"(cur.qa1), "v"(cur.qb0), "v"(cur.qb1), "v"(cur.ca), "v"(cur.cb), "v"(cur.ma), "v"(cur.mb)); }
            for (int p = wave; p < npair; p += NWAVES) {
                MOBA_STORE_STASH();
                { const int pn = p + NWAVES < npair ? p + NWAVES : p; MOBA_LOAD_PAIR(nxt, pn); }
                __builtin_amdgcn_sched_barrier(0);
                fa::Task Ta, Tb;
                fa::task_reset(Ta); fa::task_reset(Tb); Ta.kmin = 0; Ta.kmax = 0x7fffffff; Tb.kmin = 0; Tb.kmax = 0x7fffffff; Ta.imptok = 0; Tb.imptok = 0;
                Ta.q[0] = cur.qa0; Ta.q[1] = cur.qa1; Tb.q[0] = cur.qb0; Tb.q[1] = cur.qb1; Ta.cinit = cur.ca; Tb.cinit = cur.cb;
#pragma unroll
                for (int sb = 0; sb < 4; ++sb) { fa::do_blk<3, true, true>(Ta, Tb, cur.va, cur.vb, false, ring + sb * fa::SLOT, 0, nullptr, lc); if (sb & 1) __builtin_amdgcn_sched_barrier(0); }
#pragma unroll
                for (int dt = 0; dt < 4; ++dt) { sta[dt] = (u32x2){pk2(Ta.O[dt][0], Ta.O[dt][1]), pk2(Ta.O[dt][2], Ta.O[dt][3])}; stb[dt] = (u32x2){pk2(Tb.O[dt][0], Tb.O[dt][1]), pk2(Tb.O[dt][2], Tb.O[dt][3])}; }
                fa::xpose_dt_fq(sta); fa::xpose_dt_fq(stb);
                sla = Ta.L[0]; slb = Tb.L[0]; srowa = cur.rowa; srowb = cur.rowb; ssa = __popc(cur.ma & ((1u << j) - 1u)); ssb = __popc(cur.mb & ((1u << j) - 1u)); sva = cur.va; svb = cur.vb;
                cur = nxt;
            }
            MOBA_STORE_STASH();
#undef MOBA_STORE_STASH
#undef MOBA_LOAD_PAIR
        }
        bhc = bhn; jc = jn; c3 = c3 == 2 ? 0 : c3 + 1;
    }
#undef MOBA_UNIT
#undef MOBA_MASKS
    asm volatile("s_waitcnt vmcnt(0) lgkmcnt(0)\n\ts_barrier" ::: "memory");
}
__device__ __forceinline__ void ph_moba_own(const Ctx& C) {
    LAS unsigned char* L = (LAS unsigned char*)C.lds;
    const bf16_t* Q = (const bf16_t*)(C.ws + WS_Q); const bf16_t* K1 = (const bf16_t*)(C.ws + WS_K1); const bf16_t* V1 = (const bf16_t*)(C.ws + WS_V1);
    const unsigned* MM = (const unsigned*)(C.ws + WS_MMASK); const float* CI = (const float*)(C.ws + WS_MCINIT); const float* PL = (const float*)(C.ws + WS_MPL);
    bf16_t* AO = (bf16_t*)(C.ws + WS_Q);
    const int wave = C.wave;
    const int nk = (NB * NH * 32 - C.bid + C.nb - 1) / C.nb;
    bf16x8 nq[2][2]; float nci[2]; unsigned nmk[2];
#define MOBA_OWN_LOAD(u_) do { int lane_ = C.lane; asm volatile("" : "+v"(lane_)); const int bh_ = (u_) & 63, cb_ = 31 - ((u_) >> 6); \
        _Pragma("unroll") for (int ti = 0; ti < 2; ++ti) { const int t_ = 256 * cb_ + 32 * wave + 16 * ti + (lane_ & 15); \
            const bf16_t* qp_ = Q + (size_t)((bh_ >> 4) * SEQ + t_) * DM + (bh_ & 15) * DH + 8 * (lane_ >> 4); nq[ti][0] = *(const bf16x8*)qp_; nq[ti][1] = *(const bf16x8*)(qp_ + 32); \
            nci[ti] = CI[(size_t)bh_ * SEQ + t_]; nmk[ti] = MM[(size_t)bh_ * SEQ + t_]; } } while (0)
    u32x2 st[2][4]; int stt[2] = {0, 0}, sbh = 0; bool spend = false;
#pragma unroll
    for (int ti = 0; ti < 2; ++ti)
#pragma unroll
        for (int dt = 0; dt < 4; ++dt) st[ti][dt] = (u32x2){0u, 0u};
#define MOBA_OWN_STORE() do { int lane_ = C.lane; asm volatile("" : "+v"(lane_)); \
        _Pragma("unroll") for (int ti = 0; ti < 2; ++ti) { bf16_t* op_ = AO + (size_t)((sbh >> 4) * SEQ + stt[ti]) * DM + (sbh & 15) * DH + 16 * (lane_ >> 4); \
            *(u32x4*)op_ = (u32x4){st[ti][0].x, st[ti][0].y, st[ti][1].x, st[ti][1].y}; *(u32x4*)(op_ + 8) = (u32x4){st[ti][2].x, st[ti][2].y, st[ti][3].x, st[ti][3].y}; } } while (0)
    if (nk > 0) { moba_dma256<true>(L, K1, V1, C.bid & 63, 31 - (C.bid >> 6), wave, C.lane); MOBA_OWN_LOAD(C.bid); }
    for (int k = 0; k < nk; ++k) {
        const int u = C.bid + k * C.nb;
        int lane = C.lane; asm volatile("" : "+v"(lane));
        const int i16 = lane & 15, fq = lane >> 4;
        const int bh = u & 63, b = bh >> 4, h = bh & 15, cb = 31 - (u >> 6);
        LAS unsigned char* ring = L + (k & 1) * 65536;
        asm volatile("s_waitcnt vmcnt(0) lgkmcnt(0)\n\ts_barrier" ::: "memory");
        if (spend) MOBA_OWN_STORE();
        if (k + 1 < nk) { const int un = u + C.nb; moba_dma256<true>(L + ((k + 1) & 1) * 65536, K1, V1, un & 63, 31 - (un >> 6), wave, lane); }
        fa::Task T[2]; int tt[2]; unsigned mk[2];
#pragma unroll
        for (int ti = 0; ti < 2; ++ti) {
            const int R = 32 * wave + 16 * ti + i16; tt[ti] = 256 * cb + R; T[ti].imptok = 0;
            T[ti].q[0] = nq[ti][0]; T[ti].q[1] = nq[ti][1];
            T[ti].kmin = 0; T[ti].kmax = R; fa::task_reset(T[ti]);
            T[ti].cinit = nci[ti]; mk[ti] = nmk[ti];
        }
        u32x4 pw[2][3][2]; float pl[2][3];
#pragma unroll
        for (int ti = 0; ti < 2; ++ti)
#pragma unroll
            for (int s = 0; s < 3; ++s) {
                const bf16_t* pp = (const bf16_t*)(C.ws + moba_po_off(s, b)) + ((size_t)h * SEQ + tt[ti]) * DH + 16 * fq;
                pw[ti][s][0] = *(const u32x4*)pp; pw[ti][s][1] = *(const u32x4*)(pp + 8);
                pl[ti][s] = PL[((size_t)s * 64 + bh) * SEQ + tt[ti]];
            }
        if (k + 1 < nk) MOBA_OWN_LOAD(u + C.nb);
        __builtin_amdgcn_sched_barrier(0);
        { const fa::LaneC lc = fa::lane_consts(lane);
#pragma unroll
          for (int sb = 0; sb < 4; ++sb) if (64 * sb <= 32 * wave + 31) fa::do_blk<3, true, true>(T[0], T[1], true, true, 64 * sb + 63 > 32 * wave, ring + sb * fa::SLOT, 64 * sb, nullptr, lc); }
#pragma unroll
        for (int ti = 0; ti < 2; ++ti) {
            const int ns = __popc(mk[ti]); float l = fa::task_rowsum(T[ti]);
            fa::xpose_dt_fq(T[ti].O);
#pragma unroll
            for (int s = 0; s < 3; ++s) {
                const bool own = s < ns;
#pragma unroll
                for (int k2 = 0; k2 < 4; ++k2) { const unsigned w0 = pw[ti][s][k2 >> 1][2 * (k2 & 1)], w1 = pw[ti][s][k2 >> 1][2 * (k2 & 1) + 1]; const f32x4 add = (f32x4){bflo(w0), bfhi(w0), bflo(w1), bfhi(w1)}; T[ti].O[k2] = own ? T[ti].O[k2] + add : T[ti].O[k2]; }
                l = own ? l + pl[ti][s] : l;
            }
            const float sc_ = l > 0.f ? 1.0f / l : 0.f;
#pragma unroll
            for (int dt = 0; dt < 4; ++dt) { const f32x4 o = T[ti].O[dt] * sc_; st[ti][dt] = (u32x2){pk2(o[0], o[1]), pk2(o[2], o[3])}; }
            stt[ti] = tt[ti];
        }
        sbh = bh; spend = true;
    }
    if (spend) MOBA_OWN_STORE();
#undef MOBA_OWN_LOAD
#undef MOBA_OWN_STORE
    asm volatile("s_waitcnt vmcnt(0) lgkmcnt(0)\n\ts_barrier" ::: "memory");
}

struct Route { int e0, s0, e1, s1; float w0, w1; int pad0, pad1; };
__device__ __forceinline__ void ph_ln_route(const Ctx& C, int layer) {
    const float* resid = C.in[I_X]; const bf16_t* residb = (const bf16_t*)(C.ws + WS_XB)  ; const bf16_t* MIX = (const bf16_t*)(C.ws + WS_MIX);
    bf16_t* X1B = (bf16_t*)(C.ws + WS_X1B); Route* RT = (Route*)(C.ws + WS_ROUTE);
    int* rowlist = (int*)(C.ws + WS_ROWLIST); unsigned* cnt = (unsigned*)(C.ws + WS_CTL) + (layer ? CW_CNT1 : CW_CNT0);
    const float* lg = C.in[I_LNG] + (size_t)(layer * 2 + 0) * DM; const float* lb = C.in[I_LNB] + (size_t)(layer * 2 + 0) * DM;
    const float* rw = C.in[I_RW]; const float* rb = C.in[I_RB];
    LAS unsigned* lcnt = (LAS unsigned*)C.lds;
    LAS float* rec = (LAS float*)(C.lds + 256);
    LAS float* lsb = (LAS float*)(C.lds + 4096 + C.wave * 512);
    const int lane = C.lane;
    LAS unsigned char* rwl = (LAS unsigned char*)(C.lds + 8192);
    for (int gi = C.tid; gi < DM * NE / 4; gi += NTHREADS) { const int c = gi >> 2, e4 = gi & 3;
        *(LAS f32x4*)(rwl + (c >> 8) * 17408 + ((c & 255) >> 2) * 272 + (c & 3) * 64 + e4 * 16) = ((const f32x4*)rw)[gi]; }
    __syncthreads();
    for (int chunk = C.bid; chunk < NTOK / 128; chunk += C.nb) {
        if (C.tid < 16) lcnt[C.tid] = 0u;
        __syncthreads();
        for (int i2 = 0; i2 < 8; ++i2) {
            const int rl0 = C.wave * 16 + i2 * 2, row0 = chunk * 128 + rl0;
            f32x4 v[2][4]; float s[2], s2[2];
#pragma unroll
            for (int r = 0; r < 2; ++r) { const f32x4* xr = (const f32x4*)(resid + (size_t)(row0 + r) * DM) + lane; const u32x2* xb = (const u32x2*)(residb + (size_t)(row0 + r) * DM) + lane;
                const u32x2* mr = (const u32x2*)(MIX + (size_t)(row0 + r) * DM) + lane; s[r] = 0.f;
#pragma unroll
                for (int j = 0; j < 4; ++j) { const u32x2 w = mr[64 * j]; f32x4 xv;
                    if (layer) { const u32x2 q = xb[64 * j]; xv = (f32x4){bflo(q.x), bfhi(q.x), bflo(q.y), bfhi(q.y)}; } else xv = xr[64 * j];
                    v[r][j] = xv * DN_ALPHA + (f32x4){bflo(w.x), bfhi(w.x), bflo(w.y), bfhi(w.y)};
                    s[r] += (v[r][j][0] + v[r][j][1]) + (v[r][j][2] + v[r][j][3]); } }
#pragma unroll
            for (int o = 1; o < 64; o <<= 1) { s[0] += __shfl_xor(s[0], o); s[1] += __shfl_xor(s[1], o); }
#pragma unroll
            for (int r = 0; r < 2; ++r) { const float mean = s[r] * (1.f / DM); s2[r] = 0.f;
#pragma unroll
                for (int j = 0; j < 4; ++j) { v[r][j] = v[r][j] - mean; s2[r] += (v[r][j][0] * v[r][j][0] + v[r][j][1] * v[r][j][1]) + (v[r][j][2] * v[r][j][2] + v[r][j][3] * v[r][j][3]); } }
#pragma unroll
            for (int o = 1; o < 64; o <<= 1) { s2[0] += __shfl_xor(s2[0], o); s2[1] += __shfl_xor(s2[1], o); }
            const float rstd0 = 1.f / sqrtf(s2[0] * (1.f / DM) + LN_EPS), rstd1 = 1.f / sqrtf(s2[1] * (1.f / DM) + LN_EPS);
            float p[32];
#pragma unroll
            for (int q = 0; q < 32; ++q) p[q] = 0.f;
#pragma unroll
            for (int j = 0; j < 4; ++j) {
                const int c0 = 4 * lane + 256 * j;
                const f32x4 gg = *(const f32x4*)(lg + c0), bb = *(const f32x4*)(lb + c0);
#pragma unroll
                for (int r = 0; r < 2; ++r) {
                    v[r][j] = v[r][j] * (r ? rstd1 : rstd0) * gg + bb;
                    *(u32x2*)(X1B + (size_t)(row0 + r) * DM + c0) = (u32x2){pk2(v[r][j][0], v[r][j][1]), pk2(v[r][j][2], v[r][j][3])}; }
#pragma unroll
                for (int q = 0; q < 4; ++q) {
                    const LAS f32x4* wr = (const LAS f32x4*)(rwl + j * 17408 + lane * 272 + q * 64);
                    const f32x4 w0 = wr[0], w1 = wr[1], w2 = wr[2], w3 = wr[3];
#pragma unroll
                    for (int r = 0; r < 2; ++r) { const float x = v[r][j][q];
                        p[16 * r + 0] += x * w0[0]; p[16 * r + 1] += x * w0[1]; p[16 * r + 2] += x * w0[2]; p[16 * r + 3] += x * w0[3];
                        p[16 * r + 4] += x * w1[0]; p[16 * r + 5] += x * w1[1]; p[16 * r + 6] += x * w1[2]; p[16 * r + 7] += x * w1[3];
                        p[16 * r + 8] += x * w2[0]; p[16 * r + 9] += x * w2[1]; p[16 * r + 10] += x * w2[2]; p[16 * r + 11] += x * w2[3];
                        p[16 * r + 12] += x * w3[0]; p[16 * r + 13] += x * w3[1]; p[16 * r + 14] += x * w3[2]; p[16 * r + 15] += x * w3[3]; }
                    if (q == 3) asm volatile("" ::: "memory");
                }
            }
#define TRED(N, M) { const bool up = (lane & (M)) != 0; _Pragma("unroll") for (int q = 0; q < (N); ++q) { const float keep = up ? p[q + (N)] : p[q], send = up ? p[q] : p[q + (N)]; p[q] = keep + __shfl_xor(send, (M)); } }
            TRED(16, 32) TRED(8, 16) TRED(4, 8) TRED(2, 4) TRED(1, 2)
#undef TRED
            p[0] += __shfl_xor(p[0], 1);
            const float sc_own = 1.0f / (1.0f + expf(-p[0]));
            if ((lane & 1) == 0) { lsb[lane >> 1] = sc_own; lsb[32 + (lane >> 1)] = sc_own + rb[(lane >> 1) & 15]; }
            WAVE_LDS_SYNC();
            float sc[16], bi[16];
            { const LAS f32x4* a4 = (const LAS f32x4*)(lsb + ((lane >> 5) << 4)); const LAS f32x4* b4 = (const LAS f32x4*)(lsb + 32 + ((lane >> 5) << 4));
#pragma unroll
              for (int q = 0; q < 4; ++q) { const f32x4 x = a4[q], y = b4[q]; sc[4 * q] = x[0]; sc[4 * q + 1] = x[1]; sc[4 * q + 2] = x[2]; sc[4 * q + 3] = x[3]; bi[4 * q] = y[0]; bi[4 * q + 1] = y[1]; bi[4 * q + 2] = y[2]; bi[4 * q + 3] = y[3]; } }
            WAVE_LDS_SYNC();
            int gsel = 0; float gbest = -3e38f;
#pragma unroll
            for (int gq = 0; gq < 4; ++gq) {
                float m1 = -3e38f, m2 = -3e38f;
#pragma unroll
                for (int q = 0; q < 4; ++q) { const float x = bi[4 * gq + q]; if (x > m1) { m2 = m1; m1 = x; } else if (x > m2) m2 = x; }
                const float gs = m1 + m2; if (gs > gbest) { gbest = gs; gsel = gq; }
            }
            int e0 = 0, e1 = 0; float b0 = -3e38f, b1 = -3e38f, w0 = 0.f, w1 = 0.f;
#pragma unroll
            for (int e = 0; e < 16; ++e) {
                if ((e >> 2) == gsel) {
                    const float x = bi[e];
                    if (x > b0) { b1 = b0; e1 = e0; w1 = w0; b0 = x; e0 = e; w0 = sc[e]; }
                    else if (x > b1) { b1 = x; e1 = e; w1 = sc[e]; }
                }
            }
            if ((lane & 31) == 0) {
                const int rl = rl0 + (lane >> 5);
                const float ws_ = w0 + w1;
                const unsigned l0 = __hip_atomic_fetch_add(lcnt + e0, 1u, __ATOMIC_RELAXED, __HIP_MEMORY_SCOPE_WORKGROUP), l1 = __hip_atomic_fetch_add(lcnt + e1, 1u, __ATOMIC_RELAXED, __HIP_MEMORY_SCOPE_WORKGROUP);
                LAS float* r = rec + rl * 6; r[0] = __int_as_float(e0); r[1] = __int_as_float(e1); r[2] = __uint_as_float(l0); r[3] = __uint_as_float(l1); r[4] = w0 / ws_; r[5] = w1 / ws_;
            }
        }
        __syncthreads();
        if (C.tid < 16) lcnt[16 + C.tid] = atomicAdd(cnt + 64 * C.tid, lcnt[C.tid]);
        __syncthreads();
        if (C.tid < 128) {
            const LAS float* r = rec + C.tid * 6; const int row = chunk * 128 + C.tid;
            const int e0 = __float_as_int(r[0]), e1 = __float_as_int(r[1]);
            const int s0 = (int)(lcnt[16 + e0] + __float_as_uint(r[2])), s1 = (int)(lcnt[16 + e1] + __float_as_uint(r[3]));
            rowlist[e0 * NTOK + s0] = row; rowlist[e1 * NTOK + s1] = row;
            Route rr; rr.e0 = e0; rr.s0 = s0; rr.e1 = e1; rr.s1 = s1; rr.w0 = r[4]; rr.w1 = r[5]; rr.pad0 = 0; rr.pad1 = 0;
            RT[row] = rr;
        }
        __syncthreads();
    }
}
__device__ __forceinline__ void ph_combine(const Ctx& C, int layer, float* outp, LAS int* sm) {
    const bf16_t* X1B = (const bf16_t*)(C.ws + WS_X1B); const bf16_t* Y2 = (const bf16_t*)(C.ws + WS_Y2); const Route* RT = (const Route*)(C.ws + WS_ROUTE);
    bf16_t* XB = (bf16_t*)(C.ws + WS_XB);
    const float* lg = C.in[I_LNG] + (size_t)(layer * 2 + 1) * DM; const float* lb = C.in[I_LNB] + (size_t)(layer * 2 + 1) * DM;
    const int gw = C.bid * NWAVES + C.wave, NGW = C.nb * NWAVES, lane = C.lane;
    for (int row = gw; row < NTOK; row += NGW) {
        const Route r = RT[row];
        const bf16_t* y0 = Y2 + (size_t)(sm[16 + r.e0] + r.s0) * DM; const bf16_t* y1 = Y2 + (size_t)(sm[16 + r.e1] + r.s1) * DM;
        const u32x2* xr = (const u32x2*)(X1B + (size_t)row * DM) + lane;
        f32x4 v[4]; float s = 0.f;
#pragma unroll
        for (int j = 0; j < 4; ++j) {
            const int c0 = 4 * lane + 256 * j;
            const u32x2 a = *(const u32x2*)(y0 + c0), b = *(const u32x2*)(y1 + c0), x = xr[64 * j];
            const f32x4 ya = (f32x4){bflo(a.x), bfhi(a.x), bflo(a.y), bfhi(a.y)}, yb = (f32x4){bflo(b.x), bfhi(b.x), bflo(b.y), bfhi(b.y)}, xv = (f32x4){bflo(x.x), bfhi(x.x), bflo(x.y), bfhi(x.y)};
            v[j] = xv * DN_ALPHA + ya * r.w0 + yb * r.w1;
            s += (v[j][0] + v[j][1]) + (v[j][2] + v[j][3]);
        }
        const float mean = wave_sum(s) * (1.f / DM); float s2 = 0.f;
#pragma unroll
        for (int j = 0; j < 4; ++j) { v[j] = v[j] - mean; s2 += (v[j][0] * v[j][0] + v[j][1] * v[j][1]) + (v[j][2] * v[j][2] + v[j][3] * v[j][3]); }
        const float rstd = 1.f / sqrtf(wave_sum(s2) * (1.f / DM) + LN_EPS);
#pragma unroll
        for (int j = 0; j < 4; ++j) {
            const int c0 = 4 * lane + 256 * j;
            const f32x4 gg = *(const f32x4*)(lg + c0), bb = *(const f32x4*)(lb + c0);
            v[j] = v[j] * rstd * gg + bb;
            if (layer) *(f32x4*)(outp + (size_t)row * DM + c0) = v[j];
            else *(u32x2*)(XB + (size_t)row * DM + c0) = (u32x2){pk2(v[j][0], v[j][1]), pk2(v[j][2], v[j][3])};
        }
    }
}

__device__ __forceinline__ void ph_kmean(const Ctx& C) {
    const bf16_t* K1 = (const bf16_t*)(C.ws + WS_K1); float* KM = (float*)(C.ws + WS_KMEAN); float* KB2 = (float*)(C.ws + WS_KB2);
    const int gw = C.bid * NWAVES + C.wave, NGW = C.nb * NWAVES, lane = C.lane;
    for (int it = gw; it < NB * NH * 32; it += NGW) {
        const bf16_t* p = K1 + (size_t)it * 256 * DH + lane; float s = 0.f, mx = 0.f;
#pragma unroll 8
        for (int j = 0; j < 256; ++j) { const float v = bf2f(p[j * DH]); s += v; mx = fmaxf(mx, fabsf(v)); }
        KM[(size_t)it * DH + lane] = s * (1.0f / 256.0f);
        const float b2 = wave_sum(mx * mx);
        if (lane == 0) KB2[it] = b2;
    }
}
constexpr int NPHASE = 21;
__global__ void __launch_bounds__(NTHREADS, 2) fwd(Args args) {
    extern __shared__ __attribute__((aligned(16))) unsigned char lds[];
    Ctx C;
#pragma unroll
    for (int i = 0; i < 18; ++i) C.in[i] = args.in[i];
    C.out = args.out; C.ws = args.ws; C.lds = lds;
    C.tid = threadIdx.x; C.lane = C.tid & 63; C.wave = __builtin_amdgcn_readfirstlane(C.tid >> 6); C.bid = blockIdx.x; C.nb = gridDim.x;
    LAS unsigned* misc = (LAS unsigned*)(lds + LDS_BYTES - 512);
    LAS int* sm = (LAS int*)(misc + 16);
    if (C.tid < 4) misc[C.tid] = 0u;
    __syncthreads();
#if MK_SINGLE
    XcdBarrier bar = xcd_barrier_post((unsigned*)(C.ws + WS_CTL) + CW_BAR, (volatile LAS unsigned*)misc);
#define SEAM() xcd_barrier(bar)
#else
#define SEAM() do {} while (0)
#endif
    const int lo = args.ph_lo, hi = args.ph_hi;
#ifndef PH_MASK
#define PH_MASK 0xFFFFFFFFu
#endif
#define IN(k) (((PH_MASK >> (k)) & 1u) && lo <= (k) && (k) < hi)
#define BOTH(k) (IN(k) && IN((k) + 1))
#if defined(STAMP_LO)
    unsigned long long st0 = 0, st1 = 0;
#define TS(k) do { if ((k) == STAMP_LO) st0 = __builtin_amdgcn_s_memrealtime(); if ((k) == STAMP_HI) st1 = __builtin_amdgcn_s_memrealtime(); } while (0)
#else
#define TS(k) do {} while (0)
#endif
    unsigned char* ws = C.ws;
    const float2* rope = (const float2*)(ws + WS_ROPE);
    LAS unsigned char* L = (LAS unsigned char*)lds;

    TS(0); if (IN(0)) { ph_prologue(C); if (BOTH(0)) SEAM(); }
    TS(1); if (IN(1)) {
        EpiNsaIn E{(bf16_t*)(ws + WS_Q), (bf16_t*)(ws + WS_KV0), (float*)(ws + WS_GATES), rope};
        g8::StaticOrder S; S.init(NTOK / 256, 2560 / 256, C.nb, C.bid);
        g8::gemm8<false>(L, (const bf16_t*)(ws + WS_XB), DM, (const bf16_t*)(ws + WS_WT_NSA_IN), DM, S, g8::EpiEl<EpiNsaIn>{E}, g8::GatherInfo{nullptr, sm});
        if (BOTH(1)) SEAM();
    }
    TS(2); if (IN(2)) {
        EpiCmp EK{(const float*)(ws + WS_BIAS1), (const bf16_t*)(ws + WS_W2T), rope, (bf16_t*)(ws + WS_KC)}, EV{(const float*)(ws + WS_BIAS1) + 256, (const bf16_t*)(ws + WS_W2T) + 64 * 256, nullptr, (bf16_t*)(ws + WS_VC)};
        g8::StaticOrder SK, SV; SK.init(32, 1, C.nb, C.bid); SV.init(32, 1, C.nb, (C.bid + C.nb / 2) % C.nb);
        g8::gemm8<false>(L, (const bf16_t*)(ws + WS_KV0), 1024, (const bf16_t*)(ws + WS_WT_C1K), 2048, SK, EK, g8::GatherInfo{nullptr, sm});
        g8::gemm8<false>(L, (const bf16_t*)(ws + WS_KV0 + KVSEG), 1024, (const bf16_t*)(ws + WS_WT_C1V), 2048, SV, EV, g8::GatherInfo{nullptr, sm});
        if (C.nb == 256 && !((C.bid < 32) || (C.bid >= 128 && C.bid < 160))) {
            EpiNsaIn E{(bf16_t*)(ws + WS_Q), (bf16_t*)(ws + WS_KV0), (float*)(ws + WS_GATES), rope};
            const int gidx = C.bid < 128 ? C.bid - 32 : C.bid - 64, fr = C.lane & 15, fq = C.lane >> 4;
            for (int tile = gidx * NWAVES + C.wave; tile < 2048; tile += 192 * NWAVES) {
                const int row0 = (tile >> 1) * 32, col0 = 2560 + (tile & 1) * 32;
                const bf16_t* a0 = (const bf16_t*)(ws + WS_XB) + (size_t)(row0 + fr) * DM + fq * 8; const bf16_t* a1 = a0 + (size_t)16 * DM;
                const bf16_t* b0 = (const bf16_t*)(ws + WS_WT_NSA_IN) + (size_t)(col0 + fr) * DM + fq * 8; const bf16_t* b1 = b0 + (size_t)16 * DM;
                f32x4 acc[2][2]; mma_core(a0, a1, b0, b1, DM, acc);
#pragma unroll
                for (int mi = 0; mi < 2; ++mi)
#pragma unroll
                    for (int ni = 0; ni < 2; ++ni) E(row0 + 16 * mi + fr, col0 + 16 * ni + 4 * fq, acc[mi][ni]);
            }
        } else if (C.nb != 256) {
            EpiNsaIn E{(bf16_t*)(ws + WS_Q), (bf16_t*)(ws + WS_KV0), (float*)(ws + WS_GATES), rope};
            const int fr = C.lane & 15, fq = C.lane >> 4;
            for (int tile = C.bid * NWAVES + C.wave; tile < 2048; tile += C.nb * NWAVES) {
                const int row0 = (tile >> 1) * 32, col0 = 2560 + (tile & 1) * 32;
                const bf16_t* a0 = (const bf16_t*)(ws + WS_XB) + (size_t)(row0 + fr) * DM + fq * 8; const bf16_t* a1 = a0 + (size_t)16 * DM;
                const bf16_t* b0 = (const bf16_t*)(ws + WS_WT_NSA_IN) + (size_t)(col0 + fr) * DM + fq * 8; const bf16_t* b1 = b0 + (size_t)16 * DM;
                f32x4 acc[2][2]; mma_core(a0, a1, b0, b1, DM, acc);
#pragma unroll
                for (int mi = 0; mi < 2; ++mi)
#pragma unroll
                    for (int ni = 0; ni < 2; ++ni) E(row0 + 16 * mi + fr, col0 + 16 * ni + 4 * fq, acc[mi][ni]);
            }
        }
        if (BOTH(2)) SEAM();
    }
    TS(4); if (IN(4)) { ph_nsa_fa(C); if (BOTH(4)) SEAM(); }
    TS(6); if (IN(6)) {
        EpiBf16 E{(bf16_t*)(ws + WS_MIX)};
        g8::StaticOrder S; S.init(NTOK / 256, DM / 256, C.nb, C.bid);
        g8::gemm8<false>(L, (const bf16_t*)(ws + WS_Q), DM, (const bf16_t*)(ws + WS_WT_NSA_OUT), DM, S, g8::EpiEl<EpiBf16>{E}, g8::GatherInfo{nullptr, sm});
        if (BOTH(6)) SEAM();
    }
    TS(7); if (IN(7)) { ph_ln_route(C, 0); if (BOTH(7)) SEAM(); }
    TS(8); if (IN(8)) {
        load_expert_map(C, CW_CNT0, sm);
        EpiSwiGLU E{(bf16_t*)(ws + WS_HBUF)};
        g8::GroupedOrder S; S.init(sm, 4, C.nb, C.bid);
        g8::gemm8<true>(L, (const bf16_t*)(ws + WS_X1B), DM, (const bf16_t*)(ws + WS_WT_GU), 1024, S, g8::EpiEl<EpiSwiGLU>{E}, g8::GatherInfo{(const int*)(ws + WS_ROWLIST), sm});
        if (BOTH(8)) SEAM();
    }
    TS(9); if (IN(9)) {
        load_expert_map(C, CW_CNT0, sm);
        EpiBf16 E{(bf16_t*)(ws + WS_Y2)};
        g8::GroupedOrder S; S.init(sm, 4, C.nb, C.bid);
        g8::gemm8<false>(L, (const bf16_t*)(ws + WS_HBUF), DE, (const bf16_t*)(ws + WS_WT_DN), DE, S, g8::EpiEl<EpiBf16>{E}, g8::GatherInfo{nullptr, sm});
        if (BOTH(9)) SEAM();
    }
    TS(10); if (IN(10)) {
        load_expert_map(C, CW_CNT0, sm);
        ph_combine(C, 0, (float*)(ws + WS_XR), sm);
        if (BOTH(10)) SEAM();
    }
    TS(11); if (IN(11)) {
        EpiMobaIn E{(bf16_t*)(ws + WS_Q), (bf16_t*)(ws + WS_K1), (bf16_t*)(ws + WS_V1), rope};
        g8::StaticOrder S; S.init(NTOK / 256, 3072 / 256, C.nb, C.bid);
        g8::gemm8<false>(L, (const bf16_t*)(ws + WS_XB), DM, (const bf16_t*)(ws + WS_WT_MOBA_IN), DM, S, g8::EpiEl<EpiMobaIn>{E}, g8::GatherInfo{nullptr, sm});
        if (BOTH(11)) SEAM();
    }
    TS(12); if (IN(12)) { ph_kmean(C); if (BOTH(12)) SEAM(); }
    TS(13); if (IN(13)) { ph_moba_sel(C); if (BOTH(13)) SEAM(); }
    TS(14); if (IN(14)) { ph_moba_gather(C); if (BOTH(14)) SEAM(); }
    TS(15); if (IN(15)) { ph_moba_own(C); if (BOTH(15)) SEAM(); }
    TS(16); if (IN(16)) {
        EpiBf16 E{(bf16_t*)(ws + WS_MIX)};
        g8::StaticOrder S; S.init(NTOK / 256, DM / 256, C.nb, C.bid);
        g8::gemm8<false>(L, (const bf16_t*)(ws + WS_Q), DM, (const bf16_t*)(ws + WS_WT_MOBA_OUT), DM, S, g8::EpiEl<EpiBf16>{E}, g8::GatherInfo{nullptr, sm});
        if (BOTH(16)) SEAM();
    }
    TS(17); if (IN(17)) {
        ph_ln_route(C, 1);
        __syncthreads();
        { float* scr = (float*)(C.lds + C.wave * 9216); const int gw = C.bid * NWAVES + C.wave, NGW = C.nb * NWAVES;
          for (int it = gw; it < MOE_W_ITEMS; it += NGW) moe_weight_item(C, 1, it, scr); }
        if (BOTH(17)) SEAM();
    }
    TS(18); if (IN(18)) {
        load_expert_map(C, CW_CNT1, sm);
        EpiSwiGLU E{(bf16_t*)(ws + WS_HBUF)};
        g8::GroupedOrder S; S.init(sm, 4, C.nb, C.bid);
        g8::gemm8<true>(L, (const bf16_t*)(ws + WS_X1B), DM, (const bf16_t*)(ws + WS_WT_GU), 1024, S, g8::EpiEl<EpiSwiGLU>{E}, g8::GatherInfo{(const int*)(ws + WS_ROWLIST), sm});
        if (BOTH(18)) SEAM();
    }
    TS(19); if (IN(19)) {
        load_expert_map(C, CW_CNT1, sm);
        EpiBf16 E{(bf16_t*)(ws + WS_Y2)};
        g8::GroupedOrder S; S.init(sm, 4, C.nb, C.bid);
        g8::gemm8<false>(L, (const bf16_t*)(ws + WS_HBUF), DE, (const bf16_t*)(ws + WS_WT_DN), DE, S, g8::EpiEl<EpiBf16>{E}, g8::GatherInfo{nullptr, sm});
        if (BOTH(19)) SEAM();
    }
    TS(20); if (IN(20)) {
        load_expert_map(C, CW_CNT1, sm);
        ph_combine(C, 1, C.out, sm);
    }
#if defined(STAMP_LO)
    TS(NPHASE);
    if (C.bid == 0) { const unsigned long long d = (st1 - st0) * STAMP_MUL, te = __builtin_amdgcn_s_memrealtime(); while (__builtin_amdgcn_s_memrealtime() - te < d) __builtin_amdgcn_s_sleep(8); }
#endif
#undef IN
#undef BOTH
}

extern "C" void kernel_launch(void* const* d_in, const int* in_sizes, int n_in, void* d_out, int out_size, void* d_ws, size_t ws_size, hipStream_t stream) {
    static int grid = 0;
    if (grid == 0) {
        if (n_in != 18 || in_sizes[0] != NTOK * DM || out_size != NTOK * DM || ws_size < WS_END) {
            fprintf(stderr, "kernel_launch: unexpected shapes (n_in %d, in0 %d, out %d, ws %zu; need ws >= %zu); nothing launched\n", n_in, n_in > 0 ? in_sizes[0] : -1, out_size, ws_size, (size_t)WS_END);
            grid = -1; return;
        }
        int dev = 0, cus = 0, per_cu = 0;
        if (hipGetDevice(&dev) != hipSuccess || hipDeviceGetAttribute(&cus, hipDeviceAttributeMultiprocessorCount, dev) != hipSuccess) { grid = -1; return; }
        if (hipFuncSetAttribute((const void*)fwd, hipFuncAttributeMaxDynamicSharedMemorySize, LDS_BYTES) != hipSuccess) { fprintf(stderr, "kernel_launch: hipFuncSetAttribute failed\n"); grid = -1; return; }
        if (hipOccupancyMaxActiveBlocksPerMultiprocessor(&per_cu, (const void*)fwd, NTHREADS, LDS_BYTES) != hipSuccess || per_cu < 1)
            fprintf(stderr, "kernel_launch: occupancy query reports %d blocks per CU\n", per_cu);
        (void)hipGetLastError();
        grid = cus;
        if (grid != 256) { fprintf(stderr, "kernel_launch: built for a 256-CU device (got %d CUs); nothing launched\n", cus); grid = -1; return; }
    }
    if (grid < 0) return;
    if (hipMemsetAsync((char*)d_ws + WS_CTL, 0, CTL_BYTES, stream) != hipSuccess) { fprintf(stderr, "kernel_launch: memset failed\n"); return; }
    Args a{};
    for (int i = 0; i < 18; ++i) a.in[i] = (const float*)d_in[i];
    a.out = (float*)d_out; a.ws = (unsigned char*)d_ws;
#if defined(PROBE_PH)
    { const int lo3[3] = {0, PROBE_PH, PROBE_PH + 1}, hi3[3] = {PROBE_PH + 1, PROBE_PH + 1, NPHASE};
      for (int q = 0; q < 3; ++q) { if (lo3[q] >= hi3[q]) continue;
          if (q) (void)hipMemsetAsync((char*)d_ws + WS_CTL + CW_BAR * 4, 0, XCD_BAR_WORDS * 4, stream);
          a.ph_lo = lo3[q]; a.ph_hi = hi3[q]; hipLaunchKernelGGL(fwd, dim3(grid), dim3(NTHREADS), LDS_BYTES, stream, a); } }
#elif MK_SINGLE
    a.ph_lo = 0; a.ph_hi = NPHASE;
    hipLaunchKernelGGL(fwd, dim3(grid), dim3(NTHREADS), LDS_BYTES, stream, a);
#else
    for (int p = 0; p < NPHASE; ++p) { a.ph_lo = p; a.ph_hi = p + 1; hipLaunchKernelGGL(fwd, dim3(grid), dim3(NTHREADS), LDS_BYTES, stream, a); }
#endif
    const hipError_t le = hipPeekAtLastError();
    if (le != hipSuccess) fprintf(stderr, "kernel_launch: launch failed: %s\n", hipGetErrorName(le));
}
```

```cpp
#include <hip/hip_runtime.h>
#include <cstdio>
#include <cstdint>

#ifndef SEL_FUSED
#define SEL_FUSED 1
#endif
#ifndef MK_SINGLE
#define MK_SINGLE 1
#endif

#define LAS __attribute__((address_space(3)))
typedef unsigned short bf16_t;
typedef short bf16x8 __attribute__((ext_vector_type(8)));
typedef float f32x4 __attribute__((ext_vector_type(4)));
typedef unsigned u32x4 __attribute__((ext_vector_type(4)));
typedef unsigned u32x2 __attribute__((ext_vector_type(2)));

constexpr int NB = 4, SEQ = 8192, NTOK = NB * SEQ, DM = 1024, NH = 16, DH = 64, NG = 4;
constexpr int NSA_IN = 2608, NSA_INP = 2816;
constexpr int NE = 16, DE = 512;
constexpr float DN_ALPHA = 1.4142135623730951f;
constexpr float LN_EPS = 1e-5f;
constexpr int NWAVES = 8, NTHREADS = 512;
constexpr float QSCALE = 0.125f * 1.4426950408889634f;
constexpr int LDS_BYTES = 163840;
constexpr int ROWCAP = 2 * NTOK + NE * 256;

constexpr size_t MiB = 1u << 20;
constexpr size_t WS_CTL = 0, CTL_BYTES = 1 * MiB;
constexpr size_t WS_ROPE = 1 * MiB;
constexpr size_t WS_BIAS1 = 3 * MiB;
constexpr size_t WS_W2T = 3 * MiB + 4096;
constexpr size_t WS_KMP = 4 * MiB;
constexpr size_t WS_KMX = 5 * MiB;
constexpr size_t WS_ROUTE = 5 * MiB;
constexpr size_t WS_ROWLIST = 6 * MiB;
constexpr size_t WS_SEL = 8 * MiB;
constexpr size_t WS_GATES = 10 * MiB;
constexpr size_t WS_KC = 25 * MiB, WS_VC = 26 * MiB;
constexpr size_t WS_WT_NSA_IN = 27 * MiB;
constexpr size_t WS_WT_NSA_OUT = 33 * MiB;
constexpr size_t WS_WT_C1K = 35 * MiB, WS_WT_C1V = 36 * MiB;
constexpr size_t WS_WT_MOBA_IN = 37 * MiB;
constexpr size_t WS_WT_MOBA_OUT = 43 * MiB;
constexpr size_t WS_WT_GU = 45 * MiB;
constexpr size_t WS_WT_DN = 77 * MiB;
constexpr size_t WS_WT_GU1 = 433 * MiB, WS_WT_DN1 = 465 * MiB;
constexpr size_t WS_XB = 93 * MiB;
constexpr size_t WS_ATTN = 161 * MiB;
constexpr size_t WS_Q = WS_ATTN;
constexpr size_t WS_KV0 = WS_ATTN + 64 * MiB;
constexpr size_t KVSEG = 16 * MiB;
constexpr size_t WS_K1 = WS_ATTN + 64 * MiB, WS_V1 = WS_ATTN + 128 * MiB;
constexpr size_t WS_X1B = 353 * MiB;
constexpr size_t WS_MIX = WS_ATTN + 64 * MiB;
constexpr size_t WS_Y2 = WS_ATTN;
constexpr size_t WS_HBUF = WS_XB;
constexpr size_t WS_XR = 353 * MiB;
constexpr size_t WS_END = 481 * MiB;
static_assert((size_t)ROWCAP * 512 * 2 <= 68 * MiB && (size_t)ROWCAP * 1024 * 2 <= 192 * MiB, "overlay sizes");

constexpr int CW_TMO = 0;
constexpr int CW_CNT0 = 1024, CW_CNT1 = 2048;
constexpr int CW_BAR = 8192;

__device__ __forceinline__ unsigned f2bf(float f) { unsigned u = __float_as_uint(f); return (u + 0x7fffu + ((u >> 16) & 1u)) >> 16; }
typedef float f32x2v __attribute__((ext_vector_type(2)));
typedef __bf16 bf16x2v __attribute__((ext_vector_type(2)));
__device__ __forceinline__ unsigned pk2(float lo, float hi) { const f32x2v v = {lo, hi}; const bf16x2v b = __builtin_convertvector(v, bf16x2v); return __builtin_bit_cast(unsigned, b); }
__device__ __forceinline__ float bflo(unsigned u) { return __uint_as_float(u << 16); }
__device__ __forceinline__ float bfhi(unsigned u) { return __uint_as_float(u & 0xffff0000u); }
__device__ __forceinline__ float bf2f(bf16_t b) { return __uint_as_float((unsigned)b << 16); }
#define DPPF(x, ctrl) __builtin_bit_cast(float, __builtin_amdgcn_mov_dpp(__builtin_bit_cast(int, (x)), (ctrl), 0xf, 0xf, true))
__device__ __forceinline__ float wave_sum(float v) {
    v += DPPF(v, 0xB1); v += DPPF(v, 0x4E); v += DPPF(v, 0x141); v += DPPF(v, 0x140);
    { const auto s = __builtin_amdgcn_permlane16_swap(__float_as_uint(v), __float_as_uint(v), false, false); v = __uint_as_float(s[0]) + __uint_as_float(s[1]); }
    { const auto t = __builtin_amdgcn_permlane32_swap(__float_as_uint(v), __float_as_uint(v), false, false); v = __uint_as_float(t[0]) + __uint_as_float(t[1]); }
    return v;
}
__device__ __forceinline__ float wave_max(float v) {
    v = fmaxf(v, DPPF(v, 0xB1)); v = fmaxf(v, DPPF(v, 0x4E)); v = fmaxf(v, DPPF(v, 0x141)); v = fmaxf(v, DPPF(v, 0x140));
    { const auto s = __builtin_amdgcn_permlane16_swap(__float_as_uint(v), __float_as_uint(v), false, false); v = fmaxf(__uint_as_float(s[0]), __uint_as_float(s[1])); }
    { const auto t = __builtin_amdgcn_permlane32_swap(__float_as_uint(v), __float_as_uint(v), false, false); v = fmaxf(__uint_as_float(t[0]), __uint_as_float(t[1])); }
    return v;
}
__device__ __forceinline__ unsigned lane_xor16(unsigned x, int lane) { const auto s = __builtin_amdgcn_permlane16_swap(x, x, false, false); return (lane & 16) ? s[0] : s[1]; }
__device__ __forceinline__ unsigned lane_xor32(unsigned x, int lane) { const auto s = __builtin_amdgcn_permlane32_swap(x, x, false, false); return (lane & 32) ? s[0] : s[1]; }
#define WAVE_LDS_SYNC() asm volatile("s_waitcnt lgkmcnt(0)" ::: "memory")
__device__ __forceinline__ float sigmoidf_(float x) { return __builtin_amdgcn_rcpf(1.0f + __expf(-x)); }
__device__ __forceinline__ float gelu_tanh(float x) {
    const float u = 0.7978845608028654f * (x + 0.044715f * x * x * x);
    const float t = 1.0f - 2.0f * __builtin_amdgcn_rcpf(__expf(2.0f * u) + 1.0f);
    return 0.5f * x * (1.0f + t);
}

#define XB_TMO      128
#define XB_XCNT(j)  (256  + 64 * (j))
#define XB_XSUB(j)  (1280 + 64 * (j))
#define XB_XGEN(j)  (2304 + 64 * (j))
#define XB_TOP      3328
#define XB_TOPGEN   3392
#define XCD_BAR_WORDS 3456
#define XB_SPIN_CAP (1u << 22)
__device__ __forceinline__ unsigned xb_ld(unsigned* p)              { return __hip_atomic_load(p, __ATOMIC_RELAXED, __HIP_MEMORY_SCOPE_AGENT); }
__device__ __forceinline__ unsigned xb_add(unsigned* p, unsigned v) { return __hip_atomic_fetch_add(p, v, __ATOMIC_RELAXED, __HIP_MEMORY_SCOPE_AGENT); }
__device__ __forceinline__ unsigned xb_xcc_id() { return (unsigned)__builtin_amdgcn_s_getreg((3 << 11) | 20) & 0xFu; }
#define XB_SPIN(cond, bar) do { unsigned _sp = 0; while (cond) { __builtin_amdgcn_s_sleep(1); \
    if ((++_sp & 255u) == 0u) { if (xb_ld(&(bar)[XB_TMO])) break; if (_sp > XB_SPIN_CAP) { atomicAdd(&(bar)[XB_TMO], 1u); break; } } } } while (0)
struct XcdBarrier { unsigned* bar; unsigned x; volatile LAS unsigned* st; };
__device__ __forceinline__ XcdBarrier xcd_barrier_post(unsigned* bar, volatile LAS unsigned* st) {
    XcdBarrier b; b.bar = bar; b.x = xb_xcc_id(); b.st = st;
    if (threadIdx.x == 0) (void)xb_add(&bar[XB_XCNT(b.x)], 1u);
    return b;
}
__device__ __forceinline__ void xcd_barrier_complete(unsigned* bar, unsigned x, unsigned& nloc, unsigned& nx) {
    const unsigned G = gridDim.x * gridDim.y * gridDim.z;
    unsigned sum, cnt, mine, sp = 0u;
    for (;;) {
        sum = 0u; cnt = 0u; mine = 0u;
#pragma unroll
        for (unsigned j = 0; j < 16; ++j) { const unsigned c = xb_ld(&bar[XB_XCNT(j)]); sum += c; cnt += (c > 0u) ? 1u : 0u; mine = (j == x) ? c : mine; }
        if (sum == G) break;
        __builtin_amdgcn_s_sleep(1);
        if ((++sp & 255u) == 0u) { if (xb_ld(&bar[XB_TMO])) break; if (sp > XB_SPIN_CAP) { atomicAdd(&bar[XB_TMO], 1u); break; } }
    }
    nloc = mine > 0u ? mine : 1u; nx = cnt > 0u ? cnt : 1u;
}
__device__ __forceinline__ void xcd_barrier(const XcdBarrier& b) {
    asm volatile("s_waitcnt vmcnt(0)" ::: "memory");
    __syncthreads();
    if (threadIdx.x == 0) {
        unsigned* bar = b.bar;
        __builtin_amdgcn_s_waitcnt(0);
        unsigned nloc = b.st[0], nx = b.st[1];
        if (nloc == 0u) { xcd_barrier_complete(bar, b.x, nloc, nx); b.st[0] = nloc; b.st[1] = nx; }
        const unsigned old = xb_add(&bar[XB_XSUB(b.x)], 1u);
        const unsigned gen = old / nloc;
        if (old + 1u == (gen + 1u) * nloc) {
            __builtin_amdgcn_fence(__ATOMIC_RELEASE, "agent");
            asm volatile("s_waitcnt vmcnt(0)" ::: "memory");
            const unsigned og = xb_add(&bar[XB_TOP], 1u);
            const unsigned tg = og / nx;
            if (og + 1u == (tg + 1u) * nx) xb_add(&bar[XB_TOPGEN], 1u);
            else XB_SPIN(xb_ld(&bar[XB_TOPGEN]) == tg, bar);
            __builtin_amdgcn_fence(__ATOMIC_ACQUIRE, "agent");
            xb_add(&bar[XB_XGEN(b.x)], 1u);
            asm volatile("s_waitcnt vmcnt(0)" ::: "memory");
        } else {
            XB_SPIN(xb_ld(&bar[XB_XGEN(b.x)]) == gen, bar);
            __builtin_amdgcn_fence(__ATOMIC_ACQUIRE, "agent");
            asm volatile("s_waitcnt vmcnt(0)" ::: "memory");
        }
    }
    __syncthreads();
}

struct Args { const float* in[18]; float* out; unsigned char* ws; int ph_lo, ph_hi; };
struct Ctx {
    const float* in[18]; float* out; unsigned char* ws; unsigned char* lds;
    int tid, lane, wave, bid, nb;
};
enum { I_X = 0, I_NSA_WIN, I_NSA_WOUT, I_CK_W1, I_CK_W2, I_CV_W1, I_CV_W2, I_CK_POS, I_CV_POS, I_MOBA_WIN, I_MOBA_WOUT, I_RW, I_RB, I_WG, I_WU, I_WD, I_LNG, I_LNB };

__device__ __forceinline__ int il64(int d) { return d < 32 ? 2 * d : 2 * (d - 32) + 1; }
__device__ __forceinline__ int rowmap(int kind, int n) {
    switch (kind) {
        case 1: { const bool r = (n < 1024) || (n >= 1536 && n < 1792) || (n >= 2048 && n < 2304); return r ? (n & ~63) + il64(n & 63) : n; }
        case 2: return n < 2048 ? (n & ~63) + il64(n & 63) : n;
        case 3: return 2 * n;
        case 4: return 2 * n + 1;
        default: return n;
    }
}
struct TItem { const float* W; int ldw, ncols; bf16_t* WT; int K, kb, nbk, kind; };
__device__ __forceinline__ void transpose_load(const TItem& t, int lane, f32x4 (&r)[8]) {
    const int k0 = 64 * t.kb, cq = lane & 7, nn = 32 * t.nbk + 4 * cq;
#pragma unroll
    for (int i = 0; i < 8; ++i) { const int kk = 8 * i + (lane >> 3); r[i] = nn < t.ncols ? __builtin_nontemporal_load((const f32x4*)(t.W + (size_t)(k0 + kk) * t.ldw + nn)) : (f32x4){0.f, 0.f, 0.f, 0.f}; }
}
__device__ __forceinline__ void transpose_finish(const TItem& t, const f32x4 (&r)[8], float* scr, int lane) {
    const int k0 = 64 * t.kb, n0 = 32 * t.nbk, cq = lane & 7;
#pragma unroll
    for (int i = 0; i < 8; ++i) { const int kk = 8 * i + (lane >> 3); *(f32x4*)(scr + kk * 36 + 4 * cq) = r[i]; }
    WAVE_LDS_SYNC();
    const int c = lane & 7;
#pragma unroll
    for (int j = 0; j < 4; ++j) {
        const int n = (lane >> 3) + 8 * j; const float* s = scr + (8 * c) * 36 + n;
        u32x4 o; o.x = pk2(s[0 * 36], s[1 * 36]); o.y = pk2(s[2 * 36], s[3 * 36]); o.z = pk2(s[4 * 36], s[5 * 36]); o.w = pk2(s[6 * 36], s[7 * 36]);
        *(u32x4*)(t.WT + (size_t)rowmap(t.kind, n0 + n) * t.K + k0 + 8 * c) = o;
    }
    WAVE_LDS_SYNC();
}
constexpr int MOE_W_ITEMS = NE * 768;
__device__ __forceinline__ TItem moe_weight_desc(const Ctx& C, int layer, int r) {
    const int e = r / 768; int q = r % 768;
    bf16_t* gu = (bf16_t*)(C.ws + (layer ? WS_WT_GU1 : WS_WT_GU)) + (size_t)e * 1024 * 1024;
    bf16_t* dn = (bf16_t*)(C.ws + (layer ? WS_WT_DN1 : WS_WT_DN)) + (size_t)e * 1024 * 512;
    const size_t eo = (size_t)(layer * NE + e);
    if (q < 256) return TItem{C.in[I_WG] + eo * DM * DE, DE, DE, gu, DM, q / 16, q % 16, 3}; q -= 256;
    if (q < 256) return TItem{C.in[I_WU] + eo * DM * DE, DE, DE, gu, DM, q / 16, q % 16, 4}; q -= 256;
    return TItem{C.in[I_WD] + eo * DE * DM, DM, DM, dn, DE, q / 32, q % 32, 0};
}
constexpr int PRO_I_A = 16 * 82, PRO_I_B = 16 * 32, PRO_I_C = 32 * 8, PRO_I_D = 16 * 96, PRO_I_E = 16 * 32;
constexpr int PRO_L0E = 0;
constexpr int PRO_NIT = PRO_I_A + PRO_I_B + 2 * PRO_I_C + PRO_L0E * 512;
__device__ __forceinline__ TItem prologue_desc(const Ctx& C, int r) {
    if (r < PRO_I_A) return TItem{C.in[I_NSA_WIN], NSA_IN, NSA_IN, (bf16_t*)(C.ws + WS_WT_NSA_IN), DM, r / 82, r % 82, 1}; r -= PRO_I_A;
    if (r < PRO_I_B) return TItem{C.in[I_NSA_WOUT], DM, DM, (bf16_t*)(C.ws + WS_WT_NSA_OUT), DM, r / 32, r % 32, 0}; r -= PRO_I_B;
    if (r < PRO_I_C) return TItem{C.in[I_CK_W1], 256, 256, (bf16_t*)(C.ws + WS_WT_C1K), 2048, r / 8, r % 8, 0}; r -= PRO_I_C;
    if (r < PRO_I_C) return TItem{C.in[I_CV_W1], 256, 256, (bf16_t*)(C.ws + WS_WT_C1V), 2048, r / 8, r % 8, 0}; r -= PRO_I_C;
    return moe_weight_desc(C, 0, (r / 512) * 768 + (r % 512));
}
constexpr int DEF_NIT = NE * 256, DEF2_NIT = PRO_I_D + PRO_I_E;
__device__ __forceinline__ TItem deferred_desc(const Ctx& C, int r) { return moe_weight_desc(C, 0, (r / 256) * 768 + 512 + (r % 256)); }
__device__ __forceinline__ TItem deferred2_desc(const Ctx& C, int r) {
    if (r < PRO_I_D) return TItem{C.in[I_MOBA_WIN], 3072, 3072, (bf16_t*)(C.ws + WS_WT_MOBA_IN), DM, r / 96, r % 96, 2}; r -= PRO_I_D;
    return TItem{C.in[I_MOBA_WOUT], DM, DM, (bf16_t*)(C.ws + WS_WT_MOBA_OUT), DM, r / 32, r % 32, 0};
}
__device__ __forceinline__ TItem item_desc(const Ctx& C, int which, int r) {
    if (which == -1) return prologue_desc(C, r);
    if (which == -2) return deferred_desc(C, r);
    if (which == -4) return deferred2_desc(C, r);
    if (which == 2) { if (r < NE * 512) return moe_weight_desc(C, 1, (r / 512) * 768 + (r % 512)); r -= NE * 512; return moe_weight_desc(C, 0, (PRO_L0E + r / 512) * 768 + (r % 512)); }
    if (which == -3) return moe_weight_desc(C, 1, (r / 256) * 768 + 512 + (r % 256));
    return moe_weight_desc(C, which, r);
}
__device__ __forceinline__ void run_transposes(const Ctx& C, int which, int first, int limit, int stride, float* scr) {
    if (first >= limit) return;
    int it = first;
    TItem d = item_desc(C, which, it);
    f32x4 r[8]; transpose_load(d, C.lane, r);
    for (;;) {
        const int nx = it + stride; const bool has = nx < limit;
        TItem dn = d; f32x4 rn[8];
#pragma unroll
        for (int i = 0; i < 8; ++i) rn[i] = r[i];
        if (has) { dn = item_desc(C, which, nx); transpose_load(dn, C.lane, rn); }
        transpose_finish(d, r, scr, C.lane);
        if (!has) break;
        d = dn; it = nx;
#pragma unroll
        for (int i = 0; i < 8; ++i) r[i] = rn[i];
    }
}

__device__ __forceinline__ void ph_prologue(const Ctx& C) {
    float* scr = (float*)(C.lds + C.wave * 9216);
    const int gw = C.bid * NWAVES + C.wave, NGW = C.nb * NWAVES;
    run_transposes(C, -1, gw, PRO_NIT, NGW, scr);
    const int gt = C.bid * NTHREADS + C.tid, NGT = C.nb * NTHREADS;
    { u32x4* p = (u32x4*)((bf16_t*)(C.ws + WS_WT_NSA_IN) + (size_t)2624 * DM); const int n = (NSA_INP - 2624) * DM / 8;
      for (int i = gt; i < n; i += NGT) p[i] = (u32x4){0u, 0u, 0u, 0u}; }
    { const f32x4* x4 = (const f32x4*)C.in[I_X]; u32x4* o = (u32x4*)(C.ws + WS_XB); const int n = NTOK * DM / 8;
      for (int i = gt; i < n; i += 8 * NGT) {
          f32x4 a[8], b[8];
#pragma unroll
          for (int q = 0; q < 8; ++q) { const int iq = i + q * NGT < n ? i + q * NGT : i; a[q] = __builtin_nontemporal_load(x4 + 2 * iq); b[q] = __builtin_nontemporal_load(x4 + 2 * iq + 1); }
#pragma unroll
          for (int q = 0; q < 8; ++q) if (i + q * NGT < n) o[i + q * NGT] = (u32x4){pk2(a[q].x, a[q].y), pk2(a[q].z, a[q].w), pk2(b[q].x, b[q].y), pk2(b[q].z, b[q].w)};
      } }
    { const float INV[32] = {1.000000000e+00f, 7.498942018e-01f, 5.623413324e-01f, 4.216965139e-01f, 3.162277639e-01f, 2.371373922e-01f, 1.778279394e-01f, 1.333521456e-01f,
                             1.000000015e-01f, 7.498941571e-02f, 5.623412877e-02f, 4.216964915e-02f, 3.162277862e-02f, 2.371373586e-02f, 1.778279431e-02f, 1.333521493e-02f,
                             9.999999776e-03f, 7.498942316e-03f, 5.623413250e-03f, 4.216964822e-03f, 3.162277862e-03f, 2.371373819e-03f, 1.778279431e-03f, 1.333521446e-03f,
                             1.000000047e-03f, 7.498941850e-04f, 5.623413017e-04f, 4.216965463e-04f, 3.162277862e-04f, 2.371373848e-04f, 1.778279402e-04f, 1.333521504e-04f};
      float2* tab = (float2*)(C.ws + WS_ROPE);
      for (int i = gt; i < SEQ * 32; i += NGT) {
          const int t = i >> 5, f = i & 31;
          float inv = INV[0];
#pragma unroll
          for (int q = 1; q < 32; ++q) inv = (f == q) ? INV[q] : inv;
          const float ang = (float)t * inv;
          const double a = (double)ang; const double k = __builtin_rint(a * 0.15915494309189535); const float rf = (float)(a - k * 6.283185307179586);
          tab[i] = make_float2(__cosf(rf), __sinf(rf));
      } }
    for (int i = gt; i < 2 * 64 * 256; i += NGT) { const int which = i >> 14, d = (i >> 8) & 63, c = i & 255;
        ((bf16_t*)(C.ws + WS_W2T))[i] = (bf16_t)f2bf(C.in[which ? I_CV_W2 : I_CK_W2][c * 64 + d]); }
    for (int o = ((gw & 3) == 0 ? gw >> 2 : 512); o < 512; o += (NGW + 3) >> 2) {
        const int which = o >> 8, c = o & 255;
        const float* pos = C.in[which ? I_CV_POS : I_CK_POS]; const float* w1 = C.in[which ? I_CV_W1 : I_CK_W1];
        float pv[32], wv[32];
#pragma unroll
        for (int q = 0; q < 32; ++q) { const int k = C.lane + 64 * q; pv[q] = pos[k]; wv[q] = w1[(size_t)k * 256 + c]; }
        float s = 0.f;
#pragma unroll
        for (int q = 0; q < 32; ++q) s += pv[q] * wv[q];
        s = wave_sum(s);
        if (C.lane == 0) ((float*)(C.ws + WS_BIAS1))[o] = s;
    }
}

__device__ __forceinline__ void mma_core(const bf16_t* a0, const bf16_t* a1, const bf16_t* b0, const bf16_t* b1, int K, f32x4 (&acc)[2][2]) {
#pragma unroll
    for (int i = 0; i < 2; ++i)
#pragma unroll
        for (int j = 0; j < 2; ++j) acc[i][j] = (f32x4){0.f, 0.f, 0.f, 0.f};
#pragma unroll 4
    for (int k = 0; k < K; k += 32) {
        const bf16x8 A0 = *(const bf16x8*)(a0 + k), A1 = *(const bf16x8*)(a1 + k), B0 = *(const bf16x8*)(b0 + k), B1 = *(const bf16x8*)(b1 + k);
        acc[0][0] = __builtin_amdgcn_mfma_f32_16x16x32_bf16(B0, A0, acc[0][0], 0, 0, 0);
        acc[0][1] = __builtin_amdgcn_mfma_f32_16x16x32_bf16(B1, A0, acc[0][1], 0, 0, 0);
        acc[1][0] = __builtin_amdgcn_mfma_f32_16x16x32_bf16(B0, A1, acc[1][0], 0, 0, 0);
        acc[1][1] = __builtin_amdgcn_mfma_f32_16x16x32_bf16(B1, A1, acc[1][1], 0, 0, 0);
    }
}
__device__ __forceinline__ void mma_core64(const bf16_t* a0, const bf16_t* b0, int lda16, int ldb16, int K, f32x4 (&acc)[2][4]) {
#pragma unroll
    for (int i = 0; i < 2; ++i)
#pragma unroll
        for (int j = 0; j < 4; ++j) acc[i][j] = (f32x4){0.f, 0.f, 0.f, 0.f};
#pragma unroll 4
    for (int k = 0; k < K; k += 32) {
        const bf16x8 A0 = *(const bf16x8*)(a0 + k), A1 = *(const bf16x8*)(a0 + lda16 + k);
        const bf16x8 B0 = *(const bf16x8*)(b0 + k), B1 = *(const bf16x8*)(b0 + ldb16 + k), B2 = *(const bf16x8*)(b0 + 2 * ldb16 + k), B3 = *(const bf16x8*)(b0 + 3 * ldb16 + k);
        acc[0][0] = __builtin_amdgcn_mfma_f32_16x16x32_bf16(B0, A0, acc[0][0], 0, 0, 0); acc[1][0] = __builtin_amdgcn_mfma_f32_16x16x32_bf16(B0, A1, acc[1][0], 0, 0, 0);
        acc[0][1] = __builtin_amdgcn_mfma_f32_16x16x32_bf16(B1, A0, acc[0][1], 0, 0, 0); acc[1][1] = __builtin_amdgcn_mfma_f32_16x16x32_bf16(B1, A1, acc[1][1], 0, 0, 0);
        acc[0][2] = __builtin_amdgcn_mfma_f32_16x16x32_bf16(B2, A0, acc[0][2], 0, 0, 0); acc[1][2] = __builtin_amdgcn_mfma_f32_16x16x32_bf16(B2, A1, acc[1][2], 0, 0, 0);
        acc[0][3] = __builtin_amdgcn_mfma_f32_16x16x32_bf16(B3, A0, acc[0][3], 0, 0, 0); acc[1][3] = __builtin_amdgcn_mfma_f32_16x16x32_bf16(B3, A1, acc[1][3], 0, 0, 0);
    }
}
namespace g8 {
constexpr int BM = 256, BK = 64, HALF = 128, HTB = HALF * BK * 2, STAGE_BYTES = 8 * HTB, NXCD = 8, WGM = 8;
__device__ __forceinline__ int lds_byte(int r, int c) { const int st = (r >> 4) * 2 + (c >> 5), rr = r & 15, cc = c & 31, ob = rr * 64 + cc * 2; return st * 1024 + (ob ^ (((ob >> 9) & 1) << 5)); }
__device__ __forceinline__ void stage_rc(int b, int& R, int& C) { const int st = b / 1024, sb = b % 1024, swz = sb ^ (((sb >> 9) & 1) << 5); R = (st >> 1) * 16 + swz / 64; C = (st & 1) * 32 + (swz % 64) / 2; }
struct Unit { int pm, pn, bt, e; };
struct StaticOrder {
    int nM, nN, nwg, G, c;
    __device__ void init(int nM_, int nN_, int G_, int c_) { nM = nM_; nN = nN_; nwg = nM * nN; G = G_; c = c_; }
    __device__ bool next(int i, Unit& u) const {
        const long L = (long)i * G + c; if (L >= nwg) return false;
        int wgid = (int)L; { const int q = nwg / NXCD, r = nwg % NXCD, xcd = wgid % NXCD, off = wgid / NXCD; wgid = (xcd < r ? xcd * (q + 1) : r * (q + 1) + (xcd - r) * q) + off; }
        const int nig = WGM * nN, gid = wgid / nig, fm = gid * WGM, gsz = (nM - fm) < WGM ? (nM - fm) : WGM;
        u.pm = fm + ((wgid % nig) % gsz); u.pn = (wgid % nig) / gsz; u.bt = u.pn; u.e = 0; return true;
    }
};
struct GroupedOrder {
    StaticOrder so; const LAS int* sm;
    __device__ void init(const LAS int* sm_, int nN_, int G_, int c_) { sm = sm_; so.init(sm_[32] / BM, nN_, G_, c_); }
    __device__ bool next(int i, Unit& u) const {
        if (!so.next(i, u)) return false;
        const int rowt = u.pm * BM; int e = 0;
#pragma unroll
        for (int q = 1; q < NE; ++q) e = (rowt >= sm[16 + q]) ? q : e;
        u.e = e; u.bt = e * so.nN + u.pn; return true;
    }
};
struct GatherInfo { const int* rowlist; const LAS int* sm; };

__device__ __forceinline__ int perm32(int rho) { const int n = rho >> 4, i = rho & 15; return 8 * (i >> 2) + 4 * n + (i & 3); }
template <bool GATHER, class Epi, class Sched>
__device__ __forceinline__ void gemm8(LAS unsigned char* lds, const bf16_t* A, int lda, const bf16_t* Bt, int K, const Sched& S, const Epi& E, GatherInfo gi) {
    const int tid = threadIdx.x, wid = __builtin_amdgcn_readfirstlane(tid >> 6), lane = tid & 63, wr = wid >> 2, wc = wid & 3, fr = lane & 15, fq = lane >> 4;
    const int nt = K / BK;
    int Rr[2], Cc[2]; unsigned voffB[2]; unsigned vAc[2][2], vAn[2][2];
#pragma unroll
    for (int i = 0; i < 2; ++i) { stage_rc(tid * 16 + i * 8192, Rr[i], Cc[i]); voffB[i] = (unsigned)(((Rr[i] & ~31) + perm32(Rr[i] & 31)) * K + Cc[i]) * 2u;
#pragma unroll
        for (int h = 0; h < 2; ++h) { vAc[h][i] = (unsigned)((Rr[i] + HALF * h) * lda + Cc[i]) * 2u; vAn[h][i] = vAc[h][i]; } }
    const size_t kstep = (size_t)(BK * 2);
    const size_t hstepB = (size_t)HALF * K * 2, tstepB = 2 * hstepB, tstepA = (size_t)BM * lda * 2;
    const unsigned ldsw = (unsigned)wid * 1024u;
    const int aoff = lds_byte(wr * 64 + fr, fq * 8), boff = lds_byte(wc * 32 + fr, fq * 8);
#define G8_SA(b, h) (((b) * 2 + (h)) * HTB)
#define G8_SB(b, h) ((4 + (b) * 2 + (h)) * HTB)
#define G8_STAGEB(bufoff, gbase) do { _Pragma("unroll") for (int _i = 0; _i < 2; ++_i) \
        __builtin_amdgcn_global_load_lds((const unsigned*)((const char*)(gbase) + voffB[_i]), (LAS unsigned*)(lds + (bufoff) + ldsw + _i * 8192), 16, 0, 0); } while (0)
#define G8_STAGEA(bufoff, gbase, v0, v1) do { \
        __builtin_amdgcn_global_load_lds((const unsigned*)((const char*)(gbase) + (v0)), (LAS unsigned*)(lds + (bufoff) + ldsw), 16, 0, 0); \
        __builtin_amdgcn_global_load_lds((const unsigned*)((const char*)(gbase) + (v1)), (LAS unsigned*)(lds + (bufoff) + ldsw + 8192), 16, 0, 0); } while (0)
#define G8_LDA(dst, b, h) do { _Pragma("unroll") for (int m = 0; m < 4; ++m) _Pragma("unroll") for (int k = 0; k < 2; ++k) dst[m][k] = *(const LAS bf16x8*)(lds + G8_SA(b, h) + aoff + m * 2048 + k * 1024); } while (0)
#define G8_LDB(dst, b, h) do { _Pragma("unroll") for (int n = 0; n < 2; ++n) _Pragma("unroll") for (int k = 0; k < 2; ++k) dst[n][k] = *(const LAS bf16x8*)(lds + G8_SB(b, h) + boff + n * 2048 + k * 1024); } while (0)
#define G8_MMA(ai, bj, At, Bt_) do { __builtin_amdgcn_s_setprio(1); _Pragma("unroll") for (int m = 0; m < 4; ++m) _Pragma("unroll") for (int n = 0; n < 2; ++n) _Pragma("unroll") for (int k = 0; k < 2; ++k) \
        acc[ai][bj][m][n] = __builtin_amdgcn_mfma_f32_16x16x32_bf16(Bt_[n][k], At[m][k], acc[ai][bj][m][n], 0, 0, 0); __builtin_amdgcn_s_setprio(0); } while (0)
#define G8_WAIT_V(n) asm volatile("s_waitcnt vmcnt(" #n ")" ::: "memory")
#define G8_WAIT_L(n) asm volatile("s_waitcnt lgkmcnt(" #n ")" ::: "memory")
#define G8_BAR __builtin_amdgcn_s_barrier()
#define G8_SCHED __builtin_amdgcn_sched_barrier(0)
#define G8_GATHER(u, v) do { if (GATHER) { const int _eb = gi.sm[16 + (u).e], _ec = gi.sm[(u).e]; \
        _Pragma("unroll") for (int _h = 0; _h < 2; ++_h) _Pragma("unroll") for (int _i = 0; _i < 2; ++_i) { const int _s = (u).pm * BM + HALF * _h + Rr[_i] - _eb; \
            const int _t = gi.rowlist[(u).e * NTOK + (_s < _ec ? _s : 0)]; v[_h][_i] = (unsigned)(_t * K + Cc[_i]) * 2u; } } } while (0)
    Unit cur, nxt; int ui = 0;
    if (!S.next(0, cur)) return;
    f32x4 acc[2][2][4][2];
#pragma unroll
    for (int a = 0; a < 2; ++a)
#pragma unroll
        for (int b = 0; b < 2; ++b)
#pragma unroll
            for (int m = 0; m < 4; ++m)
#pragma unroll
                for (int n = 0; n < 2; ++n) acc[a][b][m][n] = (f32x4){0.f, 0.f, 0.f, 0.f};
    bf16x8 At[4][2], B0[2][2], B1[2][2];
    G8_GATHER(cur, vAc);
    const char* cA = GATHER ? (const char*)A : (const char*)A + (size_t)cur.pm * tstepA; const char* cB = (const char*)Bt + (size_t)cur.bt * tstepB;
    G8_STAGEB(G8_SB(0, 0), cB); G8_STAGEB(G8_SB(0, 1), cB + hstepB); G8_STAGEA(G8_SA(0, 0), cA, vAc[0][0], vAc[0][1]); G8_STAGEA(G8_SA(0, 1), cA, vAc[1][0], vAc[1][1]);
    if (wr == 1) G8_BAR;
    G8_WAIT_V(2); G8_BAR;
    G8_STAGEB(G8_SB(1, 0), cB + kstep); G8_STAGEA(G8_SA(1, 0), cA + kstep, vAc[0][0], vAc[0][1]); G8_STAGEB(G8_SB(1, 1), cB + hstepB + kstep);
    G8_WAIT_V(6); G8_BAR;
    for (;;) {
        const bool has_next = S.next(ui + 1, nxt);
        if (has_next) G8_GATHER(nxt, vAn);
        const char* nA = has_next ? (GATHER ? (const char*)A : (const char*)A + (size_t)nxt.pm * tstepA) : cA; const char* nB = has_next ? (const char*)Bt + (size_t)nxt.bt * tstepB : cB;
        for (int t = 0; t < nt; t += 2) {
            const bool last = (t == nt - 2);
            const char* a1 = cA + (size_t)(t + 1) * kstep;
            const char* a2 = last ? nA : cA + (size_t)(t + 2) * kstep; const char* b2 = last ? nB : cB + (size_t)(t + 2) * kstep;
            const char* a3 = a2 + kstep; const char* b3 = b2 + kstep;
            const bool usen = GATHER && last && has_next;
            const unsigned w00 = usen ? vAn[0][0] : vAc[0][0], w01 = usen ? vAn[0][1] : vAc[0][1], w10 = usen ? vAn[1][0] : vAc[1][0], w11 = usen ? vAn[1][1] : vAc[1][1];
            G8_LDB(B0, 0, 0); G8_LDB(B1, 0, 1); G8_SCHED; G8_LDA(At, 0, 0); G8_STAGEA(G8_SA(1, 1), a1, vAc[1][0], vAc[1][1]);
            G8_WAIT_V(8); G8_WAIT_L(0); G8_BAR; G8_MMA(0, 0, At, B0); G8_MMA(0, 1, At, B1); G8_BAR; G8_SCHED;
            G8_LDA(At, 0, 1); G8_STAGEB(G8_SB(0, 0), b2); G8_STAGEB(G8_SB(0, 1), b2 + hstepB); G8_STAGEA(G8_SA(0, 0), a2, w00, w01);
            G8_WAIT_V(8); G8_WAIT_L(0); G8_BAR; G8_MMA(1, 0, At, B0); G8_MMA(1, 1, At, B1); G8_BAR; G8_SCHED;
            G8_LDB(B0, 1, 0); G8_LDB(B1, 1, 1); G8_SCHED; G8_LDA(At, 1, 0); G8_STAGEA(G8_SA(0, 1), a2, w10, w11);
            G8_WAIT_V(8); G8_WAIT_L(0); G8_BAR; G8_MMA(0, 0, At, B0); G8_MMA(0, 1, At, B1); G8_BAR; G8_SCHED;
            G8_LDA(At, 1, 1); G8_STAGEB(G8_SB(1, 0), b3); G8_STAGEB(G8_SB(1, 1), b3 + hstepB); G8_STAGEA(G8_SA(1, 0), a3, w00, w01);
            G8_WAIT_V(8); G8_WAIT_L(0); G8_BAR; G8_MMA(1, 0, At, B0); G8_MMA(1, 1, At, B1); G8_BAR; G8_SCHED;
        }
        if (wr == 0) G8_BAR;
        E(acc, cur, wr, wc, fr, fq);
        if (!has_next) break;
#pragma unroll
        for (int a = 0; a < 2; ++a)
#pragma unroll
            for (int b = 0; b < 2; ++b)
#pragma unroll
                for (int m = 0; m < 4; ++m)
#pragma unroll
                    for (int n = 0; n < 2; ++n) acc[a][b][m][n] = (f32x4){0.f, 0.f, 0.f, 0.f};
        cur = nxt; cA = nA; cB = nB; ++ui;
#pragma unroll
        for (int h = 0; h < 2; ++h)
#pragma unroll
            for (int i = 0; i < 2; ++i) vAc[h][i] = vAn[h][i];
        if (wr == 1) G8_BAR;
    }
    G8_WAIT_V(0);
    G8_BAR;
    if constexpr (Epi::AFTER) E.after(acc, cur, lds, wr, wc, fr, fq, wid, lane);
#undef G8_SA
#undef G8_SB
#undef G8_STAGEA
#undef G8_STAGEB
#undef G8_LDA
#undef G8_LDB
#undef G8_MMA
#undef G8_WAIT_V
#undef G8_WAIT_L
#undef G8_BAR
#undef G8_SCHED
#undef G8_GATHER
}
template <class F> struct EpiEl {
    static constexpr bool AFTER = false;
    F f;
    __device__ __forceinline__ void operator()(const f32x4 (&acc)[2][2][4][2], const Unit& u, int wr, int wc, int fr, int fq) const {
#pragma unroll
        for (int ai = 0; ai < 2; ++ai)
#pragma unroll
            for (int m = 0; m < 4; ++m) { const int row = u.pm * BM + ai * HALF + wr * 64 + m * 16 + fr;
#pragma unroll
                for (int bj = 0; bj < 2; ++bj) f(row, u.pn * BM + bj * HALF + wc * 32 + 8 * fq, acc[ai][bj][m][0], acc[ai][bj][m][1]); }
    }
};
}

struct EpiNsaIn {
    bf16_t* Q; bf16_t* KV; float* gates; const float2* rope;
    __device__ __forceinline__ void operator()(int row, int c, f32x4 v) const {
        const int t = row & (SEQ - 1), b = row >> 13;
        if (c < 1024) {
            v = v * QSCALE;
            const int d = (c & 63) >> 1; const float2 c0 = rope[t * 32 + d], c1 = rope[t * 32 + d + 1];
            bf16_t* p = Q + (size_t)row * DM + (c & ~63);
            *(unsigned*)(p + d) = pk2(v[0] * c0.x - v[1] * c0.y, v[2] * c1.x - v[3] * c1.y);
            *(unsigned*)(p + d + 32) = pk2(v[1] * c0.x + v[0] * c0.y, v[3] * c1.x + v[2] * c1.y);
        } else if (c < 2560) {
            const int s = (c - 1024) >> 8, g = ((c - 1024) >> 6) & 3;
            bf16_t* p = KV + (size_t)s * (KVSEG / 2) + ((size_t)(b * NG + g) * SEQ + t) * DH;
            if (s == 2 || s == 4) {
                const int d = (c & 63) >> 1; const float2 c0 = rope[t * 32 + d], c1 = rope[t * 32 + d + 1];
                *(unsigned*)(p + d) = pk2(v[0] * c0.x - v[1] * c0.y, v[2] * c1.x - v[3] * c1.y);
                *(unsigned*)(p + d + 32) = pk2(v[1] * c0.x + v[0] * c0.y, v[3] * c1.x + v[2] * c1.y);
            } else {
                *(u32x2*)(p + (c & 63)) = (u32x2){pk2(v[0], v[1]), pk2(v[2], v[3])};
            }
        } else if (c < NSA_IN) {
            float* gp = gates + (size_t)row * 48 + (c - 2560);
            *(f32x4*)gp = (f32x4){sigmoidf_(v[0]), sigmoidf_(v[1]), sigmoidf_(v[2]), sigmoidf_(v[3])};
        }
    }
    __device__ __forceinline__ void operator()(int row, int c, f32x4 v, f32x4 w) const {
        const int t = row & (SEQ - 1), b = row >> 13;
        const int s = (c - 1024) >> 8;
        const bool isq = c < 1024, roped = isq || s == 2 || s == 4;
        if (roped) {
            if (isq) { v = v * QSCALE; w = w * QSCALE; }
            const int g = ((c - 1024) >> 6) & 3, d = (c & 63) >> 1;
            bf16_t* p = isq ? Q + (size_t)row * DM + (c & ~63) : KV + (size_t)s * (KVSEG / 2) + ((size_t)(b * NG + g) * SEQ + t) * DH;
            const f32x4 cs01 = *(const f32x4*)(rope + t * 32 + d), cs23 = *(const f32x4*)(rope + t * 32 + d + 2);
            *(u32x2*)(p + d) = (u32x2){pk2(v[0] * cs01[0] - v[1] * cs01[1], v[2] * cs01[2] - v[3] * cs01[3]), pk2(w[0] * cs23[0] - w[1] * cs23[1], w[2] * cs23[2] - w[3] * cs23[3])};
            *(u32x2*)(p + d + 32) = (u32x2){pk2(v[1] * cs01[0] + v[0] * cs01[1], v[3] * cs01[2] + v[2] * cs01[3]), pk2(w[1] * cs23[0] + w[0] * cs23[1], w[3] * cs23[2] + w[2] * cs23[3])};
        } else {
            const int g = ((c - 1024) >> 6) & 3;
            bf16_t* p = KV + (size_t)s * (KVSEG / 2) + ((size_t)(b * NG + g) * SEQ + t) * DH + (c & 63);
            *(u32x4*)p = (u32x4){pk2(v[0], v[1]), pk2(v[2], v[3]), pk2(w[0], w[1]), pk2(w[2], w[3])};
        }
    }
};
struct EpiMobaIn {
    bf16_t* Q; bf16_t* K; bf16_t* V; const float2* rope;
    __device__ __forceinline__ void operator()(int row, int c, f32x4 v) const {
        const int t = row & (SEQ - 1), b = row >> 13;
        if (c < 2048) {
            if (c < 1024) v = v * QSCALE;
            const int d = (c & 63) >> 1; const float2 c0 = rope[t * 32 + d], c1 = rope[t * 32 + d + 1];
            bf16_t* p = c < 1024 ? Q + (size_t)row * DM + (c & ~63) : K + ((size_t)(b * NH + ((c - 1024) >> 6)) * SEQ + t) * DH;
            *(unsigned*)(p + d) = pk2(v[0] * c0.x - v[1] * c0.y, v[2] * c1.x - v[3] * c1.y);
            *(unsigned*)(p + d + 32) = pk2(v[1] * c0.x + v[0] * c0.y, v[3] * c1.x + v[2] * c1.y);
        } else {
            bf16_t* p = V + ((size_t)(b * NH + ((c - 2048) >> 6)) * SEQ + t) * DH + (c & 63);
            *(u32x2*)p = (u32x2){pk2(v[0], v[1]), pk2(v[2], v[3])};
        }
    }
    __device__ __forceinline__ void operator()(int row, int c, f32x4 v, f32x4 w) const {
        const int t = row & (SEQ - 1), b = row >> 13;
        if (c < 2048) {
            if (c < 1024) { v = v * QSCALE; w = w * QSCALE; }
            const int d = (c & 63) >> 1;
            bf16_t* p = c < 1024 ? Q + (size_t)row * DM + (c & ~63) : K + ((size_t)(b * NH + ((c - 1024) >> 6)) * SEQ + t) * DH;
            const f32x4 cs01 = *(const f32x4*)(rope + t * 32 + d), cs23 = *(const f32x4*)(rope + t * 32 + d + 2);
            *(u32x2*)(p + d) = (u32x2){pk2(v[0] * cs01[0] - v[1] * cs01[1], v[2] * cs01[2] - v[3] * cs01[3]), pk2(w[0] * cs23[0] - w[1] * cs23[1], w[2] * cs23[2] - w[3] * cs23[3])};
            *(u32x2*)(p + d + 32) = (u32x2){pk2(v[1] * cs01[0] + v[0] * cs01[1], v[3] * cs01[2] + v[2] * cs01[3]), pk2(w[1] * cs23[0] + w[0] * cs23[1], w[3] * cs23[2] + w[2] * cs23[3])};
        } else {
            bf16_t* p = V + ((size_t)(b * NH + ((c - 2048) >> 6)) * SEQ + t) * DH + (c & 63);
            *(u32x4*)p = (u32x4){pk2(v[0], v[1]), pk2(v[2], v[3]), pk2(w[0], w[1]), pk2(w[2], w[3])};
        }
    }
};
struct EpiMobaInKM {
    static constexpr bool AFTER = false;
    EpiMobaIn f; float* KMP; float* KMX;
    __device__ __forceinline__ void operator()(const f32x4 (&acc)[2][2][4][2], const g8::Unit& u, int wr, int wc, int fr, int fq) const {
        const bool isk = u.pn >= 4 && u.pn < 8;
#pragma unroll
        for (int bj = 0; bj < 2; ++bj) {
            const int c = u.pn * g8::BM + bj * g8::HALF + wc * 32 + 8 * fq;
            float sm[8], mx[8];
#pragma unroll
            for (int q = 0; q < 8; ++q) { sm[q] = 0.f; mx[q] = 0.f; }
#pragma unroll
            for (int ai = 0; ai < 2; ++ai)
#pragma unroll
                for (int m = 0; m < 4; ++m) {
                    const int row = u.pm * g8::BM + ai * g8::HALF + wr * 64 + m * 16 + fr;
                    const f32x4 v = acc[ai][bj][m][0], w = acc[ai][bj][m][1];
                    f(row, c, v, w);
                    if (isk) {
                        const int t = row & (SEQ - 1), d = (c & 63) >> 1;
                        const f32x4 cs01 = *(const f32x4*)(f.rope + t * 32 + d), cs23 = *(const f32x4*)(f.rope + t * 32 + d + 2);
                        const float o[8] = {v[0] * cs01[0] - v[1] * cs01[1], v[2] * cs01[2] - v[3] * cs01[3], w[0] * cs23[0] - w[1] * cs23[1], w[2] * cs23[2] - w[3] * cs23[3],
                                            v[1] * cs01[0] + v[0] * cs01[1], v[3] * cs01[2] + v[2] * cs01[3], w[1] * cs23[0] + w[0] * cs23[1], w[3] * cs23[2] + w[2] * cs23[3]};
#pragma unroll
                        for (int q = 0; q < 8; ++q) { sm[q] += o[q]; mx[q] = fmaxf(mx[q], fabsf(o[q])); }
                    }
                }
            if (isk) {
#pragma unroll
                for (int q = 0; q < 8; ++q) {
                    float s = sm[q], x = mx[q];
                    s += __builtin_bit_cast(float, __builtin_amdgcn_mov_dpp(__builtin_bit_cast(int, s), 0xB1, 0xf, 0xf, true)); x = fmaxf(x, __builtin_bit_cast(float, __builtin_amdgcn_mov_dpp(__builtin_bit_cast(int, x), 0xB1, 0xf, 0xf, true)));
                    s += __builtin_bit_cast(float, __builtin_amdgcn_mov_dpp(__builtin_bit_cast(int, s), 0x4E, 0xf, 0xf, true)); x = fmaxf(x, __builtin_bit_cast(float, __builtin_amdgcn_mov_dpp(__builtin_bit_cast(int, x), 0x4E, 0xf, 0xf, true)));
                    s += __builtin_bit_cast(float, __builtin_amdgcn_mov_dpp(__builtin_bit_cast(int, s), 0x141, 0xf, 0xf, true)); x = fmaxf(x, __builtin_bit_cast(float, __builtin_amdgcn_mov_dpp(__builtin_bit_cast(int, x), 0x141, 0xf, 0xf, true)));
                    s += __builtin_bit_cast(float, __builtin_amdgcn_mov_dpp(__builtin_bit_cast(int, s), 0x140, 0xf, 0xf, true)); x = fmaxf(x, __builtin_bit_cast(float, __builtin_amdgcn_mov_dpp(__builtin_bit_cast(int, x), 0x140, 0xf, 0xf, true)));
                    sm[q] = s; mx[q] = x;
                }
                if (fr == 0) {
                    const int row0 = u.pm * g8::BM, b = row0 >> 13, blk = (row0 & (SEQ - 1)) >> 8, hd = (c - 1024) >> 6, d = (c & 63) >> 1;
                    const size_t o = ((size_t)((b * NH + hd) * 32 + blk) * 2 + wr) * 64 + d;
                    *(f32x4*)(KMP + o) = (f32x4){sm[0], sm[1], sm[2], sm[3]}; *(f32x4*)(KMP + o + 32) = (f32x4){sm[4], sm[5], sm[6], sm[7]};
                    *(f32x4*)(KMX + o) = (f32x4){mx[0], mx[1], mx[2], mx[3]}; *(f32x4*)(KMX + o + 32) = (f32x4){mx[4], mx[5], mx[6], mx[7]};
                }
            }
        }
    }
};
struct EpiCmp {
    static constexpr bool AFTER = true;
    const float* bias; const bf16_t* W2T; const float2* rope; bf16_t* OUT;
    __device__ __forceinline__ void operator()(const f32x4 (&)[2][2][4][2], const g8::Unit&, int, int, int, int) const {}
    __device__ __forceinline__ void after(const f32x4 (&acc)[2][2][4][2], const g8::Unit& u, LAS unsigned char* lds, int wr, int wc, int fr, int fq, int wid, int lane) const {
#pragma unroll
        for (int bj = 0; bj < 2; ++bj) {
            const int c0 = bj * 128 + wc * 32 + 8 * fq;
            const f32x4 bv = *(const f32x4*)(bias + c0), bw = *(const f32x4*)(bias + c0 + 4);
#pragma unroll
            for (int ai = 0; ai < 2; ++ai)
#pragma unroll
                for (int m = 0; m < 4; ++m) { const int row = ai * 128 + wr * 64 + m * 16 + fr; const f32x4 v = acc[ai][bj][m][0] + bv, w = acc[ai][bj][m][1] + bw;
                    *(LAS u32x4*)(lds + row * 528 + c0 * 2) = (u32x4){pk2(gelu_tanh(v[0]), gelu_tanh(v[1])), pk2(gelu_tanh(v[2]), gelu_tanh(v[3])), pk2(gelu_tanh(w[0]), gelu_tanh(w[1])), pk2(gelu_tanh(w[2]), gelu_tanh(w[3]))}; }
        }
        asm volatile("s_waitcnt lgkmcnt(0)\n\ts_barrier" ::: "memory");
        f32x4 o[2][4];
#pragma unroll
        for (int rt = 0; rt < 2; ++rt)
#pragma unroll
            for (int dt = 0; dt < 4; ++dt) o[rt][dt] = (f32x4){0.f, 0.f, 0.f, 0.f};
#pragma unroll
        for (int s8 = 0; s8 < 8; ++s8) {
            bf16x8 hb[2], wa[4];
#pragma unroll
            for (int rt = 0; rt < 2; ++rt) hb[rt] = *(const LAS bf16x8*)(lds + (32 * wid + 16 * rt + fr) * 528 + (32 * s8 + 8 * fq) * 2);
#pragma unroll
            for (int dt = 0; dt < 4; ++dt) wa[dt] = *(const bf16x8*)(W2T + (16 * dt + fr) * 256 + 32 * s8 + 8 * fq);
#pragma unroll
            for (int rt = 0; rt < 2; ++rt)
#pragma unroll
                for (int dt = 0; dt < 4; ++dt) o[rt][dt] = __builtin_amdgcn_mfma_f32_16x16x32_bf16(wa[dt], hb[rt], o[rt][dt], 0, 0, 0);
        }
#pragma unroll
        for (int rt = 0; rt < 2; ++rt) {
            const int rg = u.pm * 256 + 32 * wid + 16 * rt + fr, ci = rg & 511;
            if (rope) {
#pragma unroll
                for (int dt = 0; dt < 2; ++dt) {
                    const f32x4 cs01 = *(const f32x4*)(rope + (16 * ci + 31) * 32 + 16 * dt + 4 * fq), cs23 = *(const f32x4*)(rope + (16 * ci + 31) * 32 + 16 * dt + 4 * fq + 2);
                    const f32x4 lo = o[rt][dt], hi = o[rt][dt + 2];
                    o[rt][dt] = (f32x4){lo[0] * cs01[0] - hi[0] * cs01[1], lo[1] * cs01[2] - hi[1] * cs01[3], lo[2] * cs23[0] - hi[2] * cs23[1], lo[3] * cs23[2] - hi[3] * cs23[3]};
                    o[rt][dt + 2] = (f32x4){hi[0] * cs01[0] + lo[0] * cs01[1], hi[1] * cs01[2] + lo[1] * cs01[3], hi[2] * cs23[0] + lo[2] * cs23[1], hi[3] * cs23[2] + lo[3] * cs23[3]};
                }
            }
            const float z = ci == 511 ? 0.f : 1.f;
#pragma unroll
            for (int dt = 0; dt < 4; ++dt) { const f32x4 x = o[rt][dt] * z; *(u32x2*)(OUT + (size_t)rg * 64 + 16 * dt + 4 * fq) = (u32x2){pk2(x[0], x[1]), pk2(x[2], x[3])}; }
        }
    }
};
struct EpiSwiGLU {
    bf16_t* H;
    __device__ __forceinline__ void operator()(int row, int c, f32x4 v) const {
        const float h0 = v[0] * sigmoidf_(v[0]) * v[1], h1 = v[2] * sigmoidf_(v[2]) * v[3];
        *(unsigned*)(H + (size_t)row * DE + (c >> 1)) = pk2(h0, h1);
    }
    __device__ __forceinline__ void operator()(int row, int c, f32x4 v, f32x4 w) const {
        *(u32x2*)(H + (size_t)row * DE + (c >> 1)) = (u32x2){pk2(v[0] * sigmoidf_(v[0]) * v[1], v[2] * sigmoidf_(v[2]) * v[3]), pk2(w[0] * sigmoidf_(w[0]) * w[1], w[2] * sigmoidf_(w[2]) * w[3])};
    }
};
struct EpiBf16 {
    bf16_t* Y;
    __device__ __forceinline__ void operator()(int row, int c, f32x4 v) const { *(u32x2*)(Y + (size_t)row * DM + c) = (u32x2){pk2(v[0], v[1]), pk2(v[2], v[3])}; }
    __device__ __forceinline__ void operator()(int row, int c, f32x4 v, f32x4 w) const { *(u32x4*)(Y + (size_t)row * DM + c) = (u32x4){pk2(v[0], v[1]), pk2(v[2], v[3]), pk2(w[0], w[1]), pk2(w[2], w[3])}; }
};

struct ExpertMap { int cnt[NE]; int base[NE + 1]; };
__device__ __forceinline__ void load_expert_map(const Ctx& C, int cw, LAS int* sm  ) {
    if (C.tid < 64) {
        const unsigned* ctl = (const unsigned*)(C.ws + WS_CTL); const int lane = C.tid;
        const int c = lane < NE ? (int)__hip_atomic_load(ctl + cw + 64 * lane, __ATOMIC_RELAXED, __HIP_MEMORY_SCOPE_AGENT) : 0;
        const int pad = (c + 255) & ~255; int incl = pad;
#pragma unroll
        for (int o = 1; o < NE; o <<= 1) { const int t = __shfl_up(incl, o); incl += lane >= o ? t : 0; }
        if (lane < NE) { sm[lane] = c; sm[16 + lane] = incl - pad; }
        if (lane == NE - 1) sm[32] = incl;
    }
    __syncthreads();
}

__device__ __forceinline__ void load_qh(const bf16_t* qp, float (&qh)[64]) {
    const uint4* q4 = (const uint4*)qp;
#pragma unroll
    for (int c = 0; c < 8; ++c) { const uint4 w = q4[c]; qh[8 * c] = bflo(w.x); qh[8 * c + 1] = bfhi(w.x); qh[8 * c + 2] = bflo(w.y); qh[8 * c + 3] = bfhi(w.y);
        qh[8 * c + 4] = bflo(w.z); qh[8 * c + 5] = bfhi(w.z); qh[8 * c + 6] = bflo(w.w); qh[8 * c + 7] = bfhi(w.w); }
}
namespace fa {
constexpr int SLOT = 16384, NSLOT = 4;
constexpr float C2 = 0.125f * 1.4426950408889634f;
constexpr float NEGBIG = -1e30f;
typedef short v4i16 __attribute__((ext_vector_type(4)));
template <bool WITH_V = true>
__device__ __forceinline__ void dma_block(LAS unsigned char* slot, const bf16_t* Kg, const bf16_t* Vg, int wave, int lane) {
    { const int key = 8 * wave + (lane >> 3), c = (lane & 7) ^ ((key >> 1) & 7);
      __builtin_amdgcn_global_load_lds((const unsigned*)(Kg + key * 64 + 8 * c), (LAS unsigned*)(slot + wave * 1024), 16, 0, 0); }
    if (WITH_V) { const int key = 16 * (wave & 3) + (lane >> 2), cp = lane & 3, d = (wave >> 2) * 32 + ((((cp >> 1) ^ ((key >> 2) & 1))) << 4) + ((cp & 1) << 3);
      __builtin_amdgcn_global_load_lds((const unsigned*)(Vg + key * 64 + d), (LAS unsigned*)(slot + 8192 + wave * 1024), 16, 0, 0); }
}
__device__ __forceinline__ v4i16 tr_read(LAS v4i16* __restrict__ p) { return __builtin_amdgcn_ds_read_tr16_b64_v4i16(p); }
__device__ __forceinline__ void xpose_dt_fq(unsigned& x0, unsigned& x1, unsigned& x2, unsigned& x3) {
    const auto s = __builtin_amdgcn_permlane32_swap(x0, x2, false, false); x0 = s[0]; x2 = s[1];
    const auto t = __builtin_amdgcn_permlane32_swap(x1, x3, false, false); x1 = t[0]; x3 = t[1];
    const auto p = __builtin_amdgcn_permlane16_swap(x0, x1, false, false); x0 = p[0]; x1 = p[1];
    const auto q = __builtin_amdgcn_permlane16_swap(x2, x3, false, false); x2 = q[0]; x3 = q[1];
}
__device__ __forceinline__ void xpose_dt_fq(u32x2 (&x)[4]) {
    unsigned a = x[0].x, b = x[1].x, c = x[2].x, d = x[3].x; xpose_dt_fq(a, b, c, d);
    unsigned e = x[0].y, f = x[1].y, g = x[2].y, h = x[3].y; xpose_dt_fq(e, f, g, h);
    x[0] = (u32x2){a, e}; x[1] = (u32x2){b, f}; x[2] = (u32x2){c, g}; x[3] = (u32x2){d, h};
}
__device__ __forceinline__ void xpose_dt_fq(f32x4 (&x)[4]) {
#pragma unroll
    for (int r = 0; r < 4; ++r) { unsigned a = __float_as_uint(x[0][r]), b = __float_as_uint(x[1][r]), c = __float_as_uint(x[2][r]), d = __float_as_uint(x[3][r]); xpose_dt_fq(a, b, c, d);
        x[0][r] = __uint_as_float(a); x[1][r] = __uint_as_float(b); x[2][r] = __uint_as_float(c); x[3][r] = __uint_as_float(d); }
}
__device__ __forceinline__ unsigned cvt_pk_bf16(float lo, float hi) { const f32x2v v = {lo, hi}; const bf16x2v b = __builtin_convertvector(v, bf16x2v); return __builtin_bit_cast(unsigned, b); }
struct Task { bf16x8 q[2]; int kmin, kmax; float m, l, cinit; f32x4 O[4]; f32x4 L; unsigned fw0; const LAS unsigned* fwp; int imptok; };
template <int FM> __device__ __forceinline__ bool row_flag(const Task& t, int jb) {
    if (FM == 0) return true;
    if (FM == 1) { const unsigned w = t.fwp[jb >> 5]; return ((w >> (jb & 31)) & 1u) != 0u; }
    return ((t.fw0 >> (jb >> 2)) & 1u) != 0u;
}
struct LaneC { int fq, koff0, koff1, voffA, voffB; };
__device__ __forceinline__ LaneC lane_consts(int lane) {
    const int i16 = lane & 15, fq = lane >> 4, kx = (i16 >> 1) & 7, q4 = i16 >> 2, p4 = lane & 3;
    LaneC lc; lc.fq = fq; lc.koff0 = i16 * 128 + ((fq ^ kx) << 4); lc.koff1 = i16 * 128 + (((4 + fq) ^ kx) << 4);
    lc.voffA = 8192 + (4 * fq + q4) * 64 + ((0 ^ (fq & 1)) << 5) + 8 * p4; lc.voffB = 8192 + (4 * fq + q4) * 64 + ((1 ^ (fq & 1)) << 5) + 8 * p4;
    return lc;
}
__device__ __forceinline__ float xrow16_max(float x) {
    auto s = __builtin_amdgcn_permlane16_swap(__float_as_uint(x), __float_as_uint(x), false, false);
    x = fmaxf(__uint_as_float(s[0]), __uint_as_float(s[1]));
    auto t = __builtin_amdgcn_permlane32_swap(__float_as_uint(x), __float_as_uint(x), false, false);
    return fmaxf(__uint_as_float(t[0]), __uint_as_float(t[1]));
}
__device__ __forceinline__ float xrow16_sum(float x) {
    auto s = __builtin_amdgcn_permlane16_swap(__float_as_uint(x), __float_as_uint(x), false, false);
    x = __uint_as_float(s[0]) + __uint_as_float(s[1]);
    auto t = __builtin_amdgcn_permlane32_swap(__float_as_uint(x), __float_as_uint(x), false, false);
    return __uint_as_float(t[0]) + __uint_as_float(t[1]);
}
__device__ __forceinline__ void t_mask(const Task& t, f32x4 (&s)[4], int kb, int fq) {
#pragma unroll
    for (int kt = 0; kt < 4; ++kt)
#pragma unroll
        for (int r = 0; r < 4; ++r) { const int key = kb + 16 * kt + 4 * fq + r; s[kt][r] = (key >= t.kmin && key <= t.kmax) ? s[kt][r] : NEGBIG; }
}
template <int MODE> __device__ __forceinline__ float t_stats(Task& t, f32x4 (&s)[4], bool rf) {
    float bm = fmaxf(fmaxf(fmaxf(s[0][0], s[0][1]), fmaxf(s[0][2], s[0][3])), fmaxf(fmaxf(s[1][0], s[1][1]), fmaxf(s[1][2], s[1][3])));
    bm = fmaxf(bm, fmaxf(fmaxf(fmaxf(s[2][0], s[2][1]), fmaxf(s[2][2], s[2][3])), fmaxf(fmaxf(s[3][0], s[3][1]), fmaxf(s[3][2], s[3][3]))));
    bm = xrow16_max(bm);
    if (!rf) bm = NEGBIG;
    const float mnew = fmaxf(t.m, bm);
    const float alpha = __builtin_amdgcn_exp2f(t.m - mnew);
    t.m = mnew;
    const float msub = (rf && mnew > -1e29f) ? mnew : __builtin_inff();
#pragma unroll
    for (int kt = 0; kt < 4; ++kt) s[kt] = s[kt] - msub;
    if (MODE == 1) t.l *= alpha;
    return alpha;
}
__device__ __forceinline__ void t_exp(f32x4 (&s)[4]) {
#pragma unroll
    for (int kt = 0; kt < 4; ++kt)
#pragma unroll
        for (int r = 0; r < 4; ++r) s[kt][r] = __builtin_amdgcn_exp2f(s[kt][r]);
}
__device__ __forceinline__ float quad_sum(float x) {
    x += __builtin_bit_cast(float, __builtin_amdgcn_mov_dpp(__builtin_bit_cast(int, x), 0xB1, 0xf, 0xf, true));
    x += __builtin_bit_cast(float, __builtin_amdgcn_mov_dpp(__builtin_bit_cast(int, x), 0x4E, 0xf, 0xf, true));
    return x;
}
__device__ __forceinline__ void t_imp(const Task& t, const f32x4 (&s)[4], int kb, int fq, LAS float* impbase) {
    float ga[4], gb[4];
#pragma unroll
    for (int kt = 0; kt < 4; ++kt) { ga[kt] = quad_sum((s[kt][0] + s[kt][1]) + (s[kt][2] + s[kt][3])); gb[kt] = quad_sum(s[kt][3]); }
    if ((t.imptok & 0x10000) == 0) return;
    LAS float* ip = impbase + (t.imptok & 0xffff) * 130 + (kb >> 2) + fq;
#pragma unroll
    for (int kt = 0; kt < 4; ++kt) { ip[4 * kt] = ga[kt]; ip[64 * 130 + 4 * kt] = gb[kt]; }
}
__device__ __forceinline__ bf16x8 t_pack(const f32x4 (&s)[4], int u) {
    u32x4 pw; pw.x = cvt_pk_bf16(s[2 * u][0], s[2 * u][1]); pw.y = cvt_pk_bf16(s[2 * u][2], s[2 * u][3]); pw.z = cvt_pk_bf16(s[2 * u + 1][0], s[2 * u + 1][1]); pw.w = cvt_pk_bf16(s[2 * u + 1][2], s[2 * u + 1][3]);
    return __builtin_bit_cast(bf16x8, pw);
}
template <int MODE, bool DA, bool DB>
__device__ __forceinline__ void do_blk(Task& a, Task& b, bool rfa, bool rfb, bool masked, LAS unsigned char* slot, int kb, LAS float* impbase, const LaneC& lc) {
    f32x4 sa[4], sb[4];
    const float xa = (MODE >= 2) ? (rfa ? a.cinit : -__builtin_inff()) : 0.f, xb = (MODE >= 2) ? (rfb ? b.cinit : -__builtin_inff()) : 0.f;
    const f32x4 ca = (f32x4){xa, xa, xa, xa}, cb = (f32x4){xb, xb, xb, xb};
#pragma unroll
    for (int kt = 0; kt < 4; ++kt) {
        const bf16x8 k0 = *(const LAS bf16x8*)(slot + lc.koff0 + kt * 2048), k1 = *(const LAS bf16x8*)(slot + lc.koff1 + kt * 2048);
        if (DA) { sa[kt] = __builtin_amdgcn_mfma_f32_16x16x32_bf16(k0, a.q[0], ca, 0, 0, 0); sa[kt] = __builtin_amdgcn_mfma_f32_16x16x32_bf16(k1, a.q[1], sa[kt], 0, 0, 0); }
        if (DB) { sb[kt] = __builtin_amdgcn_mfma_f32_16x16x32_bf16(k0, b.q[0], cb, 0, 0, 0); sb[kt] = __builtin_amdgcn_mfma_f32_16x16x32_bf16(k1, b.q[1], sb[kt], 0, 0, 0); }
    }
    if (masked) { if (DA) t_mask(a, sa, kb, lc.fq); if (DB) t_mask(b, sb, kb, lc.fq); }
    if (MODE < 2) {
        float ala = 1.0f, alb = 1.0f;
        if (DA) ala = t_stats<MODE>(a, sa, rfa);
        if (DB) alb = t_stats<MODE>(b, sb, rfb);
        if (MODE == 0) {
            if (__ballot((DA && ala != 1.0f) || (DB && alb != 1.0f)) != 0ull) {
#pragma unroll
                for (int dt = 0; dt < 4; ++dt) { if (DA) a.O[dt] = a.O[dt] * ala; if (DB) b.O[dt] = b.O[dt] * alb; }
                if (DA) a.L = a.L * ala; if (DB) b.L = b.L * alb;
            }
        }
    }
    if (DA) t_exp(sa);
    if (DB) t_exp(sb);
    if (MODE == 1) {
        if (DA) a.l += ((sa[0][0] + sa[0][1]) + (sa[0][2] + sa[0][3])) + ((sa[1][0] + sa[1][1]) + (sa[1][2] + sa[1][3])) + ((sa[2][0] + sa[2][1]) + (sa[2][2] + sa[2][3])) + ((sa[3][0] + sa[3][1]) + (sa[3][2] + sa[3][3]));
        if (DB) b.l += ((sb[0][0] + sb[0][1]) + (sb[0][2] + sb[0][3])) + ((sb[1][0] + sb[1][1]) + (sb[1][2] + sb[1][3])) + ((sb[2][0] + sb[2][1]) + (sb[2][2] + sb[2][3])) + ((sb[3][0] + sb[3][1]) + (sb[3][2] + sb[3][3]));
    }
    if (MODE == 2) { if (DA) t_imp(a, sa, kb, lc.fq, impbase); if (DB) t_imp(b, sb, kb, lc.fq, impbase); }
    if (MODE != 1) {
        const bf16x8 ones = (bf16x8){0x3F80, 0x3F80, 0x3F80, 0x3F80, 0x3F80, 0x3F80, 0x3F80, 0x3F80};
#pragma unroll
        for (int u = 0; u < 2; ++u) {
            bf16x8 pa, pb; if (DA) pa = t_pack(sa, u); if (DB) pb = t_pack(sb, u);
            if (MODE != 2) { if (DA) a.L = __builtin_amdgcn_mfma_f32_16x16x32_bf16(ones, pa, a.L, 0, 0, 0); if (DB) b.L = __builtin_amdgcn_mfma_f32_16x16x32_bf16(ones, pb, b.L, 0, 0, 0); }
#pragma unroll
            for (int dt = 0; dt < 4; ++dt) {
                const int vo = ((dt & 1) ? lc.voffB : lc.voffA) + (dt >> 1) * 4096 + u * 2048;
                const v4i16 a0 = tr_read((LAS v4i16*)(slot + vo)), a1 = tr_read((LAS v4i16*)(slot + vo + 1024));
                const bf16x8 vf = (bf16x8){a0[0], a0[1], a0[2], a0[3], a1[0], a1[1], a1[2], a1[3]};
                if (DA) a.O[dt] = __builtin_amdgcn_mfma_f32_16x16x32_bf16(vf, pa, a.O[dt], 0, 0, 0);
                if (DB) b.O[dt] = __builtin_amdgcn_mfma_f32_16x16x32_bf16(vf, pb, b.O[dt], 0, 0, 0);
            }
        }
    }
}
template <int MODE, int FM>
__device__ __forceinline__ void flash_loop(LAS unsigned char* ring, const bf16_t* Kg, const bf16_t* Vg, int nblk, Task& Ta, Task& Tb, LAS float* impbase, int wave, int lane) {
    const int i16 = lane & 15, fq = lane >> 4;
    const int kx = (i16 >> 1) & 7;
    const int q4 = i16 >> 2, p4 = lane & 3;
    LaneC lc; lc.fq = fq; lc.koff0 = i16 * 128 + ((fq ^ kx) << 4); lc.koff1 = i16 * 128 + (((4 + fq) ^ kx) << 4);
    lc.voffA = 8192 + (4 * fq + q4) * 64 + ((0 ^ (fq & 1)) << 5) + 8 * p4; lc.voffB = 8192 + (4 * fq + q4) * 64 + ((1 ^ (fq & 1)) << 5) + 8 * p4;
    const int amin = __builtin_amdgcn_readlane(Ta.kmin, 15), amax = __builtin_amdgcn_readlane(Ta.kmax, 0), bmin = __builtin_amdgcn_readlane(Tb.kmin, 15), bmax = __builtin_amdgcn_readlane(Tb.kmax, 0);
#pragma unroll
    for (int j = 0; j < NSLOT - 1; ++j) { const int jj = j < nblk ? j : nblk - 1; dma_block(ring + j * SLOT, Kg + (size_t)jj * 4096, Vg + (size_t)jj * 4096, wave, lane); }
    for (int jb = 0; jb < nblk; ++jb) {
        asm volatile("s_waitcnt vmcnt(4) lgkmcnt(0)\n\ts_barrier" ::: "memory");
        { const int jn = jb + 3 < nblk ? jb + 3 : nblk - 1; dma_block(ring + ((jb + 3) & 3) * SLOT, Kg + (size_t)jn * 4096, Vg + (size_t)jn * 4096, wave, lane); }
        LAS unsigned char* slot = ring + (jb & 3) * SLOT;
        const int kb = jb * 64;
        const bool rfa = row_flag<FM>(Ta, jb), rfb = row_flag<FM>(Tb, jb);
        const bool na = __ballot(rfa && Ta.kmax >= kb && Ta.kmin <= kb + 63) != 0ull, nb2 = __ballot(rfb && Tb.kmax >= kb && Tb.kmin <= kb + 63) != 0ull;
        const bool masked = !((!na || (kb >= amin && kb + 63 <= amax)) && (!nb2 || (kb >= bmin && kb + 63 <= bmax)));
        if (FM == 1) {
            if (na) do_blk<MODE, true, false>(Ta, Tb, rfa, rfb, masked, slot, kb, impbase, lc);
            if (nb2) do_blk<MODE, false, true>(Ta, Tb, rfa, rfb, masked, slot, kb, impbase, lc);
        } else {
            if (na || nb2) do_blk<MODE, true, true>(Ta, Tb, rfa, rfb, masked, slot, kb, impbase, lc);
        }
    }
    asm volatile("s_waitcnt vmcnt(0) lgkmcnt(0)\n\ts_barrier" ::: "memory");
}
template <int MODE, int FM>
__device__ __forceinline__ void flash_loop2(LAS unsigned char* ring, const bf16_t* Kg, const bf16_t* Vg, int nblk, Task& Ta, Task& Tb, LAS float* impbase, int wave, int lane) {
    const int i16 = lane & 15, fq = lane >> 4;
    const int kx = (i16 >> 1) & 7;
    const int q4 = i16 >> 2, p4 = lane & 3;
    LaneC lc; lc.fq = fq; lc.koff0 = i16 * 128 + ((fq ^ kx) << 4); lc.koff1 = i16 * 128 + (((4 + fq) ^ kx) << 4);
    lc.voffA = 8192 + (4 * fq + q4) * 64 + ((0 ^ (fq & 1)) << 5) + 8 * p4; lc.voffB = 8192 + (4 * fq + q4) * 64 + ((1 ^ (fq & 1)) << 5) + 8 * p4;
    const int amin = __builtin_amdgcn_readlane(Ta.kmin, 15), amax = __builtin_amdgcn_readlane(Ta.kmax, 0), bmin = __builtin_amdgcn_readlane(Tb.kmin, 15), bmax = __builtin_amdgcn_readlane(Tb.kmax, 0);
    const int nit = (nblk + 1) >> 1;
#pragma unroll
    for (int j = 0; j < 2; ++j) { const int jj = j < nblk ? j : nblk - 1; dma_block(ring + j * SLOT, Kg + (size_t)jj * 4096, Vg + (size_t)jj * 4096, wave, lane); }
    for (int i = 0; i < nit; ++i) {
        asm volatile("s_waitcnt vmcnt(0) lgkmcnt(0)\n\ts_barrier" ::: "memory");
#pragma unroll
        for (int j = 0; j < 2; ++j) { const int jn = 2 * i + 2 + j < nblk ? 2 * i + 2 + j : nblk - 1; dma_block(ring + ((2 * i + 2 + j) & 3) * SLOT, Kg + (size_t)jn * 4096, Vg + (size_t)jn * 4096, wave, lane); }
        if (FM == 1 && !SEL_FUSED) {
#pragma unroll
        for (int k = 0; k < 2; ++k) {
            const int jb = 2 * i + k;
            if (jb < nblk) {
                LAS unsigned char* slot = ring + (jb & 3) * SLOT;
                const int kb = jb * 64;
                const bool rfa = row_flag<FM>(Ta, jb), rfb = row_flag<FM>(Tb, jb);
                const bool na = __ballot(rfa && Ta.kmax >= kb && Ta.kmin <= kb + 63) != 0ull, nb2 = __ballot(rfb && Tb.kmax >= kb && Tb.kmin <= kb + 63) != 0ull;
                const bool masked = !((!na || (kb >= amin && kb + 63 <= amax)) && (!nb2 || (kb >= bmin && kb + 63 <= bmax)));
                if (na) do_blk<MODE, true, false>(Ta, Tb, rfa, rfb, masked, slot, kb, impbase, lc);
                if (nb2) do_blk<MODE, false, true>(Ta, Tb, rfa, rfb, masked, slot, kb, impbase, lc);
            }
        }
        } else {
            const int j0 = 2 * i, j1 = 2 * i + 1;
            const bool ra0 = row_flag<FM>(Ta, j0), rb0 = row_flag<FM>(Tb, j0), ra1 = j1 < nblk && row_flag<FM>(Ta, j1), rb1 = j1 < nblk && row_flag<FM>(Tb, j1);
            if (__ballot(ra0 || rb0 || ra1 || rb1) != 0ull) {
                const int k0 = j0 * 64, k1 = j1 * 64;
                const bool mk = (FM == 0) && !(k0 >= amin && k1 + 63 <= amax && k0 >= bmin && k1 + 63 <= bmax);
                if (!mk) {
                    do_blk<MODE, true, true>(Ta, Tb, ra0, rb0, false, ring + (j0 & 3) * SLOT, k0, impbase, lc);
                    if (FM == 0) __builtin_amdgcn_sched_barrier(0);
                    do_blk<MODE, true, true>(Ta, Tb, ra1, rb1, false, ring + (j1 & 3) * SLOT, k1, impbase, lc);
                } else {
                    do_blk<MODE, true, true>(Ta, Tb, ra0, rb0, true, ring + (j0 & 3) * SLOT, k0, impbase, lc);
                    __builtin_amdgcn_sched_barrier(0);
                    do_blk<MODE, true, true>(Ta, Tb, ra1, rb1, true, ring + (j1 & 3) * SLOT, k1, impbase, lc);
                }
            }
        }
    }
    asm volatile("s_waitcnt vmcnt(0) lgkmcnt(0)\n\ts_barrier" ::: "memory");
}
__device__ __forceinline__ void task_reset(Task& t) { t.m = NEGBIG; t.l = 0.f; t.cinit = 0.f; t.L = (f32x4){0.f, 0.f, 0.f, 0.f};
#pragma unroll
    for (int dt = 0; dt < 4; ++dt) t.O[dt] = (f32x4){0.f, 0.f, 0.f, 0.f}; }
__device__ __forceinline__ float task_rowsum(const Task& t) { return t.L[0]; }
__device__ __forceinline__ float task_rowsum_stats(const Task& t) { return xrow16_sum(t.l); }
constexpr float REF_DELTA = 32.f;
__device__ __forceinline__ void task_fix_ref(Task& t) {
    t.cinit = -(t.m + REF_DELTA);
    const float sc = __builtin_amdgcn_exp2f(-REF_DELTA);
    t.L = t.L * sc;
#pragma unroll
    for (int dt = 0; dt < 4; ++dt) t.O[dt] = t.O[dt] * sc;
}
}

struct NsaRow { int RI, c, b; u32x2 out[4];
    __device__ __forceinline__ int tokl() const { return RI >> 2; }
    __device__ __forceinline__ int head() const { return RI & 3; }
    __device__ __forceinline__ int tt() const { return 64 * c + (RI >> 2); }
    __device__ __forceinline__ size_t grow() const { return (size_t)(b * SEQ + 64 * c + (RI >> 2)); }
};
__device__ __forceinline__ void nsa_row_init(NsaRow& r, fa::Task& t, const bf16_t* Q, int b, int g, int c, int R, int fq) {
    r.RI = R; r.c = c; r.b = b;
    const bf16_t* qp = Q + r.grow() * DM + (g * 4 + r.head()) * DH + 8 * fq;
    t.q[0] = *(const bf16x8*)qp; t.q[1] = *(const bf16x8*)(qp + 32);
    t.imptok = r.tokl() | (r.head() == 0 ? 0x10000 : 0); t.fw0 = 0u; t.fwp = nullptr;
#pragma unroll
    for (int dt = 0; dt < 4; ++dt) r.out[dt] = (u32x2){0u, 0u};
}
__device__ __forceinline__ void nsa_cmp_setup(const NsaRow& r, fa::Task& t) {
    const int tt_ = r.tt(); const int nv = tt_ >= 31 ? (((tt_ - 31) >> 4) + 1 > 511 ? 511 : ((tt_ - 31) >> 4) + 1) : 0;
    t.kmin = 0; t.kmax = nv - 1; fa::task_reset(t);
}
__device__ __forceinline__ void nsa_accum(NsaRow& r, const fa::Task& t, float sc) {
#pragma unroll
    for (int dt = 0; dt < 4; ++dt) { const f32x4 o = t.O[dt] * sc; const u32x2 w = r.out[dt];
        r.out[dt] = (u32x2){pk2(bflo(w.x) + o[0], bfhi(w.x) + o[1]), pk2(bflo(w.y) + o[2], bfhi(w.y) + o[3])}; }
}
__device__ __forceinline__ void nsa_store(const NsaRow& r, bf16_t* AO, int g, int fq) {
    bf16_t* op = AO + r.grow() * DM + (g * 4 + r.head()) * DH + 16 * fq;
    u32x2 o[4] = {r.out[0], r.out[1], r.out[2], r.out[3]};
    fa::xpose_dt_fq(o);
    *(u32x4*)op = (u32x4){o[0].x, o[0].y, o[1].x, o[1].y}; *(u32x4*)(op + 8) = (u32x4){o[2].x, o[2].y, o[3].x, o[3].y};
}
__device__ __forceinline__ void ph_nsa_fa(const Ctx& C) {
    LAS unsigned char* L = (LAS unsigned char*)C.lds;
    LAS unsigned char* ring = L;
    LAS float* imp = (LAS float*)(L + 65536);
    LAS unsigned* selm = (LAS unsigned*)(L + 135168);
    const bf16_t* Q = (const bf16_t*)(C.ws + WS_Q); const bf16_t* KC = (const bf16_t*)(C.ws + WS_KC); const bf16_t* VC = (const bf16_t*)(C.ws + WS_VC);
    const bf16_t* KS = (const bf16_t*)(C.ws + WS_KV0 + 2 * KVSEG); const bf16_t* VS = (const bf16_t*)(C.ws + WS_KV0 + 3 * KVSEG);
    const bf16_t* KW = (const bf16_t*)(C.ws + WS_KV0 + 4 * KVSEG); const bf16_t* VW = (const bf16_t*)(C.ws + WS_KV0 + 5 * KVSEG);
    const float* gates = (const float*)(C.ws + WS_GATES); bf16_t* AO = (bf16_t*)(C.ws + WS_Q);
    const int wave = C.wave;
    for (int u = C.bid; u < NB * NG * (SEQ / 64); u += C.nb) {
        int lane = C.lane; asm volatile("" : "+v"(lane));
        const int i16 = lane & 15, fq = lane >> 4;
        const int rnd = u / C.nb, wg = u % C.nb, xm = wg >> 3, rr = rnd & 3;
        const int bg = (C.nb == 256) ? (wg & 7) + 8 * (rnd >> 2) : (u & 15), b = bg >> 2, g = bg & 3;
        const int c = (C.nb == 256) ? 127 - 32 * rr - ((rr & 1) ? 31 - xm : xm) : 127 - (u >> 4);
        fa::Task T0, T1; NsaRow R0, R1;
        nsa_row_init(R0, T0, Q, b, g, c, 32 * wave + i16, fq);
        nsa_row_init(R1, T1, Q, b, g, c, 32 * wave + 16 + i16, fq);
        float gpre[6];
#pragma unroll
        for (int q = 0; q < 3; ++q) { gpre[q] = gates[R0.grow() * 48 + 16 * q + g * 4 + R0.head()]; gpre[3 + q] = gates[R1.grow() * 48 + 16 * q + g * 4 + R1.head()]; }
        for (int i = C.tid; i < 2 * 64 * 130 / 4; i += NTHREADS) ((LAS f32x4*)imp)[i] = (f32x4){0.f, 0.f, 0.f, 0.f};
        if (C.tid < 256) selm[C.tid] = 0u;
        LAS float* gst = (LAS float*)(L + 136192) + (64 * wave + lane) * 6;
#pragma unroll
        for (int q = 0; q < 6; ++q) gst[q] = gpre[q];
        const int nvm = ((64 * c + 63 - 31) >> 4) + 1;
        const int nvmax = nvm > 511 ? 511 : nvm;
        const int nblkc = (nvmax + 63) >> 6;
        nsa_cmp_setup(R0, T0); nsa_cmp_setup(R1, T1);
        fa::flash_loop<1, 0>(ring, KC + (size_t)bg * 512 * DH, VC + (size_t)bg * 512 * DH, nblkc, T0, T1, imp, wave, lane);
        { const float l0 = fa::task_rowsum_stats(T0), l1 = fa::task_rowsum_stats(T1);
          T0.cinit = l0 > 0.f ? -T0.m - __builtin_amdgcn_logf(l0) : -__builtin_inff(); T1.cinit = l1 > 0.f ? -T1.m - __builtin_amdgcn_logf(l1) : -__builtin_inff(); }
        fa::flash_loop<2, 0>(ring, KC + (size_t)bg * 512 * DH, VC + (size_t)bg * 512 * DH, nblkc, T0, T1, imp, wave, lane);
        nsa_accum(R0, T0, gst[0]);
        nsa_accum(R1, T1, gst[3]);
        {
            const int jq = c, ncand = jq - 2 > 0 ? jq - 2 : 0, nforced = jq == 0 ? 1 : (jq == 1 ? 2 : 3), need = 16 - nforced;
#pragma unroll
            for (int g2 = 0; g2 < 2; ++g2) {
                const int tk = 8 * wave + 4 * g2 + (lane >> 4);
                unsigned key[8]; unsigned selb = 0u;
#pragma unroll
                for (int k = 0; k < 8; ++k) { const int j = i16 + 16 * k; const bool cand = j >= 1 && j <= jq - 2;
                    key[k] = cand ? ((__float_as_uint(imp[tk * 130 + j] + imp[64 * 130 + tk * 130 + j - 1]) & 0xFFFFFF80u) | (unsigned)(127 - j)) : 0u; }
                if (ncand <= need) {
#pragma unroll
                    for (int k = 0; k < 8; ++k) selb |= (key[k] != 0u) ? (1u << k) : 0u;
                } else {
                    for (int r = 0; r < need; ++r) {
                        unsigned m = max(max(max(key[0], key[1]), max(key[2], key[3])), max(max(key[4], key[5]), max(key[6], key[7])));
                        m = max(m, (unsigned)__builtin_amdgcn_mov_dpp((int)m, 0xB1, 0xf, 0xf, true));
                        m = max(m, (unsigned)__builtin_amdgcn_mov_dpp((int)m, 0x4E, 0xf, 0xf, true));
                        m = max(m, (unsigned)__builtin_amdgcn_mov_dpp((int)m, 0x141, 0xf, 0xf, true));
                        m = max(m, (unsigned)__builtin_amdgcn_mov_dpp((int)m, 0x140, 0xf, 0xf, true));
#pragma unroll
                        for (int k = 0; k < 8; ++k) { const bool hit = key[k] == m; selb |= hit ? (1u << k) : 0u; key[k] = hit ? 0u : key[k]; }
                    }
                }
#pragma unroll
                for (int k = 0; k < 8; ++k) { const int j = i16 + 16 * k; if (j == 0 || j == jq || j == jq - 1) selb |= 1u << k; }
#pragma unroll
                for (int w2 = 0; w2 < 4; ++w2) {
                    const unsigned bits = (((selb >> (2 * w2)) & 1u) << i16) | (((selb >> (2 * w2 + 1)) & 1u) << (16 + i16));
                    if (bits) __hip_atomic_fetch_or(selm + tk * 4 + w2, bits, __ATOMIC_RELAXED, __HIP_MEMORY_SCOPE_WORKGROUP);
                }
            }
        }
        asm volatile("s_waitcnt lgkmcnt(0)\n\ts_barrier" ::: "memory");
        {
            const int jlo = c - 8 > 0 ? c - 8 : 0;
            T0.kmin = 0; T0.kmax = R0.tokl(); fa::task_reset(T0); T1.kmin = 0; T1.kmax = R1.tokl(); fa::task_reset(T1);
            fa::flash_loop<0, 0>(ring, KW + ((size_t)bg * SEQ + 64 * c) * DH, VW + ((size_t)bg * SEQ + 64 * c) * DH, 1, T0, T1, imp, wave, lane);
            fa::task_fix_ref(T0); fa::task_fix_ref(T1);
            T0.kmin = R0.tt() - 511 - 64 * jlo; T0.kmax = R0.tt() - 64 * jlo; T1.kmin = R1.tt() - 511 - 64 * jlo; T1.kmax = R1.tt() - 64 * jlo;
            if (c > jlo) fa::flash_loop2<3, 0>(ring, KW + ((size_t)bg * SEQ + 64 * jlo) * DH, VW + ((size_t)bg * SEQ + 64 * jlo) * DH, c - jlo, T0, T1, imp, wave, lane);
            const float l0 = fa::task_rowsum(T0), l1 = fa::task_rowsum(T1);
            nsa_accum(R0, T0, (l0 > 0.f ? 1.0f / l0 : 0.f) * gst[2]);
            nsa_accum(R1, T1, (l1 > 0.f ? 1.0f / l1 : 0.f) * gst[5]);
        }
        {
            T0.fwp = selm + R0.tokl() * 4; T1.fwp = selm + R1.tokl() * 4;
            T0.kmin = 0; T0.kmax = R0.tokl(); fa::task_reset(T0); T1.kmin = 0; T1.kmax = R1.tokl(); fa::task_reset(T1);
            fa::flash_loop<0, 0>(ring, KS + ((size_t)bg * SEQ + 64 * c) * DH, VS + ((size_t)bg * SEQ + 64 * c) * DH, 1, T0, T1, imp, wave, lane);
            T0.kmax = R0.tt(); T1.kmax = R1.tt(); fa::task_fix_ref(T0); fa::task_fix_ref(T1);
            if (c > 0) fa::flash_loop2<3, 1>(ring, KS + (size_t)bg * SEQ * DH, VS + (size_t)bg * SEQ * DH, c, T0, T1, imp, wave, lane);
            const float l0 = fa::task_rowsum(T0), l1 = fa::task_rowsum(T1);
            nsa_accum(R0, T0, (l0 > 0.f ? 1.0f / l0 : 0.f) * gst[1]);
            nsa_accum(R1, T1, (l1 > 0.f ? 1.0f / l1 : 0.f) * gst[4]);
        }
        nsa_store(R0, AO, g, fq); nsa_store(R1, AO, g, fq);
    }
}

constexpr size_t WS_MMASK = 6 * MiB;
constexpr size_t WS_MCINIT = 8 * MiB;
constexpr size_t WS_MPL = 31 * MiB;
__device__ __forceinline__ size_t moba_po_off(int s, int b) { const int p = s * 4 + b; return p < 10 ? (353 + 8 * (size_t)p) * MiB : (10 + 8 * (size_t)(p - 10)) * MiB; }
__device__ __forceinline__ unsigned fp8_pack4(f32x4 v) { int w = 0; w = __builtin_amdgcn_cvt_pk_fp8_f32(v[0], v[1], w, false); w = __builtin_amdgcn_cvt_pk_fp8_f32(v[2], v[3], w, true); return (unsigned)w; }
__device__ __forceinline__ f32x4 fp8_unpack4(unsigned w) { const f32x2v lo = __builtin_amdgcn_cvt_pk_f32_fp8((int)w, false), hi = __builtin_amdgcn_cvt_pk_f32_fp8((int)w, true); return (f32x4){lo[0], lo[1], hi[0], hi[1]}; }
template <bool WITH_V>
__device__ __forceinline__ void moba_dma256(LAS unsigned char* ring, const bf16_t* K1, const bf16_t* V1, int bh, int blk, int wave, int lane) {
#pragma unroll
    for (int sb = 0; sb < 4; ++sb) fa::dma_block<WITH_V>(ring + sb * fa::SLOT, K1 + ((size_t)bh * SEQ + 256 * blk + 64 * sb) * DH, V1 + ((size_t)bh * SEQ + 256 * blk + 64 * sb) * DH, wave, lane);
}
__device__ __forceinline__ void moba_stage_kmt(LAS unsigned char* kmt, const float* KMP, const float* KMX, int bh, int tid) {
    if (tid < 256) {
        const int n = tid >> 3, c8 = tid & 7;
        const float* p0 = KMP + ((size_t)(bh * 32 + n) * 2) * 64 + 8 * c8; const float* x0 = KMX + ((size_t)(bh * 32 + n) * 2) * 64 + 8 * c8;
        const f32x4 a = (*(const f32x4*)p0 + *(const f32x4*)(p0 + 64)) * (1.0f / 256.0f), b2 = (*(const f32x4*)(p0 + 4) + *(const f32x4*)(p0 + 68)) * (1.0f / 256.0f);
        u32x4 hi, lo;
        hi.x = pk2(a[0], a[1]); hi.y = pk2(a[2], a[3]); hi.z = pk2(b2[0], b2[1]); hi.w = pk2(b2[2], b2[3]);
        lo.x = pk2(a[0] - bflo(hi.x), a[1] - bfhi(hi.x)); lo.y = pk2(a[2] - bflo(hi.y), a[3] - bfhi(hi.y)); lo.z = pk2(b2[0] - bflo(hi.z), b2[1] - bfhi(hi.z)); lo.w = pk2(b2[2] - bflo(hi.w), b2[3] - bfhi(hi.w));
        const int off = n * 128 + ((c8 ^ ((n >> 1) & 7)) << 4);
        *(LAS u32x4*)(kmt + off) = hi; *(LAS u32x4*)(kmt + 4096 + off) = lo;
        const f32x4 m0 = *(const f32x4*)x0, m1 = *(const f32x4*)(x0 + 64), m2 = *(const f32x4*)(x0 + 4), m3 = *(const f32x4*)(x0 + 68);
        float s = 0.f;
#pragma unroll
        for (int q = 0; q < 4; ++q) { const float u0 = fmaxf(m0[q], m1[q]), u1 = fmaxf(m2[q], m3[q]); s += u0 * u0 + u1 * u1; }
        s += __shfl_xor(s, 1); s += __shfl_xor(s, 2); s += __shfl_xor(s, 4);
        if (c8 == 0) ((LAS float*)(kmt + 8192))[n] = s;
    }
}
__device__ __forceinline__ void ph_moba_sel(const Ctx& C) {
    LAS unsigned char* L = (LAS unsigned char*)C.lds;
    LAS unsigned char* kmt = L + 131072;
    const bf16_t* Q = (const bf16_t*)(C.ws + WS_Q); const bf16_t* K1 = (const bf16_t*)(C.ws + WS_K1);
    const float* KMP = (const float*)(C.ws + WS_KMP); const float* KMX = (const float*)(C.ws + WS_KMX); unsigned* MM = (unsigned*)(C.ws + WS_MMASK); float* CI = (float*)(C.ws + WS_MCINIT);
    const int wave = C.wave;
    const int nk = (NB * NH * 32 - C.bid + C.nb - 1) / C.nb;
    const bool bh_const = (C.nb & 63) == 0;
    if (nk > 0 && bh_const) { moba_stage_kmt(kmt, KMP, KMX, C.bid & 63, C.tid); __syncthreads(); }
    bf16x8 nq[2][2], nkk[2][2];
#define MOBA_SEL_LOAD(u_) do { int lane_ = C.lane; asm volatile("" : "+v"(lane_)); const int bh_ = (u_) & 63, cb_ = 31 - ((u_) >> 6); \
        _Pragma("unroll") for (int ti = 0; ti < 2; ++ti) { const int t_ = 256 * cb_ + 32 * wave + 16 * ti + (lane_ & 15); \
            const bf16_t* qp_ = Q + (size_t)((bh_ >> 4) * SEQ + t_) * DM + (bh_ & 15) * DH + 8 * (lane_ >> 4); nq[ti][0] = *(const bf16x8*)qp_; nq[ti][1] = *(const bf16x8*)(qp_ + 32); \
            nkk[ti][0] = (bf16x8){0, 0, 0, 0, 0, 0, 0, 0}; nkk[ti][1] = nkk[ti][0]; \
            if (cb_ == 0) { const bf16_t* kp_ = K1 + ((size_t)bh_ * SEQ + t_) * DH + 8 * (lane_ >> 4); nkk[ti][0] = *(const bf16x8*)kp_; nkk[ti][1] = *(const bf16x8*)(kp_ + 32); } } } while (0)
    if (nk > 0) MOBA_SEL_LOAD(C.bid);
    for (int k = 0; k < nk; ++k) {
        const int u = C.bid + k * C.nb;
        int lane = C.lane; asm volatile("" : "+v"(lane));
        const int i16 = lane & 15, fq = lane >> 4;
        const int bh = u & 63, cb = 31 - (u >> 6);
        if (!bh_const) { __syncthreads(); moba_stage_kmt(kmt, KMP, KMX, bh, C.tid); __syncthreads(); }
        float kmax2 = (lane <= cb) ? ((const LAS float*)(kmt + 8192))[lane] : 0.f;
        kmax2 = wave_max(kmax2);
        bf16x8 q[2][2], ks[2][2];
#pragma unroll
        for (int ti = 0; ti < 2; ++ti) { q[ti][0] = nq[ti][0]; q[ti][1] = nq[ti][1]; ks[ti][0] = nkk[ti][0]; ks[ti][1] = nkk[ti][1]; }
        if (k + 1 < nk) MOBA_SEL_LOAD(u + C.nb);
#pragma unroll
        for (int ti = 0; ti < 2; ++ti) {
            const int tt = 256 * cb + 32 * wave + 16 * ti + i16;
            const int kx = (i16 >> 1) & 7, ko0 = i16 * 128 + ((fq ^ kx) << 4), ko1 = i16 * 128 + (((4 + fq) ^ kx) << 4);
            unsigned key[8];
#pragma unroll
            for (int kt2 = 0; kt2 < 2; ++kt2) {
                const bf16x8 h0 = *(const LAS bf16x8*)(kmt + ko0 + kt2 * 2048), h1 = *(const LAS bf16x8*)(kmt + ko1 + kt2 * 2048);
                const bf16x8 l0 = *(const LAS bf16x8*)(kmt + 4096 + ko0 + kt2 * 2048), l1 = *(const LAS bf16x8*)(kmt + 4096 + ko1 + kt2 * 2048);
                f32x4 g = __builtin_amdgcn_mfma_f32_16x16x32_bf16(l0, q[ti][0], (f32x4){0.f, 0.f, 0.f, 0.f}, 0, 0, 0);
                g = __builtin_amdgcn_mfma_f32_16x16x32_bf16(l1, q[ti][1], g, 0, 0, 0);
                g = __builtin_amdgcn_mfma_f32_16x16x32_bf16(h0, q[ti][0], g, 0, 0, 0);
                g = __builtin_amdgcn_mfma_f32_16x16x32_bf16(h1, q[ti][1], g, 0, 0, 0);
#pragma unroll
                for (int r = 0; r < 4; ++r) { const int n = 16 * kt2 + 4 * fq + r; const unsigned ub = __float_as_uint(g[r]);
                    const unsigned um = (ub & 0x80000000u) ? ~ub : (ub | 0x80000000u);
                    key[4 * kt2 + r] = n < cb ? ((um & ~31u) | (unsigned)(31 - n)) : 0u; }
            }
            unsigned mk = 0u; unsigned kbest = 0u;
#pragma unroll
            for (int rd = 0; rd < 3; ++rd) {
                unsigned m = max(max(max(key[0], key[1]), max(key[2], key[3])), max(max(key[4], key[5]), max(key[6], key[7])));
                { const auto s_ = __builtin_amdgcn_permlane16_swap(m, m, false, false); m = max(s_[0], s_[1]); }
                { const auto s_ = __builtin_amdgcn_permlane32_swap(m, m, false, false); m = max(s_[0], s_[1]); }
                if (rd == 0) kbest = m;
                mk |= m != 0u ? (1u << (31 - (int)(m & 31u))) : 0u;
#pragma unroll
                for (int k = 0; k < 8; ++k) key[k] = key[k] == m ? 0u : key[k];
            }
            const bool hassel = kbest != 0u;
            float bv0; { const unsigned um = kbest & ~31u; bv0 = __uint_as_float((um & 0x80000000u) ? (um & 0x7fffffffu) : ~um); }
            float qq = 0.f, qk = 0.f;
#pragma unroll
            for (int w2 = 0; w2 < 2; ++w2)
#pragma unroll
                for (int e = 0; e < 8; ++e) { const float a = bf2f((bf16_t)q[ti][w2][e]), b2 = bf2f((bf16_t)ks[ti][w2][e]); qq += a * a; qk += a * b2; }
            qq = fa::xrow16_sum(qq); qk = fa::xrow16_sum(qk);
            const float bound = sqrtf(qq * kmax2) * 1.0001f + 1e-3f;
            const float ref = (hassel || cb == 0) ? fminf(bound, (hassel ? bv0 : qk) + 100.f) : bound;
            if (fq == 0) { MM[(size_t)bh * SEQ + tt] = mk; CI[(size_t)bh * SEQ + tt] = -ref; }
        }
    }
#undef MOBA_SEL_LOAD
    asm volatile("s_waitcnt vmcnt(0) lgkmcnt(0)\n\ts_barrier" ::: "memory");
}
struct MobaPair { bf16x8 qa0, qa1, qb0, qb1; float ca, cb; unsigned ma, mb; int rowa, rowb; bool va, vb; };
__device__ __forceinline__ void ph_moba_gather(const Ctx& C) {
    LAS unsigned char* L = (LAS unsigned char*)C.lds;
    LAS unsigned* cnt = (LAS unsigned*)(L + 131072 + 2 * 15872);
    const bf16_t* Q = (const bf16_t*)(C.ws + WS_Q); const bf16_t* K1 = (const bf16_t*)(C.ws + WS_K1); const bf16_t* V1 = (const bf16_t*)(C.ws + WS_V1);
    const unsigned* MM = (const unsigned*)(C.ws + WS_MMASK); const float* CI = (const float*)(C.ws + WS_MCINIT); f32x2v* PL = (f32x2v*)(C.ws + WS_MPL);
    const int wave = C.wave;
    const int nk = (NB * NH * 32 - C.bid + C.nb - 1) / C.nb;
    if (C.tid < 3) cnt[C.tid] = 0u;
    __syncthreads();
#define MOBA_UNIT(k_, bh_, j_) do { const int u_ = C.bid + (k_) * C.nb, rnd_ = u_ / C.nb, idx_ = (u_ % C.nb) >> 6; bh_ = u_ & 63; j_ = (C.nb == 256) ? 4 * rnd_ + ((rnd_ & 1) ? 3 - idx_ : idx_) : (u_ >> 6); } while (0)
#define MOBA_MASKS(mv_, bh_, j_, tid_) do { const unsigned* mp_ = MM + (size_t)(bh_) * SEQ + 256 * ((j_) + 1); \
        _Pragma("unroll") for (int i_ = 0; i_ < 4; ++i_) mv_[i_] = *(const u32x4*)(mp_ + 4 * (tid_) + 2048 * i_); } while (0)
#define MOBA_SCAN(mv_, j_, list_, cw_, lane_, tid_) do { const int r0_ = 256 * ((j_) + 1); const unsigned long long lt_ = (1ull << (lane_)) - 1ull; \
        _Pragma("unroll") for (int i_ = 0; i_ < 4; ++i_) { const bool in_ = r0_ + 4 * (tid_) + 2048 * i_ < SEQ; \
            const bool s0_ = in_ && ((mv_[i_].x >> (j_)) & 1u), s1_ = in_ && ((mv_[i_].y >> (j_)) & 1u), s2_ = in_ && ((mv_[i_].z >> (j_)) & 1u), s3_ = in_ && ((mv_[i_].w >> (j_)) & 1u); \
            const unsigned long long b0_ = __ballot(s0_), b1_ = __ballot(s1_), b2_ = __ballot(s2_), b3_ = __ballot(s3_); \
            const int c0_ = __popcll(b0_), c1_ = __popcll(b1_), c2_ = __popcll(b2_), c3_ = __popcll(b3_), tot_ = c0_ + c1_ + c2_ + c3_; \
            if (tot_) { unsigned base_ = 0u; if ((lane_) == 0) base_ = __hip_atomic_fetch_add((cw_), (unsigned)tot_, __ATOMIC_RELAXED, __HIP_MEMORY_SCOPE_WORKGROUP); \
                base_ = __builtin_amdgcn_readfirstlane(base_); const int rb_ = r0_ + 4 * (tid_) + 2048 * i_; \
                if (s0_) (list_)[base_ + __popcll(b0_ & lt_)] = (unsigned short)rb_; \
                if (s1_) (list_)[base_ + c0_ + __popcll(b1_ & lt_)] = (unsigned short)(rb_ + 1); \
                if (s2_) (list_)[base_ + c0_ + c1_ + __popcll(b2_ & lt_)] = (unsigned short)(rb_ + 2); \
                if (s3_) (list_)[base_ + c0_ + c1_ + c2_ + __popcll(b3_ & lt_)] = (unsigned short)(rb_ + 3); } } } while (0)
#define MOBA_LOAD_PAIR(P_, bh_, list_, n_, p_, i16_, fq_) do { const int ia_ = 32 * (p_) + (i16_), ib_ = ia_ + 16; P_.va = ia_ < (n_); P_.vb = ib_ < (n_); \
            P_.rowa = (list_)[P_.va ? ia_ : 0] & 8191; P_.rowb = (list_)[P_.vb ? ib_ : 0] & 8191; \
            { const bf16_t* qp_ = Q + (size_t)(((bh_) >> 4) * SEQ + P_.rowa) * DM + ((bh_) & 15) * DH + 8 * (fq_); P_.qa0 = *(const bf16x8*)qp_; P_.qa1 = *(const bf16x8*)(qp_ + 32); } \
            { const bf16_t* qp_ = Q + (size_t)(((bh_) >> 4) * SEQ + P_.rowb) * DM + ((bh_) & 15) * DH + 8 * (fq_); P_.qb0 = *(const bf16x8*)qp_; P_.qb1 = *(const bf16x8*)(qp_ + 32); } \
            P_.ca = CI[(size_t)(bh_) * SEQ + P_.rowa]; P_.cb = CI[(size_t)(bh_) * SEQ + P_.rowb]; P_.ma = MM[(size_t)(bh_) * SEQ + P_.rowa]; P_.mb = MM[(size_t)(bh_) * SEQ + P_.rowb]; } while (0)
    int nkv = nk;
    while (nkv > 0) { int bh_, j_; MOBA_UNIT(nkv - 1, bh_, j_); if (j_ < 31) break; --nkv; }
    if (nkv > 0) {
        int bhc = 0, jc = 0; MOBA_UNIT(0, bhc, jc);
        u32x4 mv[4]; MobaPair cur, nxt;
        u32x4 sta = (u32x4){0u, 0u, 0u, 0u}, stb = sta; float sla = 0.f, slb = 0.f, sia = 0.f, sib = 0.f; int srowa = 0, srowb = 0, ssa = 0, ssb = 0, sbh = 0; bool sva = false, svb = false;
#define MOBA_STORE_STASH(fq_) do { \
                if (sva) { *(u32x4*)(C.ws + moba_po_off(ssa, sbh >> 4) + ((size_t)(sbh & 15) * SEQ + srowa) * 64 + 16 * (fq_)) = sta; \
                    if ((fq_) == 0) PL[((size_t)ssa * 64 + sbh) * SEQ + srowa] = (f32x2v){sla, sia}; } \
                if (svb) { *(u32x4*)(C.ws + moba_po_off(ssb, sbh >> 4) + ((size_t)(sbh & 15) * SEQ + srowb) * 64 + 16 * (fq_)) = stb; \
                    if ((fq_) == 0) PL[((size_t)ssb * 64 + sbh) * SEQ + srowb] = (f32x2v){slb, sib}; } } while (0)
        { int lane = C.lane; asm volatile("" : "+v"(lane));
          const int tid = 64 * wave + lane;
          moba_dma256<true>(L, K1, V1, bhc, jc, wave, lane); MOBA_MASKS(mv, bhc, jc, tid);
          MOBA_SCAN(mv, jc, (LAS unsigned short*)(L + 131072), cnt + 0, lane, tid);
          if (nkv > 1) { int bh1, j1; MOBA_UNIT(1, bh1, j1); MOBA_MASKS(mv, bh1, j1, tid); }
          asm volatile("s_waitcnt lgkmcnt(0)\n\ts_barrier" ::: "memory");
          { const int n0 = (int)cnt[0]; MOBA_LOAD_PAIR(cur, bhc, (LAS unsigned short*)(L + 131072), n0, wave, lane & 15, lane >> 4); } }
        int c3 = 0;
        for (int k = 0; k < nkv; ++k) {
            int lane = C.lane; asm volatile("" : "+v"(lane));
            const int i16 = lane & 15, fq = lane >> 4, tid = 64 * wave + lane;
            LAS unsigned char* ring = L + (k & 1) * 65536;
            LAS unsigned short* list = (LAS unsigned short*)(L + 131072 + (k & 1) * 15872);
            LAS unsigned short* listn = (LAS unsigned short*)(L + 131072 + ((k + 1) & 1) * 15872);
            const int bh = bhc, j = jc, c3n = c3 == 2 ? 0 : c3 + 1, c3r = c3n == 2 ? 0 : c3n + 1;
            const bool has_next = k + 1 < nkv;
            int bhn = bh, jn = j;
            if (has_next) { MOBA_UNIT(k + 1, bhn, jn); }
            asm volatile("s_waitcnt lgkmcnt(0)\n\ts_barrier" ::: "memory");
            if (has_next) MOBA_SCAN(mv, jn, listn, cnt + c3n, lane, tid);
            asm volatile("s_waitcnt vmcnt(0) lgkmcnt(0)\n\ts_barrier" ::: "memory");
            asm volatile("" :: "v"(cur.qa0), "v"(cur.qa1), "v"(cur.qb0), "v"(cur.qb1), "v"(cur.ca), "v"(cur.cb), "v"(cur.ma), "v"(cur.mb));
            if (tid == 0) cnt[c3r] = 0u;
            if (has_next) moba_dma256<true>(L + ((k + 1) & 1) * 65536, K1, V1, bhn, jn, wave, lane);
            if (k + 2 < nkv) { int bh2, j2; MOBA_UNIT(k + 2, bh2, j2); MOBA_MASKS(mv, bh2, j2, tid); }
            const int n = (int)cnt[c3], npair = (n + 31) >> 5, n1 = has_next ? (int)cnt[c3n] : 0;
            const fa::LaneC lc = fa::lane_consts(lane);
            for (int p = wave; p < npair; p += NWAVES) {
                MOBA_STORE_STASH(fq);
                if (p + NWAVES < npair) MOBA_LOAD_PAIR(nxt, bh, list, n, p + NWAVES, i16, fq);
                else MOBA_LOAD_PAIR(nxt, bhn, listn, n1, wave, i16, fq);
                __builtin_amdgcn_sched_barrier(0);
                fa::Task Ta, Tb;
                fa::task_reset(Ta); fa::task_reset(Tb); Ta.kmin = 0; Ta.kmax = 0x7fffffff; Tb.kmin = 0; Tb.kmax = 0x7fffffff; Ta.imptok = 0; Tb.imptok = 0;
                Ta.q[0] = cur.qa0; Ta.q[1] = cur.qa1; Tb.q[0] = cur.qb0; Tb.q[1] = cur.qb1; Ta.cinit = cur.ca; Tb.cinit = cur.cb;
#pragma unroll
                for (int sb = 0; sb < 4; ++sb) { fa::do_blk<3, true, true>(Ta, Tb, cur.va, cur.vb, false, ring + sb * fa::SLOT, 0, nullptr, lc); if (sb & 1) __builtin_amdgcn_sched_barrier(0); }
                { float ma_ = 0.f, mb_ = 0.f;
#pragma unroll
                  for (int dt = 0; dt < 4; ++dt)
#pragma unroll
                      for (int r = 0; r < 4; ++r) { ma_ = fmaxf(ma_, fabsf(Ta.O[dt][r])); mb_ = fmaxf(mb_, fabsf(Tb.O[dt][r])); }
                  ma_ = fa::xrow16_max(ma_); mb_ = fa::xrow16_max(mb_);
                  const float sca = ma_ > 1e-36f ? 224.f * __builtin_amdgcn_rcpf(ma_) : 0.f, scb = mb_ > 1e-36f ? 224.f * __builtin_amdgcn_rcpf(mb_) : 0.f;
                  sia = ma_ > 1e-36f ? ma_ * (1.f / 224.f) : 0.f; sib = mb_ > 1e-36f ? mb_ * (1.f / 224.f) : 0.f;
                  unsigned a0 = fp8_pack4(Ta.O[0] * sca), a1 = fp8_pack4(Ta.O[1] * sca), a2 = fp8_pack4(Ta.O[2] * sca), a3 = fp8_pack4(Ta.O[3] * sca);
                  unsigned b0 = fp8_pack4(Tb.O[0] * scb), b1 = fp8_pack4(Tb.O[1] * scb), b2 = fp8_pack4(Tb.O[2] * scb), b3 = fp8_pack4(Tb.O[3] * scb);
                  fa::xpose_dt_fq(a0, a1, a2, a3); fa::xpose_dt_fq(b0, b1, b2, b3);
                  sta = (u32x4){a0, a1, a2, a3}; stb = (u32x4){b0, b1, b2, b3}; }
                sla = Ta.L[0]; slb = Tb.L[0]; srowa = cur.rowa; srowb = cur.rowb; ssa = __popc(cur.ma & ((1u << j) - 1u)); ssb = __popc(cur.mb & ((1u << j) - 1u)); sva = cur.va; svb = cur.vb; sbh = bh;
                cur = nxt;
            }
            if (wave >= npair) MOBA_LOAD_PAIR(cur, bhn, listn, n1, wave, i16, fq);
            bhc = bhn; jc = jn; c3 = c3n;
        }
        { int lane = C.lane; asm volatile("" : "+v"(lane)); MOBA_STORE_STASH(lane >> 4); }
#undef MOBA_STORE_STASH
    }
#undef MOBA_LOAD_PAIR
#undef MOBA_SCAN
#undef MOBA_UNIT
#undef MOBA_MASKS
    asm volatile("s_waitcnt vmcnt(0) lgkmcnt(0)\n\ts_barrier" ::: "memory");
}
__device__ __forceinline__ void ph_moba_own(const Ctx& C) {
    LAS unsigned char* L = (LAS unsigned char*)C.lds;
    const bf16_t* Q = (const bf16_t*)(C.ws + WS_Q); const bf16_t* K1 = (const bf16_t*)(C.ws + WS_K1); const bf16_t* V1 = (const bf16_t*)(C.ws + WS_V1);
    const unsigned* MM = (const unsigned*)(C.ws + WS_MMASK); const float* CI = (const float*)(C.ws + WS_MCINIT); const f32x2v* PL = (const f32x2v*)(C.ws + WS_MPL);
    bf16_t* AO = (bf16_t*)(C.ws + WS_Q);
    const int wave = C.wave;
    const int nk = (NB * NH * 32 - C.bid + C.nb - 1) / C.nb;
    bf16x8 nq[2][2]; float nci[2]; unsigned nmk[2];
#define MOBA_OWN_LOAD(u_) do { int lane_ = C.lane; asm volatile("" : "+v"(lane_)); const int bh_ = (u_) & 63, cb_ = 31 - ((u_) >> 6); \
        _Pragma("unroll") for (int ti = 0; ti < 2; ++ti) { const int t_ = 256 * cb_ + 32 * wave + 16 * ti + (lane_ & 15); \
            const bf16_t* qp_ = Q + (size_t)((bh_ >> 4) * SEQ + t_) * DM + (bh_ & 15) * DH + 8 * (lane_ >> 4); nq[ti][0] = *(const bf16x8*)qp_; nq[ti][1] = *(const bf16x8*)(qp_ + 32); \
            nci[ti] = CI[(size_t)bh_ * SEQ + t_]; nmk[ti] = MM[(size_t)bh_ * SEQ + t_]; } } while (0)
    u32x2 st[2][4]; int stt[2] = {0, 0}, sbh = 0; bool spend = false;
#pragma unroll
    for (int ti = 0; ti < 2; ++ti)
#pragma unroll
        for (int dt = 0; dt < 4; ++dt) st[ti][dt] = (u32x2){0u, 0u};
#define MOBA_OWN_STORE() do { int lane_ = C.lane; asm volatile("" : "+v"(lane_)); \
        _Pragma("unroll") for (int ti = 0; ti < 2; ++ti) { bf16_t* op_ = AO + (size_t)((sbh >> 4) * SEQ + stt[ti]) * DM + (sbh & 15) * DH + 16 * (lane_ >> 4); \
            *(u32x4*)op_ = (u32x4){st[ti][0].x, st[ti][0].y, st[ti][1].x, st[ti][1].y}; *(u32x4*)(op_ + 8) = (u32x4){st[ti][2].x, st[ti][2].y, st[ti][3].x, st[ti][3].y}; } } while (0)
    if (nk > 0) { moba_dma256<true>(L, K1, V1, C.bid & 63, 31 - (C.bid >> 6), wave, C.lane); MOBA_OWN_LOAD(C.bid); }
    for (int k = 0; k < nk; ++k) {
        const int u = C.bid + k * C.nb;
        int lane = C.lane; asm volatile("" : "+v"(lane));
        const int i16 = lane & 15, fq = lane >> 4;
        const int bh = u & 63, b = bh >> 4, h = bh & 15, cb = 31 - (u >> 6);
        LAS unsigned char* ring = L + (k & 1) * 65536;
        asm volatile("s_waitcnt vmcnt(0) lgkmcnt(0)\n\ts_barrier" ::: "memory");
        if (spend) MOBA_OWN_STORE();
        if (k + 1 < nk) { const int un = u + C.nb; moba_dma256<true>(L + ((k + 1) & 1) * 65536, K1, V1, un & 63, 31 - (un >> 6), wave, lane); }
        fa::Task T[2]; int tt[2]; unsigned mk[2];
#pragma unroll
        for (int ti = 0; ti < 2; ++ti) {
            const int R = 32 * wave + 16 * ti + i16; tt[ti] = 256 * cb + R; T[ti].imptok = 0;
            T[ti].q[0] = nq[ti][0]; T[ti].q[1] = nq[ti][1];
            T[ti].kmin = 0; T[ti].kmax = R; fa::task_reset(T[ti]);
            T[ti].cinit = nci[ti]; mk[ti] = nmk[ti];
        }
        u32x4 pw[2][3]; f32x2v pl[2][3];
#pragma unroll
        for (int ti = 0; ti < 2; ++ti)
#pragma unroll
            for (int s = 0; s < 3; ++s) {
                pw[ti][s] = *(const u32x4*)(C.ws + moba_po_off(s, b) + ((size_t)h * SEQ + tt[ti]) * 64 + 16 * fq);
                pl[ti][s] = PL[((size_t)s * 64 + bh) * SEQ + tt[ti]];
            }
        if (k + 1 < nk) MOBA_OWN_LOAD(u + C.nb);
        __builtin_amdgcn_sched_barrier(0);
        { const fa::LaneC lc = fa::lane_consts(lane);
#pragma unroll
          for (int sb = 0; sb < 4; ++sb) if (64 * sb <= 32 * wave + 31) fa::do_blk<3, true, true>(T[0], T[1], true, true, 64 * sb + 63 > 32 * wave, ring + sb * fa::SLOT, 64 * sb, nullptr, lc); }
#pragma unroll
        for (int ti = 0; ti < 2; ++ti) {
            const int ns = __popc(mk[ti]); float l = fa::task_rowsum(T[ti]);
            fa::xpose_dt_fq(T[ti].O);
#pragma unroll
            for (int s = 0; s < 3; ++s) {
                const bool own = s < ns;
#pragma unroll
                for (int k2 = 0; k2 < 4; ++k2) { const f32x4 add = fp8_unpack4(pw[ti][s][k2]) * pl[ti][s][1]; T[ti].O[k2] = own ? T[ti].O[k2] + add : T[ti].O[k2]; }
                l = own ? l + pl[ti][s][0] : l;
            }
            const float sc_ = l > 0.f ? 1.0f / l : 0.f;
#pragma unroll
            for (int dt = 0; dt < 4; ++dt) { const f32x4 o = T[ti].O[dt] * sc_; st[ti][dt] = (u32x2){pk2(o[0], o[1]), pk2(o[2], o[3])}; }
            stt[ti] = tt[ti];
        }
        sbh = bh; spend = true;
    }
    if (spend) MOBA_OWN_STORE();
#undef MOBA_OWN_LOAD
#undef MOBA_OWN_STORE
    asm volatile("s_waitcnt vmcnt(0) lgkmcnt(0)\n\ts_barrier" ::: "memory");
}

struct Route { int e0, s0, e1, s1; float w0, w1; int pad0, pad1; };
__device__ __forceinline__ void ph_ln_route(const Ctx& C, int layer) {
    const float* resid = C.in[I_X]; const bf16_t* residb = (const bf16_t*)(C.ws + WS_XB)  ; const bf16_t* MIX = (const bf16_t*)(C.ws + WS_MIX);
    bf16_t* X1B = (bf16_t*)(C.ws + WS_X1B); Route* RT = (Route*)(C.ws + WS_ROUTE);
    int* rowlist = (int*)(C.ws + WS_ROWLIST); unsigned* cnt = (unsigned*)(C.ws + WS_CTL) + (layer ? CW_CNT1 : CW_CNT0);
    const float* lg = C.in[I_LNG] + (size_t)(layer * 2 + 0) * DM; const float* lb = C.in[I_LNB] + (size_t)(layer * 2 + 0) * DM;
    const float* rw = C.in[I_RW]; const float* rb = C.in[I_RB];
    LAS unsigned* lcnt = (LAS unsigned*)C.lds;
    LAS float* rec = (LAS float*)(C.lds + 256);
    LAS float* lsb = (LAS float*)(C.lds + 4096 + C.wave * 512);
    const int lane = C.lane;
    LAS unsigned char* rwl = (LAS unsigned char*)(C.lds + 8192);
#pragma unroll
    for (int gi = C.tid; gi < DM * NE / 4; gi += NTHREADS) { const int c = gi >> 2, e4 = gi & 3;
        *(LAS f32x4*)(rwl + (c >> 8) * 17408 + ((c & 255) >> 2) * 272 + (c & 3) * 64 + e4 * 16) = ((const f32x4*)rw)[gi]; }
    __syncthreads();
    for (int chunk = C.bid; chunk < NTOK / 128; chunk += C.nb) {
        if (C.tid < 16) lcnt[C.tid] = 0u;
        __syncthreads();
        u32x2 nq[2][4], nw[2][4];
#define LNR_LOAD(row0_) do { _Pragma("unroll") for (int r = 0; r < 2; ++r) { const u32x2* xb_ = (const u32x2*)(residb + (size_t)((row0_) + r) * DM) + lane; const u32x2* mr_ = (const u32x2*)(MIX + (size_t)((row0_) + r) * DM) + lane; \
            _Pragma("unroll") for (int j = 0; j < 4; ++j) { nq[r][j] = __builtin_nontemporal_load(xb_ + 64 * j); nw[r][j] = __builtin_nontemporal_load(mr_ + 64 * j); } } } while (0)
        LNR_LOAD(chunk * 128 + C.wave * 16);
        for (int i2 = 0; i2 < 8; ++i2) {
            const int rl0 = C.wave * 16 + i2 * 2, row0 = chunk * 128 + rl0;
            f32x4 v[2][4]; float s[2], s2[2];
#pragma unroll
            for (int r = 0; r < 2; ++r) { s[r] = 0.f;
#pragma unroll
                for (int j = 0; j < 4; ++j) { const u32x2 w = nw[r][j], q = nq[r][j]; const f32x4 xv = (f32x4){bflo(q.x), bfhi(q.x), bflo(q.y), bfhi(q.y)};
                    v[r][j] = xv * DN_ALPHA + (f32x4){bflo(w.x), bfhi(w.x), bflo(w.y), bfhi(w.y)};
                    s[r] += (v[r][j][0] + v[r][j][1]) + (v[r][j][2] + v[r][j][3]); } }
            if (i2 + 1 < 8) LNR_LOAD(row0 + 2);
            { s[0] = wave_sum(s[0]); s[1] = wave_sum(s[1]); }
#pragma unroll
            for (int r = 0; r < 2; ++r) { const float mean = s[r] * (1.f / DM); s2[r] = 0.f;
#pragma unroll
                for (int j = 0; j < 4; ++j) { v[r][j] = v[r][j] - mean; s2[r] += (v[r][j][0] * v[r][j][0] + v[r][j][1] * v[r][j][1]) + (v[r][j][2] * v[r][j][2] + v[r][j][3] * v[r][j][3]); } }
            { s2[0] = wave_sum(s2[0]); s2[1] = wave_sum(s2[1]); }
            const float rstd0 = __builtin_amdgcn_rsqf(s2[0] * (1.f / DM) + LN_EPS), rstd1 = __builtin_amdgcn_rsqf(s2[1] * (1.f / DM) + LN_EPS);
            float p[32];
#pragma unroll
            for (int q = 0; q < 32; ++q) p[q] = 0.f;
#pragma unroll
            for (int j = 0; j < 4; ++j) {
                const int c0 = 4 * lane + 256 * j;
                const f32x4 gg = *(const f32x4*)(lg + c0), bb = *(const f32x4*)(lb + c0);
#pragma unroll
                for (int r = 0; r < 2; ++r) {
                    v[r][j] = v[r][j] * (r ? rstd1 : rstd0) * gg + bb;
                    *(u32x2*)(X1B + (size_t)(row0 + r) * DM + c0) = (u32x2){pk2(v[r][j][0], v[r][j][1]), pk2(v[r][j][2], v[r][j][3])}; }
#pragma unroll
                for (int q = 0; q < 4; ++q) {
                    const LAS f32x4* wr = (const LAS f32x4*)(rwl + j * 17408 + lane * 272 + q * 64);
                    const f32x4 w0 = wr[0], w1 = wr[1], w2 = wr[2], w3 = wr[3];
#pragma unroll
                    for (int r = 0; r < 2; ++r) { const float x = v[r][j][q];
                        p[16 * r + 0] += x * w0[0]; p[16 * r + 1] += x * w0[1]; p[16 * r + 2] += x * w0[2]; p[16 * r + 3] += x * w0[3];
                        p[16 * r + 4] += x * w1[0]; p[16 * r + 5] += x * w1[1]; p[16 * r + 6] += x * w1[2]; p[16 * r + 7] += x * w1[3];
                        p[16 * r + 8] += x * w2[0]; p[16 * r + 9] += x * w2[1]; p[16 * r + 10] += x * w2[2]; p[16 * r + 11] += x * w2[3];
                        p[16 * r + 12] += x * w3[0]; p[16 * r + 13] += x * w3[1]; p[16 * r + 14] += x * w3[2]; p[16 * r + 15] += x * w3[3]; }
                    if (q == 3) asm volatile("" ::: "memory");
                }
            }
            {
#pragma unroll
                for (int q = 0; q < 16; ++q) { const auto s_ = __builtin_amdgcn_permlane32_swap(__float_as_uint(p[q]), __float_as_uint(p[q + 16]), false, false); p[q] = __uint_as_float(s_[0]) + __uint_as_float(s_[1]); }
#pragma unroll
                for (int q = 0; q < 8; ++q) { const auto s_ = __builtin_amdgcn_permlane16_swap(__float_as_uint(p[q]), __float_as_uint(p[q + 8]), false, false); p[q] = __uint_as_float(s_[0]) + __uint_as_float(s_[1]); }
                { const bool up = (lane & 8) != 0;
#pragma unroll
                  for (int q = 0; q < 4; ++q) { const float keep = up ? p[q + 4] : p[q], send = up ? p[q] : p[q + 4]; p[q] = keep + DPPF(send, 0x128); } }
                { const bool up = (lane & 4) != 0;
#pragma unroll
                  for (int q = 0; q < 2; ++q) { const float keep = up ? p[q + 2] : p[q], send = up ? p[q] : p[q + 2]; p[q] = keep + __shfl_xor(send, 4); } }
                { const bool up = (lane & 2) != 0; const float keep = up ? p[1] : p[0], send = up ? p[0] : p[1]; p[0] = keep + DPPF(send, 0x4E); }
            }
            p[0] += DPPF(p[0], 0xB1);
            const float sc_own = 1.0f / (1.0f + expf(-p[0]));
            if ((lane & 1) == 0) { lsb[lane >> 1] = sc_own; lsb[32 + (lane >> 1)] = sc_own + rb[(lane >> 1) & 15]; }
            WAVE_LDS_SYNC();
            float sc[16], bi[16];
            { const LAS f32x4* a4 = (const LAS f32x4*)(lsb + ((lane >> 5) << 4)); const LAS f32x4* b4 = (const LAS f32x4*)(lsb + 32 + ((lane >> 5) << 4));
#pragma unroll
              for (int q = 0; q < 4; ++q) { const f32x4 x = a4[q], y = b4[q]; sc[4 * q] = x[0]; sc[4 * q + 1] = x[1]; sc[4 * q + 2] = x[2]; sc[4 * q + 3] = x[3]; bi[4 * q] = y[0]; bi[4 * q + 1] = y[1]; bi[4 * q + 2] = y[2]; bi[4 * q + 3] = y[3]; } }
            WAVE_LDS_SYNC();
            int gsel = 0; float gbest = -3e38f;
#pragma unroll
            for (int gq = 0; gq < 4; ++gq) {
                float m1 = -3e38f, m2 = -3e38f;
#pragma unroll
                for (int q = 0; q < 4; ++q) { const float x = bi[4 * gq + q]; const bool c1 = x > m1, c2 = x > m2; m2 = c1 ? m1 : (c2 ? x : m2); m1 = c1 ? x : m1; }
                const float gs = m1 + m2; const bool cg = gs > gbest; gbest = cg ? gs : gbest; gsel = cg ? gq : gsel;
            }
            int e0 = 0, e1 = 0; float b0 = -3e38f, b1 = -3e38f, w0 = 0.f, w1 = 0.f;
#pragma unroll
            for (int e = 0; e < 16; ++e) {
                const float x = bi[e]; const bool in = (e >> 2) == gsel, c0 = in && x > b0, c1 = in && !c0 && x > b1;
                b1 = c0 ? b0 : (c1 ? x : b1); e1 = c0 ? e0 : (c1 ? e : e1); w1 = c0 ? w0 : (c1 ? sc[e] : w1);
                b0 = c0 ? x : b0; e0 = c0 ? e : e0; w0 = c0 ? sc[e] : w0;
            }
            if ((lane & 31) == 0) {
                const int rl = rl0 + (lane >> 5);
                const float ws_ = w0 + w1;
                const unsigned l0 = __hip_atomic_fetch_add(lcnt + e0, 1u, __ATOMIC_RELAXED, __HIP_MEMORY_SCOPE_WORKGROUP), l1 = __hip_atomic_fetch_add(lcnt + e1, 1u, __ATOMIC_RELAXED, __HIP_MEMORY_SCOPE_WORKGROUP);
                LAS float* r = rec + rl * 6; r[0] = __int_as_float(e0); r[1] = __int_as_float(e1); r[2] = __uint_as_float(l0); r[3] = __uint_as_float(l1); r[4] = w0 / ws_; r[5] = w1 / ws_;
            }
        }
        __syncthreads();
        if (C.tid < 16) lcnt[16 + C.tid] = atomicAdd(cnt + 64 * C.tid, lcnt[C.tid]);
        __syncthreads();
        if (C.tid < 128) {
            const LAS float* r = rec + C.tid * 6; const int row = chunk * 128 + C.tid;
            const int e0 = __float_as_int(r[0]), e1 = __float_as_int(r[1]);
            const int s0 = (int)(lcnt[16 + e0] + __float_as_uint(r[2])), s1 = (int)(lcnt[16 + e1] + __float_as_uint(r[3]));
            rowlist[e0 * NTOK + s0] = row; rowlist[e1 * NTOK + s1] = row;
            Route rr; rr.e0 = e0; rr.s0 = s0; rr.e1 = e1; rr.s1 = s1; rr.w0 = r[4]; rr.w1 = r[5]; rr.pad0 = 0; rr.pad1 = 0;
            RT[row] = rr;
        }
        __syncthreads();
    }
}
__device__ __forceinline__ void ph_combine(const Ctx& C, int layer, float* outp, LAS int* sm) {
    const bf16_t* X1B = (const bf16_t*)(C.ws + WS_X1B); const bf16_t* Y2 = (const bf16_t*)(C.ws + WS_Y2); const Route* RT = (const Route*)(C.ws + WS_ROUTE);
    bf16_t* XB = (bf16_t*)(C.ws + WS_XB);
    const float* lg = C.in[I_LNG] + (size_t)(layer * 2 + 1) * DM; const float* lb = C.in[I_LNB] + (size_t)(layer * 2 + 1) * DM;
    const int gw = C.bid * NWAVES + C.wave, NGW = C.nb * NWAVES, lane = C.lane;
    Route rn = RT[gw < NTOK ? gw : 0], rn2 = RT[gw + NGW < NTOK ? gw + NGW : 0];
    u32x2 na[4], nb2[4], nx[4];
#define COMBINE_LOAD(row_, r_) do { const bf16_t* y0_ = Y2 + (size_t)(sm[16 + (r_).e0] + (r_).s0) * DM; const bf16_t* y1_ = Y2 + (size_t)(sm[16 + (r_).e1] + (r_).s1) * DM; \
        const u32x2* xr_ = (const u32x2*)(X1B + (size_t)(row_) * DM) + lane; \
        _Pragma("unroll") for (int j = 0; j < 4; ++j) { const int c0 = 4 * lane + 256 * j; na[j] = __builtin_nontemporal_load((const u32x2*)(y0_ + c0)); nb2[j] = __builtin_nontemporal_load((const u32x2*)(y1_ + c0)); nx[j] = __builtin_nontemporal_load(xr_ + 64 * j); } } while (0)
    if (gw < NTOK) COMBINE_LOAD(gw, rn);
    for (int row = gw; row < NTOK; row += NGW) {
        const Route r = rn;
        u32x2 ca[4], cb[4], cx[4];
#pragma unroll
        for (int j = 0; j < 4; ++j) { ca[j] = na[j]; cb[j] = nb2[j]; cx[j] = nx[j]; }
        rn = rn2;
        if (row + NGW < NTOK) COMBINE_LOAD(row + NGW, rn);
        rn2 = RT[row + 2 * NGW < NTOK ? row + 2 * NGW : row];
        f32x4 v[4]; float s = 0.f;
#pragma unroll
        for (int j = 0; j < 4; ++j) {
            const u32x2 a = ca[j], b = cb[j], x = cx[j];
            const f32x4 ya = (f32x4){bflo(a.x), bfhi(a.x), bflo(a.y), bfhi(a.y)}, yb = (f32x4){bflo(b.x), bfhi(b.x), bflo(b.y), bfhi(b.y)}, xv = (f32x4){bflo(x.x), bfhi(x.x), bflo(x.y), bfhi(x.y)};
            v[j] = xv * DN_ALPHA + ya * r.w0 + yb * r.w1;
            s += (v[j][0] + v[j][1]) + (v[j][2] + v[j][3]);
        }
        const float mean = wave_sum(s) * (1.f / DM); float s2 = 0.f;
#pragma unroll
        for (int j = 0; j < 4; ++j) { v[j] = v[j] - mean; s2 += (v[j][0] * v[j][0] + v[j][1] * v[j][1]) + (v[j][2] * v[j][2] + v[j][3] * v[j][3]); }
        const float rstd = __builtin_amdgcn_rsqf(wave_sum(s2) * (1.f / DM) + LN_EPS);
#pragma unroll
        for (int j = 0; j < 4; ++j) {
            const int c0 = 4 * lane + 256 * j;
            const f32x4 gg = *(const f32x4*)(lg + c0), bb = *(const f32x4*)(lb + c0);
            v[j] = v[j] * rstd * gg + bb;
            if (layer) __builtin_nontemporal_store(v[j], (f32x4*)(outp + (size_t)row * DM + c0));
            else *(u32x2*)(XB + (size_t)row * DM + c0) = (u32x2){pk2(v[j][0], v[j][1]), pk2(v[j][2], v[j][3])};
        }
    }
#undef COMBINE_LOAD
}

constexpr int NPHASE = 21;
__global__ void __launch_bounds__(NTHREADS, 2) fwd(Args args) {
    extern __shared__ __attribute__((aligned(16))) unsigned char lds[];
    Ctx C;
#pragma unroll
    for (int i = 0; i < 18; ++i) C.in[i] = args.in[i];
    C.out = args.out; C.ws = args.ws; C.lds = lds;
    C.tid = threadIdx.x; C.lane = C.tid & 63; C.wave = __builtin_amdgcn_readfirstlane(C.tid >> 6); C.bid = blockIdx.x; C.nb = gridDim.x;
    LAS unsigned* misc = (LAS unsigned*)(lds + LDS_BYTES - 512);
    LAS int* sm = (LAS int*)(misc + 16);
    if (C.tid < 4) misc[C.tid] = 0u;
    __syncthreads();
#if MK_SINGLE
    XcdBarrier bar = xcd_barrier_post((unsigned*)(C.ws + WS_CTL) + CW_BAR, (volatile LAS unsigned*)misc);
#define SEAM() xcd_barrier(bar)
#else
#define SEAM() do {} while (0)
#endif
    const int lo = args.ph_lo, hi = args.ph_hi;
#ifndef PH_MASK
#define PH_MASK 0xFFFFFFFFu
#endif
#define IN(k) (((PH_MASK >> (k)) & 1u) && lo <= (k) && (k) < hi)
#define BOTH(k) (IN(k) && IN((k) + 1))
#if defined(STAMP_LO)
    unsigned long long st0 = 0, st1 = 0;
#define TS(k) do { if ((k) == STAMP_LO) st0 = __builtin_amdgcn_s_memrealtime(); if ((k) == STAMP_HI) st1 = __builtin_amdgcn_s_memrealtime(); } while (0)
#else
#define TS(k) do {} while (0)
#endif
    unsigned char* ws = C.ws;
    const float2* rope = (const float2*)(ws + WS_ROPE);
    LAS unsigned char* L = (LAS unsigned char*)lds;

    TS(0); if (IN(0)) { ph_prologue(C); if (BOTH(0)) SEAM(); }
    TS(1); if (IN(1)) {
        EpiNsaIn E{(bf16_t*)(ws + WS_Q), (bf16_t*)(ws + WS_KV0), (float*)(ws + WS_GATES), rope};
        g8::StaticOrder S; S.init(NTOK / 256, 2560 / 256, C.nb, C.bid);
        g8::gemm8<false>(L, (const bf16_t*)(ws + WS_XB), DM, (const bf16_t*)(ws + WS_WT_NSA_IN), DM, S, g8::EpiEl<EpiNsaIn>{E}, g8::GatherInfo{nullptr, sm});
        if (BOTH(1)) SEAM();
    }
    TS(2); if (IN(2)) {
        EpiCmp EK{(const float*)(ws + WS_BIAS1), (const bf16_t*)(ws + WS_W2T), rope, (bf16_t*)(ws + WS_KC)}, EV{(const float*)(ws + WS_BIAS1) + 256, (const bf16_t*)(ws + WS_W2T) + 64 * 256, nullptr, (bf16_t*)(ws + WS_VC)};
        g8::StaticOrder SK, SV; SK.init(32, 1, C.nb, C.bid); SV.init(32, 1, C.nb, (C.bid + C.nb / 2) % C.nb);
        g8::gemm8<false>(L, (const bf16_t*)(ws + WS_KV0), 1024, (const bf16_t*)(ws + WS_WT_C1K), 2048, SK, EK, g8::GatherInfo{nullptr, sm});
        g8::gemm8<false>(L, (const bf16_t*)(ws + WS_KV0 + KVSEG), 1024, (const bf16_t*)(ws + WS_WT_C1V), 2048, SV, EV, g8::GatherInfo{nullptr, sm});
        if (C.nb == 256 && !((C.bid < 32) || (C.bid >= 128 && C.bid < 160))) {
            EpiNsaIn E{(bf16_t*)(ws + WS_Q), (bf16_t*)(ws + WS_KV0), (float*)(ws + WS_GATES), rope};
            const int gidx = C.bid < 128 ? C.bid - 32 : C.bid - 64, fr = C.lane & 15, fq = C.lane >> 4;
            for (int tile = gidx * NWAVES + C.wave; tile < 1024; tile += 192 * NWAVES) {
                const int row0 = tile * 32, col0 = 2560;
                const bf16_t* a0 = (const bf16_t*)(ws + WS_XB) + (size_t)(row0 + fr) * DM + fq * 8;
                const bf16_t* b0 = (const bf16_t*)(ws + WS_WT_NSA_IN) + (size_t)(col0 + fr) * DM + fq * 8;
                f32x4 acc[2][4]; mma_core64(a0, b0, 16 * DM, 16 * DM, DM, acc);
#pragma unroll
                for (int mi = 0; mi < 2; ++mi)
#pragma unroll
                    for (int ni = 0; ni < 4; ++ni) E(row0 + 16 * mi + fr, col0 + 16 * ni + 4 * fq, acc[mi][ni]);
            }
            { float* scr = (float*)(C.lds + C.wave * 9216);
              run_transposes(C, 2, gidx * NWAVES + C.wave, NE * 512 + (NE - PRO_L0E) * 512, 192 * NWAVES, scr); }
        } else if (C.nb != 256) {
            EpiNsaIn E{(bf16_t*)(ws + WS_Q), (bf16_t*)(ws + WS_KV0), (float*)(ws + WS_GATES), rope};
            const int fr = C.lane & 15, fq = C.lane >> 4;
            for (int tile = C.bid * NWAVES + C.wave; tile < 2048; tile += C.nb * NWAVES) {
                const int row0 = (tile >> 1) * 32, col0 = 2560 + (tile & 1) * 32;
                const bf16_t* a0 = (const bf16_t*)(ws + WS_XB) + (size_t)(row0 + fr) * DM + fq * 8; const bf16_t* a1 = a0 + (size_t)16 * DM;
                const bf16_t* b0 = (const bf16_t*)(ws + WS_WT_NSA_IN) + (size_t)(col0 + fr) * DM + fq * 8; const bf16_t* b1 = b0 + (size_t)16 * DM;
                f32x4 acc[2][2]; mma_core(a0, a1, b0, b1, DM, acc);
#pragma unroll
                for (int mi = 0; mi < 2; ++mi)
#pragma unroll
                    for (int ni = 0; ni < 2; ++ni) E(row0 + 16 * mi + fr, col0 + 16 * ni + 4 * fq, acc[mi][ni]);
            }
        }
        if (C.nb != 256) { __syncthreads(); float* scr = (float*)(C.lds + C.wave * 9216);
            run_transposes(C, 2, C.bid * NWAVES + C.wave, NE * 512 + (NE - PRO_L0E) * 512, C.nb * NWAVES, scr); }
        if (BOTH(2)) SEAM();
    }
    TS(4); if (IN(4)) { ph_nsa_fa(C); if (BOTH(4)) SEAM(); }
    TS(6); if (IN(6)) {
        EpiBf16 E{(bf16_t*)(ws + WS_MIX)};
        g8::StaticOrder S; S.init(NTOK / 256, DM / 256, C.nb, C.bid);
        g8::gemm8<false>(L, (const bf16_t*)(ws + WS_Q), DM, (const bf16_t*)(ws + WS_WT_NSA_OUT), DM, S, g8::EpiEl<EpiBf16>{E}, g8::GatherInfo{nullptr, sm});
        if (BOTH(6)) SEAM();
    }
    TS(7); if (IN(7)) { ph_ln_route(C, 0); if (BOTH(7)) SEAM(); }
    TS(8); if (IN(8)) {
        load_expert_map(C, CW_CNT0, sm);
        EpiSwiGLU E{(bf16_t*)(ws + WS_HBUF)};
        g8::GroupedOrder S; S.init(sm, 4, C.nb, C.bid);
        g8::gemm8<true>(L, (const bf16_t*)(ws + WS_X1B), DM, (const bf16_t*)(ws + WS_WT_GU), 1024, S, g8::EpiEl<EpiSwiGLU>{E}, g8::GatherInfo{(const int*)(ws + WS_ROWLIST), sm});
        {
            const int tl = ((sm[32] / g8::BM) * 4) % C.nb;
            if (C.bid >= tl) { float* scr = (float*)(C.lds + C.wave * 9216); run_transposes(C, -2, (C.bid - tl) * NWAVES + C.wave, DEF_NIT, (C.nb - tl) * NWAVES, scr); }
        }
        if (BOTH(8)) SEAM();
    }
    TS(9); if (IN(9)) {
        load_expert_map(C, CW_CNT0, sm);
        EpiBf16 E{(bf16_t*)(ws + WS_Y2)};
        g8::GroupedOrder S; S.init(sm, 4, C.nb, C.bid);
        g8::gemm8<false>(L, (const bf16_t*)(ws + WS_HBUF), DE, (const bf16_t*)(ws + WS_WT_DN), DE, S, g8::EpiEl<EpiBf16>{E}, g8::GatherInfo{nullptr, sm});
        {
            const int tl = ((sm[32] / g8::BM) * 4) % C.nb;
            if (C.bid >= tl) { float* scr = (float*)(C.lds + C.wave * 9216); run_transposes(C, -4, (C.bid - tl) * NWAVES + C.wave, DEF2_NIT, (C.nb - tl) * NWAVES, scr); }
        }
        if (BOTH(9)) SEAM();
    }
    TS(10); if (IN(10)) {
        load_expert_map(C, CW_CNT0, sm);
        ph_combine(C, 0, (float*)(ws + WS_XR), sm);
        if (BOTH(10)) SEAM();
    }
    TS(11); if (IN(11)) {
        EpiMobaIn E{(bf16_t*)(ws + WS_Q), (bf16_t*)(ws + WS_K1), (bf16_t*)(ws + WS_V1), rope};
        g8::StaticOrder S; S.init(NTOK / 256, 3072 / 256, C.nb, C.bid);
        g8::gemm8<false>(L, (const bf16_t*)(ws + WS_XB), DM, (const bf16_t*)(ws + WS_WT_MOBA_IN), DM, S, EpiMobaInKM{E, (float*)(ws + WS_KMP), (float*)(ws + WS_KMX)}, g8::GatherInfo{nullptr, sm});
        if (BOTH(11)) SEAM();
    }
    TS(12);
    TS(13); if (IN(13)) { ph_moba_sel(C); if (BOTH(13)) SEAM(); }
    TS(14); if (IN(14)) { ph_moba_gather(C); if (BOTH(14)) SEAM(); }
    TS(15); if (IN(15)) { ph_moba_own(C); if (BOTH(15)) SEAM(); }
    TS(16); if (IN(16)) {
        EpiBf16 E{(bf16_t*)(ws + WS_MIX)};
        g8::StaticOrder S; S.init(NTOK / 256, DM / 256, C.nb, C.bid);
        g8::gemm8<false>(L, (const bf16_t*)(ws + WS_Q), DM, (const bf16_t*)(ws + WS_WT_MOBA_OUT), DM, S, g8::EpiEl<EpiBf16>{E}, g8::GatherInfo{nullptr, sm});
        if (BOTH(16)) SEAM();
    }
    TS(17); if (IN(17)) {
        ph_ln_route(C, 1);
        if (BOTH(17)) SEAM();
    }
    TS(18); if (IN(18)) {
        load_expert_map(C, CW_CNT1, sm);
        EpiSwiGLU E{(bf16_t*)(ws + WS_HBUF)};
        g8::GroupedOrder S; S.init(sm, 4, C.nb, C.bid);
        g8::gemm8<true>(L, (const bf16_t*)(ws + WS_X1B), DM, (const bf16_t*)(ws + WS_WT_GU1), 1024, S, g8::EpiEl<EpiSwiGLU>{E}, g8::GatherInfo{(const int*)(ws + WS_ROWLIST), sm});
        {
            const int tl = ((sm[32] / g8::BM) * 4) % C.nb;
            if (C.bid >= tl) { float* scr = (float*)(C.lds + C.wave * 9216); run_transposes(C, -3, (C.bid - tl) * NWAVES + C.wave, NE * 256, (C.nb - tl) * NWAVES, scr); }
        }
        if (BOTH(18)) SEAM();
    }
    TS(19); if (IN(19)) {
        load_expert_map(C, CW_CNT1, sm);
        EpiBf16 E{(bf16_t*)(ws + WS_Y2)};
        g8::GroupedOrder S; S.init(sm, 4, C.nb, C.bid);
        g8::gemm8<false>(L, (const bf16_t*)(ws + WS_HBUF), DE, (const bf16_t*)(ws + WS_WT_DN1), DE, S, g8::EpiEl<EpiBf16>{E}, g8::GatherInfo{nullptr, sm});
        if (BOTH(19)) SEAM();
    }
    TS(20); if (IN(20)) {
        load_expert_map(C, CW_CNT1, sm);
        ph_combine(C, 1, C.out, sm);
    }
#if defined(STAMP_LO)
    TS(NPHASE);
    if (C.bid == 0) { const unsigned long long d = (st1 - st0) * STAMP_MUL, te = __builtin_amdgcn_s_memrealtime(); while (__builtin_amdgcn_s_memrealtime() - te < d) __builtin_amdgcn_s_sleep(8); }
#endif
#undef IN
#undef BOTH
}

extern "C" void kernel_launch(void* const* d_in, const int* in_sizes, int n_in, void* d_out, int out_size, void* d_ws, size_t ws_size, hipStream_t stream) {
    static int grid = 0;
    if (grid == 0) {
        if (n_in != 18 || in_sizes[0] != NTOK * DM || out_size != NTOK * DM || ws_size < WS_END) {
            fprintf(stderr, "kernel_launch: unexpected shapes (n_in %d, in0 %d, out %d, ws %zu; need ws >= %zu); nothing launched\n", n_in, n_in > 0 ? in_sizes[0] : -1, out_size, ws_size, (size_t)WS_END);
            grid = -1; return;
        }
        int dev = 0, cus = 0, per_cu = 0;
        if (hipGetDevice(&dev) != hipSuccess || hipDeviceGetAttribute(&cus, hipDeviceAttributeMultiprocessorCount, dev) != hipSuccess) { grid = -1; return; }
        if (hipFuncSetAttribute((const void*)fwd, hipFuncAttributeMaxDynamicSharedMemorySize, LDS_BYTES) != hipSuccess) { fprintf(stderr, "kernel_launch: hipFuncSetAttribute failed\n"); grid = -1; return; }
        if (hipOccupancyMaxActiveBlocksPerMultiprocessor(&per_cu, (const void*)fwd, NTHREADS, LDS_BYTES) != hipSuccess || per_cu < 1)
            fprintf(stderr, "kernel_launch: occupancy query reports %d blocks per CU\n", per_cu);
        (void)hipGetLastError();
        grid = cus;
        if (grid != 256) { fprintf(stderr, "kernel_launch: built for a 256-CU device (got %d CUs); nothing launched\n", cus); grid = -1; return; }
    }
    if (grid < 0) return;
    if (hipMemsetAsync((char*)d_ws + WS_CTL, 0, CTL_BYTES, stream) != hipSuccess) { fprintf(stderr, "kernel_launch: memset failed\n"); return; }
    Args a{};
    for (int i = 0; i < 18; ++i) a.in[i] = (const float*)d_in[i];
    a.out = (float*)d_out; a.ws = (unsigned char*)d_ws;
#if defined(PROBE_PH)
    { const int lo3[3] = {0, PROBE_PH, PROBE_PH + 1}, hi3[3] = {PROBE_PH + 1, PROBE_PH + 1, NPHASE};
      for (int q = 0; q < 3; ++q) { if (lo3[q] >= hi3[q]) continue;
          if (q) (void)hipMemsetAsync((char*)d_ws + WS_CTL + CW_BAR * 4, 0, XCD_BAR_WORDS * 4, stream);
          a.ph_lo = lo3[q]; a.ph_hi = hi3[q]; hipLaunchKernelGGL(fwd, dim3(grid), dim3(NTHREADS), LDS_BYTES, stream, a); } }
#elif MK_SINGLE
    a.ph_lo = 0; a.ph_hi = NPHASE;
    hipLaunchKernelGGL(fwd, dim3(grid), dim3(NTHREADS), LDS_BYTES, stream, a);
#else
    for (int p = 0; p < NPHASE; ++p) { a.ph_lo = p; a.ph_hi = p + 1; hipLaunchKernelGGL(fwd, dim3(grid), dim3(NTHREADS), LDS_BYTES, stream, a); }
#endif
    const hipError_t le = hipPeekAtLastError();
    if (le != hipSuccess) fprintf(stderr, "kernel_launch: launch failed: %s\n", hipGetErrorName(le));
}
```
